# Optimizing an MI355X kernel written in HIP

```python
import jax
import jax.numpy as jnp
from jax import lax
import numpy as np

D_MODEL = 2048
BATCH = 2
SEQ = 8192
DEPTH = 1

N_MEM = 256
HEAD_DIM = 64
FOX_HEADS = 12
SWA_HEADS = 12
SWA_KV_HEADS = 4
SWA_GROUP = SWA_HEADS // SWA_KV_HEADS
WINDOW = 128
XMEM_HEADS = 4
XMEM_HEAD_DIM = 128
Q_BLOCK = 128
N_EXPERTS = 32
TOP_K = 4
D_EXPERT = D_MODEL
SWIGLU_LIMIT = 7.0
SWIGLU_ALPHA = 1.702
ROPE_THETA = 10000.0
NORM_EPS = 1e-6
MOE_BLOCK = 256
POS_OFFSET_MAX = 1024
FORGET_BIAS_INIT = 3.0

FOX_W = FOX_HEADS * HEAD_DIM
SWA_QW = SWA_HEADS * HEAD_DIM
SWA_KVW = SWA_KV_HEADS * HEAD_DIM
XMEM_W = XMEM_HEADS * XMEM_HEAD_DIM
IN_SPLITS = (FOX_W, FOX_W, FOX_W, FOX_HEADS, SWA_QW, SWA_KVW, SWA_KVW, XMEM_W, D_MODEL, D_MODEL, D_MODEL)
IN_WIDTH = sum(IN_SPLITS)

kernel_name = 'hybrid_fox_swa_xmem_moe_layer'


def rms_norm(x, gain):
    x32 = x.astype(jnp.float32)
    x32 = x32 * lax.rsqrt(jnp.mean(x32 * x32, axis=-1, keepdims=True) + NORM_EPS)
    return x32.astype(x.dtype) * gain


def rope(x, positions):
    d = x.shape[-1]
    inv_freq = jnp.power(ROPE_THETA, -jnp.arange(0, d, 2, dtype=jnp.float32) / d)
    ang = positions.astype(jnp.float32)[..., None] * inv_freq
    cos = jnp.cos(ang)[:, :, None, :]
    sin = jnp.sin(ang)[:, :, None, :]
    x32 = x.astype(jnp.float32)
    x1, x2 = jnp.split(x32, 2, axis=-1)
    return jnp.concatenate([x1 * cos - x2 * sin, x2 * cos + x1 * sin], axis=-1).astype(x.dtype)


def forgetting_attention(q, k, v, log_f):
    B, S, H, d = q.shape
    nb = S // Q_BLOCK
    scale = d ** -0.5
    c = jnp.cumsum(log_f, axis=1).transpose(0, 2, 1)
    k_pos = jnp.arange(S)
    q_blocks = q.reshape(B, nb, Q_BLOCK, H, d).transpose(1, 0, 2, 3, 4)
    c_blocks = c.reshape(B, H, nb, Q_BLOCK).transpose(2, 0, 1, 3)

    def one_block(args):
        qb, cb, blk = args
        s = jnp.einsum('bqhd,bshd->bhqs', qb, k, preferred_element_type=jnp.float32) * scale
        s = s + cb[..., :, None] - c[:, :, None, :]
        q_pos = blk * Q_BLOCK + jnp.arange(Q_BLOCK)
        causal = k_pos[None, :] <= q_pos[:, None]
        s = jnp.where(causal, s, -jnp.inf)
        p = jax.nn.softmax(s, axis=-1)
        return jnp.einsum('bhqs,bshd->bqhd', p.astype(v.dtype), v)

    out = lax.map(one_block, (q_blocks, c_blocks, jnp.arange(nb)))
    return out.transpose(1, 0, 2, 3, 4).reshape(B, S, H * d)


def sliding_window_attention(q, k, v, sinks):
    B, S, Hq, d = q.shape
    nb = S // WINDOW
    qb = q.reshape(B, nb, WINDOW, SWA_KV_HEADS, SWA_GROUP, d)

    def band(t):
        tb = t.reshape(B, nb, WINDOW, SWA_KV_HEADS, d)
        prev = jnp.concatenate([jnp.zeros_like(tb[:, :1]), tb[:, :-1]], axis=1)
        return jnp.concatenate([prev, tb], axis=2)

    kb, vb = band(k), band(v)
    s = jnp.einsum('bnqkgd,bnskd->bnkgqs', qb, kb, preferred_element_type=jnp.float32) * (d ** -0.5)
    q_loc = WINDOW + jnp.arange(WINDOW)
    k_loc = jnp.arange(2 * WINDOW)
    rel = q_loc[:, None] - k_loc[None, :]
    in_window = (rel >= 0) & (rel < WINDOW)
    has_prev = (jnp.arange(nb) > 0)[:, None, None] | (k_loc >= WINDOW)[None, None, :]
    mask = in_window[None] & has_prev
    s = jnp.where(mask[None, :, None, None], s, -jnp.inf)
    sink = sinks.astype(jnp.float32).reshape(SWA_KV_HEADS, SWA_GROUP)[None, None, :, :, None, None]
    sink = jnp.broadcast_to(sink, s.shape[:-1] + (1,))
    p = jax.nn.softmax(jnp.concatenate([s, sink], axis=-1), axis=-1)[..., :-1]
    out = jnp.einsum('bnkgqs,bnskd->bnqkgd', p.astype(v.dtype), vb)
    return out.reshape(B, S, Hq * d)


def memory_attention(q, k, v):
    B, S, H, d = q.shape
    s = jnp.einsum('bshd,bmhd->bhsm', q, k, preferred_element_type=jnp.float32) * (d ** -0.5)
    p = jax.nn.softmax(s, axis=-1)
    out = jnp.einsum('bhsm,bmhd->bshd', p.astype(v.dtype), v)
    return out.reshape(B, S, H * d)


def moe_ffn(hn, w_router, b_router, w_gate_up, b_gate_up, w_down, b_down):
    B, S, D = hn.shape
    T = B * S
    A = T * TOP_K
    xt = hn.reshape(T, D)
    logits = jnp.matmul(xt, w_router, preferred_element_type=jnp.float32) + b_router.astype(jnp.float32)
    top_vals, top_idx = lax.top_k(logits, TOP_K)
    gates = jax.nn.softmax(top_vals, axis=-1)
    e_flat = top_idx.reshape(A)
    tok_flat = jnp.arange(A, dtype=jnp.int32) // TOP_K
    g_flat = gates.reshape(A)
    order = jnp.argsort(e_flat)
    e_s, tok_s, g_s = e_flat[order], tok_flat[order], g_flat[order]
    counts = jnp.bincount(e_flat, length=N_EXPERTS)
    padded = ((counts + MOE_BLOCK - 1) // MOE_BLOCK) * MOE_BLOCK
    raw_start = jnp.cumsum(counts) - counts
    pad_end = jnp.cumsum(padded)
    pad_start = pad_end - padded
    slot = pad_start[e_s] + (jnp.arange(A) - raw_start[e_s])
    P = ((A + MOE_BLOCK - 1) // MOE_BLOCK) * MOE_BLOCK + N_EXPERTS * MOE_BLOCK
    n_blk = P // MOE_BLOCK
    slot_tok = jnp.zeros((P,), jnp.int32).at[slot].set(tok_s)
    slot_gate = jnp.zeros((P,), jnp.float32).at[slot].set(g_s)
    blk_expert = jnp.clip(jnp.searchsorted(pad_end, jnp.arange(n_blk) * MOE_BLOCK, side='right'), 0, N_EXPERTS - 1)

    def expert_block(args):
        toks, e = args
        xb = xt[toks]
        hmid = xb @ w_gate_up[e] + b_gate_up[e]
        gate, up = jnp.split(hmid, 2, axis=-1)
        gate = jnp.minimum(gate, SWIGLU_LIMIT)
        up = jnp.clip(up, -SWIGLU_LIMIT, SWIGLU_LIMIT)
        glu = gate * jax.nn.sigmoid(gate * SWIGLU_ALPHA)
        return ((up + 1.0) * glu) @ w_down[e] + b_down[e]

    ys = lax.map(expert_block, (slot_tok.reshape(n_blk, MOE_BLOCK), blk_expert))
    ys = ys.reshape(P, D) * slot_gate[:, None].astype(ys.dtype)
    out = jnp.zeros((T, D), ys.dtype).at[slot_tok].add(ys)
    return out.reshape(B, S, D)


def hybrid_layer(h, mem, positions, norm_mix, w_in, b_forget, fox_q_norm, fox_k_norm,
                 swa_q_norm, swa_k_norm, swa_sinks, xmem_q_norm, xmem_k_norm, norm_mem,
                 w_mem_kv, w_up_fox, w_up_swa, w_up_xmem, w_out, norm_ffn, w_router,
                 b_router, w_gate_up, b_gate_up, w_down, b_down):
    B, S, _ = h.shape
    M = mem.shape[1]
    xn = rms_norm(h, norm_mix)
    proj = xn @ w_in
    fq, fk, fv, f_logit, sq, sk, sv, mq, g_fox, g_swa, g_xmem = jnp.split(
        proj, np.cumsum(IN_SPLITS)[:-1].tolist(), axis=-1)

    fq = rms_norm(fq.reshape(B, S, FOX_HEADS, HEAD_DIM), fox_q_norm)
    fk = rms_norm(fk.reshape(B, S, FOX_HEADS, HEAD_DIM), fox_k_norm)
    log_f = jax.nn.log_sigmoid(f_logit.astype(jnp.float32) + b_forget.astype(jnp.float32))
    o_fox = forgetting_attention(fq, fk, fv.reshape(B, S, FOX_HEADS, HEAD_DIM), log_f)

    sq = rope(rms_norm(sq.reshape(B, S, SWA_HEADS, HEAD_DIM), swa_q_norm), positions)
    sk = rope(rms_norm(sk.reshape(B, S, SWA_KV_HEADS, HEAD_DIM), swa_k_norm), positions)
    o_swa = sliding_window_attention(sq, sk, sv.reshape(B, S, SWA_KV_HEADS, HEAD_DIM), swa_sinks)

    mn = rms_norm(mem, norm_mem)
    mk, mv = jnp.split(mn @ w_mem_kv, 2, axis=-1)
    mk = rms_norm(mk.reshape(B, M, XMEM_HEADS, XMEM_HEAD_DIM), xmem_k_norm)
    mq = rms_norm(mq.reshape(B, S, XMEM_HEADS, XMEM_HEAD_DIM), xmem_q_norm)
    o_xmem = memory_attention(mq, mk, mv.reshape(B, M, XMEM_HEADS, XMEM_HEAD_DIM))

    merged = (jax.nn.sigmoid(g_fox) * (o_fox @ w_up_fox)
              + jax.nn.sigmoid(g_swa) * (o_swa @ w_up_swa)
              + jax.nn.sigmoid(g_xmem) * (o_xmem @ w_up_xmem))
    h = h + merged @ w_out

    hn = rms_norm(h, norm_ffn)
    return h + moe_ffn(hn, w_router, b_router, w_gate_up, b_gate_up, w_down, b_down)


def setup_inputs(seed: int = 0) -> dict:
    key = jax.random.key(seed)
    ks = jax.random.split(key, 26)
    f32 = jnp.float32
    L = DEPTH

    def normal(k, shape, scale):
        return jax.random.normal(k, shape, f32) * scale

    def gain(k, shape):
        return 1.0 + 0.05 * jax.random.normal(k, shape, f32)

    offset = jax.random.randint(ks[2], (BATCH, 1), 0, POS_OFFSET_MAX, dtype=jnp.int32)
    return {
        'x': normal(ks[0], (BATCH, SEQ, D_MODEL), 1.0),
        'mem': normal(ks[1], (BATCH, N_MEM, D_MODEL), 1.0),
        'positions': offset + jnp.arange(SEQ, dtype=jnp.int32)[None, :],
        'norm_mix': gain(ks[3], (L, D_MODEL)),
        'w_in': normal(ks[4], (L, D_MODEL, IN_WIDTH), D_MODEL ** -0.5),
        'b_forget': FORGET_BIAS_INIT + 0.5 * jax.random.normal(ks[5], (L, FOX_HEADS), f32),
        'fox_q_norm': gain(ks[6], (L, HEAD_DIM)),
        'fox_k_norm': gain(ks[7], (L, HEAD_DIM)),
        'swa_q_norm': gain(ks[8], (L, HEAD_DIM)),
        'swa_k_norm': gain(ks[9], (L, HEAD_DIM)),
        'swa_sinks': normal(ks[10], (L, SWA_HEADS), 1.0),
        'xmem_q_norm': gain(ks[11], (L, XMEM_HEAD_DIM)),
        'xmem_k_norm': gain(ks[12], (L, XMEM_HEAD_DIM)),
        'norm_mem': gain(ks[13], (L, D_MODEL)),
        'w_mem_kv': normal(ks[14], (L, D_MODEL, 2 * XMEM_W), D_MODEL ** -0.5),
        'w_up_fox': normal(ks[15], (L, FOX_W, D_MODEL), FOX_W ** -0.5),
        'w_up_swa': normal(ks[16], (L, SWA_QW, D_MODEL), SWA_QW ** -0.5),
        'w_up_xmem': normal(ks[17], (L, XMEM_W, D_MODEL), XMEM_W ** -0.5),
        'w_out': normal(ks[18], (L, D_MODEL, D_MODEL), D_MODEL ** -0.5),
        'norm_ffn': gain(ks[19], (L, D_MODEL)),
        'w_router': normal(ks[20], (L, D_MODEL, N_EXPERTS), D_MODEL ** -0.5),
        'b_router': normal(ks[21], (L, N_EXPERTS), 0.01),
        'w_gate_up': normal(ks[22], (L, N_EXPERTS, D_MODEL, 2 * D_EXPERT), D_MODEL ** -0.5),
        'b_gate_up': normal(ks[23], (L, N_EXPERTS, 2 * D_EXPERT), 0.01),
        'w_down': normal(ks[24], (L, N_EXPERTS, D_EXPERT, D_MODEL), D_EXPERT ** -0.5),
        'b_down': normal(ks[25], (L, N_EXPERTS, D_MODEL), 0.01),
    }


def reference(x, mem, positions, norm_mix, w_in, b_forget, fox_q_norm, fox_k_norm,
              swa_q_norm, swa_k_norm, swa_sinks, xmem_q_norm, xmem_k_norm, norm_mem,
              w_mem_kv, w_up_fox, w_up_swa, w_up_xmem, w_out, norm_ffn, w_router,
              b_router, w_gate_up, b_gate_up, w_down, b_down):
    h = x
    for layer in range(DEPTH):
        h = hybrid_layer(
            h, mem, positions, norm_mix[layer], w_in[layer], b_forget[layer],
            fox_q_norm[layer], fox_k_norm[layer], swa_q_norm[layer], swa_k_norm[layer],
            swa_sinks[layer], xmem_q_norm[layer], xmem_k_norm[layer], norm_mem[layer],
            w_mem_kv[layer], w_up_fox[layer], w_up_swa[layer], w_up_xmem[layer],
            w_out[layer], norm_ffn[layer], w_router[layer], b_router[layer],
            w_gate_up[layer], b_gate_up[layer], w_down[layer], b_down[layer])
    return h
```

```cpp
#include <hip/hip_runtime.h>
#include <cstdio>
#include <cstdint>

#define LAS __attribute__((address_space(3)))
#define GAS __attribute__((address_space(1)))

namespace pg8 {
typedef unsigned short bf16_t;
typedef short bf16x8 __attribute__((ext_vector_type(8)));
typedef float f32x4 __attribute__((ext_vector_type(4)));
typedef float f32x2 __attribute__((ext_vector_type(2)));
typedef unsigned u32x4 __attribute__((ext_vector_type(4)));
typedef unsigned u32x2 __attribute__((ext_vector_type(2)));
constexpr int BM = 256, BK = 64, HALF = 128, HTB = HALF * BK * 2, STAGE_BYTES = 8 * HTB, NXCD = 8, WGM = 8;
constexpr int KD = 2048;

__host__ __device__ __forceinline__ int lds_byte(int r, int c) { const int st = (r >> 4) * 2 + (c >> 5), rr = r & 15, cc = c & 31, ob = rr * 64 + cc * 2; return st * 1024 + (ob ^ (((ob >> 9) & 1) << 5)); }
__host__ __device__ __forceinline__ void stage_rc(int b, int& R, int& C) { const int st = b / 1024, sb = b % 1024, swz = sb ^ (((sb >> 9) & 1) << 5); R = (st >> 1) * 16 + swz / 64; C = (st & 1) * 32 + (swz % 64) / 2; }
__host__ __device__ __forceinline__ int perm32(int rho) { const int n = rho >> 4, i = rho & 15; return 8 * (i >> 2) + 4 * n + (i & 3); }

struct Unit { int pm, pn, e, kind; };

__device__ __forceinline__ unsigned cvt_pk_bf16(float lo, float hi) { unsigned r; asm volatile("v_cvt_pk_bf16_f32 %0, %1, %2" : "=v"(r) : "v"(lo), "v"(hi)); return r; }
__device__ __forceinline__ float bf_lo(unsigned w) { return __uint_as_float(w << 16); }
__device__ __forceinline__ float bf_hi(unsigned w) { return __uint_as_float(w & 0xffff0000u); }

template <class Epi, class Sched, bool ALIGN_EPI = true, bool SP2 = true>
__device__ __forceinline__ void gemm_phase(LAS unsigned char* lds, const Sched& S, const Epi& E) {
    const int tid = threadIdx.x, wid = __builtin_amdgcn_readfirstlane(tid >> 6), lane = tid & 63, wr = wid >> 2, wc = wid & 3, fr = lane & 15, fq = lane >> 4;
    constexpr int K = KD, nt = K / BK;
    unsigned voffB[2]; int RA[2], CA[2];
#pragma unroll
    for (int i = 0; i < 2; ++i) { int R, C; stage_rc(tid * 16 + i * 8192, R, C); const int Rb = Epi::PERM ? ((R & ~31) + perm32(R & 31)) : R;
        voffB[i] = (unsigned)(Rb * K + C) * 2u; RA[i] = R; CA[i] = C; }
    constexpr size_t kstep = (size_t)(BK * 2);
    constexpr size_t hstep = (size_t)HALF * K * 2;
    const unsigned ldsw = (unsigned)wid * 1024u;
    const int aoff = lds_byte(wr * 64 + fr, fq * 8), boff = lds_byte(wc * 32 + fr, fq * 8);
#define PG8_SA(b, h) (((b) * 2 + (h)) * HTB)
#define PG8_SB(b, h) ((4 + (b) * 2 + (h)) * HTB)
#define PG8_STAGE(bufoff, gbase, voff) do { _Pragma("unroll") for (int _i = 0; _i < 2; ++_i) \
        __builtin_amdgcn_global_load_lds((const unsigned*)((const char*)(gbase) + (voff)[_i]), (LAS unsigned*)(lds + (bufoff) + ldsw + _i * 8192), 16, 0, 0); } while (0)
#define PG8_LDA(dst, b, h) do { _Pragma("unroll") for (int m = 0; m < 4; ++m) _Pragma("unroll") for (int k = 0; k < 2; ++k) dst[m][k] = *(const LAS bf16x8*)(lds + PG8_SA(b, h) + aoff + m * 2048 + k * 1024); } while (0)
#define PG8_LDB(dst, b, h) do { _Pragma("unroll") for (int n = 0; n < 2; ++n) _Pragma("unroll") for (int k = 0; k < 2; ++k) dst[n][k] = *(const LAS bf16x8*)(lds + PG8_SB(b, h) + boff + n * 2048 + k * 1024); } while (0)
#define PG8_MMA(ai, bj, At, Bt) do { __builtin_amdgcn_s_setprio(1); _Pragma("unroll") for (int m = 0; m < 4; ++m) _Pragma("unroll") for (int n = 0; n < 2; ++n) _Pragma("unroll") for (int k = 0; k < 2; ++k) \
        acc[ai][bj][m][n] = __builtin_amdgcn_mfma_f32_16x16x32_bf16(Bt[n][k], At[m][k], acc[ai][bj][m][n], 0, 0, 0); __builtin_amdgcn_s_setprio(0); } while (0)
#define PG8_WAIT_V(n) asm volatile("s_waitcnt vmcnt(" #n ")" ::: "memory")
#define PG8_WAIT_L(n) asm volatile("s_waitcnt lgkmcnt(" #n ")" ::: "memory")
#define PG8_BAR __builtin_amdgcn_s_barrier()
#define PG8_SCHED __builtin_amdgcn_sched_barrier(0)
    Unit cur, nxt; int ui = 0;
    if (!S.next(0, cur)) return;
    f32x4 acc[2][2][4][2];
#pragma unroll
    for (int a = 0; a < 2; ++a)
#pragma unroll
        for (int b = 0; b < 2; ++b)
#pragma unroll
            for (int m = 0; m < 4; ++m)
#pragma unroll
                for (int n = 0; n < 2; ++n) acc[a][b][m][n] = (f32x4){0.f, 0.f, 0.f, 0.f};
    bf16x8 At[4][2], B0[2][2], B1[2][2];
    const char* cA = S.a_base(cur); const char* cB = S.b_base(cur);
    unsigned vo[2][2], nvo[2][2];
    S.a_offs(cur, RA, CA, vo);
    if constexpr (SP2) {
        PG8_STAGE(PG8_SB(0, 0), cB, voffB); PG8_STAGE(PG8_SB(0, 1), cB + hstep, voffB); PG8_STAGE(PG8_SA(0, 0), cA, vo[0]); PG8_STAGE(PG8_SA(0, 1), cA, vo[1]);
        if (wr == 1) PG8_BAR;
        PG8_WAIT_V(2); PG8_BAR;
        PG8_STAGE(PG8_SB(1, 0), cB + kstep, voffB); PG8_STAGE(PG8_SA(1, 0), cA + kstep, vo[0]); PG8_STAGE(PG8_SB(1, 1), cB + hstep + kstep, voffB);
        PG8_WAIT_V(6); PG8_BAR;
    } else {
        PG8_STAGE(PG8_SB(0, 0), cB, voffB); PG8_STAGE(PG8_SA(0, 0), cA, vo[0]); PG8_STAGE(PG8_SB(0, 1), cB + hstep, voffB); PG8_STAGE(PG8_SA(0, 1), cA, vo[1]);
        if (wr == 1) PG8_BAR;
        PG8_WAIT_V(4); PG8_BAR;
        PG8_STAGE(PG8_SB(1, 0), cB + kstep, voffB); PG8_STAGE(PG8_SA(1, 0), cA + kstep, vo[0]); PG8_STAGE(PG8_SB(1, 1), cB + hstep + kstep, voffB);
        PG8_WAIT_V(6); PG8_BAR;
    }
    for (;;) {
        const bool has_next = S.next(ui + 1, nxt);
        const char* nA = has_next ? S.a_base(nxt) : cA; const char* nB = has_next ? S.b_base(nxt) : cB;
        if (has_next) S.a_offs(nxt, RA, CA, nvo); else { nvo[0][0] = vo[0][0]; nvo[0][1] = vo[0][1]; nvo[1][0] = vo[1][0]; nvo[1][1] = vo[1][1]; }
        for (int t = 0; t < nt; t += 2) {
            const bool last = (t == nt - 2);
            const char* a1 = cA + (size_t)(t + 1) * kstep;
            const char* a2 = last ? nA : cA + (size_t)(t + 2) * kstep; const char* b2 = last ? nB : cB + (size_t)(t + 2) * kstep;
            const char* a3 = a2 + kstep; const char* b3 = b2 + kstep;
            unsigned v2[2][2];
            v2[0][0] = last ? nvo[0][0] : vo[0][0]; v2[0][1] = last ? nvo[0][1] : vo[0][1]; v2[1][0] = last ? nvo[1][0] : vo[1][0]; v2[1][1] = last ? nvo[1][1] : vo[1][1];
            if constexpr (SP2) {
            PG8_LDB(B0, 0, 0); PG8_LDB(B1, 0, 1); PG8_SCHED; PG8_LDA(At, 0, 0); PG8_STAGE(PG8_SA(1, 1), a1, vo[1]);
            PG8_WAIT_V(8); PG8_WAIT_L(0); PG8_BAR; PG8_MMA(0, 0, At, B0); PG8_MMA(0, 1, At, B1); PG8_BAR; PG8_SCHED;
            PG8_LDA(At, 0, 1); PG8_STAGE(PG8_SB(0, 0), b2, voffB); PG8_STAGE(PG8_SB(0, 1), b2 + hstep, voffB); PG8_STAGE(PG8_SA(0, 0), a2, v2[0]);
            PG8_WAIT_V(8); PG8_WAIT_L(0); PG8_BAR; PG8_MMA(1, 0, At, B0); PG8_MMA(1, 1, At, B1); PG8_BAR; PG8_SCHED;
            PG8_LDB(B0, 1, 0); PG8_LDB(B1, 1, 1); PG8_SCHED; PG8_LDA(At, 1, 0); PG8_STAGE(PG8_SA(0, 1), a2, v2[1]);
            PG8_WAIT_V(8); PG8_WAIT_L(0); PG8_BAR; PG8_MMA(0, 0, At, B0); PG8_MMA(0, 1, At, B1); PG8_BAR; PG8_SCHED;
            PG8_LDA(At, 1, 1); PG8_STAGE(PG8_SB(1, 0), b3, voffB); PG8_STAGE(PG8_SB(1, 1), b3 + hstep, voffB); PG8_STAGE(PG8_SA(1, 0), a3, v2[0]);
            PG8_WAIT_V(8); PG8_WAIT_L(0); PG8_BAR; PG8_MMA(1, 0, At, B0); PG8_MMA(1, 1, At, B1); PG8_BAR; PG8_SCHED;
            } else {
            PG8_LDB(B0, 0, 0); PG8_SCHED; PG8_LDA(At, 0, 0); PG8_STAGE(PG8_SA(1, 1), a1, vo[1]);
            PG8_WAIT_L(8); PG8_BAR; PG8_WAIT_L(0); PG8_MMA(0, 0, At, B0); PG8_BAR; PG8_SCHED;
            PG8_LDB(B1, 0, 1); PG8_STAGE(PG8_SB(0, 0), b2, voffB);
            PG8_BAR; PG8_WAIT_L(0); PG8_MMA(0, 1, At, B1); PG8_BAR;
            PG8_LDA(At, 0, 1); PG8_STAGE(PG8_SA(0, 0), a2, v2[0]);
            PG8_BAR; PG8_WAIT_L(0); PG8_MMA(1, 0, At, B0); PG8_BAR; PG8_SCHED;
            PG8_STAGE(PG8_SB(0, 1), b2 + hstep, voffB);
            PG8_WAIT_V(6); PG8_BAR; PG8_MMA(1, 1, At, B1); PG8_BAR;
            PG8_LDB(B0, 1, 0); PG8_SCHED; PG8_LDA(At, 1, 0); PG8_STAGE(PG8_SA(0, 1), a2, v2[1]);
            PG8_WAIT_L(8); PG8_BAR; PG8_WAIT_L(0); PG8_MMA(0, 0, At, B0); PG8_BAR; PG8_SCHED;
            PG8_LDB(B1, 1, 1); PG8_STAGE(PG8_SB(1, 0), b3, voffB);
            PG8_BAR; PG8_WAIT_L(0); PG8_MMA(0, 1, At, B1); PG8_BAR;
            PG8_LDA(At, 1, 1); PG8_STAGE(PG8_SA(1, 0), a3, v2[0]);
            PG8_BAR; PG8_WAIT_L(0); PG8_MMA(1, 0, At, B0); PG8_BAR; PG8_SCHED;
            PG8_STAGE(PG8_SB(1, 1), b3 + hstep, voffB);
            PG8_WAIT_V(6); PG8_BAR; PG8_MMA(1, 1, At, B1); PG8_BAR;
            }
            if constexpr (Epi::MID) { if (t == 10 || t == 22) E.mid(acc, cur, t == 22 ? 1 : 0, wr, wc, fr, fq); }
        }
        if constexpr (ALIGN_EPI) { if (wr == 0) PG8_BAR; }
        E(acc, cur, wr, wc, fr, fq);
        if (!has_next) break;
#pragma unroll
        for (int a = 0; a < 2; ++a)
#pragma unroll
            for (int b = 0; b < 2; ++b)
#pragma unroll
                for (int m = 0; m < 4; ++m)
#pragma unroll
                    for (int n = 0; n < 2; ++n) acc[a][b][m][n] = (f32x4){0.f, 0.f, 0.f, 0.f};
        cur = nxt; cA = nA; cB = nB; ++ui;
        vo[0][0] = nvo[0][0]; vo[0][1] = nvo[0][1]; vo[1][0] = nvo[1][0]; vo[1][1] = nvo[1][1];
        if constexpr (ALIGN_EPI) { if (wr == 1) PG8_BAR; }
    }
    PG8_WAIT_V(0);
    if constexpr (!ALIGN_EPI) { if (wr == 0) PG8_BAR; }
    PG8_BAR;
#undef PG8_SA
#undef PG8_SB
#undef PG8_STAGE
#undef PG8_LDA
#undef PG8_LDB
#undef PG8_MMA
#undef PG8_WAIT_V
#undef PG8_WAIT_L
#undef PG8_BAR
#undef PG8_SCHED
}
}

constexpr int NWAVES = 8;
constexpr int BATCH = 2, SEQ = 8192, DM = 2048, T = BATCH * SEQ;
constexpr int NMEM = 256, MROWS = BATCH * NMEM;
constexpr int INW = 10252;
constexpr int NEXP = 32, TOPK = 4, CAP = T;
constexpr int QKVW = 4096;
constexpr int C_FQ = 0, C_FK = 768, C_FV = 1536, C_SQ = 2304, C_SK = 3072, C_SV = 3328, C_MQ = 3584;
constexpr int GW = 6144;
constexpr float NORM_EPS = 1e-6f;
constexpr float LOG2E = 1.4426950408889634f;
constexpr float SWIGLU_LIMIT = 7.0f, SWIGLU_ALPHA = 1.702f;
constexpr int PER_PHASE = 9;
#ifndef MK_N_LAUNCHES
#define MK_N_LAUNCHES 1
#endif
constexpr int N_LAUNCHES = MK_N_LAUNCHES;

constexpr size_t MiB = 1u << 20;
constexpr size_t WS_CTL = 0, CTL_ZERO_BYTES = 1 * MiB;
constexpr size_t WS_WIN   = 2 * MiB;
constexpr size_t WS_WMKV  = WS_WIN + 40 * MiB;
constexpr size_t WS_WUP   = WS_WMKV + 4 * MiB;
constexpr size_t WS_WOUT  = WS_WUP + 8 * MiB;
constexpr size_t WS_WRT   = WS_WOUT + 8 * MiB;
constexpr size_t WS_WGU   = WS_WRT + 1 * MiB;
constexpr size_t WS_WD    = WS_WGU + 512 * MiB;
constexpr size_t WS_XN    = WS_WD + 256 * MiB;
constexpr size_t WS_MN    = WS_XN + 64 * MiB;
constexpr size_t WS_LOGF  = WS_MN + 2 * MiB;
constexpr size_t WS_CNEG  = WS_LOGF + 1 * MiB;
constexpr size_t WS_ROPE  = WS_CNEG + 1 * MiB;
constexpr size_t WS_QKV   = WS_ROPE + 4 * MiB;
constexpr size_t WS_G     = WS_QKV + 128 * MiB;
constexpr size_t WS_MKV   = WS_G + 192 * MiB;
constexpr size_t WS_OALL  = WS_MKV + 1 * MiB;
constexpr size_t WS_MERGED= WS_OALL + 64 * MiB;
constexpr size_t WS_HB    = WS_MERGED + 64 * MiB;
constexpr size_t WS_TOK   = WS_HB + 64 * MiB;
constexpr size_t WS_GATE  = WS_TOK + 2 * MiB;
constexpr size_t WS_RS    = WS_GATE + 2 * MiB;
constexpr size_t WS_ACT   = WS_RS + 2 * MiB;
constexpr size_t WS_END   = WS_ACT + 288 * MiB;
constexpr int CW_BAR = 4096;
constexpr int CW_QHEAD = 64;
constexpr int CW_CNT = 512;

typedef unsigned short bf16;
typedef unsigned v4u __attribute__((ext_vector_type(4)));
typedef unsigned v2u __attribute__((ext_vector_type(2)));
typedef float f32x4 __attribute__((ext_vector_type(4)));
typedef float f32x16 __attribute__((ext_vector_type(16)));
typedef short bf16x8 __attribute__((ext_vector_type(8)));
typedef short s16x4 __attribute__((ext_vector_type(4)));
typedef GAS unsigned gu32;
#define RLX_AGENT __ATOMIC_RELAXED, __HIP_MEMORY_SCOPE_AGENT
#define LDS_WAIT() asm volatile("s_waitcnt lgkmcnt(0)" ::: "memory")
#define VM_WAIT() asm volatile("s_waitcnt vmcnt(0)" ::: "memory")
__device__ __forceinline__ unsigned f2bf(float f) { unsigned u = __builtin_bit_cast(unsigned, f); return (u + 0x7fffu + ((u >> 16) & 1u)) >> 16; }
__device__ __forceinline__ unsigned pk2(float lo, float hi) { return f2bf(lo) | (f2bf(hi) << 16); }
__device__ __forceinline__ float bf2f(unsigned short b) { return __uint_as_float(((unsigned)b) << 16); }
__device__ __forceinline__ float wave_sum(float v) {
#pragma unroll
    for (int o = 1; o < 64; o <<= 1) v += __shfl_xor(v, o);
    return v;
}
__device__ __forceinline__ float sigmoidf_(float x) { return 1.0f / (1.0f + __expf(-x)); }

#define XB_TMO      128
#define XB_XCNT(j)  (256  + 64 * (j))
#define XB_XSUB(j)  (1280 + 64 * (j))
#define XB_XGEN(j)  (2304 + 64 * (j))
#define XB_TOP      3328
#define XB_TOPGEN   3392
#define XCD_BAR_WORDS 3456
#define XB_SPIN_CAP (1u << 18)

__device__ __forceinline__ unsigned xb_ld(unsigned* p)              { return __hip_atomic_load(p, __ATOMIC_RELAXED, __HIP_MEMORY_SCOPE_AGENT); }
__device__ __forceinline__ unsigned xb_add(unsigned* p, unsigned v) { return __hip_atomic_fetch_add(p, v, __ATOMIC_RELAXED, __HIP_MEMORY_SCOPE_AGENT); }
__device__ __forceinline__ unsigned xb_xcc_id() { return (unsigned)__builtin_amdgcn_s_getreg((3 << 11) | 20) & 0xFu; }
#define XB_SPIN(cond, bar) do { unsigned _sp = 0; while (cond) { __builtin_amdgcn_s_sleep(1); \
    if ((++_sp & 255u) == 0u) { if (xb_ld(&(bar)[XB_TMO])) break; if (_sp > XB_SPIN_CAP) { atomicAdd(&(bar)[XB_TMO], 1u); break; } } } } while (0)

struct XcdBarrier { unsigned* bar; unsigned x; volatile LAS unsigned* st; };

__device__ __forceinline__ XcdBarrier xcd_barrier_post(unsigned* bar, volatile LAS unsigned* st) {
    XcdBarrier b; b.bar = bar; b.x = xb_xcc_id(); b.st = st;
    if (threadIdx.x == 0) (void)xb_add(&bar[XB_XCNT(b.x)], 1u);
    return b;
}
__device__ __forceinline__ void xcd_barrier_complete(unsigned* bar, unsigned x, unsigned& nloc, unsigned& nx) {
    const unsigned G = gridDim.x * gridDim.y * gridDim.z;
    unsigned sum, cnt, mine, sp = 0u;
    for (;;) {
        sum = 0u; cnt = 0u; mine = 0u;
#pragma unroll
        for (unsigned j = 0; j < 16; ++j) { const unsigned c = xb_ld(&bar[XB_XCNT(j)]); sum += c; cnt += (c > 0u) ? 1u : 0u; mine = (j == x) ? c : mine; }
        if (sum == G) break;
        __builtin_amdgcn_s_sleep(1);
        if ((++sp & 255u) == 0u) { if (xb_ld(&bar[XB_TMO])) break; if (sp > XB_SPIN_CAP) { atomicAdd(&bar[XB_TMO], 1u); break; } }
    }
    nloc = mine > 0u ? mine : 1u; nx = cnt > 0u ? cnt : 1u;
}
__device__ __forceinline__ void xcd_barrier(const XcdBarrier& b) {
    asm volatile("s_waitcnt vmcnt(0)" ::: "memory");
    __syncthreads();
    if (threadIdx.x == 0) {
        unsigned* bar = b.bar;
        __builtin_amdgcn_s_waitcnt(0);
        unsigned nloc = b.st[0], nx = b.st[1];
        if (nloc == 0u) { xcd_barrier_complete(bar, b.x, nloc, nx); b.st[0] = nloc; b.st[1] = nx; }
        const unsigned old = xb_add(&bar[XB_XSUB(b.x)], 1u);
        const unsigned gen = old / nloc;
        if (old + 1u == (gen + 1u) * nloc) {
            __builtin_amdgcn_fence(__ATOMIC_RELEASE, "agent");
            asm volatile("s_waitcnt vmcnt(0)" ::: "memory");
            const unsigned og = xb_add(&bar[XB_TOP], 1u);
            const unsigned tg = og / nx;
            if (og + 1u == (tg + 1u) * nx) xb_add(&bar[XB_TOPGEN], 1u);
            else XB_SPIN(xb_ld(&bar[XB_TOPGEN]) == tg, bar);
            __builtin_amdgcn_fence(__ATOMIC_ACQUIRE, "agent");
            xb_add(&bar[XB_XGEN(b.x)], 1u);
            asm volatile("s_waitcnt vmcnt(0)" ::: "memory");
        } else {
            XB_SPIN(xb_ld(&bar[XB_XGEN(b.x)]) == gen, bar);
            __builtin_amdgcn_fence(__ATOMIC_ACQUIRE, "agent");
            asm volatile("s_waitcnt vmcnt(0)" ::: "memory");
        }
    }
    __syncthreads();
}

constexpr int RING_OFF = 0, RING_BYTES = 131072;
constexpr int LDSCTL_OFF = RING_BYTES, MISC_OFF = LDSCTL_OFF + 320;
constexpr int MOE_OFF = MISC_OFF + 128;
constexpr int LDS_BYTES = 147456;

struct Ctx {
    LAS unsigned char* lds;
    volatile LAS unsigned* MISC;
    gu32* ctl;
    int tid, lane, wave, vcu, G;
    const float *x, *mem; const int* pos; const float *norm_mix, *w_in, *b_forget, *fox_q_norm, *fox_k_norm, *swa_q_norm, *swa_k_norm, *swa_sinks, *xmem_q_norm, *xmem_k_norm, *norm_mem,
        *w_mem_kv, *w_up_fox, *w_up_swa, *w_up_xmem, *w_out, *norm_ffn, *w_router, *b_router, *w_gate_up, *b_gate_up, *w_down, *b_down;
    float* out;
    bf16 *Win_t, *Wmkv_t, *Wup_t, *Wout_t, *Wr_t, *Wgu_t, *Wd_t, *XN, *MN, *QKV, *G_, *MKV, *OALL, *MERGED, *HB, *ACT;
    float *LOGF, *CNEG, *ROPE, *GATEW, *RS; int* TOK;
};

__constant__ float INV_FREQ[32] = {1.000000000e+00f, 7.498942614e-01f, 5.623413324e-01f, 4.216965139e-01f, 3.162277639e-01f, 2.371373773e-01f, 1.778279394e-01f, 1.333521307e-01f,
    1.000000015e-01f, 7.498941571e-02f, 5.623413250e-02f, 4.216965288e-02f, 3.162277490e-02f, 2.371373773e-02f, 1.778279431e-02f, 1.333521493e-02f, 9.999999776e-03f, 7.498941850e-03f,
    5.623413250e-03f, 4.216964822e-03f, 3.162277630e-03f, 2.371373586e-03f, 1.778279431e-03f, 1.333521446e-03f, 1.000000047e-03f, 7.498942432e-04f, 5.623413017e-04f, 4.216965172e-04f,
    3.162277571e-04f, 2.371373703e-04f, 1.778279402e-04f, 1.333521504e-04f};

__device__ __forceinline__ void p0_transpose_item(const float* W, size_t ldw, int k0, int n0, bf16* WT, size_t ldt, int row0, int kd0, const float* ksc, LAS float* scr, int lane) {
#pragma unroll 8
    for (int i = 0; i < 32; ++i) { const int kk = 2 * i + (lane >> 5); float v = W[(size_t)(k0 + kk) * ldw + n0 + (lane & 31)]; if (ksc) v *= ksc[k0 + kk]; scr[kk * 33 + (lane & 31)] = v; }
    LDS_WAIT(); asm volatile("" ::: "memory");
    const int c = lane & 7;
#pragma unroll
    for (int j = 0; j < 4; ++j) { const int n = (lane >> 3) + 8 * j; const LAS float* s = scr + (8 * c) * 33 + n;
        v4u o; o.x = pk2(s[0 * 33], s[1 * 33]); o.y = pk2(s[2 * 33], s[3 * 33]); o.z = pk2(s[4 * 33], s[5 * 33]); o.w = pk2(s[6 * 33], s[7 * 33]);
        *(GAS v4u*)(WT + (size_t)(row0 + n) * ldt + kd0 + k0 + 8 * c) = o; }
    LDS_WAIT(); asm volatile("" ::: "memory");
}
__device__ __forceinline__ void p0_router_item(const float* W, int k0, bf16* WT, const float* ksc, LAS float* scr, int lane) {
#pragma unroll 8
    for (int i = 0; i < 32; ++i) { const int kk = 2 * i + (lane >> 5); scr[kk * 33 + (lane & 31)] = W[(size_t)(k0 + kk) * 32 + (lane & 31)] * ksc[k0 + kk]; }
    LDS_WAIT(); asm volatile("" ::: "memory");
    const int c = lane & 7;
#pragma unroll
    for (int j = 0; j < 4; ++j) { const int n = (lane >> 3) + 8 * j; const LAS float* s = scr + (8 * c) * 33 + n;
        unsigned h[8], l[8];
#pragma unroll
        for (int q = 0; q < 8; ++q) { const float v = s[q * 33]; h[q] = f2bf(v); l[q] = f2bf(v - __uint_as_float(h[q] << 16)); }
        v4u oh, ol; oh.x = h[0] | (h[1] << 16); oh.y = h[2] | (h[3] << 16); oh.z = h[4] | (h[5] << 16); oh.w = h[6] | (h[7] << 16);
        ol.x = l[0] | (l[1] << 16); ol.y = l[2] | (l[3] << 16); ol.z = l[4] | (l[5] << 16); ol.w = l[6] | (l[7] << 16);
        *(GAS v4u*)(WT + (size_t)n * 2048 + k0 + 8 * c) = oh; *(GAS v4u*)(WT + (size_t)(32 + n) * 2048 + k0 + 8 * c) = ol; }
    LDS_WAIT(); asm volatile("" ::: "memory");
}
__device__ __forceinline__ float log_sigmoidf_(float z) { return fminf(z, 0.f) - log1pf(__expf(-fabsf(z))); }

template <bool XROW>
__device__ __forceinline__ void p0_norm_row(const Ctx& C, const float* xrow, const float* gain, bf16* orow, const LAS float* Wf, int m) {
    const GAS f32x4* xr = (const GAS f32x4*)xrow + C.lane; const GAS f32x4* gr = (const GAS f32x4*)gain + C.lane;
    f32x4 v[8]; float s = 0.f;
#pragma unroll
    for (int j = 0; j < 8; ++j) { v[j] = xr[64 * j]; s += (v[j].x * v[j].x + v[j].y * v[j].y) + (v[j].z * v[j].z + v[j].w * v[j].w); }
    const float rstd = 1.0f / sqrtf(wave_sum(s) * (1.f / DM) + NORM_EPS);
    GAS unsigned long long* o8 = (GAS unsigned long long*)orow + C.lane;
#pragma unroll
    for (int j = 0; j < 8; ++j) { const f32x4 g = gr[64 * j]; v[j] = (v[j] * rstd) * g;
        o8[64 * j] = (unsigned long long)pk2(v[j].x, v[j].y) | ((unsigned long long)pk2(v[j].z, v[j].w) << 32); }
    if constexpr (XROW) {
        float mine = 0.f;
#pragma unroll 1
        for (int h = 0; h < 12; ++h) { const LAS f32x4* w = (const LAS f32x4*)(Wf + h * 2048) + C.lane; float d = 0.f;
#pragma unroll
            for (int j = 0; j < 8; ++j) { const f32x4 ww = w[64 * j]; d += (v[j].x * ww.x + v[j].y * ww.y) + (v[j].z * ww.z + v[j].w * ww.w); }
            d = wave_sum(d); if (C.lane == h) mine = d; }
        const int b = m / SEQ, t = m % SEQ;
        if (C.lane < 12) C.LOGF[(size_t)(b * 12 + C.lane) * SEQ + t] = log_sigmoidf_(mine + C.b_forget[C.lane]);
        if (C.lane < 32) { const float ang = (float)C.pos[m] * INV_FREQ[C.lane]; const double rev = (double)ang * 0.15915494309189535; const float fr = (float)(rev - floor(rev));
            C.ROPE[(size_t)m * 64 + C.lane] = __builtin_amdgcn_cosf(fr); C.ROPE[(size_t)m * 64 + 32 + C.lane] = __builtin_amdgcn_sinf(fr); }
    }
}
__device__ __forceinline__ void phase0(const Ctx& C) {
    LAS float* Wf = (LAS float*)(C.lds + RING_OFF);
    for (int idx = C.tid; idx < 12 * 2048; idx += NWAVES * 64) { const int k = idx / 12, h = idx - 12 * k; Wf[h * 2048 + k] = C.w_in[(size_t)k * INW + 2304 + h]; }
    __syncthreads();
    const int gw = C.vcu * NWAVES + C.wave, NGW = C.G * NWAVES;
    for (int m = gw; m < T; m += NGW) p0_norm_row<true>(C, C.x + (size_t)m * DM, C.norm_mix, C.XN + (size_t)m * DM, Wf, m);
    for (int m = gw; m < MROWS; m += NGW) p0_norm_row<false>(C, C.mem + (size_t)m * DM, C.norm_mem, C.MN + (size_t)m * DM, Wf, m);
    __syncthreads();
    LAS float* scr = (LAS float*)(C.lds + RING_OFF + C.wave * 16384);
    constexpr int I_GU = 32 * 32 * 128, I_D = 32 * 32 * 64, I_IN = 32 * 320, I_MKV = 32 * 32, I_UF = 12 * 64, I_US = 12 * 64, I_UX = 8 * 64, I_O = 32 * 64, I_R = 32;
    constexpr int NITEMS = I_GU + I_D + I_IN + I_MKV + I_UF + I_US + I_UX + I_O + I_R;
    for (int it = gw; it < NITEMS; it += NGW) {
        int r = it;
        if (r < I_GU) { const int e = r / 4096, q = r % 4096, kb = q / 128, pb = q % 128, tl = pb >> 3, jb = pb & 7;
            const int n0 = (jb < 4) ? (128 * tl + 32 * jb) : (2048 + 128 * tl + 32 * (jb - 4));
            p0_transpose_item(C.w_gate_up + (size_t)e * DM * 4096, 4096, 64 * kb, n0, C.Wgu_t + (size_t)e * 4096 * DM, DM, 32 * pb, 0, C.norm_ffn, scr, C.lane); continue; } r -= I_GU;
        if (r < I_D) { const int e = r / 2048, q = r % 2048, kb = q / 64, nb = q % 64;
            p0_transpose_item(C.w_down + (size_t)e * DM * DM, DM, 64 * kb, 32 * nb, C.Wd_t + (size_t)e * DM * DM, DM, 32 * nb, 0, nullptr, scr, C.lane); continue; } r -= I_D;
        if (r < I_IN) { const int kb = r / 320, pb = r % 320; const int n0 = (32 * pb < 2304) ? 32 * pb : 32 * pb + 12;
            p0_transpose_item(C.w_in, INW, 64 * kb, n0, C.Win_t, DM, 32 * pb, 0, nullptr, scr, C.lane); continue; } r -= I_IN;
        if (r < I_MKV) { const int kb = r / 32, nb = r % 32; p0_transpose_item(C.w_mem_kv, 1024, 64 * kb, 32 * nb, C.Wmkv_t, DM, 32 * nb, 0, nullptr, scr, C.lane); continue; } r -= I_MKV;
        if (r < I_UF) { const int kb = r / 64, nb = r % 64; p0_transpose_item(C.w_up_fox, DM, 64 * kb, 32 * nb, C.Wup_t, DM, 32 * nb, 0, nullptr, scr, C.lane); continue; } r -= I_UF;
        if (r < I_US) { const int kb = r / 64, nb = r % 64; p0_transpose_item(C.w_up_swa, DM, 64 * kb, 32 * nb, C.Wup_t, DM, 32 * nb, 768, nullptr, scr, C.lane); continue; } r -= I_US;
        if (r < I_UX) { const int kb = r / 64, nb = r % 64; p0_transpose_item(C.w_up_xmem, DM, 64 * kb, 32 * nb, C.Wup_t, DM, 32 * nb, 1536, nullptr, scr, C.lane); continue; } r -= I_UX;
        if (r < I_O) { const int kb = r / 64, nb = r % 64; p0_transpose_item(C.w_out, DM, 64 * kb, 32 * nb, C.Wout_t, DM, 32 * nb, 0, nullptr, scr, C.lane); continue; } r -= I_O;
        p0_router_item(C.w_router, 64 * r, C.Wr_t, C.norm_ffn, scr, C.lane);
    }
}

using pg8::Unit;
struct DenseOrder {
    const char* A; const char* Bt; int nM, nN, nwg, G, c;
    __device__ __forceinline__ void init(const void* A_, const void* Bt_, int M, int N, int G_, int c_) { A = (const char*)A_; Bt = (const char*)Bt_; nM = M / 256; nN = N / 256; nwg = nM * nN; G = G_; c = c_; }
    __device__ __forceinline__ bool map(long L, Unit& u) const {
        if (L >= nwg) return false;
        int wgid = (int)L; { const int q = nwg / 8, r = nwg % 8, xcd = wgid % 8, off = wgid / 8; wgid = (xcd < r ? xcd * (q + 1) : r * (q + 1) + (xcd - r) * q) + off; }
        const int nig = 8 * nN, gid = wgid / nig, fm = gid * 8, gsz = (nM - fm) < 8 ? (nM - fm) : 8;
        u.pm = fm + ((wgid % nig) % gsz); u.pn = (wgid % nig) / gsz; u.e = 0; u.kind = 0; return true;
    }
    __device__ __forceinline__ bool next(int i, Unit& u) const { return map((long)i * G + c, u); }
    __device__ __forceinline__ const char* a_base(const Unit& u) const { return A + (size_t)u.pm * (256 * 2048 * 2); }
    __device__ __forceinline__ const char* b_base(const Unit& u) const { return Bt + (size_t)u.pn * (256 * 2048 * 2); }
    __device__ __forceinline__ void a_offs(const Unit&, const int (&R)[2], const int (&Cc)[2], unsigned (&vo)[2][2]) const {
#pragma unroll
        for (int h = 0; h < 2; ++h)
#pragma unroll
            for (int i = 0; i < 2; ++i) vo[h][i] = (unsigned)((h * 128 + R[i]) * 2048 + Cc[i]) * 2u;
    }
};
struct P1Order {
    DenseOrder d; const char* A1; const char* B1;
    __device__ __forceinline__ bool next(int i, Unit& u) const {
        const long L = (long)i * d.G + d.c;
        if (L < d.nwg) return d.map(L, u);
        const int r = (int)(L - d.nwg); if (r >= 8) return false;
        u.pm = r >> 2; u.pn = r & 3; u.e = 0; u.kind = 1; return true;
    }
    __device__ __forceinline__ const char* a_base(const Unit& u) const { return (u.kind ? A1 : d.A) + (size_t)u.pm * (256 * 2048 * 2); }
    __device__ __forceinline__ const char* b_base(const Unit& u) const { return (u.kind ? B1 : d.Bt) + (size_t)u.pn * (256 * 2048 * 2); }
    __device__ __forceinline__ void a_offs(const Unit& u, const int (&R)[2], const int (&Cc)[2], unsigned (&vo)[2][2]) const { d.a_offs(u, R, Cc, vo); }
};
template <bool GATHER, int NT>
struct MoeOrder {
    const char* A; const char* Bt; const int* tok; const int* cnt; const LAS int* tab; int G, c;
    __device__ __forceinline__ bool next(int i, Unit& u) const {
        const int L = i * G + c; if (L >= __builtin_amdgcn_readfirstlane(tab[32])) return false;
        int e = 0;
#pragma unroll 1
        for (int j = 1; j < 32; ++j) e += (__builtin_amdgcn_readfirstlane(tab[j]) <= L) ? 1 : 0;
        const int j = L - __builtin_amdgcn_readfirstlane(tab[e]), mt = __builtin_amdgcn_readfirstlane(tab[33 + e]), per = mt * 4, ntg = j / per, r = j - ntg * per;
        u.e = e; u.pm = r >> 2; u.pn = ntg * 4 + (r & 3); u.kind = __builtin_amdgcn_readfirstlane(tab[65 + e]) + 256 * u.pm;
        return true;
    }
    __device__ __forceinline__ const char* a_base(const Unit& u) const { return GATHER ? A : A + (size_t)u.kind * (2048 * 2); }
    __device__ __forceinline__ const char* b_base(const Unit& u) const { return Bt + ((size_t)u.e * NT + u.pn) * (256 * 2048 * 2); }
    __device__ __forceinline__ void a_offs(const Unit& u, const int (&R)[2], const int (&Cc)[2], unsigned (&vo)[2][2]) const {
#pragma unroll
        for (int h = 0; h < 2; ++h)
#pragma unroll
            for (int i = 0; i < 2; ++i) {
                if constexpr (GATHER) { const int ri = 256 * u.pm + h * 128 + R[i]; const int row = (ri < cnt[u.e]) ? tok[u.e * CAP + ri] : 0; vo[h][i] = (unsigned)(row * 2048 + Cc[i]) * 2u; }
                else vo[h][i] = (unsigned)((h * 128 + R[i]) * 2048 + Cc[i]) * 2u;
            }
    }
};

using pg8::f32x2; using pg8::u32x4; using pg8::u32x2; using pg8::cvt_pk_bf16; using pg8::bf_lo; using pg8::bf_hi;
struct EpiInProj {
    static constexpr bool PERM = true, MID = false;
    bf16* QKV; bf16* Gt; bf16* MKV;
    __device__ __forceinline__ void mid(pg8::f32x4 (&)[2][2][4][2], const Unit&, int, int, int, int, int) const {}
    __device__ __forceinline__ void operator()(const pg8::f32x4 (&acc)[2][2][4][2], const Unit& u, int wr, int wc, int fr, int fq) const {
        asm volatile("" : "+v"(fr), "+v"(fq));
        const int row0 = u.pm * 256 + wr * 64 + fr;
        bf16* base; int ldc, colt; bool sg = false;
        if (u.kind) { base = MKV; ldc = 1024; colt = u.pn * 256; }
        else if (u.pn < 16) { base = QKV; ldc = QKVW; colt = u.pn * 256; }
        else { base = Gt; ldc = GW; colt = (u.pn - 16) * 256; sg = true; }
        const int col0 = colt + wc * 32 + 8 * fq;
#pragma unroll
        for (int ai = 0; ai < 2; ++ai)
#pragma unroll
            for (int m = 0; m < 4; ++m) { bf16* rowp = base + (size_t)(row0 + ai * 128 + m * 16) * ldc + col0;
#pragma unroll
                for (int bj = 0; bj < 2; ++bj) { pg8::f32x4 v0 = acc[ai][bj][m][0], v1 = acc[ai][bj][m][1];
                    if (sg) {
#pragma unroll
                        for (int q = 0; q < 4; ++q) { v0[q] = sigmoidf_(fmaxf(v0[q], -30.f)); v1[q] = sigmoidf_(fmaxf(v1[q], -30.f)); } }
                    u32x4 w; w.x = cvt_pk_bf16(v0[0], v0[1]); w.y = cvt_pk_bf16(v0[2], v0[3]); w.z = cvt_pk_bf16(v1[0], v1[1]); w.w = cvt_pk_bf16(v1[2], v1[3]);
                    *(u32x4*)(rowp + bj * 128) = w; } }
    }
};
struct EpiMerge {
    static constexpr bool PERM = true, MID = true;
    const bf16* Gt; bf16* O;
    __device__ __forceinline__ void mid(pg8::f32x4 (&acc)[2][2][4][2], const Unit& u, int which, int wr, int wc, int fr, int fq) const {
        asm volatile("" : "+v"(fr), "+v"(fq));
        const int row0 = u.pm * 256 + wr * 64 + fr, col0 = u.pn * 256 + wc * 32 + 8 * fq;
        const bf16* gn = Gt + (which ? 2048 : 0); const bf16* gd = Gt + (which ? 4096 : 2048);
#pragma unroll
        for (int ai = 0; ai < 2; ++ai)
#pragma unroll
            for (int m = 0; m < 4; ++m) { const size_t ro = (size_t)(row0 + ai * 128 + m * 16) * GW + col0;
#pragma unroll
                for (int bj = 0; bj < 2; ++bj) { const u32x4 a = *(const u32x4*)(gn + ro + bj * 128), b = *(const u32x4*)(gd + ro + bj * 128);
                    pg8::f32x4 r0, r1;
                    r0[0] = bf_lo(a.x) * __builtin_amdgcn_rcpf(bf_lo(b.x)); r0[1] = bf_hi(a.x) * __builtin_amdgcn_rcpf(bf_hi(b.x)); r0[2] = bf_lo(a.y) * __builtin_amdgcn_rcpf(bf_lo(b.y)); r0[3] = bf_hi(a.y) * __builtin_amdgcn_rcpf(bf_hi(b.y));
                    r1[0] = bf_lo(a.z) * __builtin_amdgcn_rcpf(bf_lo(b.z)); r1[1] = bf_hi(a.z) * __builtin_amdgcn_rcpf(bf_hi(b.z)); r1[2] = bf_lo(a.w) * __builtin_amdgcn_rcpf(bf_lo(b.w)); r1[3] = bf_hi(a.w) * __builtin_amdgcn_rcpf(bf_hi(b.w));
                    acc[ai][bj][m][0] *= r0; acc[ai][bj][m][1] *= r1; }
                asm volatile("" : "+v"(acc[ai][0][m][0]), "+v"(acc[ai][0][m][1]), "+v"(acc[ai][1][m][0]), "+v"(acc[ai][1][m][1]));
                asm volatile("" ::: "memory"); }
    }
    __device__ __forceinline__ void operator()(const pg8::f32x4 (&acc)[2][2][4][2], const Unit& u, int wr, int wc, int fr, int fq) const {
        asm volatile("" : "+v"(fr), "+v"(fq));
        const int row0 = u.pm * 256 + wr * 64 + fr, col0 = u.pn * 256 + wc * 32 + 8 * fq;
#pragma unroll
        for (int ai = 0; ai < 2; ++ai)
#pragma unroll
            for (int m = 0; m < 4; ++m) { const size_t rr = (size_t)(row0 + ai * 128 + m * 16);
#pragma unroll
                for (int bj = 0; bj < 2; ++bj) { const u32x4 g = *(const u32x4*)(Gt + rr * GW + 4096 + col0 + bj * 128);
                    const pg8::f32x4 v0 = acc[ai][bj][m][0], v1 = acc[ai][bj][m][1];
                    u32x4 w; w.x = cvt_pk_bf16(v0[0] * bf_lo(g.x), v0[1] * bf_hi(g.x)); w.y = cvt_pk_bf16(v0[2] * bf_lo(g.y), v0[3] * bf_hi(g.y));
                    w.z = cvt_pk_bf16(v1[0] * bf_lo(g.z), v1[1] * bf_hi(g.z)); w.w = cvt_pk_bf16(v1[2] * bf_lo(g.w), v1[3] * bf_hi(g.w));
                    *(u32x4*)(O + rr * DM + col0 + bj * 128) = w; }
                asm volatile("" ::: "memory"); }
    }
};
struct EpiOut {
    static constexpr bool PERM = false, MID = false;
    const float* X; float* out; bf16* HB;
    __device__ __forceinline__ void mid(pg8::f32x4 (&)[2][2][4][2], const Unit&, int, int, int, int, int) const {}
    __device__ __forceinline__ void operator()(const pg8::f32x4 (&acc)[2][2][4][2], const Unit& u, int wr, int wc, int fr, int fq) const {
        asm volatile("" : "+v"(fr), "+v"(fq));
        const int row0 = u.pm * 256 + wr * 64 + fr, col0 = u.pn * 256 + wc * 32 + 4 * fq;
#pragma unroll
        for (int ai = 0; ai < 2; ++ai)
#pragma unroll
            for (int m = 0; m < 4; ++m) { const size_t off = (size_t)(row0 + ai * 128 + m * 16) * DM + col0;
#pragma unroll
                for (int bj = 0; bj < 2; ++bj)
#pragma unroll
                    for (int n = 0; n < 2; ++n) { const size_t o2 = off + bj * 128 + n * 16; const pg8::f32x4 h = *(const pg8::f32x4*)(X + o2) + acc[ai][bj][m][n];
                        *(pg8::f32x4*)(out + o2) = h; u32x2 w; w.x = cvt_pk_bf16(h[0], h[1]); w.y = cvt_pk_bf16(h[2], h[3]); *(u32x2*)(HB + o2) = w; } }
    }
};
struct EpiGateUp {
    static constexpr bool PERM = true, MID = false;
    const float* RS; const float* bgu; bf16* ACT;
    __device__ __forceinline__ void mid(pg8::f32x4 (&)[2][2][4][2], const Unit&, int, int, int, int, int) const {}
    __device__ __forceinline__ void operator()(const pg8::f32x4 (&acc)[2][2][4][2], const Unit& u, int wr, int wc, int fr, int fq) const {
        asm volatile("" : "+v"(fr), "+v"(fq));
        const int r0 = wr * 64 + fr, hc0 = u.pn * 128 + wc * 32 + 8 * fq;
        const float* bg = bgu + (size_t)u.e * 4096 + hc0;
        const pg8::f32x4 bg0 = *(const pg8::f32x4*)(bg), bg1 = *(const pg8::f32x4*)(bg + 4), bu0 = *(const pg8::f32x4*)(bg + 2048), bu1 = *(const pg8::f32x4*)(bg + 2052);
#pragma unroll
        for (int ai = 0; ai < 2; ++ai)
#pragma unroll
            for (int m = 0; m < 4; ++m) { const int rl = r0 + ai * 128 + m * 16;
                const float rs = RS[u.e * CAP + 256 * u.pm + rl];
                float g[8], up[8];
#pragma unroll
                for (int q = 0; q < 4; ++q) { g[q] = rs * acc[ai][0][m][0][q] + bg0[q]; g[4 + q] = rs * acc[ai][0][m][1][q] + bg1[q]; up[q] = rs * acc[ai][1][m][0][q] + bu0[q]; up[4 + q] = rs * acc[ai][1][m][1][q] + bu1[q]; }
                float a[8];
#pragma unroll
                for (int q = 0; q < 8; ++q) { const float gg = fminf(g[q], SWIGLU_LIMIT), uu = fminf(fmaxf(up[q], -SWIGLU_LIMIT), SWIGLU_LIMIT); a[q] = (uu + 1.0f) * (gg * sigmoidf_(gg * SWIGLU_ALPHA)); }
                u32x4 w; w.x = cvt_pk_bf16(a[0], a[1]); w.y = cvt_pk_bf16(a[2], a[3]); w.z = cvt_pk_bf16(a[4], a[5]); w.w = cvt_pk_bf16(a[6], a[7]);
                *(u32x4*)(ACT + (size_t)(u.kind + rl) * DM + hc0) = w; }
    }
};
struct EpiDown {
    static constexpr bool PERM = false, MID = false;
    const int* TOK; const float* GATEW; const int* cnt; const float* bd; float* out;
    __device__ __forceinline__ void mid(pg8::f32x4 (&)[2][2][4][2], const Unit&, int, int, int, int, int) const {}
    __device__ __forceinline__ void operator()(const pg8::f32x4 (&acc)[2][2][4][2], const Unit& u, int wr, int wc, int fr, int fq) const {
        asm volatile("" : "+v"(fr), "+v"(fq));
        const int r0 = 256 * u.pm + wr * 64 + fr, col0 = u.pn * 256 + wc * 32 + 4 * fq, n_e = cnt[u.e];
        const float* bb = bd + (size_t)u.e * DM + col0;
        pg8::f32x4 bv[2][2];
#pragma unroll
        for (int bj = 0; bj < 2; ++bj)
#pragma unroll
            for (int n = 0; n < 2; ++n) bv[bj][n] = *(const pg8::f32x4*)(bb + bj * 128 + n * 16);
#pragma unroll
        for (int ai = 0; ai < 2; ++ai)
#pragma unroll
            for (int m = 0; m < 4; ++m) { const int rl = r0 + ai * 128 + m * 16;
                if (rl < n_e) { const int tk = TOK[u.e * CAP + rl]; const float gw = GATEW[u.e * CAP + rl]; float* op = out + (size_t)tk * DM + col0;
#pragma unroll
                    for (int bj = 0; bj < 2; ++bj)
#pragma unroll
                        for (int n = 0; n < 2; ++n) { const pg8::f32x4 v = (acc[ai][bj][m][n] + bv[bj][n]) * gw;
#pragma unroll
                            for (int q = 0; q < 4; ++q) __hip_atomic_fetch_add(op + bj * 128 + n * 16 + q, v[q], __ATOMIC_RELAXED, __HIP_MEMORY_SCOPE_AGENT); } } }
    }
};

__device__ __forceinline__ void phase2(const Ctx& C) {
    constexpr float C2_64 = 0.125f * LOG2E, C2_128 = 0.08838834764831845f * LOG2E;
    const int i = C.tid;
    int kind;
    const float* gain; float sc = 1.f; int gofs;
    if (i < 96)        { kind = 1; gain = C.fox_q_norm;  sc = C2_64;  gofs = (i & 7) * 8; }
    else if (i < 192)  { kind = 1; gain = C.fox_k_norm;  gofs = (i & 7) * 8; }
    else if (i < 288)  { kind = 0; gain = C.fox_k_norm;  gofs = 0; }
    else if (i < 384)  { kind = 2; gain = C.swa_q_norm;  sc = C2_64;  gofs = (i & 7) * 8; }
    else if (i < 416)  { kind = 2; gain = C.swa_k_norm;  gofs = (i & 7) * 8; }
    else if (i < 448)  { kind = 0; gain = C.swa_k_norm;  gofs = 0; }
    else               { kind = 3; gain = C.xmem_q_norm; sc = C2_128; gofs = (i & 15) * 8; }
    float gv[8];
#pragma unroll
    for (int q = 0; q < 8; ++q) gv[q] = gain[gofs + q] * sc;
    const int li = i & 7;
    const int rj = (li & 3) * 8;
    for (int m = C.vcu; m < T; m += C.G) {
        bf16* p = C.QKV + (size_t)m * QKVW + i * 8;
        const v4u raw = *(const GAS v4u*)p;
        float v[8]; v[0] = pg8::bf_lo(raw.x); v[1] = pg8::bf_hi(raw.x); v[2] = pg8::bf_lo(raw.y); v[3] = pg8::bf_hi(raw.y); v[4] = pg8::bf_lo(raw.z); v[5] = pg8::bf_hi(raw.z); v[6] = pg8::bf_lo(raw.w); v[7] = pg8::bf_hi(raw.w);
        float ss = 0.f;
#pragma unroll
        for (int q = 0; q < 8; ++q) ss += v[q] * v[q];
        ss += __shfl_xor(ss, 1); ss += __shfl_xor(ss, 2); ss += __shfl_xor(ss, 4);
        const float ss16 = ss + __shfl_xor(ss, 8);
        const float rstd = (kind == 3) ? 1.0f / sqrtf(ss16 * (1.f / 128.f) + NORM_EPS) : 1.0f / sqrtf(ss * (1.f / 64.f) + NORM_EPS);
#pragma unroll
        for (int q = 0; q < 8; ++q) v[q] = (v[q] * rstd) * gv[q];
        float o[8];
#pragma unroll
        for (int q = 0; q < 8; ++q) o[q] = __shfl_xor(v[q], 4);
        if (kind == 2) {
            const float* cs = C.ROPE + (size_t)m * 64 + rj;
            const f32x4 c0 = *(const GAS f32x4*)cs, c1 = *(const GAS f32x4*)(cs + 4), s0 = *(const GAS f32x4*)(cs + 32), s1 = *(const GAS f32x4*)(cs + 36);
            const float cc[8] = {c0.x, c0.y, c0.z, c0.w, c1.x, c1.y, c1.z, c1.w}, sn[8] = {s0.x, s0.y, s0.z, s0.w, s1.x, s1.y, s1.z, s1.w};
            const float sg = (li < 4) ? -1.f : 1.f;
#pragma unroll
            for (int q = 0; q < 8; ++q) v[q] = v[q] * cc[q] + sg * o[q] * sn[q];
        }
        if (kind != 0) { v4u w; w.x = pk2(v[0], v[1]); w.y = pk2(v[2], v[3]); w.z = pk2(v[4], v[5]); w.w = pk2(v[6], v[7]); *(GAS v4u*)p = w; }
    }
    {
        const int rsub = i >> 6, l6 = i & 63; float gk[8];
#pragma unroll
        for (int q = 0; q < 8; ++q) gk[q] = C.xmem_k_norm[(l6 & 15) * 8 + q];
        for (int m = C.vcu * 8 + rsub; m < MROWS; m += C.G * 8) {
            bf16* p = C.MKV + (size_t)m * 1024 + l6 * 8;
            const v4u raw = *(const GAS v4u*)p;
            float v[8]; v[0] = pg8::bf_lo(raw.x); v[1] = pg8::bf_hi(raw.x); v[2] = pg8::bf_lo(raw.y); v[3] = pg8::bf_hi(raw.y); v[4] = pg8::bf_lo(raw.z); v[5] = pg8::bf_hi(raw.z); v[6] = pg8::bf_lo(raw.w); v[7] = pg8::bf_hi(raw.w);
            float ss = 0.f;
#pragma unroll
            for (int q = 0; q < 8; ++q) ss += v[q] * v[q];
            ss += __shfl_xor(ss, 1); ss += __shfl_xor(ss, 2); ss += __shfl_xor(ss, 4); ss += __shfl_xor(ss, 8);
            const float rstd = 1.0f / sqrtf(ss * (1.f / 128.f) + NORM_EPS);
#pragma unroll
            for (int q = 0; q < 8; ++q) v[q] = (v[q] * rstd) * gk[q];
            v4u w; w.x = pk2(v[0], v[1]); w.y = pk2(v[2], v[3]); w.z = pk2(v[4], v[5]); w.w = pk2(v[6], v[7]); *(GAS v4u*)p = w;
        }
    }
    if (C.wave == 0) for (int sq = C.vcu; sq < BATCH * 12; sq += C.G) {
        const float* src = C.LOGF + (size_t)sq * SEQ + C.lane * 128; float* dst = C.CNEG + (size_t)sq * SEQ + C.lane * 128;
        float tot = 0.f;
#pragma unroll 4
        for (int j = 0; j < 32; ++j) { const f32x4 a = *(const GAS f32x4*)(src + 4 * j); tot += (a.x + a.y) + (a.z + a.w); }
        float incl = tot;
#pragma unroll
        for (int o = 1; o < 64; o <<= 1) { const float n = __shfl_up(incl, o); if (C.lane >= o) incl += n; }
        float run = incl - tot;
#pragma unroll 4
        for (int j = 0; j < 32; ++j) { const f32x4 a = *(const GAS f32x4*)(src + 4 * j); f32x4 c;
            run += a.x; c.x = -run * LOG2E; run += a.y; c.y = -run * LOG2E; run += a.z; c.z = -run * LOG2E; run += a.w; c.w = -run * LOG2E; *(GAS f32x4*)(dst + 4 * j) = c; }
    }
}

namespace att {
typedef __attribute__((address_space(3))) const char* lds_cptr;
__device__ __forceinline__ void glds16(const void* gsrc, unsigned lds_dst) { unsigned keep;
    asm volatile("s_mov_b32 %0, m0\n\ts_mov_b32 m0, %2\n\ts_nop 0\n\tglobal_load_lds_dwordx4 %1, off\n\ts_mov_b32 m0, %0" : "=&s"(keep) : "v"(gsrc), "s"(lds_dst) : "memory"); }
typedef float f32x2_t __attribute__((ext_vector_type(2))); typedef __bf16 bf16x2_t __attribute__((ext_vector_type(2)));
__device__ __forceinline__ unsigned cvtpk_s(float lo, float hi) { f32x2_t v = {lo, hi}; bf16x2_t b = __builtin_convertvector(v, bf16x2_t); return __builtin_bit_cast(unsigned, b); }
__device__ __forceinline__ int crow(int r, int hi) { return (r & 3) + 8 * (r >> 2) + 4 * hi; }

template <int D> struct Geo {
    static constexpr int SLOTB = 64 * D * 2, NSLOT = (D == 64) ? 3 : 2, PPT = (D == 64) ? 2 : 4;
    static constexpr int LDS_K = 0, LDS_V = NSLOT * SLOTB, LDS_WS = 2 * NSLOT * SLOTB, LDS_OST = LDS_WS + 2048, LDS_CB = LDS_OST + 8 * 4096, LDS_END = LDS_CB + 32768;
};

template <int D>
__device__ __forceinline__ void qkt(f32x16& p0, f32x16& p1, lds_cptr Kslot, const bf16x8* qr, int r32, int hi) {
    lds_cptr kb = Kslot + hi * 1024 + r32 * 16;
    p0 = f32x16{}; p1 = f32x16{};
#pragma unroll
    for (int d0 = 0; d0 < D / 16; ++d0) {
        const bf16x8 b0 = *(const LAS bf16x8*)(kb + d0 * 2048);
        const bf16x8 b1 = *(const LAS bf16x8*)(kb + d0 * 2048 + 512);
        p0 = __builtin_amdgcn_mfma_f32_32x32x16_bf16(b0, qr[d0], p0, 0, 0, 0); p1 = __builtin_amdgcn_mfma_f32_32x32x16_bf16(b1, qr[d0], p1, 0, 0, 0); }
}
template <int D>
__device__ __forceinline__ void pv(f32x16* o, int vb, bf16x8 pa0, bf16x8 pa1, bf16x8 pa2, bf16x8 pa3) {
#pragma unroll
    for (int d0 = 0; d0 < D / 32; ++d0) { s16x4 lo[4], hi[4];
#pragma unroll
        for (int ks = 0; ks < 4; ++ks) {
            asm volatile("ds_read_b64_tr_b16 %0,%1 offset:%c2" : "=&v"(lo[ks]) : "v"(vb), "i"(d0 * 4096 + ks * 1024) : "memory");
            asm volatile("ds_read_b64_tr_b16 %0,%1 offset:%c2" : "=&v"(hi[ks]) : "v"(vb), "i"(d0 * 4096 + ks * 1024 + 512) : "memory"); }
        asm volatile("s_waitcnt lgkmcnt(0)" ::: "memory"); __builtin_amdgcn_sched_barrier(0);
#define ATT_PK(k) (bf16x8){lo[k][0], lo[k][1], lo[k][2], lo[k][3], hi[k][0], hi[k][1], hi[k][2], hi[k][3]}
        o[d0] = __builtin_amdgcn_mfma_f32_32x32x16_bf16(pa0, ATT_PK(0), o[d0], 0, 0, 0);
        o[d0] = __builtin_amdgcn_mfma_f32_32x32x16_bf16(pa1, ATT_PK(1), o[d0], 0, 0, 0);
        o[d0] = __builtin_amdgcn_mfma_f32_32x32x16_bf16(pa2, ATT_PK(2), o[d0], 0, 0, 0);
        o[d0] = __builtin_amdgcn_mfma_f32_32x32x16_bf16(pa3, ATT_PK(3), o[d0], 0, 0, 0);
#undef ATT_PK
    }
}

template <int D, int MODE>
__device__ __forceinline__ void attn_unit(LAS unsigned char* shm, const bf16* Q, int pitchQ, const bf16* K, const bf16* V, int pitchKV, bf16* O, const float* cneg, float sink2, int qb) {
    typedef Geo<D> G;
    const int tid = threadIdx.x, lane = tid & 63, r32 = lane & 31, hi = lane >> 5; const int wid = __builtin_amdgcn_readfirstlane(tid >> 6);
    const int q0 = qb * 256, q0w = q0 + wid * 32;
    const unsigned lds0 = (unsigned)(uintptr_t)shm;
    LAS float* wsf = (LAS float*)(shm + G::LDS_WS) + wid * 64;
    LAS float* cb = (LAS float*)(shm + G::LDS_CB);
    const int j_lo = (MODE == 1) ? (qb > 0 ? 4 * qb - 2 : 0) : 0, j_hi = (MODE == 2) ? 4 : 4 * qb + 4;
    bf16x8 qr[D / 16];
    { const bf16* Qw = Q + (size_t)(q0w + r32) * pitchQ + hi * 8;
#pragma unroll
      for (int d0 = 0; d0 < D / 16; ++d0) qr[d0] = *(const GAS bf16x8*)(Qw + d0 * 16); }
    if constexpr (MODE == 0) {
        const int nch = (q0 + 256) / 4;
        for (int c = tid; c < nch; c += 512) { const f32x4 v = *(const GAS f32x4*)(cneg + 4 * c); *(LAS f32x4*)(cb + 4 * c) = v; }
    }
#define ATT_DMA(j, slot) do { const int _s = (slot) * G::SLOTB; \
        if constexpr (D == 64) { \
            glds16(K + (size_t)(64 * (j) + lane) * pitchKV + wid * 8, (unsigned)__builtin_amdgcn_readfirstlane(lds0 + G::LDS_K + _s + wid * 1024)); \
            glds16(V + (size_t)(64 * (j) + 16 * (wid & 3) + (lane >> 2)) * pitchKV + (wid >> 2) * 32 + (lane & 3) * 8, (unsigned)__builtin_amdgcn_readfirstlane(lds0 + G::LDS_V + _s + wid * 1024)); \
        } else { \
            _Pragma("unroll") for (int _p = 0; _p < 2; ++_p) { const int _c = wid + 8 * _p; \
                glds16(K + (size_t)(64 * (j) + lane) * pitchKV + _c * 8, (unsigned)__builtin_amdgcn_readfirstlane(lds0 + G::LDS_K + _s + _c * 1024)); } \
            _Pragma("unroll") for (int _p = 0; _p < 2; ++_p) { const int _c = wid + 8 * _p; \
                glds16(V + (size_t)(64 * (j) + 16 * (_c & 3) + (lane >> 2)) * pitchKV + (_c >> 2) * 32 + (lane & 3) * 8, (unsigned)__builtin_amdgcn_readfirstlane(lds0 + G::LDS_V + _s + _c * 1024)); } \
        } } while (0)
    int slot_i = 0;
#pragma unroll
    for (int p = 0; p < G::NSLOT - 1; ++p) if (j_lo + p < j_hi) ATT_DMA(j_lo + p, p);
    float mhat = -1e30f, l_reg = 0.f; f32x16 o[D / 32];
#pragma unroll
    for (int d0 = 0; d0 < D / 32; ++d0) o[d0] = f32x16{};
    const lds_cptr shm3 = (lds_cptr)shm;
    const int vb0 = (int)(lds0 + G::LDS_V) + ((lane >> 4) & 1) * 32 + (lane & 3) * 8 + (4 * hi + ((lane & 15) >> 2)) * 64;
    const int qabs = q0w + r32;
    for (int j = j_lo; j < j_hi; ++j) {
        if (G::NSLOT == 3 && j + 1 < j_hi) { if constexpr (G::PPT == 2) asm volatile("s_waitcnt vmcnt(2) lgkmcnt(0)\n\ts_barrier" ::: "memory"); else asm volatile("s_waitcnt vmcnt(4) lgkmcnt(0)\n\ts_barrier" ::: "memory"); }
        else asm volatile("s_waitcnt vmcnt(0) lgkmcnt(0)\n\ts_barrier" ::: "memory");
        { const int jn = j + G::NSLOT - 1; if (jn < j_hi) { int sn = slot_i + G::NSLOT - 1; if (sn >= G::NSLOT) sn -= G::NSLOT; ATT_DMA(jn, sn); } }
        bool need = true;
        if constexpr (MODE == 0) need = (64 * j <= q0w + 31);
        if constexpr (MODE == 1) need = (64 * j <= q0w + 31) && (64 * j + 63 >= q0w - 127);
        if (need) {
            f32x16 p0, p1;
            qkt<D>(p0, p1, shm3 + G::LDS_K + slot_i * G::SLOTB, qr, r32, hi);
            if constexpr (MODE == 0) {
                const LAS float* cbp = cb + 64 * j + 4 * hi;
#pragma unroll
                for (int g = 0; g < 4; ++g) { const f32x4 b0 = *(const LAS f32x4*)(cbp + 8 * g), b1 = *(const LAS f32x4*)(cbp + 32 + 8 * g);
#pragma unroll
                    for (int e = 0; e < 4; ++e) { p0[4 * g + e] += b0[e]; p1[4 * g + e] += b1[e]; } }
                if (64 * j + 63 > q0w) {
#pragma unroll
                    for (int r = 0; r < 16; ++r) { const int kv = 64 * j + crow(r, hi); if (kv > qabs) p0[r] = -INFINITY; if (kv + 32 > qabs) p1[r] = -INFINITY; } }
            }
            if constexpr (MODE == 1) {
#pragma unroll
                for (int r = 0; r < 16; ++r) { const int kv = 64 * j + crow(r, hi); const int d0_ = qabs - kv, d1_ = d0_ - 32;
                    if (d0_ < 0 || d0_ >= 128) p0[r] = -INFINITY; if (d1_ < 0 || d1_ >= 128) p1[r] = -INFINITY; }
            }
            float rm = fmaxf(p0[0], p1[0]);
#pragma unroll
            for (int r = 1; r < 16; ++r) rm = fmaxf(rm, fmaxf(p0[r], p1[r]));
            { auto rr = __builtin_amdgcn_permlane32_swap(__float_as_uint(rm), __float_as_uint(rm), false, false); rm = fmaxf(__uint_as_float(rr[0]), __uint_as_float(rr[1])); }
            if (__any(rm > mhat)) {
                const float mn = fmaxf(mhat, rm); const float f = __builtin_amdgcn_exp2f(mhat - mn); mhat = mn; l_reg *= f;
                if (hi == 0) wsf[r32] = f;
                asm volatile("s_waitcnt lgkmcnt(0)" ::: "memory");
#pragma unroll
                for (int g = 0; g < 4; ++g) { const f32x4 fv = *(const LAS f32x4*)(wsf + 8 * g + 4 * hi);
#pragma unroll
                    for (int d_ = 0; d_ < D / 32; ++d_)
#pragma unroll
                        for (int e = 0; e < 4; ++e) o[d_][4 * g + e] *= fv[e]; }
            }
            float sacc = 0.f;
#pragma unroll
            for (int r = 0; r < 16; ++r) { p0[r] = __builtin_amdgcn_exp2f(p0[r] - mhat); p1[r] = __builtin_amdgcn_exp2f(p1[r] - mhat); sacc += p0[r] + p1[r]; }
            l_reg += sacc;
            u32x4 pw0, pw1, pw2, pw3;
            pw0 = (u32x4){cvtpk_s(p0[0], p0[1]), cvtpk_s(p0[2], p0[3]), cvtpk_s(p0[4], p0[5]), cvtpk_s(p0[6], p0[7])};
            pw1 = (u32x4){cvtpk_s(p0[8], p0[9]), cvtpk_s(p0[10], p0[11]), cvtpk_s(p0[12], p0[13]), cvtpk_s(p0[14], p0[15])};
            pw2 = (u32x4){cvtpk_s(p1[0], p1[1]), cvtpk_s(p1[2], p1[3]), cvtpk_s(p1[4], p1[5]), cvtpk_s(p1[6], p1[7])};
            pw3 = (u32x4){cvtpk_s(p1[8], p1[9]), cvtpk_s(p1[10], p1[11]), cvtpk_s(p1[12], p1[13]), cvtpk_s(p1[14], p1[15])};
            pv<D>(o, vb0 + slot_i * G::SLOTB, __builtin_bit_cast(bf16x8, pw0), __builtin_bit_cast(bf16x8, pw1), __builtin_bit_cast(bf16x8, pw2), __builtin_bit_cast(bf16x8, pw3));
        }
        ++slot_i; if (slot_i == G::NSLOT) slot_i = 0;
    }
#undef ATT_DMA
    { auto rr = __builtin_amdgcn_permlane32_swap(__float_as_uint(l_reg), __float_as_uint(l_reg), false, false); l_reg = __uint_as_float(rr[0]) + __uint_as_float(rr[1]); }
    if constexpr (MODE == 1) l_reg += __builtin_amdgcn_exp2f(sink2 - mhat);
    if (hi == 0) wsf[32 + r32] = l_reg;
    asm volatile("s_waitcnt lgkmcnt(0)" ::: "memory");
    float rli[16];
#pragma unroll
    for (int g = 0; g < 4; ++g) { const f32x4 lv = *(const LAS f32x4*)(wsf + 32 + 8 * g + 4 * hi);
#pragma unroll
        for (int e = 0; e < 4; ++e) rli[4 * g + e] = __builtin_amdgcn_rcpf(lv[e]); }
    bf16* Ow = O + (size_t)q0w * 2048;
    LAS bf16* stg = (LAS bf16*)(shm + G::LDS_OST) + wid * 2048;
#pragma unroll
    for (int ps = 0; ps < D / 64; ++ps) {
#pragma unroll
        for (int r = 0; r < 16; ++r) { const int orow = crow(r, hi);
#pragma unroll
            for (int dl = 0; dl < 2; ++dl) stg[orow * 64 + dl * 32 + r32] = (bf16)f2bf(o[2 * ps + dl][r] * rli[r]); }
        asm volatile("s_waitcnt lgkmcnt(0)" ::: "memory");
#pragma unroll
        for (int i = 0; i < 4; ++i) { const int row = i * 8 + (lane >> 3), ch = lane & 7; const v4u v = *(const LAS v4u*)(stg + row * 64 + ch * 8); *(GAS v4u*)(Ow + (size_t)row * 2048 + ps * 64 + ch * 8) = v; }
        asm volatile("s_waitcnt lgkmcnt(0)" ::: "memory");
    }
    asm volatile("s_waitcnt lgkmcnt(0)\n\ts_barrier" ::: "memory");
}
}

constexpr int NU_FOX = BATCH * 12 * 32, NU_SWA = BATCH * 12 * 32, NU_XM = BATCH * 4 * 32;
__device__ __forceinline__ int att_fetch(const Ctx& C, int q) {
    int v = 0; if (C.tid == 0) v = (int)__hip_atomic_fetch_add((unsigned*)(C.ctl + CW_QHEAD + 64 * q), 1u, RLX_AGENT); return v;
}
__device__ __forceinline__ void phase3(const Ctx& C) {
    LAS unsigned char* shm = C.lds + RING_OFF;
    volatile LAS int* nxtw = (volatile LAS int*)(C.MISC + 12);
    {
        int pre = att_fetch(C, 0);
        if (C.tid == 0) *nxtw = pre;
        __syncthreads();
        int cur = __builtin_amdgcn_readfirstlane(*nxtw);
        __syncthreads();
        while (cur < NU_FOX) {
            pre = att_fetch(C, 0);
            const int qb = 31 - cur / 24, bh = cur % 24, b = bh / 12, h = bh % 12;
            const bf16* base = C.QKV + (size_t)b * SEQ * QKVW + h * 64;
            att::attn_unit<64, 0>(shm, base + C_FQ, QKVW, base + C_FK, base + C_FV, QKVW, C.OALL + (size_t)b * SEQ * 2048 + h * 64, C.CNEG + (size_t)(b * 12 + h) * SEQ, 0.f, qb);
            if (C.tid == 0) *nxtw = pre;
            __syncthreads();
            cur = __builtin_amdgcn_readfirstlane(*nxtw);
            __syncthreads();
        }
    }
    {
        int pre = att_fetch(C, 1);
        if (C.tid == 0) *nxtw = pre;
        __syncthreads();
        int cur = __builtin_amdgcn_readfirstlane(*nxtw);
        __syncthreads();
        while (cur < NU_SWA) {
            pre = att_fetch(C, 1);
            const int qb = cur / 24, bh = cur % 24, b = bh / 12, h = bh % 12, kvh = h / 3;
            const bf16* base = C.QKV + (size_t)b * SEQ * QKVW;
            att::attn_unit<64, 1>(shm, base + C_SQ + h * 64, QKVW, base + C_SK + kvh * 64, base + C_SV + kvh * 64, QKVW, C.OALL + (size_t)b * SEQ * 2048 + 768 + h * 64, nullptr, C.swa_sinks[h] * LOG2E, qb);
            if (C.tid == 0) *nxtw = pre;
            __syncthreads();
            cur = __builtin_amdgcn_readfirstlane(*nxtw);
            __syncthreads();
        }
    }
    {
        int pre = att_fetch(C, 2);
        if (C.tid == 0) *nxtw = pre;
        __syncthreads();
        int cur = __builtin_amdgcn_readfirstlane(*nxtw);
        __syncthreads();
        while (cur < NU_XM) {
            pre = att_fetch(C, 2);
            const int qb = cur / 8, bh = cur % 8, b = bh / 4, h = bh % 4;
            const bf16* kb = C.MKV + (size_t)b * NMEM * 1024 + h * 128;
            att::attn_unit<128, 2>(shm, C.QKV + (size_t)b * SEQ * QKVW + C_MQ + h * 128, QKVW, kb, kb + 512, 1024, C.OALL + (size_t)b * SEQ * 2048 + 1536 + h * 128, nullptr, 0.f, qb);
            if (C.tid == 0) *nxtw = pre;
            __syncthreads();
            cur = __builtin_amdgcn_readfirstlane(*nxtw);
            __syncthreads();
        }
    }
}

__device__ __forceinline__ void phase6(const Ctx& C) {
    LAS float* PL = (LAS float*)(C.lds + RING_OFF);
    LAS float* SS = PL + 4 * 64 * 33;
    LAS int* hist = (LAS int*)(SS + 512);
    LAS int* gb = hist + 32;
    const int rg = C.wave & 1, kq = C.wave >> 1, r32 = C.lane & 31, hi = C.lane >> 5;
    const bf16* wh = C.Wr_t + (size_t)r32 * 2048 + 512 * kq + 16 * hi; const bf16* wl = wh + 32 * 2048;
    for (int blk = C.vcu; blk < T / 64; blk += C.G) {
        if (C.tid < 32) hist[C.tid] = 0;
        const int tok = blk * 64 + 32 * rg + r32;
        const float* hr = C.out + (size_t)tok * DM + 512 * kq + 16 * hi;
        f32x16 acc = f32x16{}; float ss = 0.f;
#pragma unroll 2
        for (int kb = 0; kb < 16; ++kb) {
            float f[16];
#pragma unroll
            for (int q = 0; q < 4; ++q) { const f32x4 t = *(const GAS f32x4*)(hr + 32 * kb + 4 * q); f[4 * q] = t.x; f[4 * q + 1] = t.y; f[4 * q + 2] = t.z; f[4 * q + 3] = t.w; }
            unsigned hb[16], lb[16];
#pragma unroll
            for (int q = 0; q < 16; ++q) { ss += f[q] * f[q]; hb[q] = f2bf(f[q]); lb[q] = f2bf(f[q] - __uint_as_float(hb[q] << 16)); }
#pragma unroll
            for (int s = 0; s < 2; ++s) {
                const bf16x8 ah = *(const GAS bf16x8*)(wh + 32 * kb + 8 * s), al = *(const GAS bf16x8*)(wl + 32 * kb + 8 * s);
                v4u bh, bl;
                bh.x = hb[8 * s] | (hb[8 * s + 1] << 16); bh.y = hb[8 * s + 2] | (hb[8 * s + 3] << 16); bh.z = hb[8 * s + 4] | (hb[8 * s + 5] << 16); bh.w = hb[8 * s + 6] | (hb[8 * s + 7] << 16);
                bl.x = lb[8 * s] | (lb[8 * s + 1] << 16); bl.y = lb[8 * s + 2] | (lb[8 * s + 3] << 16); bl.z = lb[8 * s + 4] | (lb[8 * s + 5] << 16); bl.w = lb[8 * s + 6] | (lb[8 * s + 7] << 16);
                acc = __builtin_amdgcn_mfma_f32_32x32x16_bf16(ah, __builtin_bit_cast(bf16x8, bh), acc, 0, 0, 0);
                acc = __builtin_amdgcn_mfma_f32_32x32x16_bf16(ah, __builtin_bit_cast(bf16x8, bl), acc, 0, 0, 0);
                acc = __builtin_amdgcn_mfma_f32_32x32x16_bf16(al, __builtin_bit_cast(bf16x8, bh), acc, 0, 0, 0);
            }
        }
        { LAS float* pr = PL + (size_t)(kq * 64 + 32 * rg + r32) * 33;
#pragma unroll
          for (int r = 0; r < 16; ++r) pr[att::crow(r, hi)] = acc[r];
          SS[(kq * 2 + hi) * 64 + 32 * rg + r32] = ss; }
        __syncthreads();
        int sel[4]; float gt[4]; float rstd = 0.f; int lr[4];
        if (C.tid < 64) {
            float lv[32]; float s2 = 0.f;
#pragma unroll
            for (int q = 0; q < 8; ++q) s2 += SS[q * 64 + C.tid];
            rstd = 1.0f / sqrtf(s2 * (1.f / DM) + NORM_EPS);
#pragma unroll
            for (int e = 0; e < 32; ++e) { const float a = (PL[(0 * 64 + C.tid) * 33 + e] + PL[(1 * 64 + C.tid) * 33 + e]) + (PL[(2 * 64 + C.tid) * 33 + e] + PL[(3 * 64 + C.tid) * 33 + e]); lv[e] = a * rstd + C.b_router[e]; }
            float val[4];
#pragma unroll
            for (int k = 0; k < 4; ++k) { float best = lv[0]; int bi = 0;
#pragma unroll
                for (int e = 1; e < 32; ++e) if (lv[e] > best) { best = lv[e]; bi = e; }
                sel[k] = bi; val[k] = best;
#pragma unroll
                for (int e = 0; e < 32; ++e) lv[e] = (e == bi) ? -INFINITY : lv[e]; }
            float den = 0.f;
#pragma unroll
            for (int k = 0; k < 4; ++k) { gt[k] = __expf(val[k] - val[0]); den += gt[k]; }
            const float inv = 1.0f / den;
#pragma unroll
            for (int k = 0; k < 4; ++k) { gt[k] *= inv; lr[k] = __hip_atomic_fetch_add((LAS int*)(hist + sel[k]), 1, __ATOMIC_RELAXED, __HIP_MEMORY_SCOPE_WORKGROUP); }
        }
        __syncthreads();
        if (C.tid < 32) gb[C.tid] = (int)__hip_atomic_fetch_add((unsigned*)(C.ctl + CW_CNT + C.tid), (unsigned)hist[C.tid], RLX_AGENT);
        __syncthreads();
        if (C.tid < 64) {
            const int t = blk * 64 + C.tid;
#pragma unroll
            for (int k = 0; k < 4; ++k) { const int sl = sel[k] * CAP + gb[sel[k]] + lr[k]; C.TOK[sl] = t; C.GATEW[sl] = gt[k]; C.RS[sl] = rstd; }
        }
        __syncthreads();
    }
}
template <int NT>
__device__ __forceinline__ void moe_table(const Ctx& C, LAS int* tab) {
    __syncthreads();
    if (C.tid == 0) { int us = 0, rb = 0;
        for (int e = 0; e < 32; ++e) { const int n = (int)__hip_atomic_load((unsigned*)(C.ctl + CW_CNT + e), RLX_AGENT); const int mt = (n + 255) >> 8; tab[e] = us; tab[33 + e] = mt; tab[65 + e] = rb; us += mt * NT; rb += mt * 256; }
        tab[32] = us; }
    __syncthreads();
}

struct Args { const void* in[26]; float* out; unsigned char* ws; int ph_lo, ph_hi; };
__global__ void __launch_bounds__(NWAVES * 64, 2) mk_fwd(Args args) {
    extern __shared__ __attribute__((aligned(16))) unsigned char lds_raw[];
    Ctx C;
    C.lds = (LAS unsigned char*)lds_raw;
    C.MISC = (volatile LAS unsigned*)(C.lds + MISC_OFF);
    C.tid = threadIdx.x; C.lane = C.tid & 63; C.wave = __builtin_amdgcn_readfirstlane(C.tid >> 6);
    C.G = gridDim.x; { const int bx = blockIdx.x; C.vcu = (C.G % 8 == 0) ? (bx % 8) * (C.G / 8) + bx / 8 : bx; }
    unsigned char* ws = args.ws;
    C.ctl = (gu32*)(ws + WS_CTL);
    C.x = (const float*)args.in[0]; C.mem = (const float*)args.in[1]; C.pos = (const int*)args.in[2]; C.norm_mix = (const float*)args.in[3]; C.w_in = (const float*)args.in[4];
    C.b_forget = (const float*)args.in[5]; C.fox_q_norm = (const float*)args.in[6]; C.fox_k_norm = (const float*)args.in[7]; C.swa_q_norm = (const float*)args.in[8]; C.swa_k_norm = (const float*)args.in[9];
    C.swa_sinks = (const float*)args.in[10]; C.xmem_q_norm = (const float*)args.in[11]; C.xmem_k_norm = (const float*)args.in[12]; C.norm_mem = (const float*)args.in[13]; C.w_mem_kv = (const float*)args.in[14];
    C.w_up_fox = (const float*)args.in[15]; C.w_up_swa = (const float*)args.in[16]; C.w_up_xmem = (const float*)args.in[17]; C.w_out = (const float*)args.in[18]; C.norm_ffn = (const float*)args.in[19];
    C.w_router = (const float*)args.in[20]; C.b_router = (const float*)args.in[21]; C.w_gate_up = (const float*)args.in[22]; C.b_gate_up = (const float*)args.in[23]; C.w_down = (const float*)args.in[24]; C.b_down = (const float*)args.in[25];
    C.out = args.out;
    C.Win_t = (bf16*)(ws + WS_WIN); C.Wmkv_t = (bf16*)(ws + WS_WMKV); C.Wup_t = (bf16*)(ws + WS_WUP); C.Wout_t = (bf16*)(ws + WS_WOUT); C.Wr_t = (bf16*)(ws + WS_WRT); C.Wgu_t = (bf16*)(ws + WS_WGU); C.Wd_t = (bf16*)(ws + WS_WD);
    C.XN = (bf16*)(ws + WS_XN); C.MN = (bf16*)(ws + WS_MN); C.QKV = (bf16*)(ws + WS_QKV); C.G_ = (bf16*)(ws + WS_G); C.MKV = (bf16*)(ws + WS_MKV); C.OALL = (bf16*)(ws + WS_OALL); C.MERGED = (bf16*)(ws + WS_MERGED);
    C.HB = (bf16*)(ws + WS_HB); C.ACT = (bf16*)(ws + WS_ACT); C.LOGF = (float*)(ws + WS_LOGF); C.CNEG = (float*)(ws + WS_CNEG); C.ROPE = (float*)(ws + WS_ROPE); C.GATEW = (float*)(ws + WS_GATE); C.RS = (float*)(ws + WS_RS);
    C.TOK = (int*)(ws + WS_TOK);
    for (int u = C.tid; u < (LDS_BYTES - LDSCTL_OFF) / 4; u += NWAVES * 64) ((LAS unsigned*)(C.lds + LDSCTL_OFF))[u] = 0u;
    __syncthreads();
    XcdBarrier bar; bar.bar = (unsigned*)(C.ctl + CW_BAR); bar.x = 0; bar.st = nullptr;
    if (N_LAUNCHES == 1) bar = xcd_barrier_post((unsigned*)(C.ctl + CW_BAR), C.MISC + 8);
    const int lo = args.ph_lo, hi = args.ph_hi;
#ifndef MK_PHASE_MASK
#define MK_PHASE_MASK 0x1FF
#endif
#define IN(k) ((((MK_PHASE_MASK) >> (k)) & 1) && lo <= (k) && (k) < hi)
#define SEAM(k) do { if (IN(k) && IN((k) + 1)) xcd_barrier(bar); } while (0)
    LAS int* tab = (LAS int*)(C.lds + MOE_OFF);

    if (IN(0)) { phase0(C); }
    SEAM(0);
    if (IN(1)) {
        P1Order S; S.d.init(C.XN, C.Win_t, T, 10240, C.G, (int)blockIdx.x); S.A1 = (const char*)C.MN; S.B1 = (const char*)C.Wmkv_t;
        EpiInProj E{C.QKV, C.G_, C.MKV};
        pg8::gemm_phase<EpiInProj, P1Order>(C.lds + RING_OFF, S, E);
    }
    SEAM(1);
    if (IN(2)) { phase2(C); }
    SEAM(2);
    if (IN(3)) { phase3(C); }
    SEAM(3);
    if (IN(4)) {
        DenseOrder S; S.init(C.OALL, C.Wup_t, T, DM, C.G, (int)blockIdx.x);
        EpiMerge E{C.G_, C.MERGED};
        pg8::gemm_phase<EpiMerge, DenseOrder>(C.lds + RING_OFF, S, E);
    }
    SEAM(4);
    if (IN(5)) {
        DenseOrder S; S.init(C.MERGED, C.Wout_t, T, DM, C.G, (int)blockIdx.x);
        EpiOut E{C.x, C.out, C.HB};
        pg8::gemm_phase<EpiOut, DenseOrder>(C.lds + RING_OFF, S, E);
    }
    SEAM(5);
    if (IN(6)) { phase6(C); }
    SEAM(6);
    if (IN(7)) {
        moe_table<16>(C, tab);
        MoeOrder<true, 16> S{(const char*)C.HB, (const char*)C.Wgu_t, C.TOK, (const int*)(C.ctl + CW_CNT), tab, C.G, C.vcu};
        EpiGateUp E{C.RS, C.b_gate_up, C.ACT};
        pg8::gemm_phase<EpiGateUp, MoeOrder<true, 16>>(C.lds + RING_OFF, S, E);
    }
    SEAM(7);
    if (IN(8)) {
        moe_table<8>(C, tab);
        MoeOrder<false, 8> S{(const char*)C.ACT, (const char*)C.Wd_t, C.TOK, (const int*)(C.ctl + CW_CNT), tab, C.G, C.vcu};
        EpiDown E{C.TOK, C.GATEW, (const int*)(C.ctl + CW_CNT), C.b_down, C.out};
        pg8::gemm_phase<EpiDown, MoeOrder<false, 8>>(C.lds + RING_OFF, S, E);
    }
#undef IN
#undef SEAM
}

extern "C" void kernel_launch(void* const* d_in, const int* in_sizes, int n_in, void* d_out, int out_size, void* d_ws, size_t ws_size, hipStream_t stream) {
    static int grid = 0;
    if (grid == 0) {
        if (n_in != 26 || out_size != T * DM || ws_size < WS_END) { fprintf(stderr, "kernel_launch: unexpected problem (n_in %d, out %d, ws %zu < %zu); nothing launched\n", n_in, out_size, ws_size, (size_t)WS_END); grid = -1; return; }
        int dev = 0, cus = 0, per_cu = 0;
        if (hipGetDevice(&dev) != hipSuccess || hipDeviceGetAttribute(&cus, hipDeviceAttributeMultiprocessorCount, dev) != hipSuccess) { grid = -1; return; }
        if (hipFuncSetAttribute((const void*)mk_fwd, hipFuncAttributeMaxDynamicSharedMemorySize, LDS_BYTES) != hipSuccess) { fprintf(stderr, "kernel_launch: hipFuncSetAttribute failed\n"); grid = -1; return; }
        if (hipOccupancyMaxActiveBlocksPerMultiprocessor(&per_cu, (const void*)mk_fwd, NWAVES * 64, LDS_BYTES) != hipSuccess || per_cu < 1) { fprintf(stderr, "kernel_launch: occupancy query says %d\n", per_cu); }
        (void)hipGetLastError();
        grid = cus;
    }
    if (grid < 0) return;
    if (hipMemsetAsync((char*)d_ws + WS_CTL, 0, CTL_ZERO_BYTES, stream) != hipSuccess) return;
    Args a{};
    for (int i = 0; i < 26; ++i) a.in[i] = d_in[i];
    a.out = (float*)d_out; a.ws = (unsigned char*)d_ws;
    if (N_LAUNCHES == 1) { a.ph_lo = 0; a.ph_hi = PER_PHASE; hipLaunchKernelGGL(mk_fwd, dim3(grid), dim3(NWAVES * 64), LDS_BYTES, stream, a); }
    else for (int li = 0; li < PER_PHASE; ++li) { a.ph_lo = li; a.ph_hi = li + 1; hipLaunchKernelGGL(mk_fwd, dim3(grid), dim3(NWAVES * 64), LDS_BYTES, stream, a); }
    const hipError_t le = hipPeekAtLastError();
    if (le != hipSuccess) fprintf(stderr, "kernel_launch: launch failed: %s\n", hipGetErrorName(le));
}
```

```cpp
#include <hip/hip_runtime.h>
#include <cstdio>
#include <cstdint>

#define LAS __attribute__((address_space(3)))
#define GAS __attribute__((address_space(1)))

namespace pg8 {
typedef unsigned short bf16_t;
typedef short bf16x8 __attribute__((ext_vector_type(8)));
typedef float f32x4 __attribute__((ext_vector_type(4)));
typedef float f32x2 __attribute__((ext_vector_type(2)));
typedef unsigned u32x4 __attribute__((ext_vector_type(4)));
typedef unsigned u32x2 __attribute__((ext_vector_type(2)));
constexpr int BM = 256, BK = 64, HALF = 128, HTB = HALF * BK * 2, STAGE_BYTES = 8 * HTB, NXCD = 8, WGM = 8;
constexpr int KD = 2048;

__host__ __device__ __forceinline__ int lds_byte(int r, int c) { const int st = (r >> 4) * 2 + (c >> 5), rr = r & 15, cc = c & 31, ob = rr * 64 + cc * 2; return st * 1024 + (ob ^ (((ob >> 9) & 1) << 5)); }
__host__ __device__ __forceinline__ void stage_rc(int b, int& R, int& C) { const int st = b / 1024, sb = b % 1024, swz = sb ^ (((sb >> 9) & 1) << 5); R = (st >> 1) * 16 + swz / 64; C = (st & 1) * 32 + (swz % 64) / 2; }
__host__ __device__ __forceinline__ int perm32(int rho) { const int n = rho >> 4, i = rho & 15; return 8 * (i >> 2) + 4 * n + (i & 3); }

struct Unit { int pm, pn, e, kind; };

__device__ __forceinline__ unsigned cvt_pk_bf16(float lo, float hi) { unsigned r; asm volatile("v_cvt_pk_bf16_f32 %0, %1, %2" : "=v"(r) : "v"(lo), "v"(hi)); return r; }
__device__ __forceinline__ float bf_lo(unsigned w) { return __uint_as_float(w << 16); }
__device__ __forceinline__ float bf_hi(unsigned w) { return __uint_as_float(w & 0xffff0000u); }

template <class Epi, class Sched, bool ALIGN_EPI = true, bool SP2 = true>
__device__ __forceinline__ void gemm_phase(LAS unsigned char* lds, const Sched& S, const Epi& E) {
    const int tid = threadIdx.x, wid = __builtin_amdgcn_readfirstlane(tid >> 6), lane = tid & 63, wr = wid >> 2, wc = wid & 3, fr = lane & 15, fq = lane >> 4;
    constexpr int K = KD, nt = K / BK;
    unsigned voffB[2]; int RA[2], CA[2];
#pragma unroll
    for (int i = 0; i < 2; ++i) { int R, C; stage_rc(tid * 16 + i * 8192, R, C); const int Rb = Epi::PERM ? ((R & ~31) + perm32(R & 31)) : R;
        voffB[i] = (unsigned)(Rb * K + C) * 2u; RA[i] = R; CA[i] = C; }
    constexpr size_t kstep = (size_t)(BK * 2);
    constexpr size_t hstep = (size_t)HALF * K * 2;
    const unsigned ldsw = (unsigned)wid * 1024u;
    const int aoff = lds_byte(wr * 64 + fr, fq * 8), boff = lds_byte(wc * 32 + fr, fq * 8);
#define PG8_SA(b, h) (((b) * 2 + (h)) * HTB)
#define PG8_SB(b, h) ((4 + (b) * 2 + (h)) * HTB)
#define PG8_STAGE(bufoff, gbase, voff) do { _Pragma("unroll") for (int _i = 0; _i < 2; ++_i) \
        __builtin_amdgcn_global_load_lds((const unsigned*)((const char*)(gbase) + (voff)[_i]), (LAS unsigned*)(lds + (bufoff) + ldsw + _i * 8192), 16, 0, 0); } while (0)
#define PG8_LDA(dst, b, h) do { _Pragma("unroll") for (int m = 0; m < 4; ++m) _Pragma("unroll") for (int k = 0; k < 2; ++k) dst[m][k] = *(const LAS bf16x8*)(lds + PG8_SA(b, h) + aoff + m * 2048 + k * 1024); } while (0)
#define PG8_LDB(dst, b, h) do { _Pragma("unroll") for (int n = 0; n < 2; ++n) _Pragma("unroll") for (int k = 0; k < 2; ++k) dst[n][k] = *(const LAS bf16x8*)(lds + PG8_SB(b, h) + boff + n * 2048 + k * 1024); } while (0)
#define PG8_MMA(ai, bj, At, Bt) do { __builtin_amdgcn_s_setprio(1); _Pragma("unroll") for (int m = 0; m < 4; ++m) _Pragma("unroll") for (int n = 0; n < 2; ++n) _Pragma("unroll") for (int k = 0; k < 2; ++k) \
        acc[ai][bj][m][n] = __builtin_amdgcn_mfma_f32_16x16x32_bf16(Bt[n][k], At[m][k], acc[ai][bj][m][n], 0, 0, 0); __builtin_amdgcn_s_setprio(0); } while (0)
#define PG8_WAIT_V(n) asm volatile("s_waitcnt vmcnt(" #n ")" ::: "memory")
#define PG8_WAIT_L(n) asm volatile("s_waitcnt lgkmcnt(" #n ")" ::: "memory")
#define PG8_BAR __builtin_amdgcn_s_barrier()
#define PG8_SCHED __builtin_amdgcn_sched_barrier(0)
    Unit cur, nxt; int ui = 0;
    if (!S.next(0, cur)) return;
    f32x4 acc[2][2][4][2];
#pragma unroll
    for (int a = 0; a < 2; ++a)
#pragma unroll
        for (int b = 0; b < 2; ++b)
#pragma unroll
            for (int m = 0; m < 4; ++m)
#pragma unroll
                for (int n = 0; n < 2; ++n) acc[a][b][m][n] = (f32x4){0.f, 0.f, 0.f, 0.f};
    bf16x8 At[4][2], B0[2][2], B1[2][2];
    const char* cA = S.a_base(cur); const char* cB = S.b_base(cur);
    unsigned vo[2][2], nvo[2][2];
    S.a_offs(cur, RA, CA, vo);
    if constexpr (SP2) {
        PG8_STAGE(PG8_SB(0, 0), cB, voffB); PG8_STAGE(PG8_SB(0, 1), cB + hstep, voffB); PG8_STAGE(PG8_SA(0, 0), cA, vo[0]); PG8_STAGE(PG8_SA(0, 1), cA, vo[1]);
        if (wr == 1) PG8_BAR;
        PG8_WAIT_V(2); PG8_BAR;
        PG8_STAGE(PG8_SB(1, 0), cB + kstep, voffB); PG8_STAGE(PG8_SA(1, 0), cA + kstep, vo[0]); PG8_STAGE(PG8_SB(1, 1), cB + hstep + kstep, voffB);
        PG8_WAIT_V(6); PG8_BAR;
    } else {
        PG8_STAGE(PG8_SB(0, 0), cB, voffB); PG8_STAGE(PG8_SA(0, 0), cA, vo[0]); PG8_STAGE(PG8_SB(0, 1), cB + hstep, voffB); PG8_STAGE(PG8_SA(0, 1), cA, vo[1]);
        if (wr == 1) PG8_BAR;
        PG8_WAIT_V(4); PG8_BAR;
        PG8_STAGE(PG8_SB(1, 0), cB + kstep, voffB); PG8_STAGE(PG8_SA(1, 0), cA + kstep, vo[0]); PG8_STAGE(PG8_SB(1, 1), cB + hstep + kstep, voffB);
        PG8_WAIT_V(6); PG8_BAR;
    }
    for (;;) {
        const bool has_next = S.next(ui + 1, nxt);
        const char* nA = has_next ? S.a_base(nxt) : cA; const char* nB = has_next ? S.b_base(nxt) : cB;
        if (has_next) S.a_offs(nxt, RA, CA, nvo); else { nvo[0][0] = vo[0][0]; nvo[0][1] = vo[0][1]; nvo[1][0] = vo[1][0]; nvo[1][1] = vo[1][1]; }
        for (int t = 0; t < nt; t += 2) {
            const bool last = (t == nt - 2);
            const char* a1 = cA + (size_t)(t + 1) * kstep;
            const char* a2 = last ? nA : cA + (size_t)(t + 2) * kstep; const char* b2 = last ? nB : cB + (size_t)(t + 2) * kstep;
            const char* a3 = a2 + kstep; const char* b3 = b2 + kstep;
            unsigned v2[2][2];
            v2[0][0] = last ? nvo[0][0] : vo[0][0]; v2[0][1] = last ? nvo[0][1] : vo[0][1]; v2[1][0] = last ? nvo[1][0] : vo[1][0]; v2[1][1] = last ? nvo[1][1] : vo[1][1];
            if constexpr (SP2) {
            PG8_LDB(B0, 0, 0); PG8_LDB(B1, 0, 1); PG8_SCHED; PG8_LDA(At, 0, 0); PG8_STAGE(PG8_SA(1, 1), a1, vo[1]);
            PG8_WAIT_V(8); PG8_WAIT_L(0); PG8_BAR; PG8_MMA(0, 0, At, B0); PG8_MMA(0, 1, At, B1); PG8_BAR; PG8_SCHED;
            PG8_LDA(At, 0, 1); PG8_STAGE(PG8_SB(0, 0), b2, voffB); PG8_STAGE(PG8_SB(0, 1), b2 + hstep, voffB); PG8_STAGE(PG8_SA(0, 0), a2, v2[0]);
            PG8_WAIT_V(8); PG8_WAIT_L(0); PG8_BAR; PG8_MMA(1, 0, At, B0); PG8_MMA(1, 1, At, B1); PG8_BAR; PG8_SCHED;
            PG8_LDB(B0, 1, 0); PG8_LDB(B1, 1, 1); PG8_SCHED; PG8_LDA(At, 1, 0); PG8_STAGE(PG8_SA(0, 1), a2, v2[1]);
            PG8_WAIT_V(8); PG8_WAIT_L(0); PG8_BAR; PG8_MMA(0, 0, At, B0); PG8_MMA(0, 1, At, B1); PG8_BAR; PG8_SCHED;
            PG8_LDA(At, 1, 1); PG8_STAGE(PG8_SB(1, 0), b3, voffB); PG8_STAGE(PG8_SB(1, 1), b3 + hstep, voffB); PG8_STAGE(PG8_SA(1, 0), a3, v2[0]);
            PG8_WAIT_V(8); PG8_WAIT_L(0); PG8_BAR; PG8_MMA(1, 0, At, B0); PG8_MMA(1, 1, At, B1); PG8_BAR; PG8_SCHED;
            } else {
            PG8_LDB(B0, 0, 0); PG8_SCHED; PG8_LDA(At, 0, 0); PG8_STAGE(PG8_SA(1, 1), a1, vo[1]);
            PG8_WAIT_L(8); PG8_BAR; PG8_WAIT_L(0); PG8_MMA(0, 0, At, B0); PG8_BAR; PG8_SCHED;
            PG8_LDB(B1, 0, 1); PG8_STAGE(PG8_SB(0, 0), b2, voffB);
            PG8_BAR; PG8_WAIT_L(0); PG8_MMA(0, 1, At, B1); PG8_BAR;
            PG8_LDA(At, 0, 1); PG8_STAGE(PG8_SA(0, 0), a2, v2[0]);
            PG8_BAR; PG8_WAIT_L(0); PG8_MMA(1, 0, At, B0); PG8_BAR; PG8_SCHED;
            PG8_STAGE(PG8_SB(0, 1), b2 + hstep, voffB);
            PG8_WAIT_V(6); PG8_BAR; PG8_MMA(1, 1, At, B1); PG8_BAR;
            PG8_LDB(B0, 1, 0); PG8_SCHED; PG8_LDA(At, 1, 0); PG8_STAGE(PG8_SA(0, 1), a2, v2[1]);
            PG8_WAIT_L(8); PG8_BAR; PG8_WAIT_L(0); PG8_MMA(0, 0, At, B0); PG8_BAR; PG8_SCHED;
            PG8_LDB(B1, 1, 1); PG8_STAGE(PG8_SB(1, 0), b3, voffB);
            PG8_BAR; PG8_WAIT_L(0); PG8_MMA(0, 1, At, B1); PG8_BAR;
            PG8_LDA(At, 1, 1); PG8_STAGE(PG8_SA(1, 0), a3, v2[0]);
            PG8_BAR; PG8_WAIT_L(0); PG8_MMA(1, 0, At, B0); PG8_BAR; PG8_SCHED;
            PG8_STAGE(PG8_SB(1, 1), b3 + hstep, voffB);
            PG8_WAIT_V(6); PG8_BAR; PG8_MMA(1, 1, At, B1); PG8_BAR;
            }
            if constexpr (Epi::MID) { if (t == 10 || t == 22) E.mid(acc, cur, t == 22 ? 1 : 0, wr, wc, fr, fq); }
        }
        if constexpr (ALIGN_EPI) { if (wr == 0) PG8_BAR; }
        E(acc, cur, wr, wc, fr, fq);
        if (!has_next) break;
#pragma unroll
        for (int a = 0; a < 2; ++a)
#pragma unroll
            for (int b = 0; b < 2; ++b)
#pragma unroll
                for (int m = 0; m < 4; ++m)
#pragma unroll
                    for (int n = 0; n < 2; ++n) acc[a][b][m][n] = (f32x4){0.f, 0.f, 0.f, 0.f};
        cur = nxt; cA = nA; cB = nB; ++ui;
        vo[0][0] = nvo[0][0]; vo[0][1] = nvo[0][1]; vo[1][0] = nvo[1][0]; vo[1][1] = nvo[1][1];
        if constexpr (ALIGN_EPI) { if (wr == 1) PG8_BAR; }
    }
    PG8_WAIT_V(0);
    if constexpr (!ALIGN_EPI) { if (wr == 0) PG8_BAR; }
    PG8_BAR;
#undef PG8_SA
#undef PG8_SB
#undef PG8_STAGE
#undef PG8_LDA
#undef PG8_LDB
#undef PG8_MMA
#undef PG8_WAIT_V
#undef PG8_WAIT_L
#undef PG8_BAR
#undef PG8_SCHED
}
}

constexpr int NWAVES = 8;
constexpr int BATCH = 2, SEQ = 8192, DM = 2048, T = BATCH * SEQ;
constexpr int NMEM = 256, MROWS = BATCH * NMEM;
constexpr int INW = 10252;
constexpr int NEXP = 32, TOPK = 4, CAP = T;
constexpr int QKVW = 4096;
constexpr int C_FQ = 0, C_FK = 768, C_FV = 1536, C_SQ = 2304, C_SK = 3072, C_SV = 3328, C_MQ = 3584;
constexpr int GW = 6144;
constexpr float NORM_EPS = 1e-6f;
constexpr float LOG2E = 1.4426950408889634f;
constexpr float SWIGLU_LIMIT = 7.0f, SWIGLU_ALPHA = 1.702f;
constexpr int PER_PHASE = 10;
#ifndef MK_N_LAUNCHES
#define MK_N_LAUNCHES 1
#endif
constexpr int N_LAUNCHES = MK_N_LAUNCHES;

constexpr size_t MiB = 1u << 20;
constexpr size_t WS_CTL = 0, CTL_ZERO_BYTES = 1 * MiB;
constexpr size_t WS_WIN   = 2 * MiB;
constexpr size_t WS_WMKV  = WS_WIN + 40 * MiB;
constexpr size_t WS_WUP   = WS_WMKV + 4 * MiB;
constexpr size_t WS_WOUT  = WS_WUP + 8 * MiB;
constexpr size_t WS_WRT   = WS_WOUT + 8 * MiB;
constexpr size_t WS_WGU   = WS_WRT + 1 * MiB;
constexpr size_t WS_WD    = WS_WGU + 512 * MiB;
constexpr size_t WS_XN    = WS_WD + 256 * MiB;
constexpr size_t WS_MN    = WS_XN + 64 * MiB;
constexpr size_t WS_LOGF  = WS_MN + 2 * MiB;
constexpr size_t WS_CNEG  = WS_LOGF + 1 * MiB;
constexpr size_t WS_ROPE  = WS_CNEG + 1 * MiB;
constexpr size_t WS_QKV   = WS_ROPE + 4 * MiB;
constexpr size_t WS_G     = WS_QKV + 128 * MiB;
constexpr size_t WS_MKV   = WS_G + 192 * MiB;
constexpr size_t WS_OALL  = WS_MKV + 1 * MiB;
constexpr size_t WS_MERGED= WS_OALL + 64 * MiB;
constexpr size_t WS_HB    = WS_MERGED + 64 * MiB;
constexpr size_t WS_TOK   = WS_HB + 64 * MiB;
constexpr size_t WS_GATE  = WS_TOK + 2 * MiB;
constexpr size_t WS_RS    = WS_GATE + 2 * MiB;
constexpr size_t WS_ACT   = WS_RS + 2 * MiB;
constexpr size_t WS_Y     = WS_ACT + 288 * MiB;
constexpr size_t WS_TSLOT = WS_Y + 288 * MiB;
constexpr size_t WS_TGATE = WS_TSLOT + 1 * MiB;
constexpr size_t WS_END   = WS_TGATE + 1 * MiB;
constexpr int CW_BAR = 4096;
constexpr int CW_QHEAD = 64;
constexpr int CW_CNT = 512;

typedef unsigned short bf16;
typedef unsigned v4u __attribute__((ext_vector_type(4)));
typedef unsigned v2u __attribute__((ext_vector_type(2)));
typedef float f32x4 __attribute__((ext_vector_type(4)));
typedef float f32x16 __attribute__((ext_vector_type(16)));
typedef short bf16x8 __attribute__((ext_vector_type(8)));
typedef short s16x4 __attribute__((ext_vector_type(4)));
typedef GAS unsigned gu32;
#define RLX_AGENT __ATOMIC_RELAXED, __HIP_MEMORY_SCOPE_AGENT
#define LDS_WAIT() asm volatile("s_waitcnt lgkmcnt(0)" ::: "memory")
#define VM_WAIT() asm volatile("s_waitcnt vmcnt(0)" ::: "memory")
__device__ __forceinline__ unsigned f2bf(float f) { unsigned u = __builtin_bit_cast(unsigned, f); return (u + 0x7fffu + ((u >> 16) & 1u)) >> 16; }
__device__ __forceinline__ unsigned pk2(float lo, float hi) { return f2bf(lo) | (f2bf(hi) << 16); }
__device__ __forceinline__ float bf2f(unsigned short b) { return __uint_as_float(((unsigned)b) << 16); }
__device__ __forceinline__ float wave_sum(float v) {
#pragma unroll
    for (int o = 1; o < 64; o <<= 1) v += __shfl_xor(v, o);
    return v;
}
__device__ __forceinline__ float sigmoidf_(float x) { return 1.0f / (1.0f + __expf(-x)); }

#define XB_TMO      128
#define XB_XCNT(j)  (256  + 64 * (j))
#define XB_XSUB(j)  (1280 + 64 * (j))
#define XB_XGEN(j)  (2304 + 64 * (j))
#define XB_TOP      3328
#define XB_TOPGEN   3392
#define XCD_BAR_WORDS 3456
#define XB_SPIN_CAP (1u << 18)

__device__ __forceinline__ unsigned xb_ld(unsigned* p)              { return __hip_atomic_load(p, __ATOMIC_RELAXED, __HIP_MEMORY_SCOPE_AGENT); }
__device__ __forceinline__ unsigned xb_add(unsigned* p, unsigned v) { return __hip_atomic_fetch_add(p, v, __ATOMIC_RELAXED, __HIP_MEMORY_SCOPE_AGENT); }
__device__ __forceinline__ unsigned xb_xcc_id() { return (unsigned)__builtin_amdgcn_s_getreg((3 << 11) | 20) & 0xFu; }
#define XB_SPIN(cond, bar) do { unsigned _sp = 0; while (cond) { __builtin_amdgcn_s_sleep(1); \
    if ((++_sp & 255u) == 0u) { if (xb_ld(&(bar)[XB_TMO])) break; if (_sp > XB_SPIN_CAP) { atomicAdd(&(bar)[XB_TMO], 1u); break; } } } } while (0)

struct XcdBarrier { unsigned* bar; unsigned x; volatile LAS unsigned* st; };

__device__ __forceinline__ XcdBarrier xcd_barrier_post(unsigned* bar, volatile LAS unsigned* st) {
    XcdBarrier b; b.bar = bar; b.x = xb_xcc_id(); b.st = st;
    if (threadIdx.x == 0) (void)xb_add(&bar[XB_XCNT(b.x)], 1u);
    return b;
}
__device__ __forceinline__ void xcd_barrier_complete(unsigned* bar, unsigned x, unsigned& nloc, unsigned& nx) {
    const unsigned G = gridDim.x * gridDim.y * gridDim.z;
    unsigned sum, cnt, mine, sp = 0u;
    for (;;) {
        sum = 0u; cnt = 0u; mine = 0u;
#pragma unroll
        for (unsigned j = 0; j < 16; ++j) { const unsigned c = xb_ld(&bar[XB_XCNT(j)]); sum += c; cnt += (c > 0u) ? 1u : 0u; mine = (j == x) ? c : mine; }
        if (sum == G) break;
        __builtin_amdgcn_s_sleep(1);
        if ((++sp & 255u) == 0u) { if (xb_ld(&bar[XB_TMO])) break; if (sp > XB_SPIN_CAP) { atomicAdd(&bar[XB_TMO], 1u); break; } }
    }
    nloc = mine > 0u ? mine : 1u; nx = cnt > 0u ? cnt : 1u;
}
__device__ __forceinline__ void xcd_barrier(const XcdBarrier& b) {
    asm volatile("s_waitcnt vmcnt(0)" ::: "memory");
    __syncthreads();
    if (threadIdx.x == 0) {
        unsigned* bar = b.bar;
        __builtin_amdgcn_s_waitcnt(0);
        unsigned nloc = b.st[0], nx = b.st[1];
        if (nloc == 0u) { xcd_barrier_complete(bar, b.x, nloc, nx); b.st[0] = nloc; b.st[1] = nx; }
        const unsigned old = xb_add(&bar[XB_XSUB(b.x)], 1u);
        const unsigned gen = old / nloc;
        if (old + 1u == (gen + 1u) * nloc) {
            __builtin_amdgcn_fence(__ATOMIC_RELEASE, "agent");
            asm volatile("s_waitcnt vmcnt(0)" ::: "memory");
            const unsigned og = xb_add(&bar[XB_TOP], 1u);
            const unsigned tg = og / nx;
            if (og + 1u == (tg + 1u) * nx) xb_add(&bar[XB_TOPGEN], 1u);
            else XB_SPIN(xb_ld(&bar[XB_TOPGEN]) == tg, bar);
            __builtin_amdgcn_fence(__ATOMIC_ACQUIRE, "agent");
            xb_add(&bar[XB_XGEN(b.x)], 1u);
            asm volatile("s_waitcnt vmcnt(0)" ::: "memory");
        } else {
            XB_SPIN(xb_ld(&bar[XB_XGEN(b.x)]) == gen, bar);
            __builtin_amdgcn_fence(__ATOMIC_ACQUIRE, "agent");
            asm volatile("s_waitcnt vmcnt(0)" ::: "memory");
        }
    }
    __syncthreads();
}

constexpr int RING_OFF = 0, RING_BYTES = 131072;
constexpr int LDSCTL_OFF = RING_BYTES, MISC_OFF = LDSCTL_OFF + 320;
constexpr int MOE_OFF = MISC_OFF + 128;
constexpr int LDS_BYTES = 147456;

struct Ctx {
    LAS unsigned char* lds;
    volatile LAS unsigned* MISC;
    gu32* ctl;
    int tid, lane, wave, vcu, G;
    const float *x, *mem; const int* pos; const float *norm_mix, *w_in, *b_forget, *fox_q_norm, *fox_k_norm, *swa_q_norm, *swa_k_norm, *swa_sinks, *xmem_q_norm, *xmem_k_norm, *norm_mem,
        *w_mem_kv, *w_up_fox, *w_up_swa, *w_up_xmem, *w_out, *norm_ffn, *w_router, *b_router, *w_gate_up, *b_gate_up, *w_down, *b_down;
    float* out;
    bf16 *Win_t, *Wmkv_t, *Wup_t, *Wout_t, *Wr_t, *Wgu_t, *Wd_t, *XN, *MN, *QKV, *G_, *MKV, *OALL, *MERGED, *HB, *ACT;
    float *LOGF, *CNEG, *ROPE, *GATEW, *RS, *TGATE; int *TOK, *TSLOT; bf16* Y;
};

__constant__ float INV_FREQ[32] = {1.000000000e+00f, 7.498942614e-01f, 5.623413324e-01f, 4.216965139e-01f, 3.162277639e-01f, 2.371373773e-01f, 1.778279394e-01f, 1.333521307e-01f,
    1.000000015e-01f, 7.498941571e-02f, 5.623413250e-02f, 4.216965288e-02f, 3.162277490e-02f, 2.371373773e-02f, 1.778279431e-02f, 1.333521493e-02f, 9.999999776e-03f, 7.498941850e-03f,
    5.623413250e-03f, 4.216964822e-03f, 3.162277630e-03f, 2.371373586e-03f, 1.778279431e-03f, 1.333521446e-03f, 1.000000047e-03f, 7.498942432e-04f, 5.623413017e-04f, 4.216965172e-04f,
    3.162277571e-04f, 2.371373703e-04f, 1.778279402e-04f, 1.333521504e-04f};

__device__ __forceinline__ void p0_transpose_item(const float* W, size_t ldw, int k0, int n0, bf16* WT, size_t ldt, int row0, int kd0, const float* ksc, LAS float* scr, int lane) {
#pragma unroll 8
    for (int i = 0; i < 32; ++i) { const int kk = 2 * i + (lane >> 5); float v = W[(size_t)(k0 + kk) * ldw + n0 + (lane & 31)]; if (ksc) v *= ksc[k0 + kk]; scr[kk * 33 + (lane & 31)] = v; }
    LDS_WAIT(); asm volatile("" ::: "memory");
    const int c = lane & 7;
#pragma unroll
    for (int j = 0; j < 4; ++j) { const int n = (lane >> 3) + 8 * j; const LAS float* s = scr + (8 * c) * 33 + n;
        v4u o; o.x = pk2(s[0 * 33], s[1 * 33]); o.y = pk2(s[2 * 33], s[3 * 33]); o.z = pk2(s[4 * 33], s[5 * 33]); o.w = pk2(s[6 * 33], s[7 * 33]);
        *(GAS v4u*)(WT + (size_t)(row0 + n) * ldt + kd0 + k0 + 8 * c) = o; }
    LDS_WAIT(); asm volatile("" ::: "memory");
}
__device__ __forceinline__ void p0_router_item(const float* W, int k0, bf16* WT, const float* ksc, LAS float* scr, int lane) {
#pragma unroll 8
    for (int i = 0; i < 32; ++i) { const int kk = 2 * i + (lane >> 5); scr[kk * 33 + (lane & 31)] = W[(size_t)(k0 + kk) * 32 + (lane & 31)] * ksc[k0 + kk]; }
    LDS_WAIT(); asm volatile("" ::: "memory");
    const int c = lane & 7;
#pragma unroll
    for (int j = 0; j < 4; ++j) { const int n = (lane >> 3) + 8 * j; const LAS float* s = scr + (8 * c) * 33 + n;
        unsigned h[8], l[8];
#pragma unroll
        for (int q = 0; q < 8; ++q) { const float v = s[q * 33]; h[q] = f2bf(v); l[q] = f2bf(v - __uint_as_float(h[q] << 16)); }
        v4u oh, ol; oh.x = h[0] | (h[1] << 16); oh.y = h[2] | (h[3] << 16); oh.z = h[4] | (h[5] << 16); oh.w = h[6] | (h[7] << 16);
        ol.x = l[0] | (l[1] << 16); ol.y = l[2] | (l[3] << 16); ol.z = l[4] | (l[5] << 16); ol.w = l[6] | (l[7] << 16);
        *(GAS v4u*)(WT + (size_t)n * 2048 + k0 + 8 * c) = oh; *(GAS v4u*)(WT + (size_t)(32 + n) * 2048 + k0 + 8 * c) = ol; }
    LDS_WAIT(); asm volatile("" ::: "memory");
}
__device__ __forceinline__ float log_sigmoidf_(float z) { return fminf(z, 0.f) - log1pf(__expf(-fabsf(z))); }

template <bool XROW>
__device__ __forceinline__ void p0_norm_row(const Ctx& C, const float* xrow, const float* gain, bf16* orow, const LAS float* Wf, int m) {
    const GAS f32x4* xr = (const GAS f32x4*)xrow + C.lane; const GAS f32x4* gr = (const GAS f32x4*)gain + C.lane;
    f32x4 v[8]; float s = 0.f;
#pragma unroll
    for (int j = 0; j < 8; ++j) { v[j] = xr[64 * j]; s += (v[j].x * v[j].x + v[j].y * v[j].y) + (v[j].z * v[j].z + v[j].w * v[j].w); }
    const float rstd = 1.0f / sqrtf(wave_sum(s) * (1.f / DM) + NORM_EPS);
    GAS unsigned long long* o8 = (GAS unsigned long long*)orow + C.lane;
#pragma unroll
    for (int j = 0; j < 8; ++j) { const f32x4 g = gr[64 * j]; v[j] = (v[j] * rstd) * g;
        o8[64 * j] = (unsigned long long)pk2(v[j].x, v[j].y) | ((unsigned long long)pk2(v[j].z, v[j].w) << 32); }
    if constexpr (XROW) {
        float mine = 0.f;
#pragma unroll 1
        for (int h = 0; h < 12; ++h) { const LAS f32x4* w = (const LAS f32x4*)(Wf + h * 2048) + C.lane; float d = 0.f;
#pragma unroll
            for (int j = 0; j < 8; ++j) { const f32x4 ww = w[64 * j]; d += (v[j].x * ww.x + v[j].y * ww.y) + (v[j].z * ww.z + v[j].w * ww.w); }
            d = wave_sum(d); if (C.lane == h) mine = d; }
        const int b = m / SEQ, t = m % SEQ;
        if (C.lane < 12) C.LOGF[(size_t)(b * 12 + C.lane) * SEQ + t] = log_sigmoidf_(mine + C.b_forget[C.lane]);
        if (C.lane < 32) { const float ang = (float)C.pos[m] * INV_FREQ[C.lane]; const double rev = (double)ang * 0.15915494309189535; const float fr = (float)(rev - floor(rev));
            C.ROPE[(size_t)m * 64 + C.lane] = __builtin_amdgcn_cosf(fr); C.ROPE[(size_t)m * 64 + 32 + C.lane] = __builtin_amdgcn_sinf(fr); }
    }
}
__device__ __forceinline__ void phase0(const Ctx& C) {
    LAS float* Wf = (LAS float*)(C.lds + RING_OFF);
    for (int idx = C.tid; idx < 12 * 2048; idx += NWAVES * 64) { const int k = idx / 12, h = idx - 12 * k; Wf[h * 2048 + k] = C.w_in[(size_t)k * INW + 2304 + h]; }
    __syncthreads();
    const int gw = C.vcu * NWAVES + C.wave, NGW = C.G * NWAVES;
    for (int m = gw; m < T; m += NGW) p0_norm_row<true>(C, C.x + (size_t)m * DM, C.norm_mix, C.XN + (size_t)m * DM, Wf, m);
    for (int m = gw; m < MROWS; m += NGW) p0_norm_row<false>(C, C.mem + (size_t)m * DM, C.norm_mem, C.MN + (size_t)m * DM, Wf, m);
    __syncthreads();
    LAS float* scr = (LAS float*)(C.lds + RING_OFF + C.wave * 16384);
    constexpr int I_GU = 32 * 32 * 128, I_D = 32 * 32 * 64, I_IN = 32 * 320, I_MKV = 32 * 32, I_UF = 12 * 64, I_US = 12 * 64, I_UX = 8 * 64, I_O = 32 * 64, I_R = 32;
    constexpr int NITEMS = I_GU + I_D + I_IN + I_MKV + I_UF + I_US + I_UX + I_O + I_R;
    for (int it = gw; it < NITEMS; it += NGW) {
        int r = it;
        if (r < I_GU) { const int e = r / 4096, q = r % 4096, kb = q / 128, pb = q % 128, tl = pb >> 3, jb = pb & 7;
            const int n0 = (jb < 4) ? (128 * tl + 32 * jb) : (2048 + 128 * tl + 32 * (jb - 4));
            p0_transpose_item(C.w_gate_up + (size_t)e * DM * 4096, 4096, 64 * kb, n0, C.Wgu_t + (size_t)e * 4096 * DM, DM, 32 * pb, 0, C.norm_ffn, scr, C.lane); continue; } r -= I_GU;
        if (r < I_D) { const int e = r / 2048, q = r % 2048, kb = q / 64, nb = q % 64;
            p0_transpose_item(C.w_down + (size_t)e * DM * DM, DM, 64 * kb, 32 * nb, C.Wd_t + (size_t)e * DM * DM, DM, 32 * nb, 0, nullptr, scr, C.lane); continue; } r -= I_D;
        if (r < I_IN) { const int kb = r / 320, pb = r % 320; const int n0 = (32 * pb < 2304) ? 32 * pb : 32 * pb + 12;
            p0_transpose_item(C.w_in, INW, 64 * kb, n0, C.Win_t, DM, 32 * pb, 0, nullptr, scr, C.lane); continue; } r -= I_IN;
        if (r < I_MKV) { const int kb = r / 32, nb = r % 32; p0_transpose_item(C.w_mem_kv, 1024, 64 * kb, 32 * nb, C.Wmkv_t, DM, 32 * nb, 0, nullptr, scr, C.lane); continue; } r -= I_MKV;
        if (r < I_UF) { const int kb = r / 64, nb = r % 64; p0_transpose_item(C.w_up_fox, DM, 64 * kb, 32 * nb, C.Wup_t, DM, 32 * nb, 0, nullptr, scr, C.lane); continue; } r -= I_UF;
        if (r < I_US) { const int kb = r / 64, nb = r % 64; p0_transpose_item(C.w_up_swa, DM, 64 * kb, 32 * nb, C.Wup_t, DM, 32 * nb, 768, nullptr, scr, C.lane); continue; } r -= I_US;
        if (r < I_UX) { const int kb = r / 64, nb = r % 64; p0_transpose_item(C.w_up_xmem, DM, 64 * kb, 32 * nb, C.Wup_t, DM, 32 * nb, 1536, nullptr, scr, C.lane); continue; } r -= I_UX;
        if (r < I_O) { const int kb = r / 64, nb = r % 64; p0_transpose_item(C.w_out, DM, 64 * kb, 32 * nb, C.Wout_t, DM, 32 * nb, 0, nullptr, scr, C.lane); continue; } r -= I_O;
        p0_router_item(C.w_router, 64 * r, C.Wr_t, C.norm_ffn, scr, C.lane);
    }
}

using pg8::Unit;
struct DenseOrder {
    const char* A; const char* Bt; int nM, nN, nwg, G, c;
    __device__ __forceinline__ void init(const void* A_, const void* Bt_, int M, int N, int G_, int c_) { A = (const char*)A_; Bt = (const char*)Bt_; nM = M / 256; nN = N / 256; nwg = nM * nN; G = G_; c = c_; }
    __device__ __forceinline__ bool map(long L, Unit& u) const {
        if (L >= nwg) return false;
        int wgid = (int)L; { const int q = nwg / 8, r = nwg % 8, xcd = wgid % 8, off = wgid / 8; wgid = (xcd < r ? xcd * (q + 1) : r * (q + 1) + (xcd - r) * q) + off; }
        const int nig = 8 * nN, gid = wgid / nig, fm = gid * 8, gsz = (nM - fm) < 8 ? (nM - fm) : 8;
        u.pm = fm + ((wgid % nig) % gsz); u.pn = (wgid % nig) / gsz; u.e = 0; u.kind = 0; return true;
    }
    __device__ __forceinline__ bool next(int i, Unit& u) const { return map((long)i * G + c, u); }
    __device__ __forceinline__ const char* a_base(const Unit& u) const { return A + (size_t)u.pm * (256 * 2048 * 2); }
    __device__ __forceinline__ const char* b_base(const Unit& u) const { return Bt + (size_t)u.pn * (256 * 2048 * 2); }
    __device__ __forceinline__ void a_offs(const Unit&, const int (&R)[2], const int (&Cc)[2], unsigned (&vo)[2][2]) const {
#pragma unroll
        for (int h = 0; h < 2; ++h)
#pragma unroll
            for (int i = 0; i < 2; ++i) vo[h][i] = (unsigned)((h * 128 + R[i]) * 2048 + Cc[i]) * 2u;
    }
};
struct P1Order {
    DenseOrder d; const char* A1; const char* B1;
    __device__ __forceinline__ bool next(int i, Unit& u) const {
        const long L = (long)i * d.G + d.c;
        if (L < d.nwg) return d.map(L, u);
        const int r = (int)(L - d.nwg); if (r >= 8) return false;
        u.pm = r >> 2; u.pn = r & 3; u.e = 0; u.kind = 1; return true;
    }
    __device__ __forceinline__ const char* a_base(const Unit& u) const { return (u.kind ? A1 : d.A) + (size_t)u.pm * (256 * 2048 * 2); }
    __device__ __forceinline__ const char* b_base(const Unit& u) const { return (u.kind ? B1 : d.Bt) + (size_t)u.pn * (256 * 2048 * 2); }
    __device__ __forceinline__ void a_offs(const Unit& u, const int (&R)[2], const int (&Cc)[2], unsigned (&vo)[2][2]) const { d.a_offs(u, R, Cc, vo); }
};
template <bool GATHER, int NT>
struct MoeOrder {
    const char* A; const char* Bt; const int* tok; const int* cnt; const LAS int* tab; int G, c;
    __device__ __forceinline__ bool next(int i, Unit& u) const {
        const int L = i * G + c; if (L >= __builtin_amdgcn_readfirstlane(tab[32])) return false;
        int e = 0;
#pragma unroll 1
        for (int j = 1; j < 32; ++j) e += (__builtin_amdgcn_readfirstlane(tab[j]) <= L) ? 1 : 0;
        const int j = L - __builtin_amdgcn_readfirstlane(tab[e]), mt = __builtin_amdgcn_readfirstlane(tab[33 + e]), per = mt * 4, ntg = j / per, r = j - ntg * per;
        u.e = e; u.pm = r >> 2; u.pn = ntg * 4 + (r & 3); u.kind = __builtin_amdgcn_readfirstlane(tab[65 + e]) + 256 * u.pm;
        return true;
    }
    __device__ __forceinline__ const char* a_base(const Unit& u) const { return GATHER ? A : A + (size_t)u.kind * (2048 * 2); }
    __device__ __forceinline__ const char* b_base(const Unit& u) const { return Bt + ((size_t)u.e * NT + u.pn) * (256 * 2048 * 2); }
    __device__ __forceinline__ void a_offs(const Unit& u, const int (&R)[2], const int (&Cc)[2], unsigned (&vo)[2][2]) const {
#pragma unroll
        for (int h = 0; h < 2; ++h)
#pragma unroll
            for (int i = 0; i < 2; ++i) {
                if constexpr (GATHER) { const int ri = 256 * u.pm + h * 128 + R[i]; const int row = (ri < cnt[u.e]) ? tok[u.e * CAP + ri] : 0; vo[h][i] = (unsigned)(row * 2048 + Cc[i]) * 2u; }
                else vo[h][i] = (unsigned)((h * 128 + R[i]) * 2048 + Cc[i]) * 2u;
            }
    }
};

using pg8::f32x2; using pg8::u32x4; using pg8::u32x2; using pg8::cvt_pk_bf16; using pg8::bf_lo; using pg8::bf_hi;
struct EpiInProj {
    static constexpr bool PERM = true, MID = false;
    bf16* QKV; bf16* Gt; bf16* MKV;
    __device__ __forceinline__ void mid(pg8::f32x4 (&)[2][2][4][2], const Unit&, int, int, int, int, int) const {}
    __device__ __forceinline__ void operator()(const pg8::f32x4 (&acc)[2][2][4][2], const Unit& u, int wr, int wc, int fr, int fq) const {
        asm volatile("" : "+v"(fr), "+v"(fq));
        const int row0 = u.pm * 256 + wr * 64 + fr;
        bf16* base; int ldc, colt; bool sg = false;
        if (u.kind) { base = MKV; ldc = 1024; colt = u.pn * 256; }
        else if (u.pn < 16) { base = QKV; ldc = QKVW; colt = u.pn * 256; }
        else { base = Gt; ldc = GW; colt = (u.pn - 16) * 256; sg = true; }
        const int col0 = colt + wc * 32 + 8 * fq;
#pragma unroll
        for (int ai = 0; ai < 2; ++ai)
#pragma unroll
            for (int m = 0; m < 4; ++m) { bf16* rowp = base + (size_t)(row0 + ai * 128 + m * 16) * ldc + col0;
#pragma unroll
                for (int bj = 0; bj < 2; ++bj) { pg8::f32x4 v0 = acc[ai][bj][m][0], v1 = acc[ai][bj][m][1];
                    if (sg) {
#pragma unroll
                        for (int q = 0; q < 4; ++q) { v0[q] = sigmoidf_(fmaxf(v0[q], -30.f)); v1[q] = sigmoidf_(fmaxf(v1[q], -30.f)); } }
                    u32x4 w; w.x = cvt_pk_bf16(v0[0], v0[1]); w.y = cvt_pk_bf16(v0[2], v0[3]); w.z = cvt_pk_bf16(v1[0], v1[1]); w.w = cvt_pk_bf16(v1[2], v1[3]);
                    *(u32x4*)(rowp + bj * 128) = w; } }
    }
};
struct EpiMerge {
    static constexpr bool PERM = true, MID = true;
    const bf16* Gt; bf16* O;
    __device__ __forceinline__ void mid(pg8::f32x4 (&acc)[2][2][4][2], const Unit& u, int which, int wr, int wc, int fr, int fq) const {
        asm volatile("" : "+v"(fr), "+v"(fq));
        const int row0 = u.pm * 256 + wr * 64 + fr, col0 = u.pn * 256 + wc * 32 + 8 * fq;
        const bf16* gn = Gt + (which ? 2048 : 0); const bf16* gd = Gt + (which ? 4096 : 2048);
#pragma unroll
        for (int ai = 0; ai < 2; ++ai)
#pragma unroll
            for (int m = 0; m < 4; ++m) { const size_t ro = (size_t)(row0 + ai * 128 + m * 16) * GW + col0;
#pragma unroll
                for (int bj = 0; bj < 2; ++bj) { const u32x4 a = *(const u32x4*)(gn + ro + bj * 128), b = *(const u32x4*)(gd + ro + bj * 128);
                    pg8::f32x4 r0, r1;
                    r0[0] = bf_lo(a.x) * __builtin_amdgcn_rcpf(bf_lo(b.x)); r0[1] = bf_hi(a.x) * __builtin_amdgcn_rcpf(bf_hi(b.x)); r0[2] = bf_lo(a.y) * __builtin_amdgcn_rcpf(bf_lo(b.y)); r0[3] = bf_hi(a.y) * __builtin_amdgcn_rcpf(bf_hi(b.y));
                    r1[0] = bf_lo(a.z) * __builtin_amdgcn_rcpf(bf_lo(b.z)); r1[1] = bf_hi(a.z) * __builtin_amdgcn_rcpf(bf_hi(b.z)); r1[2] = bf_lo(a.w) * __builtin_amdgcn_rcpf(bf_lo(b.w)); r1[3] = bf_hi(a.w) * __builtin_amdgcn_rcpf(bf_hi(b.w));
                    acc[ai][bj][m][0] *= r0; acc[ai][bj][m][1] *= r1; }
                asm volatile("" : "+v"(acc[ai][0][m][0]), "+v"(acc[ai][0][m][1]), "+v"(acc[ai][1][m][0]), "+v"(acc[ai][1][m][1]));
                asm volatile("" ::: "memory"); }
    }
    __device__ __forceinline__ void operator()(const pg8::f32x4 (&acc)[2][2][4][2], const Unit& u, int wr, int wc, int fr, int fq) const {
        asm volatile("" : "+v"(fr), "+v"(fq));
        const int row0 = u.pm * 256 + wr * 64 + fr, col0 = u.pn * 256 + wc * 32 + 8 * fq;
#pragma unroll
        for (int ai = 0; ai < 2; ++ai)
#pragma unroll
            for (int m = 0; m < 4; ++m) { const size_t rr = (size_t)(row0 + ai * 128 + m * 16);
#pragma unroll
                for (int bj = 0; bj < 2; ++bj) { const u32x4 g = *(const u32x4*)(Gt + rr * GW + 4096 + col0 + bj * 128);
                    const pg8::f32x4 v0 = acc[ai][bj][m][0], v1 = acc[ai][bj][m][1];
                    u32x4 w; w.x = cvt_pk_bf16(v0[0] * bf_lo(g.x), v0[1] * bf_hi(g.x)); w.y = cvt_pk_bf16(v0[2] * bf_lo(g.y), v0[3] * bf_hi(g.y));
                    w.z = cvt_pk_bf16(v1[0] * bf_lo(g.z), v1[1] * bf_hi(g.z)); w.w = cvt_pk_bf16(v1[2] * bf_lo(g.w), v1[3] * bf_hi(g.w));
                    *(u32x4*)(O + rr * DM + col0 + bj * 128) = w; }
                asm volatile("" ::: "memory"); }
    }
};
struct EpiOut {
    static constexpr bool PERM = false, MID = false;
    const float* X; float* out; bf16* HB;
    __device__ __forceinline__ void mid(pg8::f32x4 (&)[2][2][4][2], const Unit&, int, int, int, int, int) const {}
    __device__ __forceinline__ void operator()(const pg8::f32x4 (&acc)[2][2][4][2], const Unit& u, int wr, int wc, int fr, int fq) const {
        asm volatile("" : "+v"(fr), "+v"(fq));
        const int row0 = u.pm * 256 + wr * 64 + fr, col0 = u.pn * 256 + wc * 32 + 4 * fq;
#pragma unroll
        for (int ai = 0; ai < 2; ++ai)
#pragma unroll
            for (int m = 0; m < 4; ++m) { const size_t off = (size_t)(row0 + ai * 128 + m * 16) * DM + col0;
#pragma unroll
                for (int bj = 0; bj < 2; ++bj)
#pragma unroll
                    for (int n = 0; n < 2; ++n) { const size_t o2 = off + bj * 128 + n * 16; const pg8::f32x4 h = *(const pg8::f32x4*)(X + o2) + acc[ai][bj][m][n];
                        *(pg8::f32x4*)(out + o2) = h; u32x2 w; w.x = cvt_pk_bf16(h[0], h[1]); w.y = cvt_pk_bf16(h[2], h[3]); *(u32x2*)(HB + o2) = w; } }
    }
};
struct EpiGateUp {
    static constexpr bool PERM = true, MID = false;
    const float* RS; const float* bgu; bf16* ACT;
    __device__ __forceinline__ void mid(pg8::f32x4 (&)[2][2][4][2], const Unit&, int, int, int, int, int) const {}
    __device__ __forceinline__ void operator()(const pg8::f32x4 (&acc)[2][2][4][2], const Unit& u, int wr, int wc, int fr, int fq) const {
        asm volatile("" : "+v"(fr), "+v"(fq));
        const int r0 = wr * 64 + fr, hc0 = u.pn * 128 + wc * 32 + 8 * fq;
        const float* bg = bgu + (size_t)u.e * 4096 + hc0;
        const pg8::f32x4 bg0 = *(const pg8::f32x4*)(bg), bg1 = *(const pg8::f32x4*)(bg + 4), bu0 = *(const pg8::f32x4*)(bg + 2048), bu1 = *(const pg8::f32x4*)(bg + 2052);
#pragma unroll
        for (int ai = 0; ai < 2; ++ai)
#pragma unroll
            for (int m = 0; m < 4; ++m) { const int rl = r0 + ai * 128 + m * 16;
                const float rs = RS[u.e * CAP + 256 * u.pm + rl];
                float g[8], up[8];
#pragma unroll
                for (int q = 0; q < 4; ++q) { g[q] = rs * acc[ai][0][m][0][q] + bg0[q]; g[4 + q] = rs * acc[ai][0][m][1][q] + bg1[q]; up[q] = rs * acc[ai][1][m][0][q] + bu0[q]; up[4 + q] = rs * acc[ai][1][m][1][q] + bu1[q]; }
                float a[8];
#pragma unroll
                for (int q = 0; q < 8; ++q) { const float gg = fminf(g[q], SWIGLU_LIMIT), uu = fminf(fmaxf(up[q], -SWIGLU_LIMIT), SWIGLU_LIMIT); a[q] = (uu + 1.0f) * (gg * sigmoidf_(gg * SWIGLU_ALPHA)); }
                u32x4 w; w.x = cvt_pk_bf16(a[0], a[1]); w.y = cvt_pk_bf16(a[2], a[3]); w.z = cvt_pk_bf16(a[4], a[5]); w.w = cvt_pk_bf16(a[6], a[7]);
                *(u32x4*)(ACT + (size_t)(u.kind + rl) * DM + hc0) = w; }
    }
};
struct EpiDown {
    static constexpr bool PERM = true, MID = false;
    const float* bd; bf16* Y;
    __device__ __forceinline__ void mid(pg8::f32x4 (&)[2][2][4][2], const Unit&, int, int, int, int, int) const {}
    __device__ __forceinline__ void operator()(const pg8::f32x4 (&acc)[2][2][4][2], const Unit& u, int wr, int wc, int fr, int fq) const {
        asm volatile("" : "+v"(fr), "+v"(fq));
        const int r0 = wr * 64 + fr, col0 = u.pn * 256 + wc * 32 + 8 * fq;
        const float* bb = bd + (size_t)u.e * DM + col0;
        pg8::f32x4 bv[2][2];
#pragma unroll
        for (int bj = 0; bj < 2; ++bj)
#pragma unroll
            for (int n = 0; n < 2; ++n) bv[bj][n] = *(const pg8::f32x4*)(bb + bj * 128 + n * 4);
#pragma unroll
        for (int ai = 0; ai < 2; ++ai)
#pragma unroll
            for (int m = 0; m < 4; ++m) { bf16* rowp = Y + (size_t)(u.kind + r0 + ai * 128 + m * 16) * DM + col0;
#pragma unroll
                for (int bj = 0; bj < 2; ++bj) { const pg8::f32x4 v0 = acc[ai][bj][m][0] + bv[bj][0], v1 = acc[ai][bj][m][1] + bv[bj][1];
                    u32x4 w; w.x = cvt_pk_bf16(v0[0], v0[1]); w.y = cvt_pk_bf16(v0[2], v0[3]); w.z = cvt_pk_bf16(v1[0], v1[1]); w.w = cvt_pk_bf16(v1[2], v1[3]);
                    *(u32x4*)(rowp + bj * 128) = w; } }
    }
};

__device__ __forceinline__ void phase2(const Ctx& C) {
    constexpr float C2_64 = 0.125f * LOG2E, C2_128 = 0.08838834764831845f * LOG2E;
    const int i = C.tid;
    int kind;
    const float* gain; float sc = 1.f; int gofs;
    if (i < 96)        { kind = 1; gain = C.fox_q_norm;  sc = C2_64;  gofs = (i & 7) * 8; }
    else if (i < 192)  { kind = 1; gain = C.fox_k_norm;  gofs = (i & 7) * 8; }
    else if (i < 288)  { kind = 0; gain = C.fox_k_norm;  gofs = 0; }
    else if (i < 384)  { kind = 2; gain = C.swa_q_norm;  sc = C2_64;  gofs = (i & 7) * 8; }
    else if (i < 416)  { kind = 2; gain = C.swa_k_norm;  gofs = (i & 7) * 8; }
    else if (i < 448)  { kind = 0; gain = C.swa_k_norm;  gofs = 0; }
    else               { kind = 3; gain = C.xmem_q_norm; sc = C2_128; gofs = (i & 15) * 8; }
    float gv[8];
#pragma unroll
    for (int q = 0; q < 8; ++q) gv[q] = gain[gofs + q] * sc;
    const int li = i & 7;
    const int rj = (li & 3) * 8;
    for (int m = C.vcu; m < T; m += C.G) {
        bf16* p = C.QKV + (size_t)m * QKVW + i * 8;
        const v4u raw = *(const GAS v4u*)p;
        float v[8]; v[0] = pg8::bf_lo(raw.x); v[1] = pg8::bf_hi(raw.x); v[2] = pg8::bf_lo(raw.y); v[3] = pg8::bf_hi(raw.y); v[4] = pg8::bf_lo(raw.z); v[5] = pg8::bf_hi(raw.z); v[6] = pg8::bf_lo(raw.w); v[7] = pg8::bf_hi(raw.w);
        float ss = 0.f;
#pragma unroll
        for (int q = 0; q < 8; ++q) ss += v[q] * v[q];
        ss += __shfl_xor(ss, 1); ss += __shfl_xor(ss, 2); ss += __shfl_xor(ss, 4);
        const float ss16 = ss + __shfl_xor(ss, 8);
        const float rstd = (kind == 3) ? 1.0f / sqrtf(ss16 * (1.f / 128.f) + NORM_EPS) : 1.0f / sqrtf(ss * (1.f / 64.f) + NORM_EPS);
#pragma unroll
        for (int q = 0; q < 8; ++q) v[q] = (v[q] * rstd) * gv[q];
        float o[8];
#pragma unroll
        for (int q = 0; q < 8; ++q) o[q] = __shfl_xor(v[q], 4);
        if (kind == 2) {
            const float* cs = C.ROPE + (size_t)m * 64 + rj;
            const f32x4 c0 = *(const GAS f32x4*)cs, c1 = *(const GAS f32x4*)(cs + 4), s0 = *(const GAS f32x4*)(cs + 32), s1 = *(const GAS f32x4*)(cs + 36);
            const float cc[8] = {c0.x, c0.y, c0.z, c0.w, c1.x, c1.y, c1.z, c1.w}, sn[8] = {s0.x, s0.y, s0.z, s0.w, s1.x, s1.y, s1.z, s1.w};
            const float sg = (li < 4) ? -1.f : 1.f;
#pragma unroll
            for (int q = 0; q < 8; ++q) v[q] = v[q] * cc[q] + sg * o[q] * sn[q];
        }
        if (kind != 0) { v4u w; w.x = pk2(v[0], v[1]); w.y = pk2(v[2], v[3]); w.z = pk2(v[4], v[5]); w.w = pk2(v[6], v[7]); *(GAS v4u*)p = w; }
    }
    {
        const int rsub = i >> 6, l6 = i & 63; float gk[8];
#pragma unroll
        for (int q = 0; q < 8; ++q) gk[q] = C.xmem_k_norm[(l6 & 15) * 8 + q];
        for (int m = C.vcu * 8 + rsub; m < MROWS; m += C.G * 8) {
            bf16* p = C.MKV + (size_t)m * 1024 + l6 * 8;
            const v4u raw = *(const GAS v4u*)p;
            float v[8]; v[0] = pg8::bf_lo(raw.x); v[1] = pg8::bf_hi(raw.x); v[2] = pg8::bf_lo(raw.y); v[3] = pg8::bf_hi(raw.y); v[4] = pg8::bf_lo(raw.z); v[5] = pg8::bf_hi(raw.z); v[6] = pg8::bf_lo(raw.w); v[7] = pg8::bf_hi(raw.w);
            float ss = 0.f;
#pragma unroll
            for (int q = 0; q < 8; ++q) ss += v[q] * v[q];
            ss += __shfl_xor(ss, 1); ss += __shfl_xor(ss, 2); ss += __shfl_xor(ss, 4); ss += __shfl_xor(ss, 8);
            const float rstd = 1.0f / sqrtf(ss * (1.f / 128.f) + NORM_EPS);
#pragma unroll
            for (int q = 0; q < 8; ++q) v[q] = (v[q] * rstd) * gk[q];
            v4u w; w.x = pk2(v[0], v[1]); w.y = pk2(v[2], v[3]); w.z = pk2(v[4], v[5]); w.w = pk2(v[6], v[7]); *(GAS v4u*)p = w;
        }
    }
    if (C.wave == 0) for (int sq = C.vcu; sq < BATCH * 12; sq += C.G) {
        const float* src = C.LOGF + (size_t)sq * SEQ + C.lane * 128; float* dst = C.CNEG + (size_t)sq * SEQ + C.lane * 128;
        float tot = 0.f;
#pragma unroll 4
        for (int j = 0; j < 32; ++j) { const f32x4 a = *(const GAS f32x4*)(src + 4 * j); tot += (a.x + a.y) + (a.z + a.w); }
        float incl = tot;
#pragma unroll
        for (int o = 1; o < 64; o <<= 1) { const float n = __shfl_up(incl, o); if (C.lane >= o) incl += n; }
        float run = incl - tot;
#pragma unroll 4
        for (int j = 0; j < 32; ++j) { const f32x4 a = *(const GAS f32x4*)(src + 4 * j); f32x4 c;
            run += a.x; c.x = -run * LOG2E; run += a.y; c.y = -run * LOG2E; run += a.z; c.z = -run * LOG2E; run += a.w; c.w = -run * LOG2E; *(GAS f32x4*)(dst + 4 * j) = c; }
    }
}

namespace att {
typedef __attribute__((address_space(3))) const char* lds_cptr;
__device__ __forceinline__ void glds16(const void* gsrc, unsigned lds_dst) { unsigned keep;
    asm volatile("s_mov_b32 %0, m0\n\ts_mov_b32 m0, %2\n\ts_nop 0\n\tglobal_load_lds_dwordx4 %1, off\n\ts_mov_b32 m0, %0" : "=&s"(keep) : "v"(gsrc), "s"(lds_dst) : "memory"); }
typedef float f32x2_t __attribute__((ext_vector_type(2))); typedef __bf16 bf16x2_t __attribute__((ext_vector_type(2)));
__device__ __forceinline__ unsigned cvtpk_s(float lo, float hi) { f32x2_t v = {lo, hi}; bf16x2_t b = __builtin_convertvector(v, bf16x2_t); return __builtin_bit_cast(unsigned, b); }
__device__ __forceinline__ int crow(int r, int hi) { return (r & 3) + 8 * (r >> 2) + 4 * hi; }

template <int D> struct Geo {
    static constexpr int SLOTB = 64 * D * 2, NSLOT = (D == 64) ? 3 : 2, PPT = (D == 64) ? 2 : 4;
    static constexpr int LDS_K = 0, LDS_V = NSLOT * SLOTB, LDS_WS = 2 * NSLOT * SLOTB, LDS_OST = LDS_WS + 2048, LDS_CB = LDS_OST + 8 * 4096, LDS_END = LDS_CB + 32768;
};

template <int D>
__device__ __forceinline__ void qkt(f32x16& p0, f32x16& p1, lds_cptr Kslot, const bf16x8* qr, int r32, int hi) {
    lds_cptr kb = Kslot + hi * 1024 + r32 * 16;
    p0 = f32x16{}; p1 = f32x16{};
#pragma unroll
    for (int d0 = 0; d0 < D / 16; ++d0) {
        const bf16x8 b0 = *(const LAS bf16x8*)(kb + d0 * 2048);
        const bf16x8 b1 = *(const LAS bf16x8*)(kb + d0 * 2048 + 512);
        p0 = __builtin_amdgcn_mfma_f32_32x32x16_bf16(b0, qr[d0], p0, 0, 0, 0); p1 = __builtin_amdgcn_mfma_f32_32x32x16_bf16(b1, qr[d0], p1, 0, 0, 0); }
}
template <int D>
__device__ __forceinline__ void pv(f32x16* o, int vb, bf16x8 pa0, bf16x8 pa1, bf16x8 pa2, bf16x8 pa3) {
#pragma unroll
    for (int d0 = 0; d0 < D / 32; ++d0) { s16x4 lo[4], hi[4];
#pragma unroll
        for (int ks = 0; ks < 4; ++ks) {
            asm volatile("ds_read_b64_tr_b16 %0,%1 offset:%c2" : "=&v"(lo[ks]) : "v"(vb), "i"(d0 * 4096 + ks * 1024) : "memory");
            asm volatile("ds_read_b64_tr_b16 %0,%1 offset:%c2" : "=&v"(hi[ks]) : "v"(vb), "i"(d0 * 4096 + ks * 1024 + 512) : "memory"); }
        asm volatile("s_waitcnt lgkmcnt(0)" ::: "memory"); __builtin_amdgcn_sched_barrier(0);
#define ATT_PK(k) (bf16x8){lo[k][0], lo[k][1], lo[k][2], lo[k][3], hi[k][0], hi[k][1], hi[k][2], hi[k][3]}
        o[d0] = __builtin_amdgcn_mfma_f32_32x32x16_bf16(pa0, ATT_PK(0), o[d0], 0, 0, 0);
        o[d0] = __builtin_amdgcn_mfma_f32_32x32x16_bf16(pa1, ATT_PK(1), o[d0], 0, 0, 0);
        o[d0] = __builtin_amdgcn_mfma_f32_32x32x16_bf16(pa2, ATT_PK(2), o[d0], 0, 0, 0);
        o[d0] = __builtin_amdgcn_mfma_f32_32x32x16_bf16(pa3, ATT_PK(3), o[d0], 0, 0, 0);
#undef ATT_PK
    }
}

template <int D, int MODE>
__device__ __forceinline__ void attn_unit(LAS unsigned char* shm, const bf16* Q, int pitchQ, const bf16* K, const bf16* V, int pitchKV, bf16* O, const float* cneg, float sink2, int qb) {
    typedef Geo<D> G;
    const int tid = threadIdx.x, lane = tid & 63, r32 = lane & 31, hi = lane >> 5; const int wid = __builtin_amdgcn_readfirstlane(tid >> 6);
    const int q0 = qb * 256, q0w = q0 + wid * 32;
    const unsigned lds0 = (unsigned)(uintptr_t)shm;
    LAS float* wsf = (LAS float*)(shm + G::LDS_WS) + wid * 64;
    LAS float* cb = (LAS float*)(shm + G::LDS_CB);
    const int j_lo = (MODE == 1) ? (qb > 0 ? 4 * qb - 2 : 0) : 0, j_hi = (MODE == 2) ? 4 : 4 * qb + 4;
    bf16x8 qr[D / 16];
    { const bf16* Qw = Q + (size_t)(q0w + r32) * pitchQ + hi * 8;
#pragma unroll
      for (int d0 = 0; d0 < D / 16; ++d0) qr[d0] = *(const GAS bf16x8*)(Qw + d0 * 16); }
    if constexpr (MODE == 0) {
        const int nch = (q0 + 256) / 4;
        for (int c = tid; c < nch; c += 512) { const f32x4 v = *(const GAS f32x4*)(cneg + 4 * c); *(LAS f32x4*)(cb + 4 * c) = v; }
    }
#define ATT_DMA(j, slot) do { const int _s = (slot) * G::SLOTB; \
        if constexpr (D == 64) { \
            glds16(K + (size_t)(64 * (j) + lane) * pitchKV + wid * 8, (unsigned)__builtin_amdgcn_readfirstlane(lds0 + G::LDS_K + _s + wid * 1024)); \
            glds16(V + (size_t)(64 * (j) + 16 * (wid & 3) + (lane >> 2)) * pitchKV + (wid >> 2) * 32 + (lane & 3) * 8, (unsigned)__builtin_amdgcn_readfirstlane(lds0 + G::LDS_V + _s + wid * 1024)); \
        } else { \
            _Pragma("unroll") for (int _p = 0; _p < 2; ++_p) { const int _c = wid + 8 * _p; \
                glds16(K + (size_t)(64 * (j) + lane) * pitchKV + _c * 8, (unsigned)__builtin_amdgcn_readfirstlane(lds0 + G::LDS_K + _s + _c * 1024)); } \
            _Pragma("unroll") for (int _p = 0; _p < 2; ++_p) { const int _c = wid + 8 * _p; \
                glds16(V + (size_t)(64 * (j) + 16 * (_c & 3) + (lane >> 2)) * pitchKV + (_c >> 2) * 32 + (lane & 3) * 8, (unsigned)__builtin_amdgcn_readfirstlane(lds0 + G::LDS_V + _s + _c * 1024)); } \
        } } while (0)
    int slot_i = 0;
#pragma unroll
    for (int p = 0; p < G::NSLOT - 1; ++p) if (j_lo + p < j_hi) ATT_DMA(j_lo + p, p);
    float mhat = -1e30f, l_reg = 0.f; f32x16 o[D / 32];
#pragma unroll
    for (int d0 = 0; d0 < D / 32; ++d0) o[d0] = f32x16{};
    const lds_cptr shm3 = (lds_cptr)shm;
    const int vb0 = (int)(lds0 + G::LDS_V) + ((lane >> 4) & 1) * 32 + (lane & 3) * 8 + (4 * hi + ((lane & 15) >> 2)) * 64;
    const int qabs = q0w + r32;
    for (int j = j_lo; j < j_hi; ++j) {
        if (G::NSLOT == 3 && j + 1 < j_hi) { if constexpr (G::PPT == 2) asm volatile("s_waitcnt vmcnt(2) lgkmcnt(0)\n\ts_barrier" ::: "memory"); else asm volatile("s_waitcnt vmcnt(4) lgkmcnt(0)\n\ts_barrier" ::: "memory"); }
        else asm volatile("s_waitcnt vmcnt(0) lgkmcnt(0)\n\ts_barrier" ::: "memory");
        { const int jn = j + G::NSLOT - 1; if (jn < j_hi) { int sn = slot_i + G::NSLOT - 1; if (sn >= G::NSLOT) sn -= G::NSLOT; ATT_DMA(jn, sn); } }
        bool need = true;
        if constexpr (MODE == 0) need = (64 * j <= q0w + 31);
        if constexpr (MODE == 1) need = (64 * j <= q0w + 31) && (64 * j + 63 >= q0w - 127);
        if (need) {
            f32x16 p0, p1;
            qkt<D>(p0, p1, shm3 + G::LDS_K + slot_i * G::SLOTB, qr, r32, hi);
            if constexpr (MODE == 0) {
                const LAS float* cbp = cb + 64 * j + 4 * hi;
#pragma unroll
                for (int g = 0; g < 4; ++g) { const f32x4 b0 = *(const LAS f32x4*)(cbp + 8 * g), b1 = *(const LAS f32x4*)(cbp + 32 + 8 * g);
#pragma unroll
                    for (int e = 0; e < 4; ++e) { p0[4 * g + e] += b0[e]; p1[4 * g + e] += b1[e]; } }
                if (64 * j + 63 > q0w) {
#pragma unroll
                    for (int r = 0; r < 16; ++r) { const int kv = 64 * j + crow(r, hi); if (kv > qabs) p0[r] = -INFINITY; if (kv + 32 > qabs) p1[r] = -INFINITY; } }
            }
            if constexpr (MODE == 1) {
#pragma unroll
                for (int r = 0; r < 16; ++r) { const int kv = 64 * j + crow(r, hi); const int d0_ = qabs - kv, d1_ = d0_ - 32;
                    if (d0_ < 0 || d0_ >= 128) p0[r] = -INFINITY; if (d1_ < 0 || d1_ >= 128) p1[r] = -INFINITY; }
            }
            float rm = fmaxf(p0[0], p1[0]);
#pragma unroll
            for (int r = 1; r < 16; ++r) rm = fmaxf(rm, fmaxf(p0[r], p1[r]));
            { auto rr = __builtin_amdgcn_permlane32_swap(__float_as_uint(rm), __float_as_uint(rm), false, false); rm = fmaxf(__uint_as_float(rr[0]), __uint_as_float(rr[1])); }
            if (__any(rm > mhat)) {
                const float mn = fmaxf(mhat, rm); const float f = __builtin_amdgcn_exp2f(mhat - mn); mhat = mn; l_reg *= f;
                if (hi == 0) wsf[r32] = f;
                asm volatile("s_waitcnt lgkmcnt(0)" ::: "memory");
#pragma unroll
                for (int g = 0; g < 4; ++g) { const f32x4 fv = *(const LAS f32x4*)(wsf + 8 * g + 4 * hi);
#pragma unroll
                    for (int d_ = 0; d_ < D / 32; ++d_)
#pragma unroll
                        for (int e = 0; e < 4; ++e) o[d_][4 * g + e] *= fv[e]; }
            }
            float sacc = 0.f;
#pragma unroll
            for (int r = 0; r < 16; ++r) { p0[r] = __builtin_amdgcn_exp2f(p0[r] - mhat); p1[r] = __builtin_amdgcn_exp2f(p1[r] - mhat); sacc += p0[r] + p1[r]; }
            l_reg += sacc;
            u32x4 pw0, pw1, pw2, pw3;
            pw0 = (u32x4){cvtpk_s(p0[0], p0[1]), cvtpk_s(p0[2], p0[3]), cvtpk_s(p0[4], p0[5]), cvtpk_s(p0[6], p0[7])};
            pw1 = (u32x4){cvtpk_s(p0[8], p0[9]), cvtpk_s(p0[10], p0[11]), cvtpk_s(p0[12], p0[13]), cvtpk_s(p0[14], p0[15])};
            pw2 = (u32x4){cvtpk_s(p1[0], p1[1]), cvtpk_s(p1[2], p1[3]), cvtpk_s(p1[4], p1[5]), cvtpk_s(p1[6], p1[7])};
            pw3 = (u32x4){cvtpk_s(p1[8], p1[9]), cvtpk_s(p1[10], p1[11]), cvtpk_s(p1[12], p1[13]), cvtpk_s(p1[14], p1[15])};
            pv<D>(o, vb0 + slot_i * G::SLOTB, __builtin_bit_cast(bf16x8, pw0), __builtin_bit_cast(bf16x8, pw1), __builtin_bit_cast(bf16x8, pw2), __builtin_bit_cast(bf16x8, pw3));
        }
        ++slot_i; if (slot_i == G::NSLOT) slot_i = 0;
    }
#undef ATT_DMA
    { auto rr = __builtin_amdgcn_permlane32_swap(__float_as_uint(l_reg), __float_as_uint(l_reg), false, false); l_reg = __uint_as_float(rr[0]) + __uint_as_float(rr[1]); }
    if constexpr (MODE == 1) l_reg += __builtin_amdgcn_exp2f(sink2 - mhat);
    if (hi == 0) wsf[32 + r32] = l_reg;
    asm volatile("s_waitcnt lgkmcnt(0)" ::: "memory");
    float rli[16];
#pragma unroll
    for (int g = 0; g < 4; ++g) { const f32x4 lv = *(const LAS f32x4*)(wsf + 32 + 8 * g + 4 * hi);
#pragma unroll
        for (int e = 0; e < 4; ++e) rli[4 * g + e] = __builtin_amdgcn_rcpf(lv[e]); }
    bf16* Ow = O + (size_t)q0w * 2048;
    LAS bf16* stg = (LAS bf16*)(shm + G::LDS_OST) + wid * 2048;
#pragma unroll
    for (int ps = 0; ps < D / 64; ++ps) {
#pragma unroll
        for (int r = 0; r < 16; ++r) { const int orow = crow(r, hi);
#pragma unroll
            for (int dl = 0; dl < 2; ++dl) stg[orow * 64 + dl * 32 + r32] = (bf16)f2bf(o[2 * ps + dl][r] * rli[r]); }
        asm volatile("s_waitcnt lgkmcnt(0)" ::: "memory");
#pragma unroll
        for (int i = 0; i < 4; ++i) { const int row = i * 8 + (lane >> 3), ch = lane & 7; const v4u v = *(const LAS v4u*)(stg + row * 64 + ch * 8); *(GAS v4u*)(Ow + (size_t)row * 2048 + ps * 64 + ch * 8) = v; }
        asm volatile("s_waitcnt lgkmcnt(0)" ::: "memory");
    }
    asm volatile("s_waitcnt lgkmcnt(0)\n\ts_barrier" ::: "memory");
}
}

constexpr int NU_FOX = BATCH * 12 * 32, NU_SWA = BATCH * 12 * 32, NU_XM = BATCH * 4 * 32;
__device__ __forceinline__ int att_fetch(const Ctx& C, int q) {
    int v = 0; if (C.tid == 0) v = (int)__hip_atomic_fetch_add((unsigned*)(C.ctl + CW_QHEAD + 64 * q), 1u, RLX_AGENT); return v;
}
__device__ __forceinline__ void phase3(const Ctx& C) {
    LAS unsigned char* shm = C.lds + RING_OFF;
    volatile LAS int* nxtw = (volatile LAS int*)(C.MISC + 12);
    {
        int pre = att_fetch(C, 0);
        if (C.tid == 0) *nxtw = pre;
        __syncthreads();
        int cur = __builtin_amdgcn_readfirstlane(*nxtw);
        __syncthreads();
        while (cur < NU_FOX) {
            pre = att_fetch(C, 0);
            const int qb = 31 - cur / 24, bh = cur % 24, b = bh / 12, h = bh % 12;
            const bf16* base = C.QKV + (size_t)b * SEQ * QKVW + h * 64;
            att::attn_unit<64, 0>(shm, base + C_FQ, QKVW, base + C_FK, base + C_FV, QKVW, C.OALL + (size_t)b * SEQ * 2048 + h * 64, C.CNEG + (size_t)(b * 12 + h) * SEQ, 0.f, qb);
            if (C.tid == 0) *nxtw = pre;
            __syncthreads();
            cur = __builtin_amdgcn_readfirstlane(*nxtw);
            __syncthreads();
        }
    }
    {
        int pre = att_fetch(C, 1);
        if (C.tid == 0) *nxtw = pre;
        __syncthreads();
        int cur = __builtin_amdgcn_readfirstlane(*nxtw);
        __syncthreads();
        while (cur < NU_SWA) {
            pre = att_fetch(C, 1);
            const int qb = cur / 24, bh = cur % 24, b = bh / 12, h = bh % 12, kvh = h / 3;
            const bf16* base = C.QKV + (size_t)b * SEQ * QKVW;
            att::attn_unit<64, 1>(shm, base + C_SQ + h * 64, QKVW, base + C_SK + kvh * 64, base + C_SV + kvh * 64, QKVW, C.OALL + (size_t)b * SEQ * 2048 + 768 + h * 64, nullptr, C.swa_sinks[h] * LOG2E, qb);
            if (C.tid == 0) *nxtw = pre;
            __syncthreads();
            cur = __builtin_amdgcn_readfirstlane(*nxtw);
            __syncthreads();
        }
    }
    {
        int pre = att_fetch(C, 2);
        if (C.tid == 0) *nxtw = pre;
        __syncthreads();
        int cur = __builtin_amdgcn_readfirstlane(*nxtw);
        __syncthreads();
        while (cur < NU_XM) {
            pre = att_fetch(C, 2);
            const int qb = cur / 8, bh = cur % 8, b = bh / 4, h = bh % 4;
            const bf16* kb = C.MKV + (size_t)b * NMEM * 1024 + h * 128;
            att::attn_unit<128, 2>(shm, C.QKV + (size_t)b * SEQ * QKVW + C_MQ + h * 128, QKVW, kb, kb + 512, 1024, C.OALL + (size_t)b * SEQ * 2048 + 1536 + h * 128, nullptr, 0.f, qb);
            if (C.tid == 0) *nxtw = pre;
            __syncthreads();
            cur = __builtin_amdgcn_readfirstlane(*nxtw);
            __syncthreads();
        }
    }
}

__device__ __forceinline__ void phase6(const Ctx& C) {
    LAS float* PL = (LAS float*)(C.lds + RING_OFF);
    LAS float* SS = PL + 4 * 64 * 33;
    LAS int* hist = (LAS int*)(SS + 512);
    LAS int* gb = hist + 32;
    const int rg = C.wave & 1, kq = C.wave >> 1, r32 = C.lane & 31, hi = C.lane >> 5;
    const bf16* wh = C.Wr_t + (size_t)r32 * 2048 + 512 * kq + 16 * hi; const bf16* wl = wh + 32 * 2048;
    for (int blk = C.vcu; blk < T / 64; blk += C.G) {
        if (C.tid < 32) hist[C.tid] = 0;
        const int tok = blk * 64 + 32 * rg + r32;
        const float* hr = C.out + (size_t)tok * DM + 512 * kq + 16 * hi;
        f32x16 acc = f32x16{}; float ss = 0.f;
#pragma unroll 2
        for (int kb = 0; kb < 16; ++kb) {
            float f[16];
#pragma unroll
            for (int q = 0; q < 4; ++q) { const f32x4 t = *(const GAS f32x4*)(hr + 32 * kb + 4 * q); f[4 * q] = t.x; f[4 * q + 1] = t.y; f[4 * q + 2] = t.z; f[4 * q + 3] = t.w; }
            unsigned hb[16], lb[16];
#pragma unroll
            for (int q = 0; q < 16; ++q) { ss += f[q] * f[q]; hb[q] = f2bf(f[q]); lb[q] = f2bf(f[q] - __uint_as_float(hb[q] << 16)); }
#pragma unroll
            for (int s = 0; s < 2; ++s) {
                const bf16x8 ah = *(const GAS bf16x8*)(wh + 32 * kb + 8 * s), al = *(const GAS bf16x8*)(wl + 32 * kb + 8 * s);
                v4u bh, bl;
                bh.x = hb[8 * s] | (hb[8 * s + 1] << 16); bh.y = hb[8 * s + 2] | (hb[8 * s + 3] << 16); bh.z = hb[8 * s + 4] | (hb[8 * s + 5] << 16); bh.w = hb[8 * s + 6] | (hb[8 * s + 7] << 16);
                bl.x = lb[8 * s] | (lb[8 * s + 1] << 16); bl.y = lb[8 * s + 2] | (lb[8 * s + 3] << 16); bl.z = lb[8 * s + 4] | (lb[8 * s + 5] << 16); bl.w = lb[8 * s + 6] | (lb[8 * s + 7] << 16);
                acc = __builtin_amdgcn_mfma_f32_32x32x16_bf16(ah, __builtin_bit_cast(bf16x8, bh), acc, 0, 0, 0);
                acc = __builtin_amdgcn_mfma_f32_32x32x16_bf16(ah, __builtin_bit_cast(bf16x8, bl), acc, 0, 0, 0);
                acc = __builtin_amdgcn_mfma_f32_32x32x16_bf16(al, __builtin_bit_cast(bf16x8, bh), acc, 0, 0, 0);
            }
        }
        { LAS float* pr = PL + (size_t)(kq * 64 + 32 * rg + r32) * 33;
#pragma unroll
          for (int r = 0; r < 16; ++r) pr[att::crow(r, hi)] = acc[r];
          SS[(kq * 2 + hi) * 64 + 32 * rg + r32] = ss; }
        __syncthreads();
        int sel[4]; float gt[4]; float rstd = 0.f; int lr[4];
        if (C.tid < 64) {
            float lv[32]; float s2 = 0.f;
#pragma unroll
            for (int q = 0; q < 8; ++q) s2 += SS[q * 64 + C.tid];
            rstd = 1.0f / sqrtf(s2 * (1.f / DM) + NORM_EPS);
#pragma unroll
            for (int e = 0; e < 32; ++e) { const float a = (PL[(0 * 64 + C.tid) * 33 + e] + PL[(1 * 64 + C.tid) * 33 + e]) + (PL[(2 * 64 + C.tid) * 33 + e] + PL[(3 * 64 + C.tid) * 33 + e]); lv[e] = a * rstd + C.b_router[e]; }
            float val[4];
#pragma unroll
            for (int k = 0; k < 4; ++k) { float best = lv[0]; int bi = 0;
#pragma unroll
                for (int e = 1; e < 32; ++e) if (lv[e] > best) { best = lv[e]; bi = e; }
                sel[k] = bi; val[k] = best;
#pragma unroll
                for (int e = 0; e < 32; ++e) lv[e] = (e == bi) ? -INFINITY : lv[e]; }
            float den = 0.f;
#pragma unroll
            for (int k = 0; k < 4; ++k) { gt[k] = __expf(val[k] - val[0]); den += gt[k]; }
            const float inv = 1.0f / den;
#pragma unroll
            for (int k = 0; k < 4; ++k) { gt[k] *= inv; lr[k] = __hip_atomic_fetch_add((LAS int*)(hist + sel[k]), 1, __ATOMIC_RELAXED, __HIP_MEMORY_SCOPE_WORKGROUP); }
        }
        __syncthreads();
        if (C.tid < 32) gb[C.tid] = (int)__hip_atomic_fetch_add((unsigned*)(C.ctl + CW_CNT + C.tid), (unsigned)hist[C.tid], RLX_AGENT);
        __syncthreads();
        if (C.tid < 64) {
            const int t = blk * 64 + C.tid;
#pragma unroll
            for (int k = 0; k < 4; ++k) { const int sl = sel[k] * CAP + gb[sel[k]] + lr[k]; C.TOK[sl] = t; C.RS[sl] = rstd; C.TSLOT[t * 4 + k] = sl; C.TGATE[t * 4 + k] = gt[k]; }
        }
        __syncthreads();
    }
}
template <int NT>
__device__ __forceinline__ void moe_table(const Ctx& C, LAS int* tab) {
    __syncthreads();
    if (C.tid == 0) { int us = 0, rb = 0;
        for (int e = 0; e < 32; ++e) { const int n = (int)__hip_atomic_load((unsigned*)(C.ctl + CW_CNT + e), RLX_AGENT); const int mt = (n + 255) >> 8; tab[e] = us; tab[33 + e] = mt; tab[65 + e] = rb; us += mt * NT; rb += mt * 256; }
        tab[32] = us; }
    __syncthreads();
}


__device__ __forceinline__ void phase9(const Ctx& C, const LAS int* tab) {
    const int gw = C.vcu * NWAVES + C.wave, NGW = C.G * NWAVES;
    for (int t = gw; t < T; t += NGW) {
        typedef int v4i_ __attribute__((ext_vector_type(4))); const v4i_ sl = *(const GAS v4i_*)(C.TSLOT + 4 * t); const f32x4 g = *(const GAS f32x4*)(C.TGATE + 4 * t);
        const int s[4] = {sl.x, sl.y, sl.z, sl.w}; const float gg[4] = {g.x, g.y, g.z, g.w};
        const bf16* yr[4];
#pragma unroll
        for (int k = 0; k < 4; ++k) { const int e = s[k] >> 14, rk = s[k] & (CAP - 1); yr[k] = C.Y + (size_t)(tab[65 + e] + rk) * DM + 8 * C.lane; }
        float* orow = C.out + (size_t)t * DM + 8 * C.lane;
#pragma unroll
        for (int j = 0; j < 4; ++j) {
            f32x4 a0 = *(const GAS f32x4*)(orow + 512 * j), a1 = *(const GAS f32x4*)(orow + 512 * j + 4);
#pragma unroll
            for (int k = 0; k < 4; ++k) { const v4u y = *(const GAS v4u*)(yr[k] + 512 * j);
                a0.x += gg[k] * pg8::bf_lo(y.x); a0.y += gg[k] * pg8::bf_hi(y.x); a0.z += gg[k] * pg8::bf_lo(y.y); a0.w += gg[k] * pg8::bf_hi(y.y);
                a1.x += gg[k] * pg8::bf_lo(y.z); a1.y += gg[k] * pg8::bf_hi(y.z); a1.z += gg[k] * pg8::bf_lo(y.w); a1.w += gg[k] * pg8::bf_hi(y.w); }
            *(GAS f32x4*)(orow + 512 * j) = a0; *(GAS f32x4*)(orow + 512 * j + 4) = a1;
        }
    }
}

struct Args { const void* in[26]; float* out; unsigned char* ws; int ph_lo, ph_hi; };
__global__ void __launch_bounds__(NWAVES * 64, 2) mk_fwd(Args args) {
    extern __shared__ __attribute__((aligned(16))) unsigned char lds_raw[];
    Ctx C;
    C.lds = (LAS unsigned char*)lds_raw;
    C.MISC = (volatile LAS unsigned*)(C.lds + MISC_OFF);
    C.tid = threadIdx.x; C.lane = C.tid & 63; C.wave = __builtin_amdgcn_readfirstlane(C.tid >> 6);
    C.G = gridDim.x; { const int bx = blockIdx.x; C.vcu = (C.G % 8 == 0) ? (bx % 8) * (C.G / 8) + bx / 8 : bx; }
    unsigned char* ws = args.ws;
    C.ctl = (gu32*)(ws + WS_CTL);
    C.x = (const float*)args.in[0]; C.mem = (const float*)args.in[1]; C.pos = (const int*)args.in[2]; C.norm_mix = (const float*)args.in[3]; C.w_in = (const float*)args.in[4];
    C.b_forget = (const float*)args.in[5]; C.fox_q_norm = (const float*)args.in[6]; C.fox_k_norm = (const float*)args.in[7]; C.swa_q_norm = (const float*)args.in[8]; C.swa_k_norm = (const float*)args.in[9];
    C.swa_sinks = (const float*)args.in[10]; C.xmem_q_norm = (const float*)args.in[11]; C.xmem_k_norm = (const float*)args.in[12]; C.norm_mem = (const float*)args.in[13]; C.w_mem_kv = (const float*)args.in[14];
    C.w_up_fox = (const float*)args.in[15]; C.w_up_swa = (const float*)args.in[16]; C.w_up_xmem = (const float*)args.in[17]; C.w_out = (const float*)args.in[18]; C.norm_ffn = (const float*)args.in[19];
    C.w_router = (const float*)args.in[20]; C.b_router = (const float*)args.in[21]; C.w_gate_up = (const float*)args.in[22]; C.b_gate_up = (const float*)args.in[23]; C.w_down = (const float*)args.in[24]; C.b_down = (const float*)args.in[25];
    C.out = args.out;
    C.Win_t = (bf16*)(ws + WS_WIN); C.Wmkv_t = (bf16*)(ws + WS_WMKV); C.Wup_t = (bf16*)(ws + WS_WUP); C.Wout_t = (bf16*)(ws + WS_WOUT); C.Wr_t = (bf16*)(ws + WS_WRT); C.Wgu_t = (bf16*)(ws + WS_WGU); C.Wd_t = (bf16*)(ws + WS_WD);
    C.XN = (bf16*)(ws + WS_XN); C.MN = (bf16*)(ws + WS_MN); C.QKV = (bf16*)(ws + WS_QKV); C.G_ = (bf16*)(ws + WS_G); C.MKV = (bf16*)(ws + WS_MKV); C.OALL = (bf16*)(ws + WS_OALL); C.MERGED = (bf16*)(ws + WS_MERGED);
    C.HB = (bf16*)(ws + WS_HB); C.ACT = (bf16*)(ws + WS_ACT); C.LOGF = (float*)(ws + WS_LOGF); C.CNEG = (float*)(ws + WS_CNEG); C.ROPE = (float*)(ws + WS_ROPE); C.GATEW = (float*)(ws + WS_GATE); C.RS = (float*)(ws + WS_RS);
    C.TOK = (int*)(ws + WS_TOK); C.TSLOT = (int*)(ws + WS_TSLOT); C.TGATE = (float*)(ws + WS_TGATE); C.Y = (bf16*)(ws + WS_Y);
    for (int u = C.tid; u < (LDS_BYTES - LDSCTL_OFF) / 4; u += NWAVES * 64) ((LAS unsigned*)(C.lds + LDSCTL_OFF))[u] = 0u;
    __syncthreads();
    XcdBarrier bar; bar.bar = (unsigned*)(C.ctl + CW_BAR); bar.x = 0; bar.st = nullptr;
    if (N_LAUNCHES == 1) bar = xcd_barrier_post((unsigned*)(C.ctl + CW_BAR), C.MISC + 8);
    const int lo = args.ph_lo, hi = args.ph_hi;
#ifndef MK_PHASE_MASK
#define MK_PHASE_MASK 0x3FF
#endif
#define IN(k) ((((MK_PHASE_MASK) >> (k)) & 1) && lo <= (k) && (k) < hi)
#define SEAM(k) do { if (IN(k) && IN((k) + 1)) xcd_barrier(bar); } while (0)
    LAS int* tab = (LAS int*)(C.lds + MOE_OFF);

    if (IN(0)) { phase0(C); }
    SEAM(0);
    if (IN(1)) {
        P1Order S; S.d.init(C.XN, C.Win_t, T, 10240, C.G, (int)blockIdx.x); S.A1 = (const char*)C.MN; S.B1 = (const char*)C.Wmkv_t;
        EpiInProj E{C.QKV, C.G_, C.MKV};
        pg8::gemm_phase<EpiInProj, P1Order>(C.lds + RING_OFF, S, E);
    }
    SEAM(1);
    if (IN(2)) { phase2(C); }
    SEAM(2);
    if (IN(3)) { phase3(C); }
    SEAM(3);
    if (IN(4)) {
        DenseOrder S; S.init(C.OALL, C.Wup_t, T, DM, C.G, (int)blockIdx.x);
        EpiMerge E{C.G_, C.MERGED};
        pg8::gemm_phase<EpiMerge, DenseOrder>(C.lds + RING_OFF, S, E);
    }
    SEAM(4);
    if (IN(5)) {
        DenseOrder S; S.init(C.MERGED, C.Wout_t, T, DM, C.G, (int)blockIdx.x);
        EpiOut E{C.x, C.out, C.HB};
        pg8::gemm_phase<EpiOut, DenseOrder>(C.lds + RING_OFF, S, E);
    }
    SEAM(5);
    if (IN(6)) { phase6(C); }
    SEAM(6);
    if (IN(7)) {
        moe_table<16>(C, tab);
        MoeOrder<true, 16> S{(const char*)C.HB, (const char*)C.Wgu_t, C.TOK, (const int*)(C.ctl + CW_CNT), tab, C.G, C.vcu};
        EpiGateUp E{C.RS, C.b_gate_up, C.ACT};
        pg8::gemm_phase<EpiGateUp, MoeOrder<true, 16>>(C.lds + RING_OFF, S, E);
    }
    SEAM(7);
    if (IN(8)) {
        moe_table<8>(C, tab);
        MoeOrder<false, 8> S{(const char*)C.ACT, (const char*)C.Wd_t, C.TOK, (const int*)(C.ctl + CW_CNT), tab, C.G, C.vcu};
        EpiDown E{C.b_down, C.Y};
        pg8::gemm_phase<EpiDown, MoeOrder<false, 8>>(C.lds + RING_OFF, S, E);
    }
    SEAM(8);
    if (IN(9)) { moe_table<8>(C, tab); phase9(C, tab); }
#undef IN
#undef SEAM
}

extern "C" void kernel_launch(void* const* d_in, const int* in_sizes, int n_in, void* d_out, int out_size, void* d_ws, size_t ws_size, hipStream_t stream) {
    static int grid = 0;
    if (grid == 0) {
        if (n_in != 26 || out_size != T * DM || ws_size < WS_END) { fprintf(stderr, "kernel_launch: unexpected problem (n_in %d, out %d, ws %zu < %zu); nothing launched\n", n_in, out_size, ws_size, (size_t)WS_END); grid = -1; return; }
        int dev = 0, cus = 0, per_cu = 0;
        if (hipGetDevice(&dev) != hipSuccess || hipDeviceGetAttribute(&cus, hipDeviceAttributeMultiprocessorCount, dev) != hipSuccess) { grid = -1; return; }
        if (hipFuncSetAttribute((const void*)mk_fwd, hipFuncAttributeMaxDynamicSharedMemorySize, LDS_BYTES) != hipSuccess) { fprintf(stderr, "kernel_launch: hipFuncSetAttribute failed\n"); grid = -1; return; }
        if (hipOccupancyMaxActiveBlocksPerMultiprocessor(&per_cu, (const void*)mk_fwd, NWAVES * 64, LDS_BYTES) != hipSuccess || per_cu < 1) { fprintf(stderr, "kernel_launch: occupancy query says %d\n", per_cu); }
        (void)hipGetLastError();
        grid = cus;
    }
    if (grid < 0) return;
    if (hipMemsetAsync((char*)d_ws + WS_CTL, 0, CTL_ZERO_BYTES, stream) != hipSuccess) return;
    Args a{};
    for (int i = 0; i < 26; ++i) a.in[i] = d_in[i];
    a.out = (float*)d_out; a.ws = (unsigned char*)d_ws;
    if (N_LAUNCHES == 1) { a.ph_lo = 0; a.ph_hi = PER_PHASE; hipLaunchKernelGGL(mk_fwd, dim3(grid), dim3(NWAVES * 64), LDS_BYTES, stream, a); }
    else for (int li = 0; li < PER_PHASE; ++li) { a.ph_lo = li; a.ph_hi = li + 1; hipLaunchKernelGGL(mk_fwd, dim3(grid), dim3(NWAVES * 64), LDS_BYTES, stream, a);
#ifdef PROBE_DUP
        if (li == PROBE_DUP) { if (PROBE_DUP == 3 || PROBE_DUP == 6) hipMemsetAsync((char*)d_ws + WS_CTL, 0, CTL_ZERO_BYTES / 2, stream); hipLaunchKernelGGL(mk_fwd, dim3(grid), dim3(NWAVES * 64), LDS_BYTES, stream, a); }
#endif
    }
    const hipError_t le = hipPeekAtLastError();
    if (le != hipSuccess) fprintf(stderr, "kernel_launch: launch failed: %s\n", hipGetErrorName(le));
}
```

```cpp
#include <hip/hip_runtime.h>
#include <cstdio>
#include <cstdint>

#define LAS __attribute__((address_space(3)))
#define GAS __attribute__((address_space(1)))

namespace pg8 {
typedef unsigned short bf16_t;
typedef short bf16x8 __attribute__((ext_vector_type(8)));
typedef float f32x4 __attribute__((ext_vector_type(4)));
typedef float f32x2 __attribute__((ext_vector_type(2)));
typedef unsigned u32x4 __attribute__((ext_vector_type(4)));
typedef unsigned u32x2 __attribute__((ext_vector_type(2)));
constexpr int BM = 256, BK = 64, HALF = 128, HTB = HALF * BK * 2, STAGE_BYTES = 8 * HTB, NXCD = 8, WGM = 8;
constexpr int KD = 2048;
typedef int v8i __attribute__((ext_vector_type(8))); typedef int v4i __attribute__((ext_vector_type(4)));
__device__ __forceinline__ v8i cat8(bf16x8 lo, bf16x8 hi) { const v4i a = __builtin_bit_cast(v4i, lo), b = __builtin_bit_cast(v4i, hi); return __builtin_shufflevector(a, b, 0, 1, 2, 3, 4, 5, 6, 7); }
__device__ __forceinline__ bf16x8 lo8(v8i v) { return __builtin_bit_cast(bf16x8, (v4i)__builtin_shufflevector(v, v, 0, 1, 2, 3)); }
__device__ __forceinline__ bf16x8 hi8(v8i v) { return __builtin_bit_cast(bf16x8, (v4i)__builtin_shufflevector(v, v, 4, 5, 6, 7)); }

__host__ __device__ __forceinline__ int lds_byte(int r, int c) { const int st = (r >> 4) * 2 + (c >> 5), rr = r & 15, cc = c & 31, ob = rr * 64 + cc * 2; return st * 1024 + (ob ^ (((ob >> 9) & 1) << 5)); }
__host__ __device__ __forceinline__ void stage_rc(int b, int& R, int& C) { const int st = b / 1024, sb = b % 1024, swz = sb ^ (((sb >> 9) & 1) << 5); R = (st >> 1) * 16 + swz / 64; C = (st & 1) * 32 + (swz % 64) / 2; }
__host__ __device__ __forceinline__ int perm32(int rho) { const int n = rho >> 4, i = rho & 15; return 8 * (i >> 2) + 4 * n + (i & 3); }

__device__ __forceinline__ void glds_s(const char* sbase, unsigned voff, unsigned lds_dst) { unsigned keep;
    asm volatile("s_mov_b32 %0, m0\n\ts_mov_b32 m0, %3\n\ts_nop 0\n\tglobal_load_lds_dwordx4 %1, %2\n\ts_mov_b32 m0, %0" : "=&s"(keep) : "v"(voff), "s"(sbase), "s"(lds_dst) : "memory"); }

struct Unit { int pm, pn, e, kind; };

__device__ __forceinline__ unsigned cvt_pk_bf16(float lo, float hi) { unsigned r; asm volatile("v_cvt_pk_bf16_f32 %0, %1, %2" : "=v"(r) : "v"(lo), "v"(hi)); return r; }
__device__ __forceinline__ float bf_lo(unsigned w) { return __uint_as_float(w << 16); }
__device__ __forceinline__ float bf_hi(unsigned w) { return __uint_as_float(w & 0xffff0000u); }

template <class Epi, class Sched, bool ALIGN_EPI = true, bool SP2 = true>
__device__ __forceinline__ void gemm_phase(LAS unsigned char* lds, const Sched& S, const Epi& E) {
    const int tid = threadIdx.x, wid = __builtin_amdgcn_readfirstlane(tid >> 6), lane = tid & 63, wr = wid >> 2, wc = wid & 3, fr = lane & 15, fq = lane >> 4;
    constexpr bool FP8 = Epi::FP8; constexpr int RB = FP8 ? 2048 : 4096, nt = RB / 128;
    unsigned voffB[2]; int RA[2], CA[2];
#pragma unroll
    for (int i = 0; i < 2; ++i) { int R, C; stage_rc(tid * 16 + i * 8192, R, C); const int Rb = Epi::PERM ? ((R & ~31) + perm32(R & 31)) : R;
        voffB[i] = (unsigned)(Rb * RB + C * 2); RA[i] = R; CA[i] = C; }
    constexpr size_t kstep = (size_t)(BK * 2);
    constexpr size_t hstep = (size_t)HALF * RB;
    const unsigned ldsbase = (unsigned)__builtin_amdgcn_readfirstlane((unsigned)(uintptr_t)lds + (unsigned)wid * 1024u);
    const int aoff = lds_byte(wr * 64 + fr, fq * 8), boff = lds_byte(wc * 32 + fr, fq * 8);
#define PG8_SA(b, h) (((b) * 2 + (h)) * HTB)
#define PG8_SB(b, h) ((4 + (b) * 2 + (h)) * HTB)
#define PG8_STAGE(bufoff, gbase, voff) do { _Pragma("unroll") for (int _i = 0; _i < 2; ++_i) \
        glds_s((const char*)(gbase), (voff)[_i], ldsbase + (unsigned)((bufoff) + _i * 8192)); } while (0)
#define PG8_LDA(dst, b, h) do { _Pragma("unroll") for (int m = 0; m < 4; ++m) dst[m] = cat8(*(const LAS bf16x8*)(lds + PG8_SA(b, h) + aoff + m * 2048), *(const LAS bf16x8*)(lds + PG8_SA(b, h) + aoff + m * 2048 + 1024)); } while (0)
#define PG8_LDB(dst, b, h) do { _Pragma("unroll") for (int n = 0; n < 2; ++n) dst[n] = cat8(*(const LAS bf16x8*)(lds + PG8_SB(b, h) + boff + n * 2048), *(const LAS bf16x8*)(lds + PG8_SB(b, h) + boff + n * 2048 + 1024)); } while (0)
#define PG8_MMA(ai, bj, At, Bt) do { __builtin_amdgcn_s_setprio(1); _Pragma("unroll") for (int m = 0; m < 4; ++m) _Pragma("unroll") for (int n = 0; n < 2; ++n) { \
        if constexpr (FP8) asm volatile("v_mfma_scale_f32_16x16x128_f8f6f4 %0, %1, %2, %0, %3, %4 op_sel_hi:[0,0,0]" : "+v"(acc[ai][bj][m][n]) : "v"(Bt[n]), "v"(At[m]), "v"(scl_b), "v"(scl_a)); \
        else { acc[ai][bj][m][n] = __builtin_amdgcn_mfma_f32_16x16x32_bf16(lo8(Bt[n]), lo8(At[m]), acc[ai][bj][m][n], 0, 0, 0); \
               acc[ai][bj][m][n] = __builtin_amdgcn_mfma_f32_16x16x32_bf16(hi8(Bt[n]), hi8(At[m]), acc[ai][bj][m][n], 0, 0, 0); } } \
        __builtin_amdgcn_s_setprio(0); } while (0)
#define PG8_WAIT_V(n) asm volatile("s_waitcnt vmcnt(" #n ")" ::: "memory")
#define PG8_WAIT_L(n) asm volatile("s_waitcnt lgkmcnt(" #n ")" ::: "memory")
#define PG8_BAR __builtin_amdgcn_s_barrier()
#define PG8_SCHED __builtin_amdgcn_sched_barrier(0)
    Unit cur, nxt; int ui = 0;
    int scl_a = Epi::SCALE_A, scl_b = Epi::SCALE_B; asm volatile("" : "+v"(scl_a), "+v"(scl_b));
    if (!S.next(0, cur)) return;
    f32x4 acc[2][2][4][2];
#pragma unroll
    for (int a = 0; a < 2; ++a)
#pragma unroll
        for (int b = 0; b < 2; ++b)
#pragma unroll
            for (int m = 0; m < 4; ++m)
#pragma unroll
                for (int n = 0; n < 2; ++n) acc[a][b][m][n] = (f32x4){0.f, 0.f, 0.f, 0.f};
    v8i At[4], B0[2], B1[2];
    const char* cA = S.a_base(cur); const char* cB = S.b_base(cur);
    unsigned vo[2][2], nvo[2][2];
    S.a_offs(cur, RA, CA, vo);
    bool has_next = S.next(1, nxt);
    if (has_next) S.a_offs(nxt, RA, CA, nvo); else { nvo[0][0] = vo[0][0]; nvo[0][1] = vo[0][1]; nvo[1][0] = vo[1][0]; nvo[1][1] = vo[1][1]; }
    if constexpr (SP2) {
        PG8_STAGE(PG8_SB(0, 0), cB, voffB); PG8_STAGE(PG8_SB(0, 1), cB + hstep, voffB); PG8_STAGE(PG8_SA(0, 0), cA, vo[0]); PG8_STAGE(PG8_SA(0, 1), cA, vo[1]);
        if (wr == 1) PG8_BAR;
        PG8_WAIT_V(2); PG8_BAR;
        PG8_STAGE(PG8_SB(1, 0), cB + kstep, voffB); PG8_STAGE(PG8_SA(1, 0), cA + kstep, vo[0]); PG8_STAGE(PG8_SB(1, 1), cB + hstep + kstep, voffB);
        PG8_WAIT_V(6); PG8_BAR;
    } else {
        PG8_STAGE(PG8_SB(0, 0), cB, voffB); PG8_STAGE(PG8_SA(0, 0), cA, vo[0]); PG8_STAGE(PG8_SB(0, 1), cB + hstep, voffB); PG8_STAGE(PG8_SA(0, 1), cA, vo[1]);
        if (wr == 1) PG8_BAR;
        PG8_WAIT_V(4); PG8_BAR;
        PG8_STAGE(PG8_SB(1, 0), cB + kstep, voffB); PG8_STAGE(PG8_SA(1, 0), cA + kstep, vo[0]); PG8_STAGE(PG8_SB(1, 1), cB + hstep + kstep, voffB);
        PG8_WAIT_V(6); PG8_BAR;
    }
    for (;;) {
        const char* nA = has_next ? S.a_base(nxt) : cA; const char* nB = has_next ? S.b_base(nxt) : cB;
        for (int t = 0; t < nt; t += 2) {
            const bool last = (t == nt - 2);
            const char* a1 = cA + (size_t)(t + 1) * kstep;
            const char* a2 = last ? nA : cA + (size_t)(t + 2) * kstep; const char* b2 = last ? nB : cB + (size_t)(t + 2) * kstep;
            const char* a3 = a2 + kstep; const char* b3 = b2 + kstep;
            unsigned v2[2][2];
            v2[0][0] = last ? nvo[0][0] : vo[0][0]; v2[0][1] = last ? nvo[0][1] : vo[0][1]; v2[1][0] = last ? nvo[1][0] : vo[1][0]; v2[1][1] = last ? nvo[1][1] : vo[1][1];
            if constexpr (SP2) {
            PG8_LDB(B0, 0, 0); PG8_LDB(B1, 0, 1); PG8_SCHED; PG8_LDA(At, 0, 0); PG8_STAGE(PG8_SA(1, 1), a1, vo[1]);
            PG8_WAIT_V(8); PG8_WAIT_L(0); PG8_BAR; PG8_MMA(0, 0, At, B0); PG8_MMA(0, 1, At, B1); PG8_BAR; PG8_SCHED;
            PG8_LDA(At, 0, 1); PG8_STAGE(PG8_SB(0, 0), b2, voffB); PG8_STAGE(PG8_SB(0, 1), b2 + hstep, voffB); PG8_STAGE(PG8_SA(0, 0), a2, v2[0]);
            PG8_WAIT_V(8); PG8_WAIT_L(0); PG8_BAR; PG8_MMA(1, 0, At, B0); PG8_MMA(1, 1, At, B1); PG8_BAR; PG8_SCHED;
            PG8_LDB(B0, 1, 0); PG8_LDB(B1, 1, 1); PG8_SCHED; PG8_LDA(At, 1, 0); PG8_STAGE(PG8_SA(0, 1), a2, v2[1]);
            PG8_WAIT_V(8); PG8_WAIT_L(0); PG8_BAR; PG8_MMA(0, 0, At, B0); PG8_MMA(0, 1, At, B1); PG8_BAR; PG8_SCHED;
            PG8_LDA(At, 1, 1); PG8_STAGE(PG8_SB(1, 0), b3, voffB); PG8_STAGE(PG8_SB(1, 1), b3 + hstep, voffB); PG8_STAGE(PG8_SA(1, 0), a3, v2[0]);
            PG8_WAIT_V(8); PG8_WAIT_L(0); PG8_BAR; PG8_MMA(1, 0, At, B0); PG8_MMA(1, 1, At, B1); PG8_BAR; PG8_SCHED;
            } else {
            PG8_LDB(B0, 0, 0); PG8_SCHED; PG8_LDA(At, 0, 0); PG8_STAGE(PG8_SA(1, 1), a1, vo[1]);
            PG8_WAIT_L(8); PG8_BAR; PG8_WAIT_L(0); PG8_MMA(0, 0, At, B0); PG8_BAR; PG8_SCHED;
            PG8_LDB(B1, 0, 1); PG8_STAGE(PG8_SB(0, 0), b2, voffB);
            PG8_BAR; PG8_WAIT_L(0); PG8_MMA(0, 1, At, B1); PG8_BAR;
            PG8_LDA(At, 0, 1); PG8_STAGE(PG8_SA(0, 0), a2, v2[0]);
            PG8_BAR; PG8_WAIT_L(0); PG8_MMA(1, 0, At, B0); PG8_BAR; PG8_SCHED;
            PG8_STAGE(PG8_SB(0, 1), b2 + hstep, voffB);
            PG8_WAIT_V(6); PG8_BAR; PG8_MMA(1, 1, At, B1); PG8_BAR;
            PG8_LDB(B0, 1, 0); PG8_SCHED; PG8_LDA(At, 1, 0); PG8_STAGE(PG8_SA(0, 1), a2, v2[1]);
            PG8_WAIT_L(8); PG8_BAR; PG8_WAIT_L(0); PG8_MMA(0, 0, At, B0); PG8_BAR; PG8_SCHED;
            PG8_LDB(B1, 1, 1); PG8_STAGE(PG8_SB(1, 0), b3, voffB);
            PG8_BAR; PG8_WAIT_L(0); PG8_MMA(0, 1, At, B1); PG8_BAR;
            PG8_LDA(At, 1, 1); PG8_STAGE(PG8_SA(1, 0), a3, v2[0]);
            PG8_BAR; PG8_WAIT_L(0); PG8_MMA(1, 0, At, B0); PG8_BAR; PG8_SCHED;
            PG8_STAGE(PG8_SB(1, 1), b3 + hstep, voffB);
            PG8_WAIT_V(6); PG8_BAR; PG8_MMA(1, 1, At, B1); PG8_BAR;
            }
            if constexpr (Epi::MID) { if (t == 10 || t == 22) E.mid(acc, cur, t == 22 ? 1 : 0, wr, wc, fr, fq); }
        }
        Unit nn; const bool has_nn = has_next && S.next(ui + 2, nn); unsigned nnvo[2][2];
        if (has_nn) S.a_offs(nn, RA, CA, nnvo); else { nnvo[0][0] = nvo[0][0]; nnvo[0][1] = nvo[0][1]; nnvo[1][0] = nvo[1][0]; nnvo[1][1] = nvo[1][1]; }
        if constexpr (ALIGN_EPI) { if (wr == 0) PG8_BAR; }
        if constexpr (FP8) asm volatile("s_nop 15\n\ts_nop 7" ::: "memory");
        E(acc, cur, wr, wc, fr, fq);
        if (!has_next) break;
#pragma unroll
        for (int a = 0; a < 2; ++a)
#pragma unroll
            for (int b = 0; b < 2; ++b)
#pragma unroll
                for (int m = 0; m < 4; ++m)
#pragma unroll
                    for (int n = 0; n < 2; ++n) acc[a][b][m][n] = (f32x4){0.f, 0.f, 0.f, 0.f};
        cur = nxt; cA = nA; cB = nB; ++ui; nxt = nn; has_next = has_nn;
        vo[0][0] = nvo[0][0]; vo[0][1] = nvo[0][1]; vo[1][0] = nvo[1][0]; vo[1][1] = nvo[1][1];
        nvo[0][0] = nnvo[0][0]; nvo[0][1] = nnvo[0][1]; nvo[1][0] = nnvo[1][0]; nvo[1][1] = nnvo[1][1];
        if constexpr (ALIGN_EPI) { if (wr == 1) PG8_BAR; }
    }
    PG8_WAIT_V(0);
    if constexpr (!ALIGN_EPI) { if (wr == 0) PG8_BAR; }
    PG8_BAR;
#undef PG8_SA
#undef PG8_SB
#undef PG8_STAGE
#undef PG8_LDA
#undef PG8_LDB
#undef PG8_MMA
#undef PG8_WAIT_V
#undef PG8_WAIT_L
#undef PG8_BAR
#undef PG8_SCHED
}
}

constexpr int NWAVES = 8;
constexpr int BATCH = 2, SEQ = 8192, DM = 2048, T = BATCH * SEQ;
constexpr int NMEM = 256, MROWS = BATCH * NMEM;
constexpr int INW = 10252;
constexpr int NEXP = 32, TOPK = 4, CAP = T;
constexpr int QKVW = 4096;
constexpr int C_FQ = 0, C_FK = 768, C_FV = 1536, C_SQ = 2304, C_SK = 3072, C_SV = 3328, C_MQ = 3584;
constexpr int GW = 6144;
constexpr float NORM_EPS = 1e-6f;
constexpr float LOG2E = 1.4426950408889634f;
constexpr float SWIGLU_LIMIT = 7.0f, SWIGLU_ALPHA = 1.702f;
constexpr int PER_PHASE = 10;
#ifndef MK_N_LAUNCHES
#define MK_N_LAUNCHES 1
#endif
constexpr int N_LAUNCHES = MK_N_LAUNCHES;

constexpr size_t MiB = 1u << 20;
constexpr size_t WS_CTL = 0, CTL_ZERO_BYTES = 1 * MiB;
constexpr size_t WS_WIN   = 2 * MiB;
constexpr size_t WS_WMKV  = WS_WIN + 40 * MiB;
constexpr size_t WS_WUP   = WS_WMKV + 4 * MiB;
constexpr size_t WS_WOUT  = WS_WUP + 8 * MiB;
constexpr size_t WS_WRT   = WS_WOUT + 8 * MiB;
constexpr size_t WS_WGU   = WS_WRT + 1 * MiB;
constexpr size_t WS_WD    = WS_WGU + 512 * MiB;
constexpr size_t WS_XN    = WS_WD + 256 * MiB;
constexpr size_t WS_MN    = WS_XN + 64 * MiB;
constexpr size_t WS_LOGF  = WS_MN + 2 * MiB;
constexpr size_t WS_CNEG  = WS_LOGF + 1 * MiB;
constexpr size_t WS_ROPE  = WS_CNEG + 1 * MiB;
constexpr size_t WS_QKV   = WS_ROPE + 4 * MiB;
constexpr size_t WS_G     = WS_QKV + 128 * MiB;
constexpr size_t WS_MKV   = WS_G + 192 * MiB;
constexpr size_t WS_OALL  = WS_MKV + 1 * MiB;
constexpr size_t WS_MERGED= WS_OALL + 64 * MiB;
constexpr size_t WS_HB    = WS_MERGED + 64 * MiB;
constexpr size_t WS_TOK   = WS_HB + 64 * MiB;
constexpr size_t WS_GATE  = WS_TOK + 2 * MiB;
constexpr size_t WS_RS    = WS_GATE + 2 * MiB;
constexpr size_t WS_ACT   = WS_RS + 2 * MiB;
constexpr size_t WS_Y     = WS_ACT + 288 * MiB;
constexpr size_t WS_TSLOT = WS_Y + 288 * MiB;
constexpr size_t WS_TGATE = WS_TSLOT + 1 * MiB;
constexpr size_t WS_END   = WS_TGATE + 1 * MiB;
constexpr int CW_BAR = 4096;
constexpr int CW_QHEAD = 64;
constexpr int CW_CNT = 512;

typedef unsigned short bf16;
typedef unsigned v4u __attribute__((ext_vector_type(4)));
typedef unsigned v2u __attribute__((ext_vector_type(2)));
typedef float f32x4 __attribute__((ext_vector_type(4)));
typedef float f32x16 __attribute__((ext_vector_type(16)));
typedef short bf16x8 __attribute__((ext_vector_type(8)));
typedef short s16x4 __attribute__((ext_vector_type(4)));
typedef GAS unsigned gu32;
#define RLX_AGENT __ATOMIC_RELAXED, __HIP_MEMORY_SCOPE_AGENT
#define LDS_WAIT() asm volatile("s_waitcnt lgkmcnt(0)" ::: "memory")
#define VM_WAIT() asm volatile("s_waitcnt vmcnt(0)" ::: "memory")
__device__ __forceinline__ unsigned f2bf(float f) { unsigned u = __builtin_bit_cast(unsigned, f); return (u + 0x7fffu + ((u >> 16) & 1u)) >> 16; }
__device__ __forceinline__ unsigned pk2(float lo, float hi) { return f2bf(lo) | (f2bf(hi) << 16); }
__device__ __forceinline__ float bf2f(unsigned short b) { return __uint_as_float(((unsigned)b) << 16); }
__device__ __forceinline__ float wave_sum(float v) {
#pragma unroll
    for (int o = 1; o < 64; o <<= 1) v += __shfl_xor(v, o);
    return v;
}
__device__ __forceinline__ float sigmoidf_(float x) { return 1.0f / (1.0f + __expf(-x)); }

constexpr int H8_SHIFT = 4, ACT8_SHIFT = 2, W8_SHIFT = 9;
constexpr float H8_MUL = 16.0f, ACT8_MUL = 4.0f, W8_MUL = 512.0f;
__device__ __forceinline__ float clamp_fp8(float v) { return __builtin_amdgcn_fmed3f(v, -448.0f, 448.0f); }
__device__ __forceinline__ unsigned pk4_fp8(float a, float b, float c, float d) {
    int p = __builtin_amdgcn_cvt_pk_fp8_f32(clamp_fp8(a), clamp_fp8(b), 0, false); p = __builtin_amdgcn_cvt_pk_fp8_f32(clamp_fp8(c), clamp_fp8(d), p, true); return (unsigned)p; }
using pg8::f32x2; using pg8::u32x4; using pg8::u32x2; using pg8::cvt_pk_bf16; using pg8::bf_lo; using pg8::bf_hi;

#define XB_TMO      128
#define XB_XCNT(j)  (256  + 64 * (j))
#define XB_XSUB(j)  (1280 + 64 * (j))
#define XB_XGEN(j)  (2304 + 64 * (j))
#define XB_TOP      3328
#define XB_TOPGEN   3392
#define XCD_BAR_WORDS 3456
#define XB_SPIN_CAP (1u << 18)

__device__ __forceinline__ unsigned xb_ld(unsigned* p)              { return __hip_atomic_load(p, __ATOMIC_RELAXED, __HIP_MEMORY_SCOPE_AGENT); }
__device__ __forceinline__ unsigned xb_add(unsigned* p, unsigned v) { return __hip_atomic_fetch_add(p, v, __ATOMIC_RELAXED, __HIP_MEMORY_SCOPE_AGENT); }
__device__ __forceinline__ unsigned xb_xcc_id() { return (unsigned)__builtin_amdgcn_s_getreg((3 << 11) | 20) & 0xFu; }
#define XB_SPIN(cond, bar) do { unsigned _sp = 0; while (cond) { __builtin_amdgcn_s_sleep(1); \
    if ((++_sp & 255u) == 0u) { if (xb_ld(&(bar)[XB_TMO])) break; if (_sp > XB_SPIN_CAP) { atomicAdd(&(bar)[XB_TMO], 1u); break; } } } } while (0)

struct XcdBarrier { unsigned* bar; unsigned x; volatile LAS unsigned* st; };

__device__ __forceinline__ XcdBarrier xcd_barrier_post(unsigned* bar, volatile LAS unsigned* st) {
    XcdBarrier b; b.bar = bar; b.x = xb_xcc_id(); b.st = st;
    if (threadIdx.x == 0) (void)xb_add(&bar[XB_XCNT(b.x)], 1u);
    return b;
}
__device__ __forceinline__ void xcd_barrier_complete(unsigned* bar, unsigned x, unsigned& nloc, unsigned& nx) {
    const unsigned G = gridDim.x * gridDim.y * gridDim.z;
    unsigned sum, cnt, mine, sp = 0u;
    for (;;) {
        sum = 0u; cnt = 0u; mine = 0u;
#pragma unroll
        for (unsigned j = 0; j < 16; ++j) { const unsigned c = xb_ld(&bar[XB_XCNT(j)]); sum += c; cnt += (c > 0u) ? 1u : 0u; mine = (j == x) ? c : mine; }
        if (sum == G) break;
        __builtin_amdgcn_s_sleep(1);
        if ((++sp & 255u) == 0u) { if (xb_ld(&bar[XB_TMO])) break; if (sp > XB_SPIN_CAP) { atomicAdd(&bar[XB_TMO], 1u); break; } }
    }
    nloc = mine > 0u ? mine : 1u; nx = cnt > 0u ? cnt : 1u;
}
__device__ __forceinline__ void xcd_barrier(const XcdBarrier& b) {
    asm volatile("s_waitcnt vmcnt(0)" ::: "memory");
    __syncthreads();
    if (threadIdx.x == 0) {
        unsigned* bar = b.bar;
        __builtin_amdgcn_s_waitcnt(0);
        unsigned nloc = b.st[0], nx = b.st[1];
        if (nloc == 0u) { xcd_barrier_complete(bar, b.x, nloc, nx); b.st[0] = nloc; b.st[1] = nx; }
        const unsigned old = xb_add(&bar[XB_XSUB(b.x)], 1u);
        const unsigned gen = old / nloc;
        if (old + 1u == (gen + 1u) * nloc) {
            __builtin_amdgcn_fence(__ATOMIC_RELEASE, "agent");
            asm volatile("s_waitcnt vmcnt(0)" ::: "memory");
            const unsigned og = xb_add(&bar[XB_TOP], 1u);
            const unsigned tg = og / nx;
            if (og + 1u == (tg + 1u) * nx) xb_add(&bar[XB_TOPGEN], 1u);
            else XB_SPIN(xb_ld(&bar[XB_TOPGEN]) == tg, bar);
            __builtin_amdgcn_fence(__ATOMIC_ACQUIRE, "agent");
            xb_add(&bar[XB_XGEN(b.x)], 1u);
            asm volatile("s_waitcnt vmcnt(0)" ::: "memory");
        } else {
            XB_SPIN(xb_ld(&bar[XB_XGEN(b.x)]) == gen, bar);
            __builtin_amdgcn_fence(__ATOMIC_ACQUIRE, "agent");
            asm volatile("s_waitcnt vmcnt(0)" ::: "memory");
        }
    }
    __syncthreads();
}

constexpr int RING_OFF = 0, RING_BYTES = 131072;
constexpr int LDSCTL_OFF = RING_BYTES, MISC_OFF = LDSCTL_OFF + 320;
constexpr int MOE_OFF = MISC_OFF + 128;
constexpr int LDS_BYTES = 147456;

struct Ctx {
    LAS unsigned char* lds;
    volatile LAS unsigned* MISC;
    gu32* ctl;
    int tid, lane, wave, vcu, G;
    const float *x, *mem; const int* pos; const float *norm_mix, *w_in, *b_forget, *fox_q_norm, *fox_k_norm, *swa_q_norm, *swa_k_norm, *swa_sinks, *xmem_q_norm, *xmem_k_norm, *norm_mem,
        *w_mem_kv, *w_up_fox, *w_up_swa, *w_up_xmem, *w_out, *norm_ffn, *w_router, *b_router, *w_gate_up, *b_gate_up, *w_down, *b_down;
    float* out;
    bf16 *Win_t, *Wmkv_t, *Wup_t, *Wout_t, *Wr_t, *Wgu_t, *Wd_t, *XN, *MN, *QKV, *G_, *MKV, *OALL, *MERGED, *HB, *ACT;
    float *LOGF, *CNEG, *ROPE, *GATEW, *RS, *TGATE; int *TOK, *TSLOT; bf16* Y;
};

__constant__ float INV_FREQ[32] = {1.000000000e+00f, 7.498942614e-01f, 5.623413324e-01f, 4.216965139e-01f, 3.162277639e-01f, 2.371373773e-01f, 1.778279394e-01f, 1.333521307e-01f,
    1.000000015e-01f, 7.498941571e-02f, 5.623413250e-02f, 4.216965288e-02f, 3.162277490e-02f, 2.371373773e-02f, 1.778279431e-02f, 1.333521493e-02f, 9.999999776e-03f, 7.498941850e-03f,
    5.623413250e-03f, 4.216964822e-03f, 3.162277630e-03f, 2.371373586e-03f, 1.778279431e-03f, 1.333521446e-03f, 1.000000047e-03f, 7.498942432e-04f, 5.623413017e-04f, 4.216965172e-04f,
    3.162277571e-04f, 2.371373703e-04f, 1.778279402e-04f, 1.333521504e-04f};

struct TItem { const float* src; const float* ksc; bf16* dst; size_t ldw; int f8; };
__device__ __forceinline__ void titem_load(const TItem& I, f32x4 (&v)[8][2], float (&sc)[8][2], int lane) {
    const int rr = lane >> 4, c4 = lane & 15;
#pragma unroll
    for (int p = 0; p < 8; ++p)
#pragma unroll
        for (int h = 0; h < 2; ++h) { const int k = 8 * p + 2 * rr + h; v[p][h] = *(const GAS f32x4*)(I.src + (size_t)k * I.ldw + 4 * c4); sc[p][h] = I.ksc ? I.ksc[k] : 1.0f; }
}
__device__ __forceinline__ void titem_store(const TItem& I, const f32x4 (&v)[8][2], const float (&sc)[8][2], LAS unsigned* tile, int lane) {
    const int rr = lane >> 4, c4 = lane & 15;
#pragma unroll
    for (int p = 0; p < 8; ++p)
#pragma unroll
        for (int q = 0; q < 4; ++q) { const int n = 4 * c4 + q, sw = (n ^ (n >> 3)) & 7;
            tile[n * 32 + 4 * (p ^ sw) + rr] = pg8::cvt_pk_bf16(v[p][0][q] * sc[p][0], v[p][1][q] * sc[p][1]); }
    LDS_WAIT(); asm volatile("" ::: "memory");
#pragma unroll
    for (int j = 0; j < 8; ++j) { const int n = 8 * j + (lane >> 3), c = lane & 7, sw = (n ^ (n >> 3)) & 7;
        const v4u o = *(const LAS v4u*)(tile + n * 32 + 4 * (c ^ sw));
        *(GAS v4u*)(I.dst + (size_t)n * DM + 8 * c) = o; }
    LDS_WAIT(); asm volatile("" ::: "memory");
}
__device__ __forceinline__ void titem8_load(const TItem& I, f32x4 (&v)[8][2], float (&sc)[8][2], int lane) {
    const int rr = lane >> 4, c4 = lane & 15;
#pragma unroll
    for (int p = 0; p < 4; ++p)
#pragma unroll
        for (int h = 0; h < 4; ++h) { const int k = 16 * p + 4 * rr + h; v[2 * p + (h >> 1)][h & 1] = *(const GAS f32x4*)(I.src + (size_t)k * I.ldw + 4 * c4); sc[2 * p + (h >> 1)][h & 1] = (I.ksc ? I.ksc[k] : 1.0f) * W8_MUL; }
}
__device__ __forceinline__ void titem8_store(const TItem& I, const f32x4 (&v)[8][2], const float (&sc)[8][2], LAS unsigned* tile, int lane) {
    const int rr = lane >> 4, c4 = lane & 15;
#pragma unroll
    for (int p = 0; p < 4; ++p)
#pragma unroll
        for (int q = 0; q < 4; ++q) { const int n = 4 * c4 + q, sw = (n >> 2) & 3;
            tile[n * 16 + 4 * (p ^ sw) + rr] = pk4_fp8(v[2 * p][0][q] * sc[2 * p][0], v[2 * p][1][q] * sc[2 * p][1], v[2 * p + 1][0][q] * sc[2 * p + 1][0], v[2 * p + 1][1][q] * sc[2 * p + 1][1]); }
    LDS_WAIT(); asm volatile("" ::: "memory");
#pragma unroll
    for (int j = 0; j < 4; ++j) { const int n = 16 * j + (lane >> 2), c = lane & 3, sw = (n >> 2) & 3;
        const v4u o = *(const LAS v4u*)(tile + n * 16 + 4 * (c ^ sw));
        *(GAS v4u*)((unsigned char*)I.dst + (size_t)n * DM + 16 * c) = o; }
    LDS_WAIT(); asm volatile("" ::: "memory");
}
__device__ __forceinline__ void p0_router_item(const float* W, int k0, bf16* WT, const float* ksc, LAS float* scr, int lane) {
#pragma unroll 8
    for (int i = 0; i < 32; ++i) { const int kk = 2 * i + (lane >> 5); scr[kk * 33 + (lane & 31)] = W[(size_t)(k0 + kk) * 32 + (lane & 31)] * ksc[k0 + kk]; }
    LDS_WAIT(); asm volatile("" ::: "memory");
    const int c = lane & 7;
#pragma unroll
    for (int j = 0; j < 4; ++j) { const int n = (lane >> 3) + 8 * j; const LAS float* s = scr + (8 * c) * 33 + n;
        unsigned h[8], l[8];
#pragma unroll
        for (int q = 0; q < 8; ++q) { const float v = s[q * 33]; h[q] = f2bf(v); l[q] = f2bf(v - __uint_as_float(h[q] << 16)); }
        v4u oh, ol; oh.x = h[0] | (h[1] << 16); oh.y = h[2] | (h[3] << 16); oh.z = h[4] | (h[5] << 16); oh.w = h[6] | (h[7] << 16);
        ol.x = l[0] | (l[1] << 16); ol.y = l[2] | (l[3] << 16); ol.z = l[4] | (l[5] << 16); ol.w = l[6] | (l[7] << 16);
        *(GAS v4u*)(WT + (size_t)n * 2048 + k0 + 8 * c) = oh; *(GAS v4u*)(WT + (size_t)(32 + n) * 2048 + k0 + 8 * c) = ol; }
    LDS_WAIT(); asm volatile("" ::: "memory");
}
__device__ __forceinline__ float log_sigmoidf_(float z) { return fminf(z, 0.f) - log1pf(__expf(-fabsf(z))); }

template <bool XROW>
__device__ __forceinline__ void p0_norm_row(const Ctx& C, const float* xrow, const float* gain, bf16* orow, const LAS float* Wf, int m) {
    const GAS f32x4* xr = (const GAS f32x4*)xrow + C.lane; const GAS f32x4* gr = (const GAS f32x4*)gain + C.lane;
    f32x4 v[8]; float s = 0.f;
#pragma unroll
    for (int j = 0; j < 8; ++j) { v[j] = xr[64 * j]; s += (v[j].x * v[j].x + v[j].y * v[j].y) + (v[j].z * v[j].z + v[j].w * v[j].w); }
    const float rstd = 1.0f / sqrtf(wave_sum(s) * (1.f / DM) + NORM_EPS);
    GAS unsigned long long* o8 = (GAS unsigned long long*)orow + C.lane;
#pragma unroll
    for (int j = 0; j < 8; ++j) { const f32x4 g = gr[64 * j]; v[j] = (v[j] * rstd) * g;
        o8[64 * j] = (unsigned long long)pk2(v[j].x, v[j].y) | ((unsigned long long)pk2(v[j].z, v[j].w) << 32); }
    if constexpr (XROW) {
        float mine = 0.f;
#pragma unroll 1
        for (int h = 0; h < 12; ++h) { const LAS f32x4* w = (const LAS f32x4*)(Wf + h * 2048) + C.lane; float d = 0.f;
#pragma unroll
            for (int j = 0; j < 8; ++j) { const f32x4 ww = w[64 * j]; d += (v[j].x * ww.x + v[j].y * ww.y) + (v[j].z * ww.z + v[j].w * ww.w); }
            d = wave_sum(d); if (C.lane == h) mine = d; }
        const int b = m / SEQ, t = m % SEQ;
        if (C.lane < 12) C.LOGF[(size_t)(b * 12 + C.lane) * SEQ + t] = log_sigmoidf_(mine + C.b_forget[C.lane]);
        if (C.lane < 32) { const float ang = (float)C.pos[m] * INV_FREQ[C.lane]; const double rev = (double)ang * 0.15915494309189535; const float fr = (float)(rev - floor(rev));
            C.ROPE[(size_t)m * 64 + C.lane] = __builtin_amdgcn_cosf(fr); C.ROPE[(size_t)m * 64 + 32 + C.lane] = __builtin_amdgcn_sinf(fr); }
    }
}
__device__ __forceinline__ void phase0(const Ctx& C) {
    LAS float* Wf = (LAS float*)(C.lds + RING_OFF);
    for (int idx = C.tid; idx < 12 * 2048; idx += NWAVES * 64) { const int k = idx / 12, h = idx - 12 * k; Wf[h * 2048 + k] = C.w_in[(size_t)k * INW + 2304 + h]; }
    __syncthreads();
    const int gw = C.vcu * NWAVES + C.wave, NGW = C.G * NWAVES;
    for (int m = gw; m < T; m += NGW) p0_norm_row<true>(C, C.x + (size_t)m * DM, C.norm_mix, C.XN + (size_t)m * DM, Wf, m);
    for (int m = gw; m < MROWS; m += NGW) p0_norm_row<false>(C, C.mem + (size_t)m * DM, C.norm_mem, C.MN + (size_t)m * DM, Wf, m);
    __syncthreads();
    LAS float* scr = (LAS float*)(C.lds + RING_OFF + C.wave * 16384);
    for (int r = gw; r < 32; r += NGW) p0_router_item(C.w_router, 64 * r, C.Wr_t, C.norm_ffn, scr, C.lane);
    constexpr int I_GU = 32 * 32 * 64, I_D = 32 * 32 * 32, I_IN = 32 * 160, I_MKV = 32 * 16, I_UF = 12 * 32, I_US = 12 * 32, I_UX = 8 * 32, I_O = 32 * 32;
    constexpr int NITEMS = I_GU + I_D + I_IN + I_MKV + I_UF + I_US + I_UX + I_O;
    auto decode = [&](int it) -> TItem {
        TItem I; int r = it; I.ksc = nullptr; I.f8 = 0;
        if (r < I_GU) { const int e = r / 2048, q = r % 2048, kb = q / 64, pb = q % 64, tl = pb >> 2, jb = pb & 3;
            const int n0 = (jb < 2) ? (128 * tl + 64 * jb) : (2048 + 128 * tl + 64 * (jb - 2));
            I.ldw = 4096; I.src = C.w_gate_up + (size_t)e * DM * 4096 + (size_t)(64 * kb) * 4096 + n0; I.ksc = C.norm_ffn + 64 * kb; I.f8 = 1; I.dst = (bf16*)((unsigned char*)C.Wgu_t + ((size_t)e * 4096 + 64 * pb) * DM + 64 * kb); return I; } r -= I_GU;
        if (r < I_D) { const int e = r / 1024, q = r % 1024, kb = q / 32, nb = q % 32;
            I.ldw = DM; I.src = C.w_down + (size_t)e * DM * DM + (size_t)(64 * kb) * DM + 64 * nb; I.f8 = 1; I.dst = (bf16*)((unsigned char*)C.Wd_t + ((size_t)e * DM + 64 * nb) * DM + 64 * kb); return I; } r -= I_D;
        if (r < I_IN) { const int kb = r / 160, pb = r % 160; const int n0 = (64 * pb < 2304) ? 64 * pb : 64 * pb + 12;
            I.ldw = INW; I.src = C.w_in + (size_t)(64 * kb) * INW + n0; I.dst = C.Win_t + (size_t)(64 * pb) * DM + 64 * kb; return I; } r -= I_IN;
        if (r < I_MKV) { const int kb = r / 16, nb = r % 16; I.ldw = 1024; I.src = C.w_mem_kv + (size_t)(64 * kb) * 1024 + 64 * nb; I.dst = C.Wmkv_t + (size_t)(64 * nb) * DM + 64 * kb; return I; } r -= I_MKV;
        if (r < I_UF) { const int kb = r / 32, nb = r % 32; I.ldw = DM; I.src = C.w_up_fox + (size_t)(64 * kb) * DM + 64 * nb; I.dst = C.Wup_t + (size_t)(64 * nb) * DM + 64 * kb; return I; } r -= I_UF;
        if (r < I_US) { const int kb = r / 32, nb = r % 32; I.ldw = DM; I.src = C.w_up_swa + (size_t)(64 * kb) * DM + 64 * nb; I.dst = C.Wup_t + (size_t)(64 * nb) * DM + 768 + 64 * kb; return I; } r -= I_US;
        if (r < I_UX) { const int kb = r / 32, nb = r % 32; I.ldw = DM; I.src = C.w_up_xmem + (size_t)(64 * kb) * DM + 64 * nb; I.dst = C.Wup_t + (size_t)(64 * nb) * DM + 1536 + 64 * kb; return I; } r -= I_UX;
        { const int kb = r / 32, nb = r % 32; I.ldw = DM; I.src = C.w_out + (size_t)(64 * kb) * DM + 64 * nb; I.dst = C.Wout_t + (size_t)(64 * nb) * DM + 64 * kb; return I; }
    };
    LAS unsigned* tile = (LAS unsigned*)(C.lds + RING_OFF + C.wave * 8192);
    __syncthreads();
    constexpr int N8 = I_GU + I_D;
    if (gw < N8) {
        TItem cur = decode(gw); f32x4 va[8][2]; float sa[8][2]; titem8_load(cur, va, sa, C.lane);
        for (int it = gw; it < N8; it += NGW) {
            const int nx = it + NGW; TItem nxt = cur; f32x4 vb[8][2]; float sb[8][2];
            if (nx < N8) { nxt = decode(nx); titem8_load(nxt, vb, sb, C.lane); }
            titem8_store(cur, va, sa, tile, C.lane);
            cur = nxt;
#pragma unroll
            for (int p = 0; p < 8; ++p)
#pragma unroll
                for (int h = 0; h < 2; ++h) { va[p][h] = vb[p][h]; sa[p][h] = sb[p][h]; }
        }
    }
    if (N8 + gw < NITEMS) {
        TItem cur = decode(N8 + gw); f32x4 va[8][2]; float sa[8][2]; titem_load(cur, va, sa, C.lane);
        for (int it = N8 + gw; it < NITEMS; it += NGW) {
            const int nx = it + NGW; TItem nxt = cur; f32x4 vb[8][2]; float sb[8][2];
            if (nx < NITEMS) { nxt = decode(nx); titem_load(nxt, vb, sb, C.lane); }
            titem_store(cur, va, sa, tile, C.lane);
            cur = nxt;
#pragma unroll
            for (int p = 0; p < 8; ++p)
#pragma unroll
                for (int h = 0; h < 2; ++h) { va[p][h] = vb[p][h]; sa[p][h] = sb[p][h]; }
        }
    }
}


using pg8::Unit;
template <int RB>
struct DenseOrderT {
    const char* A; const char* Bt; int nM, nN, nwg, G, c;
    __device__ __forceinline__ void init(const void* A_, const void* Bt_, int M, int N, int G_, int c_) { A = (const char*)A_; Bt = (const char*)Bt_; nM = M / 256; nN = N / 256; nwg = nM * nN; G = G_; c = c_; }
    __device__ __forceinline__ bool map(long L, Unit& u) const {
        if (L >= nwg) return false;
        int wgid = (int)L; { const int q = nwg / 8, r = nwg % 8, xcd = wgid % 8, off = wgid / 8; wgid = (xcd < r ? xcd * (q + 1) : r * (q + 1) + (xcd - r) * q) + off; }
        const int nig = 8 * nN, gid = wgid / nig, fm = gid * 8, gsz = (nM - fm) < 8 ? (nM - fm) : 8;
        u.pm = fm + ((wgid % nig) % gsz); u.pn = (wgid % nig) / gsz; u.e = 0; u.kind = 0; return true;
    }
    __device__ __forceinline__ bool next(int i, Unit& u) const { return map((long)i * G + c, u); }
    __device__ __forceinline__ const char* a_base(const Unit& u) const { return A + (size_t)u.pm * (256 * RB); }
    __device__ __forceinline__ const char* b_base(const Unit& u) const { return Bt + (size_t)u.pn * (256 * RB); }
    __device__ __forceinline__ void a_offs(const Unit&, const int (&R)[2], const int (&Cc)[2], unsigned (&vo)[2][2]) const {
#pragma unroll
        for (int h = 0; h < 2; ++h)
#pragma unroll
            for (int i = 0; i < 2; ++i) vo[h][i] = (unsigned)((h * 128 + R[i]) * RB + Cc[i] * 2);
    }
};
typedef DenseOrderT<4096> DenseOrder;
struct P1Order {
    DenseOrder d; const char* A1; const char* B1;
    __device__ __forceinline__ bool next(int i, Unit& u) const {
        const long L = (long)i * d.G + d.c;
        if (L < d.nwg) return d.map(L, u);
        const int r = (int)(L - d.nwg); if (r >= 8) return false;
        u.pm = r >> 2; u.pn = r & 3; u.e = 0; u.kind = 1; return true;
    }
    __device__ __forceinline__ const char* a_base(const Unit& u) const { return (u.kind ? A1 : d.A) + (size_t)u.pm * (256 * 2048 * 2); }
    __device__ __forceinline__ const char* b_base(const Unit& u) const { return (u.kind ? B1 : d.Bt) + (size_t)u.pn * (256 * 2048 * 2); }
    __device__ __forceinline__ void a_offs(const Unit& u, const int (&R)[2], const int (&Cc)[2], unsigned (&vo)[2][2]) const { d.a_offs(u, R, Cc, vo); }
};
template <bool GATHER, int NT, int RB>
struct MoeOrder {
    const char* A; const char* Bt; const int* tok; const int* cnt; const LAS int* tab; int G, c;
    __device__ __forceinline__ bool next(int i, Unit& u) const {
        const int L = i * G + c; if (L >= __builtin_amdgcn_readfirstlane(tab[32])) return false;
        int e = 0;
#pragma unroll 1
        for (int j = 1; j < 32; ++j) e += (__builtin_amdgcn_readfirstlane(tab[j]) <= L) ? 1 : 0;
        const int j = L - __builtin_amdgcn_readfirstlane(tab[e]), mt = __builtin_amdgcn_readfirstlane(tab[33 + e]), per = mt * 4, ntg = j / per, r = j - ntg * per;
        u.e = e; u.pm = r >> 2; u.pn = ntg * 4 + (r & 3); u.kind = __builtin_amdgcn_readfirstlane(tab[65 + e]) + 256 * u.pm;
        return true;
    }
    __device__ __forceinline__ const char* a_base(const Unit& u) const { return GATHER ? A : A + (size_t)u.kind * RB; }
    __device__ __forceinline__ const char* b_base(const Unit& u) const { return Bt + ((size_t)u.e * NT + u.pn) * (256 * RB); }
    __device__ __forceinline__ void a_offs(const Unit& u, const int (&R)[2], const int (&Cc)[2], unsigned (&vo)[2][2]) const {
#pragma unroll
        for (int h = 0; h < 2; ++h)
#pragma unroll
            for (int i = 0; i < 2; ++i) {
                if constexpr (GATHER) { const int n_e = __builtin_amdgcn_readfirstlane(tab[97 + u.e]); int ri = 256 * u.pm + h * 128 + R[i]; ri = ri < n_e ? ri : n_e - 1;
                    const int row = tok[u.e * CAP + ri]; vo[h][i] = (unsigned)(row * RB + Cc[i] * 2); }
                else vo[h][i] = (unsigned)((h * 128 + R[i]) * RB + Cc[i] * 2);
            }
    }
};

struct EpiInProj {
    static constexpr bool PERM = true, MID = false, FP8 = false; static constexpr int SCALE_A = 0x7f, SCALE_B = 0x7f;
    bf16* QKV; bf16* Gt; bf16* MKV;
    __device__ __forceinline__ void mid(pg8::f32x4 (&)[2][2][4][2], const Unit&, int, int, int, int, int) const {}
    __device__ __forceinline__ void operator()(const pg8::f32x4 (&acc)[2][2][4][2], const Unit& u, int wr, int wc, int fr, int fq) const {
        asm volatile("" : "+v"(fr), "+v"(fq));
        const int row0 = u.pm * 256 + wr * 64 + fr;
        bf16* base; int ldc, colt; bool sg = false;
        if (u.kind) { base = MKV; ldc = 1024; colt = u.pn * 256; }
        else if (u.pn < 16) { base = QKV; ldc = QKVW; colt = u.pn * 256; }
        else { base = Gt; ldc = GW; colt = (u.pn - 16) * 256; sg = true; }
        const int col0 = colt + wc * 32 + 8 * fq;
#pragma unroll
        for (int ai = 0; ai < 2; ++ai)
#pragma unroll
            for (int m = 0; m < 4; ++m) { bf16* rowp = base + (size_t)(row0 + ai * 128 + m * 16) * ldc + col0;
#pragma unroll
                for (int bj = 0; bj < 2; ++bj) { pg8::f32x4 v0 = acc[ai][bj][m][0], v1 = acc[ai][bj][m][1];
                    if (sg) {
#pragma unroll
                        for (int q = 0; q < 4; ++q) { v0[q] = sigmoidf_(fmaxf(v0[q], -30.f)); v1[q] = sigmoidf_(fmaxf(v1[q], -30.f)); } }
                    u32x4 w; w.x = cvt_pk_bf16(v0[0], v0[1]); w.y = cvt_pk_bf16(v0[2], v0[3]); w.z = cvt_pk_bf16(v1[0], v1[1]); w.w = cvt_pk_bf16(v1[2], v1[3]);
                    *(u32x4*)(rowp + bj * 128) = w; } }
    }
};
struct EpiMerge {
    static constexpr bool PERM = true, MID = true, FP8 = false; static constexpr int SCALE_A = 0x7f, SCALE_B = 0x7f;
    const bf16* Gt; bf16* O;
    __device__ __forceinline__ void mid(pg8::f32x4 (&acc)[2][2][4][2], const Unit& u, int which, int wr, int wc, int fr, int fq) const {
        asm volatile("" : "+v"(fr), "+v"(fq));
        const int row0 = u.pm * 256 + wr * 64 + fr, col0 = u.pn * 256 + wc * 32 + 8 * fq;
        const bf16* gn = Gt + (which ? 2048 : 0); const bf16* gd = Gt + (which ? 4096 : 2048);
#pragma unroll
        for (int ai = 0; ai < 2; ++ai)
#pragma unroll
            for (int m = 0; m < 4; ++m) { const size_t ro = (size_t)(row0 + ai * 128 + m * 16) * GW + col0;
#pragma unroll
                for (int bj = 0; bj < 2; ++bj) { const u32x4 a = *(const u32x4*)(gn + ro + bj * 128), b = *(const u32x4*)(gd + ro + bj * 128);
                    pg8::f32x4 r0, r1;
                    r0[0] = bf_lo(a.x) * __builtin_amdgcn_rcpf(bf_lo(b.x)); r0[1] = bf_hi(a.x) * __builtin_amdgcn_rcpf(bf_hi(b.x)); r0[2] = bf_lo(a.y) * __builtin_amdgcn_rcpf(bf_lo(b.y)); r0[3] = bf_hi(a.y) * __builtin_amdgcn_rcpf(bf_hi(b.y));
                    r1[0] = bf_lo(a.z) * __builtin_amdgcn_rcpf(bf_lo(b.z)); r1[1] = bf_hi(a.z) * __builtin_amdgcn_rcpf(bf_hi(b.z)); r1[2] = bf_lo(a.w) * __builtin_amdgcn_rcpf(bf_lo(b.w)); r1[3] = bf_hi(a.w) * __builtin_amdgcn_rcpf(bf_hi(b.w));
                    acc[ai][bj][m][0] *= r0; acc[ai][bj][m][1] *= r1; }
                asm volatile("" : "+v"(acc[ai][0][m][0]), "+v"(acc[ai][0][m][1]), "+v"(acc[ai][1][m][0]), "+v"(acc[ai][1][m][1]));
                asm volatile("" ::: "memory"); }
    }
    __device__ __forceinline__ void operator()(const pg8::f32x4 (&acc)[2][2][4][2], const Unit& u, int wr, int wc, int fr, int fq) const {
        asm volatile("" : "+v"(fr), "+v"(fq));
        const int row0 = u.pm * 256 + wr * 64 + fr, col0 = u.pn * 256 + wc * 32 + 8 * fq;
#pragma unroll
        for (int ai = 0; ai < 2; ++ai)
#pragma unroll
            for (int m = 0; m < 4; ++m) { const size_t rr = (size_t)(row0 + ai * 128 + m * 16);
#pragma unroll
                for (int bj = 0; bj < 2; ++bj) { const u32x4 g = *(const u32x4*)(Gt + rr * GW + 4096 + col0 + bj * 128);
                    const pg8::f32x4 v0 = acc[ai][bj][m][0], v1 = acc[ai][bj][m][1];
                    u32x4 w; w.x = cvt_pk_bf16(v0[0] * bf_lo(g.x), v0[1] * bf_hi(g.x)); w.y = cvt_pk_bf16(v0[2] * bf_lo(g.y), v0[3] * bf_hi(g.y));
                    w.z = cvt_pk_bf16(v1[0] * bf_lo(g.z), v1[1] * bf_hi(g.z)); w.w = cvt_pk_bf16(v1[2] * bf_lo(g.w), v1[3] * bf_hi(g.w));
                    *(u32x4*)(O + rr * DM + col0 + bj * 128) = w; }
                asm volatile("" ::: "memory"); }
    }
};
struct EpiOut {
    static constexpr bool PERM = false, MID = false, FP8 = false; static constexpr int SCALE_A = 0x7f, SCALE_B = 0x7f;
    const float* X; float* out; unsigned char* HB8;
    __device__ __forceinline__ void mid(pg8::f32x4 (&)[2][2][4][2], const Unit&, int, int, int, int, int) const {}
    __device__ __forceinline__ void operator()(const pg8::f32x4 (&acc)[2][2][4][2], const Unit& u, int wr, int wc, int fr, int fq) const {
        asm volatile("" : "+v"(fr), "+v"(fq));
        const int row0 = u.pm * 256 + wr * 64 + fr, col0 = u.pn * 256 + wc * 32 + 4 * fq;
#pragma unroll
        for (int ai = 0; ai < 2; ++ai)
#pragma unroll
            for (int m = 0; m < 4; ++m) { const size_t off = (size_t)(row0 + ai * 128 + m * 16) * DM + col0;
#pragma unroll
                for (int bj = 0; bj < 2; ++bj)
#pragma unroll
                    for (int n = 0; n < 2; ++n) { const size_t o2 = off + bj * 128 + n * 16; const pg8::f32x4 h = *(const pg8::f32x4*)(X + o2) + acc[ai][bj][m][n];
                        *(pg8::f32x4*)(out + o2) = h; *(unsigned*)(HB8 + o2) = pk4_fp8(h[0] * H8_MUL, h[1] * H8_MUL, h[2] * H8_MUL, h[3] * H8_MUL); } }
    }
};
struct EpiGateUp {
    static constexpr bool PERM = true, MID = false, FP8 = true; static constexpr int SCALE_A = 127 - H8_SHIFT, SCALE_B = 127 - W8_SHIFT;
    const float* RS; const float* bgu; unsigned char* ACT8;
    __device__ __forceinline__ void mid(pg8::f32x4 (&)[2][2][4][2], const Unit&, int, int, int, int, int) const {}
    __device__ __forceinline__ void operator()(const pg8::f32x4 (&acc)[2][2][4][2], const Unit& u, int wr, int wc, int fr, int fq) const {
        asm volatile("" : "+v"(fr), "+v"(fq));
        const int r0 = wr * 64 + fr, hc0 = u.pn * 128 + wc * 32 + 8 * fq;
        const float* bg = bgu + (size_t)u.e * 4096 + hc0;
        const pg8::f32x4 bg0 = *(const pg8::f32x4*)(bg), bg1 = *(const pg8::f32x4*)(bg + 4), bu0 = *(const pg8::f32x4*)(bg + 2048), bu1 = *(const pg8::f32x4*)(bg + 2052);
        float rsv[2][4];
#pragma unroll
        for (int ai = 0; ai < 2; ++ai)
#pragma unroll
            for (int m = 0; m < 4; ++m) rsv[ai][m] = RS[u.e * CAP + 256 * u.pm + r0 + ai * 128 + m * 16];
#pragma unroll
        for (int ai = 0; ai < 2; ++ai)
#pragma unroll
            for (int m = 0; m < 4; ++m) { const int rl = r0 + ai * 128 + m * 16;
                const float rs = rsv[ai][m];
                float g[8], up[8];
#pragma unroll
                for (int q = 0; q < 4; ++q) { g[q] = rs * acc[ai][0][m][0][q] + bg0[q]; g[4 + q] = rs * acc[ai][0][m][1][q] + bg1[q]; up[q] = rs * acc[ai][1][m][0][q] + bu0[q]; up[4 + q] = rs * acc[ai][1][m][1][q] + bu1[q]; }
                float a[8];
#pragma unroll
                for (int q = 0; q < 8; ++q) { const float gg = fminf(g[q], SWIGLU_LIMIT), uu = fminf(fmaxf(up[q], -SWIGLU_LIMIT), SWIGLU_LIMIT); a[q] = (uu + 1.0f) * (gg * sigmoidf_(gg * SWIGLU_ALPHA)); }
                u32x2 w; w.x = pk4_fp8(a[0] * ACT8_MUL, a[1] * ACT8_MUL, a[2] * ACT8_MUL, a[3] * ACT8_MUL); w.y = pk4_fp8(a[4] * ACT8_MUL, a[5] * ACT8_MUL, a[6] * ACT8_MUL, a[7] * ACT8_MUL);
                *(u32x2*)(ACT8 + (size_t)(u.kind + rl) * DM + hc0) = w; }
    }
};
struct EpiDown {
    static constexpr bool PERM = true, MID = false, FP8 = true; static constexpr int SCALE_A = 127 - ACT8_SHIFT, SCALE_B = 127 - W8_SHIFT;
    const float* bd; bf16* Y;
    __device__ __forceinline__ void mid(pg8::f32x4 (&)[2][2][4][2], const Unit&, int, int, int, int, int) const {}
    __device__ __forceinline__ void operator()(const pg8::f32x4 (&acc)[2][2][4][2], const Unit& u, int wr, int wc, int fr, int fq) const {
        asm volatile("" : "+v"(fr), "+v"(fq));
        const int r0 = wr * 64 + fr, col0 = u.pn * 256 + wc * 32 + 8 * fq;
        const float* bb = bd + (size_t)u.e * DM + col0;
        pg8::f32x4 bv[2][2];
#pragma unroll
        for (int bj = 0; bj < 2; ++bj)
#pragma unroll
            for (int n = 0; n < 2; ++n) bv[bj][n] = *(const pg8::f32x4*)(bb + bj * 128 + n * 4);
#pragma unroll
        for (int ai = 0; ai < 2; ++ai)
#pragma unroll
            for (int m = 0; m < 4; ++m) { bf16* rowp = Y + (size_t)(u.kind + r0 + ai * 128 + m * 16) * DM + col0;
#pragma unroll
                for (int bj = 0; bj < 2; ++bj) { const pg8::f32x4 v0 = acc[ai][bj][m][0] + bv[bj][0], v1 = acc[ai][bj][m][1] + bv[bj][1];
                    u32x4 w; w.x = cvt_pk_bf16(v0[0], v0[1]); w.y = cvt_pk_bf16(v0[2], v0[3]); w.z = cvt_pk_bf16(v1[0], v1[1]); w.w = cvt_pk_bf16(v1[2], v1[3]);
                    *(u32x4*)(rowp + bj * 128) = w; } }
    }
};

__device__ __forceinline__ void phase2(const Ctx& C) {
    constexpr float C2_64 = 0.125f * LOG2E, C2_128 = 0.08838834764831845f * LOG2E;
    const int i = C.tid;
    int kind;
    const float* gain; float sc = 1.f; int gofs;
    if (i < 96)        { kind = 1; gain = C.fox_q_norm;  sc = C2_64;  gofs = (i & 7) * 8; }
    else if (i < 192)  { kind = 1; gain = C.fox_k_norm;  gofs = (i & 7) * 8; }
    else if (i < 288)  { kind = 0; gain = C.fox_k_norm;  gofs = 0; }
    else if (i < 384)  { kind = 2; gain = C.swa_q_norm;  sc = C2_64;  gofs = (i & 7) * 8; }
    else if (i < 416)  { kind = 2; gain = C.swa_k_norm;  gofs = (i & 7) * 8; }
    else if (i < 448)  { kind = 0; gain = C.swa_k_norm;  gofs = 0; }
    else               { kind = 3; gain = C.xmem_q_norm; sc = C2_128; gofs = (i & 15) * 8; }
    float gv[8];
#pragma unroll
    for (int q = 0; q < 8; ++q) gv[q] = gain[gofs + q] * sc;
    const int li = i & 7;
    const int rj = (li & 3) * 8;
    for (int m = C.vcu; m < T; m += C.G) {
        bf16* p = C.QKV + (size_t)m * QKVW + i * 8;
        const v4u raw = *(const GAS v4u*)p;
        float v[8]; v[0] = pg8::bf_lo(raw.x); v[1] = pg8::bf_hi(raw.x); v[2] = pg8::bf_lo(raw.y); v[3] = pg8::bf_hi(raw.y); v[4] = pg8::bf_lo(raw.z); v[5] = pg8::bf_hi(raw.z); v[6] = pg8::bf_lo(raw.w); v[7] = pg8::bf_hi(raw.w);
        float ss = 0.f;
#pragma unroll
        for (int q = 0; q < 8; ++q) ss += v[q] * v[q];
        ss += __shfl_xor(ss, 1); ss += __shfl_xor(ss, 2); ss += __shfl_xor(ss, 4);
        const float ss16 = ss + __shfl_xor(ss, 8);
        const float rstd = (kind == 3) ? 1.0f / sqrtf(ss16 * (1.f / 128.f) + NORM_EPS) : 1.0f / sqrtf(ss * (1.f / 64.f) + NORM_EPS);
#pragma unroll
        for (int q = 0; q < 8; ++q) v[q] = (v[q] * rstd) * gv[q];
        float o[8];
#pragma unroll
        for (int q = 0; q < 8; ++q) o[q] = __shfl_xor(v[q], 4);
        if (kind == 2) {
            const float* cs = C.ROPE + (size_t)m * 64 + rj;
            const f32x4 c0 = *(const GAS f32x4*)cs, c1 = *(const GAS f32x4*)(cs + 4), s0 = *(const GAS f32x4*)(cs + 32), s1 = *(const GAS f32x4*)(cs + 36);
            const float cc[8] = {c0.x, c0.y, c0.z, c0.w, c1.x, c1.y, c1.z, c1.w}, sn[8] = {s0.x, s0.y, s0.z, s0.w, s1.x, s1.y, s1.z, s1.w};
            const float sg = (li < 4) ? -1.f : 1.f;
#pragma unroll
            for (int q = 0; q < 8; ++q) v[q] = v[q] * cc[q] + sg * o[q] * sn[q];
        }
        if (kind != 0) { v4u w; w.x = pk2(v[0], v[1]); w.y = pk2(v[2], v[3]); w.z = pk2(v[4], v[5]); w.w = pk2(v[6], v[7]); *(GAS v4u*)p = w; }
    }
    {
        const int rsub = i >> 6, l6 = i & 63; float gk[8];
#pragma unroll
        for (int q = 0; q < 8; ++q) gk[q] = C.xmem_k_norm[(l6 & 15) * 8 + q];
        for (int m = C.vcu * 8 + rsub; m < MROWS; m += C.G * 8) {
            bf16* p = C.MKV + (size_t)m * 1024 + l6 * 8;
            const v4u raw = *(const GAS v4u*)p;
            float v[8]; v[0] = pg8::bf_lo(raw.x); v[1] = pg8::bf_hi(raw.x); v[2] = pg8::bf_lo(raw.y); v[3] = pg8::bf_hi(raw.y); v[4] = pg8::bf_lo(raw.z); v[5] = pg8::bf_hi(raw.z); v[6] = pg8::bf_lo(raw.w); v[7] = pg8::bf_hi(raw.w);
            float ss = 0.f;
#pragma unroll
            for (int q = 0; q < 8; ++q) ss += v[q] * v[q];
            ss += __shfl_xor(ss, 1); ss += __shfl_xor(ss, 2); ss += __shfl_xor(ss, 4); ss += __shfl_xor(ss, 8);
            const float rstd = 1.0f / sqrtf(ss * (1.f / 128.f) + NORM_EPS);
#pragma unroll
            for (int q = 0; q < 8; ++q) v[q] = (v[q] * rstd) * gk[q];
            v4u w; w.x = pk2(v[0], v[1]); w.y = pk2(v[2], v[3]); w.z = pk2(v[4], v[5]); w.w = pk2(v[6], v[7]); *(GAS v4u*)p = w;
        }
    }
    if (C.wave == 0) for (int sq = C.vcu; sq < BATCH * 12; sq += C.G) {
        const float* src = C.LOGF + (size_t)sq * SEQ + C.lane * 128; float* dst = C.CNEG + (size_t)sq * SEQ + C.lane * 128;
        float tot = 0.f;
#pragma unroll 4
        for (int j = 0; j < 32; ++j) { const f32x4 a = *(const GAS f32x4*)(src + 4 * j); tot += (a.x + a.y) + (a.z + a.w); }
        float incl = tot;
#pragma unroll
        for (int o = 1; o < 64; o <<= 1) { const float n = __shfl_up(incl, o); if (C.lane >= o) incl += n; }
        float run = incl - tot;
#pragma unroll 4
        for (int j = 0; j < 32; ++j) { const f32x4 a = *(const GAS f32x4*)(src + 4 * j); f32x4 c;
            run += a.x; c.x = -run * LOG2E; run += a.y; c.y = -run * LOG2E; run += a.z; c.z = -run * LOG2E; run += a.w; c.w = -run * LOG2E; *(GAS f32x4*)(dst + 4 * j) = c; }
    }
}

namespace att {
typedef __attribute__((address_space(3))) const char* lds_cptr;
__device__ __forceinline__ void glds16(const void* gsrc, unsigned lds_dst) { unsigned keep;
    asm volatile("s_mov_b32 %0, m0\n\ts_mov_b32 m0, %2\n\ts_nop 0\n\tglobal_load_lds_dwordx4 %1, off\n\ts_mov_b32 m0, %0" : "=&s"(keep) : "v"(gsrc), "s"(lds_dst) : "memory"); }
typedef float f32x2_t __attribute__((ext_vector_type(2))); typedef __bf16 bf16x2_t __attribute__((ext_vector_type(2)));
__device__ __forceinline__ unsigned cvtpk_s(float lo, float hi) { f32x2_t v = {lo, hi}; bf16x2_t b = __builtin_convertvector(v, bf16x2_t); return __builtin_bit_cast(unsigned, b); }
__device__ __forceinline__ int crow(int r, int hi) { return (r & 3) + 8 * (r >> 2) + 4 * hi; }

template <int D> struct Geo {
    static constexpr int SLOTB = 64 * D * 2, NSLOT = (D == 64) ? 3 : 2, PPT = (D == 64) ? 2 : 4;
    static constexpr int LDS_K = 0, LDS_V = NSLOT * SLOTB, LDS_WS = 2 * NSLOT * SLOTB, LDS_OST = LDS_WS + 2048, LDS_CB = LDS_OST + 8 * 4096, LDS_END = LDS_CB + 32768;
};

template <int D>
__device__ __forceinline__ void qkt(f32x16& p0, f32x16& p1, lds_cptr Kslot, const bf16x8* qr, int r32, int hi) {
    lds_cptr kb = Kslot + hi * 1024 + r32 * 16;
    p0 = f32x16{}; p1 = f32x16{};
#pragma unroll
    for (int d0 = 0; d0 < D / 16; ++d0) {
        const bf16x8 b0 = *(const LAS bf16x8*)(kb + d0 * 2048);
        const bf16x8 b1 = *(const LAS bf16x8*)(kb + d0 * 2048 + 512);
        p0 = __builtin_amdgcn_mfma_f32_32x32x16_bf16(b0, qr[d0], p0, 0, 0, 0); p1 = __builtin_amdgcn_mfma_f32_32x32x16_bf16(b1, qr[d0], p1, 0, 0, 0); }
}
template <int D>
__device__ __forceinline__ void pv(f32x16* o, int vb, bf16x8 pa0, bf16x8 pa1, bf16x8 pa2, bf16x8 pa3) {
#pragma unroll
    for (int d0 = 0; d0 < D / 32; ++d0) { s16x4 lo[4], hi[4];
#pragma unroll
        for (int ks = 0; ks < 4; ++ks) {
            asm volatile("ds_read_b64_tr_b16 %0,%1 offset:%c2" : "=&v"(lo[ks]) : "v"(vb), "i"(d0 * 4096 + ks * 1024) : "memory");
            asm volatile("ds_read_b64_tr_b16 %0,%1 offset:%c2" : "=&v"(hi[ks]) : "v"(vb), "i"(d0 * 4096 + ks * 1024 + 512) : "memory"); }
        asm volatile("s_waitcnt lgkmcnt(0)" ::: "memory"); __builtin_amdgcn_sched_barrier(0);
#define ATT_PK(k) (bf16x8){lo[k][0], lo[k][1], lo[k][2], lo[k][3], hi[k][0], hi[k][1], hi[k][2], hi[k][3]}
        o[d0] = __builtin_amdgcn_mfma_f32_32x32x16_bf16(pa0, ATT_PK(0), o[d0], 0, 0, 0);
        o[d0] = __builtin_amdgcn_mfma_f32_32x32x16_bf16(pa1, ATT_PK(1), o[d0], 0, 0, 0);
        o[d0] = __builtin_amdgcn_mfma_f32_32x32x16_bf16(pa2, ATT_PK(2), o[d0], 0, 0, 0);
        o[d0] = __builtin_amdgcn_mfma_f32_32x32x16_bf16(pa3, ATT_PK(3), o[d0], 0, 0, 0);
#undef ATT_PK
    }
}

template <int D, int MODE>
__device__ __forceinline__ void attn_unit(LAS unsigned char* shm, const bf16* Q, int pitchQ, const bf16* K, const bf16* V, int pitchKV, bf16* O, const float* cneg, float sink2, int qb) {
    typedef Geo<D> G;
    const int tid = threadIdx.x, lane = tid & 63, r32 = lane & 31, hi = lane >> 5; const int wid = __builtin_amdgcn_readfirstlane(tid >> 6);
    const int q0 = qb * 256, q0w = q0 + wid * 32;
    const unsigned lds0 = (unsigned)(uintptr_t)shm;
    LAS float* wsf = (LAS float*)(shm + G::LDS_WS) + wid * 64;
    LAS float* cb = (LAS float*)(shm + G::LDS_CB);
    const int j_lo = (MODE == 1) ? (qb > 0 ? 4 * qb - 2 : 0) : 0, j_hi = (MODE == 2) ? 4 : 4 * qb + 4;
    bf16x8 qr[D / 16];
    { const bf16* Qw = Q + (size_t)(q0w + r32) * pitchQ + hi * 8;
#pragma unroll
      for (int d0 = 0; d0 < D / 16; ++d0) qr[d0] = *(const GAS bf16x8*)(Qw + d0 * 16); }
    if constexpr (MODE == 0) {
        const int nch = (q0 + 256) / 4;
        for (int c = tid; c < nch; c += 512) { const f32x4 v = *(const GAS f32x4*)(cneg + 4 * c); *(LAS f32x4*)(cb + 4 * c) = v; }
    }
#define ATT_DMA(j, slot) do { const int _s = (slot) * G::SLOTB; \
        if constexpr (D == 64) { \
            glds16(K + (size_t)(64 * (j) + lane) * pitchKV + wid * 8, (unsigned)__builtin_amdgcn_readfirstlane(lds0 + G::LDS_K + _s + wid * 1024)); \
            glds16(V + (size_t)(64 * (j) + 16 * (wid & 3) + (lane >> 2)) * pitchKV + (wid >> 2) * 32 + (lane & 3) * 8, (unsigned)__builtin_amdgcn_readfirstlane(lds0 + G::LDS_V + _s + wid * 1024)); \
        } else { \
            _Pragma("unroll") for (int _p = 0; _p < 2; ++_p) { const int _c = wid + 8 * _p; \
                glds16(K + (size_t)(64 * (j) + lane) * pitchKV + _c * 8, (unsigned)__builtin_amdgcn_readfirstlane(lds0 + G::LDS_K + _s + _c * 1024)); } \
            _Pragma("unroll") for (int _p = 0; _p < 2; ++_p) { const int _c = wid + 8 * _p; \
                glds16(V + (size_t)(64 * (j) + 16 * (_c & 3) + (lane >> 2)) * pitchKV + (_c >> 2) * 32 + (lane & 3) * 8, (unsigned)__builtin_amdgcn_readfirstlane(lds0 + G::LDS_V + _s + _c * 1024)); } \
        } } while (0)
    int slot_i = 0;
#pragma unroll
    for (int p = 0; p < G::NSLOT - 1; ++p) if (j_lo + p < j_hi) ATT_DMA(j_lo + p, p);
    float mhat = -1e30f, l_reg = 0.f; f32x16 o[D / 32];
#pragma unroll
    for (int d0 = 0; d0 < D / 32; ++d0) o[d0] = f32x16{};
    const lds_cptr shm3 = (lds_cptr)shm;
    const int vb0 = (int)(lds0 + G::LDS_V) + ((lane >> 4) & 1) * 32 + (lane & 3) * 8 + (4 * hi + ((lane & 15) >> 2)) * 64;
    const int qabs = q0w + r32;
    for (int j = j_lo; j < j_hi; ++j) {
        if (G::NSLOT == 3 && j + 1 < j_hi) { if constexpr (G::PPT == 2) asm volatile("s_waitcnt vmcnt(2) lgkmcnt(0)\n\ts_barrier" ::: "memory"); else asm volatile("s_waitcnt vmcnt(4) lgkmcnt(0)\n\ts_barrier" ::: "memory"); }
        else asm volatile("s_waitcnt vmcnt(0) lgkmcnt(0)\n\ts_barrier" ::: "memory");
        { const int jn = j + G::NSLOT - 1; if (jn < j_hi) { int sn = slot_i + G::NSLOT - 1; if (sn >= G::NSLOT) sn -= G::NSLOT; ATT_DMA(jn, sn); } }
        bool need = true;
        if constexpr (MODE == 0) need = (64 * j <= q0w + 31);
        if constexpr (MODE == 1) need = (64 * j <= q0w + 31) && (64 * j + 63 >= q0w - 127);
        if (need) {
            f32x16 p0, p1;
            qkt<D>(p0, p1, shm3 + G::LDS_K + slot_i * G::SLOTB, qr, r32, hi);
            if constexpr (MODE == 0) {
                const LAS float* cbp = cb + 64 * j + 4 * hi;
#pragma unroll
                for (int g = 0; g < 4; ++g) { const f32x4 b0 = *(const LAS f32x4*)(cbp + 8 * g), b1 = *(const LAS f32x4*)(cbp + 32 + 8 * g);
#pragma unroll
                    for (int e = 0; e < 4; ++e) { p0[4 * g + e] += b0[e]; p1[4 * g + e] += b1[e]; } }
                if (64 * j + 63 > q0w) {
#pragma unroll
                    for (int r = 0; r < 16; ++r) { const int kv = 64 * j + crow(r, hi); if (kv > qabs) p0[r] = -INFINITY; if (kv + 32 > qabs) p1[r] = -INFINITY; } }
            }
            if constexpr (MODE == 1) {
#pragma unroll
                for (int r = 0; r < 16; ++r) { const int kv = 64 * j + crow(r, hi); const int d0_ = qabs - kv, d1_ = d0_ - 32;
                    if (d0_ < 0 || d0_ >= 128) p0[r] = -INFINITY; if (d1_ < 0 || d1_ >= 128) p1[r] = -INFINITY; }
            }
            float rm = fmaxf(p0[0], p1[0]);
#pragma unroll
            for (int r = 1; r < 16; ++r) rm = fmaxf(rm, fmaxf(p0[r], p1[r]));
            { auto rr = __builtin_amdgcn_permlane32_swap(__float_as_uint(rm), __float_as_uint(rm), false, false); rm = fmaxf(__uint_as_float(rr[0]), __uint_as_float(rr[1])); }
            if (__any(rm > mhat)) {
                const float mn = fmaxf(mhat, rm); const float f = __builtin_amdgcn_exp2f(mhat - mn); mhat = mn; l_reg *= f;
                if (hi == 0) wsf[r32] = f;
                asm volatile("s_waitcnt lgkmcnt(0)" ::: "memory");
#pragma unroll
                for (int g = 0; g < 4; ++g) { const f32x4 fv = *(const LAS f32x4*)(wsf + 8 * g + 4 * hi);
#pragma unroll
                    for (int d_ = 0; d_ < D / 32; ++d_)
#pragma unroll
                        for (int e = 0; e < 4; ++e) o[d_][4 * g + e] *= fv[e]; }
            }
            float sacc = 0.f;
#pragma unroll
            for (int r = 0; r < 16; ++r) { p0[r] = __builtin_amdgcn_exp2f(p0[r] - mhat); p1[r] = __builtin_amdgcn_exp2f(p1[r] - mhat); sacc += p0[r] + p1[r]; }
            l_reg += sacc;
            u32x4 pw0, pw1, pw2, pw3;
            pw0 = (u32x4){cvtpk_s(p0[0], p0[1]), cvtpk_s(p0[2], p0[3]), cvtpk_s(p0[4], p0[5]), cvtpk_s(p0[6], p0[7])};
            pw1 = (u32x4){cvtpk_s(p0[8], p0[9]), cvtpk_s(p0[10], p0[11]), cvtpk_s(p0[12], p0[13]), cvtpk_s(p0[14], p0[15])};
            pw2 = (u32x4){cvtpk_s(p1[0], p1[1]), cvtpk_s(p1[2], p1[3]), cvtpk_s(p1[4], p1[5]), cvtpk_s(p1[6], p1[7])};
            pw3 = (u32x4){cvtpk_s(p1[8], p1[9]), cvtpk_s(p1[10], p1[11]), cvtpk_s(p1[12], p1[13]), cvtpk_s(p1[14], p1[15])};
            pv<D>(o, vb0 + slot_i * G::SLOTB, __builtin_bit_cast(bf16x8, pw0), __builtin_bit_cast(bf16x8, pw1), __builtin_bit_cast(bf16x8, pw2), __builtin_bit_cast(bf16x8, pw3));
        }
        ++slot_i; if (slot_i == G::NSLOT) slot_i = 0;
    }
#undef ATT_DMA
    { auto rr = __builtin_amdgcn_permlane32_swap(__float_as_uint(l_reg), __float_as_uint(l_reg), false, false); l_reg = __uint_as_float(rr[0]) + __uint_as_float(rr[1]); }
    if constexpr (MODE == 1) l_reg += __builtin_amdgcn_exp2f(sink2 - mhat);
    if (hi == 0) wsf[32 + r32] = l_reg;
    asm volatile("s_waitcnt lgkmcnt(0)" ::: "memory");
    float rli[16];
#pragma unroll
    for (int g = 0; g < 4; ++g) { const f32x4 lv = *(const LAS f32x4*)(wsf + 32 + 8 * g + 4 * hi);
#pragma unroll
        for (int e = 0; e < 4; ++e) rli[4 * g + e] = __builtin_amdgcn_rcpf(lv[e]); }
    bf16* Ow = O + (size_t)q0w * 2048;
    LAS bf16* stg = (LAS bf16*)(shm + G::LDS_OST) + wid * 2048;
#pragma unroll
    for (int ps = 0; ps < D / 64; ++ps) {
#pragma unroll
        for (int r = 0; r < 16; ++r) { const int orow = crow(r, hi);
#pragma unroll
            for (int dl = 0; dl < 2; ++dl) stg[orow * 64 + dl * 32 + r32] = (bf16)f2bf(o[2 * ps + dl][r] * rli[r]); }
        asm volatile("s_waitcnt lgkmcnt(0)" ::: "memory");
#pragma unroll
        for (int i = 0; i < 4; ++i) { const int row = i * 8 + (lane >> 3), ch = lane & 7; const v4u v = *(const LAS v4u*)(stg + row * 64 + ch * 8); *(GAS v4u*)(Ow + (size_t)row * 2048 + ps * 64 + ch * 8) = v; }
        asm volatile("s_waitcnt lgkmcnt(0)" ::: "memory");
    }
    asm volatile("s_waitcnt lgkmcnt(0)\n\ts_barrier" ::: "memory");
}
}

constexpr int NU_FOX = BATCH * 12 * 32, NU_SWA = BATCH * 12 * 32, NU_XM = BATCH * 4 * 32;
__device__ __forceinline__ int att_fetch(const Ctx& C, int q) {
    int v = 0; if (C.tid == 0) v = (int)__hip_atomic_fetch_add((unsigned*)(C.ctl + CW_QHEAD + 64 * q), 1u, RLX_AGENT); return v;
}
__device__ __forceinline__ void phase3(const Ctx& C) {
    LAS unsigned char* shm = C.lds + RING_OFF;
    volatile LAS int* nxtw = (volatile LAS int*)(C.MISC + 12);
    {
        int pre = att_fetch(C, 0);
        if (C.tid == 0) *nxtw = pre;
        __syncthreads();
        int cur = __builtin_amdgcn_readfirstlane(*nxtw);
        __syncthreads();
        while (cur < NU_FOX) {
            pre = att_fetch(C, 0);
            const int qb = 31 - cur / 24, bh = cur % 24, b = bh / 12, h = bh % 12;
            const bf16* base = C.QKV + (size_t)b * SEQ * QKVW + h * 64;
            att::attn_unit<64, 0>(shm, base + C_FQ, QKVW, base + C_FK, base + C_FV, QKVW, C.OALL + (size_t)b * SEQ * 2048 + h * 64, C.CNEG + (size_t)(b * 12 + h) * SEQ, 0.f, qb);
            if (C.tid == 0) *nxtw = pre;
            __syncthreads();
            cur = __builtin_amdgcn_readfirstlane(*nxtw);
            __syncthreads();
        }
    }
    {
        int pre = att_fetch(C, 1);
        if (C.tid == 0) *nxtw = pre;
        __syncthreads();
        int cur = __builtin_amdgcn_readfirstlane(*nxtw);
        __syncthreads();
        while (cur < NU_SWA) {
            pre = att_fetch(C, 1);
            const int qb = cur / 24, bh = cur % 24, b = bh / 12, h = bh % 12, kvh = h / 3;
            const bf16* base = C.QKV + (size_t)b * SEQ * QKVW;
            att::attn_unit<64, 1>(shm, base + C_SQ + h * 64, QKVW, base + C_SK + kvh * 64, base + C_SV + kvh * 64, QKVW, C.OALL + (size_t)b * SEQ * 2048 + 768 + h * 64, nullptr, C.swa_sinks[h] * LOG2E, qb);
            if (C.tid == 0) *nxtw = pre;
            __syncthreads();
            cur = __builtin_amdgcn_readfirstlane(*nxtw);
            __syncthreads();
        }
    }
    {
        int pre = att_fetch(C, 2);
        if (C.tid == 0) *nxtw = pre;
        __syncthreads();
        int cur = __builtin_amdgcn_readfirstlane(*nxtw);
        __syncthreads();
        while (cur < NU_XM) {
            pre = att_fetch(C, 2);
            const int qb = cur / 8, bh = cur % 8, b = bh / 4, h = bh % 4;
            const bf16* kb = C.MKV + (size_t)b * NMEM * 1024 + h * 128;
            att::attn_unit<128, 2>(shm, C.QKV + (size_t)b * SEQ * QKVW + C_MQ + h * 128, QKVW, kb, kb + 512, 1024, C.OALL + (size_t)b * SEQ * 2048 + 1536 + h * 128, nullptr, 0.f, qb);
            if (C.tid == 0) *nxtw = pre;
            __syncthreads();
            cur = __builtin_amdgcn_readfirstlane(*nxtw);
            __syncthreads();
        }
    }
}

__device__ __forceinline__ void phase6(const Ctx& C) {
    LAS float* PL = (LAS float*)(C.lds + RING_OFF);
    LAS float* SS = PL + 4 * 64 * 33;
    LAS int* hist = (LAS int*)(SS + 512);
    LAS int* gb = hist + 32;
    const int rg = C.wave & 1, kq = C.wave >> 1, r32 = C.lane & 31, hi = C.lane >> 5;
    const bf16* wh = C.Wr_t + (size_t)r32 * 2048 + 512 * kq + 16 * hi; const bf16* wl = wh + 32 * 2048;
    for (int blk = C.vcu; blk < T / 64; blk += C.G) {
        if (C.tid < 32) hist[C.tid] = 0;
        const int tok = blk * 64 + 32 * rg + r32;
        const float* hr = C.out + (size_t)tok * DM + 512 * kq + 16 * hi;
        f32x16 acc = f32x16{}; float ss = 0.f;
#pragma unroll 2
        for (int kb = 0; kb < 16; ++kb) {
            float f[16];
#pragma unroll
            for (int q = 0; q < 4; ++q) { const f32x4 t = *(const GAS f32x4*)(hr + 32 * kb + 4 * q); f[4 * q] = t.x; f[4 * q + 1] = t.y; f[4 * q + 2] = t.z; f[4 * q + 3] = t.w; }
            unsigned hb[16], lb[16];
#pragma unroll
            for (int q = 0; q < 16; ++q) { ss += f[q] * f[q]; hb[q] = f2bf(f[q]); lb[q] = f2bf(f[q] - __uint_as_float(hb[q] << 16)); }
#pragma unroll
            for (int s = 0; s < 2; ++s) {
                const bf16x8 ah = *(const GAS bf16x8*)(wh + 32 * kb + 8 * s), al = *(const GAS bf16x8*)(wl + 32 * kb + 8 * s);
                v4u bh, bl;
                bh.x = hb[8 * s] | (hb[8 * s + 1] << 16); bh.y = hb[8 * s + 2] | (hb[8 * s + 3] << 16); bh.z = hb[8 * s + 4] | (hb[8 * s + 5] << 16); bh.w = hb[8 * s + 6] | (hb[8 * s + 7] << 16);
                bl.x = lb[8 * s] | (lb[8 * s + 1] << 16); bl.y = lb[8 * s + 2] | (lb[8 * s + 3] << 16); bl.z = lb[8 * s + 4] | (lb[8 * s + 5] << 16); bl.w = lb[8 * s + 6] | (lb[8 * s + 7] << 16);
                acc = __builtin_amdgcn_mfma_f32_32x32x16_bf16(ah, __builtin_bit_cast(bf16x8, bh), acc, 0, 0, 0);
                acc = __builtin_amdgcn_mfma_f32_32x32x16_bf16(ah, __builtin_bit_cast(bf16x8, bl), acc, 0, 0, 0);
                acc = __builtin_amdgcn_mfma_f32_32x32x16_bf16(al, __builtin_bit_cast(bf16x8, bh), acc, 0, 0, 0);
            }
        }
        { LAS float* pr = PL + (size_t)(kq * 64 + 32 * rg + r32) * 33;
#pragma unroll
          for (int r = 0; r < 16; ++r) pr[att::crow(r, hi)] = acc[r];
          SS[(kq * 2 + hi) * 64 + 32 * rg + r32] = ss; }
        __syncthreads();
        int sel[4]; float gt[4]; float rstd = 0.f; int lr[4];
        if (C.tid < 64) {
            float lv[32]; float s2 = 0.f;
#pragma unroll
            for (int q = 0; q < 8; ++q) s2 += SS[q * 64 + C.tid];
            rstd = 1.0f / sqrtf(s2 * (1.f / DM) + NORM_EPS);
#pragma unroll
            for (int e = 0; e < 32; ++e) { const float a = (PL[(0 * 64 + C.tid) * 33 + e] + PL[(1 * 64 + C.tid) * 33 + e]) + (PL[(2 * 64 + C.tid) * 33 + e] + PL[(3 * 64 + C.tid) * 33 + e]); lv[e] = a * rstd + C.b_router[e]; }
            float val[4];
#pragma unroll
            for (int k = 0; k < 4; ++k) { float best = lv[0]; int bi = 0;
#pragma unroll
                for (int e = 1; e < 32; ++e) if (lv[e] > best) { best = lv[e]; bi = e; }
                sel[k] = bi; val[k] = best;
#pragma unroll
                for (int e = 0; e < 32; ++e) lv[e] = (e == bi) ? -INFINITY : lv[e]; }
            float den = 0.f;
#pragma unroll
            for (int k = 0; k < 4; ++k) { gt[k] = __expf(val[k] - val[0]); den += gt[k]; }
            const float inv = 1.0f / den;
#pragma unroll
            for (int k = 0; k < 4; ++k) { gt[k] *= inv; lr[k] = __hip_atomic_fetch_add((LAS int*)(hist + sel[k]), 1, __ATOMIC_RELAXED, __HIP_MEMORY_SCOPE_WORKGROUP); }
        }
        __syncthreads();
        if (C.tid < 32) gb[C.tid] = (int)__hip_atomic_fetch_add((unsigned*)(C.ctl + CW_CNT + C.tid), (unsigned)hist[C.tid], RLX_AGENT);
        __syncthreads();
        if (C.tid < 64) {
            const int t = blk * 64 + C.tid;
#pragma unroll
            for (int k = 0; k < 4; ++k) { const int sl = sel[k] * CAP + gb[sel[k]] + lr[k]; C.TOK[sl] = t; C.RS[sl] = rstd; C.TSLOT[t * 4 + k] = sl; C.TGATE[t * 4 + k] = gt[k]; }
        }
        __syncthreads();
    }
}
template <int NT>
__device__ __forceinline__ void moe_table(const Ctx& C, LAS int* tab) {
    __syncthreads();
    if (C.tid == 0) { int us = 0, rb = 0;
        for (int e = 0; e < 32; ++e) { const int n = (int)__hip_atomic_load((unsigned*)(C.ctl + CW_CNT + e), RLX_AGENT); const int mt = (n + 255) >> 8; tab[e] = us; tab[33 + e] = mt; tab[65 + e] = rb; tab[97 + e] = n; us += mt * NT; rb += mt * 256; }
        tab[32] = us; }
    __syncthreads();
}


__device__ __forceinline__ void phase9(const Ctx& C, const LAS int* tab) {
    const int gw = C.vcu * NWAVES + C.wave, NGW = C.G * NWAVES;
    for (int t = gw; t < T; t += NGW) {
        typedef int v4i_ __attribute__((ext_vector_type(4))); const v4i_ sl = *(const GAS v4i_*)(C.TSLOT + 4 * t); const f32x4 g = *(const GAS f32x4*)(C.TGATE + 4 * t);
        const int s[4] = {sl.x, sl.y, sl.z, sl.w}; const float gg[4] = {g.x, g.y, g.z, g.w};
        const bf16* yr[4];
#pragma unroll
        for (int k = 0; k < 4; ++k) { const int e = s[k] >> 14, rk = s[k] & (CAP - 1); yr[k] = C.Y + (size_t)(tab[65 + e] + rk) * DM + 8 * C.lane; }
        float* orow = C.out + (size_t)t * DM + 8 * C.lane;
#pragma unroll
        for (int j = 0; j < 4; ++j) {
            f32x4 a0 = *(const GAS f32x4*)(orow + 512 * j), a1 = *(const GAS f32x4*)(orow + 512 * j + 4);
#pragma unroll
            for (int k = 0; k < 4; ++k) { const v4u y = *(const GAS v4u*)(yr[k] + 512 * j);
                a0.x += gg[k] * pg8::bf_lo(y.x); a0.y += gg[k] * pg8::bf_hi(y.x); a0.z += gg[k] * pg8::bf_lo(y.y); a0.w += gg[k] * pg8::bf_hi(y.y);
                a1.x += gg[k] * pg8::bf_lo(y.z); a1.y += gg[k] * pg8::bf_hi(y.z); a1.z += gg[k] * pg8::bf_lo(y.w); a1.w += gg[k] * pg8::bf_hi(y.w); }
            *(GAS f32x4*)(orow + 512 * j) = a0; *(GAS f32x4*)(orow + 512 * j + 4) = a1;
        }
    }
}

struct Args { const void* in[26]; float* out; unsigned char* ws; int ph_lo, ph_hi; };
__global__ void __launch_bounds__(NWAVES * 64, 2) mk_fwd(Args args) {
    extern __shared__ __attribute__((aligned(16))) unsigned char lds_raw[];
    Ctx C;
    C.lds = (LAS unsigned char*)lds_raw;
    C.MISC = (volatile LAS unsigned*)(C.lds + MISC_OFF);
    C.tid = threadIdx.x; C.lane = C.tid & 63; C.wave = __builtin_amdgcn_readfirstlane(C.tid >> 6);
    C.G = gridDim.x; { const int bx = blockIdx.x; C.vcu = (C.G % 8 == 0) ? (bx % 8) * (C.G / 8) + bx / 8 : bx; }
    unsigned char* ws = args.ws;
    C.ctl = (gu32*)(ws + WS_CTL);
    C.x = (const float*)args.in[0]; C.mem = (const float*)args.in[1]; C.pos = (const int*)args.in[2]; C.norm_mix = (const float*)args.in[3]; C.w_in = (const float*)args.in[4];
    C.b_forget = (const float*)args.in[5]; C.fox_q_norm = (const float*)args.in[6]; C.fox_k_norm = (const float*)args.in[7]; C.swa_q_norm = (const float*)args.in[8]; C.swa_k_norm = (const float*)args.in[9];
    C.swa_sinks = (const float*)args.in[10]; C.xmem_q_norm = (const float*)args.in[11]; C.xmem_k_norm = (const float*)args.in[12]; C.norm_mem = (const float*)args.in[13]; C.w_mem_kv = (const float*)args.in[14];
    C.w_up_fox = (const float*)args.in[15]; C.w_up_swa = (const float*)args.in[16]; C.w_up_xmem = (const float*)args.in[17]; C.w_out = (const float*)args.in[18]; C.norm_ffn = (const float*)args.in[19];
    C.w_router = (const float*)args.in[20]; C.b_router = (const float*)args.in[21]; C.w_gate_up = (const float*)args.in[22]; C.b_gate_up = (const float*)args.in[23]; C.w_down = (const float*)args.in[24]; C.b_down = (const float*)args.in[25];
    C.out = args.out;
    C.Win_t = (bf16*)(ws + WS_WIN); C.Wmkv_t = (bf16*)(ws + WS_WMKV); C.Wup_t = (bf16*)(ws + WS_WUP); C.Wout_t = (bf16*)(ws + WS_WOUT); C.Wr_t = (bf16*)(ws + WS_WRT); C.Wgu_t = (bf16*)(ws + WS_WGU); C.Wd_t = (bf16*)(ws + WS_WD);
    C.XN = (bf16*)(ws + WS_XN); C.MN = (bf16*)(ws + WS_MN); C.QKV = (bf16*)(ws + WS_QKV); C.G_ = (bf16*)(ws + WS_G); C.MKV = (bf16*)(ws + WS_MKV); C.OALL = (bf16*)(ws + WS_OALL); C.MERGED = (bf16*)(ws + WS_MERGED);
    C.HB = (bf16*)(ws + WS_HB); C.ACT = (bf16*)(ws + WS_ACT); C.LOGF = (float*)(ws + WS_LOGF); C.CNEG = (float*)(ws + WS_CNEG); C.ROPE = (float*)(ws + WS_ROPE); C.GATEW = (float*)(ws + WS_GATE); C.RS = (float*)(ws + WS_RS);
    C.TOK = (int*)(ws + WS_TOK); C.TSLOT = (int*)(ws + WS_TSLOT); C.TGATE = (float*)(ws + WS_TGATE); C.Y = (bf16*)(ws + WS_Y);
    for (int u = C.tid; u < (LDS_BYTES - LDSCTL_OFF) / 4; u += NWAVES * 64) ((LAS unsigned*)(C.lds + LDSCTL_OFF))[u] = 0u;
    __syncthreads();
    XcdBarrier bar; bar.bar = (unsigned*)(C.ctl + CW_BAR); bar.x = 0; bar.st = nullptr;
    if (N_LAUNCHES == 1) bar = xcd_barrier_post((unsigned*)(C.ctl + CW_BAR), C.MISC + 8);
    const int lo = args.ph_lo, hi = args.ph_hi;
#ifndef MK_PHASE_MASK
#define MK_PHASE_MASK 0x3FF
#endif
#define IN(k) ((((MK_PHASE_MASK) >> (k)) & 1) && lo <= (k) && (k) < hi)
#define SEAM(k) do { if (IN(k) && IN((k) + 1)) xcd_barrier(bar); } while (0)
    LAS int* tab = (LAS int*)(C.lds + MOE_OFF);

    if (IN(0)) { phase0(C); }
    SEAM(0);
    if (IN(1)) {
        P1Order S; S.d.init(C.XN, C.Win_t, T, 10240, C.G, (int)blockIdx.x); S.A1 = (const char*)C.MN; S.B1 = (const char*)C.Wmkv_t;
        EpiInProj E{C.QKV, C.G_, C.MKV};
        pg8::gemm_phase<EpiInProj, P1Order>(C.lds + RING_OFF, S, E);
    }
    SEAM(1);
    if (IN(2)) { phase2(C); }
    SEAM(2);
    if (IN(3)) { phase3(C); }
    SEAM(3);
    if (IN(4)) {
        DenseOrder S; S.init(C.OALL, C.Wup_t, T, DM, C.G, (int)blockIdx.x);
        EpiMerge E{C.G_, C.MERGED};
        pg8::gemm_phase<EpiMerge, DenseOrder>(C.lds + RING_OFF, S, E);
    }
    SEAM(4);
    if (IN(5)) {
        DenseOrder S; S.init(C.MERGED, C.Wout_t, T, DM, C.G, (int)blockIdx.x);
        EpiOut E{C.x, C.out, (unsigned char*)C.HB};
        pg8::gemm_phase<EpiOut, DenseOrder>(C.lds + RING_OFF, S, E);
    }
    SEAM(5);
    if (IN(6)) { phase6(C); }
    SEAM(6);
    if (IN(7)) {
        moe_table<16>(C, tab);
        MoeOrder<true, 16, 2048> S{(const char*)C.HB, (const char*)C.Wgu_t, C.TOK, (const int*)(C.ctl + CW_CNT), tab, C.G, C.vcu};
        EpiGateUp E{C.RS, C.b_gate_up, (unsigned char*)C.ACT};
        pg8::gemm_phase<EpiGateUp, MoeOrder<true, 16, 2048>>(C.lds + RING_OFF, S, E);
    }
    SEAM(7);
    if (IN(8)) {
        moe_table<8>(C, tab);
        MoeOrder<false, 8, 2048> S{(const char*)C.ACT, (const char*)C.Wd_t, C.TOK, (const int*)(C.ctl + CW_CNT), tab, C.G, C.vcu};
        EpiDown E{C.b_down, C.Y};
        pg8::gemm_phase<EpiDown, MoeOrder<false, 8, 2048>>(C.lds + RING_OFF, S, E);
    }
    SEAM(8);
    if (IN(9)) { moe_table<8>(C, tab); phase9(C, tab); }
#undef IN
#undef SEAM
}

extern "C" void kernel_launch(void* const* d_in, const int* in_sizes, int n_in, void* d_out, int out_size, void* d_ws, size_t ws_size, hipStream_t stream) {
    static int grid = 0;
    if (grid == 0) {
        if (n_in != 26 || out_size != T * DM || ws_size < WS_END) { fprintf(stderr, "kernel_launch: unexpected problem (n_in %d, out %d, ws %zu < %zu); nothing launched\n", n_in, out_size, ws_size, (size_t)WS_END); grid = -1; return; }
        int dev = 0, cus = 0, per_cu = 0;
        if (hipGetDevice(&dev) != hipSuccess || hipDeviceGetAttribute(&cus, hipDeviceAttributeMultiprocessorCount, dev) != hipSuccess) { grid = -1; return; }
        if (hipFuncSetAttribute((const void*)mk_fwd, hipFuncAttributeMaxDynamicSharedMemorySize, LDS_BYTES) != hipSuccess) { fprintf(stderr, "kernel_launch: hipFuncSetAttribute failed\n"); grid = -1; return; }
        if (hipOccupancyMaxActiveBlocksPerMultiprocessor(&per_cu, (const void*)mk_fwd, NWAVES * 64, LDS_BYTES) != hipSuccess || per_cu < 1) { fprintf(stderr, "kernel_launch: occupancy query says %d\n", per_cu); }
        (void)hipGetLastError();
        grid = cus;
    }
    if (grid < 0) return;
    if (hipMemsetAsync((char*)d_ws + WS_CTL, 0, CTL_ZERO_BYTES, stream) != hipSuccess) return;
    Args a{};
    for (int i = 0; i < 26; ++i) a.in[i] = d_in[i];
    a.out = (float*)d_out; a.ws = (unsigned char*)d_ws;
    if (N_LAUNCHES == 1) { a.ph_lo = 0; a.ph_hi = PER_PHASE; hipLaunchKernelGGL(mk_fwd, dim3(grid), dim3(NWAVES * 64), LDS_BYTES, stream, a); }
    else for (int li = 0; li < PER_PHASE; ++li) { a.ph_lo = li; a.ph_hi = li + 1; hipLaunchKernelGGL(mk_fwd, dim3(grid), dim3(NWAVES * 64), LDS_BYTES, stream, a);
#ifdef PROBE_DUP
        if (li == PROBE_DUP) { if (PROBE_DUP == 3 || PROBE_DUP == 6) hipMemsetAsync((char*)d_ws + WS_CTL, 0, CTL_ZERO_BYTES / 2, stream); hipLaunchKernelGGL(mk_fwd, dim3(grid), dim3(NWAVES * 64), LDS_BYTES, stream, a); }
#endif
    }
    const hipError_t le = hipPeekAtLastError();
    if (le != hipSuccess) fprintf(stderr, "kernel_launch: launch failed: %s\n", hipGetErrorName(le));
}
```

```cpp
#include <hip/hip_runtime.h>
#include <cstdio>
#include <cstdint>

#define LAS __attribute__((address_space(3)))
#define GAS __attribute__((address_space(1)))

namespace pg8 {
typedef unsigned short bf16_t;
typedef short bf16x8 __attribute__((ext_vector_type(8)));
typedef float f32x4 __attribute__((ext_vector_type(4)));
typedef float f32x2 __attribute__((ext_vector_type(2)));
typedef unsigned u32x4 __attribute__((ext_vector_type(4)));
typedef unsigned u32x2 __attribute__((ext_vector_type(2)));
constexpr int BM = 256, BK = 64, HALF = 128, HTB = HALF * BK * 2, STAGE_BYTES = 8 * HTB, NXCD = 8, WGM = 8;
constexpr int KD = 2048;
typedef int v8i __attribute__((ext_vector_type(8))); typedef int v4i __attribute__((ext_vector_type(4)));
__device__ __forceinline__ v8i cat8(bf16x8 lo, bf16x8 hi) { const v4i a = __builtin_bit_cast(v4i, lo), b = __builtin_bit_cast(v4i, hi); return __builtin_shufflevector(a, b, 0, 1, 2, 3, 4, 5, 6, 7); }
__device__ __forceinline__ bf16x8 lo8(v8i v) { return __builtin_bit_cast(bf16x8, (v4i)__builtin_shufflevector(v, v, 0, 1, 2, 3)); }
__device__ __forceinline__ bf16x8 hi8(v8i v) { return __builtin_bit_cast(bf16x8, (v4i)__builtin_shufflevector(v, v, 4, 5, 6, 7)); }

__host__ __device__ __forceinline__ int lds_byte(int r, int c) { const int st = (r >> 4) * 2 + (c >> 5), rr = r & 15, cc = c & 31, ob = rr * 64 + cc * 2; return st * 1024 + (ob ^ (((ob >> 9) & 1) << 5)); }
__host__ __device__ __forceinline__ void stage_rc(int b, int& R, int& C) { const int st = b / 1024, sb = b % 1024, swz = sb ^ (((sb >> 9) & 1) << 5); R = (st >> 1) * 16 + swz / 64; C = (st & 1) * 32 + (swz % 64) / 2; }
__host__ __device__ __forceinline__ int perm32(int rho) { const int n = rho >> 4, i = rho & 15; return 8 * (i >> 2) + 4 * n + (i & 3); }

__device__ __forceinline__ void glds_s(const char* sbase, unsigned voff, unsigned lds_dst) { unsigned keep;
    asm volatile("s_mov_b32 %0, m0\n\ts_mov_b32 m0, %3\n\ts_nop 0\n\tglobal_load_lds_dwordx4 %1, %2\n\ts_mov_b32 m0, %0" : "=&s"(keep) : "v"(voff), "s"(sbase), "s"(lds_dst) : "memory"); }

struct Unit { int pm, pn, e, kind; };

__device__ __forceinline__ unsigned cvt_pk_bf16(float lo, float hi) { unsigned r; asm volatile("v_cvt_pk_bf16_f32 %0, %1, %2" : "=v"(r) : "v"(lo), "v"(hi)); return r; }
__device__ __forceinline__ float bf_lo(unsigned w) { return __uint_as_float(w << 16); }
__device__ __forceinline__ float bf_hi(unsigned w) { return __uint_as_float(w & 0xffff0000u); }

template <class Epi, class Sched, bool ALIGN_EPI = true, bool SP2 = true>
__device__ __forceinline__ void gemm_phase(LAS unsigned char* lds, const Sched& S, const Epi& E) {
    const int tid = threadIdx.x, wid = __builtin_amdgcn_readfirstlane(tid >> 6), lane = tid & 63, wr = wid >> 2, wc = wid & 3, fr = lane & 15, fq = lane >> 4;
    constexpr bool FP8 = Epi::FP8; constexpr int RB = FP8 ? 2048 : 4096, nt = RB / 128;
    unsigned voffB[2]; int RA[2], CA[2];
#pragma unroll
    for (int i = 0; i < 2; ++i) { int R, C; stage_rc(tid * 16 + i * 8192, R, C); const int Rb = Epi::PERM ? ((R & ~31) + perm32(R & 31)) : R;
        voffB[i] = (unsigned)(Rb * RB + C * 2); RA[i] = R; CA[i] = C; }
    constexpr size_t kstep = (size_t)(BK * 2);
    constexpr size_t hstep = (size_t)HALF * RB;
    const unsigned ldsbase = (unsigned)__builtin_amdgcn_readfirstlane((unsigned)(uintptr_t)lds + (unsigned)wid * 1024u);
    const int aoff = lds_byte(wr * 64 + fr, fq * 8), boff = lds_byte(wc * 32 + fr, fq * 8);
#define PG8_SA(b, h) (((b) * 2 + (h)) * HTB)
#define PG8_SB(b, h) ((4 + (b) * 2 + (h)) * HTB)
#define PG8_STAGE(bufoff, gbase, voff) do { _Pragma("unroll") for (int _i = 0; _i < 2; ++_i) \
        glds_s((const char*)(gbase), (voff)[_i], ldsbase + (unsigned)((bufoff) + _i * 8192)); } while (0)
#define PG8_LDA(dst, b, h) do { _Pragma("unroll") for (int m = 0; m < 4; ++m) dst[m] = cat8(*(const LAS bf16x8*)(lds + PG8_SA(b, h) + aoff + m * 2048), *(const LAS bf16x8*)(lds + PG8_SA(b, h) + aoff + m * 2048 + 1024)); } while (0)
#define PG8_LDB(dst, b, h) do { _Pragma("unroll") for (int n = 0; n < 2; ++n) dst[n] = cat8(*(const LAS bf16x8*)(lds + PG8_SB(b, h) + boff + n * 2048), *(const LAS bf16x8*)(lds + PG8_SB(b, h) + boff + n * 2048 + 1024)); } while (0)
#define PG8_MMA(ai, bj, At, Bt) do { __builtin_amdgcn_s_setprio(1); _Pragma("unroll") for (int m = 0; m < 4; ++m) _Pragma("unroll") for (int n = 0; n < 2; ++n) { \
        if constexpr (FP8) asm volatile("v_mfma_scale_f32_16x16x128_f8f6f4 %0, %1, %2, %0, %3, %4 op_sel_hi:[0,0,0]" : "+v"(acc[ai][bj][m][n]) : "v"(Bt[n]), "v"(At[m]), "v"(scl_b), "v"(scl_a)); \
        else { acc[ai][bj][m][n] = __builtin_amdgcn_mfma_f32_16x16x32_bf16(lo8(Bt[n]), lo8(At[m]), acc[ai][bj][m][n], 0, 0, 0); \
               acc[ai][bj][m][n] = __builtin_amdgcn_mfma_f32_16x16x32_bf16(hi8(Bt[n]), hi8(At[m]), acc[ai][bj][m][n], 0, 0, 0); } } \
        __builtin_amdgcn_s_setprio(0); } while (0)
#define PG8_WAIT_V(n) asm volatile("s_waitcnt vmcnt(" #n ")" ::: "memory")
#define PG8_WAIT_L(n) asm volatile("s_waitcnt lgkmcnt(" #n ")" ::: "memory")
#define PG8_BAR __builtin_amdgcn_s_barrier()
#define PG8_SCHED __builtin_amdgcn_sched_barrier(0)
    Unit cur, nxt; int ui = 0;
    int scl_a = Epi::SCALE_A, scl_b = Epi::SCALE_B; asm volatile("" : "+v"(scl_a), "+v"(scl_b));
    if (!S.next(0, cur)) return;
    f32x4 acc[2][2][4][2];
#pragma unroll
    for (int a = 0; a < 2; ++a)
#pragma unroll
        for (int b = 0; b < 2; ++b)
#pragma unroll
            for (int m = 0; m < 4; ++m)
#pragma unroll
                for (int n = 0; n < 2; ++n) acc[a][b][m][n] = (f32x4){0.f, 0.f, 0.f, 0.f};
    v8i At[4], B0[2], B1[2];
    const char* cA = S.a_base(cur); const char* cB = S.b_base(cur);
    unsigned vo[2][2], nvo[2][2];
    S.a_offs(cur, RA, CA, vo);
    bool has_next = S.next(1, nxt);
    if (has_next) S.a_offs(nxt, RA, CA, nvo); else { nvo[0][0] = vo[0][0]; nvo[0][1] = vo[0][1]; nvo[1][0] = vo[1][0]; nvo[1][1] = vo[1][1]; }
    if constexpr (SP2) {
        PG8_STAGE(PG8_SB(0, 0), cB, voffB); PG8_STAGE(PG8_SB(0, 1), cB + hstep, voffB); PG8_STAGE(PG8_SA(0, 0), cA, vo[0]); PG8_STAGE(PG8_SA(0, 1), cA, vo[1]);
        if (wr == 1) PG8_BAR;
        PG8_WAIT_V(2); PG8_BAR;
        PG8_STAGE(PG8_SB(1, 0), cB + kstep, voffB); PG8_STAGE(PG8_SA(1, 0), cA + kstep, vo[0]); PG8_STAGE(PG8_SB(1, 1), cB + hstep + kstep, voffB);
        PG8_WAIT_V(6); PG8_BAR;
    } else {
        PG8_STAGE(PG8_SB(0, 0), cB, voffB); PG8_STAGE(PG8_SA(0, 0), cA, vo[0]); PG8_STAGE(PG8_SB(0, 1), cB + hstep, voffB); PG8_STAGE(PG8_SA(0, 1), cA, vo[1]);
        if (wr == 1) PG8_BAR;
        PG8_WAIT_V(4); PG8_BAR;
        PG8_STAGE(PG8_SB(1, 0), cB + kstep, voffB); PG8_STAGE(PG8_SA(1, 0), cA + kstep, vo[0]); PG8_STAGE(PG8_SB(1, 1), cB + hstep + kstep, voffB);
        PG8_WAIT_V(6); PG8_BAR;
    }
    for (;;) {
        const char* nA = has_next ? S.a_base(nxt) : cA; const char* nB = has_next ? S.b_base(nxt) : cB;
        for (int t = 0; t < nt; t += 2) {
            const bool last = (t == nt - 2);
            const char* a1 = cA + (size_t)(t + 1) * kstep;
            const char* a2 = last ? nA : cA + (size_t)(t + 2) * kstep; const char* b2 = last ? nB : cB + (size_t)(t + 2) * kstep;
            const char* a3 = a2 + kstep; const char* b3 = b2 + kstep;
            unsigned v2[2][2];
            v2[0][0] = last ? nvo[0][0] : vo[0][0]; v2[0][1] = last ? nvo[0][1] : vo[0][1]; v2[1][0] = last ? nvo[1][0] : vo[1][0]; v2[1][1] = last ? nvo[1][1] : vo[1][1];
            if constexpr (SP2) {
            PG8_LDB(B0, 0, 0); PG8_LDB(B1, 0, 1); PG8_SCHED; PG8_LDA(At, 0, 0); PG8_STAGE(PG8_SA(1, 1), a1, vo[1]);
            PG8_WAIT_V(8); PG8_WAIT_L(0); PG8_BAR; PG8_MMA(0, 0, At, B0); PG8_MMA(0, 1, At, B1); PG8_BAR; PG8_SCHED;
            PG8_LDA(At, 0, 1); PG8_STAGE(PG8_SB(0, 0), b2, voffB); PG8_STAGE(PG8_SB(0, 1), b2 + hstep, voffB); PG8_STAGE(PG8_SA(0, 0), a2, v2[0]);
            PG8_WAIT_V(8); PG8_WAIT_L(0); PG8_BAR; PG8_MMA(1, 0, At, B0); PG8_MMA(1, 1, At, B1); PG8_BAR; PG8_SCHED;
            PG8_LDB(B0, 1, 0); PG8_LDB(B1, 1, 1); PG8_SCHED; PG8_LDA(At, 1, 0); PG8_STAGE(PG8_SA(0, 1), a2, v2[1]);
            PG8_WAIT_V(8); PG8_WAIT_L(0); PG8_BAR; PG8_MMA(0, 0, At, B0); PG8_MMA(0, 1, At, B1); PG8_BAR; PG8_SCHED;
            PG8_LDA(At, 1, 1); PG8_STAGE(PG8_SB(1, 0), b3, voffB); PG8_STAGE(PG8_SB(1, 1), b3 + hstep, voffB); PG8_STAGE(PG8_SA(1, 0), a3, v2[0]);
            PG8_WAIT_V(8); PG8_WAIT_L(0); PG8_BAR; PG8_MMA(1, 0, At, B0); PG8_MMA(1, 1, At, B1); PG8_BAR; PG8_SCHED;
            } else {
            PG8_LDB(B0, 0, 0); PG8_SCHED; PG8_LDA(At, 0, 0); PG8_STAGE(PG8_SA(1, 1), a1, vo[1]);
            PG8_WAIT_L(8); PG8_BAR; PG8_WAIT_L(0); PG8_MMA(0, 0, At, B0); PG8_BAR; PG8_SCHED;
            PG8_LDB(B1, 0, 1); PG8_STAGE(PG8_SB(0, 0), b2, voffB);
            PG8_BAR; PG8_WAIT_L(0); PG8_MMA(0, 1, At, B1); PG8_BAR;
            PG8_LDA(At, 0, 1); PG8_STAGE(PG8_SA(0, 0), a2, v2[0]);
            PG8_BAR; PG8_WAIT_L(0); PG8_MMA(1, 0, At, B0); PG8_BAR; PG8_SCHED;
            PG8_STAGE(PG8_SB(0, 1), b2 + hstep, voffB);
            PG8_WAIT_V(6); PG8_BAR; PG8_MMA(1, 1, At, B1); PG8_BAR;
            PG8_LDB(B0, 1, 0); PG8_SCHED; PG8_LDA(At, 1, 0); PG8_STAGE(PG8_SA(0, 1), a2, v2[1]);
            PG8_WAIT_L(8); PG8_BAR; PG8_WAIT_L(0); PG8_MMA(0, 0, At, B0); PG8_BAR; PG8_SCHED;
            PG8_LDB(B1, 1, 1); PG8_STAGE(PG8_SB(1, 0), b3, voffB);
            PG8_BAR; PG8_WAIT_L(0); PG8_MMA(0, 1, At, B1); PG8_BAR;
            PG8_LDA(At, 1, 1); PG8_STAGE(PG8_SA(1, 0), a3, v2[0]);
            PG8_BAR; PG8_WAIT_L(0); PG8_MMA(1, 0, At, B0); PG8_BAR; PG8_SCHED;
            PG8_STAGE(PG8_SB(1, 1), b3 + hstep, voffB);
            PG8_WAIT_V(6); PG8_BAR; PG8_MMA(1, 1, At, B1); PG8_BAR;
            }
            if constexpr (Epi::MID) { if (t == 10 || t == 22) E.mid(acc, cur, t == 22 ? 1 : 0, wr, wc, fr, fq); }
        }
        Unit nn; const bool has_nn = has_next && S.next(ui + 2, nn); unsigned nnvo[2][2];
        if (has_nn) S.a_offs(nn, RA, CA, nnvo); else { nnvo[0][0] = nvo[0][0]; nnvo[0][1] = nvo[0][1]; nnvo[1][0] = nvo[1][0]; nnvo[1][1] = nvo[1][1]; }
        if constexpr (ALIGN_EPI) { if (wr == 0) PG8_BAR; }
        if constexpr (FP8) asm volatile("s_nop 15\n\ts_nop 7" ::: "memory");
        E(acc, cur, wr, wc, fr, fq);
        if (!has_next) break;
#pragma unroll
        for (int a = 0; a < 2; ++a)
#pragma unroll
            for (int b = 0; b < 2; ++b)
#pragma unroll
                for (int m = 0; m < 4; ++m)
#pragma unroll
                    for (int n = 0; n < 2; ++n) acc[a][b][m][n] = (f32x4){0.f, 0.f, 0.f, 0.f};
        cur = nxt; cA = nA; cB = nB; ++ui; nxt = nn; has_next = has_nn;
        vo[0][0] = nvo[0][0]; vo[0][1] = nvo[0][1]; vo[1][0] = nvo[1][0]; vo[1][1] = nvo[1][1];
        nvo[0][0] = nnvo[0][0]; nvo[0][1] = nnvo[0][1]; nvo[1][0] = nnvo[1][0]; nvo[1][1] = nnvo[1][1];
        if constexpr (ALIGN_EPI) { if (wr == 1) PG8_BAR; }
    }
    PG8_WAIT_V(0);
    if constexpr (!ALIGN_EPI) { if (wr == 0) PG8_BAR; }
    PG8_BAR;
#undef PG8_SA
#undef PG8_SB
#undef PG8_STAGE
#undef PG8_LDA
#undef PG8_LDB
#undef PG8_MMA
#undef PG8_WAIT_V
#undef PG8_WAIT_L
#undef PG8_BAR
#undef PG8_SCHED
}
}

constexpr int NWAVES = 8;
constexpr int BATCH = 2, SEQ = 8192, DM = 2048, T = BATCH * SEQ;
constexpr int NMEM = 256, MROWS = BATCH * NMEM;
constexpr int INW = 10252;
constexpr int NEXP = 32, TOPK = 4, CAP = T;
constexpr int QKVW = 4096;
constexpr int C_FQ = 0, C_FK = 768, C_FV = 1536, C_SQ = 2304, C_SK = 3072, C_SV = 3328, C_MQ = 3584;
constexpr int GW = 6144;
constexpr float NORM_EPS = 1e-6f;
constexpr float LOG2E = 1.4426950408889634f;
constexpr float SWIGLU_LIMIT = 7.0f, SWIGLU_ALPHA = 1.702f;
constexpr int PER_PHASE = 10;
#ifndef MK_N_LAUNCHES
#define MK_N_LAUNCHES 1
#endif
constexpr int N_LAUNCHES = MK_N_LAUNCHES;

constexpr size_t MiB = 1u << 20;
constexpr size_t WS_CTL = 0, CTL_ZERO_BYTES = 1 * MiB;
constexpr size_t WS_WIN   = 2 * MiB;
constexpr size_t WS_WMKV  = WS_WIN + 40 * MiB;
constexpr size_t WS_WUP   = WS_WMKV + 4 * MiB;
constexpr size_t WS_WOUT  = WS_WUP + 8 * MiB;
constexpr size_t WS_WRT   = WS_WOUT + 8 * MiB;
constexpr size_t WS_WGU   = WS_WRT + 1 * MiB;
constexpr size_t WS_WD    = WS_WGU + 512 * MiB;
constexpr size_t WS_XN    = WS_WD + 256 * MiB;
constexpr size_t WS_MN    = WS_XN + 64 * MiB;
constexpr size_t WS_LOGF  = WS_MN + 2 * MiB;
constexpr size_t WS_CNEG  = WS_LOGF + 1 * MiB;
constexpr size_t WS_ROPE  = WS_CNEG + 1 * MiB;
constexpr size_t WS_QKV   = WS_ROPE + 4 * MiB;
constexpr size_t WS_G     = WS_QKV + 128 * MiB;
constexpr size_t WS_MKV   = WS_G + 192 * MiB;
constexpr size_t WS_OALL  = WS_MKV + 1 * MiB;
constexpr size_t WS_MERGED= WS_OALL + 64 * MiB;
constexpr size_t WS_HB    = WS_MERGED + 64 * MiB;
constexpr size_t WS_TOK   = WS_HB + 64 * MiB;
constexpr size_t WS_GATE  = WS_TOK + 2 * MiB;
constexpr size_t WS_RS    = WS_GATE + 2 * MiB;
constexpr size_t WS_ACT   = WS_RS + 2 * MiB;
constexpr size_t WS_Y     = WS_ACT + 288 * MiB;
constexpr size_t WS_TSLOT = WS_Y + 288 * MiB;
constexpr size_t WS_TGATE = WS_TSLOT + 1 * MiB;
constexpr size_t WS_END   = WS_TGATE + 1 * MiB;
constexpr int CW_BAR = 4096;
constexpr int CW_QHEAD = 64;
constexpr int CW_CNT = 512;

typedef unsigned short bf16;
typedef unsigned v4u __attribute__((ext_vector_type(4)));
typedef unsigned v2u __attribute__((ext_vector_type(2)));
typedef float f32x4 __attribute__((ext_vector_type(4)));
typedef float f32x16 __attribute__((ext_vector_type(16)));
typedef short bf16x8 __attribute__((ext_vector_type(8)));
typedef short s16x4 __attribute__((ext_vector_type(4)));
typedef GAS unsigned gu32;
#define RLX_AGENT __ATOMIC_RELAXED, __HIP_MEMORY_SCOPE_AGENT
#define LDS_WAIT() asm volatile("s_waitcnt lgkmcnt(0)" ::: "memory")
#define VM_WAIT() asm volatile("s_waitcnt vmcnt(0)" ::: "memory")
__device__ __forceinline__ unsigned f2bf(float f) { unsigned u = __builtin_bit_cast(unsigned, f); return (u + 0x7fffu + ((u >> 16) & 1u)) >> 16; }
__device__ __forceinline__ unsigned pk2(float lo, float hi) { return f2bf(lo) | (f2bf(hi) << 16); }
__device__ __forceinline__ float bf2f(unsigned short b) { return __uint_as_float(((unsigned)b) << 16); }
__device__ __forceinline__ float wave_sum(float v) {
#pragma unroll
    for (int o = 1; o < 64; o <<= 1) v += __shfl_xor(v, o);
    return v;
}
__device__ __forceinline__ float sigmoidf_(float x) { return 1.0f / (1.0f + __expf(-x)); }

constexpr int H8_SHIFT = 4, ACT8_SHIFT = 2, W8_SHIFT = 9;
constexpr float H8_MUL = 16.0f, ACT8_MUL = 4.0f, W8_MUL = 512.0f;
__device__ __forceinline__ float clamp_fp8(float v) { return __builtin_amdgcn_fmed3f(v, -448.0f, 448.0f); }
__device__ __forceinline__ unsigned pk4_fp8(float a, float b, float c, float d) {
    int p = __builtin_amdgcn_cvt_pk_fp8_f32(clamp_fp8(a), clamp_fp8(b), 0, false); p = __builtin_amdgcn_cvt_pk_fp8_f32(clamp_fp8(c), clamp_fp8(d), p, true); return (unsigned)p; }
using pg8::f32x2; using pg8::u32x4; using pg8::u32x2; using pg8::cvt_pk_bf16; using pg8::bf_lo; using pg8::bf_hi;

#define XB_TMO      128
#define XB_XCNT(j)  (256  + 64 * (j))
#define XB_XSUB(j)  (1280 + 64 * (j))
#define XB_XGEN(j)  (2304 + 64 * (j))
#define XB_TOP      3328
#define XB_TOPGEN   3392
#define XCD_BAR_WORDS 3456
#define XB_SPIN_CAP (1u << 18)

__device__ __forceinline__ unsigned xb_ld(unsigned* p)              { return __hip_atomic_load(p, __ATOMIC_RELAXED, __HIP_MEMORY_SCOPE_AGENT); }
__device__ __forceinline__ unsigned xb_add(unsigned* p, unsigned v) { return __hip_atomic_fetch_add(p, v, __ATOMIC_RELAXED, __HIP_MEMORY_SCOPE_AGENT); }
__device__ __forceinline__ unsigned xb_xcc_id() { return (unsigned)__builtin_amdgcn_s_getreg((3 << 11) | 20) & 0xFu; }
#define XB_SPIN(cond, bar) do { unsigned _sp = 0; while (cond) { __builtin_amdgcn_s_sleep(1); \
    if ((++_sp & 255u) == 0u) { if (xb_ld(&(bar)[XB_TMO])) break; if (_sp > XB_SPIN_CAP) { atomicAdd(&(bar)[XB_TMO], 1u); break; } } } } while (0)

struct XcdBarrier { unsigned* bar; unsigned x; volatile LAS unsigned* st; };

__device__ __forceinline__ XcdBarrier xcd_barrier_post(unsigned* bar, volatile LAS unsigned* st) {
    XcdBarrier b; b.bar = bar; b.x = xb_xcc_id(); b.st = st;
    if (threadIdx.x == 0) (void)xb_add(&bar[XB_XCNT(b.x)], 1u);
    return b;
}
__device__ __forceinline__ void xcd_barrier_complete(unsigned* bar, unsigned x, unsigned& nloc, unsigned& nx) {
    const unsigned G = gridDim.x * gridDim.y * gridDim.z;
    unsigned sum, cnt, mine, sp = 0u;
    for (;;) {
        sum = 0u; cnt = 0u; mine = 0u;
#pragma unroll
        for (unsigned j = 0; j < 16; ++j) { const unsigned c = xb_ld(&bar[XB_XCNT(j)]); sum += c; cnt += (c > 0u) ? 1u : 0u; mine = (j == x) ? c : mine; }
        if (sum == G) break;
        __builtin_amdgcn_s_sleep(1);
        if ((++sp & 255u) == 0u) { if (xb_ld(&bar[XB_TMO])) break; if (sp > XB_SPIN_CAP) { atomicAdd(&bar[XB_TMO], 1u); break; } }
    }
    nloc = mine > 0u ? mine : 1u; nx = cnt > 0u ? cnt : 1u;
}
__device__ __forceinline__ void xcd_barrier(const XcdBarrier& b) {
    asm volatile("s_waitcnt vmcnt(0)" ::: "memory");
    __syncthreads();
    if (threadIdx.x == 0) {
        unsigned* bar = b.bar;
        __builtin_amdgcn_s_waitcnt(0);
        unsigned nloc = b.st[0], nx = b.st[1];
        if (nloc == 0u) { xcd_barrier_complete(bar, b.x, nloc, nx); b.st[0] = nloc; b.st[1] = nx; }
        const unsigned old = xb_add(&bar[XB_XSUB(b.x)], 1u);
        const unsigned gen = old / nloc;
        if (old + 1u == (gen + 1u) * nloc) {
            __builtin_amdgcn_fence(__ATOMIC_RELEASE, "agent");
            asm volatile("s_waitcnt vmcnt(0)" ::: "memory");
            const unsigned og = xb_add(&bar[XB_TOP], 1u);
            const unsigned tg = og / nx;
            if (og + 1u == (tg + 1u) * nx) xb_add(&bar[XB_TOPGEN], 1u);
            else XB_SPIN(xb_ld(&bar[XB_TOPGEN]) == tg, bar);
            __builtin_amdgcn_fence(__ATOMIC_ACQUIRE, "agent");
            xb_add(&bar[XB_XGEN(b.x)], 1u);
            asm volatile("s_waitcnt vmcnt(0)" ::: "memory");
        } else {
            XB_SPIN(xb_ld(&bar[XB_XGEN(b.x)]) == gen, bar);
            __builtin_amdgcn_fence(__ATOMIC_ACQUIRE, "agent");
            asm volatile("s_waitcnt vmcnt(0)" ::: "memory");
        }
    }
    __syncthreads();
}

constexpr int RING_OFF = 0, RING_BYTES = 131072;
constexpr int LDSCTL_OFF = RING_BYTES, MISC_OFF = LDSCTL_OFF + 320;
constexpr int MOE_OFF = MISC_OFF + 128;
constexpr int LDS_BYTES = 147456;

struct Ctx {
    LAS unsigned char* lds;
    volatile LAS unsigned* MISC;
    gu32* ctl;
    int tid, lane, wave, vcu, G;
    const float *x, *mem; const int* pos; const float *norm_mix, *w_in, *b_forget, *fox_q_norm, *fox_k_norm, *swa_q_norm, *swa_k_norm, *swa_sinks, *xmem_q_norm, *xmem_k_norm, *norm_mem,
        *w_mem_kv, *w_up_fox, *w_up_swa, *w_up_xmem, *w_out, *norm_ffn, *w_router, *b_router, *w_gate_up, *b_gate_up, *w_down, *b_down;
    float* out;
    bf16 *Win_t, *Wmkv_t, *Wup_t, *Wout_t, *Wr_t, *Wgu_t, *Wd_t, *XN, *MN, *QKV, *G_, *MKV, *OALL, *MERGED, *HB, *ACT;
    float *LOGF, *CNEG, *ROPE, *GATEW, *RS, *TGATE; int *TOK, *TSLOT; bf16* Y;
};

__constant__ float INV_FREQ[32] = {1.000000000e+00f, 7.498942614e-01f, 5.623413324e-01f, 4.216965139e-01f, 3.162277639e-01f, 2.371373773e-01f, 1.778279394e-01f, 1.333521307e-01f,
    1.000000015e-01f, 7.498941571e-02f, 5.623413250e-02f, 4.216965288e-02f, 3.162277490e-02f, 2.371373773e-02f, 1.778279431e-02f, 1.333521493e-02f, 9.999999776e-03f, 7.498941850e-03f,
    5.623413250e-03f, 4.216964822e-03f, 3.162277630e-03f, 2.371373586e-03f, 1.778279431e-03f, 1.333521446e-03f, 1.000000047e-03f, 7.498942432e-04f, 5.623413017e-04f, 4.216965172e-04f,
    3.162277571e-04f, 2.371373703e-04f, 1.778279402e-04f, 1.333521504e-04f};

struct TItem { const float* src; const float* ksc; bf16* dst; size_t ldw; int f8; };
__device__ __forceinline__ void titem_load(const TItem& I, f32x4 (&v)[8][2], float (&sc)[8][2], int lane) {
    const int rr = lane >> 4, c4 = lane & 15;
#pragma unroll
    for (int p = 0; p < 8; ++p)
#pragma unroll
        for (int h = 0; h < 2; ++h) { const int k = 8 * p + 2 * rr + h; v[p][h] = *(const GAS f32x4*)(I.src + (size_t)k * I.ldw + 4 * c4); sc[p][h] = I.ksc ? I.ksc[k] : 1.0f; }
}
__device__ __forceinline__ void titem_store(const TItem& I, const f32x4 (&v)[8][2], const float (&sc)[8][2], LAS unsigned* tile, int lane) {
    const int rr = lane >> 4, c4 = lane & 15;
#pragma unroll
    for (int p = 0; p < 8; ++p)
#pragma unroll
        for (int q = 0; q < 4; ++q) { const int n = 4 * c4 + q, sw = (n ^ (n >> 3)) & 7;
            tile[n * 32 + 4 * (p ^ sw) + rr] = pg8::cvt_pk_bf16(v[p][0][q] * sc[p][0], v[p][1][q] * sc[p][1]); }
    LDS_WAIT(); asm volatile("" ::: "memory");
#pragma unroll
    for (int j = 0; j < 8; ++j) { const int n = 8 * j + (lane >> 3), c = lane & 7, sw = (n ^ (n >> 3)) & 7;
        const v4u o = *(const LAS v4u*)(tile + n * 32 + 4 * (c ^ sw));
        *(GAS v4u*)(I.dst + (size_t)n * DM + 8 * c) = o; }
    LDS_WAIT(); asm volatile("" ::: "memory");
}
__device__ __forceinline__ void titem8_load(const TItem& I, f32x4 (&v)[8][2], float (&sc)[8][2], int lane) {
    const int rr = lane >> 4, c4 = lane & 15;
#pragma unroll
    for (int p = 0; p < 4; ++p)
#pragma unroll
        for (int h = 0; h < 4; ++h) { const int k = 16 * p + 4 * rr + h; v[2 * p + (h >> 1)][h & 1] = *(const GAS f32x4*)(I.src + (size_t)k * I.ldw + 4 * c4); sc[2 * p + (h >> 1)][h & 1] = (I.ksc ? I.ksc[k] : 1.0f) * W8_MUL; }
}
__device__ __forceinline__ void titem8_store(const TItem& I, const f32x4 (&v)[8][2], const float (&sc)[8][2], LAS unsigned* tile, int lane) {
    const int rr = lane >> 4, c4 = lane & 15;
#pragma unroll
    for (int p = 0; p < 4; ++p)
#pragma unroll
        for (int q = 0; q < 4; ++q) { const int n = 4 * c4 + q, sw = (n >> 2) & 3;
            tile[n * 16 + 4 * (p ^ sw) + rr] = pk4_fp8(v[2 * p][0][q] * sc[2 * p][0], v[2 * p][1][q] * sc[2 * p][1], v[2 * p + 1][0][q] * sc[2 * p + 1][0], v[2 * p + 1][1][q] * sc[2 * p + 1][1]); }
    LDS_WAIT(); asm volatile("" ::: "memory");
#pragma unroll
    for (int j = 0; j < 4; ++j) { const int n = 16 * j + (lane >> 2), c = lane & 3, sw = (n >> 2) & 3;
        const v4u o = *(const LAS v4u*)(tile + n * 16 + 4 * (c ^ sw));
        *(GAS v4u*)((unsigned char*)I.dst + (size_t)n * DM + 16 * c) = o; }
    LDS_WAIT(); asm volatile("" ::: "memory");
}
__device__ __forceinline__ void p0_router_item(const float* W, int k0, bf16* WT, const float* ksc, LAS float* scr, int lane) {
#pragma unroll 8
    for (int i = 0; i < 32; ++i) { const int kk = 2 * i + (lane >> 5); scr[kk * 33 + (lane & 31)] = W[(size_t)(k0 + kk) * 32 + (lane & 31)] * ksc[k0 + kk]; }
    LDS_WAIT(); asm volatile("" ::: "memory");
    const int c = lane & 7;
#pragma unroll
    for (int j = 0; j < 4; ++j) { const int n = (lane >> 3) + 8 * j; const LAS float* s = scr + (8 * c) * 33 + n;
        unsigned h[8], l[8];
#pragma unroll
        for (int q = 0; q < 8; ++q) { const float v = s[q * 33]; h[q] = f2bf(v); l[q] = f2bf(v - __uint_as_float(h[q] << 16)); }
        v4u oh, ol; oh.x = h[0] | (h[1] << 16); oh.y = h[2] | (h[3] << 16); oh.z = h[4] | (h[5] << 16); oh.w = h[6] | (h[7] << 16);
        ol.x = l[0] | (l[1] << 16); ol.y = l[2] | (l[3] << 16); ol.z = l[4] | (l[5] << 16); ol.w = l[6] | (l[7] << 16);
        *(GAS v4u*)(WT + (size_t)n * 2048 + k0 + 8 * c) = oh; *(GAS v4u*)(WT + (size_t)(32 + n) * 2048 + k0 + 8 * c) = ol; }
    LDS_WAIT(); asm volatile("" ::: "memory");
}
__device__ __forceinline__ float log_sigmoidf_(float z) { return fminf(z, 0.f) - log1pf(__expf(-fabsf(z))); }

template <bool XROW>
__device__ __forceinline__ void p0_norm_row(const Ctx& C, const float* xrow, const float* gain, bf16* orow, const LAS float* Wf, int m) {
    const GAS f32x4* xr = (const GAS f32x4*)xrow + C.lane; const GAS f32x4* gr = (const GAS f32x4*)gain + C.lane;
    f32x4 v[8]; float s = 0.f;
#pragma unroll
    for (int j = 0; j < 8; ++j) { v[j] = xr[64 * j]; s += (v[j].x * v[j].x + v[j].y * v[j].y) + (v[j].z * v[j].z + v[j].w * v[j].w); }
    const float rstd = 1.0f / sqrtf(wave_sum(s) * (1.f / DM) + NORM_EPS);
    GAS unsigned long long* o8 = (GAS unsigned long long*)orow + C.lane;
#pragma unroll
    for (int j = 0; j < 8; ++j) { const f32x4 g = gr[64 * j]; v[j] = (v[j] * rstd) * g;
        o8[64 * j] = (unsigned long long)pk2(v[j].x, v[j].y) | ((unsigned long long)pk2(v[j].z, v[j].w) << 32); }
    if constexpr (XROW) {
        float mine = 0.f;
#pragma unroll 1
        for (int h = 0; h < 12; ++h) { const LAS f32x4* w = (const LAS f32x4*)(Wf + h * 2048) + C.lane; float d = 0.f;
#pragma unroll
            for (int j = 0; j < 8; ++j) { const f32x4 ww = w[64 * j]; d += (v[j].x * ww.x + v[j].y * ww.y) + (v[j].z * ww.z + v[j].w * ww.w); }
            d = wave_sum(d); if (C.lane == h) mine = d; }
        const int b = m / SEQ, t = m % SEQ;
        if (C.lane < 12) C.LOGF[(size_t)(b * 12 + C.lane) * SEQ + t] = log_sigmoidf_(mine + C.b_forget[C.lane]);
        if (C.lane < 32) { const float ang = (float)C.pos[m] * INV_FREQ[C.lane]; const double rev = (double)ang * 0.15915494309189535; const float fr = (float)(rev - floor(rev));
            C.ROPE[(size_t)m * 64 + C.lane] = __builtin_amdgcn_cosf(fr); C.ROPE[(size_t)m * 64 + 32 + C.lane] = __builtin_amdgcn_sinf(fr); }
    }
}
__device__ __forceinline__ void phase0(const Ctx& C) {
    LAS float* Wf = (LAS float*)(C.lds + RING_OFF);
    for (int idx = C.tid; idx < 12 * 2048; idx += NWAVES * 64) { const int k = idx / 12, h = idx - 12 * k; Wf[h * 2048 + k] = C.w_in[(size_t)k * INW + 2304 + h]; }
    __syncthreads();
    const int gw = C.vcu * NWAVES + C.wave, NGW = C.G * NWAVES;
    for (int m = gw; m < T; m += NGW) p0_norm_row<true>(C, C.x + (size_t)m * DM, C.norm_mix, C.XN + (size_t)m * DM, Wf, m);
    for (int m = gw; m < MROWS; m += NGW) p0_norm_row<false>(C, C.mem + (size_t)m * DM, C.norm_mem, C.MN + (size_t)m * DM, Wf, m);
    __syncthreads();
    LAS float* scr = (LAS float*)(C.lds + RING_OFF + C.wave * 16384);
    for (int r = gw; r < 32; r += NGW) p0_router_item(C.w_router, 64 * r, C.Wr_t, C.norm_ffn, scr, C.lane);
    constexpr int I_GU = 32 * 32 * 64, I_D = 32 * 32 * 32, I_IN = 32 * 160, I_MKV = 32 * 16, I_UF = 12 * 32, I_US = 12 * 32, I_UX = 8 * 32, I_O = 32 * 32;
    constexpr int NITEMS = I_GU + I_D + I_IN + I_MKV + I_UF + I_US + I_UX + I_O;
    auto decode = [&](int it) -> TItem {
        TItem I; int r = it; I.ksc = nullptr; I.f8 = 0;
        if (r < I_GU) { const int e = r / 2048, q = r % 2048, kb = q / 64, pb = q % 64, tl = pb >> 2, jb = pb & 3;
            const int n0 = (jb < 2) ? (128 * tl + 64 * jb) : (2048 + 128 * tl + 64 * (jb - 2));
            I.ldw = 4096; I.src = C.w_gate_up + (size_t)e * DM * 4096 + (size_t)(64 * kb) * 4096 + n0; I.ksc = C.norm_ffn + 64 * kb; I.f8 = 1; I.dst = (bf16*)((unsigned char*)C.Wgu_t + ((size_t)e * 4096 + 64 * pb) * DM + 64 * kb); return I; } r -= I_GU;
        if (r < I_D) { const int e = r / 1024, q = r % 1024, kb = q / 32, nb = q % 32;
            I.ldw = DM; I.src = C.w_down + (size_t)e * DM * DM + (size_t)(64 * kb) * DM + 64 * nb; I.f8 = 1; I.dst = (bf16*)((unsigned char*)C.Wd_t + ((size_t)e * DM + 64 * nb) * DM + 64 * kb); return I; } r -= I_D;
        if (r < I_IN) { const int kb = r / 160, pb = r % 160; const int n0 = (64 * pb < 2304) ? 64 * pb : 64 * pb + 12;
            I.ldw = INW; I.src = C.w_in + (size_t)(64 * kb) * INW + n0; I.dst = C.Win_t + (size_t)(64 * pb) * DM + 64 * kb; return I; } r -= I_IN;
        if (r < I_MKV) { const int kb = r / 16, nb = r % 16; I.ldw = 1024; I.src = C.w_mem_kv + (size_t)(64 * kb) * 1024 + 64 * nb; I.dst = C.Wmkv_t + (size_t)(64 * nb) * DM + 64 * kb; return I; } r -= I_MKV;
        if (r < I_UF) { const int kb = r / 32, nb = r % 32; I.ldw = DM; I.src = C.w_up_fox + (size_t)(64 * kb) * DM + 64 * nb; I.dst = C.Wup_t + (size_t)(64 * nb) * DM + 64 * kb; return I; } r -= I_UF;
        if (r < I_US) { const int kb = r / 32, nb = r % 32; I.ldw = DM; I.src = C.w_up_swa + (size_t)(64 * kb) * DM + 64 * nb; I.dst = C.Wup_t + (size_t)(64 * nb) * DM + 768 + 64 * kb; return I; } r -= I_US;
        if (r < I_UX) { const int kb = r / 32, nb = r % 32; I.ldw = DM; I.src = C.w_up_xmem + (size_t)(64 * kb) * DM + 64 * nb; I.dst = C.Wup_t + (size_t)(64 * nb) * DM + 1536 + 64 * kb; return I; } r -= I_UX;
        { const int kb = r / 32, nb = r % 32; I.ldw = DM; I.src = C.w_out + (size_t)(64 * kb) * DM + 64 * nb; I.dst = C.Wout_t + (size_t)(64 * nb) * DM + 64 * kb; return I; }
    };
    LAS unsigned* tile = (LAS unsigned*)(C.lds + RING_OFF + C.wave * 8192);
    __syncthreads();
    constexpr int N8 = I_GU + I_D;
    if (gw < N8) {
        TItem cur = decode(gw); f32x4 va[8][2]; float sa[8][2]; titem8_load(cur, va, sa, C.lane);
        for (int it = gw; it < N8; it += NGW) {
            const int nx = it + NGW; TItem nxt = cur; f32x4 vb[8][2]; float sb[8][2];
            if (nx < N8) { nxt = decode(nx); titem8_load(nxt, vb, sb, C.lane); }
            titem8_store(cur, va, sa, tile, C.lane);
            cur = nxt;
#pragma unroll
            for (int p = 0; p < 8; ++p)
#pragma unroll
                for (int h = 0; h < 2; ++h) { va[p][h] = vb[p][h]; sa[p][h] = sb[p][h]; }
        }
    }
    if (N8 + gw < NITEMS) {
        TItem cur = decode(N8 + gw); f32x4 va[8][2]; float sa[8][2]; titem_load(cur, va, sa, C.lane);
        for (int it = N8 + gw; it < NITEMS; it += NGW) {
            const int nx = it + NGW; TItem nxt = cur; f32x4 vb[8][2]; float sb[8][2];
            if (nx < NITEMS) { nxt = decode(nx); titem_load(nxt, vb, sb, C.lane); }
            titem_store(cur, va, sa, tile, C.lane);
            cur = nxt;
#pragma unroll
            for (int p = 0; p < 8; ++p)
#pragma unroll
                for (int h = 0; h < 2; ++h) { va[p][h] = vb[p][h]; sa[p][h] = sb[p][h]; }
        }
    }
}


using pg8::Unit;
template <int RB>
struct DenseOrderT {
    const char* A; const char* Bt; int nM, nN, nwg, G, c;
    __device__ __forceinline__ void init(const void* A_, const void* Bt_, int M, int N, int G_, int c_) { A = (const char*)A_; Bt = (const char*)Bt_; nM = M / 256; nN = N / 256; nwg = nM * nN; G = G_; c = c_; }
    __device__ __forceinline__ bool map(long L, Unit& u) const {
        if (L >= nwg) return false;
        int wgid = (int)L; { const int q = nwg / 8, r = nwg % 8, xcd = wgid % 8, off = wgid / 8; wgid = (xcd < r ? xcd * (q + 1) : r * (q + 1) + (xcd - r) * q) + off; }
        const int nig = 8 * nN, gid = wgid / nig, fm = gid * 8, gsz = (nM - fm) < 8 ? (nM - fm) : 8;
        u.pm = fm + ((wgid % nig) % gsz); u.pn = (wgid % nig) / gsz; u.e = 0; u.kind = 0; return true;
    }
    __device__ __forceinline__ bool next(int i, Unit& u) const { return map((long)i * G + c, u); }
    __device__ __forceinline__ const char* a_base(const Unit& u) const { return A + (size_t)u.pm * (256 * RB); }
    __device__ __forceinline__ const char* b_base(const Unit& u) const { return Bt + (size_t)u.pn * (256 * RB); }
    __device__ __forceinline__ void a_offs(const Unit&, const int (&R)[2], const int (&Cc)[2], unsigned (&vo)[2][2]) const {
#pragma unroll
        for (int h = 0; h < 2; ++h)
#pragma unroll
            for (int i = 0; i < 2; ++i) vo[h][i] = (unsigned)((h * 128 + R[i]) * RB + Cc[i] * 2);
    }
};
typedef DenseOrderT<4096> DenseOrder;
struct P1Order {
    DenseOrder d; const char* A1; const char* B1;
    __device__ __forceinline__ bool next(int i, Unit& u) const {
        const long L = (long)i * d.G + d.c;
        if (L < d.nwg) return d.map(L, u);
        const int r = (int)(L - d.nwg); if (r >= 8) return false;
        u.pm = r >> 2; u.pn = r & 3; u.e = 0; u.kind = 1; return true;
    }
    __device__ __forceinline__ const char* a_base(const Unit& u) const { return (u.kind ? A1 : d.A) + (size_t)u.pm * (256 * 2048 * 2); }
    __device__ __forceinline__ const char* b_base(const Unit& u) const { return (u.kind ? B1 : d.Bt) + (size_t)u.pn * (256 * 2048 * 2); }
    __device__ __forceinline__ void a_offs(const Unit& u, const int (&R)[2], const int (&Cc)[2], unsigned (&vo)[2][2]) const { d.a_offs(u, R, Cc, vo); }
};
template <bool GATHER, int NT, int RB>
struct MoeOrder {
    const char* A; const char* Bt; const int* tok; const int* cnt; const LAS int* tab; int G, c;
    __device__ __forceinline__ bool next(int i, Unit& u) const {
        const int L = i * G + c; if (L >= __builtin_amdgcn_readfirstlane(tab[32])) return false;
        int e = 0;
#pragma unroll 1
        for (int j = 1; j < 32; ++j) e += (__builtin_amdgcn_readfirstlane(tab[j]) <= L) ? 1 : 0;
        const int j = L - __builtin_amdgcn_readfirstlane(tab[e]), mt = __builtin_amdgcn_readfirstlane(tab[33 + e]), per = mt * 4, ntg = j / per, r = j - ntg * per;
        u.e = e; u.pm = r >> 2; u.pn = ntg * 4 + (r & 3); u.kind = __builtin_amdgcn_readfirstlane(tab[65 + e]) + 256 * u.pm;
        return true;
    }
    __device__ __forceinline__ const char* a_base(const Unit& u) const { return GATHER ? A : A + (size_t)u.kind * RB; }
    __device__ __forceinline__ const char* b_base(const Unit& u) const { return Bt + ((size_t)u.e * NT + u.pn) * (256 * RB); }
    __device__ __forceinline__ void a_offs(const Unit& u, const int (&R)[2], const int (&Cc)[2], unsigned (&vo)[2][2]) const {
#pragma unroll
        for (int h = 0; h < 2; ++h)
#pragma unroll
            for (int i = 0; i < 2; ++i) {
                if constexpr (GATHER) { const int n_e = __builtin_amdgcn_readfirstlane(tab[97 + u.e]); int ri = 256 * u.pm + h * 128 + R[i]; ri = ri < n_e ? ri : n_e - 1;
                    const int row = tok[u.e * CAP + ri]; vo[h][i] = (unsigned)(row * RB + Cc[i] * 2); }
                else vo[h][i] = (unsigned)((h * 128 + R[i]) * RB + Cc[i] * 2);
            }
    }
};

struct EpiInProj {
    static constexpr bool PERM = true, MID = false, FP8 = false; static constexpr int SCALE_A = 0x7f, SCALE_B = 0x7f;
    bf16* QKV; bf16* Gt; bf16* MKV;
    __device__ __forceinline__ void mid(pg8::f32x4 (&)[2][2][4][2], const Unit&, int, int, int, int, int) const {}
    __device__ __forceinline__ void operator()(const pg8::f32x4 (&acc)[2][2][4][2], const Unit& u, int wr, int wc, int fr, int fq) const {
        asm volatile("" : "+v"(fr), "+v"(fq));
        const int row0 = u.pm * 256 + wr * 64 + fr;
        bf16* base; int ldc, colt; bool sg = false;
        if (u.kind) { base = MKV; ldc = 1024; colt = u.pn * 256; }
        else if (u.pn < 16) { base = QKV; ldc = QKVW; colt = u.pn * 256; }
        else { base = Gt; ldc = GW; colt = (u.pn - 16) * 256; sg = true; }
        const int col0 = colt + wc * 32 + 8 * fq;
#pragma unroll
        for (int ai = 0; ai < 2; ++ai)
#pragma unroll
            for (int m = 0; m < 4; ++m) { bf16* rowp = base + (size_t)(row0 + ai * 128 + m * 16) * ldc + col0;
#pragma unroll
                for (int bj = 0; bj < 2; ++bj) { pg8::f32x4 v0 = acc[ai][bj][m][0], v1 = acc[ai][bj][m][1];
                    if (sg) {
#pragma unroll
                        for (int q = 0; q < 4; ++q) { v0[q] = sigmoidf_(fmaxf(v0[q], -30.f)); v1[q] = sigmoidf_(fmaxf(v1[q], -30.f)); } }
                    u32x4 w; w.x = cvt_pk_bf16(v0[0], v0[1]); w.y = cvt_pk_bf16(v0[2], v0[3]); w.z = cvt_pk_bf16(v1[0], v1[1]); w.w = cvt_pk_bf16(v1[2], v1[3]);
                    *(u32x4*)(rowp + bj * 128) = w; } }
    }
};
struct EpiMerge {
    static constexpr bool PERM = true, MID = true, FP8 = false; static constexpr int SCALE_A = 0x7f, SCALE_B = 0x7f;
    const bf16* Gt; bf16* O;
    __device__ __forceinline__ void mid(pg8::f32x4 (&acc)[2][2][4][2], const Unit& u, int which, int wr, int wc, int fr, int fq) const {
        asm volatile("" : "+v"(fr), "+v"(fq));
        const int row0 = u.pm * 256 + wr * 64 + fr, col0 = u.pn * 256 + wc * 32 + 8 * fq;
        const bf16* gn = Gt + (which ? 2048 : 0); const bf16* gd = Gt + (which ? 4096 : 2048);
#pragma unroll
        for (int ai = 0; ai < 2; ++ai)
#pragma unroll
            for (int m = 0; m < 4; ++m) { const size_t ro = (size_t)(row0 + ai * 128 + m * 16) * GW + col0;
#pragma unroll
                for (int bj = 0; bj < 2; ++bj) { const u32x4 a = *(const u32x4*)(gn + ro + bj * 128), b = *(const u32x4*)(gd + ro + bj * 128);
                    pg8::f32x4 r0, r1;
                    r0[0] = bf_lo(a.x) * __builtin_amdgcn_rcpf(bf_lo(b.x)); r0[1] = bf_hi(a.x) * __builtin_amdgcn_rcpf(bf_hi(b.x)); r0[2] = bf_lo(a.y) * __builtin_amdgcn_rcpf(bf_lo(b.y)); r0[3] = bf_hi(a.y) * __builtin_amdgcn_rcpf(bf_hi(b.y));
                    r1[0] = bf_lo(a.z) * __builtin_amdgcn_rcpf(bf_lo(b.z)); r1[1] = bf_hi(a.z) * __builtin_amdgcn_rcpf(bf_hi(b.z)); r1[2] = bf_lo(a.w) * __builtin_amdgcn_rcpf(bf_lo(b.w)); r1[3] = bf_hi(a.w) * __builtin_amdgcn_rcpf(bf_hi(b.w));
                    acc[ai][bj][m][0] *= r0; acc[ai][bj][m][1] *= r1; }
                asm volatile("" : "+v"(acc[ai][0][m][0]), "+v"(acc[ai][0][m][1]), "+v"(acc[ai][1][m][0]), "+v"(acc[ai][1][m][1]));
                asm volatile("" ::: "memory"); }
    }
    __device__ __forceinline__ void operator()(const pg8::f32x4 (&acc)[2][2][4][2], const Unit& u, int wr, int wc, int fr, int fq) const {
        asm volatile("" : "+v"(fr), "+v"(fq));
        const int row0 = u.pm * 256 + wr * 64 + fr, col0 = u.pn * 256 + wc * 32 + 8 * fq;
#pragma unroll
        for (int ai = 0; ai < 2; ++ai)
#pragma unroll
            for (int m = 0; m < 4; ++m) { const size_t rr = (size_t)(row0 + ai * 128 + m * 16);
#pragma unroll
                for (int bj = 0; bj < 2; ++bj) { const u32x4 g = *(const u32x4*)(Gt + rr * GW + 4096 + col0 + bj * 128);
                    const pg8::f32x4 v0 = acc[ai][bj][m][0], v1 = acc[ai][bj][m][1];
                    u32x4 w; w.x = cvt_pk_bf16(v0[0] * bf_lo(g.x), v0[1] * bf_hi(g.x)); w.y = cvt_pk_bf16(v0[2] * bf_lo(g.y), v0[3] * bf_hi(g.y));
                    w.z = cvt_pk_bf16(v1[0] * bf_lo(g.z), v1[1] * bf_hi(g.z)); w.w = cvt_pk_bf16(v1[2] * bf_lo(g.w), v1[3] * bf_hi(g.w));
                    *(u32x4*)(O + rr * DM + col0 + bj * 128) = w; }
                asm volatile("" ::: "memory"); }
    }
};
struct EpiOut {
    static constexpr bool PERM = false, MID = false, FP8 = false; static constexpr int SCALE_A = 0x7f, SCALE_B = 0x7f;
    const float* X; float* out; unsigned char* HB8;
    __device__ __forceinline__ void mid(pg8::f32x4 (&)[2][2][4][2], const Unit&, int, int, int, int, int) const {}
    __device__ __forceinline__ void operator()(const pg8::f32x4 (&acc)[2][2][4][2], const Unit& u, int wr, int wc, int fr, int fq) const {
        asm volatile("" : "+v"(fr), "+v"(fq));
        const int row0 = u.pm * 256 + wr * 64 + fr, col0 = u.pn * 256 + wc * 32 + 4 * fq;
#pragma unroll
        for (int ai = 0; ai < 2; ++ai)
#pragma unroll
            for (int m = 0; m < 4; ++m) { const size_t off = (size_t)(row0 + ai * 128 + m * 16) * DM + col0;
#pragma unroll
                for (int bj = 0; bj < 2; ++bj)
#pragma unroll
                    for (int n = 0; n < 2; ++n) { const size_t o2 = off + bj * 128 + n * 16; const pg8::f32x4 h = *(const pg8::f32x4*)(X + o2) + acc[ai][bj][m][n];
                        *(pg8::f32x4*)(out + o2) = h; *(unsigned*)(HB8 + o2) = pk4_fp8(h[0] * H8_MUL, h[1] * H8_MUL, h[2] * H8_MUL, h[3] * H8_MUL); } }
    }
};
struct EpiGateUp {
    static constexpr bool PERM = true, MID = false, FP8 = true; static constexpr int SCALE_A = 127 - H8_SHIFT, SCALE_B = 127 - W8_SHIFT;
    const float* RS; const float* bgu; unsigned char* ACT8;
    __device__ __forceinline__ void mid(pg8::f32x4 (&)[2][2][4][2], const Unit&, int, int, int, int, int) const {}
    __device__ __forceinline__ void operator()(const pg8::f32x4 (&acc)[2][2][4][2], const Unit& u, int wr, int wc, int fr, int fq) const {
        asm volatile("" : "+v"(fr), "+v"(fq));
        const int r0 = wr * 64 + fr, hc0 = u.pn * 128 + wc * 32 + 8 * fq;
        const float* bg = bgu + (size_t)u.e * 4096 + hc0;
        const pg8::f32x4 bg0 = *(const pg8::f32x4*)(bg), bg1 = *(const pg8::f32x4*)(bg + 4), bu0 = *(const pg8::f32x4*)(bg + 2048), bu1 = *(const pg8::f32x4*)(bg + 2052);
        float rsv[2][4];
#pragma unroll
        for (int ai = 0; ai < 2; ++ai)
#pragma unroll
            for (int m = 0; m < 4; ++m) rsv[ai][m] = RS[u.e * CAP + 256 * u.pm + r0 + ai * 128 + m * 16];
#pragma unroll
        for (int ai = 0; ai < 2; ++ai)
#pragma unroll
            for (int m = 0; m < 4; ++m) { const int rl = r0 + ai * 128 + m * 16;
                const float rs = rsv[ai][m];
                float g[8], up[8];
#pragma unroll
                for (int q = 0; q < 4; ++q) { g[q] = rs * acc[ai][0][m][0][q] + bg0[q]; g[4 + q] = rs * acc[ai][0][m][1][q] + bg1[q]; up[q] = rs * acc[ai][1][m][0][q] + bu0[q]; up[4 + q] = rs * acc[ai][1][m][1][q] + bu1[q]; }
                float a[8];
#pragma unroll
                for (int q = 0; q < 8; ++q) { const float gg = fminf(g[q], SWIGLU_LIMIT), uu = fminf(fmaxf(up[q], -SWIGLU_LIMIT), SWIGLU_LIMIT); a[q] = (uu + 1.0f) * (gg * sigmoidf_(gg * SWIGLU_ALPHA)); }
                u32x2 w; w.x = pk4_fp8(a[0] * ACT8_MUL, a[1] * ACT8_MUL, a[2] * ACT8_MUL, a[3] * ACT8_MUL); w.y = pk4_fp8(a[4] * ACT8_MUL, a[5] * ACT8_MUL, a[6] * ACT8_MUL, a[7] * ACT8_MUL);
                *(u32x2*)(ACT8 + (size_t)(u.kind + rl) * DM + hc0) = w; }
    }
};
struct EpiDown {
    static constexpr bool PERM = true, MID = false, FP8 = true; static constexpr int SCALE_A = 127 - ACT8_SHIFT, SCALE_B = 127 - W8_SHIFT;
    const float* bd; bf16* Y;
    __device__ __forceinline__ void mid(pg8::f32x4 (&)[2][2][4][2], const Unit&, int, int, int, int, int) const {}
    __device__ __forceinline__ void operator()(const pg8::f32x4 (&acc)[2][2][4][2], const Unit& u, int wr, int wc, int fr, int fq) const {
        asm volatile("" : "+v"(fr), "+v"(fq));
        const int r0 = wr * 64 + fr, col0 = u.pn * 256 + wc * 32 + 8 * fq;
        const float* bb = bd + (size_t)u.e * DM + col0;
        pg8::f32x4 bv[2][2];
#pragma unroll
        for (int bj = 0; bj < 2; ++bj)
#pragma unroll
            for (int n = 0; n < 2; ++n) bv[bj][n] = *(const pg8::f32x4*)(bb + bj * 128 + n * 4);
#pragma unroll
        for (int ai = 0; ai < 2; ++ai)
#pragma unroll
            for (int m = 0; m < 4; ++m) { bf16* rowp = Y + (size_t)(u.kind + r0 + ai * 128 + m * 16) * DM + col0;
#pragma unroll
                for (int bj = 0; bj < 2; ++bj) { const pg8::f32x4 v0 = acc[ai][bj][m][0] + bv[bj][0], v1 = acc[ai][bj][m][1] + bv[bj][1];
                    u32x4 w; w.x = cvt_pk_bf16(v0[0], v0[1]); w.y = cvt_pk_bf16(v0[2], v0[3]); w.z = cvt_pk_bf16(v1[0], v1[1]); w.w = cvt_pk_bf16(v1[2], v1[3]);
                    *(u32x4*)(rowp + bj * 128) = w; } }
    }
};

__device__ __forceinline__ void phase2(const Ctx& C) {
    constexpr float C2_64 = 0.125f * LOG2E, C2_128 = 0.08838834764831845f * LOG2E;
    const int i = C.tid;
    int kind;
    const float* gain; float sc = 1.f; int gofs;
    if (i < 96)        { kind = 1; gain = C.fox_q_norm;  sc = C2_64;  gofs = (i & 7) * 8; }
    else if (i < 192)  { kind = 1; gain = C.fox_k_norm;  gofs = (i & 7) * 8; }
    else if (i < 288)  { kind = 0; gain = C.fox_k_norm;  gofs = 0; }
    else if (i < 384)  { kind = 2; gain = C.swa_q_norm;  sc = C2_64;  gofs = (i & 7) * 8; }
    else if (i < 416)  { kind = 2; gain = C.swa_k_norm;  gofs = (i & 7) * 8; }
    else if (i < 448)  { kind = 0; gain = C.swa_k_norm;  gofs = 0; }
    else               { kind = 3; gain = C.xmem_q_norm; sc = C2_128; gofs = (i & 15) * 8; }
    float gv[8];
#pragma unroll
    for (int q = 0; q < 8; ++q) gv[q] = gain[gofs + q] * sc;
    const int li = i & 7;
    const int rj = (li & 3) * 8;
    constexpr int RU = 4;
    for (int m0 = C.vcu * RU; m0 < T; m0 += C.G * RU) {
        v4u raw[RU]; f32x4 c0[RU], c1[RU], s0[RU], s1[RU];
#pragma unroll
        for (int u = 0; u < RU; ++u) { raw[u] = *(const GAS v4u*)(C.QKV + (size_t)(m0 + u) * QKVW + i * 8);
            if (kind == 2) { const float* cs = C.ROPE + (size_t)(m0 + u) * 64 + rj; c0[u] = *(const GAS f32x4*)cs; c1[u] = *(const GAS f32x4*)(cs + 4); s0[u] = *(const GAS f32x4*)(cs + 32); s1[u] = *(const GAS f32x4*)(cs + 36); } }
#pragma unroll
        for (int u = 0; u < RU; ++u) {
            bf16* p = C.QKV + (size_t)(m0 + u) * QKVW + i * 8;
            float v[8]; v[0] = pg8::bf_lo(raw[u].x); v[1] = pg8::bf_hi(raw[u].x); v[2] = pg8::bf_lo(raw[u].y); v[3] = pg8::bf_hi(raw[u].y); v[4] = pg8::bf_lo(raw[u].z); v[5] = pg8::bf_hi(raw[u].z); v[6] = pg8::bf_lo(raw[u].w); v[7] = pg8::bf_hi(raw[u].w);
            float ss = 0.f;
#pragma unroll
            for (int q = 0; q < 8; ++q) ss += v[q] * v[q];
            ss += __shfl_xor(ss, 1); ss += __shfl_xor(ss, 2); ss += __shfl_xor(ss, 4);
            const float ss16 = ss + __shfl_xor(ss, 8);
            const float rstd = (kind == 3) ? 1.0f / sqrtf(ss16 * (1.f / 128.f) + NORM_EPS) : 1.0f / sqrtf(ss * (1.f / 64.f) + NORM_EPS);
#pragma unroll
            for (int q = 0; q < 8; ++q) v[q] = (v[q] * rstd) * gv[q];
            float o[8];
#pragma unroll
            for (int q = 0; q < 8; ++q) o[q] = __shfl_xor(v[q], 4);
            if (kind == 2) {
                const float cc[8] = {c0[u].x, c0[u].y, c0[u].z, c0[u].w, c1[u].x, c1[u].y, c1[u].z, c1[u].w}, sn[8] = {s0[u].x, s0[u].y, s0[u].z, s0[u].w, s1[u].x, s1[u].y, s1[u].z, s1[u].w};
                const float sg = (li < 4) ? -1.f : 1.f;
#pragma unroll
                for (int q = 0; q < 8; ++q) v[q] = v[q] * cc[q] + sg * o[q] * sn[q];
            }
            if (kind != 0) { v4u w; w.x = pk2(v[0], v[1]); w.y = pk2(v[2], v[3]); w.z = pk2(v[4], v[5]); w.w = pk2(v[6], v[7]); *(GAS v4u*)p = w; }
        }
    }
    {
        const int rsub = i >> 6, l6 = i & 63; float gk[8];
#pragma unroll
        for (int q = 0; q < 8; ++q) gk[q] = C.xmem_k_norm[(l6 & 15) * 8 + q];
        for (int m = C.vcu * 8 + rsub; m < MROWS; m += C.G * 8) {
            bf16* p = C.MKV + (size_t)m * 1024 + l6 * 8;
            const v4u raw = *(const GAS v4u*)p;
            float v[8]; v[0] = pg8::bf_lo(raw.x); v[1] = pg8::bf_hi(raw.x); v[2] = pg8::bf_lo(raw.y); v[3] = pg8::bf_hi(raw.y); v[4] = pg8::bf_lo(raw.z); v[5] = pg8::bf_hi(raw.z); v[6] = pg8::bf_lo(raw.w); v[7] = pg8::bf_hi(raw.w);
            float ss = 0.f;
#pragma unroll
            for (int q = 0; q < 8; ++q) ss += v[q] * v[q];
            ss += __shfl_xor(ss, 1); ss += __shfl_xor(ss, 2); ss += __shfl_xor(ss, 4); ss += __shfl_xor(ss, 8);
            const float rstd = 1.0f / sqrtf(ss * (1.f / 128.f) + NORM_EPS);
#pragma unroll
            for (int q = 0; q < 8; ++q) v[q] = (v[q] * rstd) * gk[q];
            v4u w; w.x = pk2(v[0], v[1]); w.y = pk2(v[2], v[3]); w.z = pk2(v[4], v[5]); w.w = pk2(v[6], v[7]); *(GAS v4u*)p = w;
        }
    }
    if (C.wave == 0) for (int sq = C.vcu; sq < BATCH * 12; sq += C.G) {
        const float* src = C.LOGF + (size_t)sq * SEQ + C.lane * 128; float* dst = C.CNEG + (size_t)sq * SEQ + C.lane * 128;
        float tot = 0.f;
#pragma unroll 4
        for (int j = 0; j < 32; ++j) { const f32x4 a = *(const GAS f32x4*)(src + 4 * j); tot += (a.x + a.y) + (a.z + a.w); }
        float incl = tot;
#pragma unroll
        for (int o = 1; o < 64; o <<= 1) { const float n = __shfl_up(incl, o); if (C.lane >= o) incl += n; }
        float run = incl - tot;
#pragma unroll 4
        for (int j = 0; j < 32; ++j) { const f32x4 a = *(const GAS f32x4*)(src + 4 * j); f32x4 c;
            run += a.x; c.x = -run * LOG2E; run += a.y; c.y = -run * LOG2E; run += a.z; c.z = -run * LOG2E; run += a.w; c.w = -run * LOG2E; *(GAS f32x4*)(dst + 4 * j) = c; }
    }
}

namespace att {
typedef __attribute__((address_space(3))) const char* lds_cptr;
__device__ __forceinline__ void glds16(const void* gsrc, unsigned lds_dst) { unsigned keep;
    asm volatile("s_mov_b32 %0, m0\n\ts_mov_b32 m0, %2\n\ts_nop 0\n\tglobal_load_lds_dwordx4 %1, off\n\ts_mov_b32 m0, %0" : "=&s"(keep) : "v"(gsrc), "s"(lds_dst) : "memory"); }
typedef float f32x2_t __attribute__((ext_vector_type(2))); typedef __bf16 bf16x2_t __attribute__((ext_vector_type(2)));
__device__ __forceinline__ unsigned cvtpk_s(float lo, float hi) { f32x2_t v = {lo, hi}; bf16x2_t b = __builtin_convertvector(v, bf16x2_t); return __builtin_bit_cast(unsigned, b); }
__device__ __forceinline__ int crow(int r, int hi) { return (r & 3) + 8 * (r >> 2) + 4 * hi; }

template <int D> struct Geo {
    static constexpr int SLOTB = 64 * D * 2, NSLOT = (D == 64) ? 3 : 2, PPT = (D == 64) ? 2 : 4;
    static constexpr int LDS_K = 0, LDS_V = NSLOT * SLOTB, LDS_WS = 2 * NSLOT * SLOTB, LDS_WMIN = LDS_WS + 2048, LDS_OST = LDS_WMIN + 64, LDS_CB = LDS_OST + 8 * 4096, LDS_END = LDS_CB + 32768;
};

template <int D>
__device__ __forceinline__ void qkt(f32x16& p0, f32x16& p1, lds_cptr Kslot, const bf16x8* qr, int r32, int hi) {
    lds_cptr kb = Kslot + hi * 1024 + r32 * 16;
    p0 = f32x16{}; p1 = f32x16{};
#pragma unroll
    for (int d0 = 0; d0 < D / 16; ++d0) {
        const bf16x8 b0 = *(const LAS bf16x8*)(kb + d0 * 2048);
        const bf16x8 b1 = *(const LAS bf16x8*)(kb + d0 * 2048 + 512);
        p0 = __builtin_amdgcn_mfma_f32_32x32x16_bf16(b0, qr[d0], p0, 0, 0, 0); p1 = __builtin_amdgcn_mfma_f32_32x32x16_bf16(b1, qr[d0], p1, 0, 0, 0); }
}
template <int D>
__device__ __forceinline__ void pv(f32x16* o, int vb, bf16x8 pa0, bf16x8 pa1, bf16x8 pa2, bf16x8 pa3) {
#pragma unroll
    for (int d0 = 0; d0 < D / 32; ++d0) { s16x4 lo[4], hi[4];
#pragma unroll
        for (int ks = 0; ks < 4; ++ks) {
            asm volatile("ds_read_b64_tr_b16 %0,%1 offset:%c2" : "=&v"(lo[ks]) : "v"(vb), "i"(d0 * 4096 + ks * 1024) : "memory");
            asm volatile("ds_read_b64_tr_b16 %0,%1 offset:%c2" : "=&v"(hi[ks]) : "v"(vb), "i"(d0 * 4096 + ks * 1024 + 512) : "memory"); }
        asm volatile("s_waitcnt lgkmcnt(0)" ::: "memory"); __builtin_amdgcn_sched_barrier(0);
#define ATT_PK(k) (bf16x8){lo[k][0], lo[k][1], lo[k][2], lo[k][3], hi[k][0], hi[k][1], hi[k][2], hi[k][3]}
        o[d0] = __builtin_amdgcn_mfma_f32_32x32x16_bf16(pa0, ATT_PK(0), o[d0], 0, 0, 0);
        o[d0] = __builtin_amdgcn_mfma_f32_32x32x16_bf16(pa1, ATT_PK(1), o[d0], 0, 0, 0);
        o[d0] = __builtin_amdgcn_mfma_f32_32x32x16_bf16(pa2, ATT_PK(2), o[d0], 0, 0, 0);
        o[d0] = __builtin_amdgcn_mfma_f32_32x32x16_bf16(pa3, ATT_PK(3), o[d0], 0, 0, 0);
#undef ATT_PK
    }
}

template <int D, int MODE>
__device__ __forceinline__ void attn_unit(LAS unsigned char* shm, const bf16* Q, int pitchQ, const bf16* K, const bf16* V, int pitchKV, bf16* O, const float* cneg, float sink2, int qb, float bqk = 0.f) {
    typedef Geo<D> G;
    const int tid = threadIdx.x, lane = tid & 63, r32 = lane & 31, hi = lane >> 5; const int wid = __builtin_amdgcn_readfirstlane(tid >> 6);
    const int q0 = qb * 256, q0w = q0 + wid * 32;
    const unsigned lds0 = (unsigned)(uintptr_t)shm;
    LAS float* wsf = (LAS float*)(shm + G::LDS_WS) + wid * 64;
    LAS float* cb = (LAS float*)(shm + G::LDS_CB);
    const int j_lo = (MODE == 1) ? (qb > 0 ? 4 * qb - 2 : 0) : 0, j_hi = (MODE == 2) ? 4 : 4 * qb + 4;
    bf16x8 qr[D / 16];
    { const bf16* Qw = Q + (size_t)(q0w + r32) * pitchQ + hi * 8;
#pragma unroll
      for (int d0 = 0; d0 < D / 16; ++d0) qr[d0] = *(const GAS bf16x8*)(Qw + d0 * 16); }
    if constexpr (MODE == 0) {
        const int nch = (q0 + 256) / 4;
        for (int c = tid; c < nch; c += 512) { const f32x4 v = *(const GAS f32x4*)(cneg + 4 * c); *(LAS f32x4*)(cb + 4 * c) = v; }
    }
#define ATT_DMA(j, slot) do { const int _s = (slot) * G::SLOTB; \
        if constexpr (D == 64) { \
            glds16(K + (size_t)(64 * (j) + lane) * pitchKV + wid * 8, (unsigned)__builtin_amdgcn_readfirstlane(lds0 + G::LDS_K + _s + wid * 1024)); \
            glds16(V + (size_t)(64 * (j) + 16 * (wid & 3) + (lane >> 2)) * pitchKV + (wid >> 2) * 32 + (lane & 3) * 8, (unsigned)__builtin_amdgcn_readfirstlane(lds0 + G::LDS_V + _s + wid * 1024)); \
        } else { \
            _Pragma("unroll") for (int _p = 0; _p < 2; ++_p) { const int _c = wid + 8 * _p; \
                glds16(K + (size_t)(64 * (j) + lane) * pitchKV + _c * 8, (unsigned)__builtin_amdgcn_readfirstlane(lds0 + G::LDS_K + _s + _c * 1024)); } \
            _Pragma("unroll") for (int _p = 0; _p < 2; ++_p) { const int _c = wid + 8 * _p; \
                glds16(V + (size_t)(64 * (j) + 16 * (_c & 3) + (lane >> 2)) * pitchKV + (_c >> 2) * 32 + (lane & 3) * 8, (unsigned)__builtin_amdgcn_readfirstlane(lds0 + G::LDS_V + _s + _c * 1024)); } \
        } } while (0)
    int slot_i = 0;
    constexpr bool REV = (MODE == 0);
    const int nst = j_hi - j_lo;
#define ATT_TILE(st_) (REV ? (j_hi - 1 - (st_)) : (j_lo + (st_)))
#pragma unroll
    for (int p = 0; p < G::NSLOT - 1; ++p) if (p < nst) ATT_DMA(ATT_TILE(p), p);
    float mhat = -1e30f, l_reg = 0.f; f32x16 o[D / 32];
#pragma unroll
    for (int d0 = 0; d0 < D / 32; ++d0) o[d0] = f32x16{};
    const lds_cptr shm3 = (lds_cptr)shm;
    const int vb0 = (int)(lds0 + G::LDS_V) + ((lane >> 4) & 1) * 32 + (lane & 3) * 8 + (4 * hi + ((lane & 15) >> 2)) * 64;
    const int qabs = q0w + r32;
    LAS float* wmin = (LAS float*)(shm + G::LDS_WMIN);
    for (int st = 0; st < nst; ++st) {
        const int j = ATT_TILE(st);
        if (G::NSLOT == 3 && st + 1 < nst) { if constexpr (G::PPT == 2) asm volatile("s_waitcnt vmcnt(2) lgkmcnt(0)\n\ts_barrier" ::: "memory"); else asm volatile("s_waitcnt vmcnt(4) lgkmcnt(0)\n\ts_barrier" ::: "memory"); }
        else asm volatile("s_waitcnt vmcnt(0) lgkmcnt(0)\n\ts_barrier" ::: "memory");
        if constexpr (MODE == 0) { if (st >= 5) {
            const LAS float* wm = wmin + ((st - 1) & 1) * 8; const f32x4 a = *(const LAS f32x4*)wm, b = *(const LAS f32x4*)(wm + 4);
            const float gmin = fminf(fminf(fminf(a.x, a.y), fminf(a.z, a.w)), fminf(fminf(b.x, b.y), fminf(b.z, b.w)));
            if (cb[64 * j + 63] + bqk < gmin - 40.0f) break; } }
        { const int sn_ = st + G::NSLOT - 1; if (sn_ < nst) { int sn = slot_i + G::NSLOT - 1; if (sn >= G::NSLOT) sn -= G::NSLOT; ATT_DMA(ATT_TILE(sn_), sn); } }
        bool need = true;
        if constexpr (MODE == 0) need = (64 * j <= q0w + 31);
        if constexpr (MODE == 1) need = (64 * j <= q0w + 31) && (64 * j + 63 >= q0w - 127);
        if (need) {
            f32x16 p0, p1;
            qkt<D>(p0, p1, shm3 + G::LDS_K + slot_i * G::SLOTB, qr, r32, hi);
            if constexpr (MODE == 0) {
                const LAS float* cbp = cb + 64 * j + 4 * hi;
#pragma unroll
                for (int g = 0; g < 4; ++g) { const f32x4 b0 = *(const LAS f32x4*)(cbp + 8 * g), b1 = *(const LAS f32x4*)(cbp + 32 + 8 * g);
#pragma unroll
                    for (int e = 0; e < 4; ++e) { p0[4 * g + e] += b0[e]; p1[4 * g + e] += b1[e]; } }
                if (64 * j + 63 > q0w) {
#pragma unroll
                    for (int r = 0; r < 16; ++r) { const int kv = 64 * j + crow(r, hi); if (kv > qabs) p0[r] = -INFINITY; if (kv + 32 > qabs) p1[r] = -INFINITY; } }
            }
            if constexpr (MODE == 1) {
#pragma unroll
                for (int r = 0; r < 16; ++r) { const int kv = 64 * j + crow(r, hi); const int d0_ = qabs - kv, d1_ = d0_ - 32;
                    if (d0_ < 0 || d0_ >= 128) p0[r] = -INFINITY; if (d1_ < 0 || d1_ >= 128) p1[r] = -INFINITY; }
            }
            float rm = fmaxf(p0[0], p1[0]);
#pragma unroll
            for (int r = 1; r < 16; ++r) rm = fmaxf(rm, fmaxf(p0[r], p1[r]));
            { auto rr = __builtin_amdgcn_permlane32_swap(__float_as_uint(rm), __float_as_uint(rm), false, false); rm = fmaxf(__uint_as_float(rr[0]), __uint_as_float(rr[1])); }
            if (__any(rm > mhat)) {
                const float mn = fmaxf(mhat, rm); const float f = __builtin_amdgcn_exp2f(mhat - mn); mhat = mn; l_reg *= f;
                if (hi == 0) wsf[r32] = f;
                asm volatile("s_waitcnt lgkmcnt(0)" ::: "memory");
#pragma unroll
                for (int g = 0; g < 4; ++g) { const f32x4 fv = *(const LAS f32x4*)(wsf + 8 * g + 4 * hi);
#pragma unroll
                    for (int d_ = 0; d_ < D / 32; ++d_)
#pragma unroll
                        for (int e = 0; e < 4; ++e) o[d_][4 * g + e] *= fv[e]; }
            }
            float sacc = 0.f;
#pragma unroll
            for (int r = 0; r < 16; ++r) { p0[r] = __builtin_amdgcn_exp2f(p0[r] - mhat); p1[r] = __builtin_amdgcn_exp2f(p1[r] - mhat); sacc += p0[r] + p1[r]; }
            l_reg += sacc;
            u32x4 pw0, pw1, pw2, pw3;
            pw0 = (u32x4){cvtpk_s(p0[0], p0[1]), cvtpk_s(p0[2], p0[3]), cvtpk_s(p0[4], p0[5]), cvtpk_s(p0[6], p0[7])};
            pw1 = (u32x4){cvtpk_s(p0[8], p0[9]), cvtpk_s(p0[10], p0[11]), cvtpk_s(p0[12], p0[13]), cvtpk_s(p0[14], p0[15])};
            pw2 = (u32x4){cvtpk_s(p1[0], p1[1]), cvtpk_s(p1[2], p1[3]), cvtpk_s(p1[4], p1[5]), cvtpk_s(p1[6], p1[7])};
            pw3 = (u32x4){cvtpk_s(p1[8], p1[9]), cvtpk_s(p1[10], p1[11]), cvtpk_s(p1[12], p1[13]), cvtpk_s(p1[14], p1[15])};
            pv<D>(o, vb0 + slot_i * G::SLOTB, __builtin_bit_cast(bf16x8, pw0), __builtin_bit_cast(bf16x8, pw1), __builtin_bit_cast(bf16x8, pw2), __builtin_bit_cast(bf16x8, pw3));
        }
        if constexpr (MODE == 0) { float mn = mhat;
#pragma unroll
            for (int of = 1; of < 32; of <<= 1) mn = fminf(mn, __shfl_xor(mn, of));
            if (lane == 0) wmin[(st & 1) * 8 + wid] = mn; }
        ++slot_i; if (slot_i == G::NSLOT) slot_i = 0;
    }
#undef ATT_DMA
#undef ATT_TILE
    if constexpr (MODE == 0) asm volatile("s_waitcnt vmcnt(0)" ::: "memory");
    { auto rr = __builtin_amdgcn_permlane32_swap(__float_as_uint(l_reg), __float_as_uint(l_reg), false, false); l_reg = __uint_as_float(rr[0]) + __uint_as_float(rr[1]); }
    if constexpr (MODE == 1) l_reg += __builtin_amdgcn_exp2f(sink2 - mhat);
    if (hi == 0) wsf[32 + r32] = l_reg;
    asm volatile("s_waitcnt lgkmcnt(0)" ::: "memory");
    float rli[16];
#pragma unroll
    for (int g = 0; g < 4; ++g) { const f32x4 lv = *(const LAS f32x4*)(wsf + 32 + 8 * g + 4 * hi);
#pragma unroll
        for (int e = 0; e < 4; ++e) rli[4 * g + e] = __builtin_amdgcn_rcpf(lv[e]); }
    bf16* Ow = O + (size_t)q0w * 2048;
    LAS bf16* stg = (LAS bf16*)(shm + G::LDS_OST) + wid * 2048;
#pragma unroll
    for (int ps = 0; ps < D / 64; ++ps) {
#pragma unroll
        for (int r = 0; r < 16; ++r) { const int orow = crow(r, hi);
#pragma unroll
            for (int dl = 0; dl < 2; ++dl) stg[orow * 64 + dl * 32 + r32] = (bf16)f2bf(o[2 * ps + dl][r] * rli[r]); }
        asm volatile("s_waitcnt lgkmcnt(0)" ::: "memory");
#pragma unroll
        for (int i = 0; i < 4; ++i) { const int row = i * 8 + (lane >> 3), ch = lane & 7; const v4u v = *(const LAS v4u*)(stg + row * 64 + ch * 8); *(GAS v4u*)(Ow + (size_t)row * 2048 + ps * 64 + ch * 8) = v; }
        asm volatile("s_waitcnt lgkmcnt(0)" ::: "memory");
    }
    asm volatile("s_waitcnt lgkmcnt(0)\n\ts_barrier" ::: "memory");
}
}

constexpr int NU_FOX = BATCH * 12 * 32, NU_SWA = BATCH * 12 * 32, NU_XM = BATCH * 4 * 32;
__device__ __forceinline__ int att_fetch(const Ctx& C, int q) {
    int v = 0; if (C.tid == 0) v = (int)__hip_atomic_fetch_add((unsigned*)(C.ctl + CW_QHEAD + 64 * q), 1u, RLX_AGENT); return v;
}
__device__ __forceinline__ void phase3(const Ctx& C) {
    LAS unsigned char* shm = C.lds + RING_OFF;
    volatile LAS int* nxtw = (volatile LAS int*)(C.MISC + 12);
    {
        float gq = fabsf(C.fox_q_norm[C.lane]), gk = fabsf(C.fox_k_norm[C.lane]);
#pragma unroll
        for (int of = 1; of < 64; of <<= 1) { gq = fmaxf(gq, __shfl_xor(gq, of)); gk = fmaxf(gk, __shfl_xor(gk, of)); }
        const float bqk = 64.0f * gq * gk * (0.125f * LOG2E) * 1.02f;
        int pre = att_fetch(C, 0);
        if (C.tid == 0) *nxtw = pre;
        __syncthreads();
        int cur = __builtin_amdgcn_readfirstlane(*nxtw);
        __syncthreads();
        while (cur < NU_FOX) {
            pre = att_fetch(C, 0);
            const int qb = 31 - cur / 24, bh = cur % 24, b = bh / 12, h = bh % 12;
            const bf16* base = C.QKV + (size_t)b * SEQ * QKVW + h * 64;
            att::attn_unit<64, 0>(shm, base + C_FQ, QKVW, base + C_FK, base + C_FV, QKVW, C.OALL + (size_t)b * SEQ * 2048 + h * 64, C.CNEG + (size_t)(b * 12 + h) * SEQ, 0.f, qb, bqk);
            if (C.tid == 0) *nxtw = pre;
            __syncthreads();
            cur = __builtin_amdgcn_readfirstlane(*nxtw);
            __syncthreads();
        }
    }
    {
        int pre = att_fetch(C, 1);
        if (C.tid == 0) *nxtw = pre;
        __syncthreads();
        int cur = __builtin_amdgcn_readfirstlane(*nxtw);
        __syncthreads();
        while (cur < NU_SWA) {
            pre = att_fetch(C, 1);
            const int qb = cur / 24, bh = cur % 24, b = bh / 12, h = bh % 12, kvh = h / 3;
            const bf16* base = C.QKV + (size_t)b * SEQ * QKVW;
            att::attn_unit<64, 1>(shm, base + C_SQ + h * 64, QKVW, base + C_SK + kvh * 64, base + C_SV + kvh * 64, QKVW, C.OALL + (size_t)b * SEQ * 2048 + 768 + h * 64, nullptr, C.swa_sinks[h] * LOG2E, qb);
            if (C.tid == 0) *nxtw = pre;
            __syncthreads();
            cur = __builtin_amdgcn_readfirstlane(*nxtw);
            __syncthreads();
        }
    }
    {
        int pre = att_fetch(C, 2);
        if (C.tid == 0) *nxtw = pre;
        __syncthreads();
        int cur = __builtin_amdgcn_readfirstlane(*nxtw);
        __syncthreads();
        while (cur < NU_XM) {
            pre = att_fetch(C, 2);
            const int qb = cur / 8, bh = cur % 8, b = bh / 4, h = bh % 4;
            const bf16* kb = C.MKV + (size_t)b * NMEM * 1024 + h * 128;
            att::attn_unit<128, 2>(shm, C.QKV + (size_t)b * SEQ * QKVW + C_MQ + h * 128, QKVW, kb, kb + 512, 1024, C.OALL + (size_t)b * SEQ * 2048 + 1536 + h * 128, nullptr, 0.f, qb);
            if (C.tid == 0) *nxtw = pre;
            __syncthreads();
            cur = __builtin_amdgcn_readfirstlane(*nxtw);
            __syncthreads();
        }
    }
}

__device__ __forceinline__ void phase6(const Ctx& C) {
    LAS float* PL = (LAS float*)(C.lds + RING_OFF);
    LAS float* SS = PL + 4 * 64 * 33;
    LAS int* hist = (LAS int*)(SS + 512);
    LAS int* gb = hist + 32;
    const int rg = C.wave & 1, kq = C.wave >> 1, r32 = C.lane & 31, hi = C.lane >> 5;
    const bf16* wh = C.Wr_t + (size_t)r32 * 2048 + 512 * kq + 16 * hi; const bf16* wl = wh + 32 * 2048;
    for (int blk = C.vcu; blk < T / 64; blk += C.G) {
        if (C.tid < 32) hist[C.tid] = 0;
        const int tok = blk * 64 + 32 * rg + r32;
        const float* hr = C.out + (size_t)tok * DM + 512 * kq + 16 * hi;
        f32x16 acc = f32x16{}; float ss = 0.f;
#pragma unroll 2
        for (int kb = 0; kb < 16; ++kb) {
            float f[16];
#pragma unroll
            for (int q = 0; q < 4; ++q) { const f32x4 t = *(const GAS f32x4*)(hr + 32 * kb + 4 * q); f[4 * q] = t.x; f[4 * q + 1] = t.y; f[4 * q + 2] = t.z; f[4 * q + 3] = t.w; }
            unsigned hb[16], lb[16];
#pragma unroll
            for (int q = 0; q < 16; ++q) { ss += f[q] * f[q]; hb[q] = f2bf(f[q]); lb[q] = f2bf(f[q] - __uint_as_float(hb[q] << 16)); }
#pragma unroll
            for (int s = 0; s < 2; ++s) {
                const bf16x8 ah = *(const GAS bf16x8*)(wh + 32 * kb + 8 * s), al = *(const GAS bf16x8*)(wl + 32 * kb + 8 * s);
                v4u bh, bl;
                bh.x = hb[8 * s] | (hb[8 * s + 1] << 16); bh.y = hb[8 * s + 2] | (hb[8 * s + 3] << 16); bh.z = hb[8 * s + 4] | (hb[8 * s + 5] << 16); bh.w = hb[8 * s + 6] | (hb[8 * s + 7] << 16);
                bl.x = lb[8 * s] | (lb[8 * s + 1] << 16); bl.y = lb[8 * s + 2] | (lb[8 * s + 3] << 16); bl.z = lb[8 * s + 4] | (lb[8 * s + 5] << 16); bl.w = lb[8 * s + 6] | (lb[8 * s + 7] << 16);
                acc = __builtin_amdgcn_mfma_f32_32x32x16_bf16(ah, __builtin_bit_cast(bf16x8, bh), acc, 0, 0, 0);
                acc = __builtin_amdgcn_mfma_f32_32x32x16_bf16(ah, __builtin_bit_cast(bf16x8, bl), acc, 0, 0, 0);
                acc = __builtin_amdgcn_mfma_f32_32x32x16_bf16(al, __builtin_bit_cast(bf16x8, bh), acc, 0, 0, 0);
            }
        }
        { LAS float* pr = PL + (size_t)(kq * 64 + 32 * rg + r32) * 33;
#pragma unroll
          for (int r = 0; r < 16; ++r) pr[att::crow(r, hi)] = acc[r];
          SS[(kq * 2 + hi) * 64 + 32 * rg + r32] = ss; }
        __syncthreads();
        int sel[4]; float gt[4]; float rstd = 0.f; int lr[4];
        if (C.tid < 64) {
            float lv[32]; float s2 = 0.f;
#pragma unroll
            for (int q = 0; q < 8; ++q) s2 += SS[q * 64 + C.tid];
            rstd = 1.0f / sqrtf(s2 * (1.f / DM) + NORM_EPS);
#pragma unroll
            for (int e = 0; e < 32; ++e) { const float a = (PL[(0 * 64 + C.tid) * 33 + e] + PL[(1 * 64 + C.tid) * 33 + e]) + (PL[(2 * 64 + C.tid) * 33 + e] + PL[(3 * 64 + C.tid) * 33 + e]); lv[e] = a * rstd + C.b_router[e]; }
            float val[4];
#pragma unroll
            for (int k = 0; k < 4; ++k) { float best = lv[0]; int bi = 0;
#pragma unroll
                for (int e = 1; e < 32; ++e) if (lv[e] > best) { best = lv[e]; bi = e; }
                sel[k] = bi; val[k] = best;
#pragma unroll
                for (int e = 0; e < 32; ++e) lv[e] = (e == bi) ? -INFINITY : lv[e]; }
            float den = 0.f;
#pragma unroll
            for (int k = 0; k < 4; ++k) { gt[k] = __expf(val[k] - val[0]); den += gt[k]; }
            const float inv = 1.0f / den;
#pragma unroll
            for (int k = 0; k < 4; ++k) { gt[k] *= inv; lr[k] = __hip_atomic_fetch_add((LAS int*)(hist + sel[k]), 1, __ATOMIC_RELAXED, __HIP_MEMORY_SCOPE_WORKGROUP); }
        }
        __syncthreads();
        if (C.tid < 32) gb[C.tid] = (int)__hip_atomic_fetch_add((unsigned*)(C.ctl + CW_CNT + C.tid), (unsigned)hist[C.tid], RLX_AGENT);
        __syncthreads();
        if (C.tid < 64) {
            const int t = blk * 64 + C.tid;
#pragma unroll
            for (int k = 0; k < 4; ++k) { const int sl = sel[k] * CAP + gb[sel[k]] + lr[k]; C.TOK[sl] = t; C.RS[sl] = rstd; C.TSLOT[t * 4 + k] = sl; C.TGATE[t * 4 + k] = gt[k]; }
        }
        __syncthreads();
    }
}
template <int NT>
__device__ __forceinline__ void moe_table(const Ctx& C, LAS int* tab) {
    __syncthreads();
    if (C.tid == 0) { int us = 0, rb = 0;
        for (int e = 0; e < 32; ++e) { const int n = (int)__hip_atomic_load((unsigned*)(C.ctl + CW_CNT + e), RLX_AGENT); const int mt = (n + 255) >> 8; tab[e] = us; tab[33 + e] = mt; tab[65 + e] = rb; tab[97 + e] = n; us += mt * NT; rb += mt * 256; }
        tab[32] = us; }
    __syncthreads();
}


__device__ __forceinline__ void phase9(const Ctx& C, const LAS int* tab) {
    const int gw = C.vcu * NWAVES + C.wave, NGW = C.G * NWAVES;
    for (int t = gw; t < T; t += NGW) {
        typedef int v4i_ __attribute__((ext_vector_type(4))); const v4i_ sl = *(const GAS v4i_*)(C.TSLOT + 4 * t); const f32x4 g = *(const GAS f32x4*)(C.TGATE + 4 * t);
        const int s[4] = {sl.x, sl.y, sl.z, sl.w}; const float gg[4] = {g.x, g.y, g.z, g.w};
        const bf16* yr[4];
#pragma unroll
        for (int k = 0; k < 4; ++k) { const int e = s[k] >> 14, rk = s[k] & (CAP - 1); yr[k] = C.Y + (size_t)(tab[65 + e] + rk) * DM + 8 * C.lane; }
        float* orow = C.out + (size_t)t * DM + 8 * C.lane;
#pragma unroll
        for (int j = 0; j < 4; ++j) {
            f32x4 a0 = *(const GAS f32x4*)(orow + 512 * j), a1 = *(const GAS f32x4*)(orow + 512 * j + 4);
#pragma unroll
            for (int k = 0; k < 4; ++k) { const v4u y = *(const GAS v4u*)(yr[k] + 512 * j);
                a0.x += gg[k] * pg8::bf_lo(y.x); a0.y += gg[k] * pg8::bf_hi(y.x); a0.z += gg[k] * pg8::bf_lo(y.y); a0.w += gg[k] * pg8::bf_hi(y.y);
                a1.x += gg[k] * pg8::bf_lo(y.z); a1.y += gg[k] * pg8::bf_hi(y.z); a1.z += gg[k] * pg8::bf_lo(y.w); a1.w += gg[k] * pg8::bf_hi(y.w); }
            *(GAS f32x4*)(orow + 512 * j) = a0; *(GAS f32x4*)(orow + 512 * j + 4) = a1;
        }
    }
}

struct Args { const void* in[26]; float* out; unsigned char* ws; int ph_lo, ph_hi; };
__global__ void __launch_bounds__(NWAVES * 64, 2) mk_fwd(Args args) {
    extern __shared__ __attribute__((aligned(16))) unsigned char lds_raw[];
    Ctx C;
    C.lds = (LAS unsigned char*)lds_raw;
    C.MISC = (volatile LAS unsigned*)(C.lds + MISC_OFF);
    C.tid = threadIdx.x; C.lane = C.tid & 63; C.wave = __builtin_amdgcn_readfirstlane(C.tid >> 6);
    C.G = gridDim.x; { const int bx = blockIdx.x; C.vcu = (C.G % 8 == 0) ? (bx % 8) * (C.G / 8) + bx / 8 : bx; }
    unsigned char* ws = args.ws;
    C.ctl = (gu32*)(ws + WS_CTL);
    C.x = (const float*)args.in[0]; C.mem = (const float*)args.in[1]; C.pos = (const int*)args.in[2]; C.norm_mix = (const float*)args.in[3]; C.w_in = (const float*)args.in[4];
    C.b_forget = (const float*)args.in[5]; C.fox_q_norm = (const float*)args.in[6]; C.fox_k_norm = (const float*)args.in[7]; C.swa_q_norm = (const float*)args.in[8]; C.swa_k_norm = (const float*)args.in[9];
    C.swa_sinks = (const float*)args.in[10]; C.xmem_q_norm = (const float*)args.in[11]; C.xmem_k_norm = (const float*)args.in[12]; C.norm_mem = (const float*)args.in[13]; C.w_mem_kv = (const float*)args.in[14];
    C.w_up_fox = (const float*)args.in[15]; C.w_up_swa = (const float*)args.in[16]; C.w_up_xmem = (const float*)args.in[17]; C.w_out = (const float*)args.in[18]; C.norm_ffn = (const float*)args.in[19];
    C.w_router = (const float*)args.in[20]; C.b_router = (const float*)args.in[21]; C.w_gate_up = (const float*)args.in[22]; C.b_gate_up = (const float*)args.in[23]; C.w_down = (const float*)args.in[24]; C.b_down = (const float*)args.in[25];
    C.out = args.out;
    C.Win_t = (bf16*)(ws + WS_WIN); C.Wmkv_t = (bf16*)(ws + WS_WMKV); C.Wup_t = (bf16*)(ws + WS_WUP); C.Wout_t = (bf16*)(ws + WS_WOUT); C.Wr_t = (bf16*)(ws + WS_WRT); C.Wgu_t = (bf16*)(ws + WS_WGU); C.Wd_t = (bf16*)(ws + WS_WD);
    C.XN = (bf16*)(ws + WS_XN); C.MN = (bf16*)(ws + WS_MN); C.QKV = (bf16*)(ws + WS_QKV); C.G_ = (bf16*)(ws + WS_G); C.MKV = (bf16*)(ws + WS_MKV); C.OALL = (bf16*)(ws + WS_OALL); C.MERGED = (bf16*)(ws + WS_MERGED);
    C.HB = (bf16*)(ws + WS_HB); C.ACT = (bf16*)(ws + WS_ACT); C.LOGF = (float*)(ws + WS_LOGF); C.CNEG = (float*)(ws + WS_CNEG); C.ROPE = (float*)(ws + WS_ROPE); C.GATEW = (float*)(ws + WS_GATE); C.RS = (float*)(ws + WS_RS);
    C.TOK = (int*)(ws + WS_TOK); C.TSLOT = (int*)(ws + WS_TSLOT); C.TGATE = (float*)(ws + WS_TGATE); C.Y = (bf16*)(ws + WS_Y);
    for (int u = C.tid; u < (LDS_BYTES - LDSCTL_OFF) / 4; u += NWAVES * 64) ((LAS unsigned*)(C.lds + LDSCTL_OFF))[u] = 0u;
    __syncthreads();
    XcdBarrier bar; bar.bar = (unsigned*)(C.ctl + CW_BAR); bar.x = 0; bar.st = nullptr;
    if (N_LAUNCHES == 1) bar = xcd_barrier_post((unsigned*)(C.ctl + CW_BAR), C.MISC + 8);
    const int lo = args.ph_lo, hi = args.ph_hi;
#ifndef MK_PHASE_MASK
#define MK_PHASE_MASK 0x3FF
#endif
#define IN(k) ((((MK_PHASE_MASK) >> (k)) & 1) && lo <= (k) && (k) < hi)
#define SEAM(k) do { if (IN(k) && IN((k) + 1)) xcd_barrier(bar); } while (0)
    LAS int* tab = (LAS int*)(C.lds + MOE_OFF);

    if (IN(0)) { phase0(C); }
    SEAM(0);
    if (IN(1)) {
        P1Order S; S.d.init(C.XN, C.Win_t, T, 10240, C.G, (int)blockIdx.x); S.A1 = (const char*)C.MN; S.B1 = (const char*)C.Wmkv_t;
        EpiInProj E{C.QKV, C.G_, C.MKV};
        pg8::gemm_phase<EpiInProj, P1Order>(C.lds + RING_OFF, S, E);
    }
    SEAM(1);
    if (IN(2)) { phase2(C); }
    SEAM(2);
    if (IN(3)) { phase3(C); }
    SEAM(3);
    if (IN(4)) {
        DenseOrder S; S.init(C.OALL, C.Wup_t, T, DM, C.G, (int)blockIdx.x);
        EpiMerge E{C.G_, C.MERGED};
        pg8::gemm_phase<EpiMerge, DenseOrder>(C.lds + RING_OFF, S, E);
    }
    SEAM(4);
    if (IN(5)) {
        DenseOrder S; S.init(C.MERGED, C.Wout_t, T, DM, C.G, (int)blockIdx.x);
        EpiOut E{C.x, C.out, (unsigned char*)C.HB};
        pg8::gemm_phase<EpiOut, DenseOrder>(C.lds + RING_OFF, S, E);
    }
    SEAM(5);
    if (IN(6)) { phase6(C); }
    SEAM(6);
    if (IN(7)) {
        moe_table<16>(C, tab);
        MoeOrder<true, 16, 2048> S{(const char*)C.HB, (const char*)C.Wgu_t, C.TOK, (const int*)(C.ctl + CW_CNT), tab, C.G, C.vcu};
        EpiGateUp E{C.RS, C.b_gate_up, (unsigned char*)C.ACT};
        pg8::gemm_phase<EpiGateUp, MoeOrder<true, 16, 2048>>(C.lds + RING_OFF, S, E);
    }
    SEAM(7);
    if (IN(8)) {
        moe_table<8>(C, tab);
        MoeOrder<false, 8, 2048> S{(const char*)C.ACT, (const char*)C.Wd_t, C.TOK, (const int*)(C.ctl + CW_CNT), tab, C.G, C.vcu};
        EpiDown E{C.b_down, C.Y};
        pg8::gemm_phase<EpiDown, MoeOrder<false, 8, 2048>>(C.lds + RING_OFF, S, E);
    }
    SEAM(8);
    if (IN(9)) { moe_table<8>(C, tab); phase9(C, tab); }
#undef IN
#undef SEAM
}

extern "C" void kernel_launch(void* const* d_in, const int* in_sizes, int n_in, void* d_out, int out_size, void* d_ws, size_t ws_size, hipStream_t stream) {
    static int grid = 0;
    if (grid == 0) {
        if (n_in != 26 || out_size != T * DM || ws_size < WS_END) { fprintf(stderr, "kernel_launch: unexpected problem (n_in %d, out %d, ws %zu < %zu); nothing launched\n", n_in, out_size, ws_size, (size_t)WS_END); grid = -1; return; }
        int dev = 0, cus = 0, per_cu = 0;
        if (hipGetDevice(&dev) != hipSuccess || hipDeviceGetAttribute(&cus, hipDeviceAttributeMultiprocessorCount, dev) != hipSuccess) { grid = -1; return; }
        if (hipFuncSetAttribute((const void*)mk_fwd, hipFuncAttributeMaxDynamicSharedMemorySize, LDS_BYTES) != hipSuccess) { fprintf(stderr, "kernel_launch: hipFuncSetAttribute failed\n"); grid = -1; return; }
        if (hipOccupancyMaxActiveBlocksPerMultiprocessor(&per_cu, (const void*)mk_fwd, NWAVES * 64, LDS_BYTES) != hipSuccess || per_cu < 1) { fprintf(stderr, "kernel_launch: occupancy query says %d\n", per_cu); }
        (void)hipGetLastError();
        grid = cus;
    }
    if (grid < 0) return;
    if (hipMemsetAsync((char*)d_ws + WS_CTL, 0, CTL_ZERO_BYTES, stream) != hipSuccess) return;
    Args a{};
    for (int i = 0; i < 26; ++i) a.in[i] = d_in[i];
    a.out = (float*)d_out; a.ws = (unsigned char*)d_ws;
    if (N_LAUNCHES == 1) { a.ph_lo = 0; a.ph_hi = PER_PHASE; hipLaunchKernelGGL(mk_fwd, dim3(grid), dim3(NWAVES * 64), LDS_BYTES, stream, a); }
    else for (int li = 0; li < PER_PHASE; ++li) { a.ph_lo = li; a.ph_hi = li + 1; hipLaunchKernelGGL(mk_fwd, dim3(grid), dim3(NWAVES * 64), LDS_BYTES, stream, a);
#ifdef PROBE_DUP
        if (li == PROBE_DUP) { if (PROBE_DUP == 3 || PROBE_DUP == 6) hipMemsetAsync((char*)d_ws + WS_CTL, 0, CTL_ZERO_BYTES / 2, stream); hipLaunchKernelGGL(mk_fwd, dim3(grid), dim3(NWAVES * 64), LDS_BYTES, stream, a); }
#endif
    }
    const hipError_t le = hipPeekAtLastError();
    if (le != hipSuccess) fprintf(stderr, "kernel_launch: launch failed: %s\n", hipGetErrorName(le));
}
```

```cpp
#include <hip/hip_runtime.h>
#include <cstdio>
#include <cstdint>

#define LAS __attribute__((address_space(3)))
#define GAS __attribute__((address_space(1)))

namespace pg8 {
typedef unsigned short bf16_t;
typedef short bf16x8 __attribute__((ext_vector_type(8)));
typedef float f32x4 __attribute__((ext_vector_type(4)));
typedef float f32x2 __attribute__((ext_vector_type(2)));
typedef unsigned u32x4 __attribute__((ext_vector_type(4)));
typedef unsigned u32x2 __attribute__((ext_vector_type(2)));
constexpr int BM = 256, BK = 64, HALF = 128, HTB = HALF * BK * 2, STAGE_BYTES = 8 * HTB, NXCD = 8, WGM = 8;
constexpr int KD = 2048;
typedef int v8i __attribute__((ext_vector_type(8))); typedef int v4i __attribute__((ext_vector_type(4)));
__device__ __forceinline__ v8i cat8(bf16x8 lo, bf16x8 hi) { const v4i a = __builtin_bit_cast(v4i, lo), b = __builtin_bit_cast(v4i, hi); return __builtin_shufflevector(a, b, 0, 1, 2, 3, 4, 5, 6, 7); }
__device__ __forceinline__ bf16x8 lo8(v8i v) { return __builtin_bit_cast(bf16x8, (v4i)__builtin_shufflevector(v, v, 0, 1, 2, 3)); }
__device__ __forceinline__ bf16x8 hi8(v8i v) { return __builtin_bit_cast(bf16x8, (v4i)__builtin_shufflevector(v, v, 4, 5, 6, 7)); }

__host__ __device__ __forceinline__ int lds_byte(int r, int c) { const int st = (r >> 4) * 2 + (c >> 5), rr = r & 15, cc = c & 31, ob = rr * 64 + cc * 2; return st * 1024 + (ob ^ (((ob >> 9) & 1) << 5)); }
__host__ __device__ __forceinline__ void stage_rc(int b, int& R, int& C) { const int st = b / 1024, sb = b % 1024, swz = sb ^ (((sb >> 9) & 1) << 5); R = (st >> 1) * 16 + swz / 64; C = (st & 1) * 32 + (swz % 64) / 2; }
__host__ __device__ __forceinline__ int perm32(int rho) { const int n = rho >> 4, i = rho & 15; return 8 * (i >> 2) + 4 * n + (i & 3); }

__device__ __forceinline__ void glds_s(const char* sbase, unsigned voff, unsigned lds_dst) { unsigned keep;
    asm volatile("s_mov_b32 %0, m0\n\ts_mov_b32 m0, %3\n\ts_nop 0\n\tglobal_load_lds_dwordx4 %1, %2\n\ts_mov_b32 m0, %0" : "=&s"(keep) : "v"(voff), "s"(sbase), "s"(lds_dst) : "memory"); }

#define PG8_PIN4(a, b, c, d, txt) asm volatile(txt : "+v"(a), "+v"(b), "+v"(c), "+v"(d))
#define PG8_PIN_ACC(txt) do { _Pragma("unroll") for (int _a = 0; _a < 2; ++_a) _Pragma("unroll") for (int _b = 0; _b < 2; ++_b) { \
        PG8_PIN4(acc[_a][_b][0][0], acc[_a][_b][0][1], acc[_a][_b][1][0], acc[_a][_b][1][1], ""); PG8_PIN4(acc[_a][_b][2][0], acc[_a][_b][2][1], acc[_a][_b][3][0], acc[_a][_b][3][1], ""); } \
        PG8_PIN4(acc[0][0][0][0], acc[0][1][0][0], acc[1][0][0][0], acc[1][1][0][0], txt); \
        _Pragma("unroll") for (int _a = 0; _a < 2; ++_a) _Pragma("unroll") for (int _b = 0; _b < 2; ++_b) { \
        PG8_PIN4(acc[_a][_b][0][0], acc[_a][_b][0][1], acc[_a][_b][1][0], acc[_a][_b][1][1], ""); PG8_PIN4(acc[_a][_b][2][0], acc[_a][_b][2][1], acc[_a][_b][3][0], acc[_a][_b][3][1], ""); } } while (0)

struct Unit { int pm, pn, e, kind; };

typedef float f32x2_cv __attribute__((ext_vector_type(2))); typedef __bf16 bf16x2_cv __attribute__((ext_vector_type(2)));
__device__ __forceinline__ unsigned cvt_pk_bf16(float lo, float hi) { const f32x2_cv v = {lo, hi}; const bf16x2_cv b = __builtin_convertvector(v, bf16x2_cv); return __builtin_bit_cast(unsigned, b); }
__device__ __forceinline__ float bf_lo(unsigned w) { return __uint_as_float(w << 16); }
__device__ __forceinline__ float bf_hi(unsigned w) { return __uint_as_float(w & 0xffff0000u); }

template <class Epi, class Sched, bool ALIGN_EPI = true, bool SP2 = true>
__device__ __forceinline__ void gemm_phase(LAS unsigned char* lds, const Sched& S, const Epi& E) {
    const int tid = threadIdx.x, wid = __builtin_amdgcn_readfirstlane(tid >> 6), lane = tid & 63, wr = wid >> 2, wc = wid & 3, fr = lane & 15, fq = lane >> 4;
    constexpr bool FP8 = Epi::FP8; constexpr int RB = FP8 ? 2048 : 4096, nt = RB / 128;
    unsigned voffB[2]; int RA[2], CA[2];
#pragma unroll
    for (int i = 0; i < 2; ++i) { int R, C; stage_rc(tid * 16 + i * 8192, R, C); const int Rb = Epi::PERM ? ((R & ~31) + perm32(R & 31)) : R;
        voffB[i] = (unsigned)(Rb * RB + C * 2); RA[i] = R; CA[i] = C; }
    constexpr size_t kstep = (size_t)(BK * 2);
    constexpr size_t hstep = (size_t)HALF * RB;
    const unsigned ldsbase = (unsigned)__builtin_amdgcn_readfirstlane((unsigned)(uintptr_t)lds + (unsigned)wid * 1024u);
    const int aoff = lds_byte(wr * 64 + fr, fq * 8), boff = lds_byte(wc * 32 + fr, fq * 8);
#define PG8_SA(b, h) (((b) * 2 + (h)) * HTB)
#define PG8_SB(b, h) ((4 + (b) * 2 + (h)) * HTB)
#define PG8_STAGE(bufoff, gbase, voff) do { _Pragma("unroll") for (int _i = 0; _i < 2; ++_i) \
        glds_s((const char*)(gbase), (voff)[_i], ldsbase + (unsigned)((bufoff) + _i * 8192)); } while (0)
#define PG8_LDA(dst, b, h) do { _Pragma("unroll") for (int m = 0; m < 4; ++m) dst[m] = cat8(*(const LAS bf16x8*)(lds + PG8_SA(b, h) + aoff + m * 2048), *(const LAS bf16x8*)(lds + PG8_SA(b, h) + aoff + m * 2048 + 1024)); } while (0)
#define PG8_LDB(dst, b, h) do { _Pragma("unroll") for (int n = 0; n < 2; ++n) dst[n] = cat8(*(const LAS bf16x8*)(lds + PG8_SB(b, h) + boff + n * 2048), *(const LAS bf16x8*)(lds + PG8_SB(b, h) + boff + n * 2048 + 1024)); } while (0)
#define PG8_MMA(ai, bj, At, Bt) do { __builtin_amdgcn_s_setprio(1); _Pragma("unroll") for (int m = 0; m < 4; ++m) _Pragma("unroll") for (int n = 0; n < 2; ++n) { \
        if constexpr (FP8 && Epi::ASM_MFMA) asm volatile("v_mfma_scale_f32_16x16x128_f8f6f4 %0, %1, %2, %0, %3, %4 op_sel_hi:[0,0,0]" : "+v"(acc[ai][bj][m][n]) : "v"(Bt[n]), "v"(At[m]), "v"(scl_b), "v"(scl_a)); \
        else if constexpr (FP8) acc[ai][bj][m][n] = __builtin_amdgcn_mfma_scale_f32_16x16x128_f8f6f4(Bt[n], At[m], acc[ai][bj][m][n], 0, 0, 0, Epi::SCALE_B, 0, Epi::SCALE_A); \
        else { acc[ai][bj][m][n] = __builtin_amdgcn_mfma_f32_16x16x32_bf16(lo8(Bt[n]), lo8(At[m]), acc[ai][bj][m][n], 0, 0, 0); \
               acc[ai][bj][m][n] = __builtin_amdgcn_mfma_f32_16x16x32_bf16(hi8(Bt[n]), hi8(At[m]), acc[ai][bj][m][n], 0, 0, 0); } } \
        __builtin_amdgcn_s_setprio(0); } while (0)
#ifdef PROBE_DRAIN8
#define PG8_WAIT_V(n) do { if constexpr (FP8 && !Epi::ASM_MFMA) asm volatile("s_waitcnt vmcnt(0)" ::: "memory"); else asm volatile("s_waitcnt vmcnt(" #n ")" ::: "memory"); } while (0)
#else
#define PG8_WAIT_V(n) asm volatile("s_waitcnt vmcnt(" #n ")" ::: "memory")
#endif
#define PG8_WAIT_L(n) asm volatile("s_waitcnt lgkmcnt(" #n ")" ::: "memory")
#define PG8_BAR __builtin_amdgcn_s_barrier()
#define PG8_SCHED __builtin_amdgcn_sched_barrier(0)
    Unit cur, nxt; int ui = 0;
    int scl_a = Epi::SCALE_A, scl_b = Epi::SCALE_B; asm volatile("" : "+v"(scl_a), "+v"(scl_b));
    if (!S.next(0, cur)) return;
    f32x4 acc[2][2][4][2];
#pragma unroll
    for (int a = 0; a < 2; ++a)
#pragma unroll
        for (int b = 0; b < 2; ++b)
#pragma unroll
            for (int m = 0; m < 4; ++m)
#pragma unroll
                for (int n = 0; n < 2; ++n) acc[a][b][m][n] = (f32x4){0.f, 0.f, 0.f, 0.f};
    if constexpr (Epi::FP8) PG8_PIN_ACC("s_nop 7");
    v8i At[4], B0[2], B1[2];
    const char* cA = S.a_base(cur); const char* cB = S.b_base(cur);
    unsigned vo[2][2], nvo[2][2];
    S.a_offs(cur, RA, CA, vo);
    bool has_next = S.next(1, nxt);
    if (has_next) S.a_offs(nxt, RA, CA, nvo); else { nvo[0][0] = vo[0][0]; nvo[0][1] = vo[0][1]; nvo[1][0] = vo[1][0]; nvo[1][1] = vo[1][1]; }
    if constexpr (SP2) {
        PG8_STAGE(PG8_SB(0, 0), cB, voffB); PG8_STAGE(PG8_SB(0, 1), cB + hstep, voffB); PG8_STAGE(PG8_SA(0, 0), cA, vo[0]); PG8_STAGE(PG8_SA(0, 1), cA, vo[1]);
        if (wr == 1) PG8_BAR;
        PG8_WAIT_V(2); PG8_BAR;
        PG8_STAGE(PG8_SB(1, 0), cB + kstep, voffB); PG8_STAGE(PG8_SA(1, 0), cA + kstep, vo[0]); PG8_STAGE(PG8_SB(1, 1), cB + hstep + kstep, voffB);
        PG8_WAIT_V(6); PG8_BAR;
    } else {
        PG8_STAGE(PG8_SB(0, 0), cB, voffB); PG8_STAGE(PG8_SA(0, 0), cA, vo[0]); PG8_STAGE(PG8_SB(0, 1), cB + hstep, voffB); PG8_STAGE(PG8_SA(0, 1), cA, vo[1]);
        if (wr == 1) PG8_BAR;
        PG8_WAIT_V(4); PG8_BAR;
        PG8_STAGE(PG8_SB(1, 0), cB + kstep, voffB); PG8_STAGE(PG8_SA(1, 0), cA + kstep, vo[0]); PG8_STAGE(PG8_SB(1, 1), cB + hstep + kstep, voffB);
        PG8_WAIT_V(6); PG8_BAR;
    }
    for (;;) {
        const char* nA = has_next ? S.a_base(nxt) : cA; const char* nB = has_next ? S.b_base(nxt) : cB;
        for (int t = 0; t < nt; t += 2) {
            const bool last = (t == nt - 2);
            const char* a1 = cA + (size_t)(t + 1) * kstep;
            const char* a2 = last ? nA : cA + (size_t)(t + 2) * kstep; const char* b2 = last ? nB : cB + (size_t)(t + 2) * kstep;
            const char* a3 = a2 + kstep; const char* b3 = b2 + kstep;
            unsigned v2[2][2];
            v2[0][0] = last ? nvo[0][0] : vo[0][0]; v2[0][1] = last ? nvo[0][1] : vo[0][1]; v2[1][0] = last ? nvo[1][0] : vo[1][0]; v2[1][1] = last ? nvo[1][1] : vo[1][1];
            if constexpr (SP2) {
            PG8_LDB(B0, 0, 0); PG8_LDB(B1, 0, 1); PG8_SCHED; PG8_LDA(At, 0, 0); PG8_STAGE(PG8_SA(1, 1), a1, vo[1]);
            PG8_WAIT_V(8); PG8_WAIT_L(0); PG8_BAR; PG8_MMA(0, 0, At, B0); PG8_MMA(0, 1, At, B1); PG8_BAR; PG8_SCHED;
            PG8_LDA(At, 0, 1); PG8_STAGE(PG8_SB(0, 0), b2, voffB); PG8_STAGE(PG8_SB(0, 1), b2 + hstep, voffB); PG8_STAGE(PG8_SA(0, 0), a2, v2[0]);
            PG8_WAIT_V(8); PG8_WAIT_L(0); PG8_BAR; PG8_MMA(1, 0, At, B0); PG8_MMA(1, 1, At, B1); PG8_BAR; PG8_SCHED;
            PG8_LDB(B0, 1, 0); PG8_LDB(B1, 1, 1); PG8_SCHED; PG8_LDA(At, 1, 0); PG8_STAGE(PG8_SA(0, 1), a2, v2[1]);
            PG8_WAIT_V(8); PG8_WAIT_L(0); PG8_BAR; PG8_MMA(0, 0, At, B0); PG8_MMA(0, 1, At, B1); PG8_BAR; PG8_SCHED;
            PG8_LDA(At, 1, 1); PG8_STAGE(PG8_SB(1, 0), b3, voffB); PG8_STAGE(PG8_SB(1, 1), b3 + hstep, voffB); PG8_STAGE(PG8_SA(1, 0), a3, v2[0]);
            PG8_WAIT_V(8); PG8_WAIT_L(0); PG8_BAR; PG8_MMA(1, 0, At, B0); PG8_MMA(1, 1, At, B1); PG8_BAR; PG8_SCHED;
            } else {
            PG8_LDB(B0, 0, 0); PG8_SCHED; PG8_LDA(At, 0, 0); PG8_STAGE(PG8_SA(1, 1), a1, vo[1]);
            PG8_WAIT_L(8); PG8_BAR; PG8_WAIT_L(0); PG8_MMA(0, 0, At, B0); PG8_BAR; PG8_SCHED;
            PG8_LDB(B1, 0, 1); PG8_STAGE(PG8_SB(0, 0), b2, voffB);
            PG8_BAR; PG8_WAIT_L(0); PG8_MMA(0, 1, At, B1); PG8_BAR;
            PG8_LDA(At, 0, 1); PG8_STAGE(PG8_SA(0, 0), a2, v2[0]);
            PG8_BAR; PG8_WAIT_L(0); PG8_MMA(1, 0, At, B0); PG8_BAR; PG8_SCHED;
            PG8_STAGE(PG8_SB(0, 1), b2 + hstep, voffB);
            PG8_WAIT_V(6); PG8_BAR; PG8_MMA(1, 1, At, B1); PG8_BAR;
            PG8_LDB(B0, 1, 0); PG8_SCHED; PG8_LDA(At, 1, 0); PG8_STAGE(PG8_SA(0, 1), a2, v2[1]);
            PG8_WAIT_L(8); PG8_BAR; PG8_WAIT_L(0); PG8_MMA(0, 0, At, B0); PG8_BAR; PG8_SCHED;
            PG8_LDB(B1, 1, 1); PG8_STAGE(PG8_SB(1, 0), b3, voffB);
            PG8_BAR; PG8_WAIT_L(0); PG8_MMA(0, 1, At, B1); PG8_BAR;
            PG8_LDA(At, 1, 1); PG8_STAGE(PG8_SA(1, 0), a3, v2[0]);
            PG8_BAR; PG8_WAIT_L(0); PG8_MMA(1, 0, At, B0); PG8_BAR; PG8_SCHED;
            PG8_STAGE(PG8_SB(1, 1), b3 + hstep, voffB);
            PG8_WAIT_V(6); PG8_BAR; PG8_MMA(1, 1, At, B1); PG8_BAR;
            }
            if constexpr (Epi::MID) { if (t == 10 || t == 22) E.mid(acc, cur, t == 22 ? 1 : 0, wr, wc, fr, fq); }
        }
        Unit nn; const bool has_nn = has_next && S.next(ui + 2, nn); unsigned nnvo[2][2];
        if (has_nn) S.a_offs(nn, RA, CA, nnvo); else { nnvo[0][0] = nvo[0][0]; nnvo[0][1] = nvo[0][1]; nnvo[1][0] = nvo[1][0]; nnvo[1][1] = nvo[1][1]; }
        if constexpr (ALIGN_EPI) { if (wr == 0) PG8_BAR; }
        if constexpr (FP8) PG8_PIN_ACC("s_nop 15\n\ts_nop 7");
        E(acc, cur, wr, wc, fr, fq);
        if (!has_next) break;
#pragma unroll
        for (int a = 0; a < 2; ++a)
#pragma unroll
            for (int b = 0; b < 2; ++b)
#pragma unroll
                for (int m = 0; m < 4; ++m)
#pragma unroll
                    for (int n = 0; n < 2; ++n) acc[a][b][m][n] = (f32x4){0.f, 0.f, 0.f, 0.f};
        if constexpr (FP8) PG8_PIN_ACC("s_nop 7");
        cur = nxt; cA = nA; cB = nB; ++ui; nxt = nn; has_next = has_nn;
        vo[0][0] = nvo[0][0]; vo[0][1] = nvo[0][1]; vo[1][0] = nvo[1][0]; vo[1][1] = nvo[1][1];
        nvo[0][0] = nnvo[0][0]; nvo[0][1] = nnvo[0][1]; nvo[1][0] = nnvo[1][0]; nvo[1][1] = nnvo[1][1];
        if constexpr (ALIGN_EPI) { if (wr == 1) PG8_BAR; }
    }
    PG8_WAIT_V(0);
    if constexpr (!ALIGN_EPI) { if (wr == 0) PG8_BAR; }
    PG8_BAR;
#undef PG8_SA
#undef PG8_SB
#undef PG8_STAGE
#undef PG8_LDA
#undef PG8_LDB
#undef PG8_MMA
#undef PG8_WAIT_V
#undef PG8_WAIT_L
#undef PG8_BAR
#undef PG8_SCHED
}
}

constexpr int NWAVES = 8;
constexpr int BATCH = 2, SEQ = 8192, DM = 2048, T = BATCH * SEQ;
constexpr int NMEM = 256, MROWS = BATCH * NMEM;
constexpr int INW = 10252;
constexpr int NEXP = 32, TOPK = 4, CAP = T;
constexpr int QKVW = 4096;
constexpr int C_FQ = 0, C_FK = 768, C_FV = 1536, C_SQ = 2304, C_SK = 3072, C_SV = 3328, C_MQ = 3584;
constexpr int GW = 6144;
constexpr float NORM_EPS = 1e-6f;
constexpr float LOG2E = 1.4426950408889634f;
constexpr float SWIGLU_LIMIT = 7.0f, SWIGLU_ALPHA = 1.702f;
constexpr int PER_PHASE = 10;
#ifndef MK_N_LAUNCHES
#define MK_N_LAUNCHES 1
#endif
constexpr int N_LAUNCHES = MK_N_LAUNCHES;

constexpr size_t MiB = 1u << 20;
constexpr size_t WS_CTL = 0, CTL_ZERO_BYTES = 1 * MiB;
constexpr size_t WS_WIN   = 2 * MiB;
constexpr size_t WS_WMKV  = WS_WIN + 40 * MiB;
constexpr size_t WS_WUP   = WS_WMKV + 4 * MiB;
constexpr size_t WS_WOUT  = WS_WUP + 8 * MiB;
constexpr size_t WS_WRT   = WS_WOUT + 8 * MiB;
constexpr size_t WS_WGU   = WS_WRT + 1 * MiB;
constexpr size_t WS_WD    = WS_WGU + 512 * MiB;
constexpr size_t WS_XN    = WS_WD + 256 * MiB;
constexpr size_t WS_MN    = WS_XN + 64 * MiB;
constexpr size_t WS_LOGF  = WS_MN + 2 * MiB;
constexpr size_t WS_CNEG  = WS_LOGF + 1 * MiB;
constexpr size_t WS_ROPE  = WS_CNEG + 1 * MiB;
constexpr size_t WS_QKV   = WS_ROPE + 4 * MiB;
constexpr size_t WS_G     = WS_QKV + 128 * MiB;
constexpr size_t WS_MKV   = WS_G + 192 * MiB;
constexpr size_t WS_OALL  = WS_MKV + 1 * MiB;
constexpr size_t WS_MERGED= WS_OALL + 64 * MiB;
constexpr size_t WS_HB    = WS_MERGED + 64 * MiB;
constexpr size_t WS_TOK   = WS_HB + 64 * MiB;
constexpr size_t WS_GATE  = WS_TOK + 2 * MiB;
constexpr size_t WS_RS    = WS_GATE + 2 * MiB;
constexpr size_t WS_ACT   = WS_RS + 2 * MiB;
constexpr size_t WS_Y     = WS_ACT + 288 * MiB;
constexpr size_t WS_TSLOT = WS_Y + 288 * MiB;
constexpr size_t WS_TGATE = WS_TSLOT + 1 * MiB;
constexpr size_t WS_XN8   = WS_TGATE + 1 * MiB;
constexpr size_t WS_WIN8  = WS_XN8 + 32 * MiB;
constexpr size_t WS_END   = WS_WIN8 + 12 * MiB;
constexpr int CW_BAR = 4096;
constexpr int CW_QHEAD = 64;
constexpr int CW_CNT = 512;

typedef unsigned short bf16;
typedef unsigned v4u __attribute__((ext_vector_type(4)));
typedef unsigned v2u __attribute__((ext_vector_type(2)));
typedef float f32x4 __attribute__((ext_vector_type(4)));
typedef float f32x16 __attribute__((ext_vector_type(16)));
typedef short bf16x8 __attribute__((ext_vector_type(8)));
typedef short s16x4 __attribute__((ext_vector_type(4)));
typedef GAS unsigned gu32;
#define RLX_AGENT __ATOMIC_RELAXED, __HIP_MEMORY_SCOPE_AGENT
#define LDS_WAIT() asm volatile("s_waitcnt lgkmcnt(0)" ::: "memory")
#define VM_WAIT() asm volatile("s_waitcnt vmcnt(0)" ::: "memory")
__device__ __forceinline__ unsigned f2bf(float f) { unsigned u = __builtin_bit_cast(unsigned, f); return (u + 0x7fffu + ((u >> 16) & 1u)) >> 16; }
__device__ __forceinline__ unsigned pk2(float lo, float hi) { return f2bf(lo) | (f2bf(hi) << 16); }
__device__ __forceinline__ float bf2f(unsigned short b) { return __uint_as_float(((unsigned)b) << 16); }
__device__ __forceinline__ float wave_sum(float v) {
#pragma unroll
    for (int o = 1; o < 64; o <<= 1) v += __shfl_xor(v, o);
    return v;
}
__device__ __forceinline__ float sigmoidf_(float x) { return __builtin_amdgcn_rcpf(1.0f + __builtin_amdgcn_exp2f(x * (-LOG2E))); }

constexpr int H8_SHIFT = 4, ACT8_SHIFT = 2, W8_SHIFT = 9;
constexpr float H8_MUL = 16.0f, ACT8_MUL = 4.0f, W8_MUL = 512.0f;
__device__ __forceinline__ float clamp_fp8(float v) { return __builtin_amdgcn_fmed3f(v, -448.0f, 448.0f); }
__device__ __forceinline__ unsigned pk4_fp8(float a, float b, float c, float d) {
    int p = __builtin_amdgcn_cvt_pk_fp8_f32(clamp_fp8(a), clamp_fp8(b), 0, false); p = __builtin_amdgcn_cvt_pk_fp8_f32(clamp_fp8(c), clamp_fp8(d), p, true); return (unsigned)p; }
using pg8::f32x2; using pg8::u32x4; using pg8::u32x2; using pg8::cvt_pk_bf16; using pg8::bf_lo; using pg8::bf_hi;

#define XB_TMO      128
#define XB_XCNT(j)  (256  + 64 * (j))
#define XB_XSUB(j)  (1280 + 64 * (j))
#define XB_XGEN(j)  (2304 + 64 * (j))
#define XB_TOP      3328
#define XB_TOPGEN   3392
#define XCD_BAR_WORDS 3456
#define XB_SPIN_CAP (1u << 18)

__device__ __forceinline__ unsigned xb_ld(unsigned* p)              { return __hip_atomic_load(p, __ATOMIC_RELAXED, __HIP_MEMORY_SCOPE_AGENT); }
__device__ __forceinline__ unsigned xb_add(unsigned* p, unsigned v) { return __hip_atomic_fetch_add(p, v, __ATOMIC_RELAXED, __HIP_MEMORY_SCOPE_AGENT); }
__device__ __forceinline__ unsigned xb_xcc_id() { return (unsigned)__builtin_amdgcn_s_getreg((3 << 11) | 20) & 0xFu; }
#define XB_SPIN(cond, bar) do { unsigned _sp = 0; while (cond) { __builtin_amdgcn_s_sleep(1); \
    if ((++_sp & 255u) == 0u) { if (xb_ld(&(bar)[XB_TMO])) break; if (_sp > XB_SPIN_CAP) { atomicAdd(&(bar)[XB_TMO], 1u); break; } } } } while (0)

struct XcdBarrier { unsigned* bar; unsigned x; volatile LAS unsigned* st; };

__device__ __forceinline__ XcdBarrier xcd_barrier_post(unsigned* bar, volatile LAS unsigned* st) {
    XcdBarrier b; b.bar = bar; b.x = xb_xcc_id(); b.st = st;
    if (threadIdx.x == 0) (void)xb_add(&bar[XB_XCNT(b.x)], 1u);
    return b;
}
__device__ __forceinline__ void xcd_barrier_complete(unsigned* bar, unsigned x, unsigned& nloc, unsigned& nx) {
    const unsigned G = gridDim.x * gridDim.y * gridDim.z;
    unsigned sum, cnt, mine, sp = 0u;
    for (;;) {
        sum = 0u; cnt = 0u; mine = 0u;
#pragma unroll
        for (unsigned j = 0; j < 16; ++j) { const unsigned c = xb_ld(&bar[XB_XCNT(j)]); sum += c; cnt += (c > 0u) ? 1u : 0u; mine = (j == x) ? c : mine; }
        if (sum == G) break;
        __builtin_amdgcn_s_sleep(1);
        if ((++sp & 255u) == 0u) { if (xb_ld(&bar[XB_TMO])) break; if (sp > XB_SPIN_CAP) { atomicAdd(&bar[XB_TMO], 1u); break; } }
    }
    nloc = mine > 0u ? mine : 1u; nx = cnt > 0u ? cnt : 1u;
}
__device__ __forceinline__ void xcd_barrier(const XcdBarrier& b) {
    asm volatile("s_waitcnt vmcnt(0)" ::: "memory");
    __syncthreads();
    if (threadIdx.x == 0) {
        unsigned* bar = b.bar;
        __builtin_amdgcn_s_waitcnt(0);
        unsigned nloc = b.st[0], nx = b.st[1];
        if (nloc == 0u) { xcd_barrier_complete(bar, b.x, nloc, nx); b.st[0] = nloc; b.st[1] = nx; }
        const unsigned old = xb_add(&bar[XB_XSUB(b.x)], 1u);
        const unsigned gen = old / nloc;
        if (old + 1u == (gen + 1u) * nloc) {
            __builtin_amdgcn_fence(__ATOMIC_RELEASE, "agent");
            asm volatile("s_waitcnt vmcnt(0)" ::: "memory");
            const unsigned og = xb_add(&bar[XB_TOP], 1u);
            const unsigned tg = og / nx;
            if (og + 1u == (tg + 1u) * nx) xb_add(&bar[XB_TOPGEN], 1u);
            else XB_SPIN(xb_ld(&bar[XB_TOPGEN]) == tg, bar);
            __builtin_amdgcn_fence(__ATOMIC_ACQUIRE, "agent");
            xb_add(&bar[XB_XGEN(b.x)], 1u);
            asm volatile("s_waitcnt vmcnt(0)" ::: "memory");
        } else {
            XB_SPIN(xb_ld(&bar[XB_XGEN(b.x)]) == gen, bar);
            __builtin_amdgcn_fence(__ATOMIC_ACQUIRE, "agent");
            asm volatile("s_waitcnt vmcnt(0)" ::: "memory");
        }
    }
    __syncthreads();
}

constexpr int RING_OFF = 0, RING_BYTES = 131072;
constexpr int LDSCTL_OFF = RING_BYTES, MISC_OFF = LDSCTL_OFF + 320;
constexpr int MOE_OFF = MISC_OFF + 128;
constexpr int LDS_BYTES = 147456;

struct Ctx {
    LAS unsigned char* lds;
    volatile LAS unsigned* MISC;
    gu32* ctl;
    int tid, lane, wave, vcu, G;
    const float *x, *mem; const int* pos; const float *norm_mix, *w_in, *b_forget, *fox_q_norm, *fox_k_norm, *swa_q_norm, *swa_k_norm, *swa_sinks, *xmem_q_norm, *xmem_k_norm, *norm_mem,
        *w_mem_kv, *w_up_fox, *w_up_swa, *w_up_xmem, *w_out, *norm_ffn, *w_router, *b_router, *w_gate_up, *b_gate_up, *w_down, *b_down;
    float* out;
    bf16 *Win_t, *Wmkv_t, *Wup_t, *Wout_t, *Wr_t, *Wgu_t, *Wd_t, *XN, *MN, *QKV, *G_, *MKV, *OALL, *MERGED, *HB, *ACT;
    float *LOGF, *CNEG, *ROPE, *GATEW, *RS, *TGATE; int *TOK, *TSLOT; bf16* Y; unsigned char *XN8, *Win8;
};

#ifndef PROBE_INW
#define PROBE_INW 64
#endif
__constant__ float INV_FREQ[32] = {1.000000000e+00f, 7.498942614e-01f, 5.623413324e-01f, 4.216965139e-01f, 3.162277639e-01f, 2.371373773e-01f, 1.778279394e-01f, 1.333521307e-01f,
    1.000000015e-01f, 7.498941571e-02f, 5.623413250e-02f, 4.216965288e-02f, 3.162277490e-02f, 2.371373773e-02f, 1.778279431e-02f, 1.333521493e-02f, 9.999999776e-03f, 7.498941850e-03f,
    5.623413250e-03f, 4.216964822e-03f, 3.162277630e-03f, 2.371373586e-03f, 1.778279431e-03f, 1.333521446e-03f, 1.000000047e-03f, 7.498942432e-04f, 5.623413017e-04f, 4.216965172e-04f,
    3.162277571e-04f, 2.371373703e-04f, 1.778279402e-04f, 1.333521504e-04f};

struct TItem { const float* src; const float* ksc; bf16* dst; size_t ldw; int f8; };
__device__ __forceinline__ void titem_load(const TItem& I, f32x4 (&v)[8][2], float (&sc)[8][2], int lane) {
    const int rr = lane >> 4, c4 = lane & 15;
#pragma unroll
    for (int p = 0; p < 8; ++p)
#pragma unroll
        for (int h = 0; h < 2; ++h) { const int k = 8 * p + 2 * rr + h; v[p][h] = *(const GAS f32x4*)(I.src + (size_t)k * I.ldw + 4 * c4); sc[p][h] = I.ksc ? I.ksc[k] : 1.0f; }
}
__device__ __forceinline__ void titem_store(const TItem& I, const f32x4 (&v)[8][2], const float (&sc)[8][2], LAS unsigned* tile, int lane) {
    const int rr = lane >> 4, c4 = lane & 15;
#pragma unroll
    for (int p = 0; p < 8; ++p)
#pragma unroll
        for (int q = 0; q < 4; ++q) { const int n = 4 * c4 + q, sw = (n ^ (n >> 3)) & 7;
            tile[n * 32 + 4 * (p ^ sw) + rr] = pg8::cvt_pk_bf16(v[p][0][q] * sc[p][0], v[p][1][q] * sc[p][1]); }
    LDS_WAIT(); asm volatile("" ::: "memory");
#pragma unroll
    for (int j = 0; j < 8; ++j) { const int n = 8 * j + (lane >> 3), c = lane & 7, sw = (n ^ (n >> 3)) & 7;
        const v4u o = *(const LAS v4u*)(tile + n * 32 + 4 * (c ^ sw));
        *(GAS v4u*)(I.dst + (size_t)n * DM + 8 * c) = o; }
    LDS_WAIT(); asm volatile("" ::: "memory");
}
__device__ __forceinline__ void titem8_load(const TItem& I, f32x4 (&v)[8][2], float (&sc)[8][2], int lane) {
    const int rr = lane >> 4, c4 = lane & 15;
#pragma unroll
    for (int p = 0; p < 4; ++p)
#pragma unroll
        for (int h = 0; h < 4; ++h) { const int k = 16 * p + 4 * rr + h; v[2 * p + (h >> 1)][h & 1] = *(const GAS f32x4*)(I.src + (size_t)k * I.ldw + 4 * c4); sc[2 * p + (h >> 1)][h & 1] = (I.ksc ? I.ksc[k] : 1.0f) * W8_MUL; }
}
__device__ __forceinline__ void titem8_store(const TItem& I, const f32x4 (&v)[8][2], const float (&sc)[8][2], LAS unsigned* tile, int lane) {
    const int rr = lane >> 4, c4 = lane & 15;
#pragma unroll
    for (int p = 0; p < 4; ++p)
#pragma unroll
        for (int q = 0; q < 4; ++q) { const int n = 4 * c4 + q, sw = (n >> 2) & 3;
            tile[n * 16 + 4 * (p ^ sw) + rr] = pk4_fp8(v[2 * p][0][q] * sc[2 * p][0], v[2 * p][1][q] * sc[2 * p][1], v[2 * p + 1][0][q] * sc[2 * p + 1][0], v[2 * p + 1][1][q] * sc[2 * p + 1][1]); }
    LDS_WAIT(); asm volatile("" ::: "memory");
#pragma unroll
    for (int j = 0; j < 4; ++j) { const int n = 16 * j + (lane >> 2), c = lane & 3, sw = (n >> 2) & 3;
        const v4u o = *(const LAS v4u*)(tile + n * 16 + 4 * (c ^ sw));
        *(GAS v4u*)((unsigned char*)I.dst + (size_t)n * DM + 16 * c) = o; }
    LDS_WAIT(); asm volatile("" ::: "memory");
}
__device__ __forceinline__ void p0_router_item(const float* W, int k0, bf16* WT, const float* ksc, LAS float* scr, int lane) {
#pragma unroll 8
    for (int i = 0; i < 32; ++i) { const int kk = 2 * i + (lane >> 5); scr[kk * 33 + (lane & 31)] = W[(size_t)(k0 + kk) * 32 + (lane & 31)] * ksc[k0 + kk]; }
    LDS_WAIT(); asm volatile("" ::: "memory");
    const int c = lane & 7;
#pragma unroll
    for (int j = 0; j < 4; ++j) { const int n = (lane >> 3) + 8 * j; const LAS float* s = scr + (8 * c) * 33 + n;
        unsigned h[8], l[8];
#pragma unroll
        for (int q = 0; q < 8; ++q) { const float v = s[q * 33]; h[q] = f2bf(v); l[q] = f2bf(v - __uint_as_float(h[q] << 16)); }
        v4u oh, ol; oh.x = h[0] | (h[1] << 16); oh.y = h[2] | (h[3] << 16); oh.z = h[4] | (h[5] << 16); oh.w = h[6] | (h[7] << 16);
        ol.x = l[0] | (l[1] << 16); ol.y = l[2] | (l[3] << 16); ol.z = l[4] | (l[5] << 16); ol.w = l[6] | (l[7] << 16);
        *(GAS v4u*)(WT + (size_t)n * 2048 + k0 + 8 * c) = oh; *(GAS v4u*)(WT + (size_t)(32 + n) * 2048 + k0 + 8 * c) = ol; }
    LDS_WAIT(); asm volatile("" ::: "memory");
}
__device__ __forceinline__ float log_sigmoidf_(float z) { return fminf(z, 0.f) - log1pf(__expf(-fabsf(z))); }

template <bool XROW>
__device__ __forceinline__ void p0_norm_row(const Ctx& C, const float* xrow, const float* gain, bf16* orow, const LAS float* Wf, int m) {
    const GAS f32x4* xr = (const GAS f32x4*)xrow + C.lane; const GAS f32x4* gr = (const GAS f32x4*)gain + C.lane;
    f32x4 v[8]; float s = 0.f;
#pragma unroll
    for (int j = 0; j < 8; ++j) { v[j] = xr[64 * j]; s += (v[j].x * v[j].x + v[j].y * v[j].y) + (v[j].z * v[j].z + v[j].w * v[j].w); }
    const float rstd = 1.0f / sqrtf(wave_sum(s) * (1.f / DM) + NORM_EPS);
    GAS unsigned long long* o8 = (GAS unsigned long long*)orow + C.lane;
#pragma unroll
    for (int j = 0; j < 8; ++j) { const f32x4 g = gr[64 * j]; v[j] = (v[j] * rstd) * g;
        o8[64 * j] = (unsigned long long)pk2(v[j].x, v[j].y) | ((unsigned long long)pk2(v[j].z, v[j].w) << 32);
        if constexpr (XROW) ((GAS unsigned*)(C.XN8 + (size_t)m * DM))[C.lane + 64 * j] = pk4_fp8(v[j].x * H8_MUL, v[j].y * H8_MUL, v[j].z * H8_MUL, v[j].w * H8_MUL); }
    if constexpr (XROW) {
        float mine = 0.f;
#pragma unroll 1
        for (int h = 0; h < 12; ++h) { const LAS f32x4* w = (const LAS f32x4*)(Wf + h * 2048) + C.lane; float d = 0.f;
#pragma unroll
            for (int j = 0; j < 8; ++j) { const f32x4 ww = w[64 * j]; d += (v[j].x * ww.x + v[j].y * ww.y) + (v[j].z * ww.z + v[j].w * ww.w); }
            d = wave_sum(d); if (C.lane == h) mine = d; }
        const int b = m / SEQ, t = m % SEQ;
        if (C.lane < 12) C.LOGF[(size_t)(b * 12 + C.lane) * SEQ + t] = log_sigmoidf_(mine + C.b_forget[C.lane]);
        if (C.lane < 32) { const float ang = (float)C.pos[m] * INV_FREQ[C.lane]; const double rev = (double)ang * 0.15915494309189535; const float fr = (float)(rev - floor(rev));
            C.ROPE[(size_t)m * 64 + C.lane] = __builtin_amdgcn_cosf(fr); C.ROPE[(size_t)m * 64 + 32 + C.lane] = __builtin_amdgcn_sinf(fr); }
    }
}
__device__ __forceinline__ void phase0(const Ctx& C) {
    LAS float* Wf = (LAS float*)(C.lds + RING_OFF);
    for (int idx = C.tid; idx < 12 * 2048; idx += NWAVES * 64) { const int k = idx / 12, h = idx - 12 * k; Wf[h * 2048 + k] = C.w_in[(size_t)k * INW + 2304 + h]; }
    __syncthreads();
    const int gw = C.vcu * NWAVES + C.wave, NGW = C.G * NWAVES;
    for (int m = gw; m < T; m += NGW) p0_norm_row<true>(C, C.x + (size_t)m * DM, C.norm_mix, C.XN + (size_t)m * DM, Wf, m);
    for (int m = gw; m < MROWS; m += NGW) p0_norm_row<false>(C, C.mem + (size_t)m * DM, C.norm_mem, C.MN + (size_t)m * DM, Wf, m);
    __syncthreads();
    LAS float* scr = (LAS float*)(C.lds + RING_OFF + C.wave * 16384);
    for (int r = gw; r < 32; r += NGW) p0_router_item(C.w_router, 64 * r, C.Wr_t, C.norm_ffn, scr, C.lane);
    constexpr int I_GU = 32 * 32 * 64, I_D = 32 * 32 * 32, I_ING = 32 * 96, I_IN = 32 * PROBE_INW, I_MKV = 32 * 16, I_UF = 12 * 32, I_US = 12 * 32, I_UX = 8 * 32, I_O = 32 * 32;
    constexpr int NITEMS = I_GU + I_D + I_ING + I_IN + I_MKV + I_UF + I_US + I_UX + I_O;
    auto decode = [&](int it) -> TItem {
        TItem I; int r = it; I.ksc = nullptr; I.f8 = 0;
        if (r < I_GU) { const int e = r / 2048, q = r % 2048, kb = q / 64, pb = q % 64, tl = pb >> 2, jb = pb & 3;
            const int n0 = (jb < 2) ? (128 * tl + 64 * jb) : (2048 + 128 * tl + 64 * (jb - 2));
            I.ldw = 4096; I.src = C.w_gate_up + (size_t)e * DM * 4096 + (size_t)(64 * kb) * 4096 + n0; I.ksc = C.norm_ffn + 64 * kb; I.f8 = 1; I.dst = (bf16*)((unsigned char*)C.Wgu_t + ((size_t)e * 4096 + 64 * pb) * DM + 64 * kb); return I; } r -= I_GU;
        if (r < I_D) { const int e = r / 1024, q = r % 1024, kb = q / 32, nb = q % 32;
            I.ldw = DM; I.src = C.w_down + (size_t)e * DM * DM + (size_t)(64 * kb) * DM + 64 * nb; I.f8 = 1; I.dst = (bf16*)((unsigned char*)C.Wd_t + ((size_t)e * DM + 64 * nb) * DM + 64 * kb); return I; } r -= I_D;
        if (r < I_ING) { const int kb = r / 96, pb = r % 96;
            I.ldw = INW; I.src = C.w_in + (size_t)(64 * kb) * INW + 4108 + 64 * pb; I.f8 = 1; I.dst = (bf16*)((unsigned char*)C.Win8 + (size_t)(64 * pb) * DM + 64 * kb); return I; } r -= I_ING;
        if (r < I_IN) { const int kb = r / PROBE_INW, pb = r % PROBE_INW; const int n0 = (64 * pb < 2304) ? 64 * pb : 64 * pb + 12;
            I.ldw = INW; I.src = C.w_in + (size_t)(64 * kb) * INW + n0; I.dst = C.Win_t + (size_t)(64 * pb) * DM + 64 * kb; return I; } r -= I_IN;
        if (r < I_MKV) { const int kb = r / 16, nb = r % 16; I.ldw = 1024; I.src = C.w_mem_kv + (size_t)(64 * kb) * 1024 + 64 * nb; I.dst = C.Wmkv_t + (size_t)(64 * nb) * DM + 64 * kb; return I; } r -= I_MKV;
        if (r < I_UF) { const int kb = r / 32, nb = r % 32; I.ldw = DM; I.src = C.w_up_fox + (size_t)(64 * kb) * DM + 64 * nb; I.dst = C.Wup_t + (size_t)(64 * nb) * DM + 64 * kb; return I; } r -= I_UF;
        if (r < I_US) { const int kb = r / 32, nb = r % 32; I.ldw = DM; I.src = C.w_up_swa + (size_t)(64 * kb) * DM + 64 * nb; I.dst = C.Wup_t + (size_t)(64 * nb) * DM + 768 + 64 * kb; return I; } r -= I_US;
        if (r < I_UX) { const int kb = r / 32, nb = r % 32; I.ldw = DM; I.src = C.w_up_xmem + (size_t)(64 * kb) * DM + 64 * nb; I.dst = C.Wup_t + (size_t)(64 * nb) * DM + 1536 + 64 * kb; return I; } r -= I_UX;
        { const int kb = r / 32, nb = r % 32; I.ldw = DM; I.src = C.w_out + (size_t)(64 * kb) * DM + 64 * nb; I.dst = C.Wout_t + (size_t)(64 * nb) * DM + 64 * kb; return I; }
    };
    LAS unsigned* tile = (LAS unsigned*)(C.lds + RING_OFF + C.wave * 8192);
    __syncthreads();
    constexpr int N8 = I_GU + I_D + I_ING;
    if (gw < N8) {
        TItem cur = decode(gw); f32x4 va[8][2]; float sa[8][2]; titem8_load(cur, va, sa, C.lane);
        for (int it = gw; it < N8; it += NGW) {
            const int nx = it + NGW; TItem nxt = cur; f32x4 vb[8][2]; float sb[8][2];
            if (nx < N8) { nxt = decode(nx); titem8_load(nxt, vb, sb, C.lane); }
            titem8_store(cur, va, sa, tile, C.lane);
            cur = nxt;
#pragma unroll
            for (int p = 0; p < 8; ++p)
#pragma unroll
                for (int h = 0; h < 2; ++h) { va[p][h] = vb[p][h]; sa[p][h] = sb[p][h]; }
        }
    }
    if (N8 + gw < NITEMS) {
        TItem cur = decode(N8 + gw); f32x4 va[8][2]; float sa[8][2]; titem_load(cur, va, sa, C.lane);
        for (int it = N8 + gw; it < NITEMS; it += NGW) {
            const int nx = it + NGW; TItem nxt = cur; f32x4 vb[8][2]; float sb[8][2];
            if (nx < NITEMS) { nxt = decode(nx); titem_load(nxt, vb, sb, C.lane); }
            titem_store(cur, va, sa, tile, C.lane);
            cur = nxt;
#pragma unroll
            for (int p = 0; p < 8; ++p)
#pragma unroll
                for (int h = 0; h < 2; ++h) { va[p][h] = vb[p][h]; sa[p][h] = sb[p][h]; }
        }
    }
}


using pg8::Unit;
template <int RB>
struct DenseOrderT {
    const char* A; const char* Bt; int nM, nN, nwg, G, c;
    __device__ __forceinline__ void init(const void* A_, const void* Bt_, int M, int N, int G_, int c_) { A = (const char*)A_; Bt = (const char*)Bt_; nM = M / 256; nN = N / 256; nwg = nM * nN; G = G_; c = c_; }
    __device__ __forceinline__ bool map(long L, Unit& u) const {
        if (L >= nwg) return false;
        int wgid = (int)L; { const int q = nwg / 8, r = nwg % 8, xcd = wgid % 8, off = wgid / 8; wgid = (xcd < r ? xcd * (q + 1) : r * (q + 1) + (xcd - r) * q) + off; }
        const int nig = 8 * nN, gid = wgid / nig, fm = gid * 8, gsz = (nM - fm) < 8 ? (nM - fm) : 8;
        u.pm = fm + ((wgid % nig) % gsz); u.pn = (wgid % nig) / gsz; u.e = 0; u.kind = 0; return true;
    }
    __device__ __forceinline__ bool next(int i, Unit& u) const { return map((long)i * G + c, u); }
    __device__ __forceinline__ const char* a_base(const Unit& u) const { return A + (size_t)u.pm * (256 * RB); }
    __device__ __forceinline__ const char* b_base(const Unit& u) const { return Bt + (size_t)u.pn * (256 * RB); }
    __device__ __forceinline__ void a_offs(const Unit&, const int (&R)[2], const int (&Cc)[2], unsigned (&vo)[2][2]) const {
#pragma unroll
        for (int h = 0; h < 2; ++h)
#pragma unroll
            for (int i = 0; i < 2; ++i) vo[h][i] = (unsigned)((h * 128 + R[i]) * RB + Cc[i] * 2);
    }
};
typedef DenseOrderT<4096> DenseOrder;
struct P1Order {
    DenseOrder d; const char* A1; const char* B1;
    __device__ __forceinline__ bool next(int i, Unit& u) const {
        const long L = (long)i * d.G + d.c;
        if (L < d.nwg) return d.map(L, u);
        const int r = (int)(L - d.nwg); if (r >= 8) return false;
        u.pm = r >> 2; u.pn = r & 3; u.e = 0; u.kind = 1; return true;
    }
    __device__ __forceinline__ const char* a_base(const Unit& u) const { return (u.kind ? A1 : d.A) + (size_t)u.pm * (256 * 2048 * 2); }
    __device__ __forceinline__ const char* b_base(const Unit& u) const { return (u.kind ? B1 : d.Bt) + (size_t)u.pn * (256 * 2048 * 2); }
    __device__ __forceinline__ void a_offs(const Unit& u, const int (&R)[2], const int (&Cc)[2], unsigned (&vo)[2][2]) const { d.a_offs(u, R, Cc, vo); }
};
template <bool GATHER, int NT, int RB>
struct MoeOrder {
    const char* A; const char* Bt; const int* tok; const int* cnt; const LAS int* tab; int G, c;
    __device__ __forceinline__ bool next(int i, Unit& u) const {
        const int L = i * G + c; if (L >= __builtin_amdgcn_readfirstlane(tab[32])) return false;
        int e = 0;
#pragma unroll 1
        for (int j = 1; j < 32; ++j) e += (__builtin_amdgcn_readfirstlane(tab[j]) <= L) ? 1 : 0;
        const int j = L - __builtin_amdgcn_readfirstlane(tab[e]), mt = __builtin_amdgcn_readfirstlane(tab[33 + e]), per = mt * 4, ntg = j / per, r = j - ntg * per;
        u.e = e; u.pm = r >> 2; u.pn = ntg * 4 + (r & 3); u.kind = __builtin_amdgcn_readfirstlane(tab[65 + e]) + 256 * u.pm;
        return true;
    }
    __device__ __forceinline__ const char* a_base(const Unit& u) const { return GATHER ? A : A + (size_t)u.kind * RB; }
    __device__ __forceinline__ const char* b_base(const Unit& u) const { return Bt + ((size_t)u.e * NT + u.pn) * (256 * RB); }
    __device__ __forceinline__ void a_offs(const Unit& u, const int (&R)[2], const int (&Cc)[2], unsigned (&vo)[2][2]) const {
#pragma unroll
        for (int h = 0; h < 2; ++h)
#pragma unroll
            for (int i = 0; i < 2; ++i) {
                if constexpr (GATHER) { const int n_e = __builtin_amdgcn_readfirstlane(tab[97 + u.e]); int ri = 256 * u.pm + h * 128 + R[i]; ri = ri < n_e ? ri : n_e - 1;
                    const int row = tok[u.e * CAP + ri]; vo[h][i] = (unsigned)(row * RB + Cc[i] * 2); }
                else vo[h][i] = (unsigned)((h * 128 + R[i]) * RB + Cc[i] * 2);
            }
    }
};

struct EpiInProj {
    static constexpr bool PERM = true, MID = false, FP8 = false, ASM_MFMA = false; static constexpr int SCALE_A = 0x7f, SCALE_B = 0x7f;
    bf16* QKV; bf16* Gt; bf16* MKV; int noop;
    __device__ __forceinline__ void mid(pg8::f32x4 (&)[2][2][4][2], const Unit&, int, int, int, int, int) const {}
    __device__ __forceinline__ void operator()(const pg8::f32x4 (&acc)[2][2][4][2], const Unit& u, int wr, int wc, int fr, int fq) const {
        asm volatile("" : "+v"(fr), "+v"(fq));
        if (noop) return;
        const int row0 = u.pm * 256 + wr * 64 + fr;
        bf16* base; int ldc, colt; bool sg = false;
        if (u.kind) { base = MKV; ldc = 1024; colt = u.pn * 256; }
        else if (u.pn < 16) { base = QKV; ldc = QKVW; colt = u.pn * 256; }
        else { base = Gt; ldc = GW; colt = (u.pn - 16) * 256; sg = true; }
        const int col0 = colt + wc * 32 + 8 * fq;
#pragma unroll
        for (int ai = 0; ai < 2; ++ai)
#pragma unroll
            for (int m = 0; m < 4; ++m) { bf16* rowp = base + (size_t)(row0 + ai * 128 + m * 16) * ldc + col0;
#pragma unroll
                for (int bj = 0; bj < 2; ++bj) { pg8::f32x4 v0 = acc[ai][bj][m][0], v1 = acc[ai][bj][m][1];
                    if (sg) {
#pragma unroll
                        for (int q = 0; q < 4; ++q) { v0[q] = sigmoidf_(fmaxf(v0[q], -30.f)); v1[q] = sigmoidf_(fmaxf(v1[q], -30.f)); } }
                    u32x4 w; w.x = cvt_pk_bf16(v0[0], v0[1]); w.y = cvt_pk_bf16(v0[2], v0[3]); w.z = cvt_pk_bf16(v1[0], v1[1]); w.w = cvt_pk_bf16(v1[2], v1[3]);
                    *(u32x4*)(rowp + bj * 128) = w; } }
    }
};
#ifndef PROBE_GASM
#define PROBE_GASM true
#endif
struct EpiGates {
    static constexpr bool PERM = true, MID = false, FP8 = true, ASM_MFMA = PROBE_GASM; static constexpr int SCALE_A = 127 - H8_SHIFT, SCALE_B = 127 - W8_SHIFT;
    bf16* Gt;
    __device__ __forceinline__ void mid(pg8::f32x4 (&)[2][2][4][2], const Unit&, int, int, int, int, int) const {}
    __device__ __forceinline__ void operator()(const pg8::f32x4 (&acc)[2][2][4][2], const Unit& u, int wr, int wc, int fr, int fq) const {
        asm volatile("" : "+v"(fr), "+v"(fq));
        const int row0 = u.pm * 256 + wr * 64 + fr, col0 = u.pn * 256 + wc * 32 + 8 * fq;
#pragma unroll
        for (int ai = 0; ai < 2; ++ai)
#pragma unroll
            for (int m = 0; m < 4; ++m) { bf16* rowp = Gt + (size_t)(row0 + ai * 128 + m * 16) * GW + col0;
#pragma unroll
                for (int bj = 0; bj < 2; ++bj) { pg8::f32x4 v0 = acc[ai][bj][m][0], v1 = acc[ai][bj][m][1];
#pragma unroll
                    for (int q = 0; q < 4; ++q) { v0[q] = sigmoidf_(fmaxf(v0[q], -30.f)); v1[q] = sigmoidf_(fmaxf(v1[q], -30.f)); }
                    u32x4 w; w.x = cvt_pk_bf16(v0[0], v0[1]); w.y = cvt_pk_bf16(v0[2], v0[3]); w.z = cvt_pk_bf16(v1[0], v1[1]); w.w = cvt_pk_bf16(v1[2], v1[3]);
                    *(u32x4*)(rowp + bj * 128) = w; } }
    }
};
struct EpiMerge {
    static constexpr bool PERM = true, MID = true, FP8 = false, ASM_MFMA = false; static constexpr int SCALE_A = 0x7f, SCALE_B = 0x7f;
    const bf16* Gt; bf16* O;
    __device__ __forceinline__ void mid(pg8::f32x4 (&acc)[2][2][4][2], const Unit& u, int which, int wr, int wc, int fr, int fq) const {
        asm volatile("" : "+v"(fr), "+v"(fq));
        const int row0 = u.pm * 256 + wr * 64 + fr, col0 = u.pn * 256 + wc * 32 + 8 * fq;
        const bf16* gn = Gt + (which ? 2048 : 0); const bf16* gd = Gt + (which ? 4096 : 2048);
#pragma unroll
        for (int ai = 0; ai < 2; ++ai)
#pragma unroll
            for (int m = 0; m < 4; ++m) { const size_t ro = (size_t)(row0 + ai * 128 + m * 16) * GW + col0;
#pragma unroll
                for (int bj = 0; bj < 2; ++bj) { const u32x4 a = *(const u32x4*)(gn + ro + bj * 128), b = *(const u32x4*)(gd + ro + bj * 128);
                    pg8::f32x4 r0, r1;
                    r0[0] = bf_lo(a.x) * __builtin_amdgcn_rcpf(bf_lo(b.x)); r0[1] = bf_hi(a.x) * __builtin_amdgcn_rcpf(bf_hi(b.x)); r0[2] = bf_lo(a.y) * __builtin_amdgcn_rcpf(bf_lo(b.y)); r0[3] = bf_hi(a.y) * __builtin_amdgcn_rcpf(bf_hi(b.y));
                    r1[0] = bf_lo(a.z) * __builtin_amdgcn_rcpf(bf_lo(b.z)); r1[1] = bf_hi(a.z) * __builtin_amdgcn_rcpf(bf_hi(b.z)); r1[2] = bf_lo(a.w) * __builtin_amdgcn_rcpf(bf_lo(b.w)); r1[3] = bf_hi(a.w) * __builtin_amdgcn_rcpf(bf_hi(b.w));
                    acc[ai][bj][m][0] *= r0; acc[ai][bj][m][1] *= r1; }
                asm volatile("" : "+v"(acc[ai][0][m][0]), "+v"(acc[ai][0][m][1]), "+v"(acc[ai][1][m][0]), "+v"(acc[ai][1][m][1]));
                asm volatile("" ::: "memory"); }
    }
    __device__ __forceinline__ void operator()(const pg8::f32x4 (&acc)[2][2][4][2], const Unit& u, int wr, int wc, int fr, int fq) const {
        asm volatile("" : "+v"(fr), "+v"(fq));
        const int row0 = u.pm * 256 + wr * 64 + fr, col0 = u.pn * 256 + wc * 32 + 8 * fq;
#pragma unroll
        for (int ai = 0; ai < 2; ++ai)
#pragma unroll
            for (int m = 0; m < 4; ++m) { const size_t rr = (size_t)(row0 + ai * 128 + m * 16);
#pragma unroll
                for (int bj = 0; bj < 2; ++bj) { const u32x4 g = *(const u32x4*)(Gt + rr * GW + 4096 + col0 + bj * 128);
                    const pg8::f32x4 v0 = acc[ai][bj][m][0], v1 = acc[ai][bj][m][1];
                    u32x4 w; w.x = cvt_pk_bf16(v0[0] * bf_lo(g.x), v0[1] * bf_hi(g.x)); w.y = cvt_pk_bf16(v0[2] * bf_lo(g.y), v0[3] * bf_hi(g.y));
                    w.z = cvt_pk_bf16(v1[0] * bf_lo(g.z), v1[1] * bf_hi(g.z)); w.w = cvt_pk_bf16(v1[2] * bf_lo(g.w), v1[3] * bf_hi(g.w));
                    *(u32x4*)(O + rr * DM + col0 + bj * 128) = w; }
                asm volatile("" ::: "memory"); }
    }
};
struct EpiOut {
    static constexpr bool PERM = false, MID = false, FP8 = false, ASM_MFMA = false; static constexpr int SCALE_A = 0x7f, SCALE_B = 0x7f;
    const float* X; float* out; unsigned char* HB8;
    __device__ __forceinline__ void mid(pg8::f32x4 (&)[2][2][4][2], const Unit&, int, int, int, int, int) const {}
    __device__ __forceinline__ void operator()(const pg8::f32x4 (&acc)[2][2][4][2], const Unit& u, int wr, int wc, int fr, int fq) const {
        asm volatile("" : "+v"(fr), "+v"(fq));
        const int row0 = u.pm * 256 + wr * 64 + fr, col0 = u.pn * 256 + wc * 32 + 4 * fq;
#pragma unroll
        for (int ai = 0; ai < 2; ++ai)
#pragma unroll
            for (int m = 0; m < 4; ++m) { const size_t off = (size_t)(row0 + ai * 128 + m * 16) * DM + col0;
#pragma unroll
                for (int bj = 0; bj < 2; ++bj)
#pragma unroll
                    for (int n = 0; n < 2; ++n) { const size_t o2 = off + bj * 128 + n * 16; const pg8::f32x4 h = *(const pg8::f32x4*)(X + o2) + acc[ai][bj][m][n];
                        *(pg8::f32x4*)(out + o2) = h; *(unsigned*)(HB8 + o2) = pk4_fp8(h[0] * H8_MUL, h[1] * H8_MUL, h[2] * H8_MUL, h[3] * H8_MUL); } }
    }
};
struct EpiGateUp {
    static constexpr bool PERM = true, MID = false, FP8 = true, ASM_MFMA = true; static constexpr int SCALE_A = 127 - H8_SHIFT, SCALE_B = 127 - W8_SHIFT;
    const float* RS; const float* bgu; unsigned char* ACT8;
    __device__ __forceinline__ void mid(pg8::f32x4 (&)[2][2][4][2], const Unit&, int, int, int, int, int) const {}
    __device__ __forceinline__ void operator()(const pg8::f32x4 (&acc)[2][2][4][2], const Unit& u, int wr, int wc, int fr, int fq) const {
        asm volatile("" : "+v"(fr), "+v"(fq));
        const int r0 = wr * 64 + fr, hc0 = u.pn * 128 + wc * 32 + 8 * fq;
        const float* bg = bgu + (size_t)u.e * 4096 + hc0;
        const pg8::f32x4 bg0 = *(const pg8::f32x4*)(bg), bg1 = *(const pg8::f32x4*)(bg + 4), bu0 = *(const pg8::f32x4*)(bg + 2048), bu1 = *(const pg8::f32x4*)(bg + 2052);
        float rsv[2][4];
#pragma unroll
        for (int ai = 0; ai < 2; ++ai)
#pragma unroll
            for (int m = 0; m < 4; ++m) rsv[ai][m] = RS[u.e * CAP + 256 * u.pm + r0 + ai * 128 + m * 16];
#pragma unroll
        for (int ai = 0; ai < 2; ++ai)
#pragma unroll
            for (int m = 0; m < 4; ++m) { const int rl = r0 + ai * 128 + m * 16;
                const float rs = rsv[ai][m];
                float g[8], up[8];
#pragma unroll
                for (int q = 0; q < 4; ++q) { g[q] = rs * acc[ai][0][m][0][q] + bg0[q]; g[4 + q] = rs * acc[ai][0][m][1][q] + bg1[q]; up[q] = rs * acc[ai][1][m][0][q] + bu0[q]; up[4 + q] = rs * acc[ai][1][m][1][q] + bu1[q]; }
                float a[8];
#pragma unroll
                for (int q = 0; q < 8; ++q) { const float gg = fminf(g[q], SWIGLU_LIMIT), uu = fminf(fmaxf(up[q], -SWIGLU_LIMIT), SWIGLU_LIMIT); a[q] = (uu + 1.0f) * (gg * sigmoidf_(gg * SWIGLU_ALPHA)); }
                u32x2 w; w.x = pk4_fp8(a[0] * ACT8_MUL, a[1] * ACT8_MUL, a[2] * ACT8_MUL, a[3] * ACT8_MUL); w.y = pk4_fp8(a[4] * ACT8_MUL, a[5] * ACT8_MUL, a[6] * ACT8_MUL, a[7] * ACT8_MUL);
                *(u32x2*)(ACT8 + (size_t)(u.kind + rl) * DM + hc0) = w; }
    }
};
struct EpiDown {
    static constexpr bool PERM = true, MID = false, FP8 = true, ASM_MFMA = true; static constexpr int SCALE_A = 127 - ACT8_SHIFT, SCALE_B = 127 - W8_SHIFT;
    const float* bd; bf16* Y;
    __device__ __forceinline__ void mid(pg8::f32x4 (&)[2][2][4][2], const Unit&, int, int, int, int, int) const {}
    __device__ __forceinline__ void operator()(const pg8::f32x4 (&acc)[2][2][4][2], const Unit& u, int wr, int wc, int fr, int fq) const {
        asm volatile("" : "+v"(fr), "+v"(fq));
        const int r0 = wr * 64 + fr, col0 = u.pn * 256 + wc * 32 + 8 * fq;
        const float* bb = bd + (size_t)u.e * DM + col0;
        pg8::f32x4 bv[2][2];
#pragma unroll
        for (int bj = 0; bj < 2; ++bj)
#pragma unroll
            for (int n = 0; n < 2; ++n) bv[bj][n] = *(const pg8::f32x4*)(bb + bj * 128 + n * 4);
#pragma unroll
        for (int ai = 0; ai < 2; ++ai)
#pragma unroll
            for (int m = 0; m < 4; ++m) { bf16* rowp = Y + (size_t)(u.kind + r0 + ai * 128 + m * 16) * DM + col0;
#pragma unroll
                for (int bj = 0; bj < 2; ++bj) { const pg8::f32x4 v0 = acc[ai][bj][m][0] + bv[bj][0], v1 = acc[ai][bj][m][1] + bv[bj][1];
                    u32x4 w; w.x = cvt_pk_bf16(v0[0], v0[1]); w.y = cvt_pk_bf16(v0[2], v0[3]); w.z = cvt_pk_bf16(v1[0], v1[1]); w.w = cvt_pk_bf16(v1[2], v1[3]);
                    *(u32x4*)(rowp + bj * 128) = w; } }
    }
};

__device__ __forceinline__ void phase2(const Ctx& C) {
    constexpr float C2_64 = 0.125f * LOG2E, C2_128 = 0.08838834764831845f * LOG2E;
    const int i = C.tid;
    int kind;
    const float* gain; float sc = 1.f; int gofs;
    if (i < 96)        { kind = 1; gain = C.fox_q_norm;  sc = C2_64;  gofs = (i & 7) * 8; }
    else if (i < 192)  { kind = 1; gain = C.fox_k_norm;  gofs = (i & 7) * 8; }
    else if (i < 288)  { kind = 0; gain = C.fox_k_norm;  gofs = 0; }
    else if (i < 384)  { kind = 2; gain = C.swa_q_norm;  sc = C2_64;  gofs = (i & 7) * 8; }
    else if (i < 416)  { kind = 2; gain = C.swa_k_norm;  gofs = (i & 7) * 8; }
    else if (i < 448)  { kind = 0; gain = C.swa_k_norm;  gofs = 0; }
    else               { kind = 3; gain = C.xmem_q_norm; sc = C2_128; gofs = (i & 15) * 8; }
    float gv[8];
#pragma unroll
    for (int q = 0; q < 8; ++q) gv[q] = gain[gofs + q] * sc;
    const int li = i & 7;
    const int rj = (li & 3) * 8;
    constexpr int RU = 4;
    for (int m0 = C.vcu * RU; m0 < T; m0 += C.G * RU) {
        v4u raw[RU]; f32x4 c0[RU], c1[RU], s0[RU], s1[RU];
#pragma unroll
        for (int u = 0; u < RU; ++u) { raw[u] = *(const GAS v4u*)(C.QKV + (size_t)(m0 + u) * QKVW + i * 8);
            if (kind == 2) { const float* cs = C.ROPE + (size_t)(m0 + u) * 64 + rj; c0[u] = *(const GAS f32x4*)cs; c1[u] = *(const GAS f32x4*)(cs + 4); s0[u] = *(const GAS f32x4*)(cs + 32); s1[u] = *(const GAS f32x4*)(cs + 36); } }
#pragma unroll
        for (int u = 0; u < RU; ++u) {
            bf16* p = C.QKV + (size_t)(m0 + u) * QKVW + i * 8;
            float v[8]; v[0] = pg8::bf_lo(raw[u].x); v[1] = pg8::bf_hi(raw[u].x); v[2] = pg8::bf_lo(raw[u].y); v[3] = pg8::bf_hi(raw[u].y); v[4] = pg8::bf_lo(raw[u].z); v[5] = pg8::bf_hi(raw[u].z); v[6] = pg8::bf_lo(raw[u].w); v[7] = pg8::bf_hi(raw[u].w);
            float ss = 0.f;
#pragma unroll
            for (int q = 0; q < 8; ++q) ss += v[q] * v[q];
            ss += __shfl_xor(ss, 1); ss += __shfl_xor(ss, 2); ss += __shfl_xor(ss, 4);
            const float ss16 = ss + __shfl_xor(ss, 8);
            const float rstd = (kind == 3) ? 1.0f / sqrtf(ss16 * (1.f / 128.f) + NORM_EPS) : 1.0f / sqrtf(ss * (1.f / 64.f) + NORM_EPS);
#pragma unroll
            for (int q = 0; q < 8; ++q) v[q] = (v[q] * rstd) * gv[q];
            float o[8];
#pragma unroll
            for (int q = 0; q < 8; ++q) o[q] = __shfl_xor(v[q], 4);
            if (kind == 2) {
                const float cc[8] = {c0[u].x, c0[u].y, c0[u].z, c0[u].w, c1[u].x, c1[u].y, c1[u].z, c1[u].w}, sn[8] = {s0[u].x, s0[u].y, s0[u].z, s0[u].w, s1[u].x, s1[u].y, s1[u].z, s1[u].w};
                const float sg = (li < 4) ? -1.f : 1.f;
#pragma unroll
                for (int q = 0; q < 8; ++q) v[q] = v[q] * cc[q] + sg * o[q] * sn[q];
            }
            if (kind != 0) { v4u w; w.x = pk2(v[0], v[1]); w.y = pk2(v[2], v[3]); w.z = pk2(v[4], v[5]); w.w = pk2(v[6], v[7]); *(GAS v4u*)p = w; }
        }
    }
    {
        const int rsub = i >> 6, l6 = i & 63; float gk[8];
#pragma unroll
        for (int q = 0; q < 8; ++q) gk[q] = C.xmem_k_norm[(l6 & 15) * 8 + q];
        for (int m = C.vcu * 8 + rsub; m < MROWS; m += C.G * 8) {
            bf16* p = C.MKV + (size_t)m * 1024 + l6 * 8;
            const v4u raw = *(const GAS v4u*)p;
            float v[8]; v[0] = pg8::bf_lo(raw.x); v[1] = pg8::bf_hi(raw.x); v[2] = pg8::bf_lo(raw.y); v[3] = pg8::bf_hi(raw.y); v[4] = pg8::bf_lo(raw.z); v[5] = pg8::bf_hi(raw.z); v[6] = pg8::bf_lo(raw.w); v[7] = pg8::bf_hi(raw.w);
            float ss = 0.f;
#pragma unroll
            for (int q = 0; q < 8; ++q) ss += v[q] * v[q];
            ss += __shfl_xor(ss, 1); ss += __shfl_xor(ss, 2); ss += __shfl_xor(ss, 4); ss += __shfl_xor(ss, 8);
            const float rstd = 1.0f / sqrtf(ss * (1.f / 128.f) + NORM_EPS);
#pragma unroll
            for (int q = 0; q < 8; ++q) v[q] = (v[q] * rstd) * gk[q];
            v4u w; w.x = pk2(v[0], v[1]); w.y = pk2(v[2], v[3]); w.z = pk2(v[4], v[5]); w.w = pk2(v[6], v[7]); *(GAS v4u*)p = w;
        }
    }
    if (C.wave == 0) for (int sq = C.vcu; sq < BATCH * 12; sq += C.G) {
        const float* src = C.LOGF + (size_t)sq * SEQ + C.lane * 128; float* dst = C.CNEG + (size_t)sq * SEQ + C.lane * 128;
        float tot = 0.f;
#pragma unroll 4
        for (int j = 0; j < 32; ++j) { const f32x4 a = *(const GAS f32x4*)(src + 4 * j); tot += (a.x + a.y) + (a.z + a.w); }
        float incl = tot;
#pragma unroll
        for (int o = 1; o < 64; o <<= 1) { const float n = __shfl_up(incl, o); if (C.lane >= o) incl += n; }
        float run = incl - tot;
#pragma unroll 4
        for (int j = 0; j < 32; ++j) { const f32x4 a = *(const GAS f32x4*)(src + 4 * j); f32x4 c;
            run += a.x; c.x = -run * LOG2E; run += a.y; c.y = -run * LOG2E; run += a.z; c.z = -run * LOG2E; run += a.w; c.w = -run * LOG2E; *(GAS f32x4*)(dst + 4 * j) = c; }
    }
}

namespace att {
typedef __attribute__((address_space(3))) const char* lds_cptr;
__device__ __forceinline__ void glds16(const void* gsrc, unsigned lds_dst) { unsigned keep;
    asm volatile("s_mov_b32 %0, m0\n\ts_mov_b32 m0, %2\n\ts_nop 0\n\tglobal_load_lds_dwordx4 %1, off\n\ts_mov_b32 m0, %0" : "=&s"(keep) : "v"(gsrc), "s"(lds_dst) : "memory"); }
typedef float f32x2_t __attribute__((ext_vector_type(2))); typedef __bf16 bf16x2_t __attribute__((ext_vector_type(2)));
__device__ __forceinline__ unsigned cvtpk_s(float lo, float hi) { f32x2_t v = {lo, hi}; bf16x2_t b = __builtin_convertvector(v, bf16x2_t); return __builtin_bit_cast(unsigned, b); }
__device__ __forceinline__ int crow(int r, int hi) { return (r & 3) + 8 * (r >> 2) + 4 * hi; }

template <int D> struct Geo {
    static constexpr int SLOTB = 64 * D * 2, NSLOT = (D == 64) ? 3 : 2, PPT = (D == 64) ? 2 : 4;
    static constexpr int LDS_K = 0, LDS_V = NSLOT * SLOTB, LDS_WS = 2 * NSLOT * SLOTB, LDS_WMIN = LDS_WS + 2048, LDS_OST = LDS_WMIN + 64, LDS_CB = LDS_OST + 8 * 4096, LDS_END = LDS_CB + 32768;
};

template <int D>
__device__ __forceinline__ void qkt(f32x16& p0, f32x16& p1, lds_cptr Kslot, const bf16x8* qr, int r32, int hi) {
    lds_cptr kb = Kslot + hi * 1024 + r32 * 16;
    p0 = f32x16{}; p1 = f32x16{};
#pragma unroll
    for (int d0 = 0; d0 < D / 16; ++d0) {
        const bf16x8 b0 = *(const LAS bf16x8*)(kb + d0 * 2048);
        const bf16x8 b1 = *(const LAS bf16x8*)(kb + d0 * 2048 + 512);
        p0 = __builtin_amdgcn_mfma_f32_32x32x16_bf16(b0, qr[d0], p0, 0, 0, 0); p1 = __builtin_amdgcn_mfma_f32_32x32x16_bf16(b1, qr[d0], p1, 0, 0, 0); }
}
template <int D>
__device__ __forceinline__ void pv(f32x16* o, int vb, bf16x8 pa0, bf16x8 pa1, bf16x8 pa2, bf16x8 pa3) {
#pragma unroll
    for (int d0 = 0; d0 < D / 32; ++d0) { s16x4 lo[4], hi[4];
#pragma unroll
        for (int ks = 0; ks < 4; ++ks) {
            asm volatile("ds_read_b64_tr_b16 %0,%1 offset:%c2" : "=&v"(lo[ks]) : "v"(vb), "i"(d0 * 4096 + ks * 1024) : "memory");
            asm volatile("ds_read_b64_tr_b16 %0,%1 offset:%c2" : "=&v"(hi[ks]) : "v"(vb), "i"(d0 * 4096 + ks * 1024 + 512) : "memory"); }
        asm volatile("s_waitcnt lgkmcnt(0)" ::: "memory"); __builtin_amdgcn_sched_barrier(0);
#define ATT_PK(k) (bf16x8){lo[k][0], lo[k][1], lo[k][2], lo[k][3], hi[k][0], hi[k][1], hi[k][2], hi[k][3]}
        o[d0] = __builtin_amdgcn_mfma_f32_32x32x16_bf16(pa0, ATT_PK(0), o[d0], 0, 0, 0);
        o[d0] = __builtin_amdgcn_mfma_f32_32x32x16_bf16(pa1, ATT_PK(1), o[d0], 0, 0, 0);
        o[d0] = __builtin_amdgcn_mfma_f32_32x32x16_bf16(pa2, ATT_PK(2), o[d0], 0, 0, 0);
        o[d0] = __builtin_amdgcn_mfma_f32_32x32x16_bf16(pa3, ATT_PK(3), o[d0], 0, 0, 0);
#undef ATT_PK
    }
}

template <int D, int MODE>
__device__ __forceinline__ void attn_unit(LAS unsigned char* shm, const bf16* Q, int pitchQ, const bf16* K, const bf16* V, int pitchKV, bf16* O, const float* cneg, float sink2, int qb, float bqk = 0.f) {
    typedef Geo<D> G;
    const int tid = threadIdx.x, lane = tid & 63, r32 = lane & 31, hi = lane >> 5; const int wid = __builtin_amdgcn_readfirstlane(tid >> 6);
    const int q0 = qb * 256, q0w = q0 + wid * 32;
    const unsigned lds0 = (unsigned)(uintptr_t)shm;
    LAS float* wsf = (LAS float*)(shm + G::LDS_WS) + wid * 64;
    LAS float* cb = (LAS float*)(shm + G::LDS_CB);
    const int j_lo = (MODE == 1) ? (qb > 0 ? 4 * qb - 2 : 0) : 0, j_hi = (MODE == 2) ? 4 : 4 * qb + 4;
    bf16x8 qr[D / 16];
    { const bf16* Qw = Q + (size_t)(q0w + r32) * pitchQ + hi * 8;
#pragma unroll
      for (int d0 = 0; d0 < D / 16; ++d0) qr[d0] = *(const GAS bf16x8*)(Qw + d0 * 16); }
    if constexpr (MODE == 0) {
        const int nch = (q0 + 256) / 4;
        for (int c = tid; c < nch; c += 512) { const f32x4 v = *(const GAS f32x4*)(cneg + 4 * c); *(LAS f32x4*)(cb + 4 * c) = v; }
    }
#define ATT_DMA(j, slot) do { const int _s = (slot) * G::SLOTB; \
        if constexpr (D == 64) { \
            glds16(K + (size_t)(64 * (j) + lane) * pitchKV + wid * 8, (unsigned)__builtin_amdgcn_readfirstlane(lds0 + G::LDS_K + _s + wid * 1024)); \
            glds16(V + (size_t)(64 * (j) + 16 * (wid & 3) + (lane >> 2)) * pitchKV + (wid >> 2) * 32 + (lane & 3) * 8, (unsigned)__builtin_amdgcn_readfirstlane(lds0 + G::LDS_V + _s + wid * 1024)); \
        } else { \
            _Pragma("unroll") for (int _p = 0; _p < 2; ++_p) { const int _c = wid + 8 * _p; \
                glds16(K + (size_t)(64 * (j) + lane) * pitchKV + _c * 8, (unsigned)__builtin_amdgcn_readfirstlane(lds0 + G::LDS_K + _s + _c * 1024)); } \
            _Pragma("unroll") for (int _p = 0; _p < 2; ++_p) { const int _c = wid + 8 * _p; \
                glds16(V + (size_t)(64 * (j) + 16 * (_c & 3) + (lane >> 2)) * pitchKV + (_c >> 2) * 32 + (lane & 3) * 8, (unsigned)__builtin_amdgcn_readfirstlane(lds0 + G::LDS_V + _s + _c * 1024)); } \
        } } while (0)
    int slot_i = 0;
    constexpr bool REV = (MODE == 0);
    const int nst = j_hi - j_lo;
#define ATT_TILE(st_) (REV ? (j_hi - 1 - (st_)) : (j_lo + (st_)))
#pragma unroll
    for (int p = 0; p < G::NSLOT - 1; ++p) if (p < nst) ATT_DMA(ATT_TILE(p), p);
    float mhat = -1e30f, l_reg = 0.f; f32x16 o[D / 32];
#pragma unroll
    for (int d0 = 0; d0 < D / 32; ++d0) o[d0] = f32x16{};
    const lds_cptr shm3 = (lds_cptr)shm;
    const int vb0 = (int)(lds0 + G::LDS_V) + ((lane >> 4) & 1) * 32 + (lane & 3) * 8 + (4 * hi + ((lane & 15) >> 2)) * 64;
    const int qabs = q0w + r32;
    LAS float* wmin = (LAS float*)(shm + G::LDS_WMIN);
    for (int st = 0; st < nst; ++st) {
        const int j = ATT_TILE(st);
        if (G::NSLOT == 3 && st + 1 < nst) { if constexpr (G::PPT == 2) asm volatile("s_waitcnt vmcnt(2) lgkmcnt(0)\n\ts_barrier" ::: "memory"); else asm volatile("s_waitcnt vmcnt(4) lgkmcnt(0)\n\ts_barrier" ::: "memory"); }
        else asm volatile("s_waitcnt vmcnt(0) lgkmcnt(0)\n\ts_barrier" ::: "memory");
        if constexpr (MODE == 0) { if (st >= 5) {
            const LAS float* wm = wmin + ((st - 1) & 1) * 8; const f32x4 a = *(const LAS f32x4*)wm, b = *(const LAS f32x4*)(wm + 4);
            const float gmin = fminf(fminf(fminf(a.x, a.y), fminf(a.z, a.w)), fminf(fminf(b.x, b.y), fminf(b.z, b.w)));
            if (cb[64 * j + 63] + bqk < gmin - 40.0f) break; } }
        { const int sn_ = st + G::NSLOT - 1; if (sn_ < nst) { int sn = slot_i + G::NSLOT - 1; if (sn >= G::NSLOT) sn -= G::NSLOT; ATT_DMA(ATT_TILE(sn_), sn); } }
        bool need = true;
        if constexpr (MODE == 0) need = (64 * j <= q0w + 31);
        if constexpr (MODE == 1) need = (64 * j <= q0w + 31) && (64 * j + 63 >= q0w - 127);
        if (need) {
            f32x16 p0, p1;
            qkt<D>(p0, p1, shm3 + G::LDS_K + slot_i * G::SLOTB, qr, r32, hi);
            if constexpr (MODE == 0) {
                const LAS float* cbp = cb + 64 * j + 4 * hi;
#pragma unroll
                for (int g = 0; g < 4; ++g) { const f32x4 b0 = *(const LAS f32x4*)(cbp + 8 * g), b1 = *(const LAS f32x4*)(cbp + 32 + 8 * g);
#pragma unroll
                    for (int e = 0; e < 4; ++e) { p0[4 * g + e] += b0[e]; p1[4 * g + e] += b1[e]; } }
                if (64 * j + 63 > q0w) {
#pragma unroll
                    for (int r = 0; r < 16; ++r) { const int kv = 64 * j + crow(r, hi); if (kv > qabs) p0[r] = -INFINITY; if (kv + 32 > qabs) p1[r] = -INFINITY; } }
            }
            if constexpr (MODE == 1) {
#pragma unroll
                for (int r = 0; r < 16; ++r) { const int kv = 64 * j + crow(r, hi); const int d0_ = qabs - kv, d1_ = d0_ - 32;
                    if (d0_ < 0 || d0_ >= 128) p0[r] = -INFINITY; if (d1_ < 0 || d1_ >= 128) p1[r] = -INFINITY; }
            }
            float rm = fmaxf(p0[0], p1[0]);
#pragma unroll
            for (int r = 1; r < 16; ++r) rm = fmaxf(rm, fmaxf(p0[r], p1[r]));
            { auto rr = __builtin_amdgcn_permlane32_swap(__float_as_uint(rm), __float_as_uint(rm), false, false); rm = fmaxf(__uint_as_float(rr[0]), __uint_as_float(rr[1])); }
            if (__any(rm > mhat)) {
                const float mn = fmaxf(mhat, rm); const float f = __builtin_amdgcn_exp2f(mhat - mn); mhat = mn; l_reg *= f;
                if (hi == 0) wsf[r32] = f;
                asm volatile("s_waitcnt lgkmcnt(0)" ::: "memory");
#pragma unroll
                for (int g = 0; g < 4; ++g) { const f32x4 fv = *(const LAS f32x4*)(wsf + 8 * g + 4 * hi);
#pragma unroll
                    for (int d_ = 0; d_ < D / 32; ++d_)
#pragma unroll
                        for (int e = 0; e < 4; ++e) o[d_][4 * g + e] *= fv[e]; }
            }
            float sacc = 0.f;
#pragma unroll
            for (int r = 0; r < 16; ++r) { p0[r] = __builtin_amdgcn_exp2f(p0[r] - mhat); p1[r] = __builtin_amdgcn_exp2f(p1[r] - mhat); sacc += p0[r] + p1[r]; }
            l_reg += sacc;
            u32x4 pw0, pw1, pw2, pw3;
            pw0 = (u32x4){cvtpk_s(p0[0], p0[1]), cvtpk_s(p0[2], p0[3]), cvtpk_s(p0[4], p0[5]), cvtpk_s(p0[6], p0[7])};
            pw1 = (u32x4){cvtpk_s(p0[8], p0[9]), cvtpk_s(p0[10], p0[11]), cvtpk_s(p0[12], p0[13]), cvtpk_s(p0[14], p0[15])};
            pw2 = (u32x4){cvtpk_s(p1[0], p1[1]), cvtpk_s(p1[2], p1[3]), cvtpk_s(p1[4], p1[5]), cvtpk_s(p1[6], p1[7])};
            pw3 = (u32x4){cvtpk_s(p1[8], p1[9]), cvtpk_s(p1[10], p1[11]), cvtpk_s(p1[12], p1[13]), cvtpk_s(p1[14], p1[15])};
            pv<D>(o, vb0 + slot_i * G::SLOTB, __builtin_bit_cast(bf16x8, pw0), __builtin_bit_cast(bf16x8, pw1), __builtin_bit_cast(bf16x8, pw2), __builtin_bit_cast(bf16x8, pw3));
        }
        if constexpr (MODE == 0) { float mn = mhat;
#pragma unroll
            for (int of = 1; of < 32; of <<= 1) mn = fminf(mn, __shfl_xor(mn, of));
            if (lane == 0) wmin[(st & 1) * 8 + wid] = mn; }
        ++slot_i; if (slot_i == G::NSLOT) slot_i = 0;
    }
#undef ATT_DMA
#undef ATT_TILE
    if constexpr (MODE == 0) asm volatile("s_waitcnt vmcnt(0)" ::: "memory");
    { auto rr = __builtin_amdgcn_permlane32_swap(__float_as_uint(l_reg), __float_as_uint(l_reg), false, false); l_reg = __uint_as_float(rr[0]) + __uint_as_float(rr[1]); }
    if constexpr (MODE == 1) l_reg += __builtin_amdgcn_exp2f(sink2 - mhat);
    if (hi == 0) wsf[32 + r32] = l_reg;
    asm volatile("s_waitcnt lgkmcnt(0)" ::: "memory");
    float rli[16];
#pragma unroll
    for (int g = 0; g < 4; ++g) { const f32x4 lv = *(const LAS f32x4*)(wsf + 32 + 8 * g + 4 * hi);
#pragma unroll
        for (int e = 0; e < 4; ++e) rli[4 * g + e] = __builtin_amdgcn_rcpf(lv[e]); }
    bf16* Ow = O + (size_t)q0w * 2048;
    LAS bf16* stg = (LAS bf16*)(shm + G::LDS_OST) + wid * 2048;
#pragma unroll
    for (int ps = 0; ps < D / 64; ++ps) {
#pragma unroll
        for (int r = 0; r < 16; ++r) { const int orow = crow(r, hi);
#pragma unroll
            for (int dl = 0; dl < 2; ++dl) stg[orow * 64 + dl * 32 + r32] = (bf16)f2bf(o[2 * ps + dl][r] * rli[r]); }
        asm volatile("s_waitcnt lgkmcnt(0)" ::: "memory");
#pragma unroll
        for (int i = 0; i < 4; ++i) { const int row = i * 8 + (lane >> 3), ch = lane & 7; const v4u v = *(const LAS v4u*)(stg + row * 64 + ch * 8); *(GAS v4u*)(Ow + (size_t)row * 2048 + ps * 64 + ch * 8) = v; }
        asm volatile("s_waitcnt lgkmcnt(0)" ::: "memory");
    }
    asm volatile("s_waitcnt lgkmcnt(0)\n\ts_barrier" ::: "memory");
}
}

constexpr int NU_FOX = BATCH * 12 * 32, NU_SWA = BATCH * 12 * 32, NU_XM = BATCH * 4 * 32;
__device__ __forceinline__ int att_fetch(const Ctx& C, int q) {
    int v = 0; if (C.tid == 0) v = (int)__hip_atomic_fetch_add((unsigned*)(C.ctl + CW_QHEAD + 64 * q), 1u, RLX_AGENT); return v;
}
__device__ __forceinline__ void phase3(const Ctx& C) {
    LAS unsigned char* shm = C.lds + RING_OFF;
    volatile LAS int* nxtw = (volatile LAS int*)(C.MISC + 12);
    {
        float gq = fabsf(C.fox_q_norm[C.lane]), gk = fabsf(C.fox_k_norm[C.lane]);
#pragma unroll
        for (int of = 1; of < 64; of <<= 1) { gq = fmaxf(gq, __shfl_xor(gq, of)); gk = fmaxf(gk, __shfl_xor(gk, of)); }
        const float bqk = 64.0f * gq * gk * (0.125f * LOG2E) * 1.02f;
        int pre = att_fetch(C, 0);
        if (C.tid == 0) *nxtw = pre;
        __syncthreads();
        int cur = __builtin_amdgcn_readfirstlane(*nxtw);
        __syncthreads();
        while (cur < NU_FOX) {
            pre = att_fetch(C, 0);
            const int qb = 31 - cur / 24, bh = cur % 24, b = bh / 12, h = bh % 12;
            const bf16* base = C.QKV + (size_t)b * SEQ * QKVW + h * 64;
            att::attn_unit<64, 0>(shm, base + C_FQ, QKVW, base + C_FK, base + C_FV, QKVW, C.OALL + (size_t)b * SEQ * 2048 + h * 64, C.CNEG + (size_t)(b * 12 + h) * SEQ, 0.f, qb, bqk);
            if (C.tid == 0) *nxtw = pre;
            __syncthreads();
            cur = __builtin_amdgcn_readfirstlane(*nxtw);
            __syncthreads();
        }
    }
    {
        int pre = att_fetch(C, 1);
        if (C.tid == 0) *nxtw = pre;
        __syncthreads();
        int cur = __builtin_amdgcn_readfirstlane(*nxtw);
        __syncthreads();
        while (cur < NU_SWA) {
            pre = att_fetch(C, 1);
            const int qb = cur / 24, bh = cur % 24, b = bh / 12, h = bh % 12, kvh = h / 3;
            const bf16* base = C.QKV + (size_t)b * SEQ * QKVW;
            att::attn_unit<64, 1>(shm, base + C_SQ + h * 64, QKVW, base + C_SK + kvh * 64, base + C_SV + kvh * 64, QKVW, C.OALL + (size_t)b * SEQ * 2048 + 768 + h * 64, nullptr, C.swa_sinks[h] * LOG2E, qb);
            if (C.tid == 0) *nxtw = pre;
            __syncthreads();
            cur = __builtin_amdgcn_readfirstlane(*nxtw);
            __syncthreads();
        }
    }
    {
        int pre = att_fetch(C, 2);
        if (C.tid == 0) *nxtw = pre;
        __syncthreads();
        int cur = __builtin_amdgcn_readfirstlane(*nxtw);
        __syncthreads();
        while (cur < NU_XM) {
            pre = att_fetch(C, 2);
            const int qb = cur / 8, bh = cur % 8, b = bh / 4, h = bh % 4;
            const bf16* kb = C.MKV + (size_t)b * NMEM * 1024 + h * 128;
            att::attn_unit<128, 2>(shm, C.QKV + (size_t)b * SEQ * QKVW + C_MQ + h * 128, QKVW, kb, kb + 512, 1024, C.OALL + (size_t)b * SEQ * 2048 + 1536 + h * 128, nullptr, 0.f, qb);
            if (C.tid == 0) *nxtw = pre;
            __syncthreads();
            cur = __builtin_amdgcn_readfirstlane(*nxtw);
            __syncthreads();
        }
    }
}

__device__ __forceinline__ void phase6(const Ctx& C) {
    LAS float* PL = (LAS float*)(C.lds + RING_OFF);
    LAS float* SS = PL + 4 * 64 * 33;
    LAS int* hist = (LAS int*)(SS + 512);
    LAS int* gb = hist + 32;
    const int rg = C.wave & 1, kq = C.wave >> 1, r32 = C.lane & 31, hi = C.lane >> 5;
    const bf16* wh = C.Wr_t + (size_t)r32 * 2048 + 512 * kq + 16 * hi; const bf16* wl = wh + 32 * 2048;
    for (int blk = C.vcu; blk < T / 64; blk += C.G) {
        if (C.tid < 32) hist[C.tid] = 0;
        const int tok = blk * 64 + 32 * rg + r32;
        const float* hr = C.out + (size_t)tok * DM + 512 * kq + 16 * hi;
        f32x16 acc = f32x16{}; float ss = 0.f;
#pragma unroll 2
        for (int kb = 0; kb < 16; ++kb) {
            float f[16];
#pragma unroll
            for (int q = 0; q < 4; ++q) { const f32x4 t = *(const GAS f32x4*)(hr + 32 * kb + 4 * q); f[4 * q] = t.x; f[4 * q + 1] = t.y; f[4 * q + 2] = t.z; f[4 * q + 3] = t.w; }
            unsigned hb[16], lb[16];
#pragma unroll
            for (int q = 0; q < 16; ++q) { ss += f[q] * f[q]; hb[q] = f2bf(f[q]); lb[q] = f2bf(f[q] - __uint_as_float(hb[q] << 16)); }
#pragma unroll
            for (int s = 0; s < 2; ++s) {
                const bf16x8 ah = *(const GAS bf16x8*)(wh + 32 * kb + 8 * s), al = *(const GAS bf16x8*)(wl + 32 * kb + 8 * s);
                v4u bh, bl;
                bh.x = hb[8 * s] | (hb[8 * s + 1] << 16); bh.y = hb[8 * s + 2] | (hb[8 * s + 3] << 16); bh.z = hb[8 * s + 4] | (hb[8 * s + 5] << 16); bh.w = hb[8 * s + 6] | (hb[8 * s + 7] << 16);
                bl.x = lb[8 * s] | (lb[8 * s + 1] << 16); bl.y = lb[8 * s + 2] | (lb[8 * s + 3] << 16); bl.z = lb[8 * s + 4] | (lb[8 * s + 5] << 16); bl.w = lb[8 * s + 6] | (lb[8 * s + 7] << 16);
                acc = __builtin_amdgcn_mfma_f32_32x32x16_bf16(ah, __builtin_bit_cast(bf16x8, bh), acc, 0, 0, 0);
                acc = __builtin_amdgcn_mfma_f32_32x32x16_bf16(ah, __builtin_bit_cast(bf16x8, bl), acc, 0, 0, 0);
                acc = __builtin_amdgcn_mfma_f32_32x32x16_bf16(al, __builtin_bit_cast(bf16x8, bh), acc, 0, 0, 0);
            }
        }
        { LAS float* pr = PL + (size_t)(kq * 64 + 32 * rg + r32) * 33;
#pragma unroll
          for (int r = 0; r < 16; ++r) pr[att::crow(r, hi)] = acc[r];
          SS[(kq * 2 + hi) * 64 + 32 * rg + r32] = ss; }
        __syncthreads();
        int sel[4]; float gt[4]; float rstd = 0.f; int lr[4];
        if (C.tid < 64) {
            float lv[32]; float s2 = 0.f;
#pragma unroll
            for (int q = 0; q < 8; ++q) s2 += SS[q * 64 + C.tid];
            rstd = 1.0f / sqrtf(s2 * (1.f / DM) + NORM_EPS);
#pragma unroll
            for (int e = 0; e < 32; ++e) { const float a = (PL[(0 * 64 + C.tid) * 33 + e] + PL[(1 * 64 + C.tid) * 33 + e]) + (PL[(2 * 64 + C.tid) * 33 + e] + PL[(3 * 64 + C.tid) * 33 + e]); lv[e] = a * rstd + C.b_router[e]; }
            float val[4];
#pragma unroll
            for (int k = 0; k < 4; ++k) { float best = lv[0]; int bi = 0;
#pragma unroll
                for (int e = 1; e < 32; ++e) if (lv[e] > best) { best = lv[e]; bi = e; }
                sel[k] = bi; val[k] = best;
#pragma unroll
                for (int e = 0; e < 32; ++e) lv[e] = (e == bi) ? -INFINITY : lv[e]; }
            float den = 0.f;
#pragma unroll
            for (int k = 0; k < 4; ++k) { gt[k] = __expf(val[k] - val[0]); den += gt[k]; }
            const float inv = 1.0f / den;
#pragma unroll
            for (int k = 0; k < 4; ++k) { gt[k] *= inv; lr[k] = __hip_atomic_fetch_add((LAS int*)(hist + sel[k]), 1, __ATOMIC_RELAXED, __HIP_MEMORY_SCOPE_WORKGROUP); }
        }
        __syncthreads();
        if (C.tid < 32) gb[C.tid] = (int)__hip_atomic_fetch_add((unsigned*)(C.ctl + CW_CNT + C.tid), (unsigned)hist[C.tid], RLX_AGENT);
        __syncthreads();
        if (C.tid < 64) {
            const int t = blk * 64 + C.tid;
#pragma unroll
            for (int k = 0; k < 4; ++k) { const int sl = sel[k] * CAP + gb[sel[k]] + lr[k]; C.TOK[sl] = t; C.RS[sl] = rstd; C.TSLOT[t * 4 + k] = sl; C.TGATE[t * 4 + k] = gt[k]; }
        }
        __syncthreads();
    }
}
template <int NT>
__device__ __forceinline__ void moe_table(const Ctx& C, LAS int* tab) {
    __syncthreads();
    if (C.tid == 0) { int us = 0, rb = 0;
        for (int e = 0; e < 32; ++e) { const int n = (int)__hip_atomic_load((unsigned*)(C.ctl + CW_CNT + e), RLX_AGENT); const int mt = (n + 255) >> 8; tab[e] = us; tab[33 + e] = mt; tab[65 + e] = rb; tab[97 + e] = n; us += mt * NT; rb += mt * 256; }
        tab[32] = us; }
    __syncthreads();
}


__device__ __forceinline__ void phase9(const Ctx& C, const LAS int* tab) {
    const int gw = C.vcu * NWAVES + C.wave, NGW = C.G * NWAVES;
    for (int t = gw; t < T; t += NGW) {
        typedef int v4i_ __attribute__((ext_vector_type(4))); const v4i_ sl = *(const GAS v4i_*)(C.TSLOT + 4 * t); const f32x4 g = *(const GAS f32x4*)(C.TGATE + 4 * t);
        const int s[4] = {sl.x, sl.y, sl.z, sl.w}; const float gg[4] = {g.x, g.y, g.z, g.w};
        const bf16* yr[4];
#pragma unroll
        for (int k = 0; k < 4; ++k) { const int e = s[k] >> 14, rk = s[k] & (CAP - 1); yr[k] = C.Y + (size_t)(tab[65 + e] + rk) * DM + 8 * C.lane; }
        float* orow = C.out + (size_t)t * DM + 8 * C.lane;
#pragma unroll
        for (int j = 0; j < 4; ++j) {
            f32x4 a0 = *(const GAS f32x4*)(orow + 512 * j), a1 = *(const GAS f32x4*)(orow + 512 * j + 4);
#pragma unroll
            for (int k = 0; k < 4; ++k) { const v4u y = *(const GAS v4u*)(yr[k] + 512 * j);
                a0.x += gg[k] * pg8::bf_lo(y.x); a0.y += gg[k] * pg8::bf_hi(y.x); a0.z += gg[k] * pg8::bf_lo(y.y); a0.w += gg[k] * pg8::bf_hi(y.y);
                a1.x += gg[k] * pg8::bf_lo(y.z); a1.y += gg[k] * pg8::bf_hi(y.z); a1.z += gg[k] * pg8::bf_lo(y.w); a1.w += gg[k] * pg8::bf_hi(y.w); }
            *(GAS f32x4*)(orow + 512 * j) = a0; *(GAS f32x4*)(orow + 512 * j + 4) = a1;
        }
    }
}

struct Args { const void* in[26]; float* out; unsigned char* ws; int ph_lo, ph_hi, probe, pad; };
__global__ void __launch_bounds__(NWAVES * 64, 2) mk_fwd(Args args) {
    extern __shared__ __attribute__((aligned(16))) unsigned char lds_raw[];
    Ctx C;
    C.lds = (LAS unsigned char*)lds_raw;
    C.MISC = (volatile LAS unsigned*)(C.lds + MISC_OFF);
    C.tid = threadIdx.x; C.lane = C.tid & 63; C.wave = __builtin_amdgcn_readfirstlane(C.tid >> 6);
    C.G = gridDim.x; { const int bx = blockIdx.x; C.vcu = (C.G % 8 == 0) ? (bx % 8) * (C.G / 8) + bx / 8 : bx; }
    unsigned char* ws = args.ws;
    C.ctl = (gu32*)(ws + WS_CTL);
    C.x = (const float*)args.in[0]; C.mem = (const float*)args.in[1]; C.pos = (const int*)args.in[2]; C.norm_mix = (const float*)args.in[3]; C.w_in = (const float*)args.in[4];
    C.b_forget = (const float*)args.in[5]; C.fox_q_norm = (const float*)args.in[6]; C.fox_k_norm = (const float*)args.in[7]; C.swa_q_norm = (const float*)args.in[8]; C.swa_k_norm = (const float*)args.in[9];
    C.swa_sinks = (const float*)args.in[10]; C.xmem_q_norm = (const float*)args.in[11]; C.xmem_k_norm = (const float*)args.in[12]; C.norm_mem = (const float*)args.in[13]; C.w_mem_kv = (const float*)args.in[14];
    C.w_up_fox = (const float*)args.in[15]; C.w_up_swa = (const float*)args.in[16]; C.w_up_xmem = (const float*)args.in[17]; C.w_out = (const float*)args.in[18]; C.norm_ffn = (const float*)args.in[19];
    C.w_router = (const float*)args.in[20]; C.b_router = (const float*)args.in[21]; C.w_gate_up = (const float*)args.in[22]; C.b_gate_up = (const float*)args.in[23]; C.w_down = (const float*)args.in[24]; C.b_down = (const float*)args.in[25];
    C.out = args.out;
    C.Win_t = (bf16*)(ws + WS_WIN); C.Wmkv_t = (bf16*)(ws + WS_WMKV); C.Wup_t = (bf16*)(ws + WS_WUP); C.Wout_t = (bf16*)(ws + WS_WOUT); C.Wr_t = (bf16*)(ws + WS_WRT); C.Wgu_t = (bf16*)(ws + WS_WGU); C.Wd_t = (bf16*)(ws + WS_WD);
    C.XN = (bf16*)(ws + WS_XN); C.MN = (bf16*)(ws + WS_MN); C.QKV = (bf16*)(ws + WS_QKV); C.G_ = (bf16*)(ws + WS_G); C.MKV = (bf16*)(ws + WS_MKV); C.OALL = (bf16*)(ws + WS_OALL); C.MERGED = (bf16*)(ws + WS_MERGED);
    C.HB = (bf16*)(ws + WS_HB); C.ACT = (bf16*)(ws + WS_ACT); C.LOGF = (float*)(ws + WS_LOGF); C.CNEG = (float*)(ws + WS_CNEG); C.ROPE = (float*)(ws + WS_ROPE); C.GATEW = (float*)(ws + WS_GATE); C.RS = (float*)(ws + WS_RS);
    C.TOK = (int*)(ws + WS_TOK); C.TSLOT = (int*)(ws + WS_TSLOT); C.TGATE = (float*)(ws + WS_TGATE); C.Y = (bf16*)(ws + WS_Y); C.XN8 = ws + WS_XN8; C.Win8 = ws + WS_WIN8;
    for (int u = C.tid; u < (LDS_BYTES - LDSCTL_OFF) / 4; u += NWAVES * 64) ((LAS unsigned*)(C.lds + LDSCTL_OFF))[u] = 0u;
    __syncthreads();
    XcdBarrier bar; bar.bar = (unsigned*)(C.ctl + CW_BAR); bar.x = 0; bar.st = nullptr;
    if (N_LAUNCHES == 1) bar = xcd_barrier_post((unsigned*)(C.ctl + CW_BAR), C.MISC + 8);
    const int lo = args.ph_lo, hi = args.ph_hi;
#ifndef MK_PHASE_MASK
#define MK_PHASE_MASK 0x3FF
#endif
#define IN(k) ((((MK_PHASE_MASK) >> (k)) & 1) && lo <= (k) && (k) < hi)
#define SEAM(k) do { if (IN(k) && IN((k) + 1)) xcd_barrier(bar); } while (0)
    LAS int* tab = (LAS int*)(C.lds + MOE_OFF);

    if (IN(0)) { phase0(C); }
    SEAM(0);
    if (IN(1)) {
        P1Order S; S.d.init(C.XN, C.Win_t, T, PROBE_INW * 64, C.G, (int)blockIdx.x); S.A1 = (const char*)C.MN; S.B1 = (const char*)C.Wmkv_t;
        EpiInProj E{C.QKV, C.G_, C.MKV, args.probe == 1};
        if (args.probe != 3) pg8::gemm_phase<EpiInProj, P1Order>(C.lds + RING_OFF, S, E);
        DenseOrderT<2048> S8; S8.init(C.XN8, C.Win8, T, 6144, C.G, (int)blockIdx.x);
#ifdef PROBE_DET
#pragma unroll 1
        for (int rep = 0; rep < 2; ++rep) { EpiGates E8{rep ? C.Y : C.ACT}; pg8::gemm_phase<EpiGates, DenseOrderT<2048>>(C.lds + RING_OFF, S8, E8); }
#else
#ifdef PROBE_GDUMMY
        EpiGates E8{C.ACT};
#else
        EpiGates E8{C.G_};
#endif
        if (args.probe != 2) pg8::gemm_phase<EpiGates, DenseOrderT<2048>>(C.lds + RING_OFF, S8, E8);
#endif
    }
    SEAM(1);
    if (IN(2)) { phase2(C);
#ifdef PROBE_DET
        { const v4u* d1 = (const v4u*)C.ACT; const v4u* d2 = (const v4u*)C.Y; unsigned bad = 0; const size_t nw = (size_t)T * GW * 2 / 16;
          for (size_t i = (size_t)blockIdx.x * 512 + C.tid; i < nw; i += (size_t)C.G * 512) { const v4u a = d1[i], b = d2[i]; bad += (a.x != b.x) | (a.y != b.y) | (a.z != b.z) | (a.w != b.w); }
          if (bad) atomicAdd((unsigned*)(C.ctl + 2048), bad); }
#endif
    }
    SEAM(2);
    if (IN(3)) { phase3(C); }
    SEAM(3);
    if (IN(4)) {
        DenseOrder S; S.init(C.OALL, C.Wup_t, T, DM, C.G, (int)blockIdx.x);
        EpiMerge E{C.G_, C.MERGED};
        pg8::gemm_phase<EpiMerge, DenseOrder>(C.lds + RING_OFF, S, E);
    }
    SEAM(4);
    if (IN(5)) {
        DenseOrder S; S.init(C.MERGED, C.Wout_t, T, DM, C.G, (int)blockIdx.x);
        EpiOut E{C.x, C.out, (unsigned char*)C.HB};
        pg8::gemm_phase<EpiOut, DenseOrder>(C.lds + RING_OFF, S, E);
    }
    SEAM(5);
    if (IN(6)) { phase6(C); }
    SEAM(6);
    if (IN(7)) {
        moe_table<16>(C, tab);
        MoeOrder<true, 16, 2048> S{(const char*)C.HB, (const char*)C.Wgu_t, C.TOK, (const int*)(C.ctl + CW_CNT), tab, C.G, C.vcu};
        EpiGateUp E{C.RS, C.b_gate_up, (unsigned char*)C.ACT};
        pg8::gemm_phase<EpiGateUp, MoeOrder<true, 16, 2048>>(C.lds + RING_OFF, S, E);
    }
    SEAM(7);
    if (IN(8)) {
        moe_table<8>(C, tab);
        MoeOrder<false, 8, 2048> S{(const char*)C.ACT, (const char*)C.Wd_t, C.TOK, (const int*)(C.ctl + CW_CNT), tab, C.G, C.vcu};
        EpiDown E{C.b_down, C.Y};
        pg8::gemm_phase<EpiDown, MoeOrder<false, 8, 2048>>(C.lds + RING_OFF, S, E);
    }
    SEAM(8);
    if (IN(9)) { moe_table<8>(C, tab); phase9(C, tab);
#ifdef PROBE_DET
        if (blockIdx.x == 0 && C.tid == 0 && __hip_atomic_load((unsigned*)(C.ctl + 2048), RLX_AGENT) != 0u) C.out[12345] = __builtin_nanf("");
#endif
    }
#undef IN
#undef SEAM
}

extern "C" void kernel_launch(void* const* d_in, const int* in_sizes, int n_in, void* d_out, int out_size, void* d_ws, size_t ws_size, hipStream_t stream) {
    static int grid = 0;
    if (grid == 0) {
        if (n_in != 26 || out_size != T * DM || ws_size < WS_END) { fprintf(stderr, "kernel_launch: unexpected problem (n_in %d, out %d, ws %zu < %zu); nothing launched\n", n_in, out_size, ws_size, (size_t)WS_END); grid = -1; return; }
        int dev = 0, cus = 0, per_cu = 0;
        if (hipGetDevice(&dev) != hipSuccess || hipDeviceGetAttribute(&cus, hipDeviceAttributeMultiprocessorCount, dev) != hipSuccess) { grid = -1; return; }
        if (hipFuncSetAttribute((const void*)mk_fwd, hipFuncAttributeMaxDynamicSharedMemorySize, LDS_BYTES) != hipSuccess) { fprintf(stderr, "kernel_launch: hipFuncSetAttribute failed\n"); grid = -1; return; }
        if (hipOccupancyMaxActiveBlocksPerMultiprocessor(&per_cu, (const void*)mk_fwd, NWAVES * 64, LDS_BYTES) != hipSuccess || per_cu < 1) { fprintf(stderr, "kernel_launch: occupancy query says %d\n", per_cu); }
        (void)hipGetLastError();
        grid = cus;
    }
    if (grid < 0) return;
    if (hipMemsetAsync((char*)d_ws + WS_CTL, 0, CTL_ZERO_BYTES, stream) != hipSuccess) return;
#ifdef PROBE_MEMSET8
    hipMemsetAsync((char*)d_ws + WS_XN8, 0, 44 * MiB, stream);
#endif
    Args a{};
    for (int i = 0; i < 26; ++i) a.in[i] = d_in[i];
    a.out = (float*)d_out; a.ws = (unsigned char*)d_ws;
    if (N_LAUNCHES == 1) { a.ph_lo = 0; a.ph_hi = PER_PHASE; hipLaunchKernelGGL(mk_fwd, dim3(grid), dim3(NWAVES * 64), LDS_BYTES, stream, a); }
    else for (int li = 0; li < PER_PHASE; ++li) { a.ph_lo = li; a.ph_hi = li + 1;
#ifdef PROBE_SPLIT_P1
        if (li == 1) { a.probe = 2; hipLaunchKernelGGL(mk_fwd, dim3(grid), dim3(NWAVES * 64), LDS_BYTES, stream, a); a.probe = 3; hipLaunchKernelGGL(mk_fwd, dim3(grid), dim3(NWAVES * 64), LDS_BYTES, stream, a); a.probe = 0; continue; }
#endif
        hipLaunchKernelGGL(mk_fwd, dim3(grid), dim3(NWAVES * 64), LDS_BYTES, stream, a);
#ifdef PROBE_DUP
        if (li == PROBE_DUP) { if (PROBE_DUP == 3 || PROBE_DUP == 6) hipMemsetAsync((char*)d_ws + WS_CTL, 0, CTL_ZERO_BYTES / 2, stream);
#ifdef PROBE_FLAG
            a.probe = PROBE_FLAG;
#endif
            hipLaunchKernelGGL(mk_fwd, dim3(grid), dim3(NWAVES * 64), LDS_BYTES, stream, a); a.probe = 0; }
#endif
    }
    const hipError_t le = hipPeekAtLastError();
    if (le != hipSuccess) fprintf(stderr, "kernel_launch: launch failed: %s\n", hipGetErrorName(le));
}
```

```cpp
#include <hip/hip_runtime.h>
#include <cstdio>
#include <cstdint>

#define LAS __attribute__((address_space(3)))
#define GAS __attribute__((address_space(1)))

namespace pg8 {
typedef unsigned short bf16_t;
typedef short bf16x8 __attribute__((ext_vector_type(8)));
typedef float f32x4 __attribute__((ext_vector_type(4)));
typedef float f32x2 __attribute__((ext_vector_type(2)));
typedef unsigned u32x4 __attribute__((ext_vector_type(4)));
typedef unsigned u32x2 __attribute__((ext_vector_type(2)));
constexpr int BM = 256, BK = 64, HALF = 128, HTB = HALF * BK * 2, STAGE_BYTES = 8 * HTB, NXCD = 8, WGM = 8;
constexpr int KD = 2048;
typedef int v8i __attribute__((ext_vector_type(8))); typedef int v4i __attribute__((ext_vector_type(4)));
__device__ __forceinline__ v8i cat8(bf16x8 lo, bf16x8 hi) { const v4i a = __builtin_bit_cast(v4i, lo), b = __builtin_bit_cast(v4i, hi); return __builtin_shufflevector(a, b, 0, 1, 2, 3, 4, 5, 6, 7); }
__device__ __forceinline__ bf16x8 lo8(v8i v) { return __builtin_bit_cast(bf16x8, (v4i)__builtin_shufflevector(v, v, 0, 1, 2, 3)); }
__device__ __forceinline__ bf16x8 hi8(v8i v) { return __builtin_bit_cast(bf16x8, (v4i)__builtin_shufflevector(v, v, 4, 5, 6, 7)); }

__host__ __device__ __forceinline__ int lds_byte(int r, int c) { const int st = (r >> 4) * 2 + (c >> 5), rr = r & 15, cc = c & 31, ob = rr * 64 + cc * 2; return st * 1024 + (ob ^ (((ob >> 9) & 1) << 5)); }
__host__ __device__ __forceinline__ void stage_rc(int b, int& R, int& C) { const int st = b / 1024, sb = b % 1024, swz = sb ^ (((sb >> 9) & 1) << 5); R = (st >> 1) * 16 + swz / 64; C = (st & 1) * 32 + (swz % 64) / 2; }
__host__ __device__ __forceinline__ int perm32(int rho) { const int n = rho >> 4, i = rho & 15; return 8 * (i >> 2) + 4 * n + (i & 3); }

__device__ __forceinline__ void glds_s(const char* sbase, unsigned voff, unsigned lds_dst) { unsigned keep;
    asm volatile("s_mov_b32 %0, m0\n\ts_mov_b32 m0, %3\n\ts_nop 0\n\tglobal_load_lds_dwordx4 %1, %2\n\ts_mov_b32 m0, %0" : "=&s"(keep) : "v"(voff), "s"(sbase), "s"(lds_dst) : "memory"); }

#define PG8_PIN4(a, b, c, d, txt) asm volatile(txt : "+v"(a), "+v"(b), "+v"(c), "+v"(d))
#define PG8_PIN_ACC(txt) do { _Pragma("unroll") for (int _a = 0; _a < 2; ++_a) _Pragma("unroll") for (int _b = 0; _b < 2; ++_b) { \
        PG8_PIN4(acc[_a][_b][0][0], acc[_a][_b][0][1], acc[_a][_b][1][0], acc[_a][_b][1][1], ""); PG8_PIN4(acc[_a][_b][2][0], acc[_a][_b][2][1], acc[_a][_b][3][0], acc[_a][_b][3][1], ""); } \
        PG8_PIN4(acc[0][0][0][0], acc[0][1][0][0], acc[1][0][0][0], acc[1][1][0][0], txt); \
        _Pragma("unroll") for (int _a = 0; _a < 2; ++_a) _Pragma("unroll") for (int _b = 0; _b < 2; ++_b) { \
        PG8_PIN4(acc[_a][_b][0][0], acc[_a][_b][0][1], acc[_a][_b][1][0], acc[_a][_b][1][1], ""); PG8_PIN4(acc[_a][_b][2][0], acc[_a][_b][2][1], acc[_a][_b][3][0], acc[_a][_b][3][1], ""); } } while (0)

struct Unit { int pm, pn, e, kind; };

typedef float f32x2_cv __attribute__((ext_vector_type(2))); typedef __bf16 bf16x2_cv __attribute__((ext_vector_type(2)));
__device__ __forceinline__ unsigned cvt_pk_bf16(float lo, float hi) { const f32x2_cv v = {lo, hi}; const bf16x2_cv b = __builtin_convertvector(v, bf16x2_cv); return __builtin_bit_cast(unsigned, b); }
__device__ __forceinline__ float bf_lo(unsigned w) { return __uint_as_float(w << 16); }
__device__ __forceinline__ float bf_hi(unsigned w) { return __uint_as_float(w & 0xffff0000u); }

template <class Epi, class Sched, bool ALIGN_EPI = true, bool SP2 = true>
__device__ __forceinline__ void gemm_phase(LAS unsigned char* lds, const Sched& S, const Epi& E) {
    const int tid = threadIdx.x, wid = __builtin_amdgcn_readfirstlane(tid >> 6), lane = tid & 63, wr = wid >> 2, wc = wid & 3, fr = lane & 15, fq = lane >> 4;
    constexpr bool FP8 = Epi::FP8; constexpr int RB = FP8 ? 2048 : 4096, nt = RB / 128;
    unsigned voffB[2]; int RA[2], CA[2];
#pragma unroll
    for (int i = 0; i < 2; ++i) { int R, C; stage_rc(tid * 16 + i * 8192, R, C); const int Rb = Epi::PERM ? ((R & ~31) + perm32(R & 31)) : R;
        voffB[i] = (unsigned)(Rb * RB + C * 2); RA[i] = R; CA[i] = C; }
    constexpr size_t kstep = (size_t)(BK * 2);
    constexpr size_t hstep = (size_t)HALF * RB;
    const unsigned ldsbase = (unsigned)__builtin_amdgcn_readfirstlane((unsigned)(uintptr_t)lds + (unsigned)wid * 1024u);
    const int aoff = lds_byte(wr * 64 + fr, fq * 8), boff = lds_byte(wc * 32 + fr, fq * 8);
#define PG8_SA(b, h) (((b) * 2 + (h)) * HTB)
#define PG8_SB(b, h) ((4 + (b) * 2 + (h)) * HTB)
#define PG8_STAGE(bufoff, gbase, voff) do { _Pragma("unroll") for (int _i = 0; _i < 2; ++_i) \
        glds_s((const char*)(gbase), (voff)[_i], ldsbase + (unsigned)((bufoff) + _i * 8192)); } while (0)
#define PG8_LDA(dst, b, h) do { _Pragma("unroll") for (int m = 0; m < 4; ++m) dst[m] = cat8(*(const LAS bf16x8*)(lds + PG8_SA(b, h) + aoff + m * 2048), *(const LAS bf16x8*)(lds + PG8_SA(b, h) + aoff + m * 2048 + 1024)); } while (0)
#define PG8_LDB(dst, b, h) do { _Pragma("unroll") for (int n = 0; n < 2; ++n) dst[n] = cat8(*(const LAS bf16x8*)(lds + PG8_SB(b, h) + boff + n * 2048), *(const LAS bf16x8*)(lds + PG8_SB(b, h) + boff + n * 2048 + 1024)); } while (0)
#define PG8_MMA(ai, bj, At, Bt) do { __builtin_amdgcn_s_setprio(1); _Pragma("unroll") for (int m = 0; m < 4; ++m) _Pragma("unroll") for (int n = 0; n < 2; ++n) { \
        if constexpr (FP8 && Epi::ASM_MFMA) asm volatile("v_mfma_scale_f32_16x16x128_f8f6f4 %0, %1, %2, %0, %3, %4 op_sel_hi:[0,0,0]" : "+v"(acc[ai][bj][m][n]) : "v"(Bt[n]), "v"(At[m]), "v"(scl_b), "v"(scl_a)); \
        else if constexpr (FP8) acc[ai][bj][m][n] = __builtin_amdgcn_mfma_scale_f32_16x16x128_f8f6f4(Bt[n], At[m], acc[ai][bj][m][n], 0, 0, 0, Epi::SCALE_B, 0, Epi::SCALE_A); \
        else { acc[ai][bj][m][n] = __builtin_amdgcn_mfma_f32_16x16x32_bf16(lo8(Bt[n]), lo8(At[m]), acc[ai][bj][m][n], 0, 0, 0); \
               acc[ai][bj][m][n] = __builtin_amdgcn_mfma_f32_16x16x32_bf16(hi8(Bt[n]), hi8(At[m]), acc[ai][bj][m][n], 0, 0, 0); } } \
        __builtin_amdgcn_s_setprio(0); } while (0)
#ifdef PROBE_DRAIN8
#define PG8_WAIT_V(n) do { if constexpr (FP8 && !Epi::ASM_MFMA) asm volatile("s_waitcnt vmcnt(0)" ::: "memory"); else asm volatile("s_waitcnt vmcnt(" #n ")" ::: "memory"); } while (0)
#else
#define PG8_WAIT_V(n) asm volatile("s_waitcnt vmcnt(" #n ")" ::: "memory")
#endif
#define PG8_WAIT_L(n) asm volatile("s_waitcnt lgkmcnt(" #n ")" ::: "memory")
#define PG8_BAR __builtin_amdgcn_s_barrier()
#define PG8_SCHED __builtin_amdgcn_sched_barrier(0)
    Unit cur, nxt; int ui = 0;
    int scl_a = Epi::SCALE_A, scl_b = Epi::SCALE_B; asm volatile("" : "+v"(scl_a), "+v"(scl_b));
    if (!S.next(0, cur)) return;
    f32x4 acc[2][2][4][2];
#pragma unroll
    for (int a = 0; a < 2; ++a)
#pragma unroll
        for (int b = 0; b < 2; ++b)
#pragma unroll
            for (int m = 0; m < 4; ++m)
#pragma unroll
                for (int n = 0; n < 2; ++n) acc[a][b][m][n] = (f32x4){0.f, 0.f, 0.f, 0.f};
    if constexpr (Epi::FP8) PG8_PIN_ACC("s_nop 7");
    v8i At[4], B0[2], B1[2];
    const char* cA = S.a_base(cur); const char* cB = S.b_base(cur);
    unsigned vo[2][2], nvo[2][2];
    S.a_offs(cur, RA, CA, vo);
    bool has_next = S.next(1, nxt);
    if (has_next) S.a_offs(nxt, RA, CA, nvo); else { nvo[0][0] = vo[0][0]; nvo[0][1] = vo[0][1]; nvo[1][0] = vo[1][0]; nvo[1][1] = vo[1][1]; }
    if constexpr (SP2) {
        PG8_STAGE(PG8_SB(0, 0), cB, voffB); PG8_STAGE(PG8_SB(0, 1), cB + hstep, voffB); PG8_STAGE(PG8_SA(0, 0), cA, vo[0]); PG8_STAGE(PG8_SA(0, 1), cA, vo[1]);
        if (wr == 1) PG8_BAR;
        PG8_WAIT_V(2); PG8_BAR;
        PG8_STAGE(PG8_SB(1, 0), cB + kstep, voffB); PG8_STAGE(PG8_SA(1, 0), cA + kstep, vo[0]); PG8_STAGE(PG8_SB(1, 1), cB + hstep + kstep, voffB);
        PG8_WAIT_V(6); PG8_BAR;
    } else {
        PG8_STAGE(PG8_SB(0, 0), cB, voffB); PG8_STAGE(PG8_SA(0, 0), cA, vo[0]); PG8_STAGE(PG8_SB(0, 1), cB + hstep, voffB); PG8_STAGE(PG8_SA(0, 1), cA, vo[1]);
        if (wr == 1) PG8_BAR;
        PG8_WAIT_V(4); PG8_BAR;
        PG8_STAGE(PG8_SB(1, 0), cB + kstep, voffB); PG8_STAGE(PG8_SA(1, 0), cA + kstep, vo[0]); PG8_STAGE(PG8_SB(1, 1), cB + hstep + kstep, voffB);
        PG8_WAIT_V(6); PG8_BAR;
    }
    for (;;) {
        const char* nA = has_next ? S.a_base(nxt) : cA; const char* nB = has_next ? S.b_base(nxt) : cB;
        for (int t = 0; t < nt; t += 2) {
            const bool last = (t == nt - 2);
            const char* a1 = cA + (size_t)(t + 1) * kstep;
            const char* a2 = last ? nA : cA + (size_t)(t + 2) * kstep; const char* b2 = last ? nB : cB + (size_t)(t + 2) * kstep;
            const char* a3 = a2 + kstep; const char* b3 = b2 + kstep;
            unsigned v2[2][2];
            v2[0][0] = last ? nvo[0][0] : vo[0][0]; v2[0][1] = last ? nvo[0][1] : vo[0][1]; v2[1][0] = last ? nvo[1][0] : vo[1][0]; v2[1][1] = last ? nvo[1][1] : vo[1][1];
            if constexpr (SP2) {
            PG8_LDB(B0, 0, 0); PG8_LDB(B1, 0, 1); PG8_SCHED; PG8_LDA(At, 0, 0); PG8_STAGE(PG8_SA(1, 1), a1, vo[1]);
            PG8_WAIT_V(8); PG8_WAIT_L(0); PG8_BAR; PG8_MMA(0, 0, At, B0); PG8_MMA(0, 1, At, B1); PG8_BAR; PG8_SCHED;
            PG8_LDA(At, 0, 1); PG8_STAGE(PG8_SB(0, 0), b2, voffB); PG8_STAGE(PG8_SB(0, 1), b2 + hstep, voffB); PG8_STAGE(PG8_SA(0, 0), a2, v2[0]);
            PG8_WAIT_V(8); PG8_WAIT_L(0); PG8_BAR; PG8_MMA(1, 0, At, B0); PG8_MMA(1, 1, At, B1); PG8_BAR; PG8_SCHED;
            PG8_LDB(B0, 1, 0); PG8_LDB(B1, 1, 1); PG8_SCHED; PG8_LDA(At, 1, 0); PG8_STAGE(PG8_SA(0, 1), a2, v2[1]);
            PG8_WAIT_V(8); PG8_WAIT_L(0); PG8_BAR; PG8_MMA(0, 0, At, B0); PG8_MMA(0, 1, At, B1); PG8_BAR; PG8_SCHED;
            PG8_LDA(At, 1, 1); PG8_STAGE(PG8_SB(1, 0), b3, voffB); PG8_STAGE(PG8_SB(1, 1), b3 + hstep, voffB); PG8_STAGE(PG8_SA(1, 0), a3, v2[0]);
            PG8_WAIT_V(8); PG8_WAIT_L(0); PG8_BAR; PG8_MMA(1, 0, At, B0); PG8_MMA(1, 1, At, B1); PG8_BAR; PG8_SCHED;
            } else {
            PG8_LDB(B0, 0, 0); PG8_SCHED; PG8_LDA(At, 0, 0); PG8_STAGE(PG8_SA(1, 1), a1, vo[1]);
            PG8_WAIT_L(8); PG8_BAR; PG8_WAIT_L(0); PG8_MMA(0, 0, At, B0); PG8_BAR; PG8_SCHED;
            PG8_LDB(B1, 0, 1); PG8_STAGE(PG8_SB(0, 0), b2, voffB);
            PG8_BAR; PG8_WAIT_L(0); PG8_MMA(0, 1, At, B1); PG8_BAR;
            PG8_LDA(At, 0, 1); PG8_STAGE(PG8_SA(0, 0), a2, v2[0]);
            PG8_BAR; PG8_WAIT_L(0); PG8_MMA(1, 0, At, B0); PG8_BAR; PG8_SCHED;
            PG8_STAGE(PG8_SB(0, 1), b2 + hstep, voffB);
            PG8_WAIT_V(6); PG8_BAR; PG8_MMA(1, 1, At, B1); PG8_BAR;
            PG8_LDB(B0, 1, 0); PG8_SCHED; PG8_LDA(At, 1, 0); PG8_STAGE(PG8_SA(0, 1), a2, v2[1]);
            PG8_WAIT_L(8); PG8_BAR; PG8_WAIT_L(0); PG8_MMA(0, 0, At, B0); PG8_BAR; PG8_SCHED;
            PG8_LDB(B1, 1, 1); PG8_STAGE(PG8_SB(1, 0), b3, voffB);
            PG8_BAR; PG8_WAIT_L(0); PG8_MMA(0, 1, At, B1); PG8_BAR;
            PG8_LDA(At, 1, 1); PG8_STAGE(PG8_SA(1, 0), a3, v2[0]);
            PG8_BAR; PG8_WAIT_L(0); PG8_MMA(1, 0, At, B0); PG8_BAR; PG8_SCHED;
            PG8_STAGE(PG8_SB(1, 1), b3 + hstep, voffB);
            PG8_WAIT_V(6); PG8_BAR; PG8_MMA(1, 1, At, B1); PG8_BAR;
            }
            if constexpr (Epi::MID) { if (t == 10 || t == 22) E.mid(acc, cur, t == 22 ? 1 : 0, wr, wc, fr, fq); }
        }
        Unit nn; const bool has_nn = has_next && S.next(ui + 2, nn); unsigned nnvo[2][2];
        if (has_nn) S.a_offs(nn, RA, CA, nnvo); else { nnvo[0][0] = nvo[0][0]; nnvo[0][1] = nvo[0][1]; nnvo[1][0] = nvo[1][0]; nnvo[1][1] = nvo[1][1]; }
        if constexpr (ALIGN_EPI) { if (wr == 0) PG8_BAR; }
        if constexpr (FP8) PG8_PIN_ACC("s_nop 15\n\ts_nop 7");
        E(acc, cur, wr, wc, fr, fq);
        if (!has_next) break;
#pragma unroll
        for (int a = 0; a < 2; ++a)
#pragma unroll
            for (int b = 0; b < 2; ++b)
#pragma unroll
                for (int m = 0; m < 4; ++m)
#pragma unroll
                    for (int n = 0; n < 2; ++n) acc[a][b][m][n] = (f32x4){0.f, 0.f, 0.f, 0.f};
        if constexpr (FP8) PG8_PIN_ACC("s_nop 7");
        cur = nxt; cA = nA; cB = nB; ++ui; nxt = nn; has_next = has_nn;
        vo[0][0] = nvo[0][0]; vo[0][1] = nvo[0][1]; vo[1][0] = nvo[1][0]; vo[1][1] = nvo[1][1];
        nvo[0][0] = nnvo[0][0]; nvo[0][1] = nnvo[0][1]; nvo[1][0] = nnvo[1][0]; nvo[1][1] = nnvo[1][1];
        if constexpr (ALIGN_EPI) { if (wr == 1) PG8_BAR; }
    }
    PG8_WAIT_V(0);
    if constexpr (!ALIGN_EPI) { if (wr == 0) PG8_BAR; }
    PG8_BAR;
#undef PG8_SA
#undef PG8_SB
#undef PG8_STAGE
#undef PG8_LDA
#undef PG8_LDB
#undef PG8_MMA
#undef PG8_WAIT_V
#undef PG8_WAIT_L
#undef PG8_BAR
#undef PG8_SCHED
}
}

constexpr int NWAVES = 8;
constexpr int BATCH = 2, SEQ = 8192, DM = 2048, T = BATCH * SEQ;
constexpr int NMEM = 256, MROWS = BATCH * NMEM;
constexpr int INW = 10252;
constexpr int NEXP = 32, TOPK = 4, CAP = T;
constexpr int QKVW = 4096;
constexpr int C_FQ = 0, C_FK = 768, C_FV = 1536, C_SQ = 2304, C_SK = 3072, C_SV = 3328, C_MQ = 3584;
constexpr int GW = 6144;
constexpr float NORM_EPS = 1e-6f;
constexpr float LOG2E = 1.4426950408889634f;
constexpr float SWIGLU_LIMIT = 7.0f, SWIGLU_ALPHA = 1.702f;
constexpr int PER_PHASE = 10;
#ifndef MK_N_LAUNCHES
#define MK_N_LAUNCHES 1
#endif
constexpr int N_LAUNCHES = MK_N_LAUNCHES;

constexpr size_t MiB = 1u << 20;
constexpr size_t WS_CTL = 0, CTL_ZERO_BYTES = 1 * MiB;
constexpr size_t WS_WIN   = 2 * MiB;
constexpr size_t WS_WMKV  = WS_WIN + 40 * MiB;
constexpr size_t WS_WUP   = WS_WMKV + 4 * MiB;
constexpr size_t WS_WOUT  = WS_WUP + 8 * MiB;
constexpr size_t WS_WRT   = WS_WOUT + 8 * MiB;
constexpr size_t WS_WGU   = WS_WRT + 1 * MiB;
constexpr size_t WS_WD    = WS_WGU + 512 * MiB;
constexpr size_t WS_XN    = WS_WD + 256 * MiB;
constexpr size_t WS_MN    = WS_XN + 64 * MiB;
constexpr size_t WS_LOGF  = WS_MN + 2 * MiB;
constexpr size_t WS_CNEG  = WS_LOGF + 1 * MiB;
constexpr size_t WS_ROPE  = WS_CNEG + 1 * MiB;
constexpr size_t WS_QKV   = WS_ROPE + 4 * MiB;
constexpr size_t WS_G     = WS_QKV + 128 * MiB;
constexpr size_t WS_MKV   = WS_G + 192 * MiB;
constexpr size_t WS_OALL  = WS_MKV + 1 * MiB;
constexpr size_t WS_MERGED= WS_OALL + 64 * MiB;
constexpr size_t WS_HB    = WS_MERGED + 64 * MiB;
constexpr size_t WS_TOK   = WS_HB + 64 * MiB;
constexpr size_t WS_GATE  = WS_TOK + 2 * MiB;
constexpr size_t WS_RS    = WS_GATE + 2 * MiB;
constexpr size_t WS_ACT   = WS_RS + 2 * MiB;
constexpr size_t WS_Y     = WS_ACT + 288 * MiB;
constexpr size_t WS_TSLOT = WS_Y + 288 * MiB;
constexpr size_t WS_TGATE = WS_TSLOT + 1 * MiB;
constexpr size_t WS_XN8   = WS_TGATE + 1 * MiB;
constexpr size_t WS_WIN8  = WS_XN8 + 32 * MiB;
constexpr size_t WS_END   = WS_WIN8 + 12 * MiB;
constexpr int CW_BAR = 4096;
constexpr int CW_QHEAD = 64;
constexpr int CW_CNT = 512;

typedef unsigned short bf16;
typedef unsigned v4u __attribute__((ext_vector_type(4)));
typedef unsigned v2u __attribute__((ext_vector_type(2)));
typedef float f32x4 __attribute__((ext_vector_type(4)));
typedef float f32x16 __attribute__((ext_vector_type(16)));
typedef short bf16x8 __attribute__((ext_vector_type(8)));
typedef short s16x4 __attribute__((ext_vector_type(4)));
typedef GAS unsigned gu32;
#define RLX_AGENT __ATOMIC_RELAXED, __HIP_MEMORY_SCOPE_AGENT
#define LDS_WAIT() asm volatile("s_waitcnt lgkmcnt(0)" ::: "memory")
#define VM_WAIT() asm volatile("s_waitcnt vmcnt(0)" ::: "memory")
__device__ __forceinline__ unsigned f2bf(float f) { unsigned u = __builtin_bit_cast(unsigned, f); return (u + 0x7fffu + ((u >> 16) & 1u)) >> 16; }
__device__ __forceinline__ unsigned pk2(float lo, float hi) { return f2bf(lo) | (f2bf(hi) << 16); }
__device__ __forceinline__ float bf2f(unsigned short b) { return __uint_as_float(((unsigned)b) << 16); }
__device__ __forceinline__ float wave_sum(float v) {
#pragma unroll
    for (int o = 1; o < 64; o <<= 1) v += __shfl_xor(v, o);
    return v;
}
__device__ __forceinline__ float sigmoidf_(float x) { return __builtin_amdgcn_rcpf(1.0f + __builtin_amdgcn_exp2f(x * (-LOG2E))); }

constexpr int H8_SHIFT = 4, ACT8_SHIFT = 2, W8_SHIFT = 9;
constexpr float H8_MUL = 16.0f, ACT8_MUL = 4.0f, W8_MUL = 512.0f;
__device__ __forceinline__ float clamp_fp8(float v) { return __builtin_amdgcn_fmed3f(v, -448.0f, 448.0f); }
__device__ __forceinline__ unsigned pk4_fp8(float a, float b, float c, float d) {
    int p = __builtin_amdgcn_cvt_pk_fp8_f32(clamp_fp8(a), clamp_fp8(b), 0, false); p = __builtin_amdgcn_cvt_pk_fp8_f32(clamp_fp8(c), clamp_fp8(d), p, true); return (unsigned)p; }
using pg8::f32x2; using pg8::u32x4; using pg8::u32x2; using pg8::cvt_pk_bf16; using pg8::bf_lo; using pg8::bf_hi;

#define XB_TMO      128
#define XB_XCNT(j)  (256  + 64 * (j))
#define XB_XSUB(j)  (1280 + 64 * (j))
#define XB_XGEN(j)  (2304 + 64 * (j))
#define XB_TOP      3328
#define XB_TOPGEN   3392
#define XCD_BAR_WORDS 3456
#define XB_SPIN_CAP (1u << 18)

__device__ __forceinline__ unsigned xb_ld(unsigned* p)              { return __hip_atomic_load(p, __ATOMIC_RELAXED, __HIP_MEMORY_SCOPE_AGENT); }
__device__ __forceinline__ unsigned xb_add(unsigned* p, unsigned v) { return __hip_atomic_fetch_add(p, v, __ATOMIC_RELAXED, __HIP_MEMORY_SCOPE_AGENT); }
__device__ __forceinline__ unsigned xb_xcc_id() { return (unsigned)__builtin_amdgcn_s_getreg((3 << 11) | 20) & 0xFu; }
#define XB_SPIN(cond, bar) do { unsigned _sp = 0; while (cond) { __builtin_amdgcn_s_sleep(1); \
    if ((++_sp & 255u) == 0u) { if (xb_ld(&(bar)[XB_TMO])) break; if (_sp > XB_SPIN_CAP) { atomicAdd(&(bar)[XB_TMO], 1u); break; } } } } while (0)

struct XcdBarrier { unsigned* bar; unsigned x; volatile LAS unsigned* st; };

__device__ __forceinline__ XcdBarrier xcd_barrier_post(unsigned* bar, volatile LAS unsigned* st) {
    XcdBarrier b; b.bar = bar; b.x = xb_xcc_id(); b.st = st;
    if (threadIdx.x == 0) (void)xb_add(&bar[XB_XCNT(b.x)], 1u);
    return b;
}
__device__ __forceinline__ void xcd_barrier_complete(unsigned* bar, unsigned x, unsigned& nloc, unsigned& nx) {
    const unsigned G = gridDim.x * gridDim.y * gridDim.z;
    unsigned sum, cnt, mine, sp = 0u;
    for (;;) {
        sum = 0u; cnt = 0u; mine = 0u;
#pragma unroll
        for (unsigned j = 0; j < 16; ++j) { const unsigned c = xb_ld(&bar[XB_XCNT(j)]); sum += c; cnt += (c > 0u) ? 1u : 0u; mine = (j == x) ? c : mine; }
        if (sum == G) break;
        __builtin_amdgcn_s_sleep(1);
        if ((++sp & 255u) == 0u) { if (xb_ld(&bar[XB_TMO])) break; if (sp > XB_SPIN_CAP) { atomicAdd(&bar[XB_TMO], 1u); break; } }
    }
    nloc = mine > 0u ? mine : 1u; nx = cnt > 0u ? cnt : 1u;
}
__device__ __forceinline__ void xcd_barrier(const XcdBarrier& b) {
    asm volatile("s_waitcnt vmcnt(0)" ::: "memory");
    __syncthreads();
    if (threadIdx.x == 0) {
        unsigned* bar = b.bar;
        __builtin_amdgcn_s_waitcnt(0);
        unsigned nloc = b.st[0], nx = b.st[1];
        if (nloc == 0u) { xcd_barrier_complete(bar, b.x, nloc, nx); b.st[0] = nloc; b.st[1] = nx; }
        const unsigned old = xb_add(&bar[XB_XSUB(b.x)], 1u);
        const unsigned gen = old / nloc;
        if (old + 1u == (gen + 1u) * nloc) {
            __builtin_amdgcn_fence(__ATOMIC_RELEASE, "agent");
            asm volatile("s_waitcnt vmcnt(0)" ::: "memory");
            const unsigned og = xb_add(&bar[XB_TOP], 1u);
            const unsigned tg = og / nx;
            if (og + 1u == (tg + 1u) * nx) xb_add(&bar[XB_TOPGEN], 1u);
            else XB_SPIN(xb_ld(&bar[XB_TOPGEN]) == tg, bar);
            __builtin_amdgcn_fence(__ATOMIC_ACQUIRE, "agent");
            xb_add(&bar[XB_XGEN(b.x)], 1u);
            asm volatile("s_waitcnt vmcnt(0)" ::: "memory");
        } else {
            XB_SPIN(xb_ld(&bar[XB_XGEN(b.x)]) == gen, bar);
            __builtin_amdgcn_fence(__ATOMIC_ACQUIRE, "agent");
            asm volatile("s_waitcnt vmcnt(0)" ::: "memory");
        }
    }
    __syncthreads();
}

constexpr int RING_OFF = 0, RING_BYTES = 131072;
constexpr int LDSCTL_OFF = RING_BYTES, MISC_OFF = LDSCTL_OFF + 320;
constexpr int MOE_OFF = MISC_OFF + 128;
constexpr int LDS_BYTES = 147456;

struct Ctx {
    LAS unsigned char* lds;
    volatile LAS unsigned* MISC;
    gu32* ctl;
    int tid, lane, wave, vcu, G;
    const float *x, *mem; const int* pos; const float *norm_mix, *w_in, *b_forget, *fox_q_norm, *fox_k_norm, *swa_q_norm, *swa_k_norm, *swa_sinks, *xmem_q_norm, *xmem_k_norm, *norm_mem,
        *w_mem_kv, *w_up_fox, *w_up_swa, *w_up_xmem, *w_out, *norm_ffn, *w_router, *b_router, *w_gate_up, *b_gate_up, *w_down, *b_down;
    float* out;
    bf16 *Win_t, *Wmkv_t, *Wup_t, *Wout_t, *Wr_t, *Wgu_t, *Wd_t, *XN, *MN, *QKV, *G_, *MKV, *OALL, *MERGED, *HB, *ACT;
    float *LOGF, *CNEG, *ROPE, *GATEW, *RS, *TGATE; int *TOK, *TSLOT; bf16* Y; unsigned char *XN8, *Win8;
};

#ifndef PROBE_INW
#define PROBE_INW 64
#endif
__constant__ float INV_FREQ[32] = {1.000000000e+00f, 7.498942614e-01f, 5.623413324e-01f, 4.216965139e-01f, 3.162277639e-01f, 2.371373773e-01f, 1.778279394e-01f, 1.333521307e-01f,
    1.000000015e-01f, 7.498941571e-02f, 5.623413250e-02f, 4.216965288e-02f, 3.162277490e-02f, 2.371373773e-02f, 1.778279431e-02f, 1.333521493e-02f, 9.999999776e-03f, 7.498941850e-03f,
    5.623413250e-03f, 4.216964822e-03f, 3.162277630e-03f, 2.371373586e-03f, 1.778279431e-03f, 1.333521446e-03f, 1.000000047e-03f, 7.498942432e-04f, 5.623413017e-04f, 4.216965172e-04f,
    3.162277571e-04f, 2.371373703e-04f, 1.778279402e-04f, 1.333521504e-04f};

struct TItem { const float* src; const float* ksc; bf16* dst; size_t ldw; int f8, gap; };
__device__ __forceinline__ void titem_load(const TItem& I, f32x4 (&v)[8][2], float (&sc)[8][2], int lane) {
    const int rr = lane >> 4, c4 = lane & 15;
#pragma unroll
    for (int p = 0; p < 8; ++p)
#pragma unroll
        for (int h = 0; h < 2; ++h) { const int k = 8 * p + 2 * rr + h; v[p][h] = *(const GAS f32x4*)(I.src + (size_t)k * I.ldw + 4 * c4 + (c4 >= 8 ? I.gap : 0)); sc[p][h] = I.ksc ? I.ksc[k] : 1.0f; }
}
__device__ __forceinline__ void titem_store(const TItem& I, const f32x4 (&v)[8][2], const float (&sc)[8][2], LAS unsigned* tile, int lane) {
    const int rr = lane >> 4, c4 = lane & 15;
#pragma unroll
    for (int p = 0; p < 8; ++p)
#pragma unroll
        for (int q = 0; q < 4; ++q) { const int n = 4 * c4 + q, sw = (n ^ (n >> 3)) & 7;
            tile[n * 32 + 4 * (p ^ sw) + rr] = pg8::cvt_pk_bf16(v[p][0][q] * sc[p][0], v[p][1][q] * sc[p][1]); }
    LDS_WAIT(); asm volatile("" ::: "memory");
#pragma unroll
    for (int j = 0; j < 8; ++j) { const int n = 8 * j + (lane >> 3), c = lane & 7, sw = (n ^ (n >> 3)) & 7;
        const v4u o = *(const LAS v4u*)(tile + n * 32 + 4 * (c ^ sw));
        *(GAS v4u*)(I.dst + (size_t)n * DM + 8 * c) = o; }
    LDS_WAIT(); asm volatile("" ::: "memory");
}
__device__ __forceinline__ void titem8_load(const TItem& I, int hf, f32x4 (&v)[8][2], float (&sc)[8][2], int lane) {
    const int rr = lane >> 4, c4 = lane & 15;
#pragma unroll
    for (int p = 0; p < 4; ++p)
#pragma unroll
        for (int h = 0; h < 4; ++h) { const int k = 64 * hf + 16 * p + 4 * rr + h; v[2 * p + (h >> 1)][h & 1] = *(const GAS f32x4*)(I.src + (size_t)k * I.ldw + 4 * c4); sc[2 * p + (h >> 1)][h & 1] = (I.ksc ? I.ksc[k] : 1.0f) * W8_MUL; }
}
__device__ __forceinline__ void titem8_pack(int hf, const f32x4 (&v)[8][2], const float (&sc)[8][2], LAS unsigned* tile, int lane) {
    const int rr = lane >> 4, c4 = lane & 15;
#pragma unroll
    for (int p = 0; p < 4; ++p)
#pragma unroll
        for (int q = 0; q < 4; ++q) { const int n = 4 * c4 + q, sw = (n ^ (n >> 3)) & 7;
            tile[n * 32 + 4 * ((4 * hf + p) ^ sw) + rr] = pk4_fp8(v[2 * p][0][q] * sc[2 * p][0], v[2 * p][1][q] * sc[2 * p][1], v[2 * p + 1][0][q] * sc[2 * p + 1][0], v[2 * p + 1][1][q] * sc[2 * p + 1][1]); }
}
__device__ __forceinline__ void titem8_flush(const TItem& I, LAS unsigned* tile, int lane) {
    LDS_WAIT(); asm volatile("" ::: "memory");
#pragma unroll
    for (int j = 0; j < 8; ++j) { const int n = 8 * j + (lane >> 3), c = lane & 7, sw = (n ^ (n >> 3)) & 7;
        const v4u o = *(const LAS v4u*)(tile + n * 32 + 4 * (c ^ sw));
        *(GAS v4u*)((unsigned char*)I.dst + (size_t)n * DM + 16 * c) = o; }
    LDS_WAIT(); asm volatile("" ::: "memory");
}
__device__ __forceinline__ void p0_router_item(const float* W, int k0, bf16* WT, const float* ksc, LAS float* scr, int lane) {
#pragma unroll 8
    for (int i = 0; i < 32; ++i) { const int kk = 2 * i + (lane >> 5); scr[kk * 33 + (lane & 31)] = W[(size_t)(k0 + kk) * 32 + (lane & 31)] * ksc[k0 + kk]; }
    LDS_WAIT(); asm volatile("" ::: "memory");
    const int c = lane & 7;
#pragma unroll
    for (int j = 0; j < 4; ++j) { const int n = (lane >> 3) + 8 * j; const LAS float* s = scr + (8 * c) * 33 + n;
        unsigned h[8], l[8];
#pragma unroll
        for (int q = 0; q < 8; ++q) { const float v = s[q * 33]; h[q] = f2bf(v); l[q] = f2bf(v - __uint_as_float(h[q] << 16)); }
        v4u oh, ol; oh.x = h[0] | (h[1] << 16); oh.y = h[2] | (h[3] << 16); oh.z = h[4] | (h[5] << 16); oh.w = h[6] | (h[7] << 16);
        ol.x = l[0] | (l[1] << 16); ol.y = l[2] | (l[3] << 16); ol.z = l[4] | (l[5] << 16); ol.w = l[6] | (l[7] << 16);
        *(GAS v4u*)(WT + (size_t)n * 2048 + k0 + 8 * c) = oh; *(GAS v4u*)(WT + (size_t)(32 + n) * 2048 + k0 + 8 * c) = ol; }
    LDS_WAIT(); asm volatile("" ::: "memory");
}
__device__ __forceinline__ float log_sigmoidf_(float z) { return fminf(z, 0.f) - log1pf(__expf(-fabsf(z))); }

template <bool XROW>
__device__ __forceinline__ void p0_norm_row(const Ctx& C, const float* xrow, const float* gain, bf16* orow, const LAS float* Wf, int m) {
    const GAS f32x4* xr = (const GAS f32x4*)xrow + C.lane; const GAS f32x4* gr = (const GAS f32x4*)gain + C.lane;
    f32x4 v[8]; float s = 0.f;
#pragma unroll
    for (int j = 0; j < 8; ++j) { v[j] = xr[64 * j]; s += (v[j].x * v[j].x + v[j].y * v[j].y) + (v[j].z * v[j].z + v[j].w * v[j].w); }
    const float rstd = 1.0f / sqrtf(wave_sum(s) * (1.f / DM) + NORM_EPS);
    GAS unsigned long long* o8 = (GAS unsigned long long*)orow + C.lane;
#pragma unroll
    for (int j = 0; j < 8; ++j) { const f32x4 g = gr[64 * j]; v[j] = (v[j] * rstd) * g;
        o8[64 * j] = (unsigned long long)pk2(v[j].x, v[j].y) | ((unsigned long long)pk2(v[j].z, v[j].w) << 32);
        if constexpr (XROW) ((GAS unsigned*)(C.XN8 + (size_t)m * DM))[C.lane + 64 * j] = pk4_fp8(v[j].x * H8_MUL, v[j].y * H8_MUL, v[j].z * H8_MUL, v[j].w * H8_MUL); }
    if constexpr (XROW) {
        float mine = 0.f;
#pragma unroll 1
        for (int h = 0; h < 12; ++h) { const LAS f32x4* w = (const LAS f32x4*)(Wf + h * 2048) + C.lane; float d = 0.f;
#pragma unroll
            for (int j = 0; j < 8; ++j) { const f32x4 ww = w[64 * j]; d += (v[j].x * ww.x + v[j].y * ww.y) + (v[j].z * ww.z + v[j].w * ww.w); }
            d = wave_sum(d); if (C.lane == h) mine = d; }
        const int b = m / SEQ, t = m % SEQ;
        if (C.lane < 12) C.LOGF[(size_t)(b * 12 + C.lane) * SEQ + t] = log_sigmoidf_(mine + C.b_forget[C.lane]);
        if (C.lane < 32) { const float ang = (float)C.pos[m] * INV_FREQ[C.lane]; const double rev = (double)ang * 0.15915494309189535; const float fr = (float)(rev - floor(rev));
            C.ROPE[(size_t)m * 64 + C.lane] = __builtin_amdgcn_cosf(fr); C.ROPE[(size_t)m * 64 + 32 + C.lane] = __builtin_amdgcn_sinf(fr); }
    }
}
__device__ __forceinline__ void phase0(const Ctx& C) {
    const int gw = C.vcu * NWAVES + C.wave, NGW = C.G * NWAVES;
    LAS float* scr = (LAS float*)(C.lds + RING_OFF + C.wave * 16384);
    for (int r = gw; r < 32; r += NGW) p0_router_item(C.w_router, 64 * r, C.Wr_t, C.norm_ffn, scr, C.lane);
    constexpr int I_GU = 32 * 16 * 64, I_D = 32 * 16 * 32, I_ING = 16 * 96, I_IN = 32 * PROBE_INW, I_MKV = 32 * 16, I_UF = 12 * 32, I_US = 12 * 32, I_UX = 8 * 32, I_O = 32 * 32;
    constexpr int NITEMS = I_GU + I_D + I_ING + I_IN + I_MKV + I_UF + I_US + I_UX + I_O;
    auto decode = [&](int it) -> TItem {
        TItem I; int r = it; I.ksc = nullptr; I.f8 = 0; I.gap = 0;
        if (r < I_GU) { const int e = r / 1024, q = r % 1024, kb = 2 * (q / 64), pb = q % 64, tl = pb >> 2, jb = pb & 3;
            const int n0 = (jb < 2) ? (128 * tl + 64 * jb) : (2048 + 128 * tl + 64 * (jb - 2));
            I.ldw = 4096; I.src = C.w_gate_up + (size_t)e * DM * 4096 + (size_t)(64 * kb) * 4096 + n0; I.ksc = C.norm_ffn + 64 * kb; I.f8 = 1; I.dst = (bf16*)((unsigned char*)C.Wgu_t + ((size_t)e * 4096 + 64 * pb) * DM + 64 * kb); return I; } r -= I_GU;
        if (r < I_D) { const int e = r / 512, q = r % 512, kb = 2 * (q / 32), nb = q % 32;
            I.ldw = DM; I.src = C.w_down + (size_t)e * DM * DM + (size_t)(64 * kb) * DM + 64 * nb; I.f8 = 1; I.dst = (bf16*)((unsigned char*)C.Wd_t + ((size_t)e * DM + 64 * nb) * DM + 64 * kb); return I; } r -= I_D;
        if (r < I_ING) { const int kb = 2 * (r / 96), pb = r % 96;
            I.ldw = INW; I.src = C.w_in + (size_t)(64 * kb) * INW + 4108 + 64 * pb; I.f8 = 1; I.dst = (bf16*)((unsigned char*)C.Win8 + (size_t)(64 * pb) * DM + 64 * kb); return I; } r -= I_ING;
        if (r < I_IN) { const int kb = r / PROBE_INW, pb = r % PROBE_INW; int p0 = 64 * pb; const int tl = pb >> 2, q4 = pb & 3;
            if (tl == 3 || tl == 4 || tl == 5 || tl == 12) { p0 = 256 * tl + 128 * (q4 & 1) + 32 * (q4 >> 1); I.gap = 32; }
            const int n0 = (p0 < 2304) ? p0 : p0 + 12;
            I.ldw = INW; I.src = C.w_in + (size_t)(64 * kb) * INW + n0; I.dst = C.Win_t + (size_t)(64 * pb) * DM + 64 * kb; return I; } r -= I_IN;
        if (r < I_MKV) { const int kb = r / 16, nb = r % 16; I.ldw = 1024; I.src = C.w_mem_kv + (size_t)(64 * kb) * 1024 + 64 * nb; I.dst = C.Wmkv_t + (size_t)(64 * nb) * DM + 64 * kb; return I; } r -= I_MKV;
        if (r < I_UF) { const int kb = r / 32, nb = r % 32; I.ldw = DM; I.src = C.w_up_fox + (size_t)(64 * kb) * DM + 64 * nb; I.dst = C.Wup_t + (size_t)(64 * nb) * DM + 64 * kb; return I; } r -= I_UF;
        if (r < I_US) { const int kb = r / 32, nb = r % 32; I.ldw = DM; I.src = C.w_up_swa + (size_t)(64 * kb) * DM + 64 * nb; I.dst = C.Wup_t + (size_t)(64 * nb) * DM + 768 + 64 * kb; return I; } r -= I_US;
        if (r < I_UX) { const int kb = r / 32, nb = r % 32; I.ldw = DM; I.src = C.w_up_xmem + (size_t)(64 * kb) * DM + 64 * nb; I.dst = C.Wup_t + (size_t)(64 * nb) * DM + 1536 + 64 * kb; return I; } r -= I_UX;
        { const int kb = r / 32, nb = r % 32; I.ldw = DM; I.src = C.w_out + (size_t)(64 * kb) * DM + 64 * nb; I.dst = C.Wout_t + (size_t)(64 * nb) * DM + 64 * kb; return I; }
    };
    LAS unsigned* tile = (LAS unsigned*)(C.lds + RING_OFF + C.wave * 8192);
    __syncthreads();
    constexpr int N8 = I_GU + I_D + I_ING;
    if (gw < N8) {
        const int nh = 2 * ((N8 - gw + NGW - 1) / NGW);
        TItem cur = decode(gw); f32x4 va[8][2]; float sa[8][2]; titem8_load(cur, 0, va, sa, C.lane);
        for (int hs = 0; hs < nh; ++hs) {
            const int hf = hs & 1; TItem nxt = cur; f32x4 vb[8][2]; float sb[8][2];
            if (hs + 1 < nh) { if (hf == 1) nxt = decode(gw + ((hs + 1) >> 1) * NGW); titem8_load(nxt, hf ^ 1, vb, sb, C.lane); }
            titem8_pack(hf, va, sa, tile, C.lane);
            if (hf == 1) titem8_flush(cur, tile, C.lane);
            cur = nxt;
#pragma unroll
            for (int p = 0; p < 8; ++p)
#pragma unroll
                for (int h = 0; h < 2; ++h) { va[p][h] = vb[p][h]; sa[p][h] = sb[p][h]; }
        }
    }
    if (N8 + gw < NITEMS) {
        TItem cur = decode(N8 + gw); f32x4 va[8][2]; float sa[8][2]; titem_load(cur, va, sa, C.lane);
        for (int it = N8 + gw; it < NITEMS; it += NGW) {
            const int nx = it + NGW; TItem nxt = cur; f32x4 vb[8][2]; float sb[8][2];
            if (nx < NITEMS) { nxt = decode(nx); titem_load(nxt, vb, sb, C.lane); }
            titem_store(cur, va, sa, tile, C.lane);
            cur = nxt;
#pragma unroll
            for (int p = 0; p < 8; ++p)
#pragma unroll
                for (int h = 0; h < 2; ++h) { va[p][h] = vb[p][h]; sa[p][h] = sb[p][h]; }
        }
    }
    __syncthreads();
    LAS float* Wf = (LAS float*)(C.lds + RING_OFF);
    for (int idx = C.tid; idx < 12 * 2048; idx += NWAVES * 64) { const int k = idx / 12, h = idx - 12 * k; Wf[h * 2048 + k] = C.w_in[(size_t)k * INW + 2304 + h]; }
    __syncthreads();
    for (int m = gw; m < T; m += NGW) p0_norm_row<true>(C, C.x + (size_t)m * DM, C.norm_mix, C.XN + (size_t)m * DM, Wf, m);
    for (int m = gw; m < MROWS; m += NGW) p0_norm_row<false>(C, C.mem + (size_t)m * DM, C.norm_mem, C.MN + (size_t)m * DM, Wf, m);
    __syncthreads();
}

using pg8::Unit;
template <int RB>
struct DenseOrderT {
    const char* A; const char* Bt; int nM, nN, nwg, G, c;
    __device__ __forceinline__ void init(const void* A_, const void* Bt_, int M, int N, int G_, int c_) { A = (const char*)A_; Bt = (const char*)Bt_; nM = M / 256; nN = N / 256; nwg = nM * nN; G = G_; c = c_; }
    __device__ __forceinline__ bool map(long L, Unit& u) const {
        if (L >= nwg) return false;
        int wgid = (int)L; { const int q = nwg / 8, r = nwg % 8, xcd = wgid % 8, off = wgid / 8; wgid = (xcd < r ? xcd * (q + 1) : r * (q + 1) + (xcd - r) * q) + off; }
        const int nig = 8 * nN, gid = wgid / nig, fm = gid * 8, gsz = (nM - fm) < 8 ? (nM - fm) : 8;
        u.pm = fm + ((wgid % nig) % gsz); u.pn = (wgid % nig) / gsz; u.e = 0; u.kind = 0; return true;
    }
    __device__ __forceinline__ bool next(int i, Unit& u) const { return map((long)i * G + c, u); }
    __device__ __forceinline__ const char* a_base(const Unit& u) const { return A + (size_t)u.pm * (256 * RB); }
    __device__ __forceinline__ const char* b_base(const Unit& u) const { return Bt + (size_t)u.pn * (256 * RB); }
    __device__ __forceinline__ void a_offs(const Unit&, const int (&R)[2], const int (&Cc)[2], unsigned (&vo)[2][2]) const {
#pragma unroll
        for (int h = 0; h < 2; ++h)
#pragma unroll
            for (int i = 0; i < 2; ++i) vo[h][i] = (unsigned)((h * 128 + R[i]) * RB + Cc[i] * 2);
    }
};
typedef DenseOrderT<4096> DenseOrder;
struct P1Order {
    DenseOrder d; const char* A1; const char* B1;
    __device__ __forceinline__ bool next(int i, Unit& u) const {
        const long L = (long)i * d.G + d.c;
        if (L < d.nwg) return d.map(L, u);
        const int r = (int)(L - d.nwg); if (r >= 8) return false;
        u.pm = r >> 2; u.pn = r & 3; u.e = 0; u.kind = 1; return true;
    }
    __device__ __forceinline__ const char* a_base(const Unit& u) const { return (u.kind ? A1 : d.A) + (size_t)u.pm * (256 * 2048 * 2); }
    __device__ __forceinline__ const char* b_base(const Unit& u) const { return (u.kind ? B1 : d.Bt) + (size_t)u.pn * (256 * 2048 * 2); }
    __device__ __forceinline__ void a_offs(const Unit& u, const int (&R)[2], const int (&Cc)[2], unsigned (&vo)[2][2]) const { d.a_offs(u, R, Cc, vo); }
};
struct P1bOrder {
    DenseOrderT<2048> d;
    __device__ __forceinline__ bool next(int i, Unit& u) const {
        const int c = d.c;
        if (c < 8) return i < 4 ? d.map((long)i * d.G + c, u) : false;
        if (i < 6) return d.map((long)i * d.G + c, u);
        if (i == 6 && c < 24) { const int idx = c - 8; return d.map((long)(4 + (idx & 1)) * d.G + (idx >> 1), u); }
        return false;
    }
    __device__ __forceinline__ const char* a_base(const Unit& u) const { return d.a_base(u); }
    __device__ __forceinline__ const char* b_base(const Unit& u) const { return d.b_base(u); }
    __device__ __forceinline__ void a_offs(const Unit& u, const int (&R)[2], const int (&Cc)[2], unsigned (&vo)[2][2]) const { d.a_offs(u, R, Cc, vo); }
};
template <bool GATHER, int NT, int RB>
struct MoeOrder {
    const char* A; const char* Bt; const int* tok; const int* cnt; const LAS int* tab; int G, c;
    __device__ __forceinline__ bool next(int i, Unit& u) const {
        const int L = i * G + c; if (L >= __builtin_amdgcn_readfirstlane(tab[32])) return false;
        int e = 0;
#pragma unroll 1
        for (int j = 1; j < 32; ++j) e += (__builtin_amdgcn_readfirstlane(tab[j]) <= L) ? 1 : 0;
        const int j = L - __builtin_amdgcn_readfirstlane(tab[e]), mt = __builtin_amdgcn_readfirstlane(tab[33 + e]), per = mt * 4, ntg = j / per, r = j - ntg * per;
        u.e = e; u.pm = r >> 2; u.pn = ntg * 4 + (r & 3); u.kind = __builtin_amdgcn_readfirstlane(tab[65 + e]) + 256 * u.pm;
        return true;
    }
    __device__ __forceinline__ const char* a_base(const Unit& u) const { return GATHER ? A : A + (size_t)u.kind * RB; }
    __device__ __forceinline__ const char* b_base(const Unit& u) const { return Bt + ((size_t)u.e * NT + u.pn) * (256 * RB); }
    __device__ __forceinline__ void a_offs(const Unit& u, const int (&R)[2], const int (&Cc)[2], unsigned (&vo)[2][2]) const {
#pragma unroll
        for (int h = 0; h < 2; ++h)
#pragma unroll
            for (int i = 0; i < 2; ++i) {
                if constexpr (GATHER) { const int n_e = __builtin_amdgcn_readfirstlane(tab[97 + u.e]); int ri = 256 * u.pm + h * 128 + R[i]; ri = ri < n_e ? ri : n_e - 1;
                    const int row = tok[u.e * CAP + ri]; vo[h][i] = (unsigned)(row * RB + Cc[i] * 2); }
                else vo[h][i] = (unsigned)((h * 128 + R[i]) * RB + Cc[i] * 2);
            }
    }
};

struct EpiInProj {
    static constexpr bool PERM = true, MID = false, FP8 = false, ASM_MFMA = false; static constexpr int SCALE_A = 0x7f, SCALE_B = 0x7f;
    bf16* QKV; bf16* Gt; bf16* MKV; int noop; const float* gk_fox; const float* gk_swa; const float* rope;
    __device__ __forceinline__ void mid(pg8::f32x4 (&)[2][2][4][2], const Unit&, int, int, int, int, int) const {}
    __device__ __forceinline__ void operator()(const pg8::f32x4 (&acc)[2][2][4][2], const Unit& u, int wr, int wc, int fr, int fq) const {
        asm volatile("" : "+v"(fr), "+v"(fq));
        if (noop) return;
        if (!u.kind && (u.pn == 3 || u.pn == 4 || u.pn == 5 || u.pn == 12)) {
            const bool swa = (u.pn == 12); const float* gp = (swa ? gk_swa : gk_fox) + 8 * fq;
            float gn[2][8];
#pragma unroll
            for (int bj = 0; bj < 2; ++bj) { const pg8::f32x4 a = *(const pg8::f32x4*)(gp + 32 * bj), b = *(const pg8::f32x4*)(gp + 32 * bj + 4);
                gn[bj][0] = a[0]; gn[bj][1] = a[1]; gn[bj][2] = a[2]; gn[bj][3] = a[3]; gn[bj][4] = b[0]; gn[bj][5] = b[1]; gn[bj][6] = b[2]; gn[bj][7] = b[3]; }
#pragma unroll
            for (int ai = 0; ai < 2; ++ai)
#pragma unroll
                for (int m = 0; m < 4; ++m) { const int row = u.pm * 256 + wr * 64 + fr + ai * 128 + m * 16;
                    float x[2][8]; float ss = 0.f;
#pragma unroll
                    for (int bj = 0; bj < 2; ++bj)
#pragma unroll
                        for (int n = 0; n < 2; ++n)
#pragma unroll
                            for (int e = 0; e < 4; ++e) { const float v = acc[ai][bj][m][n][e]; x[bj][4 * n + e] = v; ss += v * v; }
                    ss += __shfl_xor(ss, 16); ss += __shfl_xor(ss, 32);
                    const float rstd = 1.0f / sqrtf(ss * (1.f / 64.f) + NORM_EPS);
#pragma unroll
                    for (int bj = 0; bj < 2; ++bj)
#pragma unroll
                        for (int q = 0; q < 8; ++q) x[bj][q] = (x[bj][q] * rstd) * gn[bj][q];
                    if (swa) { const float* cs = rope + (size_t)row * 64 + 8 * fq;
                        const pg8::f32x4 c0 = *(const pg8::f32x4*)cs, c1 = *(const pg8::f32x4*)(cs + 4), s0 = *(const pg8::f32x4*)(cs + 32), s1 = *(const pg8::f32x4*)(cs + 36);
                        const float cc[8] = {c0[0], c0[1], c0[2], c0[3], c1[0], c1[1], c1[2], c1[3]}, sn[8] = {s0[0], s0[1], s0[2], s0[3], s1[0], s1[1], s1[2], s1[3]};
#pragma unroll
                        for (int q = 0; q < 8; ++q) { const float x1 = x[0][q], x2 = x[1][q]; x[0][q] = x1 * cc[q] - x2 * sn[q]; x[1][q] = x2 * cc[q] + x1 * sn[q]; } }
                    bf16* rowp = QKV + (size_t)row * QKVW + u.pn * 256 + 64 * wc + 8 * fq;
#pragma unroll
                    for (int bj = 0; bj < 2; ++bj) { u32x4 w; w.x = cvt_pk_bf16(x[bj][0], x[bj][1]); w.y = cvt_pk_bf16(x[bj][2], x[bj][3]); w.z = cvt_pk_bf16(x[bj][4], x[bj][5]); w.w = cvt_pk_bf16(x[bj][6], x[bj][7]);
                        *(u32x4*)(rowp + 32 * bj) = w; } }
            return;
        }
        const int row0 = u.pm * 256 + wr * 64 + fr;
        bf16* base; int ldc, colt; bool sg = false;
        if (u.kind) { base = MKV; ldc = 1024; colt = u.pn * 256; }
        else if (u.pn < 16) { base = QKV; ldc = QKVW; colt = u.pn * 256; }
        else { base = Gt; ldc = GW; colt = (u.pn - 16) * 256; sg = true; }
        const int col0 = colt + wc * 32 + 8 * fq;
#pragma unroll
        for (int ai = 0; ai < 2; ++ai)
#pragma unroll
            for (int m = 0; m < 4; ++m) { bf16* rowp = base + (size_t)(row0 + ai * 128 + m * 16) * ldc + col0;
#pragma unroll
                for (int bj = 0; bj < 2; ++bj) { pg8::f32x4 v0 = acc[ai][bj][m][0], v1 = acc[ai][bj][m][1];
                    if (sg) {
#pragma unroll
                        for (int q = 0; q < 4; ++q) { v0[q] = sigmoidf_(fmaxf(v0[q], -30.f)); v1[q] = sigmoidf_(fmaxf(v1[q], -30.f)); } }
                    u32x4 w; w.x = cvt_pk_bf16(v0[0], v0[1]); w.y = cvt_pk_bf16(v0[2], v0[3]); w.z = cvt_pk_bf16(v1[0], v1[1]); w.w = cvt_pk_bf16(v1[2], v1[3]);
                    *(u32x4*)(rowp + bj * 128) = w; } }
    }
};
#ifndef PROBE_GASM
#define PROBE_GASM true
#endif
struct EpiGates {
    static constexpr bool PERM = true, MID = false, FP8 = true, ASM_MFMA = PROBE_GASM; static constexpr int SCALE_A = 127 - H8_SHIFT, SCALE_B = 127 - W8_SHIFT;
    bf16* Gt;
    __device__ __forceinline__ void mid(pg8::f32x4 (&)[2][2][4][2], const Unit&, int, int, int, int, int) const {}
    __device__ __forceinline__ void operator()(const pg8::f32x4 (&acc)[2][2][4][2], const Unit& u, int wr, int wc, int fr, int fq) const {
        asm volatile("" : "+v"(fr), "+v"(fq));
        const int row0 = u.pm * 256 + wr * 64 + fr, col0 = u.pn * 256 + wc * 32 + 8 * fq;
#pragma unroll
        for (int ai = 0; ai < 2; ++ai)
#pragma unroll
            for (int m = 0; m < 4; ++m) { bf16* rowp = Gt + (size_t)(row0 + ai * 128 + m * 16) * GW + col0;
#pragma unroll
                for (int bj = 0; bj < 2; ++bj) { unsigned wv[4];
#pragma unroll
                    for (int n = 0; n < 2; ++n)
#pragma unroll
                        for (int hq = 0; hq < 2; ++hq) { typedef pg8::f32x2 f2;
                            f2 x = {fmaxf(acc[ai][bj][m][n][2 * hq], -30.f), fmaxf(acc[ai][bj][m][n][2 * hq + 1], -30.f)};
                            const f2 t = x * (-LOG2E); f2 e; e.x = __builtin_amdgcn_exp2f(t.x); e.y = __builtin_amdgcn_exp2f(t.y);
                            const f2 d = e + 1.0f; wv[2 * n + hq] = cvt_pk_bf16(__builtin_amdgcn_rcpf(d.x), __builtin_amdgcn_rcpf(d.y)); }
                    u32x4 w; w.x = wv[0]; w.y = wv[1]; w.z = wv[2]; w.w = wv[3];
                    *(u32x4*)(rowp + bj * 128) = w; } }
    }
};
struct EpiMerge {
    static constexpr bool PERM = true, MID = true, FP8 = false, ASM_MFMA = false; static constexpr int SCALE_A = 0x7f, SCALE_B = 0x7f;
    const bf16* Gt; bf16* O;
    __device__ __forceinline__ void mid(pg8::f32x4 (&acc)[2][2][4][2], const Unit& u, int which, int wr, int wc, int fr, int fq) const {
        asm volatile("" : "+v"(fr), "+v"(fq));
        const int row0 = u.pm * 256 + wr * 64 + fr, col0 = u.pn * 256 + wc * 32 + 8 * fq;
        const bf16* gn = Gt + (which ? 2048 : 0); const bf16* gd = Gt + (which ? 4096 : 2048);
#pragma unroll
        for (int ai = 0; ai < 2; ++ai)
#pragma unroll
            for (int m = 0; m < 4; ++m) { const size_t ro = (size_t)(row0 + ai * 128 + m * 16) * GW + col0;
#pragma unroll
                for (int bj = 0; bj < 2; ++bj) { const u32x4 a = *(const u32x4*)(gn + ro + bj * 128), b = *(const u32x4*)(gd + ro + bj * 128);
                    pg8::f32x4 r0, r1;
                    r0[0] = bf_lo(a.x) * __builtin_amdgcn_rcpf(bf_lo(b.x)); r0[1] = bf_hi(a.x) * __builtin_amdgcn_rcpf(bf_hi(b.x)); r0[2] = bf_lo(a.y) * __builtin_amdgcn_rcpf(bf_lo(b.y)); r0[3] = bf_hi(a.y) * __builtin_amdgcn_rcpf(bf_hi(b.y));
                    r1[0] = bf_lo(a.z) * __builtin_amdgcn_rcpf(bf_lo(b.z)); r1[1] = bf_hi(a.z) * __builtin_amdgcn_rcpf(bf_hi(b.z)); r1[2] = bf_lo(a.w) * __builtin_amdgcn_rcpf(bf_lo(b.w)); r1[3] = bf_hi(a.w) * __builtin_amdgcn_rcpf(bf_hi(b.w));
                    acc[ai][bj][m][0] *= r0; acc[ai][bj][m][1] *= r1; }
                asm volatile("" : "+v"(acc[ai][0][m][0]), "+v"(acc[ai][0][m][1]), "+v"(acc[ai][1][m][0]), "+v"(acc[ai][1][m][1]));
                asm volatile("" ::: "memory"); }
    }
    __device__ __forceinline__ void operator()(const pg8::f32x4 (&acc)[2][2][4][2], const Unit& u, int wr, int wc, int fr, int fq) const {
        asm volatile("" : "+v"(fr), "+v"(fq));
        const int row0 = u.pm * 256 + wr * 64 + fr, col0 = u.pn * 256 + wc * 32 + 8 * fq;
#pragma unroll
        for (int ai = 0; ai < 2; ++ai)
#pragma unroll
            for (int m = 0; m < 4; ++m) { const size_t rr = (size_t)(row0 + ai * 128 + m * 16);
#pragma unroll
                for (int bj = 0; bj < 2; ++bj) { const u32x4 g = *(const u32x4*)(Gt + rr * GW + 4096 + col0 + bj * 128);
                    const pg8::f32x4 v0 = acc[ai][bj][m][0], v1 = acc[ai][bj][m][1];
                    u32x4 w; w.x = cvt_pk_bf16(v0[0] * bf_lo(g.x), v0[1] * bf_hi(g.x)); w.y = cvt_pk_bf16(v0[2] * bf_lo(g.y), v0[3] * bf_hi(g.y));
                    w.z = cvt_pk_bf16(v1[0] * bf_lo(g.z), v1[1] * bf_hi(g.z)); w.w = cvt_pk_bf16(v1[2] * bf_lo(g.w), v1[3] * bf_hi(g.w));
                    *(u32x4*)(O + rr * DM + col0 + bj * 128) = w; }
                asm volatile("" ::: "memory"); }
    }
};
struct EpiOut {
    static constexpr bool PERM = true, MID = false, FP8 = false, ASM_MFMA = false; static constexpr int SCALE_A = 0x7f, SCALE_B = 0x7f;
    const float* X; float* out; unsigned char* HB8; int noop;
    __device__ __forceinline__ void mid(pg8::f32x4 (&)[2][2][4][2], const Unit&, int, int, int, int, int) const {}
    __device__ __forceinline__ void operator()(const pg8::f32x4 (&acc)[2][2][4][2], const Unit& u, int wr, int wc, int fr, int fq) const {
        asm volatile("" : "+v"(fr), "+v"(fq));
        if (noop) return;
        const int row0 = u.pm * 256 + wr * 64 + fr, col0 = u.pn * 256 + wc * 32 + 8 * fq;
#pragma unroll
        for (int ai = 0; ai < 2; ++ai)
#pragma unroll
            for (int mp = 0; mp < 2; ++mp) {
                pg8::f32x4 xv[2][2][2];
#pragma unroll
                for (int mm = 0; mm < 2; ++mm) { const size_t off = (size_t)(row0 + ai * 128 + (2 * mp + mm) * 16) * DM + col0;
#pragma unroll
                    for (int bj = 0; bj < 2; ++bj) { xv[mm][bj][0] = *(const pg8::f32x4*)(X + off + bj * 128); xv[mm][bj][1] = *(const pg8::f32x4*)(X + off + bj * 128 + 4); } }
#pragma unroll
                for (int mm = 0; mm < 2; ++mm) { const int m = 2 * mp + mm; const size_t off = (size_t)(row0 + ai * 128 + m * 16) * DM + col0;
#pragma unroll
                    for (int bj = 0; bj < 2; ++bj) { const pg8::f32x4 h0 = xv[mm][bj][0] + acc[ai][bj][m][0], h1 = xv[mm][bj][1] + acc[ai][bj][m][1];
                        *(pg8::f32x4*)(out + off + bj * 128) = h0; *(pg8::f32x4*)(out + off + bj * 128 + 4) = h1;
                        u32x2 w; w.x = pk4_fp8(h0[0] * H8_MUL, h0[1] * H8_MUL, h0[2] * H8_MUL, h0[3] * H8_MUL); w.y = pk4_fp8(h1[0] * H8_MUL, h1[1] * H8_MUL, h1[2] * H8_MUL, h1[3] * H8_MUL);
                        *(u32x2*)(HB8 + off + bj * 128) = w; } }
                asm volatile("" ::: "memory");
            }
    }
};
struct EpiGateUp {
    static constexpr bool PERM = true, MID = false, FP8 = true, ASM_MFMA = true; static constexpr int SCALE_A = 127 - H8_SHIFT, SCALE_B = 127 - W8_SHIFT;
    const float* RS; const float* bgu; unsigned char* ACT8;
    __device__ __forceinline__ void mid(pg8::f32x4 (&)[2][2][4][2], const Unit&, int, int, int, int, int) const {}
    __device__ __forceinline__ void operator()(const pg8::f32x4 (&acc)[2][2][4][2], const Unit& u, int wr, int wc, int fr, int fq) const {
        asm volatile("" : "+v"(fr), "+v"(fq));
        const int r0 = wr * 64 + fr, hc0 = u.pn * 128 + wc * 32 + 8 * fq;
        const float* bg = bgu + (size_t)u.e * 4096 + hc0;
        const pg8::f32x4 bg0 = *(const pg8::f32x4*)(bg), bg1 = *(const pg8::f32x4*)(bg + 4), bu0 = *(const pg8::f32x4*)(bg + 2048), bu1 = *(const pg8::f32x4*)(bg + 2052);
        float rsv[2][4];
#pragma unroll
        for (int ai = 0; ai < 2; ++ai)
#pragma unroll
            for (int m = 0; m < 4; ++m) rsv[ai][m] = RS[u.e * CAP + 256 * u.pm + r0 + ai * 128 + m * 16];
#pragma unroll
        for (int ai = 0; ai < 2; ++ai)
#pragma unroll
            for (int m = 0; m < 4; ++m) { const int rl = r0 + ai * 128 + m * 16;
                const float rs = rsv[ai][m];
                typedef pg8::f32x2 f2;
                f2 a2[4];
#pragma unroll
                for (int n = 0; n < 2; ++n)
#pragma unroll
                    for (int hq = 0; hq < 2; ++hq) {
                        const f2 ag = {acc[ai][0][m][n][2 * hq], acc[ai][0][m][n][2 * hq + 1]}, au = {acc[ai][1][m][n][2 * hq], acc[ai][1][m][n][2 * hq + 1]};
                        const f2 bgv = n ? (f2){bg1[2 * hq], bg1[2 * hq + 1]} : (f2){bg0[2 * hq], bg0[2 * hq + 1]}, buv = n ? (f2){bu1[2 * hq], bu1[2 * hq + 1]} : (f2){bu0[2 * hq], bu0[2 * hq + 1]};
                        f2 g = ag * rs + bgv, up = au * rs + buv;
                        g.x = fminf(g.x, SWIGLU_LIMIT); g.y = fminf(g.y, SWIGLU_LIMIT);
                        up.x = __builtin_amdgcn_fmed3f(up.x, -SWIGLU_LIMIT, SWIGLU_LIMIT); up.y = __builtin_amdgcn_fmed3f(up.y, -SWIGLU_LIMIT, SWIGLU_LIMIT);
                        const f2 t = g * (-SWIGLU_ALPHA * LOG2E);
                        f2 e; e.x = __builtin_amdgcn_exp2f(t.x); e.y = __builtin_amdgcn_exp2f(t.y);
                        const f2 d = e + 1.0f;
                        f2 r; r.x = __builtin_amdgcn_rcpf(d.x); r.y = __builtin_amdgcn_rcpf(d.y);
                        const f2 sg = (g * ACT8_MUL) * r;
                        a2[2 * n + hq] = up * sg + sg;
                    }
                u32x2 w;
                { int p0 = __builtin_amdgcn_cvt_pk_fp8_f32(a2[0].x, a2[0].y, 0, false); p0 = __builtin_amdgcn_cvt_pk_fp8_f32(a2[1].x, a2[1].y, p0, true); w.x = (unsigned)p0;
                  int p1 = __builtin_amdgcn_cvt_pk_fp8_f32(a2[2].x, a2[2].y, 0, false); p1 = __builtin_amdgcn_cvt_pk_fp8_f32(a2[3].x, a2[3].y, p1, true); w.y = (unsigned)p1; }
                *(u32x2*)(ACT8 + (size_t)(u.kind + rl) * DM + hc0) = w; }
    }
};
struct EpiDown {
    static constexpr bool PERM = true, MID = false, FP8 = true, ASM_MFMA = true; static constexpr int SCALE_A = 127 - ACT8_SHIFT, SCALE_B = 127 - W8_SHIFT;
    const float* bd; bf16* Y;
    __device__ __forceinline__ void mid(pg8::f32x4 (&)[2][2][4][2], const Unit&, int, int, int, int, int) const {}
    __device__ __forceinline__ void operator()(const pg8::f32x4 (&acc)[2][2][4][2], const Unit& u, int wr, int wc, int fr, int fq) const {
        asm volatile("" : "+v"(fr), "+v"(fq));
        const int r0 = wr * 64 + fr, col0 = u.pn * 256 + wc * 32 + 8 * fq;
        const float* bb = bd + (size_t)u.e * DM + col0;
        pg8::f32x4 bv[2][2];
#pragma unroll
        for (int bj = 0; bj < 2; ++bj)
#pragma unroll
            for (int n = 0; n < 2; ++n) bv[bj][n] = *(const pg8::f32x4*)(bb + bj * 128 + n * 4);
#pragma unroll
        for (int ai = 0; ai < 2; ++ai)
#pragma unroll
            for (int m = 0; m < 4; ++m) { bf16* rowp = Y + (size_t)(u.kind + r0 + ai * 128 + m * 16) * DM + col0;
#pragma unroll
                for (int bj = 0; bj < 2; ++bj) { const pg8::f32x4 v0 = acc[ai][bj][m][0] + bv[bj][0], v1 = acc[ai][bj][m][1] + bv[bj][1];
                    u32x4 w; w.x = cvt_pk_bf16(v0[0], v0[1]); w.y = cvt_pk_bf16(v0[2], v0[3]); w.z = cvt_pk_bf16(v1[0], v1[1]); w.w = cvt_pk_bf16(v1[2], v1[3]);
                    *(u32x4*)(rowp + bj * 128) = w; } }
    }
};

__device__ __forceinline__ void logf_cumsum(const Ctx& C) {
    LAS float* wt = (LAS float*)(C.lds + RING_OFF);
    for (int sq = (int)blockIdx.x; sq < BATCH * 12; sq += C.G) {
        const float* src = C.LOGF + (size_t)sq * SEQ + C.tid * 16; float* dst = C.CNEG + (size_t)sq * SEQ + C.tid * 16;
        f32x4 a[4]; float tot = 0.f;
#pragma unroll
        for (int j = 0; j < 4; ++j) { a[j] = *(const GAS f32x4*)(src + 4 * j); tot += (a[j].x + a[j].y) + (a[j].z + a[j].w); }
        float incl = tot;
#pragma unroll
        for (int o = 1; o < 64; o <<= 1) { const float n = __shfl_up(incl, o); if (C.lane >= o) incl += n; }
        if (C.lane == 63) wt[C.wave] = incl;
        __syncthreads();
        float run = incl - tot;
        for (int w = 0; w < C.wave; ++w) run += wt[w];
#pragma unroll
        for (int j = 0; j < 4; ++j) { f32x4 c; run += a[j].x; c.x = -run * LOG2E; run += a[j].y; c.y = -run * LOG2E; run += a[j].z; c.z = -run * LOG2E; run += a[j].w; c.w = -run * LOG2E; *(GAS f32x4*)(dst + 4 * j) = c; }
        __syncthreads();
    }
}

namespace att {
typedef __attribute__((address_space(3))) const char* lds_cptr;
__device__ __forceinline__ void glds16(const void* gsrc, unsigned lds_dst) { unsigned keep;
    asm volatile("s_mov_b32 %0, m0\n\ts_mov_b32 m0, %2\n\ts_nop 0\n\tglobal_load_lds_dwordx4 %1, off\n\ts_mov_b32 m0, %0" : "=&s"(keep) : "v"(gsrc), "s"(lds_dst) : "memory"); }
typedef float f32x2_t __attribute__((ext_vector_type(2))); typedef __bf16 bf16x2_t __attribute__((ext_vector_type(2)));
__device__ __forceinline__ unsigned cvtpk_s(float lo, float hi) { f32x2_t v = {lo, hi}; bf16x2_t b = __builtin_convertvector(v, bf16x2_t); return __builtin_bit_cast(unsigned, b); }
__device__ __forceinline__ int crow(int r, int hi) { return (r & 3) + 8 * (r >> 2) + 4 * hi; }

template <int D> struct Geo {
    static constexpr int SLOTB = 64 * D * 2, NSLOT = (D == 64) ? 3 : 2, PPT = (D == 64) ? 2 : 4;
    static constexpr int LDS_K = 0, LDS_V = NSLOT * SLOTB, LDS_WS = 2 * NSLOT * SLOTB, LDS_WMIN = LDS_WS + 2048, LDS_OST = LDS_WMIN + 64, LDS_CB = LDS_OST + 8 * 4096, LDS_END = LDS_CB + 32768;
};

template <int D>
__device__ __forceinline__ void qkt(f32x16& p0, f32x16& p1, lds_cptr Kslot, const bf16x8* qr, int r32, int hi) {
    lds_cptr kb = Kslot + hi * 1024 + r32 * 16;
    p0 = f32x16{}; p1 = f32x16{};
#pragma unroll
    for (int d0 = 0; d0 < D / 16; ++d0) {
        const bf16x8 b0 = *(const LAS bf16x8*)(kb + d0 * 2048);
        const bf16x8 b1 = *(const LAS bf16x8*)(kb + d0 * 2048 + 512);
        p0 = __builtin_amdgcn_mfma_f32_32x32x16_bf16(b0, qr[d0], p0, 0, 0, 0); p1 = __builtin_amdgcn_mfma_f32_32x32x16_bf16(b1, qr[d0], p1, 0, 0, 0); }
}
template <int D>
__device__ __forceinline__ void pv(f32x16* o, int vb, bf16x8 pa0, bf16x8 pa1, bf16x8 pa2, bf16x8 pa3) {
#pragma unroll
    for (int d0 = 0; d0 < D / 32; ++d0) { s16x4 lo[4], hi[4];
#pragma unroll
        for (int ks = 0; ks < 4; ++ks) {
            asm volatile("ds_read_b64_tr_b16 %0,%1 offset:%c2" : "=&v"(lo[ks]) : "v"(vb), "i"(d0 * 4096 + ks * 1024) : "memory");
            asm volatile("ds_read_b64_tr_b16 %0,%1 offset:%c2" : "=&v"(hi[ks]) : "v"(vb), "i"(d0 * 4096 + ks * 1024 + 512) : "memory"); }
        asm volatile("s_waitcnt lgkmcnt(0)" ::: "memory"); __builtin_amdgcn_sched_barrier(0);
#define ATT_PK(k) (bf16x8){lo[k][0], lo[k][1], lo[k][2], lo[k][3], hi[k][0], hi[k][1], hi[k][2], hi[k][3]}
        o[d0] = __builtin_amdgcn_mfma_f32_32x32x16_bf16(pa0, ATT_PK(0), o[d0], 0, 0, 0);
        o[d0] = __builtin_amdgcn_mfma_f32_32x32x16_bf16(pa1, ATT_PK(1), o[d0], 0, 0, 0);
        o[d0] = __builtin_amdgcn_mfma_f32_32x32x16_bf16(pa2, ATT_PK(2), o[d0], 0, 0, 0);
        o[d0] = __builtin_amdgcn_mfma_f32_32x32x16_bf16(pa3, ATT_PK(3), o[d0], 0, 0, 0);
#undef ATT_PK
    }
}

template <int D, int MODE>
__device__ __forceinline__ void attn_unit(LAS unsigned char* shm, const bf16* Q, int pitchQ, const bf16* K, const bf16* V, int pitchKV, bf16* O, const float* cneg, float sink2, int qb, const float* qgain, const float* kgain, const float* ropet, float bqk = 0.f) {
    typedef Geo<D> G;
    int tid = threadIdx.x; asm volatile("" : "+v"(tid));
    const int lane = tid & 63, r32 = lane & 31, hi = lane >> 5; const int wid = __builtin_amdgcn_readfirstlane(tid >> 6);
    const int q0 = qb * 256, q0w = q0 + wid * 32;
    const unsigned lds0 = (unsigned)(uintptr_t)shm;
    LAS float* wsf = (LAS float*)(shm + G::LDS_WS) + wid * 64;
    LAS float* cb = (LAS float*)(shm + G::LDS_CB);
    const int j_lo = (MODE == 1) ? (qb > 0 ? 4 * qb - 2 : 0) : 0, j_hi = (MODE == 2) ? 4 : 4 * qb + 4;
    bf16x8 qr[D / 16];
    { const bf16* Qw = Q + (size_t)(q0w + r32) * pitchQ + hi * 8;
#pragma unroll
      for (int d0 = 0; d0 < D / 16; ++d0) qr[d0] = *(const GAS bf16x8*)(Qw + d0 * 16); }
    {
#define ATT_UNPK(dst, src) do { const v4u w_ = __builtin_bit_cast(v4u, src); dst[0] = pg8::bf_lo(w_.x); dst[1] = pg8::bf_hi(w_.x); dst[2] = pg8::bf_lo(w_.y); dst[3] = pg8::bf_hi(w_.y); dst[4] = pg8::bf_lo(w_.z); dst[5] = pg8::bf_hi(w_.z); dst[6] = pg8::bf_lo(w_.w); dst[7] = pg8::bf_hi(w_.w); } while (0)
#define ATT_PK8(dst, src) do { v4u w_; w_.x = cvtpk_s(src[0], src[1]); w_.y = cvtpk_s(src[2], src[3]); w_.z = cvtpk_s(src[4], src[5]); w_.w = cvtpk_s(src[6], src[7]); dst = __builtin_bit_cast(bf16x8, w_); } while (0)
        float ss = 0.f;
#pragma unroll
        for (int d0 = 0; d0 < D / 16; ++d0) { float t[8]; ATT_UNPK(t, qr[d0]);
#pragma unroll
            for (int j = 0; j < 8; ++j) ss += t[j] * t[j]; }
        { auto rr = __builtin_amdgcn_permlane32_swap(__float_as_uint(ss), __float_as_uint(ss), false, false); ss = __uint_as_float(rr[0]) + __uint_as_float(rr[1]); }
        const float rq = (1.0f / sqrtf(ss * (1.f / D) + NORM_EPS)) * ((D == 64 ? 0.125f : 0.08838834764831845f) * LOG2E);
        if constexpr (MODE == 1) {
            const float* cs = ropet + (size_t)(q0w + r32) * 64 + 8 * hi;
#pragma unroll
            for (int d0 = 0; d0 < 2; ++d0) { float x1[8], x2[8]; ATT_UNPK(x1, qr[d0]); ATT_UNPK(x2, qr[d0 + 2]);
                const float* g1 = qgain + 16 * d0 + 8 * hi;
                const f32x4 ga = *(const GAS f32x4*)g1, gb = *(const GAS f32x4*)(g1 + 4), gc = *(const GAS f32x4*)(g1 + 32), gd = *(const GAS f32x4*)(g1 + 36);
                const f32x4 c0 = *(const GAS f32x4*)(cs + 16 * d0), c1 = *(const GAS f32x4*)(cs + 16 * d0 + 4), s0 = *(const GAS f32x4*)(cs + 32 + 16 * d0), s1 = *(const GAS f32x4*)(cs + 36 + 16 * d0);
                const float gg1[8] = {ga.x, ga.y, ga.z, ga.w, gb.x, gb.y, gb.z, gb.w}, gg2[8] = {gc.x, gc.y, gc.z, gc.w, gd.x, gd.y, gd.z, gd.w};
                const float cc[8] = {c0.x, c0.y, c0.z, c0.w, c1.x, c1.y, c1.z, c1.w}, sn[8] = {s0.x, s0.y, s0.z, s0.w, s1.x, s1.y, s1.z, s1.w};
#pragma unroll
                for (int j = 0; j < 8; ++j) { const float a = (x1[j] * rq) * gg1[j], b = (x2[j] * rq) * gg2[j]; x1[j] = a * cc[j] - b * sn[j]; x2[j] = b * cc[j] + a * sn[j]; }
                ATT_PK8(qr[d0], x1); ATT_PK8(qr[d0 + 2], x2); asm volatile("" ::: "memory"); }
        } else {
#pragma unroll
            for (int d0 = 0; d0 < D / 16; ++d0) { float t[8]; ATT_UNPK(t, qr[d0]);
                const float* gp = qgain + 16 * d0 + 8 * hi; f32x4 ga = *(const GAS f32x4*)gp, gb = *(const GAS f32x4*)(gp + 4);
                if constexpr (MODE == 2) { ga = ga * *(const GAS f32x4*)(kgain + 16 * d0 + 8 * hi); gb = gb * *(const GAS f32x4*)(kgain + 16 * d0 + 8 * hi + 4); }
                t[0] = (t[0] * rq) * ga.x; t[1] = (t[1] * rq) * ga.y; t[2] = (t[2] * rq) * ga.z; t[3] = (t[3] * rq) * ga.w; t[4] = (t[4] * rq) * gb.x; t[5] = (t[5] * rq) * gb.y; t[6] = (t[6] * rq) * gb.z; t[7] = (t[7] * rq) * gb.w;
                ATT_PK8(qr[d0], t); asm volatile("" ::: "memory"); }
        }
#undef ATT_UNPK
#undef ATT_PK8
    }
    if constexpr (MODE == 2) {
        const int key = tid >> 1, hf = tid & 1; const bf16* kp = K + (size_t)key * pitchKV + 64 * hf; float ss = 0.f;
#pragma unroll
        for (int c = 0; c < 8; ++c) { const v4u w = *(const GAS v4u*)(kp + 8 * c); const float a0 = pg8::bf_lo(w.x), a1 = pg8::bf_hi(w.x), a2 = pg8::bf_lo(w.y), a3 = pg8::bf_hi(w.y), a4 = pg8::bf_lo(w.z), a5 = pg8::bf_hi(w.z), a6 = pg8::bf_lo(w.w), a7 = pg8::bf_hi(w.w);
            ss += (a0 * a0 + a1 * a1) + (a2 * a2 + a3 * a3) + (a4 * a4 + a5 * a5) + (a6 * a6 + a7 * a7); }
        ss += __shfl_xor(ss, 1);
        if (hf == 0) cb[key] = 1.0f / sqrtf(ss * (1.f / 128.f) + NORM_EPS);
    }
    if constexpr (MODE == 0) {
        const int nch = (q0 + 256) / 4;
        for (int c = tid; c < nch; c += 512) { const f32x4 v = *(const GAS f32x4*)(cneg + 4 * c); *(LAS f32x4*)(cb + 4 * c) = v; }
    }
#define ATT_DMA(j, slot) do { const int _s = (slot) * G::SLOTB; \
        if constexpr (D == 64) { \
            glds16(K + (size_t)(64 * (j) + lane) * pitchKV + wid * 8, (unsigned)__builtin_amdgcn_readfirstlane(lds0 + G::LDS_K + _s + wid * 1024)); \
            glds16(V + (size_t)(64 * (j) + 16 * (wid & 3) + (lane >> 2)) * pitchKV + (wid >> 2) * 32 + (lane & 3) * 8, (unsigned)__builtin_amdgcn_readfirstlane(lds0 + G::LDS_V + _s + wid * 1024)); \
        } else { \
            _Pragma("unroll") for (int _p = 0; _p < 2; ++_p) { const int _c = wid + 8 * _p; \
                glds16(K + (size_t)(64 * (j) + lane) * pitchKV + _c * 8, (unsigned)__builtin_amdgcn_readfirstlane(lds0 + G::LDS_K + _s + _c * 1024)); } \
            _Pragma("unroll") for (int _p = 0; _p < 2; ++_p) { const int _c = wid + 8 * _p; \
                glds16(V + (size_t)(64 * (j) + 16 * (_c & 3) + (lane >> 2)) * pitchKV + (_c >> 2) * 32 + (lane & 3) * 8, (unsigned)__builtin_amdgcn_readfirstlane(lds0 + G::LDS_V + _s + _c * 1024)); } \
        } } while (0)
    int slot_i = 0;
    constexpr bool REV = (MODE == 0);
    const int nst = j_hi - j_lo;
#define ATT_TILE(st_) (REV ? (j_hi - 1 - (st_)) : (j_lo + (st_)))
#pragma unroll
    for (int p = 0; p < G::NSLOT - 1; ++p) if (p < nst) ATT_DMA(ATT_TILE(p), p);
    float mhat = -1e30f, l_reg = 0.f; f32x16 o[D / 32];
#pragma unroll
    for (int d0 = 0; d0 < D / 32; ++d0) o[d0] = f32x16{};
    const lds_cptr shm3 = (lds_cptr)shm;
    const int vb0 = (int)(lds0 + G::LDS_V) + ((lane >> 4) & 1) * 32 + (lane & 3) * 8 + (4 * hi + ((lane & 15) >> 2)) * 64;
    const int qabs = q0w + r32;
    LAS float* wmin = (LAS float*)(shm + G::LDS_WMIN);
    for (int st = 0; st < nst; ++st) {
        const int j = ATT_TILE(st);
        if (G::NSLOT == 3 && st + 1 < nst) { if constexpr (G::PPT == 2) asm volatile("s_waitcnt vmcnt(2) lgkmcnt(0)\n\ts_barrier" ::: "memory"); else asm volatile("s_waitcnt vmcnt(4) lgkmcnt(0)\n\ts_barrier" ::: "memory"); }
        else asm volatile("s_waitcnt vmcnt(0) lgkmcnt(0)\n\ts_barrier" ::: "memory");
        if constexpr (MODE == 0) { if (st >= 5) {
            const LAS float* wm = wmin + ((st - 1) & 1) * 8; const f32x4 a = *(const LAS f32x4*)wm, b = *(const LAS f32x4*)(wm + 4);
            const float gmin = fminf(fminf(fminf(a.x, a.y), fminf(a.z, a.w)), fminf(fminf(b.x, b.y), fminf(b.z, b.w)));
            if (cb[64 * j + 63] + bqk < gmin - 40.0f) break; } }
        { const int sn_ = st + G::NSLOT - 1; if (sn_ < nst) { int sn = slot_i + G::NSLOT - 1; if (sn >= G::NSLOT) sn -= G::NSLOT; ATT_DMA(ATT_TILE(sn_), sn); } }
        bool need = true;
        if constexpr (MODE == 0) need = (64 * j <= q0w + 31);
        if constexpr (MODE == 1) need = (64 * j <= q0w + 31) && (64 * j + 63 >= q0w - 127);
        if (need) {
            f32x16 p0, p1;
            qkt<D>(p0, p1, shm3 + G::LDS_K + slot_i * G::SLOTB, qr, r32, hi);
            if constexpr (MODE == 2) {
                const LAS float* rkp = cb + 64 * j + 4 * hi;
#pragma unroll
                for (int g = 0; g < 4; ++g) { const f32x4 b0 = *(const LAS f32x4*)(rkp + 8 * g), b1 = *(const LAS f32x4*)(rkp + 32 + 8 * g);
#pragma unroll
                    for (int e = 0; e < 4; ++e) { p0[4 * g + e] *= b0[e]; p1[4 * g + e] *= b1[e]; } }
            }
            if constexpr (MODE == 0) {
                const LAS float* cbp = cb + 64 * j + 4 * hi;
#pragma unroll
                for (int g = 0; g < 4; ++g) { const f32x4 b0 = *(const LAS f32x4*)(cbp + 8 * g), b1 = *(const LAS f32x4*)(cbp + 32 + 8 * g);
#pragma unroll
                    for (int e = 0; e < 4; ++e) { p0[4 * g + e] += b0[e]; p1[4 * g + e] += b1[e]; } }
                if (64 * j + 63 > q0w) {
#pragma unroll
                    for (int r = 0; r < 16; ++r) { const int kv = 64 * j + crow(r, hi); if (kv > qabs) p0[r] = -INFINITY; if (kv + 32 > qabs) p1[r] = -INFINITY; } }
            }
            if constexpr (MODE == 1) {
#pragma unroll
                for (int r = 0; r < 16; ++r) { const int kv = 64 * j + crow(r, hi); const int d0_ = qabs - kv, d1_ = d0_ - 32;
                    if (d0_ < 0 || d0_ >= 128) p0[r] = -INFINITY; if (d1_ < 0 || d1_ >= 128) p1[r] = -INFINITY; }
            }
            float rm = fmaxf(p0[0], p1[0]);
#pragma unroll
            for (int r = 1; r < 16; ++r) rm = fmaxf(rm, fmaxf(p0[r], p1[r]));
            { auto rr = __builtin_amdgcn_permlane32_swap(__float_as_uint(rm), __float_as_uint(rm), false, false); rm = fmaxf(__uint_as_float(rr[0]), __uint_as_float(rr[1])); }
            if (__any(rm > mhat)) {
                const float mn = fmaxf(mhat, rm); const float f = __builtin_amdgcn_exp2f(mhat - mn); mhat = mn; l_reg *= f;
                if (hi == 0) wsf[r32] = f;
                asm volatile("s_waitcnt lgkmcnt(0)" ::: "memory");
#pragma unroll
                for (int g = 0; g < 4; ++g) { const f32x4 fv = *(const LAS f32x4*)(wsf + 8 * g + 4 * hi);
#pragma unroll
                    for (int d_ = 0; d_ < D / 32; ++d_)
#pragma unroll
                        for (int e = 0; e < 4; ++e) o[d_][4 * g + e] *= fv[e]; }
            }
            float sacc = 0.f;
#pragma unroll
            for (int r = 0; r < 16; ++r) { p0[r] = __builtin_amdgcn_exp2f(p0[r] - mhat); p1[r] = __builtin_amdgcn_exp2f(p1[r] - mhat); sacc += p0[r] + p1[r]; }
            l_reg += sacc;
            u32x4 pw0, pw1, pw2, pw3;
            pw0 = (u32x4){cvtpk_s(p0[0], p0[1]), cvtpk_s(p0[2], p0[3]), cvtpk_s(p0[4], p0[5]), cvtpk_s(p0[6], p0[7])};
            pw1 = (u32x4){cvtpk_s(p0[8], p0[9]), cvtpk_s(p0[10], p0[11]), cvtpk_s(p0[12], p0[13]), cvtpk_s(p0[14], p0[15])};
            pw2 = (u32x4){cvtpk_s(p1[0], p1[1]), cvtpk_s(p1[2], p1[3]), cvtpk_s(p1[4], p1[5]), cvtpk_s(p1[6], p1[7])};
            pw3 = (u32x4){cvtpk_s(p1[8], p1[9]), cvtpk_s(p1[10], p1[11]), cvtpk_s(p1[12], p1[13]), cvtpk_s(p1[14], p1[15])};
            pv<D>(o, vb0 + slot_i * G::SLOTB, __builtin_bit_cast(bf16x8, pw0), __builtin_bit_cast(bf16x8, pw1), __builtin_bit_cast(bf16x8, pw2), __builtin_bit_cast(bf16x8, pw3));
        }
        if constexpr (MODE == 0) { float mn = mhat;
#pragma unroll
            for (int of = 1; of < 32; of <<= 1) mn = fminf(mn, __shfl_xor(mn, of));
            if (lane == 0) wmin[(st & 1) * 8 + wid] = mn; }
        ++slot_i; if (slot_i == G::NSLOT) slot_i = 0;
    }
#undef ATT_DMA
#undef ATT_TILE
    if constexpr (MODE == 0) asm volatile("s_waitcnt vmcnt(0)" ::: "memory");
    { auto rr = __builtin_amdgcn_permlane32_swap(__float_as_uint(l_reg), __float_as_uint(l_reg), false, false); l_reg = __uint_as_float(rr[0]) + __uint_as_float(rr[1]); }
    if constexpr (MODE == 1) l_reg += __builtin_amdgcn_exp2f(sink2 - mhat);
    if (hi == 0) wsf[32 + r32] = l_reg;
    asm volatile("s_waitcnt lgkmcnt(0)" ::: "memory");
    float rli[16];
#pragma unroll
    for (int g = 0; g < 4; ++g) { const f32x4 lv = *(const LAS f32x4*)(wsf + 32 + 8 * g + 4 * hi);
#pragma unroll
        for (int e = 0; e < 4; ++e) rli[4 * g + e] = __builtin_amdgcn_rcpf(lv[e]); }
    bf16* Ow = O + (size_t)q0w * 2048;
    LAS bf16* stg = (LAS bf16*)(shm + G::LDS_OST) + wid * 2048;
#pragma unroll
    for (int ps = 0; ps < D / 64; ++ps) {
#pragma unroll
        for (int r = 0; r < 16; ++r) { const int orow = crow(r, hi);
#pragma unroll
            for (int dl = 0; dl < 2; ++dl) stg[orow * 64 + dl * 32 + r32] = (bf16)f2bf(o[2 * ps + dl][r] * rli[r]); }
        asm volatile("s_waitcnt lgkmcnt(0)" ::: "memory");
#pragma unroll
        for (int i = 0; i < 4; ++i) { const int row = i * 8 + (lane >> 3), ch = lane & 7; const v4u v = *(const LAS v4u*)(stg + row * 64 + ch * 8); *(GAS v4u*)(Ow + (size_t)row * 2048 + ps * 64 + ch * 8) = v; }
        asm volatile("s_waitcnt lgkmcnt(0)" ::: "memory");
    }
    asm volatile("s_waitcnt lgkmcnt(0)\n\ts_barrier" ::: "memory");
}
}

constexpr int NU_FOX = BATCH * 12 * 32, NU_SWA = BATCH * 12 * 32, NU_XM = BATCH * 4 * 32;
__device__ __forceinline__ int att_fetch(const Ctx& C, int q) {
    int v = 0; if (C.tid == 0) v = (int)__hip_atomic_fetch_add((unsigned*)(C.ctl + CW_QHEAD + 64 * q), 1u, RLX_AGENT); return v;
}
__device__ __forceinline__ void phase3(const Ctx& C, int sel = 0) {
    LAS unsigned char* shm = C.lds + RING_OFF;
    volatile LAS int* nxtw = (volatile LAS int*)(C.MISC + 12);
    if (sel == 0 || sel == 4) {
        float gq = fabsf(C.fox_q_norm[C.lane]), gk = fabsf(C.fox_k_norm[C.lane]);
#pragma unroll
        for (int of = 1; of < 64; of <<= 1) { gq = fmaxf(gq, __shfl_xor(gq, of)); gk = fmaxf(gk, __shfl_xor(gk, of)); }
        const float bqk = 64.0f * gq * gk * (0.125f * LOG2E) * 1.02f;
        int pre = att_fetch(C, 0);
        if (C.tid == 0) *nxtw = pre;
        __syncthreads();
        int cur = __builtin_amdgcn_readfirstlane(*nxtw);
        __syncthreads();
        while (cur < NU_FOX) {
            pre = att_fetch(C, 0);
            const int qb = 31 - cur / 24, bh = cur % 24, b = bh / 12, h = bh % 12;
            const bf16* base = C.QKV + (size_t)b * SEQ * QKVW + h * 64;
            att::attn_unit<64, 0>(shm, base + C_FQ, QKVW, base + C_FK, base + C_FV, QKVW, C.OALL + (size_t)b * SEQ * 2048 + h * 64, C.CNEG + (size_t)(b * 12 + h) * SEQ, 0.f, qb, C.fox_q_norm, nullptr, nullptr, bqk);
            if (C.tid == 0) *nxtw = pre;
            __syncthreads();
            cur = __builtin_amdgcn_readfirstlane(*nxtw);
            __syncthreads();
        }
    }
    if (sel == 0 || sel == 5) {
        int pre = att_fetch(C, 1);
        if (C.tid == 0) *nxtw = pre;
        __syncthreads();
        int cur = __builtin_amdgcn_readfirstlane(*nxtw);
        __syncthreads();
        while (cur < NU_SWA) {
            pre = att_fetch(C, 1);
            const int qb = cur / 24, bh = cur % 24, b = bh / 12, h = bh % 12, kvh = h / 3;
            const bf16* base = C.QKV + (size_t)b * SEQ * QKVW;
            att::attn_unit<64, 1>(shm, base + C_SQ + h * 64, QKVW, base + C_SK + kvh * 64, base + C_SV + kvh * 64, QKVW, C.OALL + (size_t)b * SEQ * 2048 + 768 + h * 64, nullptr, C.swa_sinks[h] * LOG2E, qb, C.swa_q_norm, nullptr, C.ROPE + (size_t)b * SEQ * 64);
            if (C.tid == 0) *nxtw = pre;
            __syncthreads();
            cur = __builtin_amdgcn_readfirstlane(*nxtw);
            __syncthreads();
        }
    }
    if (sel == 0 || sel == 6) {
        int pre = att_fetch(C, 2);
        if (C.tid == 0) *nxtw = pre;
        __syncthreads();
        int cur = __builtin_amdgcn_readfirstlane(*nxtw);
        __syncthreads();
        while (cur < NU_XM) {
            pre = att_fetch(C, 2);
            const int qb = cur / 8, bh = cur % 8, b = bh / 4, h = bh % 4;
            const bf16* kb = C.MKV + (size_t)b * NMEM * 1024 + h * 128;
            att::attn_unit<128, 2>(shm, C.QKV + (size_t)b * SEQ * QKVW + C_MQ + h * 128, QKVW, kb, kb + 512, 1024, C.OALL + (size_t)b * SEQ * 2048 + 1536 + h * 128, nullptr, 0.f, qb, C.xmem_q_norm, C.xmem_k_norm, nullptr);
            if (C.tid == 0) *nxtw = pre;
            __syncthreads();
            cur = __builtin_amdgcn_readfirstlane(*nxtw);
            __syncthreads();
        }
    }
}

__device__ __forceinline__ void phase6(const Ctx& C) {
    LAS float* PL = (LAS float*)(C.lds + RING_OFF);
    LAS float* SS = PL + 4 * 64 * 33;
    LAS int* hist = (LAS int*)(SS + 512);
    LAS int* gb = hist + 32;
    const int rg = C.wave & 1, kq = C.wave >> 1, r32 = C.lane & 31, hi = C.lane >> 5;
    const bf16* wh = C.Wr_t + (size_t)r32 * 2048 + 512 * kq + 16 * hi; const bf16* wl = wh + 32 * 2048;
    for (int blk = C.vcu; blk < T / 64; blk += C.G) {
        if (C.tid < 32) hist[C.tid] = 0;
        const int tok = blk * 64 + 32 * rg + r32;
        const float* hr = C.out + (size_t)tok * DM + 512 * kq + 16 * hi;
        f32x16 acc = f32x16{}; float ss = 0.f;
#pragma unroll 2
        for (int kb = 0; kb < 16; ++kb) {
            float f[16];
#pragma unroll
            for (int q = 0; q < 4; ++q) { const f32x4 t = *(const GAS f32x4*)(hr + 32 * kb + 4 * q); f[4 * q] = t.x; f[4 * q + 1] = t.y; f[4 * q + 2] = t.z; f[4 * q + 3] = t.w; }
            unsigned hb[16], lb[16];
#pragma unroll
            for (int q = 0; q < 16; ++q) { ss += f[q] * f[q]; hb[q] = f2bf(f[q]); lb[q] = f2bf(f[q] - __uint_as_float(hb[q] << 16)); }
#pragma unroll
            for (int s = 0; s < 2; ++s) {
                const bf16x8 ah = *(const GAS bf16x8*)(wh + 32 * kb + 8 * s), al = *(const GAS bf16x8*)(wl + 32 * kb + 8 * s);
                v4u bh, bl;
                bh.x = hb[8 * s] | (hb[8 * s + 1] << 16); bh.y = hb[8 * s + 2] | (hb[8 * s + 3] << 16); bh.z = hb[8 * s + 4] | (hb[8 * s + 5] << 16); bh.w = hb[8 * s + 6] | (hb[8 * s + 7] << 16);
                bl.x = lb[8 * s] | (lb[8 * s + 1] << 16); bl.y = lb[8 * s + 2] | (lb[8 * s + 3] << 16); bl.z = lb[8 * s + 4] | (lb[8 * s + 5] << 16); bl.w = lb[8 * s + 6] | (lb[8 * s + 7] << 16);
                acc = __builtin_amdgcn_mfma_f32_32x32x16_bf16(ah, __builtin_bit_cast(bf16x8, bh), acc, 0, 0, 0);
                acc = __builtin_amdgcn_mfma_f32_32x32x16_bf16(ah, __builtin_bit_cast(bf16x8, bl), acc, 0, 0, 0);
                acc = __builtin_amdgcn_mfma_f32_32x32x16_bf16(al, __builtin_bit_cast(bf16x8, bh), acc, 0, 0, 0);
            }
        }
        { LAS float* pr = PL + (size_t)(kq * 64 + 32 * rg + r32) * 33;
#pragma unroll
          for (int r = 0; r < 16; ++r) pr[att::crow(r, hi)] = acc[r];
          SS[(kq * 2 + hi) * 64 + 32 * rg + r32] = ss; }
        __syncthreads();
        int sel[4]; float gt[4]; float rstd = 0.f; int lr[4];
        if (C.tid < 64) {
            float lv[32]; float s2 = 0.f;
#pragma unroll
            for (int q = 0; q < 8; ++q) s2 += SS[q * 64 + C.tid];
            rstd = 1.0f / sqrtf(s2 * (1.f / DM) + NORM_EPS);
#pragma unroll
            for (int e = 0; e < 32; ++e) { const float a = (PL[(0 * 64 + C.tid) * 33 + e] + PL[(1 * 64 + C.tid) * 33 + e]) + (PL[(2 * 64 + C.tid) * 33 + e] + PL[(3 * 64 + C.tid) * 33 + e]); lv[e] = a * rstd + C.b_router[e]; }
            float val[4];
#pragma unroll
            for (int k = 0; k < 4; ++k) { float best = lv[0]; int bi = 0;
#pragma unroll
                for (int e = 1; e < 32; ++e) if (lv[e] > best) { best = lv[e]; bi = e; }
                sel[k] = bi; val[k] = best;
#pragma unroll
                for (int e = 0; e < 32; ++e) lv[e] = (e == bi) ? -INFINITY : lv[e]; }
            float den = 0.f;
#pragma unroll
            for (int k = 0; k < 4; ++k) { gt[k] = __expf(val[k] - val[0]); den += gt[k]; }
            const float inv = 1.0f / den;
#pragma unroll
            for (int k = 0; k < 4; ++k) { gt[k] *= inv; lr[k] = __hip_atomic_fetch_add((LAS int*)(hist + sel[k]), 1, __ATOMIC_RELAXED, __HIP_MEMORY_SCOPE_WORKGROUP); }
        }
        __syncthreads();
        if (C.tid < 32) gb[C.tid] = (int)__hip_atomic_fetch_add((unsigned*)(C.ctl + CW_CNT + C.tid), (unsigned)hist[C.tid], RLX_AGENT);
        __syncthreads();
        if (C.tid < 64) {
            const int t = blk * 64 + C.tid;
#pragma unroll
            for (int k = 0; k < 4; ++k) { const int sl = sel[k] * CAP + gb[sel[k]] + lr[k]; C.TOK[sl] = t; C.RS[sl] = rstd; C.TSLOT[t * 4 + k] = sl; C.TGATE[t * 4 + k] = gt[k]; }
        }
        __syncthreads();
    }
}
template <int NT>
__device__ __forceinline__ void moe_table(const Ctx& C, LAS int* tab) {
    __syncthreads();
    if (C.tid == 0) { int us = 0, rb = 0;
        for (int e = 0; e < 32; ++e) { const int n = (int)__hip_atomic_load((unsigned*)(C.ctl + CW_CNT + e), RLX_AGENT); const int mt = (n + 255) >> 8; tab[e] = us; tab[33 + e] = mt; tab[65 + e] = rb; tab[97 + e] = n; us += mt * NT; rb += mt * 256; }
        tab[32] = us; }
    __syncthreads();
}


__device__ __forceinline__ void phase9(const Ctx& C, const LAS int* tab) {
    const int gw = C.vcu * NWAVES + C.wave, NGW = C.G * NWAVES;
    for (int t = gw; t < T; t += NGW) {
        typedef int v4i_ __attribute__((ext_vector_type(4))); const v4i_ sl = *(const GAS v4i_*)(C.TSLOT + 4 * t); const f32x4 g = *(const GAS f32x4*)(C.TGATE + 4 * t);
        const int s[4] = {sl.x, sl.y, sl.z, sl.w}; const float gg[4] = {g.x, g.y, g.z, g.w};
        const bf16* yr[4];
#pragma unroll
        for (int k = 0; k < 4; ++k) { const int e = s[k] >> 14, rk = s[k] & (CAP - 1); yr[k] = C.Y + (size_t)(tab[65 + e] + rk) * DM + 8 * C.lane; }
        float* orow = C.out + (size_t)t * DM + 8 * C.lane;
#pragma unroll
        for (int j = 0; j < 4; ++j) {
            f32x4 a0 = *(const GAS f32x4*)(orow + 512 * j), a1 = *(const GAS f32x4*)(orow + 512 * j + 4);
#pragma unroll
            for (int k = 0; k < 4; ++k) { const v4u y = *(const GAS v4u*)(yr[k] + 512 * j);
                a0.x += gg[k] * pg8::bf_lo(y.x); a0.y += gg[k] * pg8::bf_hi(y.x); a0.z += gg[k] * pg8::bf_lo(y.y); a0.w += gg[k] * pg8::bf_hi(y.y);
                a1.x += gg[k] * pg8::bf_lo(y.z); a1.y += gg[k] * pg8::bf_hi(y.z); a1.z += gg[k] * pg8::bf_lo(y.w); a1.w += gg[k] * pg8::bf_hi(y.w); }
            *(GAS f32x4*)(orow + 512 * j) = a0; *(GAS f32x4*)(orow + 512 * j + 4) = a1;
        }
    }
}

struct Args { const void* in[26]; float* out; unsigned char* ws; int ph_lo, ph_hi, probe, pad; };
__global__ void __launch_bounds__(NWAVES * 64, 2) mk_fwd(Args args) {
    extern __shared__ __attribute__((aligned(16))) unsigned char lds_raw[];
    Ctx C;
    C.lds = (LAS unsigned char*)lds_raw;
    C.MISC = (volatile LAS unsigned*)(C.lds + MISC_OFF);
    C.tid = threadIdx.x; C.lane = C.tid & 63; C.wave = __builtin_amdgcn_readfirstlane(C.tid >> 6);
    C.G = gridDim.x; { const int bx = blockIdx.x; C.vcu = (C.G % 8 == 0) ? (bx % 8) * (C.G / 8) + bx / 8 : bx; }
    unsigned char* ws = args.ws;
    C.ctl = (gu32*)(ws + WS_CTL);
    C.x = (const float*)args.in[0]; C.mem = (const float*)args.in[1]; C.pos = (const int*)args.in[2]; C.norm_mix = (const float*)args.in[3]; C.w_in = (const float*)args.in[4];
    C.b_forget = (const float*)args.in[5]; C.fox_q_norm = (const float*)args.in[6]; C.fox_k_norm = (const float*)args.in[7]; C.swa_q_norm = (const float*)args.in[8]; C.swa_k_norm = (const float*)args.in[9];
    C.swa_sinks = (const float*)args.in[10]; C.xmem_q_norm = (const float*)args.in[11]; C.xmem_k_norm = (const float*)args.in[12]; C.norm_mem = (const float*)args.in[13]; C.w_mem_kv = (const float*)args.in[14];
    C.w_up_fox = (const float*)args.in[15]; C.w_up_swa = (const float*)args.in[16]; C.w_up_xmem = (const float*)args.in[17]; C.w_out = (const float*)args.in[18]; C.norm_ffn = (const float*)args.in[19];
    C.w_router = (const float*)args.in[20]; C.b_router = (const float*)args.in[21]; C.w_gate_up = (const float*)args.in[22]; C.b_gate_up = (const float*)args.in[23]; C.w_down = (const float*)args.in[24]; C.b_down = (const float*)args.in[25];
    C.out = args.out;
#define WS_PTRS() do { unsigned char* w_ = args.ws; asm volatile("" : "+s"(w_)); \
    C.ctl = (gu32*)(w_ + WS_CTL); C.Win_t = (bf16*)(w_ + WS_WIN); C.Wmkv_t = (bf16*)(w_ + WS_WMKV); C.Wup_t = (bf16*)(w_ + WS_WUP); C.Wout_t = (bf16*)(w_ + WS_WOUT); C.Wr_t = (bf16*)(w_ + WS_WRT); C.Wgu_t = (bf16*)(w_ + WS_WGU); C.Wd_t = (bf16*)(w_ + WS_WD); \
    C.XN = (bf16*)(w_ + WS_XN); C.MN = (bf16*)(w_ + WS_MN); C.QKV = (bf16*)(w_ + WS_QKV); C.G_ = (bf16*)(w_ + WS_G); C.MKV = (bf16*)(w_ + WS_MKV); C.OALL = (bf16*)(w_ + WS_OALL); C.MERGED = (bf16*)(w_ + WS_MERGED); \
    C.HB = (bf16*)(w_ + WS_HB); C.ACT = (bf16*)(w_ + WS_ACT); C.LOGF = (float*)(w_ + WS_LOGF); C.CNEG = (float*)(w_ + WS_CNEG); C.ROPE = (float*)(w_ + WS_ROPE); C.GATEW = (float*)(w_ + WS_GATE); C.RS = (float*)(w_ + WS_RS); \
    C.TOK = (int*)(w_ + WS_TOK); C.TSLOT = (int*)(w_ + WS_TSLOT); C.TGATE = (float*)(w_ + WS_TGATE); C.Y = (bf16*)(w_ + WS_Y); C.XN8 = w_ + WS_XN8; C.Win8 = w_ + WS_WIN8; } while (0)
    WS_PTRS();
    for (int u = C.tid; u < (LDS_BYTES - LDSCTL_OFF) / 4; u += NWAVES * 64) ((LAS unsigned*)(C.lds + LDSCTL_OFF))[u] = 0u;
    __syncthreads();
    XcdBarrier bar; bar.bar = (unsigned*)(C.ctl + CW_BAR); bar.x = 0; bar.st = nullptr;
    if (N_LAUNCHES == 1) bar = xcd_barrier_post((unsigned*)(C.ctl + CW_BAR), C.MISC + 8);
    const int lo = args.ph_lo, hi = args.ph_hi;
#ifndef MK_PHASE_MASK
#define MK_PHASE_MASK 0x3FF
#endif
#define IN(k) ((((MK_PHASE_MASK) >> (k)) & 1) && lo <= (k) && (k) < hi)
#define SEAM(k) do { if (IN(k) && IN((k) + 1)) xcd_barrier(bar); } while (0)
    LAS int* tab = (LAS int*)(C.lds + MOE_OFF);

    if (IN(0)) { WS_PTRS(); phase0(C); }
    SEAM(0);
    if (IN(1)) { WS_PTRS();
        logf_cumsum(C);
        P1Order S; S.d.init(C.XN, C.Win_t, T, PROBE_INW * 64, C.G, (int)blockIdx.x); S.A1 = (const char*)C.MN; S.B1 = (const char*)C.Wmkv_t;
        EpiInProj E{C.QKV, C.G_, C.MKV, args.probe == 1, C.fox_k_norm, C.swa_k_norm, C.ROPE};
        if (args.probe != 3) pg8::gemm_phase<EpiInProj, P1Order>(C.lds + RING_OFF, S, E);
        P1bOrder S8; S8.d.init(C.XN8, C.Win8, T, 6144, C.G, (int)blockIdx.x);
#ifdef PROBE_DET
#pragma unroll 1
        for (int rep = 0; rep < 2; ++rep) { EpiGates E8{rep ? C.Y : C.ACT}; pg8::gemm_phase<EpiGates, P1bOrder>(C.lds + RING_OFF, S8, E8); }
#else
#ifdef PROBE_GDUMMY
        EpiGates E8{C.ACT};
#else
        EpiGates E8{C.G_};
#endif
        if (args.probe != 2) pg8::gemm_phase<EpiGates, P1bOrder>(C.lds + RING_OFF, S8, E8);
#endif
    }
    SEAM(1);
    if (IN(3)) { WS_PTRS(); phase3(C, args.probe >= 4 ? args.probe : 0); }
    SEAM(3);
    if (IN(4)) { WS_PTRS();
        DenseOrder S; S.init(C.OALL, C.Wup_t, T, DM, C.G, (int)blockIdx.x);
        EpiMerge E{C.G_, C.MERGED};
        pg8::gemm_phase<EpiMerge, DenseOrder>(C.lds + RING_OFF, S, E);
    }
    SEAM(4);
    if (IN(5)) { WS_PTRS();
        DenseOrder S; S.init(C.MERGED, C.Wout_t, T, DM, C.G, (int)blockIdx.x);
        EpiOut E{C.x, C.out, (unsigned char*)C.HB, args.probe == 1};
        pg8::gemm_phase<EpiOut, DenseOrder, false>(C.lds + RING_OFF, S, E);
    }
    SEAM(5);
    if (IN(6)) { WS_PTRS(); phase6(C); }
    SEAM(6);
    if (IN(7)) { WS_PTRS();
        moe_table<16>(C, tab);
        MoeOrder<true, 16, 2048> S{(const char*)C.HB, (const char*)C.Wgu_t, C.TOK, (const int*)(C.ctl + CW_CNT), tab, C.G, C.vcu};
        EpiGateUp E{C.RS, C.b_gate_up, (unsigned char*)C.ACT};
        pg8::gemm_phase<EpiGateUp, MoeOrder<true, 16, 2048>>(C.lds + RING_OFF, S, E);
    }
    SEAM(7);
    if (IN(8)) { WS_PTRS();
        moe_table<8>(C, tab);
        MoeOrder<false, 8, 2048> S{(const char*)C.ACT, (const char*)C.Wd_t, C.TOK, (const int*)(C.ctl + CW_CNT), tab, C.G, C.vcu};
        EpiDown E{C.b_down, C.Y};
        pg8::gemm_phase<EpiDown, MoeOrder<false, 8, 2048>>(C.lds + RING_OFF, S, E);
    }
    SEAM(8);
    if (IN(9)) { WS_PTRS(); moe_table<8>(C, tab); phase9(C, tab);
#ifdef PROBE_DET
        if (blockIdx.x == 0 && C.tid == 0 && __hip_atomic_load((unsigned*)(C.ctl + 2048), RLX_AGENT) != 0u) C.out[12345] = __builtin_nanf("");
#endif
    }
#undef IN
#undef SEAM
}

extern "C" void kernel_launch(void* const* d_in, const int* in_sizes, int n_in, void* d_out, int out_size, void* d_ws, size_t ws_size, hipStream_t stream) {
    static int grid = 0;
    if (grid == 0) {
        if (n_in != 26 || out_size != T * DM || ws_size < WS_END) { fprintf(stderr, "kernel_launch: unexpected problem (n_in %d, out %d, ws %zu < %zu); nothing launched\n", n_in, out_size, ws_size, (size_t)WS_END); grid = -1; return; }
        int dev = 0, cus = 0, per_cu = 0;
        if (hipGetDevice(&dev) != hipSuccess || hipDeviceGetAttribute(&cus, hipDeviceAttributeMultiprocessorCount, dev) != hipSuccess) { grid = -1; return; }
        if (hipFuncSetAttribute((const void*)mk_fwd, hipFuncAttributeMaxDynamicSharedMemorySize, LDS_BYTES) != hipSuccess) { fprintf(stderr, "kernel_launch: hipFuncSetAttribute failed\n"); grid = -1; return; }
        if (hipOccupancyMaxActiveBlocksPerMultiprocessor(&per_cu, (const void*)mk_fwd, NWAVES * 64, LDS_BYTES) != hipSuccess || per_cu < 1) { fprintf(stderr, "kernel_launch: occupancy query says %d\n", per_cu); }
        (void)hipGetLastError();
        grid = cus;
    }
    if (grid < 0) return;
    if (hipMemsetAsync((char*)d_ws + WS_CTL, 0, CTL_ZERO_BYTES, stream) != hipSuccess) return;
#ifdef PROBE_MEMSET8
    hipMemsetAsync((char*)d_ws + WS_XN8, 0, 44 * MiB, stream);
#endif
    Args a{};
    for (int i = 0; i < 26; ++i) a.in[i] = d_in[i];
    a.out = (float*)d_out; a.ws = (unsigned char*)d_ws;
    if (N_LAUNCHES == 1) { a.ph_lo = 0; a.ph_hi = PER_PHASE; hipLaunchKernelGGL(mk_fwd, dim3(grid), dim3(NWAVES * 64), LDS_BYTES, stream, a); }
    else for (int li = 0; li < PER_PHASE; ++li) { a.ph_lo = li; a.ph_hi = li + 1;
#ifdef PROBE_SPLIT_P1
        if (li == 1) { a.probe = 2; hipLaunchKernelGGL(mk_fwd, dim3(grid), dim3(NWAVES * 64), LDS_BYTES, stream, a); a.probe = 3; hipLaunchKernelGGL(mk_fwd, dim3(grid), dim3(NWAVES * 64), LDS_BYTES, stream, a); a.probe = 0; continue; }
#endif
        hipLaunchKernelGGL(mk_fwd, dim3(grid), dim3(NWAVES * 64), LDS_BYTES, stream, a);
#ifdef PROBE_DUP
        if (li == PROBE_DUP) { if (PROBE_DUP == 3 || PROBE_DUP == 6) hipMemsetAsync((char*)d_ws + WS_CTL, 0, CTL_ZERO_BYTES / 2, stream);
#ifdef PROBE_FLAG
            a.probe = PROBE_FLAG;
#endif
            hipLaunchKernelGGL(mk_fwd, dim3(grid), dim3(NWAVES * 64), LDS_BYTES, stream, a); a.probe = 0; }
#endif
    }
    const hipError_t le = hipPeekAtLastError();
    if (le != hipSuccess) fprintf(stderr, "kernel_launch: launch failed: %s\n", hipGetErrorName(le));
}
```

```cpp
#include <hip/hip_runtime.h>
#include <cstdio>
#include <cstdint>

#define LAS __attribute__((address_space(3)))
#define GAS __attribute__((address_space(1)))

namespace pg8 {
typedef unsigned short bf16_t;
typedef short bf16x8 __attribute__((ext_vector_type(8)));
typedef float f32x4 __attribute__((ext_vector_type(4)));
typedef float f32x2 __attribute__((ext_vector_type(2)));
typedef unsigned u32x4 __attribute__((ext_vector_type(4)));
typedef unsigned u32x2 __attribute__((ext_vector_type(2)));
constexpr int BM = 256, BK = 64, HALF = 128, HTB = HALF * BK * 2, STAGE_BYTES = 8 * HTB, NXCD = 8, WGM = 8;
constexpr int KD = 2048;
typedef int v8i __attribute__((ext_vector_type(8))); typedef int v4i __attribute__((ext_vector_type(4)));
__device__ __forceinline__ v8i cat8(bf16x8 lo, bf16x8 hi) { const v4i a = __builtin_bit_cast(v4i, lo), b = __builtin_bit_cast(v4i, hi); return __builtin_shufflevector(a, b, 0, 1, 2, 3, 4, 5, 6, 7); }
__device__ __forceinline__ bf16x8 lo8(v8i v) { return __builtin_bit_cast(bf16x8, (v4i)__builtin_shufflevector(v, v, 0, 1, 2, 3)); }
__device__ __forceinline__ bf16x8 hi8(v8i v) { return __builtin_bit_cast(bf16x8, (v4i)__builtin_shufflevector(v, v, 4, 5, 6, 7)); }

__host__ __device__ __forceinline__ int lds_byte(int r, int c) { const int st = (r >> 4) * 2 + (c >> 5), rr = r & 15, cc = c & 31, ob = rr * 64 + cc * 2; return st * 1024 + (ob ^ (((ob >> 9) & 1) << 5)); }
__host__ __device__ __forceinline__ void stage_rc(int b, int& R, int& C) { const int st = b / 1024, sb = b % 1024, swz = sb ^ (((sb >> 9) & 1) << 5); R = (st >> 1) * 16 + swz / 64; C = (st & 1) * 32 + (swz % 64) / 2; }
__host__ __device__ __forceinline__ int perm32(int rho) { const int n = rho >> 4, i = rho & 15; return 8 * (i >> 2) + 4 * n + (i & 3); }

__device__ __forceinline__ void glds_s(const char* sbase, unsigned voff, unsigned lds_dst) { unsigned keep;
    asm volatile("s_mov_b32 %0, m0\n\ts_mov_b32 m0, %3\n\ts_nop 0\n\tglobal_load_lds_dwordx4 %1, %2\n\ts_mov_b32 m0, %0" : "=&s"(keep) : "v"(voff), "s"(sbase), "s"(lds_dst) : "memory"); }

#define PG8_PIN4(a, b, c, d, txt) asm volatile(txt : "+v"(a), "+v"(b), "+v"(c), "+v"(d))
#define PG8_PIN_ACC(txt) do { _Pragma("unroll") for (int _a = 0; _a < 2; ++_a) _Pragma("unroll") for (int _b = 0; _b < 2; ++_b) { \
        PG8_PIN4(acc[_a][_b][0][0], acc[_a][_b][0][1], acc[_a][_b][1][0], acc[_a][_b][1][1], ""); PG8_PIN4(acc[_a][_b][2][0], acc[_a][_b][2][1], acc[_a][_b][3][0], acc[_a][_b][3][1], ""); } \
        PG8_PIN4(acc[0][0][0][0], acc[0][1][0][0], acc[1][0][0][0], acc[1][1][0][0], txt); \
        _Pragma("unroll") for (int _a = 0; _a < 2; ++_a) _Pragma("unroll") for (int _b = 0; _b < 2; ++_b) { \
        PG8_PIN4(acc[_a][_b][0][0], acc[_a][_b][0][1], acc[_a][_b][1][0], acc[_a][_b][1][1], ""); PG8_PIN4(acc[_a][_b][2][0], acc[_a][_b][2][1], acc[_a][_b][3][0], acc[_a][_b][3][1], ""); } } while (0)

struct Unit { int pm, pn, e, kind; };

typedef float f32x2_cv __attribute__((ext_vector_type(2))); typedef __bf16 bf16x2_cv __attribute__((ext_vector_type(2)));
__device__ __forceinline__ unsigned cvt_pk_bf16(float lo, float hi) { const f32x2_cv v = {lo, hi}; const bf16x2_cv b = __builtin_convertvector(v, bf16x2_cv); return __builtin_bit_cast(unsigned, b); }
__device__ __forceinline__ float bf_lo(unsigned w) { return __uint_as_float(w << 16); }
__device__ __forceinline__ float bf_hi(unsigned w) { return __uint_as_float(w & 0xffff0000u); }

template <class Epi, class Sched, bool ALIGN_EPI = true, bool SP2 = true>
__device__ __forceinline__ void gemm_phase(LAS unsigned char* lds, const Sched& S, const Epi& E) {
    const int tid = threadIdx.x, wid = __builtin_amdgcn_readfirstlane(tid >> 6), lane = tid & 63, wr = wid >> 2, wc = wid & 3, fr = lane & 15, fq = lane >> 4;
    constexpr bool FP8 = Epi::FP8; constexpr int RB = FP8 ? 2048 : 4096, nt = RB / 128;
    unsigned voffB[2]; int RA[2], CA[2];
#pragma unroll
    for (int i = 0; i < 2; ++i) { int R, C; stage_rc(tid * 16 + i * 8192, R, C); const int Rb = Epi::PERM ? ((R & ~31) + perm32(R & 31)) : R;
        voffB[i] = (unsigned)(Rb * RB + C * 2); RA[i] = R; CA[i] = C; }
    constexpr size_t kstep = (size_t)(BK * 2);
    constexpr size_t hstep = (size_t)HALF * RB;
    const unsigned ldsbase = (unsigned)__builtin_amdgcn_readfirstlane((unsigned)(uintptr_t)lds + (unsigned)wid * 1024u);
    const int aoff = lds_byte(wr * 64 + fr, fq * 8), boff = lds_byte(wc * 32 + fr, fq * 8);
#define PG8_SA(b, h) (((b) * 2 + (h)) * HTB)
#define PG8_SB(b, h) ((4 + (b) * 2 + (h)) * HTB)
#define PG8_STAGE(bufoff, gbase, voff) do { _Pragma("unroll") for (int _i = 0; _i < 2; ++_i) \
        glds_s((const char*)(gbase), (voff)[_i], ldsbase + (unsigned)((bufoff) + _i * 8192)); } while (0)
#define PG8_LDA(dst, b, h) do { _Pragma("unroll") for (int m = 0; m < 4; ++m) dst[m] = cat8(*(const LAS bf16x8*)(lds + PG8_SA(b, h) + aoff + m * 2048), *(const LAS bf16x8*)(lds + PG8_SA(b, h) + aoff + m * 2048 + 1024)); } while (0)
#define PG8_LDB(dst, b, h) do { _Pragma("unroll") for (int n = 0; n < 2; ++n) dst[n] = cat8(*(const LAS bf16x8*)(lds + PG8_SB(b, h) + boff + n * 2048), *(const LAS bf16x8*)(lds + PG8_SB(b, h) + boff + n * 2048 + 1024)); } while (0)
#define PG8_MMA(ai, bj, At, Bt) do { __builtin_amdgcn_s_setprio(1); _Pragma("unroll") for (int m = 0; m < 4; ++m) _Pragma("unroll") for (int n = 0; n < 2; ++n) { \
        if constexpr (FP8 && Epi::ASM_MFMA) asm volatile("v_mfma_scale_f32_16x16x128_f8f6f4 %0, %1, %2, %0, %3, %4 op_sel_hi:[0,0,0]" : "+v"(acc[ai][bj][m][n]) : "v"(Bt[n]), "v"(At[m]), "v"(scl_b), "v"(scl_a)); \
        else if constexpr (FP8) acc[ai][bj][m][n] = __builtin_amdgcn_mfma_scale_f32_16x16x128_f8f6f4(Bt[n], At[m], acc[ai][bj][m][n], 0, 0, 0, Epi::SCALE_B, 0, Epi::SCALE_A); \
        else { acc[ai][bj][m][n] = __builtin_amdgcn_mfma_f32_16x16x32_bf16(lo8(Bt[n]), lo8(At[m]), acc[ai][bj][m][n], 0, 0, 0); \
               acc[ai][bj][m][n] = __builtin_amdgcn_mfma_f32_16x16x32_bf16(hi8(Bt[n]), hi8(At[m]), acc[ai][bj][m][n], 0, 0, 0); } } \
        __builtin_amdgcn_s_setprio(0); } while (0)
#ifdef PROBE_DRAIN8
#define PG8_WAIT_V(n) do { if constexpr (FP8 && !Epi::ASM_MFMA) asm volatile("s_waitcnt vmcnt(0)" ::: "memory"); else asm volatile("s_waitcnt vmcnt(" #n ")" ::: "memory"); } while (0)
#else
#define PG8_WAIT_V(n) asm volatile("s_waitcnt vmcnt(" #n ")" ::: "memory")
#endif
#define PG8_WAIT_L(n) asm volatile("s_waitcnt lgkmcnt(" #n ")" ::: "memory")
#define PG8_BAR __builtin_amdgcn_s_barrier()
#define PG8_SCHED __builtin_amdgcn_sched_barrier(0)
    Unit cur, nxt; int ui = 0;
    int scl_a = Epi::SCALE_A, scl_b = Epi::SCALE_B; asm volatile("" : "+v"(scl_a), "+v"(scl_b));
    if (!S.next(0, cur)) return;
    f32x4 acc[2][2][4][2];
#pragma unroll
    for (int a = 0; a < 2; ++a)
#pragma unroll
        for (int b = 0; b < 2; ++b)
#pragma unroll
            for (int m = 0; m < 4; ++m)
#pragma unroll
                for (int n = 0; n < 2; ++n) acc[a][b][m][n] = (f32x4){0.f, 0.f, 0.f, 0.f};
    if constexpr (Epi::FP8) PG8_PIN_ACC("s_nop 7");
    v8i At[4], B0[2], B1[2];
    const char* cA = S.a_base(cur); const char* cB = S.b_base(cur);
    unsigned vo[2][2], nvo[2][2];
    S.a_offs(cur, RA, CA, vo);
    bool has_next = S.next(1, nxt);
    if (has_next) S.a_offs(nxt, RA, CA, nvo); else { nvo[0][0] = vo[0][0]; nvo[0][1] = vo[0][1]; nvo[1][0] = vo[1][0]; nvo[1][1] = vo[1][1]; }
    if constexpr (SP2) {
        PG8_STAGE(PG8_SB(0, 0), cB, voffB); PG8_STAGE(PG8_SB(0, 1), cB + hstep, voffB); PG8_STAGE(PG8_SA(0, 0), cA, vo[0]); PG8_STAGE(PG8_SA(0, 1), cA, vo[1]);
        if (wr == 1) PG8_BAR;
        PG8_WAIT_V(2); PG8_BAR;
        PG8_STAGE(PG8_SB(1, 0), cB + kstep, voffB); PG8_STAGE(PG8_SA(1, 0), cA + kstep, vo[0]); PG8_STAGE(PG8_SB(1, 1), cB + hstep + kstep, voffB);
        PG8_WAIT_V(6); PG8_BAR;
    } else {
        PG8_STAGE(PG8_SB(0, 0), cB, voffB); PG8_STAGE(PG8_SA(0, 0), cA, vo[0]); PG8_STAGE(PG8_SB(0, 1), cB + hstep, voffB); PG8_STAGE(PG8_SA(0, 1), cA, vo[1]);
        if (wr == 1) PG8_BAR;
        PG8_WAIT_V(4); PG8_BAR;
        PG8_STAGE(PG8_SB(1, 0), cB + kstep, voffB); PG8_STAGE(PG8_SA(1, 0), cA + kstep, vo[0]); PG8_STAGE(PG8_SB(1, 1), cB + hstep + kstep, voffB);
        PG8_WAIT_V(6); PG8_BAR;
    }
    for (;;) {
        const char* nA = has_next ? S.a_base(nxt) : cA; const char* nB = has_next ? S.b_base(nxt) : cB;
        for (int t = 0; t < nt; t += 2) {
            const bool last = (t == nt - 2);
            const char* a1 = cA + (size_t)(t + 1) * kstep;
            const char* a2 = last ? nA : cA + (size_t)(t + 2) * kstep; const char* b2 = last ? nB : cB + (size_t)(t + 2) * kstep;
            const char* a3 = a2 + kstep; const char* b3 = b2 + kstep;
            unsigned v2[2][2];
            v2[0][0] = last ? nvo[0][0] : vo[0][0]; v2[0][1] = last ? nvo[0][1] : vo[0][1]; v2[1][0] = last ? nvo[1][0] : vo[1][0]; v2[1][1] = last ? nvo[1][1] : vo[1][1];
            if constexpr (SP2) {
            PG8_LDB(B0, 0, 0); PG8_LDB(B1, 0, 1); PG8_SCHED; PG8_LDA(At, 0, 0); PG8_STAGE(PG8_SA(1, 1), a1, vo[1]);
            PG8_WAIT_V(8); PG8_WAIT_L(0); PG8_BAR; PG8_MMA(0, 0, At, B0); PG8_MMA(0, 1, At, B1); PG8_BAR; PG8_SCHED;
            PG8_LDA(At, 0, 1); PG8_STAGE(PG8_SB(0, 0), b2, voffB); PG8_STAGE(PG8_SB(0, 1), b2 + hstep, voffB); PG8_STAGE(PG8_SA(0, 0), a2, v2[0]);
            PG8_WAIT_V(8); PG8_WAIT_L(0); PG8_BAR; PG8_MMA(1, 0, At, B0); PG8_MMA(1, 1, At, B1); PG8_BAR; PG8_SCHED;
            PG8_LDB(B0, 1, 0); PG8_LDB(B1, 1, 1); PG8_SCHED; PG8_LDA(At, 1, 0); PG8_STAGE(PG8_SA(0, 1), a2, v2[1]);
            PG8_WAIT_V(8); PG8_WAIT_L(0); PG8_BAR; PG8_MMA(0, 0, At, B0); PG8_MMA(0, 1, At, B1); PG8_BAR; PG8_SCHED;
            PG8_LDA(At, 1, 1); PG8_STAGE(PG8_SB(1, 0), b3, voffB); PG8_STAGE(PG8_SB(1, 1), b3 + hstep, voffB); PG8_STAGE(PG8_SA(1, 0), a3, v2[0]);
            PG8_WAIT_V(8); PG8_WAIT_L(0); PG8_BAR; PG8_MMA(1, 0, At, B0); PG8_MMA(1, 1, At, B1); PG8_BAR; PG8_SCHED;
            } else {
            PG8_LDB(B0, 0, 0); PG8_SCHED; PG8_LDA(At, 0, 0); PG8_STAGE(PG8_SA(1, 1), a1, vo[1]);
            PG8_WAIT_L(8); PG8_BAR; PG8_WAIT_L(0); PG8_MMA(0, 0, At, B0); PG8_BAR; PG8_SCHED;
            PG8_LDB(B1, 0, 1); PG8_STAGE(PG8_SB(0, 0), b2, voffB);
            PG8_BAR; PG8_WAIT_L(0); PG8_MMA(0, 1, At, B1); PG8_BAR;
            PG8_LDA(At, 0, 1); PG8_STAGE(PG8_SA(0, 0), a2, v2[0]);
            PG8_BAR; PG8_WAIT_L(0); PG8_MMA(1, 0, At, B0); PG8_BAR; PG8_SCHED;
            PG8_STAGE(PG8_SB(0, 1), b2 + hstep, voffB);
            PG8_WAIT_V(6); PG8_BAR; PG8_MMA(1, 1, At, B1); PG8_BAR;
            PG8_LDB(B0, 1, 0); PG8_SCHED; PG8_LDA(At, 1, 0); PG8_STAGE(PG8_SA(0, 1), a2, v2[1]);
            PG8_WAIT_L(8); PG8_BAR; PG8_WAIT_L(0); PG8_MMA(0, 0, At, B0); PG8_BAR; PG8_SCHED;
            PG8_LDB(B1, 1, 1); PG8_STAGE(PG8_SB(1, 0), b3, voffB);
            PG8_BAR; PG8_WAIT_L(0); PG8_MMA(0, 1, At, B1); PG8_BAR;
            PG8_LDA(At, 1, 1); PG8_STAGE(PG8_SA(1, 0), a3, v2[0]);
            PG8_BAR; PG8_WAIT_L(0); PG8_MMA(1, 0, At, B0); PG8_BAR; PG8_SCHED;
            PG8_STAGE(PG8_SB(1, 1), b3 + hstep, voffB);
            PG8_WAIT_V(6); PG8_BAR; PG8_MMA(1, 1, At, B1); PG8_BAR;
            }
            if constexpr (Epi::MID) { if (t == 10 || t == 22) E.mid(acc, cur, t == 22 ? 1 : 0, wr, wc, fr, fq); }
        }
        Unit nn; const bool has_nn = has_next && S.next(ui + 2, nn); unsigned nnvo[2][2];
        if (has_nn) S.a_offs(nn, RA, CA, nnvo); else { nnvo[0][0] = nvo[0][0]; nnvo[0][1] = nvo[0][1]; nnvo[1][0] = nvo[1][0]; nnvo[1][1] = nvo[1][1]; }
        if constexpr (ALIGN_EPI) { if (wr == 0) PG8_BAR; }
        if constexpr (FP8) PG8_PIN_ACC("s_nop 15\n\ts_nop 7");
        E(acc, cur, wr, wc, fr, fq);
        if (!has_next) break;
#pragma unroll
        for (int a = 0; a < 2; ++a)
#pragma unroll
            for (int b = 0; b < 2; ++b)
#pragma unroll
                for (int m = 0; m < 4; ++m)
#pragma unroll
                    for (int n = 0; n < 2; ++n) acc[a][b][m][n] = (f32x4){0.f, 0.f, 0.f, 0.f};
        if constexpr (FP8) PG8_PIN_ACC("s_nop 7");
        cur = nxt; cA = nA; cB = nB; ++ui; nxt = nn; has_next = has_nn;
        vo[0][0] = nvo[0][0]; vo[0][1] = nvo[0][1]; vo[1][0] = nvo[1][0]; vo[1][1] = nvo[1][1];
        nvo[0][0] = nnvo[0][0]; nvo[0][1] = nnvo[0][1]; nvo[1][0] = nnvo[1][0]; nvo[1][1] = nnvo[1][1];
        if constexpr (ALIGN_EPI) { if (wr == 1) PG8_BAR; }
    }
    PG8_WAIT_V(0);
    if constexpr (!ALIGN_EPI) { if (wr == 0) PG8_BAR; }
    PG8_BAR;
#undef PG8_SA
#undef PG8_SB
#undef PG8_STAGE
#undef PG8_LDA
#undef PG8_LDB
#undef PG8_MMA
#undef PG8_WAIT_V
#undef PG8_WAIT_L
#undef PG8_BAR
#undef PG8_SCHED
}
}

constexpr int NWAVES = 8;
constexpr int BATCH = 2, SEQ = 8192, DM = 2048, T = BATCH * SEQ;
constexpr int NMEM = 256, MROWS = BATCH * NMEM;
constexpr int INW = 10252;
constexpr int NEXP = 32, TOPK = 4, CAP = T;
constexpr int QKVW = 4096;
constexpr int C_FQ = 0, C_FK = 768, C_FV = 1536, C_SQ = 2304, C_SK = 3072, C_SV = 3328, C_MQ = 3584;
constexpr int GW = 6144;
constexpr float NORM_EPS = 1e-6f;
constexpr float LOG2E = 1.4426950408889634f;
constexpr float SWIGLU_LIMIT = 7.0f, SWIGLU_ALPHA = 1.702f;
constexpr int PER_PHASE = 10;
#ifndef MK_N_LAUNCHES
#define MK_N_LAUNCHES 1
#endif
constexpr int N_LAUNCHES = MK_N_LAUNCHES;

constexpr size_t MiB = 1u << 20;
constexpr size_t WS_CTL = 0, CTL_ZERO_BYTES = 1 * MiB;
constexpr size_t WS_WIN   = 2 * MiB;
constexpr size_t WS_WMKV  = WS_WIN + 40 * MiB;
constexpr size_t WS_WUP   = WS_WMKV + 4 * MiB;
constexpr size_t WS_WOUT  = WS_WUP + 8 * MiB;
constexpr size_t WS_WRT   = WS_WOUT + 8 * MiB;
constexpr size_t WS_WGU   = WS_WRT + 1 * MiB;
constexpr size_t WS_WD    = WS_WGU + 512 * MiB;
constexpr size_t WS_XN    = WS_WD + 256 * MiB;
constexpr size_t WS_MN    = WS_XN + 64 * MiB;
constexpr size_t WS_LOGF  = WS_MN + 2 * MiB;
constexpr size_t WS_CNEG  = WS_LOGF + 1 * MiB;
constexpr size_t WS_ROPE  = WS_CNEG + 1 * MiB;
constexpr size_t WS_QKV   = WS_ROPE + 4 * MiB;
constexpr size_t WS_G     = WS_QKV + 128 * MiB;
constexpr size_t WS_MKV   = WS_G + 192 * MiB;
constexpr size_t WS_OALL  = WS_MKV + 1 * MiB;
constexpr size_t WS_MERGED= WS_OALL + 64 * MiB;
constexpr size_t WS_HB    = WS_MERGED + 64 * MiB;
constexpr size_t WS_TOK   = WS_HB + 64 * MiB;
constexpr size_t WS_GATE  = WS_TOK + 2 * MiB;
constexpr size_t WS_RS    = WS_GATE + 2 * MiB;
constexpr size_t WS_ACT   = WS_RS + 2 * MiB;
constexpr size_t WS_Y     = WS_ACT + 288 * MiB;
constexpr size_t WS_TSLOT = WS_Y + 288 * MiB;
constexpr size_t WS_TGATE = WS_TSLOT + 1 * MiB;
constexpr size_t WS_XN8   = WS_TGATE + 1 * MiB;
constexpr size_t WS_WIN8  = WS_XN8 + 32 * MiB;
constexpr size_t WS_END   = WS_WIN8 + 12 * MiB;
constexpr int CW_BAR = 4096;
constexpr int CW_QHEAD = 64;
constexpr int CW_CNT = 512;

typedef unsigned short bf16;
typedef unsigned v4u __attribute__((ext_vector_type(4)));
typedef unsigned v2u __attribute__((ext_vector_type(2)));
typedef float f32x4 __attribute__((ext_vector_type(4)));
typedef float f32x16 __attribute__((ext_vector_type(16)));
typedef short bf16x8 __attribute__((ext_vector_type(8)));
typedef short s16x4 __attribute__((ext_vector_type(4)));
typedef GAS unsigned gu32;
#define RLX_AGENT __ATOMIC_RELAXED, __HIP_MEMORY_SCOPE_AGENT
#define LDS_WAIT() asm volatile("s_waitcnt lgkmcnt(0)" ::: "memory")
#define VM_WAIT() asm volatile("s_waitcnt vmcnt(0)" ::: "memory")
__device__ __forceinline__ unsigned f2bf(float f) { unsigned u = __builtin_bit_cast(unsigned, f); return (u + 0x7fffu + ((u >> 16) & 1u)) >> 16; }
__device__ __forceinline__ unsigned pk2(float lo, float hi) { return f2bf(lo) | (f2bf(hi) << 16); }
__device__ __forceinline__ float bf2f(unsigned short b) { return __uint_as_float(((unsigned)b) << 16); }
__device__ __forceinline__ float wave_sum(float v) {
#pragma unroll
    for (int o = 1; o < 64; o <<= 1) v += __shfl_xor(v, o);
    return v;
}
__device__ __forceinline__ float sigmoidf_(float x) { return __builtin_amdgcn_rcpf(1.0f + __builtin_amdgcn_exp2f(x * (-LOG2E))); }

constexpr int H8_SHIFT = 4, ACT8_SHIFT = 2, W8_SHIFT = 9;
constexpr float H8_MUL = 16.0f, ACT8_MUL = 4.0f, W8_MUL = 512.0f;
__device__ __forceinline__ float clamp_fp8(float v) { return __builtin_amdgcn_fmed3f(v, -448.0f, 448.0f); }
__device__ __forceinline__ unsigned pk4_fp8(float a, float b, float c, float d) {
    int p = __builtin_amdgcn_cvt_pk_fp8_f32(clamp_fp8(a), clamp_fp8(b), 0, false); p = __builtin_amdgcn_cvt_pk_fp8_f32(clamp_fp8(c), clamp_fp8(d), p, true); return (unsigned)p; }
using pg8::f32x2; using pg8::u32x4; using pg8::u32x2; using pg8::cvt_pk_bf16; using pg8::bf_lo; using pg8::bf_hi;

#define XB_TMO      128
#define XB_XCNT(j)  (256  + 64 * (j))
#define XB_XSUB(j)  (1280 + 64 * (j))
#define XB_XGEN(j)  (2304 + 64 * (j))
#define XB_TOP      3328
#define XB_TOPGEN   3392
#define XCD_BAR_WORDS 3456
#define XB_SPIN_CAP (1u << 18)

__device__ __forceinline__ unsigned xb_ld(unsigned* p)              { return __hip_atomic_load(p, __ATOMIC_RELAXED, __HIP_MEMORY_SCOPE_AGENT); }
__device__ __forceinline__ unsigned xb_add(unsigned* p, unsigned v) { return __hip_atomic_fetch_add(p, v, __ATOMIC_RELAXED, __HIP_MEMORY_SCOPE_AGENT); }
__device__ __forceinline__ unsigned xb_xcc_id() { return (unsigned)__builtin_amdgcn_s_getreg((3 << 11) | 20) & 0xFu; }
#define XB_SPIN(cond, bar) do { unsigned _sp = 0; while (cond) { __builtin_amdgcn_s_sleep(1); \
    if ((++_sp & 255u) == 0u) { if (xb_ld(&(bar)[XB_TMO])) break; if (_sp > XB_SPIN_CAP) { atomicAdd(&(bar)[XB_TMO], 1u); break; } } } } while (0)

struct XcdBarrier { unsigned* bar; unsigned x; volatile LAS unsigned* st; };

__device__ __forceinline__ XcdBarrier xcd_barrier_post(unsigned* bar, volatile LAS unsigned* st) {
    XcdBarrier b; b.bar = bar; b.x = xb_xcc_id(); b.st = st;
    if (threadIdx.x == 0) (void)xb_add(&bar[XB_XCNT(b.x)], 1u);
    return b;
}
__device__ __forceinline__ void xcd_barrier_complete(unsigned* bar, unsigned x, unsigned& nloc, unsigned& nx) {
    const unsigned G = gridDim.x * gridDim.y * gridDim.z;
    unsigned sum, cnt, mine, sp = 0u;
    for (;;) {
        sum = 0u; cnt = 0u; mine = 0u;
#pragma unroll
        for (unsigned j = 0; j < 16; ++j) { const unsigned c = xb_ld(&bar[XB_XCNT(j)]); sum += c; cnt += (c > 0u) ? 1u : 0u; mine = (j == x) ? c : mine; }
        if (sum == G) break;
        __builtin_amdgcn_s_sleep(1);
        if ((++sp & 255u) == 0u) { if (xb_ld(&bar[XB_TMO])) break; if (sp > XB_SPIN_CAP) { atomicAdd(&bar[XB_TMO], 1u); break; } }
    }
    nloc = mine > 0u ? mine : 1u; nx = cnt > 0u ? cnt : 1u;
}
__device__ __forceinline__ void xcd_barrier(const XcdBarrier& b) {
    asm volatile("s_waitcnt vmcnt(0)" ::: "memory");
    __syncthreads();
    if (threadIdx.x == 0) {
        unsigned* bar = b.bar;
        __builtin_amdgcn_s_waitcnt(0);
        unsigned nloc = b.st[0], nx = b.st[1];
        if (nloc == 0u) { xcd_barrier_complete(bar, b.x, nloc, nx); b.st[0] = nloc; b.st[1] = nx; }
        const unsigned old = xb_add(&bar[XB_XSUB(b.x)], 1u);
        const unsigned gen = old / nloc;
        if (old + 1u == (gen + 1u) * nloc) {
            __builtin_amdgcn_fence(__ATOMIC_RELEASE, "agent");
            asm volatile("s_waitcnt vmcnt(0)" ::: "memory");
            const unsigned og = xb_add(&bar[XB_TOP], 1u);
            const unsigned tg = og / nx;
            if (og + 1u == (tg + 1u) * nx) xb_add(&bar[XB_TOPGEN], 1u);
            else XB_SPIN(xb_ld(&bar[XB_TOPGEN]) == tg, bar);
            __builtin_amdgcn_fence(__ATOMIC_ACQUIRE, "agent");
            xb_add(&bar[XB_XGEN(b.x)], 1u);
            asm volatile("s_waitcnt vmcnt(0)" ::: "memory");
        } else {
            XB_SPIN(xb_ld(&bar[XB_XGEN(b.x)]) == gen, bar);
            __builtin_amdgcn_fence(__ATOMIC_ACQUIRE, "agent");
            asm volatile("s_waitcnt vmcnt(0)" ::: "memory");
        }
    }
    __syncthreads();
}

constexpr int RING_OFF = 0, RING_BYTES = 131072;
constexpr int LDSCTL_OFF = RING_BYTES, MISC_OFF = LDSCTL_OFF + 320;
constexpr int MOE_OFF = MISC_OFF + 128;
constexpr int LDS_BYTES = 147456;

struct Ctx {
    LAS unsigned char* lds;
    volatile LAS unsigned* MISC;
    gu32* ctl;
    int tid, lane, wave, vcu, G, probe;
    const float *x, *mem; const int* pos; const float *norm_mix, *w_in, *b_forget, *fox_q_norm, *fox_k_norm, *swa_q_norm, *swa_k_norm, *swa_sinks, *xmem_q_norm, *xmem_k_norm, *norm_mem,
        *w_mem_kv, *w_up_fox, *w_up_swa, *w_up_xmem, *w_out, *norm_ffn, *w_router, *b_router, *w_gate_up, *b_gate_up, *w_down, *b_down;
    float* out;
    bf16 *Win_t, *Wmkv_t, *Wup_t, *Wout_t, *Wr_t, *Wgu_t, *Wd_t, *XN, *MN, *QKV, *G_, *MKV, *OALL, *MERGED, *HB, *ACT;
    float *LOGF, *CNEG, *ROPE, *GATEW, *RS, *TGATE; int *TOK, *TSLOT; bf16* Y; unsigned char *XN8, *Win8;
};

#ifndef PROBE_INW
#define PROBE_INW 64
#endif
__constant__ float INV_FREQ[32] = {1.000000000e+00f, 7.498942614e-01f, 5.623413324e-01f, 4.216965139e-01f, 3.162277639e-01f, 2.371373773e-01f, 1.778279394e-01f, 1.333521307e-01f,
    1.000000015e-01f, 7.498941571e-02f, 5.623413250e-02f, 4.216965288e-02f, 3.162277490e-02f, 2.371373773e-02f, 1.778279431e-02f, 1.333521493e-02f, 9.999999776e-03f, 7.498941850e-03f,
    5.623413250e-03f, 4.216964822e-03f, 3.162277630e-03f, 2.371373586e-03f, 1.778279431e-03f, 1.333521446e-03f, 1.000000047e-03f, 7.498942432e-04f, 5.623413017e-04f, 4.216965172e-04f,
    3.162277571e-04f, 2.371373703e-04f, 1.778279402e-04f, 1.333521504e-04f};

struct TItem { const float* src; const float* ksc; bf16* dst; size_t ldw; int f8, gap; };
__device__ __forceinline__ void titem_load(const TItem& I, f32x4 (&v)[8][2], float (&sc)[8][2], int lane) {
    const int rr = lane >> 4, c4 = lane & 15;
#pragma unroll
    for (int p = 0; p < 8; ++p)
#pragma unroll
        for (int h = 0; h < 2; ++h) { const int k = 8 * p + 2 * rr + h; v[p][h] = *(const GAS f32x4*)(I.src + (size_t)k * I.ldw + 4 * c4 + (c4 >= 8 ? I.gap : 0)); sc[p][h] = I.ksc ? I.ksc[k] : 1.0f; }
}
__device__ __forceinline__ void titem_store(const TItem& I, const f32x4 (&v)[8][2], const float (&sc)[8][2], LAS unsigned* tile, int lane) {
    const int rr = lane >> 4, c4 = lane & 15;
#pragma unroll
    for (int p = 0; p < 8; ++p)
#pragma unroll
        for (int q = 0; q < 4; ++q) { const int n = 4 * c4 + q, sw = (n ^ (n >> 3)) & 7;
            tile[n * 32 + 4 * (p ^ sw) + rr] = pg8::cvt_pk_bf16(v[p][0][q] * sc[p][0], v[p][1][q] * sc[p][1]); }
    LDS_WAIT(); asm volatile("" ::: "memory");
#pragma unroll
    for (int j = 0; j < 8; ++j) { const int n = 8 * j + (lane >> 3), c = lane & 7, sw = (n ^ (n >> 3)) & 7;
        const v4u o = *(const LAS v4u*)(tile + n * 32 + 4 * (c ^ sw));
        *(GAS v4u*)(I.dst + (size_t)n * DM + 8 * c) = o; }
    LDS_WAIT(); asm volatile("" ::: "memory");
}
__device__ __forceinline__ void titem8_load(const TItem& I, int hf, f32x4 (&v)[8][2], float (&sc)[8][2], int lane) {
    const int rr = lane >> 4, c4 = lane & 15;
#pragma unroll
    for (int p = 0; p < 4; ++p)
#pragma unroll
        for (int h = 0; h < 4; ++h) { const int k = 64 * hf + 16 * p + 4 * rr + h; v[2 * p + (h >> 1)][h & 1] = *(const GAS f32x4*)(I.src + (size_t)k * I.ldw + 4 * c4); sc[2 * p + (h >> 1)][h & 1] = (I.ksc ? I.ksc[k] : 1.0f) * W8_MUL; }
}
__device__ __forceinline__ void titem8_pack(int hf, const f32x4 (&v)[8][2], const float (&sc)[8][2], LAS unsigned* tile, int lane) {
    const int rr = lane >> 4, c4 = lane & 15;
#pragma unroll
    for (int p = 0; p < 4; ++p)
#pragma unroll
        for (int q = 0; q < 4; ++q) { const int n = 4 * c4 + q, sw = (n ^ (n >> 3)) & 7;
            tile[n * 32 + 4 * ((4 * hf + p) ^ sw) + rr] = pk4_fp8(v[2 * p][0][q] * sc[2 * p][0], v[2 * p][1][q] * sc[2 * p][1], v[2 * p + 1][0][q] * sc[2 * p + 1][0], v[2 * p + 1][1][q] * sc[2 * p + 1][1]); }
}
__device__ __forceinline__ void titem8_flush(const TItem& I, LAS unsigned* tile, int lane) {
    LDS_WAIT(); asm volatile("" ::: "memory");
#pragma unroll
    for (int j = 0; j < 8; ++j) { const int n = 8 * j + (lane >> 3), c = lane & 7, sw = (n ^ (n >> 3)) & 7;
        const v4u o = *(const LAS v4u*)(tile + n * 32 + 4 * (c ^ sw));
        *(GAS v4u*)((unsigned char*)I.dst + (size_t)n * DM + 16 * c) = o; }
    LDS_WAIT(); asm volatile("" ::: "memory");
}
__device__ __forceinline__ void p0_router_item(const float* W, int k0, bf16* WT, const float* ksc, LAS float* scr, int lane) {
#pragma unroll 8
    for (int i = 0; i < 32; ++i) { const int kk = 2 * i + (lane >> 5); scr[kk * 33 + (lane & 31)] = W[(size_t)(k0 + kk) * 32 + (lane & 31)] * ksc[k0 + kk]; }
    LDS_WAIT(); asm volatile("" ::: "memory");
    const int c = lane & 7;
#pragma unroll
    for (int j = 0; j < 4; ++j) { const int n = (lane >> 3) + 8 * j; const LAS float* s = scr + (8 * c) * 33 + n;
        unsigned h[8], l[8];
#pragma unroll
        for (int q = 0; q < 8; ++q) { const float v = s[q * 33]; h[q] = f2bf(v); l[q] = f2bf(v - __uint_as_float(h[q] << 16)); }
        v4u oh, ol; oh.x = h[0] | (h[1] << 16); oh.y = h[2] | (h[3] << 16); oh.z = h[4] | (h[5] << 16); oh.w = h[6] | (h[7] << 16);
        ol.x = l[0] | (l[1] << 16); ol.y = l[2] | (l[3] << 16); ol.z = l[4] | (l[5] << 16); ol.w = l[6] | (l[7] << 16);
        *(GAS v4u*)(WT + (size_t)n * 2048 + k0 + 8 * c) = oh; *(GAS v4u*)(WT + (size_t)(32 + n) * 2048 + k0 + 8 * c) = ol; }
    LDS_WAIT(); asm volatile("" ::: "memory");
}
__device__ __forceinline__ float log_sigmoidf_(float z) { return fminf(z, 0.f) - log1pf(__expf(-fabsf(z))); }

template <bool XROW>
__device__ __forceinline__ void p0_norm_row(const Ctx& C, const float* xrow, const float* gain, bf16* orow, const LAS float* Wf, int m) {
    const GAS f32x4* xr = (const GAS f32x4*)xrow + C.lane; const GAS f32x4* gr = (const GAS f32x4*)gain + C.lane;
    f32x4 v[8]; float s = 0.f;
#pragma unroll
    for (int j = 0; j < 8; ++j) { v[j] = xr[64 * j]; s += (v[j].x * v[j].x + v[j].y * v[j].y) + (v[j].z * v[j].z + v[j].w * v[j].w); }
    const float rstd = 1.0f / sqrtf(wave_sum(s) * (1.f / DM) + NORM_EPS);
    GAS unsigned long long* o8 = (GAS unsigned long long*)orow + C.lane;
#pragma unroll
    for (int j = 0; j < 8; ++j) { const f32x4 g = gr[64 * j]; v[j] = (v[j] * rstd) * g;
        o8[64 * j] = (unsigned long long)pk2(v[j].x, v[j].y) | ((unsigned long long)pk2(v[j].z, v[j].w) << 32);
        if constexpr (XROW) ((GAS unsigned*)(C.XN8 + (size_t)m * DM))[C.lane + 64 * j] = pk4_fp8(v[j].x * H8_MUL, v[j].y * H8_MUL, v[j].z * H8_MUL, v[j].w * H8_MUL); }
    if constexpr (XROW) {
        float mine = 0.f;
#pragma unroll 1
        for (int h = 0; h < 12; ++h) { const LAS f32x4* w = (const LAS f32x4*)(Wf + h * 2048) + C.lane; float d = 0.f;
#pragma unroll
            for (int j = 0; j < 8; ++j) { const f32x4 ww = w[64 * j]; d += (v[j].x * ww.x + v[j].y * ww.y) + (v[j].z * ww.z + v[j].w * ww.w); }
            d = wave_sum(d); if (C.lane == h) mine = d; }
        const int b = m / SEQ, t = m % SEQ;
        if (C.lane < 12) C.LOGF[(size_t)(b * 12 + C.lane) * SEQ + t] = log_sigmoidf_(mine + C.b_forget[C.lane]);
        if (C.lane < 32) { const float ang = (float)C.pos[m] * INV_FREQ[C.lane]; const double rev = (double)ang * 0.15915494309189535; const float fr = (float)(rev - floor(rev));
            C.ROPE[(size_t)m * 64 + C.lane] = __builtin_amdgcn_cosf(fr); C.ROPE[(size_t)m * 64 + 32 + C.lane] = __builtin_amdgcn_sinf(fr); }
    }
}
__device__ __forceinline__ void p0_x_rows2(const Ctx& C, const LAS float* Wf, int m0, int m1) {
    const GAS f32x4* gr = (const GAS f32x4*)C.norm_mix + C.lane;
    const int mm[2] = {m0, m1};
    f32x4 v[2][8]; float s[2] = {0.f, 0.f};
#pragma unroll
    for (int r = 0; r < 2; ++r) { const GAS f32x4* xr = (const GAS f32x4*)(C.x + (size_t)mm[r] * DM) + C.lane;
#pragma unroll
        for (int j = 0; j < 8; ++j) v[r][j] = xr[64 * j]; }
#pragma unroll
    for (int r = 0; r < 2; ++r)
#pragma unroll
        for (int j = 0; j < 8; ++j) s[r] += (v[r][j].x * v[r][j].x + v[r][j].y * v[r][j].y) + (v[r][j].z * v[r][j].z + v[r][j].w * v[r][j].w);
    float rstd[2];
#pragma unroll
    for (int r = 0; r < 2; ++r) rstd[r] = 1.0f / sqrtf(wave_sum(s[r]) * (1.f / DM) + NORM_EPS);
#pragma unroll
    for (int j = 0; j < 8; ++j) { const f32x4 g = gr[64 * j];
#pragma unroll
        for (int r = 0; r < 2; ++r) { v[r][j] = (v[r][j] * rstd[r]) * g;
            ((GAS unsigned long long*)(C.XN + (size_t)mm[r] * DM))[C.lane + 64 * j] = (unsigned long long)pk2(v[r][j].x, v[r][j].y) | ((unsigned long long)pk2(v[r][j].z, v[r][j].w) << 32);
            ((GAS unsigned*)(C.XN8 + (size_t)mm[r] * DM))[C.lane + 64 * j] = pk4_fp8(v[r][j].x * H8_MUL, v[r][j].y * H8_MUL, v[r][j].z * H8_MUL, v[r][j].w * H8_MUL); } }
    float mine[2] = {0.f, 0.f};
#pragma unroll 1
    for (int h = 0; h < 12; ++h) { const LAS f32x4* w = (const LAS f32x4*)(Wf + h * 2048) + C.lane; float d0 = 0.f, d1 = 0.f;
#pragma unroll
        for (int j = 0; j < 8; ++j) { const f32x4 ww = w[64 * j];
            d0 += (v[0][j].x * ww.x + v[0][j].y * ww.y) + (v[0][j].z * ww.z + v[0][j].w * ww.w); d1 += (v[1][j].x * ww.x + v[1][j].y * ww.y) + (v[1][j].z * ww.z + v[1][j].w * ww.w); }
        d0 = wave_sum(d0); d1 = wave_sum(d1); if (C.lane == h) { mine[0] = d0; mine[1] = d1; } }
#pragma unroll
    for (int r = 0; r < 2; ++r) { const int m = mm[r], b = m / SEQ, t = m % SEQ;
        if (C.lane < 12) C.LOGF[(size_t)(b * 12 + C.lane) * SEQ + t] = log_sigmoidf_(mine[r] + C.b_forget[C.lane]);
        if (C.lane < 32) { const float ang = (float)C.pos[m] * INV_FREQ[C.lane]; const double rev = (double)ang * 0.15915494309189535; const float fr = (float)(rev - floor(rev));
            C.ROPE[(size_t)m * 64 + C.lane] = __builtin_amdgcn_cosf(fr); C.ROPE[(size_t)m * 64 + 32 + C.lane] = __builtin_amdgcn_sinf(fr); } }
}
__device__ __forceinline__ void phase0(const Ctx& C) {
    const int gw = C.vcu * NWAVES + C.wave, NGW = C.G * NWAVES;
    LAS float* scr = (LAS float*)(C.lds + RING_OFF + C.wave * 16384);
    for (int r = gw; r < 32; r += NGW) p0_router_item(C.w_router, 64 * r, C.Wr_t, C.norm_ffn, scr, C.lane);
    constexpr int I_GU = 32 * 16 * 64, I_D = 32 * 16 * 32, I_ING = 16 * 96, I_IN = 32 * PROBE_INW, I_MKV = 32 * 16, I_UF = 12 * 32, I_US = 12 * 32, I_UX = 8 * 32, I_O = 32 * 32;
    constexpr int NITEMS = I_GU + I_D + I_ING + I_IN + I_MKV + I_UF + I_US + I_UX + I_O;
    auto decode = [&](int it) -> TItem {
        TItem I; int r = it; I.ksc = nullptr; I.f8 = 0; I.gap = 0;
        if (r < I_GU) { const int e = r / 1024, q = r % 1024, kb = 2 * (q / 64), pb = q % 64, tl = pb >> 2, jb = pb & 3;
            const int n0 = (jb < 2) ? (128 * tl + 64 * jb) : (2048 + 128 * tl + 64 * (jb - 2));
            I.ldw = 4096; I.src = C.w_gate_up + (size_t)e * DM * 4096 + (size_t)(64 * kb) * 4096 + n0; I.ksc = C.norm_ffn + 64 * kb; I.f8 = 1; I.dst = (bf16*)((unsigned char*)C.Wgu_t + ((size_t)e * 4096 + 64 * pb) * DM + 64 * kb); return I; } r -= I_GU;
        if (r < I_D) { const int e = r / 512, q = r % 512, kb = 2 * (q / 32), nb = q % 32;
            I.ldw = DM; I.src = C.w_down + (size_t)e * DM * DM + (size_t)(64 * kb) * DM + 64 * nb; I.f8 = 1; I.dst = (bf16*)((unsigned char*)C.Wd_t + ((size_t)e * DM + 64 * nb) * DM + 64 * kb); return I; } r -= I_D;
        if (r < I_ING) { const int kb = 2 * (r / 96), pb = r % 96;
            I.ldw = INW; I.src = C.w_in + (size_t)(64 * kb) * INW + 4108 + 64 * pb; I.f8 = 1; I.dst = (bf16*)((unsigned char*)C.Win8 + (size_t)(64 * pb) * DM + 64 * kb); return I; } r -= I_ING;
        if (r < I_IN) { const int kb = r / PROBE_INW, pb = r % PROBE_INW; int p0 = 64 * pb; const int tl = pb >> 2, q4 = pb & 3;
            if (tl == 3 || tl == 4 || tl == 5 || tl == 12) { p0 = 256 * tl + 128 * (q4 & 1) + 32 * (q4 >> 1); I.gap = 32; }
            const int n0 = (p0 < 2304) ? p0 : p0 + 12;
            I.ldw = INW; I.src = C.w_in + (size_t)(64 * kb) * INW + n0; I.dst = C.Win_t + (size_t)(64 * pb) * DM + 64 * kb; return I; } r -= I_IN;
        if (r < I_MKV) { const int kb = r / 16, nb = r % 16; I.ldw = 1024; I.src = C.w_mem_kv + (size_t)(64 * kb) * 1024 + 64 * nb; I.dst = C.Wmkv_t + (size_t)(64 * nb) * DM + 64 * kb; return I; } r -= I_MKV;
        if (r < I_UF) { const int kb = r / 32, nb = r % 32; I.ldw = DM; I.src = C.w_up_fox + (size_t)(64 * kb) * DM + 64 * nb; I.dst = C.Wup_t + (size_t)(64 * nb) * DM + 64 * kb; return I; } r -= I_UF;
        if (r < I_US) { const int kb = r / 32, nb = r % 32; I.ldw = DM; I.src = C.w_up_swa + (size_t)(64 * kb) * DM + 64 * nb; I.dst = C.Wup_t + (size_t)(64 * nb) * DM + 768 + 64 * kb; return I; } r -= I_US;
        if (r < I_UX) { const int kb = r / 32, nb = r % 32; I.ldw = DM; I.src = C.w_up_xmem + (size_t)(64 * kb) * DM + 64 * nb; I.dst = C.Wup_t + (size_t)(64 * nb) * DM + 1536 + 64 * kb; return I; } r -= I_UX;
        { const int kb = r / 32, nb = r % 32; I.ldw = DM; I.src = C.w_out + (size_t)(64 * kb) * DM + 64 * nb; I.dst = C.Wout_t + (size_t)(64 * nb) * DM + 64 * kb; return I; }
    };
    LAS unsigned* tile = (LAS unsigned*)(C.lds + RING_OFF + C.wave * 8192);
    __syncthreads();
    constexpr int N8 = I_GU + I_D + I_ING;
    if (gw < N8) {
        const int nh = 2 * ((N8 - gw + NGW - 1) / NGW);
        TItem cur = decode(gw); f32x4 va[8][2]; float sa[8][2]; titem8_load(cur, 0, va, sa, C.lane);
        for (int hs = 0; hs < nh; ++hs) {
            const int hf = hs & 1; TItem nxt = cur; f32x4 vb[8][2]; float sb[8][2];
            if (hs + 1 < nh) { if (hf == 1) nxt = decode(gw + ((hs + 1) >> 1) * NGW); titem8_load(nxt, hf ^ 1, vb, sb, C.lane); }
#ifdef PROBE_P0STREAM
            if (C.probe == 7) { unsigned char* dd = (unsigned char*)C.ACT + ((size_t)(gw + (hs >> 1) * NGW) * 2 + hf) * 4096 + C.lane * 16;
#pragma unroll
                for (int p = 0; p < 4; ++p) { v4u o; o.x = pk4_fp8(va[2*p][0].x * sa[2*p][0], va[2*p][1].x * sa[2*p][1], va[2*p+1][0].x * sa[2*p+1][0], va[2*p+1][1].x * sa[2*p+1][1]);
                    o.y = pk4_fp8(va[2*p][0].y * sa[2*p][0], va[2*p][1].y * sa[2*p][1], va[2*p+1][0].y * sa[2*p+1][0], va[2*p+1][1].y * sa[2*p+1][1]);
                    o.z = pk4_fp8(va[2*p][0].z * sa[2*p][0], va[2*p][1].z * sa[2*p][1], va[2*p+1][0].z * sa[2*p+1][0], va[2*p+1][1].z * sa[2*p+1][1]);
                    o.w = pk4_fp8(va[2*p][0].w * sa[2*p][0], va[2*p][1].w * sa[2*p][1], va[2*p+1][0].w * sa[2*p+1][0], va[2*p+1][1].w * sa[2*p+1][1]);
                    *(GAS v4u*)(dd + p * 1024) = o; } }
            else
#endif
            { titem8_pack(hf, va, sa, tile, C.lane);
              if (hf == 1) titem8_flush(cur, tile, C.lane); }
            cur = nxt;
#pragma unroll
            for (int p = 0; p < 8; ++p)
#pragma unroll
                for (int h = 0; h < 2; ++h) { va[p][h] = vb[p][h]; sa[p][h] = sb[p][h]; }
        }
    }
    if (N8 + gw < NITEMS) {
        TItem cur = decode(N8 + gw); f32x4 va[8][2]; float sa[8][2]; titem_load(cur, va, sa, C.lane);
        for (int it = N8 + gw; it < NITEMS; it += NGW) {
            const int nx = it + NGW; TItem nxt = cur; f32x4 vb[8][2]; float sb[8][2];
            if (nx < NITEMS) { nxt = decode(nx); titem_load(nxt, vb, sb, C.lane); }
            titem_store(cur, va, sa, tile, C.lane);
            cur = nxt;
#pragma unroll
            for (int p = 0; p < 8; ++p)
#pragma unroll
                for (int h = 0; h < 2; ++h) { va[p][h] = vb[p][h]; sa[p][h] = sb[p][h]; }
        }
    }
    __syncthreads();
    LAS float* Wf = (LAS float*)(C.lds + RING_OFF);
    for (int idx = C.tid; idx < 12 * 2048; idx += NWAVES * 64) { const int k = idx / 12, h = idx - 12 * k; Wf[h * 2048 + k] = C.w_in[(size_t)k * INW + 2304 + h]; }
    __syncthreads();
    { int m = gw; for (; m + NGW < T; m += 2 * NGW) p0_x_rows2(C, Wf, m, m + NGW); if (m < T) p0_norm_row<true>(C, C.x + (size_t)m * DM, C.norm_mix, C.XN + (size_t)m * DM, Wf, m); }
    for (int m = gw; m < MROWS; m += NGW) p0_norm_row<false>(C, C.mem + (size_t)m * DM, C.norm_mem, C.MN + (size_t)m * DM, Wf, m);
    __syncthreads();
}

using pg8::Unit;
template <int RB>
struct DenseOrderT {
    const char* A; const char* Bt; int nM, nN, nwg, G, c;
    __device__ __forceinline__ void init(const void* A_, const void* Bt_, int M, int N, int G_, int c_) { A = (const char*)A_; Bt = (const char*)Bt_; nM = M / 256; nN = N / 256; nwg = nM * nN; G = G_; c = c_; }
    __device__ __forceinline__ bool map(long L, Unit& u) const {
        if (L >= nwg) return false;
        int wgid = (int)L; { const int q = nwg / 8, r = nwg % 8, xcd = wgid % 8, off = wgid / 8; wgid = (xcd < r ? xcd * (q + 1) : r * (q + 1) + (xcd - r) * q) + off; }
        const int nig = 8 * nN, gid = wgid / nig, fm = gid * 8, gsz = (nM - fm) < 8 ? (nM - fm) : 8;
        u.pm = fm + ((wgid % nig) % gsz); u.pn = (wgid % nig) / gsz; u.e = 0; u.kind = 0; return true;
    }
    __device__ __forceinline__ bool next(int i, Unit& u) const { return map((long)i * G + c, u); }
    __device__ __forceinline__ const char* a_base(const Unit& u) const { return A + (size_t)u.pm * (256 * RB); }
    __device__ __forceinline__ const char* b_base(const Unit& u) const { return Bt + (size_t)u.pn * (256 * RB); }
    __device__ __forceinline__ void a_offs(const Unit&, const int (&R)[2], const int (&Cc)[2], unsigned (&vo)[2][2]) const {
#pragma unroll
        for (int h = 0; h < 2; ++h)
#pragma unroll
            for (int i = 0; i < 2; ++i) vo[h][i] = (unsigned)((h * 128 + R[i]) * RB + Cc[i] * 2);
    }
};
typedef DenseOrderT<4096> DenseOrder;
struct P1Order {
    DenseOrder d; const char* A1; const char* B1;
    __device__ __forceinline__ bool next(int i, Unit& u) const {
        const long L = (long)i * d.G + d.c;
        if (L < d.nwg) return d.map(L, u);
        const int r = (int)(L - d.nwg); if (r >= 8) return false;
        u.pm = r >> 2; u.pn = r & 3; u.e = 0; u.kind = 1; return true;
    }
    __device__ __forceinline__ const char* a_base(const Unit& u) const { return (u.kind ? A1 : d.A) + (size_t)u.pm * (256 * 2048 * 2); }
    __device__ __forceinline__ const char* b_base(const Unit& u) const { return (u.kind ? B1 : d.Bt) + (size_t)u.pn * (256 * 2048 * 2); }
    __device__ __forceinline__ void a_offs(const Unit& u, const int (&R)[2], const int (&Cc)[2], unsigned (&vo)[2][2]) const { d.a_offs(u, R, Cc, vo); }
};
struct P1bOrder {
    DenseOrderT<2048> d;
    __device__ __forceinline__ bool next(int i, Unit& u) const {
        const int c = d.c;
        if (c < 8) return i < 4 ? d.map((long)i * d.G + c, u) : false;
        if (i < 6) return d.map((long)i * d.G + c, u);
        if (i == 6 && c < 24) { const int idx = c - 8; return d.map((long)(4 + (idx & 1)) * d.G + (idx >> 1), u); }
        return false;
    }
    __device__ __forceinline__ const char* a_base(const Unit& u) const { return d.a_base(u); }
    __device__ __forceinline__ const char* b_base(const Unit& u) const { return d.b_base(u); }
    __device__ __forceinline__ void a_offs(const Unit& u, const int (&R)[2], const int (&Cc)[2], unsigned (&vo)[2][2]) const { d.a_offs(u, R, Cc, vo); }
};
template <bool GATHER, int NT, int RB>
struct MoeOrder {
    const char* A; const char* Bt; const int* tok; const int* cnt; const LAS int* tab; int G, c;
    __device__ __forceinline__ bool next(int i, Unit& u) const {
        const int L = i * G + c; if (L >= __builtin_amdgcn_readfirstlane(tab[32])) return false;
        int e = 0;
#pragma unroll 1
        for (int j = 1; j < 32; ++j) e += (__builtin_amdgcn_readfirstlane(tab[j]) <= L) ? 1 : 0;
        const int j = L - __builtin_amdgcn_readfirstlane(tab[e]), mt = __builtin_amdgcn_readfirstlane(tab[33 + e]), per = mt * 4, ntg = j / per, r = j - ntg * per;
        u.e = e; u.pm = r >> 2; u.pn = ntg * 4 + (r & 3); u.kind = __builtin_amdgcn_readfirstlane(tab[65 + e]) + 256 * u.pm;
        return true;
    }
    __device__ __forceinline__ const char* a_base(const Unit& u) const { return GATHER ? A : A + (size_t)u.kind * RB; }
    __device__ __forceinline__ const char* b_base(const Unit& u) const { return Bt + ((size_t)u.e * NT + u.pn) * (256 * RB); }
    __device__ __forceinline__ void a_offs(const Unit& u, const int (&R)[2], const int (&Cc)[2], unsigned (&vo)[2][2]) const {
#pragma unroll
        for (int h = 0; h < 2; ++h)
#pragma unroll
            for (int i = 0; i < 2; ++i) {
                if constexpr (GATHER) { const int n_e = __builtin_amdgcn_readfirstlane(tab[97 + u.e]); int ri = 256 * u.pm + h * 128 + R[i]; ri = ri < n_e ? ri : n_e - 1;
                    const int row = tok[u.e * CAP + ri]; vo[h][i] = (unsigned)(row * RB + Cc[i] * 2); }
                else vo[h][i] = (unsigned)((h * 128 + R[i]) * RB + Cc[i] * 2);
            }
    }
};

struct EpiInProj {
    static constexpr bool PERM = true, MID = false, FP8 = false, ASM_MFMA = false; static constexpr int SCALE_A = 0x7f, SCALE_B = 0x7f;
    bf16* QKV; bf16* Gt; bf16* MKV; int noop; const float* gk_fox; const float* gk_swa; const float* rope;
    __device__ __forceinline__ void mid(pg8::f32x4 (&)[2][2][4][2], const Unit&, int, int, int, int, int) const {}
    __device__ __forceinline__ void operator()(const pg8::f32x4 (&acc)[2][2][4][2], const Unit& u, int wr, int wc, int fr, int fq) const {
        asm volatile("" : "+v"(fr), "+v"(fq));
        if (noop) return;
        if (!u.kind && (u.pn == 3 || u.pn == 4 || u.pn == 5 || u.pn == 12)) {
            const bool swa = (u.pn == 12); const float* gp = (swa ? gk_swa : gk_fox) + 8 * fq;
            float gn[2][8];
#pragma unroll
            for (int bj = 0; bj < 2; ++bj) { const pg8::f32x4 a = *(const pg8::f32x4*)(gp + 32 * bj), b = *(const pg8::f32x4*)(gp + 32 * bj + 4);
                gn[bj][0] = a[0]; gn[bj][1] = a[1]; gn[bj][2] = a[2]; gn[bj][3] = a[3]; gn[bj][4] = b[0]; gn[bj][5] = b[1]; gn[bj][6] = b[2]; gn[bj][7] = b[3]; }
#pragma unroll
            for (int ai = 0; ai < 2; ++ai)
#pragma unroll
                for (int m = 0; m < 4; ++m) { const int row = u.pm * 256 + wr * 64 + fr + ai * 128 + m * 16;
                    float x[2][8]; float ss = 0.f;
#pragma unroll
                    for (int bj = 0; bj < 2; ++bj)
#pragma unroll
                        for (int n = 0; n < 2; ++n)
#pragma unroll
                            for (int e = 0; e < 4; ++e) { const float v = acc[ai][bj][m][n][e]; x[bj][4 * n + e] = v; ss += v * v; }
                    ss += __shfl_xor(ss, 16); ss += __shfl_xor(ss, 32);
                    const float rstd = 1.0f / sqrtf(ss * (1.f / 64.f) + NORM_EPS);
#pragma unroll
                    for (int bj = 0; bj < 2; ++bj)
#pragma unroll
                        for (int q = 0; q < 8; ++q) x[bj][q] = (x[bj][q] * rstd) * gn[bj][q];
                    if (swa) { const float* cs = rope + (size_t)row * 64 + 8 * fq;
                        const pg8::f32x4 c0 = *(const pg8::f32x4*)cs, c1 = *(const pg8::f32x4*)(cs + 4), s0 = *(const pg8::f32x4*)(cs + 32), s1 = *(const pg8::f32x4*)(cs + 36);
                        const float cc[8] = {c0[0], c0[1], c0[2], c0[3], c1[0], c1[1], c1[2], c1[3]}, sn[8] = {s0[0], s0[1], s0[2], s0[3], s1[0], s1[1], s1[2], s1[3]};
#pragma unroll
                        for (int q = 0; q < 8; ++q) { const float x1 = x[0][q], x2 = x[1][q]; x[0][q] = x1 * cc[q] - x2 * sn[q]; x[1][q] = x2 * cc[q] + x1 * sn[q]; } }
                    bf16* rowp = QKV + (size_t)row * QKVW + u.pn * 256 + 64 * wc + 8 * fq;
#pragma unroll
                    for (int bj = 0; bj < 2; ++bj) { u32x4 w; w.x = cvt_pk_bf16(x[bj][0], x[bj][1]); w.y = cvt_pk_bf16(x[bj][2], x[bj][3]); w.z = cvt_pk_bf16(x[bj][4], x[bj][5]); w.w = cvt_pk_bf16(x[bj][6], x[bj][7]);
                        *(u32x4*)(rowp + 32 * bj) = w; } }
            return;
        }
        const int row0 = u.pm * 256 + wr * 64 + fr;
        bf16* base; int ldc, colt; bool sg = false;
        if (u.kind) { base = MKV; ldc = 1024; colt = u.pn * 256; }
        else if (u.pn < 16) { base = QKV; ldc = QKVW; colt = u.pn * 256; }
        else { base = Gt; ldc = GW; colt = (u.pn - 16) * 256; sg = true; }
        const int col0 = colt + wc * 32 + 8 * fq;
#pragma unroll
        for (int ai = 0; ai < 2; ++ai)
#pragma unroll
            for (int m = 0; m < 4; ++m) { bf16* rowp = base + (size_t)(row0 + ai * 128 + m * 16) * ldc + col0;
#pragma unroll
                for (int bj = 0; bj < 2; ++bj) { pg8::f32x4 v0 = acc[ai][bj][m][0], v1 = acc[ai][bj][m][1];
                    if (sg) {
#pragma unroll
                        for (int q = 0; q < 4; ++q) { v0[q] = sigmoidf_(fmaxf(v0[q], -30.f)); v1[q] = sigmoidf_(fmaxf(v1[q], -30.f)); } }
                    u32x4 w; w.x = cvt_pk_bf16(v0[0], v0[1]); w.y = cvt_pk_bf16(v0[2], v0[3]); w.z = cvt_pk_bf16(v1[0], v1[1]); w.w = cvt_pk_bf16(v1[2], v1[3]);
                    *(u32x4*)(rowp + bj * 128) = w; } }
    }
};
#ifndef PROBE_GASM
#define PROBE_GASM true
#endif
struct EpiGates {
    static constexpr bool PERM = true, MID = false, FP8 = true, ASM_MFMA = PROBE_GASM; static constexpr int SCALE_A = 127 - H8_SHIFT, SCALE_B = 127 - W8_SHIFT;
    bf16* Gt;
    __device__ __forceinline__ void mid(pg8::f32x4 (&)[2][2][4][2], const Unit&, int, int, int, int, int) const {}
    __device__ __forceinline__ void operator()(const pg8::f32x4 (&acc)[2][2][4][2], const Unit& u, int wr, int wc, int fr, int fq) const {
        asm volatile("" : "+v"(fr), "+v"(fq));
        const int row0 = u.pm * 256 + wr * 64 + fr, col0 = u.pn * 256 + wc * 32 + 8 * fq;
#pragma unroll
        for (int ai = 0; ai < 2; ++ai)
#pragma unroll
            for (int m = 0; m < 4; ++m) { bf16* rowp = Gt + (size_t)(row0 + ai * 128 + m * 16) * GW + col0;
#pragma unroll
                for (int bj = 0; bj < 2; ++bj) { unsigned wv[4];
#pragma unroll
                    for (int n = 0; n < 2; ++n)
#pragma unroll
                        for (int hq = 0; hq < 2; ++hq) { typedef pg8::f32x2 f2;
                            f2 x = {fmaxf(acc[ai][bj][m][n][2 * hq], -30.f), fmaxf(acc[ai][bj][m][n][2 * hq + 1], -30.f)};
                            const f2 t = x * (-LOG2E); f2 e; e.x = __builtin_amdgcn_exp2f(t.x); e.y = __builtin_amdgcn_exp2f(t.y);
                            const f2 d = e + 1.0f; wv[2 * n + hq] = cvt_pk_bf16(__builtin_amdgcn_rcpf(d.x), __builtin_amdgcn_rcpf(d.y)); }
                    u32x4 w; w.x = wv[0]; w.y = wv[1]; w.z = wv[2]; w.w = wv[3];
                    *(u32x4*)(rowp + bj * 128) = w; } }
    }
};
struct EpiMerge {
    static constexpr bool PERM = true, MID = true, FP8 = false, ASM_MFMA = false; static constexpr int SCALE_A = 0x7f, SCALE_B = 0x7f;
    const bf16* Gt; bf16* O;
    __device__ __forceinline__ void mid(pg8::f32x4 (&acc)[2][2][4][2], const Unit& u, int which, int wr, int wc, int fr, int fq) const {
        asm volatile("" : "+v"(fr), "+v"(fq));
        const int row0 = u.pm * 256 + wr * 64 + fr, col0 = u.pn * 256 + wc * 32 + 8 * fq;
        const bf16* gn = Gt + (which ? 2048 : 0); const bf16* gd = Gt + (which ? 4096 : 2048);
#pragma unroll
        for (int ai = 0; ai < 2; ++ai)
#pragma unroll
            for (int m = 0; m < 4; ++m) { const size_t ro = (size_t)(row0 + ai * 128 + m * 16) * GW + col0;
#pragma unroll
                for (int bj = 0; bj < 2; ++bj) { const u32x4 a = *(const u32x4*)(gn + ro + bj * 128), b = *(const u32x4*)(gd + ro + bj * 128);
                    pg8::f32x4 r0, r1;
                    r0[0] = bf_lo(a.x) * __builtin_amdgcn_rcpf(bf_lo(b.x)); r0[1] = bf_hi(a.x) * __builtin_amdgcn_rcpf(bf_hi(b.x)); r0[2] = bf_lo(a.y) * __builtin_amdgcn_rcpf(bf_lo(b.y)); r0[3] = bf_hi(a.y) * __builtin_amdgcn_rcpf(bf_hi(b.y));
                    r1[0] = bf_lo(a.z) * __builtin_amdgcn_rcpf(bf_lo(b.z)); r1[1] = bf_hi(a.z) * __builtin_amdgcn_rcpf(bf_hi(b.z)); r1[2] = bf_lo(a.w) * __builtin_amdgcn_rcpf(bf_lo(b.w)); r1[3] = bf_hi(a.w) * __builtin_amdgcn_rcpf(bf_hi(b.w));
                    acc[ai][bj][m][0] *= r0; acc[ai][bj][m][1] *= r1; }
                asm volatile("" : "+v"(acc[ai][0][m][0]), "+v"(acc[ai][0][m][1]), "+v"(acc[ai][1][m][0]), "+v"(acc[ai][1][m][1]));
                asm volatile("" ::: "memory"); }
    }
    __device__ __forceinline__ void operator()(const pg8::f32x4 (&acc)[2][2][4][2], const Unit& u, int wr, int wc, int fr, int fq) const {
        asm volatile("" : "+v"(fr), "+v"(fq));
        const int row0 = u.pm * 256 + wr * 64 + fr, col0 = u.pn * 256 + wc * 32 + 8 * fq;
#pragma unroll
        for (int ai = 0; ai < 2; ++ai)
#pragma unroll
            for (int m = 0; m < 4; ++m) { const size_t rr = (size_t)(row0 + ai * 128 + m * 16);
#pragma unroll
                for (int bj = 0; bj < 2; ++bj) { const u32x4 g = *(const u32x4*)(Gt + rr * GW + 4096 + col0 + bj * 128);
                    const pg8::f32x4 v0 = acc[ai][bj][m][0], v1 = acc[ai][bj][m][1];
                    u32x4 w; w.x = cvt_pk_bf16(v0[0] * bf_lo(g.x), v0[1] * bf_hi(g.x)); w.y = cvt_pk_bf16(v0[2] * bf_lo(g.y), v0[3] * bf_hi(g.y));
                    w.z = cvt_pk_bf16(v1[0] * bf_lo(g.z), v1[1] * bf_hi(g.z)); w.w = cvt_pk_bf16(v1[2] * bf_lo(g.w), v1[3] * bf_hi(g.w));
                    *(u32x4*)(O + rr * DM + col0 + bj * 128) = w; }
                asm volatile("" ::: "memory"); }
    }
};
struct EpiOut {
    static constexpr bool PERM = true, MID = false, FP8 = false, ASM_MFMA = false; static constexpr int SCALE_A = 0x7f, SCALE_B = 0x7f;
    const float* X; float* out; unsigned char* HB8; int noop;
    __device__ __forceinline__ void mid(pg8::f32x4 (&)[2][2][4][2], const Unit&, int, int, int, int, int) const {}
    __device__ __forceinline__ void operator()(const pg8::f32x4 (&acc)[2][2][4][2], const Unit& u, int wr, int wc, int fr, int fq) const {
        asm volatile("" : "+v"(fr), "+v"(fq));
        if (noop) return;
        const int row0 = u.pm * 256 + wr * 64 + fr, col0 = u.pn * 256 + wc * 32 + 8 * fq;
#pragma unroll
        for (int ai = 0; ai < 2; ++ai)
#pragma unroll
            for (int mp = 0; mp < 2; ++mp) {
                pg8::f32x4 xv[2][2][2];
#pragma unroll
                for (int mm = 0; mm < 2; ++mm) { const size_t off = (size_t)(row0 + ai * 128 + (2 * mp + mm) * 16) * DM + col0;
#pragma unroll
                    for (int bj = 0; bj < 2; ++bj) { xv[mm][bj][0] = *(const pg8::f32x4*)(X + off + bj * 128); xv[mm][bj][1] = *(const pg8::f32x4*)(X + off + bj * 128 + 4); } }
#pragma unroll
                for (int mm = 0; mm < 2; ++mm) { const int m = 2 * mp + mm; const size_t off = (size_t)(row0 + ai * 128 + m * 16) * DM + col0;
#pragma unroll
                    for (int bj = 0; bj < 2; ++bj) { const pg8::f32x4 h0 = xv[mm][bj][0] + acc[ai][bj][m][0], h1 = xv[mm][bj][1] + acc[ai][bj][m][1];
                        *(pg8::f32x4*)(out + off + bj * 128) = h0; *(pg8::f32x4*)(out + off + bj * 128 + 4) = h1;
                        u32x2 w; w.x = pk4_fp8(h0[0] * H8_MUL, h0[1] * H8_MUL, h0[2] * H8_MUL, h0[3] * H8_MUL); w.y = pk4_fp8(h1[0] * H8_MUL, h1[1] * H8_MUL, h1[2] * H8_MUL, h1[3] * H8_MUL);
                        *(u32x2*)(HB8 + off + bj * 128) = w; } }
                asm volatile("" ::: "memory");
            }
    }
};
struct EpiGateUp {
    static constexpr bool PERM = true, MID = false, FP8 = true, ASM_MFMA = true; static constexpr int SCALE_A = 127 - H8_SHIFT, SCALE_B = 127 - W8_SHIFT;
    const float* RS; const float* bgu; unsigned char* ACT8;
    __device__ __forceinline__ void mid(pg8::f32x4 (&)[2][2][4][2], const Unit&, int, int, int, int, int) const {}
    __device__ __forceinline__ void operator()(const pg8::f32x4 (&acc)[2][2][4][2], const Unit& u, int wr, int wc, int fr, int fq) const {
        asm volatile("" : "+v"(fr), "+v"(fq));
        const int r0 = wr * 64 + fr, hc0 = u.pn * 128 + wc * 32 + 8 * fq;
        const float* bg = bgu + (size_t)u.e * 4096 + hc0;
        const pg8::f32x4 bg0 = *(const pg8::f32x4*)(bg), bg1 = *(const pg8::f32x4*)(bg + 4), bu0 = *(const pg8::f32x4*)(bg + 2048), bu1 = *(const pg8::f32x4*)(bg + 2052);
        float rsv[2][4];
#pragma unroll
        for (int ai = 0; ai < 2; ++ai)
#pragma unroll
            for (int m = 0; m < 4; ++m) rsv[ai][m] = RS[u.e * CAP + 256 * u.pm + r0 + ai * 128 + m * 16];
#pragma unroll
        for (int ai = 0; ai < 2; ++ai)
#pragma unroll
            for (int m = 0; m < 4; ++m) { const int rl = r0 + ai * 128 + m * 16;
                const float rs = rsv[ai][m];
                typedef pg8::f32x2 f2;
                f2 a2[4];
#pragma unroll
                for (int n = 0; n < 2; ++n)
#pragma unroll
                    for (int hq = 0; hq < 2; ++hq) {
                        const f2 ag = {acc[ai][0][m][n][2 * hq], acc[ai][0][m][n][2 * hq + 1]}, au = {acc[ai][1][m][n][2 * hq], acc[ai][1][m][n][2 * hq + 1]};
                        const f2 bgv = n ? (f2){bg1[2 * hq], bg1[2 * hq + 1]} : (f2){bg0[2 * hq], bg0[2 * hq + 1]}, buv = n ? (f2){bu1[2 * hq], bu1[2 * hq + 1]} : (f2){bu0[2 * hq], bu0[2 * hq + 1]};
                        f2 g = ag * rs + bgv, up = au * rs + buv;
                        g.x = fminf(g.x, SWIGLU_LIMIT); g.y = fminf(g.y, SWIGLU_LIMIT);
                        up.x = __builtin_amdgcn_fmed3f(up.x, -SWIGLU_LIMIT, SWIGLU_LIMIT); up.y = __builtin_amdgcn_fmed3f(up.y, -SWIGLU_LIMIT, SWIGLU_LIMIT);
                        const f2 t = g * (-SWIGLU_ALPHA * LOG2E);
                        f2 e; e.x = __builtin_amdgcn_exp2f(t.x); e.y = __builtin_amdgcn_exp2f(t.y);
                        const f2 d = e + 1.0f;
                        f2 r; r.x = __builtin_amdgcn_rcpf(d.x); r.y = __builtin_amdgcn_rcpf(d.y);
                        const f2 sg = (g * ACT8_MUL) * r;
                        a2[2 * n + hq] = up * sg + sg;
                    }
                u32x2 w;
                { int p0 = __builtin_amdgcn_cvt_pk_fp8_f32(a2[0].x, a2[0].y, 0, false); p0 = __builtin_amdgcn_cvt_pk_fp8_f32(a2[1].x, a2[1].y, p0, true); w.x = (unsigned)p0;
                  int p1 = __builtin_amdgcn_cvt_pk_fp8_f32(a2[2].x, a2[2].y, 0, false); p1 = __builtin_amdgcn_cvt_pk_fp8_f32(a2[3].x, a2[3].y, p1, true); w.y = (unsigned)p1; }
                *(u32x2*)(ACT8 + (size_t)(u.kind + rl) * DM + hc0) = w; }
    }
};
struct EpiDown {
    static constexpr bool PERM = true, MID = false, FP8 = true, ASM_MFMA = true; static constexpr int SCALE_A = 127 - ACT8_SHIFT, SCALE_B = 127 - W8_SHIFT;
    const float* bd; bf16* Y;
    __device__ __forceinline__ void mid(pg8::f32x4 (&)[2][2][4][2], const Unit&, int, int, int, int, int) const {}
    __device__ __forceinline__ void operator()(const pg8::f32x4 (&acc)[2][2][4][2], const Unit& u, int wr, int wc, int fr, int fq) const {
        asm volatile("" : "+v"(fr), "+v"(fq));
        const int r0 = wr * 64 + fr, col0 = u.pn * 256 + wc * 32 + 8 * fq;
        const float* bb = bd + (size_t)u.e * DM + col0;
        pg8::f32x4 bv[2][2];
#pragma unroll
        for (int bj = 0; bj < 2; ++bj)
#pragma unroll
            for (int n = 0; n < 2; ++n) bv[bj][n] = *(const pg8::f32x4*)(bb + bj * 128 + n * 4);
#pragma unroll
        for (int ai = 0; ai < 2; ++ai)
#pragma unroll
            for (int m = 0; m < 4; ++m) { bf16* rowp = Y + (size_t)(u.kind + r0 + ai * 128 + m * 16) * DM + col0;
#pragma unroll
                for (int bj = 0; bj < 2; ++bj) { const pg8::f32x4 v0 = acc[ai][bj][m][0] + bv[bj][0], v1 = acc[ai][bj][m][1] + bv[bj][1];
                    u32x4 w; w.x = cvt_pk_bf16(v0[0], v0[1]); w.y = cvt_pk_bf16(v0[2], v0[3]); w.z = cvt_pk_bf16(v1[0], v1[1]); w.w = cvt_pk_bf16(v1[2], v1[3]);
                    *(u32x4*)(rowp + bj * 128) = w; } }
    }
};

__device__ __forceinline__ void logf_cumsum(const Ctx& C) {
    LAS float* wt = (LAS float*)(C.lds + RING_OFF);
    for (int sq = (int)blockIdx.x; sq < BATCH * 12; sq += C.G) {
        const float* src = C.LOGF + (size_t)sq * SEQ + C.tid * 16; float* dst = C.CNEG + (size_t)sq * SEQ + C.tid * 16;
        f32x4 a[4]; float tot = 0.f;
#pragma unroll
        for (int j = 0; j < 4; ++j) { a[j] = *(const GAS f32x4*)(src + 4 * j); tot += (a[j].x + a[j].y) + (a[j].z + a[j].w); }
        float incl = tot;
#pragma unroll
        for (int o = 1; o < 64; o <<= 1) { const float n = __shfl_up(incl, o); if (C.lane >= o) incl += n; }
        if (C.lane == 63) wt[C.wave] = incl;
        __syncthreads();
        float run = incl - tot;
        for (int w = 0; w < C.wave; ++w) run += wt[w];
#pragma unroll
        for (int j = 0; j < 4; ++j) { f32x4 c; run += a[j].x; c.x = -run * LOG2E; run += a[j].y; c.y = -run * LOG2E; run += a[j].z; c.z = -run * LOG2E; run += a[j].w; c.w = -run * LOG2E; *(GAS f32x4*)(dst + 4 * j) = c; }
        __syncthreads();
    }
}

namespace att {
typedef __attribute__((address_space(3))) const char* lds_cptr;
__device__ __forceinline__ void glds16(const void* gsrc, unsigned lds_dst) { unsigned keep;
    asm volatile("s_mov_b32 %0, m0\n\ts_mov_b32 m0, %2\n\ts_nop 0\n\tglobal_load_lds_dwordx4 %1, off\n\ts_mov_b32 m0, %0" : "=&s"(keep) : "v"(gsrc), "s"(lds_dst) : "memory"); }
typedef float f32x2_t __attribute__((ext_vector_type(2))); typedef __bf16 bf16x2_t __attribute__((ext_vector_type(2)));
__device__ __forceinline__ unsigned cvtpk_s(float lo, float hi) { f32x2_t v = {lo, hi}; bf16x2_t b = __builtin_convertvector(v, bf16x2_t); return __builtin_bit_cast(unsigned, b); }
__device__ __forceinline__ int crow(int r, int hi) { return (r & 3) + 8 * (r >> 2) + 4 * hi; }

template <int D> struct Geo {
    static constexpr int SLOTB = 64 * D * 2, NSLOT = (D == 64) ? 3 : 2, PPT = (D == 64) ? 2 : 4;
    static constexpr int LDS_K = 0, LDS_V = NSLOT * SLOTB, LDS_WS = 2 * NSLOT * SLOTB, LDS_WMIN = LDS_WS + 2048, LDS_OST = LDS_WMIN + 64, LDS_CB = LDS_OST + 8 * 4096, LDS_END = LDS_CB + 32768;
};

template <int D>
__device__ __forceinline__ void qkt(f32x16& p0, f32x16& p1, lds_cptr Kslot, const bf16x8* qr, int r32, int hi) {
    lds_cptr kb = Kslot + hi * 1024 + r32 * 16;
    p0 = f32x16{}; p1 = f32x16{};
#pragma unroll
    for (int d0 = 0; d0 < D / 16; ++d0) {
        const bf16x8 b0 = *(const LAS bf16x8*)(kb + d0 * 2048);
        const bf16x8 b1 = *(const LAS bf16x8*)(kb + d0 * 2048 + 512);
        p0 = __builtin_amdgcn_mfma_f32_32x32x16_bf16(b0, qr[d0], p0, 0, 0, 0); p1 = __builtin_amdgcn_mfma_f32_32x32x16_bf16(b1, qr[d0], p1, 0, 0, 0); }
}
template <int D>
__device__ __forceinline__ void pv(f32x16* o, int vb, bf16x8 pa0, bf16x8 pa1, bf16x8 pa2, bf16x8 pa3) {
#pragma unroll
    for (int d0 = 0; d0 < D / 32; ++d0) { s16x4 lo[4], hi[4];
#pragma unroll
        for (int ks = 0; ks < 4; ++ks) {
            asm volatile("ds_read_b64_tr_b16 %0,%1 offset:%c2" : "=&v"(lo[ks]) : "v"(vb), "i"(d0 * 4096 + ks * 1024) : "memory");
            asm volatile("ds_read_b64_tr_b16 %0,%1 offset:%c2" : "=&v"(hi[ks]) : "v"(vb), "i"(d0 * 4096 + ks * 1024 + 512) : "memory"); }
        asm volatile("s_waitcnt lgkmcnt(0)" ::: "memory"); __builtin_amdgcn_sched_barrier(0);
#define ATT_PK(k) (bf16x8){lo[k][0], lo[k][1], lo[k][2], lo[k][3], hi[k][0], hi[k][1], hi[k][2], hi[k][3]}
        o[d0] = __builtin_amdgcn_mfma_f32_32x32x16_bf16(pa0, ATT_PK(0), o[d0], 0, 0, 0);
        o[d0] = __builtin_amdgcn_mfma_f32_32x32x16_bf16(pa1, ATT_PK(1), o[d0], 0, 0, 0);
        o[d0] = __builtin_amdgcn_mfma_f32_32x32x16_bf16(pa2, ATT_PK(2), o[d0], 0, 0, 0);
        o[d0] = __builtin_amdgcn_mfma_f32_32x32x16_bf16(pa3, ATT_PK(3), o[d0], 0, 0, 0);
#undef ATT_PK
    }
}

template <int D, int MODE>
__device__ __forceinline__ void attn_unit(LAS unsigned char* shm, const bf16* Q, int pitchQ, const bf16* K, const bf16* V, int pitchKV, bf16* O, const float* cneg, float sink2, int qb, const float* qgain, const float* kgain, const float* ropet, float bqk = 0.f) {
    typedef Geo<D> G;
    int tid = threadIdx.x; asm volatile("" : "+v"(tid));
    const int lane = tid & 63, r32 = lane & 31, hi = lane >> 5; const int wid = __builtin_amdgcn_readfirstlane(tid >> 6);
    const int q0 = qb * 256, q0w = q0 + wid * 32;
    const unsigned lds0 = (unsigned)(uintptr_t)shm;
    LAS float* wsf = (LAS float*)(shm + G::LDS_WS) + wid * 64;
    LAS float* cb = (LAS float*)(shm + G::LDS_CB);
    const int j_lo = (MODE == 1) ? (qb > 0 ? 4 * qb - 2 : 0) : 0, j_hi = (MODE == 2) ? 4 : 4 * qb + 4;
    bf16x8 qr[D / 16];
    { const bf16* Qw = Q + (size_t)(q0w + r32) * pitchQ + hi * 8;
#pragma unroll
      for (int d0 = 0; d0 < D / 16; ++d0) qr[d0] = *(const GAS bf16x8*)(Qw + d0 * 16); }
    {
#define ATT_UNPK(dst, src) do { const v4u w_ = __builtin_bit_cast(v4u, src); dst[0] = pg8::bf_lo(w_.x); dst[1] = pg8::bf_hi(w_.x); dst[2] = pg8::bf_lo(w_.y); dst[3] = pg8::bf_hi(w_.y); dst[4] = pg8::bf_lo(w_.z); dst[5] = pg8::bf_hi(w_.z); dst[6] = pg8::bf_lo(w_.w); dst[7] = pg8::bf_hi(w_.w); } while (0)
#define ATT_PK8(dst, src) do { v4u w_; w_.x = cvtpk_s(src[0], src[1]); w_.y = cvtpk_s(src[2], src[3]); w_.z = cvtpk_s(src[4], src[5]); w_.w = cvtpk_s(src[6], src[7]); dst = __builtin_bit_cast(bf16x8, w_); } while (0)
        float ss = 0.f;
#pragma unroll
        for (int d0 = 0; d0 < D / 16; ++d0) { float t[8]; ATT_UNPK(t, qr[d0]);
#pragma unroll
            for (int j = 0; j < 8; ++j) ss += t[j] * t[j]; }
        { auto rr = __builtin_amdgcn_permlane32_swap(__float_as_uint(ss), __float_as_uint(ss), false, false); ss = __uint_as_float(rr[0]) + __uint_as_float(rr[1]); }
        const float rq = (1.0f / sqrtf(ss * (1.f / D) + NORM_EPS)) * ((D == 64 ? 0.125f : 0.08838834764831845f) * LOG2E);
        if constexpr (MODE == 1) {
            const float* cs = ropet + (size_t)(q0w + r32) * 64 + 8 * hi;
#pragma unroll
            for (int d0 = 0; d0 < 2; ++d0) { float x1[8], x2[8]; ATT_UNPK(x1, qr[d0]); ATT_UNPK(x2, qr[d0 + 2]);
                const float* g1 = qgain + 16 * d0 + 8 * hi;
                const f32x4 ga = *(const GAS f32x4*)g1, gb = *(const GAS f32x4*)(g1 + 4), gc = *(const GAS f32x4*)(g1 + 32), gd = *(const GAS f32x4*)(g1 + 36);
                const f32x4 c0 = *(const GAS f32x4*)(cs + 16 * d0), c1 = *(const GAS f32x4*)(cs + 16 * d0 + 4), s0 = *(const GAS f32x4*)(cs + 32 + 16 * d0), s1 = *(const GAS f32x4*)(cs + 36 + 16 * d0);
                const float gg1[8] = {ga.x, ga.y, ga.z, ga.w, gb.x, gb.y, gb.z, gb.w}, gg2[8] = {gc.x, gc.y, gc.z, gc.w, gd.x, gd.y, gd.z, gd.w};
                const float cc[8] = {c0.x, c0.y, c0.z, c0.w, c1.x, c1.y, c1.z, c1.w}, sn[8] = {s0.x, s0.y, s0.z, s0.w, s1.x, s1.y, s1.z, s1.w};
#pragma unroll
                for (int j = 0; j < 8; ++j) { const float a = (x1[j] * rq) * gg1[j], b = (x2[j] * rq) * gg2[j]; x1[j] = a * cc[j] - b * sn[j]; x2[j] = b * cc[j] + a * sn[j]; }
                ATT_PK8(qr[d0], x1); ATT_PK8(qr[d0 + 2], x2); asm volatile("" ::: "memory"); }
        } else {
#pragma unroll
            for (int d0 = 0; d0 < D / 16; ++d0) { float t[8]; ATT_UNPK(t, qr[d0]);
                const float* gp = qgain + 16 * d0 + 8 * hi; f32x4 ga = *(const GAS f32x4*)gp, gb = *(const GAS f32x4*)(gp + 4);
                if constexpr (MODE == 2) { ga = ga * *(const GAS f32x4*)(kgain + 16 * d0 + 8 * hi); gb = gb * *(const GAS f32x4*)(kgain + 16 * d0 + 8 * hi + 4); }
                t[0] = (t[0] * rq) * ga.x; t[1] = (t[1] * rq) * ga.y; t[2] = (t[2] * rq) * ga.z; t[3] = (t[3] * rq) * ga.w; t[4] = (t[4] * rq) * gb.x; t[5] = (t[5] * rq) * gb.y; t[6] = (t[6] * rq) * gb.z; t[7] = (t[7] * rq) * gb.w;
                ATT_PK8(qr[d0], t); asm volatile("" ::: "memory"); }
        }
#undef ATT_UNPK
#undef ATT_PK8
    }
    if constexpr (MODE == 2) {
        const int key = tid >> 1, hf = tid & 1; const bf16* kp = K + (size_t)key * pitchKV + 64 * hf; float ss = 0.f;
#pragma unroll
        for (int c = 0; c < 8; ++c) { const v4u w = *(const GAS v4u*)(kp + 8 * c); const float a0 = pg8::bf_lo(w.x), a1 = pg8::bf_hi(w.x), a2 = pg8::bf_lo(w.y), a3 = pg8::bf_hi(w.y), a4 = pg8::bf_lo(w.z), a5 = pg8::bf_hi(w.z), a6 = pg8::bf_lo(w.w), a7 = pg8::bf_hi(w.w);
            ss += (a0 * a0 + a1 * a1) + (a2 * a2 + a3 * a3) + (a4 * a4 + a5 * a5) + (a6 * a6 + a7 * a7); }
        ss += __shfl_xor(ss, 1);
        if (hf == 0) cb[key] = 1.0f / sqrtf(ss * (1.f / 128.f) + NORM_EPS);
    }
    if constexpr (MODE == 0) {
        const int nch = (q0 + 256) / 4;
        for (int c = tid; c < nch; c += 512) { const f32x4 v = *(const GAS f32x4*)(cneg + 4 * c); *(LAS f32x4*)(cb + 4 * c) = v; }
    }
#define ATT_DMA(j, slot) do { const int _s = (slot) * G::SLOTB; \
        if constexpr (D == 64) { \
            glds16(K + (size_t)(64 * (j) + lane) * pitchKV + wid * 8, (unsigned)__builtin_amdgcn_readfirstlane(lds0 + G::LDS_K + _s + wid * 1024)); \
            glds16(V + (size_t)(64 * (j) + 16 * (wid & 3) + (lane >> 2)) * pitchKV + (wid >> 2) * 32 + (lane & 3) * 8, (unsigned)__builtin_amdgcn_readfirstlane(lds0 + G::LDS_V + _s + wid * 1024)); \
        } else { \
            _Pragma("unroll") for (int _p = 0; _p < 2; ++_p) { const int _c = wid + 8 * _p; \
                glds16(K + (size_t)(64 * (j) + lane) * pitchKV + _c * 8, (unsigned)__builtin_amdgcn_readfirstlane(lds0 + G::LDS_K + _s + _c * 1024)); } \
            _Pragma("unroll") for (int _p = 0; _p < 2; ++_p) { const int _c = wid + 8 * _p; \
                glds16(V + (size_t)(64 * (j) + 16 * (_c & 3) + (lane >> 2)) * pitchKV + (_c >> 2) * 32 + (lane & 3) * 8, (unsigned)__builtin_amdgcn_readfirstlane(lds0 + G::LDS_V + _s + _c * 1024)); } \
        } } while (0)
    int slot_i = 0;
    constexpr bool REV = (MODE == 0);
    const int nst = j_hi - j_lo;
#define ATT_TILE(st_) (REV ? (j_hi - 1 - (st_)) : (j_lo + (st_)))
#pragma unroll
    for (int p = 0; p < G::NSLOT - 1; ++p) if (p < nst) ATT_DMA(ATT_TILE(p), p);
    float mhat = -1e30f, l_reg = 0.f; f32x16 o[D / 32];
#pragma unroll
    for (int d0 = 0; d0 < D / 32; ++d0) o[d0] = f32x16{};
    const lds_cptr shm3 = (lds_cptr)shm;
    const int vb0 = (int)(lds0 + G::LDS_V) + ((lane >> 4) & 1) * 32 + (lane & 3) * 8 + (4 * hi + ((lane & 15) >> 2)) * 64;
    const int qabs = q0w + r32;
    LAS float* wmin = (LAS float*)(shm + G::LDS_WMIN);
    for (int st = 0; st < nst; ++st) {
        const int j = ATT_TILE(st);
        if (G::NSLOT == 3 && st + 1 < nst) { if constexpr (G::PPT == 2) asm volatile("s_waitcnt vmcnt(2) lgkmcnt(0)\n\ts_barrier" ::: "memory"); else asm volatile("s_waitcnt vmcnt(4) lgkmcnt(0)\n\ts_barrier" ::: "memory"); }
        else asm volatile("s_waitcnt vmcnt(0) lgkmcnt(0)\n\ts_barrier" ::: "memory");
        if constexpr (MODE == 0) { if (st >= 5) {
            const LAS float* wm = wmin + ((st - 1) & 1) * 8; const f32x4 a = *(const LAS f32x4*)wm, b = *(const LAS f32x4*)(wm + 4);
            const float gmin = fminf(fminf(fminf(a.x, a.y), fminf(a.z, a.w)), fminf(fminf(b.x, b.y), fminf(b.z, b.w)));
            if (cb[64 * j + 63] + bqk < gmin - 40.0f) break; } }
        { const int sn_ = st + G::NSLOT - 1; if (sn_ < nst) { int sn = slot_i + G::NSLOT - 1; if (sn >= G::NSLOT) sn -= G::NSLOT; ATT_DMA(ATT_TILE(sn_), sn); } }
        bool need = true;
        if constexpr (MODE == 0) need = (64 * j <= q0w + 31);
        if constexpr (MODE == 1) need = (64 * j <= q0w + 31) && (64 * j + 63 >= q0w - 127);
        if (need) {
            f32x16 p0, p1;
            qkt<D>(p0, p1, shm3 + G::LDS_K + slot_i * G::SLOTB, qr, r32, hi);
            if constexpr (MODE == 2) {
                const LAS float* rkp = cb + 64 * j + 4 * hi;
#pragma unroll
                for (int g = 0; g < 4; ++g) { const f32x4 b0 = *(const LAS f32x4*)(rkp + 8 * g), b1 = *(const LAS f32x4*)(rkp + 32 + 8 * g);
#pragma unroll
                    for (int e = 0; e < 4; ++e) { p0[4 * g + e] *= b0[e]; p1[4 * g + e] *= b1[e]; } }
            }
            if constexpr (MODE == 0) {
                const LAS float* cbp = cb + 64 * j + 4 * hi;
#pragma unroll
                for (int g = 0; g < 4; ++g) { const f32x4 b0 = *(const LAS f32x4*)(cbp + 8 * g), b1 = *(const LAS f32x4*)(cbp + 32 + 8 * g);
#pragma unroll
                    for (int e = 0; e < 4; ++e) { p0[4 * g + e] += b0[e]; p1[4 * g + e] += b1[e]; } }
                if (64 * j + 63 > q0w) {
#pragma unroll
                    for (int r = 0; r < 16; ++r) { const int kv = 64 * j + crow(r, hi); if (kv > qabs) p0[r] = -INFINITY; if (kv + 32 > qabs) p1[r] = -INFINITY; } }
            }
            if constexpr (MODE == 1) {
#pragma unroll
                for (int r = 0; r < 16; ++r) { const int kv = 64 * j + crow(r, hi); const int d0_ = qabs - kv, d1_ = d0_ - 32;
                    if (d0_ < 0 || d0_ >= 128) p0[r] = -INFINITY; if (d1_ < 0 || d1_ >= 128) p1[r] = -INFINITY; }
            }
            float rm = fmaxf(p0[0], p1[0]);
#pragma unroll
            for (int r = 1; r < 16; ++r) rm = fmaxf(rm, fmaxf(p0[r], p1[r]));
            { auto rr = __builtin_amdgcn_permlane32_swap(__float_as_uint(rm), __float_as_uint(rm), false, false); rm = fmaxf(__uint_as_float(rr[0]), __uint_as_float(rr[1])); }
            if (__any(rm > mhat)) {
                const float mn = fmaxf(mhat, rm); const float f = __builtin_amdgcn_exp2f(mhat - mn); mhat = mn; l_reg *= f;
                if (hi == 0) wsf[r32] = f;
                asm volatile("s_waitcnt lgkmcnt(0)" ::: "memory");
#pragma unroll
                for (int g = 0; g < 4; ++g) { const f32x4 fv = *(const LAS f32x4*)(wsf + 8 * g + 4 * hi);
#pragma unroll
                    for (int d_ = 0; d_ < D / 32; ++d_)
#pragma unroll
                        for (int e = 0; e < 4; ++e) o[d_][4 * g + e] *= fv[e]; }
            }
            float sacc = 0.f;
#pragma unroll
            for (int r = 0; r < 16; ++r) { p0[r] = __builtin_amdgcn_exp2f(p0[r] - mhat); p1[r] = __builtin_amdgcn_exp2f(p1[r] - mhat); sacc += p0[r] + p1[r]; }
            l_reg += sacc;
            u32x4 pw0, pw1, pw2, pw3;
            pw0 = (u32x4){cvtpk_s(p0[0], p0[1]), cvtpk_s(p0[2], p0[3]), cvtpk_s(p0[4], p0[5]), cvtpk_s(p0[6], p0[7])};
            pw1 = (u32x4){cvtpk_s(p0[8], p0[9]), cvtpk_s(p0[10], p0[11]), cvtpk_s(p0[12], p0[13]), cvtpk_s(p0[14], p0[15])};
            pw2 = (u32x4){cvtpk_s(p1[0], p1[1]), cvtpk_s(p1[2], p1[3]), cvtpk_s(p1[4], p1[5]), cvtpk_s(p1[6], p1[7])};
            pw3 = (u32x4){cvtpk_s(p1[8], p1[9]), cvtpk_s(p1[10], p1[11]), cvtpk_s(p1[12], p1[13]), cvtpk_s(p1[14], p1[15])};
            pv<D>(o, vb0 + slot_i * G::SLOTB, __builtin_bit_cast(bf16x8, pw0), __builtin_bit_cast(bf16x8, pw1), __builtin_bit_cast(bf16x8, pw2), __builtin_bit_cast(bf16x8, pw3));
        }
        if constexpr (MODE == 0) { float mn = mhat;
#pragma unroll
            for (int of = 1; of < 32; of <<= 1) mn = fminf(mn, __shfl_xor(mn, of));
            if (lane == 0) wmin[(st & 1) * 8 + wid] = mn; }
        ++slot_i; if (slot_i == G::NSLOT) slot_i = 0;
    }
#undef ATT_DMA
#undef ATT_TILE
    if constexpr (MODE == 0) asm volatile("s_waitcnt vmcnt(0)" ::: "memory");
    { auto rr = __builtin_amdgcn_permlane32_swap(__float_as_uint(l_reg), __float_as_uint(l_reg), false, false); l_reg = __uint_as_float(rr[0]) + __uint_as_float(rr[1]); }
    if constexpr (MODE == 1) l_reg += __builtin_amdgcn_exp2f(sink2 - mhat);
    if (hi == 0) wsf[32 + r32] = l_reg;
    asm volatile("s_waitcnt lgkmcnt(0)" ::: "memory");
    float rli[16];
#pragma unroll
    for (int g = 0; g < 4; ++g) { const f32x4 lv = *(const LAS f32x4*)(wsf + 32 + 8 * g + 4 * hi);
#pragma unroll
        for (int e = 0; e < 4; ++e) rli[4 * g + e] = __builtin_amdgcn_rcpf(lv[e]); }
    bf16* Ow = O + (size_t)q0w * 2048;
    LAS bf16* stg = (LAS bf16*)(shm + G::LDS_OST) + wid * 2048;
#pragma unroll
    for (int ps = 0; ps < D / 64; ++ps) {
#pragma unroll
        for (int r = 0; r < 16; ++r) { const int orow = crow(r, hi);
#pragma unroll
            for (int dl = 0; dl < 2; ++dl) stg[orow * 64 + dl * 32 + r32] = (bf16)f2bf(o[2 * ps + dl][r] * rli[r]); }
        asm volatile("s_waitcnt lgkmcnt(0)" ::: "memory");
#pragma unroll
        for (int i = 0; i < 4; ++i) { const int row = i * 8 + (lane >> 3), ch = lane & 7; const v4u v = *(const LAS v4u*)(stg + row * 64 + ch * 8); *(GAS v4u*)(Ow + (size_t)row * 2048 + ps * 64 + ch * 8) = v; }
        asm volatile("s_waitcnt lgkmcnt(0)" ::: "memory");
    }
    asm volatile("s_waitcnt lgkmcnt(0)\n\ts_barrier" ::: "memory");
}
}

constexpr int NU_FOX = BATCH * 12 * 32, NU_SWA = BATCH * 12 * 32, NU_XM = BATCH * 4 * 32;
__device__ __forceinline__ int att_fetch(const Ctx& C, int q) {
    int v = 0; if (C.tid == 0) v = (int)__hip_atomic_fetch_add((unsigned*)(C.ctl + CW_QHEAD + 64 * q), 1u, RLX_AGENT); return v;
}
__device__ __forceinline__ void phase3(const Ctx& C, int sel = 0) {
    LAS unsigned char* shm = C.lds + RING_OFF;
    volatile LAS int* nxtw = (volatile LAS int*)(C.MISC + 12);
    if (sel == 0 || sel == 4) {
        float gq = fabsf(C.fox_q_norm[C.lane]), gk = fabsf(C.fox_k_norm[C.lane]);
#pragma unroll
        for (int of = 1; of < 64; of <<= 1) { gq = fmaxf(gq, __shfl_xor(gq, of)); gk = fmaxf(gk, __shfl_xor(gk, of)); }
        const float bqk = 64.0f * gq * gk * (0.125f * LOG2E) * 1.02f;
        int pre = att_fetch(C, 0);
        if (C.tid == 0) *nxtw = pre;
        __syncthreads();
        int cur = __builtin_amdgcn_readfirstlane(*nxtw);
        __syncthreads();
        while (cur < NU_FOX) {
            pre = att_fetch(C, 0);
            const int qb = 31 - cur / 24, bh = cur % 24, b = bh / 12, h = bh % 12;
            const bf16* base = C.QKV + (size_t)b * SEQ * QKVW + h * 64;
            att::attn_unit<64, 0>(shm, base + C_FQ, QKVW, base + C_FK, base + C_FV, QKVW, C.OALL + (size_t)b * SEQ * 2048 + h * 64, C.CNEG + (size_t)(b * 12 + h) * SEQ, 0.f, qb, C.fox_q_norm, nullptr, nullptr, bqk);
            if (C.tid == 0) *nxtw = pre;
            __syncthreads();
            cur = __builtin_amdgcn_readfirstlane(*nxtw);
            __syncthreads();
        }
    }
    if (sel == 0 || sel == 5) {
        int pre = att_fetch(C, 1);
        if (C.tid == 0) *nxtw = pre;
        __syncthreads();
        int cur = __builtin_amdgcn_readfirstlane(*nxtw);
        __syncthreads();
        while (cur < NU_SWA) {
            pre = att_fetch(C, 1);
            const int qb = cur / 24, bh = cur % 24, b = bh / 12, h = bh % 12, kvh = h / 3;
            const bf16* base = C.QKV + (size_t)b * SEQ * QKVW;
            att::attn_unit<64, 1>(shm, base + C_SQ + h * 64, QKVW, base + C_SK + kvh * 64, base + C_SV + kvh * 64, QKVW, C.OALL + (size_t)b * SEQ * 2048 + 768 + h * 64, nullptr, C.swa_sinks[h] * LOG2E, qb, C.swa_q_norm, nullptr, C.ROPE + (size_t)b * SEQ * 64);
            if (C.tid == 0) *nxtw = pre;
            __syncthreads();
            cur = __builtin_amdgcn_readfirstlane(*nxtw);
            __syncthreads();
        }
    }
    if (sel == 0 || sel == 6) {
        int pre = att_fetch(C, 2);
        if (C.tid == 0) *nxtw = pre;
        __syncthreads();
        int cur = __builtin_amdgcn_readfirstlane(*nxtw);
        __syncthreads();
        while (cur < NU_XM) {
            pre = att_fetch(C, 2);
            const int qb = cur / 8, bh = cur % 8, b = bh / 4, h = bh % 4;
            const bf16* kb = C.MKV + (size_t)b * NMEM * 1024 + h * 128;
            att::attn_unit<128, 2>(shm, C.QKV + (size_t)b * SEQ * QKVW + C_MQ + h * 128, QKVW, kb, kb + 512, 1024, C.OALL + (size_t)b * SEQ * 2048 + 1536 + h * 128, nullptr, 0.f, qb, C.xmem_q_norm, C.xmem_k_norm, nullptr);
            if (C.tid == 0) *nxtw = pre;
            __syncthreads();
            cur = __builtin_amdgcn_readfirstlane(*nxtw);
            __syncthreads();
        }
    }
}

__device__ __forceinline__ void phase6(const Ctx& C) {
    LAS float* PL = (LAS float*)(C.lds + RING_OFF);
    LAS float* SS = PL + 4 * 64 * 33;
    LAS int* hist = (LAS int*)(SS + 512);
    LAS int* gb = hist + 32;
    const int rg = C.wave & 1, kq = C.wave >> 1, r32 = C.lane & 31, hi = C.lane >> 5;
    const bf16* wh = C.Wr_t + (size_t)r32 * 2048 + 512 * kq + 16 * hi; const bf16* wl = wh + 32 * 2048;
    for (int blk = C.vcu; blk < T / 64; blk += C.G) {
        if (C.tid < 32) hist[C.tid] = 0;
        const int tok = blk * 64 + 32 * rg + r32;
        const float* hr = C.out + (size_t)tok * DM + 512 * kq + 16 * hi;
        f32x16 acc = f32x16{}; float ss = 0.f;
#pragma unroll 2
        for (int kb = 0; kb < 16; ++kb) {
            float f[16];
#pragma unroll
            for (int q = 0; q < 4; ++q) { const f32x4 t = *(const GAS f32x4*)(hr + 32 * kb + 4 * q); f[4 * q] = t.x; f[4 * q + 1] = t.y; f[4 * q + 2] = t.z; f[4 * q + 3] = t.w; }
            unsigned hb[16], lb[16];
#pragma unroll
            for (int q = 0; q < 16; ++q) { ss += f[q] * f[q]; hb[q] = f2bf(f[q]); lb[q] = f2bf(f[q] - __uint_as_float(hb[q] << 16)); }
#pragma unroll
            for (int s = 0; s < 2; ++s) {
                const bf16x8 ah = *(const GAS bf16x8*)(wh + 32 * kb + 8 * s), al = *(const GAS bf16x8*)(wl + 32 * kb + 8 * s);
                v4u bh, bl;
                bh.x = hb[8 * s] | (hb[8 * s + 1] << 16); bh.y = hb[8 * s + 2] | (hb[8 * s + 3] << 16); bh.z = hb[8 * s + 4] | (hb[8 * s + 5] << 16); bh.w = hb[8 * s + 6] | (hb[8 * s + 7] << 16);
                bl.x = lb[8 * s] | (lb[8 * s + 1] << 16); bl.y = lb[8 * s + 2] | (lb[8 * s + 3] << 16); bl.z = lb[8 * s + 4] | (lb[8 * s + 5] << 16); bl.w = lb[8 * s + 6] | (lb[8 * s + 7] << 16);
                acc = __builtin_amdgcn_mfma_f32_32x32x16_bf16(ah, __builtin_bit_cast(bf16x8, bh), acc, 0, 0, 0);
                acc = __builtin_amdgcn_mfma_f32_32x32x16_bf16(ah, __builtin_bit_cast(bf16x8, bl), acc, 0, 0, 0);
                acc = __builtin_amdgcn_mfma_f32_32x32x16_bf16(al, __builtin_bit_cast(bf16x8, bh), acc, 0, 0, 0);
            }
        }
        { LAS float* pr = PL + (size_t)(kq * 64 + 32 * rg + r32) * 33;
#pragma unroll
          for (int r = 0; r < 16; ++r) pr[att::crow(r, hi)] = acc[r];
          SS[(kq * 2 + hi) * 64 + 32 * rg + r32] = ss; }
        __syncthreads();
        int sel[4]; float gt[4]; float rstd = 0.f; int lr[4];
        if (C.tid < 64) {
            float lv[32]; float s2 = 0.f;
#pragma unroll
            for (int q = 0; q < 8; ++q) s2 += SS[q * 64 + C.tid];
            rstd = 1.0f / sqrtf(s2 * (1.f / DM) + NORM_EPS);
#pragma unroll
            for (int e = 0; e < 32; ++e) { const float a = (PL[(0 * 64 + C.tid) * 33 + e] + PL[(1 * 64 + C.tid) * 33 + e]) + (PL[(2 * 64 + C.tid) * 33 + e] + PL[(3 * 64 + C.tid) * 33 + e]); lv[e] = a * rstd + C.b_router[e]; }
            float val[4];
#pragma unroll
            for (int k = 0; k < 4; ++k) { float best = lv[0]; int bi = 0;
#pragma unroll
                for (int e = 1; e < 32; ++e) if (lv[e] > best) { best = lv[e]; bi = e; }
                sel[k] = bi; val[k] = best;
#pragma unroll
                for (int e = 0; e < 32; ++e) lv[e] = (e == bi) ? -INFINITY : lv[e]; }
            float den = 0.f;
#pragma unroll
            for (int k = 0; k < 4; ++k) { gt[k] = __expf(val[k] - val[0]); den += gt[k]; }
            const float inv = 1.0f / den;
#pragma unroll
            for (int k = 0; k < 4; ++k) { gt[k] *= inv; lr[k] = __hip_atomic_fetch_add((LAS int*)(hist + sel[k]), 1, __ATOMIC_RELAXED, __HIP_MEMORY_SCOPE_WORKGROUP); }
        }
        __syncthreads();
        if (C.tid < 32) gb[C.tid] = (int)__hip_atomic_fetch_add((unsigned*)(C.ctl + CW_CNT + C.tid), (unsigned)hist[C.tid], RLX_AGENT);
        __syncthreads();
        if (C.tid < 64) {
            const int t = blk * 64 + C.tid;
#pragma unroll
            for (int k = 0; k < 4; ++k) { const int sl = sel[k] * CAP + gb[sel[k]] + lr[k]; C.TOK[sl] = t; C.RS[sl] = rstd; C.TSLOT[t * 4 + k] = sl; C.TGATE[t * 4 + k] = gt[k]; }
        }
        __syncthreads();
    }
}
template <int NT>
__device__ __forceinline__ void moe_table(const Ctx& C, LAS int* tab) {
    __syncthreads();
    if (C.tid == 0) { int us = 0, rb = 0;
        for (int e = 0; e < 32; ++e) { const int n = (int)__hip_atomic_load((unsigned*)(C.ctl + CW_CNT + e), RLX_AGENT); const int mt = (n + 255) >> 8; tab[e] = us; tab[33 + e] = mt; tab[65 + e] = rb; tab[97 + e] = n; us += mt * NT; rb += mt * 256; }
        tab[32] = us; }
    __syncthreads();
}


__device__ __forceinline__ void phase9(const Ctx& C, const LAS int* tab) {
    const int gw = C.vcu * NWAVES + C.wave, NGW = C.G * NWAVES;
    for (int t = gw; t < T; t += NGW) {
        typedef int v4i_ __attribute__((ext_vector_type(4))); const v4i_ sl = *(const GAS v4i_*)(C.TSLOT + 4 * t); const f32x4 g = *(const GAS f32x4*)(C.TGATE + 4 * t);
        const int s[4] = {sl.x, sl.y, sl.z, sl.w}; const float gg[4] = {g.x, g.y, g.z, g.w};
        const bf16* yr[4];
#pragma unroll
        for (int k = 0; k < 4; ++k) { const int e = s[k] >> 14, rk = s[k] & (CAP - 1); yr[k] = C.Y + (size_t)(tab[65 + e] + rk) * DM + 8 * C.lane; }
        float* orow = C.out + (size_t)t * DM + 8 * C.lane;
#pragma unroll
        for (int j = 0; j < 4; ++j) {
            f32x4 a0 = *(const GAS f32x4*)(orow + 512 * j), a1 = *(const GAS f32x4*)(orow + 512 * j + 4);
#pragma unroll
            for (int k = 0; k < 4; ++k) { const v4u y = *(const GAS v4u*)(yr[k] + 512 * j);
                a0.x += gg[k] * pg8::bf_lo(y.x); a0.y += gg[k] * pg8::bf_hi(y.x); a0.z += gg[k] * pg8::bf_lo(y.y); a0.w += gg[k] * pg8::bf_hi(y.y);
                a1.x += gg[k] * pg8::bf_lo(y.z); a1.y += gg[k] * pg8::bf_hi(y.z); a1.z += gg[k] * pg8::bf_lo(y.w); a1.w += gg[k] * pg8::bf_hi(y.w); }
            *(GAS f32x4*)(orow + 512 * j) = a0; *(GAS f32x4*)(orow + 512 * j + 4) = a1;
        }
    }
}

struct Args { const void* in[26]; float* out; unsigned char* ws; int ph_lo, ph_hi, probe, pad; };
__global__ void __launch_bounds__(NWAVES * 64, 2) mk_fwd(Args args) {
    extern __shared__ __attribute__((aligned(16))) unsigned char lds_raw[];
    Ctx C;
    C.lds = (LAS unsigned char*)lds_raw;
    C.MISC = (volatile LAS unsigned*)(C.lds + MISC_OFF);
    C.tid = threadIdx.x; C.lane = C.tid & 63; C.wave = __builtin_amdgcn_readfirstlane(C.tid >> 6);
    C.probe = args.probe; C.G = gridDim.x; { const int bx = blockIdx.x; C.vcu = (C.G % 8 == 0) ? (bx % 8) * (C.G / 8) + bx / 8 : bx; }
    unsigned char* ws = args.ws;
    C.ctl = (gu32*)(ws + WS_CTL);
    C.x = (const float*)args.in[0]; C.mem = (const float*)args.in[1]; C.pos = (const int*)args.in[2]; C.norm_mix = (const float*)args.in[3]; C.w_in = (const float*)args.in[4];
    C.b_forget = (const float*)args.in[5]; C.fox_q_norm = (const float*)args.in[6]; C.fox_k_norm = (const float*)args.in[7]; C.swa_q_norm = (const float*)args.in[8]; C.swa_k_norm = (const float*)args.in[9];
    C.swa_sinks = (const float*)args.in[10]; C.xmem_q_norm = (const float*)args.in[11]; C.xmem_k_norm = (const float*)args.in[12]; C.norm_mem = (const float*)args.in[13]; C.w_mem_kv = (const float*)args.in[14];
    C.w_up_fox = (const float*)args.in[15]; C.w_up_swa = (const float*)args.in[16]; C.w_up_xmem = (const float*)args.in[17]; C.w_out = (const float*)args.in[18]; C.norm_ffn = (const float*)args.in[19];
    C.w_router = (const float*)args.in[20]; C.b_router = (const float*)args.in[21]; C.w_gate_up = (const float*)args.in[22]; C.b_gate_up = (const float*)args.in[23]; C.w_down = (const float*)args.in[24]; C.b_down = (const float*)args.in[25];
    C.out = args.out;
#define WS_PTRS() do { unsigned char* w_ = args.ws; asm volatile("" : "+s"(w_)); \
    C.ctl = (gu32*)(w_ + WS_CTL); C.Win_t = (bf16*)(w_ + WS_WIN); C.Wmkv_t = (bf16*)(w_ + WS_WMKV); C.Wup_t = (bf16*)(w_ + WS_WUP); C.Wout_t = (bf16*)(w_ + WS_WOUT); C.Wr_t = (bf16*)(w_ + WS_WRT); C.Wgu_t = (bf16*)(w_ + WS_WGU); C.Wd_t = (bf16*)(w_ + WS_WD); \
    C.XN = (bf16*)(w_ + WS_XN); C.MN = (bf16*)(w_ + WS_MN); C.QKV = (bf16*)(w_ + WS_QKV); C.G_ = (bf16*)(w_ + WS_G); C.MKV = (bf16*)(w_ + WS_MKV); C.OALL = (bf16*)(w_ + WS_OALL); C.MERGED = (bf16*)(w_ + WS_MERGED); \
    C.HB = (bf16*)(w_ + WS_HB); C.ACT = (bf16*)(w_ + WS_ACT); C.LOGF = (float*)(w_ + WS_LOGF); C.CNEG = (float*)(w_ + WS_CNEG); C.ROPE = (float*)(w_ + WS_ROPE); C.GATEW = (float*)(w_ + WS_GATE); C.RS = (float*)(w_ + WS_RS); \
    C.TOK = (int*)(w_ + WS_TOK); C.TSLOT = (int*)(w_ + WS_TSLOT); C.TGATE = (float*)(w_ + WS_TGATE); C.Y = (bf16*)(w_ + WS_Y); C.XN8 = w_ + WS_XN8; C.Win8 = w_ + WS_WIN8; } while (0)
    WS_PTRS();
    for (int u = C.tid; u < (LDS_BYTES - LDSCTL_OFF) / 4; u += NWAVES * 64) ((LAS unsigned*)(C.lds + LDSCTL_OFF))[u] = 0u;
    __syncthreads();
    XcdBarrier bar; bar.bar = (unsigned*)(C.ctl + CW_BAR); bar.x = 0; bar.st = nullptr;
    if (N_LAUNCHES == 1) bar = xcd_barrier_post((unsigned*)(C.ctl + CW_BAR), C.MISC + 8);
    const int lo = args.ph_lo, hi = args.ph_hi;
#ifndef MK_PHASE_MASK
#define MK_PHASE_MASK 0x3FF
#endif
#define IN(k) ((((MK_PHASE_MASK) >> (k)) & 1) && lo <= (k) && (k) < hi)
#define SEAM(k) do { if (IN(k) && IN((k) + 1)) xcd_barrier(bar); } while (0)
    LAS int* tab = (LAS int*)(C.lds + MOE_OFF);

    if (IN(0)) { WS_PTRS(); phase0(C); }
    SEAM(0);
    if (IN(1)) { WS_PTRS();
        logf_cumsum(C);
        P1Order S; S.d.init(C.XN, C.Win_t, T, PROBE_INW * 64, C.G, (int)blockIdx.x); S.A1 = (const char*)C.MN; S.B1 = (const char*)C.Wmkv_t;
        EpiInProj E{C.QKV, C.G_, C.MKV, args.probe == 1, C.fox_k_norm, C.swa_k_norm, C.ROPE};
        if (args.probe != 3) pg8::gemm_phase<EpiInProj, P1Order>(C.lds + RING_OFF, S, E);
        P1bOrder S8; S8.d.init(C.XN8, C.Win8, T, 6144, C.G, (int)blockIdx.x);
#ifdef PROBE_DET
#pragma unroll 1
        for (int rep = 0; rep < 2; ++rep) { EpiGates E8{rep ? C.Y : C.ACT}; pg8::gemm_phase<EpiGates, P1bOrder>(C.lds + RING_OFF, S8, E8); }
#else
#ifdef PROBE_GDUMMY
        EpiGates E8{C.ACT};
#else
        EpiGates E8{C.G_};
#endif
        if (args.probe != 2) pg8::gemm_phase<EpiGates, P1bOrder>(C.lds + RING_OFF, S8, E8);
#endif
    }
    SEAM(1);
    if (IN(3)) { WS_PTRS(); phase3(C, args.probe >= 4 ? args.probe : 0); }
    SEAM(3);
    if (IN(4)) { WS_PTRS();
        DenseOrder S; S.init(C.OALL, C.Wup_t, T, DM, C.G, (int)blockIdx.x);
        EpiMerge E{C.G_, C.MERGED};
        pg8::gemm_phase<EpiMerge, DenseOrder>(C.lds + RING_OFF, S, E);
    }
    SEAM(4);
    if (IN(5)) { WS_PTRS();
        DenseOrder S; S.init(C.MERGED, C.Wout_t, T, DM, C.G, (int)blockIdx.x);
        EpiOut E{C.x, C.out, (unsigned char*)C.HB, args.probe == 1};
        pg8::gemm_phase<EpiOut, DenseOrder, false>(C.lds + RING_OFF, S, E);
    }
    SEAM(5);
    if (IN(6)) { WS_PTRS(); phase6(C); }
    SEAM(6);
    if (IN(7)) { WS_PTRS();
        moe_table<16>(C, tab);
        MoeOrder<true, 16, 2048> S{(const char*)C.HB, (const char*)C.Wgu_t, C.TOK, (const int*)(C.ctl + CW_CNT), tab, C.G, C.vcu};
        EpiGateUp E{C.RS, C.b_gate_up, (unsigned char*)C.ACT};
        pg8::gemm_phase<EpiGateUp, MoeOrder<true, 16, 2048>>(C.lds + RING_OFF, S, E);
    }
    SEAM(7);
    if (IN(8)) { WS_PTRS();
        moe_table<8>(C, tab);
        MoeOrder<false, 8, 2048> S{(const char*)C.ACT, (const char*)C.Wd_t, C.TOK, (const int*)(C.ctl + CW_CNT), tab, C.G, C.vcu};
        EpiDown E{C.b_down, C.Y};
        pg8::gemm_phase<EpiDown, MoeOrder<false, 8, 2048>>(C.lds + RING_OFF, S, E);
    }
    SEAM(8);
    if (IN(9)) { WS_PTRS(); moe_table<8>(C, tab); phase9(C, tab);
#ifdef PROBE_DET
        if (blockIdx.x == 0 && C.tid == 0 && __hip_atomic_load((unsigned*)(C.ctl + 2048), RLX_AGENT) != 0u) C.out[12345] = __builtin_nanf("");
#endif
    }
#undef IN
#undef SEAM
}

extern "C" void kernel_launch(void* const* d_in, const int* in_sizes, int n_in, void* d_out, int out_size, void* d_ws, size_t ws_size, hipStream_t stream) {
    static int grid = 0;
    if (grid == 0) {
        if (n_in != 26 || out_size != T * DM || ws_size < WS_END) { fprintf(stderr, "kernel_launch: unexpected problem (n_in %d, out %d, ws %zu < %zu); nothing launched\n", n_in, out_size, ws_size, (size_t)WS_END); grid = -1; return; }
        int dev = 0, cus = 0, per_cu = 0;
        if (hipGetDevice(&dev) != hipSuccess || hipDeviceGetAttribute(&cus, hipDeviceAttributeMultiprocessorCount, dev) != hipSuccess) { grid = -1; return; }
        if (hipFuncSetAttribute((const void*)mk_fwd, hipFuncAttributeMaxDynamicSharedMemorySize, LDS_BYTES) != hipSuccess) { fprintf(stderr, "kernel_launch: hipFuncSetAttribute failed\n"); grid = -1; return; }
        if (hipOccupancyMaxActiveBlocksPerMultiprocessor(&per_cu, (const void*)mk_fwd, NWAVES * 64, LDS_BYTES) != hipSuccess || per_cu < 1) { fprintf(stderr, "kernel_launch: occupancy query says %d\n", per_cu); }
        (void)hipGetLastError();
        grid = cus;
    }
    if (grid < 0) return;
    if (hipMemsetAsync((char*)d_ws + WS_CTL, 0, CTL_ZERO_BYTES, stream) != hipSuccess) return;
#ifdef PROBE_MEMSET8
    hipMemsetAsync((char*)d_ws + WS_XN8, 0, 44 * MiB, stream);
#endif
    Args a{};
    for (int i = 0; i < 26; ++i) a.in[i] = d_in[i];
    a.out = (float*)d_out; a.ws = (unsigned char*)d_ws;
    if (N_LAUNCHES == 1) { a.ph_lo = 0; a.ph_hi = PER_PHASE; hipLaunchKernelGGL(mk_fwd, dim3(grid), dim3(NWAVES * 64), LDS_BYTES, stream, a); }
    else for (int li = 0; li < PER_PHASE; ++li) { a.ph_lo = li; a.ph_hi = li + 1;
#ifdef PROBE_SPLIT_P1
        if (li == 1) { a.probe = 2; hipLaunchKernelGGL(mk_fwd, dim3(grid), dim3(NWAVES * 64), LDS_BYTES, stream, a); a.probe = 3; hipLaunchKernelGGL(mk_fwd, dim3(grid), dim3(NWAVES * 64), LDS_BYTES, stream, a); a.probe = 0; continue; }
#endif
        hipLaunchKernelGGL(mk_fwd, dim3(grid), dim3(NWAVES * 64), LDS_BYTES, stream, a);
#ifdef PROBE_DUP
        if (li == PROBE_DUP) { if (PROBE_DUP == 3 || PROBE_DUP == 6) hipMemsetAsync((char*)d_ws + WS_CTL, 0, CTL_ZERO_BYTES / 2, stream);
#ifdef PROBE_FLAG
            a.probe = PROBE_FLAG;
#endif
            hipLaunchKernelGGL(mk_fwd, dim3(grid), dim3(NWAVES * 64), LDS_BYTES, stream, a); a.probe = 0; }
#endif
    }
    const hipError_t le = hipPeekAtLastError();
    if (le != hipSuccess) fprintf(stderr, "kernel_launch: launch failed: %s\n", hipGetErrorName(le));
}
```

```cpp
#include <hip/hip_runtime.h>
#include <cstdio>
#include <cstdint>

#define LAS __attribute__((address_space(3)))
#define GAS __attribute__((address_space(1)))

namespace pg8 {
typedef unsigned short bf16_t;
typedef short bf16x8 __attribute__((ext_vector_type(8)));
typedef float f32x4 __attribute__((ext_vector_type(4)));
typedef float f32x2 __attribute__((ext_vector_type(2)));
typedef unsigned u32x4 __attribute__((ext_vector_type(4)));
typedef unsigned u32x2 __attribute__((ext_vector_type(2)));
constexpr int BM = 256, BK = 64, HALF = 128, HTB = HALF * BK * 2, STAGE_BYTES = 8 * HTB, NXCD = 8, WGM = 8;
constexpr int KD = 2048;
typedef int v8i __attribute__((ext_vector_type(8))); typedef int v4i __attribute__((ext_vector_type(4)));
__device__ __forceinline__ v8i cat8(bf16x8 lo, bf16x8 hi) { const v4i a = __builtin_bit_cast(v4i, lo), b = __builtin_bit_cast(v4i, hi); return __builtin_shufflevector(a, b, 0, 1, 2, 3, 4, 5, 6, 7); }
__device__ __forceinline__ bf16x8 lo8(v8i v) { return __builtin_bit_cast(bf16x8, (v4i)__builtin_shufflevector(v, v, 0, 1, 2, 3)); }
__device__ __forceinline__ bf16x8 hi8(v8i v) { return __builtin_bit_cast(bf16x8, (v4i)__builtin_shufflevector(v, v, 4, 5, 6, 7)); }

__host__ __device__ __forceinline__ int lds_byte(int r, int c) { const int st = (r >> 4) * 2 + (c >> 5), rr = r & 15, cc = c & 31, ob = rr * 64 + cc * 2; return st * 1024 + (ob ^ (((ob >> 9) & 1) << 5)); }
__host__ __device__ __forceinline__ void stage_rc(int b, int& R, int& C) { const int st = b / 1024, sb = b % 1024, swz = sb ^ (((sb >> 9) & 1) << 5); R = (st >> 1) * 16 + swz / 64; C = (st & 1) * 32 + (swz % 64) / 2; }
__host__ __device__ __forceinline__ int perm32(int rho) { const int n = rho >> 4, i = rho & 15; return 8 * (i >> 2) + 4 * n + (i & 3); }

__device__ __forceinline__ void glds_s(const char* sbase, unsigned voff, unsigned lds_dst) { unsigned keep;
    asm volatile("s_mov_b32 %0, m0\n\ts_mov_b32 m0, %3\n\ts_nop 0\n\tglobal_load_lds_dwordx4 %1, %2\n\ts_mov_b32 m0, %0" : "=&s"(keep) : "v"(voff), "s"(sbase), "s"(lds_dst) : "memory"); }

#define PG8_PIN4(a, b, c, d, txt) asm volatile(txt : "+v"(a), "+v"(b), "+v"(c), "+v"(d))
#define PG8_PIN_ACC(txt) do { _Pragma("unroll") for (int _a = 0; _a < 2; ++_a) _Pragma("unroll") for (int _b = 0; _b < 2; ++_b) { \
        PG8_PIN4(acc[_a][_b][0][0], acc[_a][_b][0][1], acc[_a][_b][1][0], acc[_a][_b][1][1], ""); PG8_PIN4(acc[_a][_b][2][0], acc[_a][_b][2][1], acc[_a][_b][3][0], acc[_a][_b][3][1], ""); } \
        PG8_PIN4(acc[0][0][0][0], acc[0][1][0][0], acc[1][0][0][0], acc[1][1][0][0], txt); \
        _Pragma("unroll") for (int _a = 0; _a < 2; ++_a) _Pragma("unroll") for (int _b = 0; _b < 2; ++_b) { \
        PG8_PIN4(acc[_a][_b][0][0], acc[_a][_b][0][1], acc[_a][_b][1][0], acc[_a][_b][1][1], ""); PG8_PIN4(acc[_a][_b][2][0], acc[_a][_b][2][1], acc[_a][_b][3][0], acc[_a][_b][3][1], ""); } } while (0)

struct Unit { int pm, pn, e, kind; };

typedef float f32x2_cv __attribute__((ext_vector_type(2))); typedef __bf16 bf16x2_cv __attribute__((ext_vector_type(2)));
__device__ __forceinline__ unsigned cvt_pk_bf16(float lo, float hi) { const f32x2_cv v = {lo, hi}; const bf16x2_cv b = __builtin_convertvector(v, bf16x2_cv); return __builtin_bit_cast(unsigned, b); }
__device__ __forceinline__ float bf_lo(unsigned w) { return __uint_as_float(w << 16); }
__device__ __forceinline__ float bf_hi(unsigned w) { return __uint_as_float(w & 0xffff0000u); }

template <class Epi, class Sched, bool ALIGN_EPI = true, bool SP2 = true>
__device__ __forceinline__ void gemm_phase(LAS unsigned char* lds, const Sched& S, const Epi& E) {
    const int tid = threadIdx.x, wid = __builtin_amdgcn_readfirstlane(tid >> 6), lane = tid & 63, wr = wid >> 2, wc = wid & 3, fr = lane & 15, fq = lane >> 4;
    constexpr bool FP8 = Epi::FP8; constexpr int RB = FP8 ? 2048 : 4096, nt = RB / 128;
    unsigned voffB[2]; int RA[2], CA[2];
#pragma unroll
    for (int i = 0; i < 2; ++i) { int R, C; stage_rc(tid * 16 + i * 8192, R, C); const int Rb = Epi::PERM ? ((R & ~31) + perm32(R & 31)) : R;
        voffB[i] = (unsigned)(Rb * (Epi::BTILED ? 128 : RB) + C * 2); RA[i] = R; CA[i] = C; }
    constexpr size_t kstep = (size_t)(BK * 2);
    constexpr size_t hstep = (size_t)HALF * RB;
    constexpr size_t bkstep = Epi::BTILED ? (size_t)32768 : kstep, bhstep = Epi::BTILED ? (size_t)16384 : hstep;
    const unsigned ldsbase = (unsigned)__builtin_amdgcn_readfirstlane((unsigned)(uintptr_t)lds + (unsigned)wid * 1024u);
    const int aoff = lds_byte(wr * 64 + fr, fq * 8), boff = lds_byte(wc * 32 + fr, fq * 8);
#define PG8_SA(b, h) (((b) * 2 + (h)) * HTB)
#define PG8_SB(b, h) ((4 + (b) * 2 + (h)) * HTB)
#define PG8_STAGE(bufoff, gbase, voff) do { _Pragma("unroll") for (int _i = 0; _i < 2; ++_i) \
        glds_s((const char*)(gbase), (voff)[_i], ldsbase + (unsigned)((bufoff) + _i * 8192)); } while (0)
#define PG8_LDA(dst, b, h) do { _Pragma("unroll") for (int m = 0; m < 4; ++m) dst[m] = cat8(*(const LAS bf16x8*)(lds + PG8_SA(b, h) + aoff + m * 2048), *(const LAS bf16x8*)(lds + PG8_SA(b, h) + aoff + m * 2048 + 1024)); } while (0)
#define PG8_LDB(dst, b, h) do { _Pragma("unroll") for (int n = 0; n < 2; ++n) dst[n] = cat8(*(const LAS bf16x8*)(lds + PG8_SB(b, h) + boff + n * 2048), *(const LAS bf16x8*)(lds + PG8_SB(b, h) + boff + n * 2048 + 1024)); } while (0)
#define PG8_MMA(ai, bj, At, Bt) do { __builtin_amdgcn_s_setprio(1); _Pragma("unroll") for (int m = 0; m < 4; ++m) _Pragma("unroll") for (int n = 0; n < 2; ++n) { \
        if constexpr (FP8 && Epi::ASM_MFMA) asm volatile("v_mfma_scale_f32_16x16x128_f8f6f4 %0, %1, %2, %0, %3, %4 op_sel_hi:[0,0,0]" : "+v"(acc[ai][bj][m][n]) : "v"(Bt[n]), "v"(At[m]), "v"(scl_b), "v"(scl_a)); \
        else if constexpr (FP8) acc[ai][bj][m][n] = __builtin_amdgcn_mfma_scale_f32_16x16x128_f8f6f4(Bt[n], At[m], acc[ai][bj][m][n], 0, 0, 0, Epi::SCALE_B, 0, Epi::SCALE_A); \
        else { acc[ai][bj][m][n] = __builtin_amdgcn_mfma_f32_16x16x32_bf16(lo8(Bt[n]), lo8(At[m]), acc[ai][bj][m][n], 0, 0, 0); \
               acc[ai][bj][m][n] = __builtin_amdgcn_mfma_f32_16x16x32_bf16(hi8(Bt[n]), hi8(At[m]), acc[ai][bj][m][n], 0, 0, 0); } } \
        __builtin_amdgcn_s_setprio(0); } while (0)
#ifdef PROBE_DRAIN8
#define PG8_WAIT_V(n) do { if constexpr (FP8 && !Epi::ASM_MFMA) asm volatile("s_waitcnt vmcnt(0)" ::: "memory"); else asm volatile("s_waitcnt vmcnt(" #n ")" ::: "memory"); } while (0)
#else
#define PG8_WAIT_V(n) asm volatile("s_waitcnt vmcnt(" #n ")" ::: "memory")
#endif
#define PG8_WAIT_L(n) asm volatile("s_waitcnt lgkmcnt(" #n ")" ::: "memory")
#define PG8_BAR __builtin_amdgcn_s_barrier()
#define PG8_SCHED __builtin_amdgcn_sched_barrier(0)
    Unit cur, nxt; int ui = 0;
    int scl_a = Epi::SCALE_A, scl_b = Epi::SCALE_B; asm volatile("" : "+v"(scl_a), "+v"(scl_b));
    if (!S.next(0, cur)) return;
    f32x4 acc[2][2][4][2];
#pragma unroll
    for (int a = 0; a < 2; ++a)
#pragma unroll
        for (int b = 0; b < 2; ++b)
#pragma unroll
            for (int m = 0; m < 4; ++m)
#pragma unroll
                for (int n = 0; n < 2; ++n) acc[a][b][m][n] = (f32x4){0.f, 0.f, 0.f, 0.f};
    if constexpr (Epi::FP8) PG8_PIN_ACC("s_nop 7");
    v8i At[4], B0[2], B1[2];
    const char* cA = S.a_base(cur); const char* cB = S.b_base(cur);
    unsigned vo[2][2], nvo[2][2];
    S.a_offs(cur, RA, CA, vo);
    bool has_next = S.next(1, nxt);
    if (has_next) S.a_offs(nxt, RA, CA, nvo); else { nvo[0][0] = vo[0][0]; nvo[0][1] = vo[0][1]; nvo[1][0] = vo[1][0]; nvo[1][1] = vo[1][1]; }
    if constexpr (SP2) {
        PG8_STAGE(PG8_SB(0, 0), cB, voffB); PG8_STAGE(PG8_SB(0, 1), cB + bhstep, voffB); PG8_STAGE(PG8_SA(0, 0), cA, vo[0]); PG8_STAGE(PG8_SA(0, 1), cA, vo[1]);
        if (wr == 1) PG8_BAR;
        PG8_WAIT_V(2); PG8_BAR;
        PG8_STAGE(PG8_SB(1, 0), cB + bkstep, voffB); PG8_STAGE(PG8_SA(1, 0), cA + kstep, vo[0]); PG8_STAGE(PG8_SB(1, 1), cB + bhstep + bkstep, voffB);
        PG8_WAIT_V(6); PG8_BAR;
    } else {
        PG8_STAGE(PG8_SB(0, 0), cB, voffB); PG8_STAGE(PG8_SA(0, 0), cA, vo[0]); PG8_STAGE(PG8_SB(0, 1), cB + bhstep, voffB); PG8_STAGE(PG8_SA(0, 1), cA, vo[1]);
        if (wr == 1) PG8_BAR;
        PG8_WAIT_V(4); PG8_BAR;
        PG8_STAGE(PG8_SB(1, 0), cB + bkstep, voffB); PG8_STAGE(PG8_SA(1, 0), cA + kstep, vo[0]); PG8_STAGE(PG8_SB(1, 1), cB + bhstep + bkstep, voffB);
        PG8_WAIT_V(6); PG8_BAR;
    }
    for (;;) {
        const char* nA = has_next ? S.a_base(nxt) : cA; const char* nB = has_next ? S.b_base(nxt) : cB;
        for (int t = 0; t < nt; t += 2) {
            const bool last = (t == nt - 2);
            const char* a1 = cA + (size_t)(t + 1) * kstep;
            const char* a2 = last ? nA : cA + (size_t)(t + 2) * kstep; const char* b2 = last ? nB : cB + (size_t)(t + 2) * bkstep;
            const char* a3 = a2 + kstep; const char* b3 = b2 + bkstep;
            unsigned v2[2][2];
            v2[0][0] = last ? nvo[0][0] : vo[0][0]; v2[0][1] = last ? nvo[0][1] : vo[0][1]; v2[1][0] = last ? nvo[1][0] : vo[1][0]; v2[1][1] = last ? nvo[1][1] : vo[1][1];
            if constexpr (SP2) {
            PG8_LDB(B0, 0, 0); PG8_LDB(B1, 0, 1); PG8_SCHED; PG8_LDA(At, 0, 0); PG8_STAGE(PG8_SA(1, 1), a1, vo[1]);
            PG8_WAIT_V(8); PG8_WAIT_L(0); PG8_BAR; PG8_MMA(0, 0, At, B0); PG8_MMA(0, 1, At, B1); PG8_BAR; PG8_SCHED;
            PG8_LDA(At, 0, 1); PG8_STAGE(PG8_SB(0, 0), b2, voffB); PG8_STAGE(PG8_SB(0, 1), b2 + bhstep, voffB); PG8_STAGE(PG8_SA(0, 0), a2, v2[0]);
            PG8_WAIT_V(8); PG8_WAIT_L(0); PG8_BAR; PG8_MMA(1, 0, At, B0); PG8_MMA(1, 1, At, B1); PG8_BAR; PG8_SCHED;
            PG8_LDB(B0, 1, 0); PG8_LDB(B1, 1, 1); PG8_SCHED; PG8_LDA(At, 1, 0); PG8_STAGE(PG8_SA(0, 1), a2, v2[1]);
            PG8_WAIT_V(8); PG8_WAIT_L(0); PG8_BAR; PG8_MMA(0, 0, At, B0); PG8_MMA(0, 1, At, B1); PG8_BAR; PG8_SCHED;
            PG8_LDA(At, 1, 1); PG8_STAGE(PG8_SB(1, 0), b3, voffB); PG8_STAGE(PG8_SB(1, 1), b3 + bhstep, voffB); PG8_STAGE(PG8_SA(1, 0), a3, v2[0]);
            PG8_WAIT_V(8); PG8_WAIT_L(0); PG8_BAR; PG8_MMA(1, 0, At, B0); PG8_MMA(1, 1, At, B1); PG8_BAR; PG8_SCHED;
            } else {
            PG8_LDB(B0, 0, 0); PG8_SCHED; PG8_LDA(At, 0, 0); PG8_STAGE(PG8_SA(1, 1), a1, vo[1]);
            PG8_WAIT_L(8); PG8_BAR; PG8_WAIT_L(0); PG8_MMA(0, 0, At, B0); PG8_BAR; PG8_SCHED;
            PG8_LDB(B1, 0, 1); PG8_STAGE(PG8_SB(0, 0), b2, voffB);
            PG8_BAR; PG8_WAIT_L(0); PG8_MMA(0, 1, At, B1); PG8_BAR;
            PG8_LDA(At, 0, 1); PG8_STAGE(PG8_SA(0, 0), a2, v2[0]);
            PG8_BAR; PG8_WAIT_L(0); PG8_MMA(1, 0, At, B0); PG8_BAR; PG8_SCHED;
            PG8_STAGE(PG8_SB(0, 1), b2 + bhstep, voffB);
            PG8_WAIT_V(6); PG8_BAR; PG8_MMA(1, 1, At, B1); PG8_BAR;
            PG8_LDB(B0, 1, 0); PG8_SCHED; PG8_LDA(At, 1, 0); PG8_STAGE(PG8_SA(0, 1), a2, v2[1]);
            PG8_WAIT_L(8); PG8_BAR; PG8_WAIT_L(0); PG8_MMA(0, 0, At, B0); PG8_BAR; PG8_SCHED;
            PG8_LDB(B1, 1, 1); PG8_STAGE(PG8_SB(1, 0), b3, voffB);
            PG8_BAR; PG8_WAIT_L(0); PG8_MMA(0, 1, At, B1); PG8_BAR;
            PG8_LDA(At, 1, 1); PG8_STAGE(PG8_SA(1, 0), a3, v2[0]);
            PG8_BAR; PG8_WAIT_L(0); PG8_MMA(1, 0, At, B0); PG8_BAR; PG8_SCHED;
            PG8_STAGE(PG8_SB(1, 1), b3 + bhstep, voffB);
            PG8_WAIT_V(6); PG8_BAR; PG8_MMA(1, 1, At, B1); PG8_BAR;
            }
            if constexpr (Epi::MID) { if (t == 10 || t == 22) E.mid(acc, cur, t == 22 ? 1 : 0, wr, wc, fr, fq); }
        }
        Unit nn; const bool has_nn = has_next && S.next(ui + 2, nn); unsigned nnvo[2][2];
        if (has_nn) S.a_offs(nn, RA, CA, nnvo); else { nnvo[0][0] = nvo[0][0]; nnvo[0][1] = nvo[0][1]; nnvo[1][0] = nvo[1][0]; nnvo[1][1] = nvo[1][1]; }
        if constexpr (ALIGN_EPI) { if (wr == 0) PG8_BAR; }
        if constexpr (FP8) PG8_PIN_ACC("s_nop 15\n\ts_nop 7");
        E(acc, cur, wr, wc, fr, fq);
        if (!has_next) break;
#pragma unroll
        for (int a = 0; a < 2; ++a)
#pragma unroll
            for (int b = 0; b < 2; ++b)
#pragma unroll
                for (int m = 0; m < 4; ++m)
#pragma unroll
                    for (int n = 0; n < 2; ++n) acc[a][b][m][n] = (f32x4){0.f, 0.f, 0.f, 0.f};
        if constexpr (FP8) PG8_PIN_ACC("s_nop 7");
        cur = nxt; cA = nA; cB = nB; ++ui; nxt = nn; has_next = has_nn;
        vo[0][0] = nvo[0][0]; vo[0][1] = nvo[0][1]; vo[1][0] = nvo[1][0]; vo[1][1] = nvo[1][1];
        nvo[0][0] = nnvo[0][0]; nvo[0][1] = nnvo[0][1]; nvo[1][0] = nnvo[1][0]; nvo[1][1] = nnvo[1][1];
        if constexpr (ALIGN_EPI) { if (wr == 1) PG8_BAR; }
    }
    PG8_WAIT_V(0);
    if constexpr (!ALIGN_EPI) { if (wr == 0) PG8_BAR; }
    PG8_BAR;
#undef PG8_SA
#undef PG8_SB
#undef PG8_STAGE
#undef PG8_LDA
#undef PG8_LDB
#undef PG8_MMA
#undef PG8_WAIT_V
#undef PG8_WAIT_L
#undef PG8_BAR
#undef PG8_SCHED
}
}

constexpr int NWAVES = 8;
constexpr int BATCH = 2, SEQ = 8192, DM = 2048, T = BATCH * SEQ;
constexpr int NMEM = 256, MROWS = BATCH * NMEM;
constexpr int INW = 10252;
constexpr int NEXP = 32, TOPK = 4, CAP = T;
constexpr int QKVW = 4096;
constexpr int C_FQ = 0, C_FK = 768, C_FV = 1536, C_SQ = 2304, C_SK = 3072, C_SV = 3328, C_MQ = 3584;
constexpr int GW = 6144;
constexpr float NORM_EPS = 1e-6f;
constexpr float LOG2E = 1.4426950408889634f;
constexpr float SWIGLU_LIMIT = 7.0f, SWIGLU_ALPHA = 1.702f;
constexpr int PER_PHASE = 10;
#ifndef MK_LATE_WD
#define MK_LATE_WD 0
#endif
constexpr bool LATE_WD = false;
#ifndef MK_CONV_IN_P3
#define MK_CONV_IN_P3 1
#endif
constexpr bool CONV_IN_P3 = MK_CONV_IN_P3;
#ifndef MK_N_LAUNCHES
#define MK_N_LAUNCHES 1
#endif
constexpr int N_LAUNCHES = MK_N_LAUNCHES;

constexpr size_t MiB = 1u << 20;
constexpr size_t WS_CTL = 0, CTL_ZERO_BYTES = 1 * MiB;
constexpr size_t WS_WIN   = 2 * MiB;
constexpr size_t WS_WMKV  = WS_WIN + 40 * MiB;
constexpr size_t WS_WUP   = WS_WMKV + 4 * MiB;
constexpr size_t WS_WOUT  = WS_WUP + 8 * MiB;
constexpr size_t WS_WRT   = WS_WOUT + 8 * MiB;
constexpr size_t WS_WGU   = WS_WRT + 1 * MiB;
constexpr size_t WS_WD    = WS_WGU + 512 * MiB;
constexpr size_t WS_XN    = WS_WD + 256 * MiB;
constexpr size_t WS_MN    = WS_XN + 64 * MiB;
constexpr size_t WS_LOGF  = WS_MN + 2 * MiB;
constexpr size_t WS_CNEG  = WS_LOGF + 1 * MiB;
constexpr size_t WS_ROPE  = WS_CNEG + 1 * MiB;
constexpr size_t WS_QKV   = WS_ROPE + 4 * MiB;
constexpr size_t WS_G     = WS_QKV + 128 * MiB;
constexpr size_t WS_MKV   = WS_G + 192 * MiB;
constexpr size_t WS_OALL  = WS_MKV + 1 * MiB;
constexpr size_t WS_MERGED= WS_OALL + 64 * MiB;
constexpr size_t WS_HB    = WS_MERGED + 64 * MiB;
constexpr size_t WS_TOK   = WS_HB + 64 * MiB;
constexpr size_t WS_GATE  = WS_TOK + 2 * MiB;
constexpr size_t WS_RS    = WS_GATE + 2 * MiB;
constexpr size_t WS_ACT   = WS_RS + 2 * MiB;
constexpr size_t WS_Y     = WS_ACT + 288 * MiB;
constexpr size_t WS_TSLOT = WS_Y + 288 * MiB;
constexpr size_t WS_TGATE = WS_TSLOT + 1 * MiB;
constexpr size_t WS_XN8   = WS_TGATE + 1 * MiB;
constexpr size_t WS_WIN8  = WS_XN8 + 32 * MiB;
constexpr size_t WS_END   = WS_WIN8 + 12 * MiB;
constexpr int CW_BAR = 4096;
constexpr int CW_QHEAD = 64;
constexpr int CW_CNT = 512;

typedef unsigned short bf16;
typedef unsigned v4u __attribute__((ext_vector_type(4)));
typedef unsigned v2u __attribute__((ext_vector_type(2)));
typedef float f32x4 __attribute__((ext_vector_type(4)));
typedef float f32x16 __attribute__((ext_vector_type(16)));
typedef short bf16x8 __attribute__((ext_vector_type(8)));
typedef short s16x4 __attribute__((ext_vector_type(4)));
typedef GAS unsigned gu32;
#define RLX_AGENT __ATOMIC_RELAXED, __HIP_MEMORY_SCOPE_AGENT
#define LDS_WAIT() asm volatile("s_waitcnt lgkmcnt(0)" ::: "memory")
#define VM_WAIT() asm volatile("s_waitcnt vmcnt(0)" ::: "memory")
__device__ __forceinline__ unsigned f2bf(float f) { unsigned u = __builtin_bit_cast(unsigned, f); return (u + 0x7fffu + ((u >> 16) & 1u)) >> 16; }
__device__ __forceinline__ unsigned pk2(float lo, float hi) { return f2bf(lo) | (f2bf(hi) << 16); }
__device__ __forceinline__ float bf2f(unsigned short b) { return __uint_as_float(((unsigned)b) << 16); }
__device__ __forceinline__ float wave_sum(float v) {
#pragma unroll
    for (int o = 1; o < 64; o <<= 1) v += __shfl_xor(v, o);
    return v;
}
__device__ __forceinline__ float sigmoidf_(float x) { return __builtin_amdgcn_rcpf(1.0f + __builtin_amdgcn_exp2f(x * (-LOG2E))); }

constexpr int H8_SHIFT = 4, ACT8_SHIFT = 2, W8_SHIFT = 9;
constexpr float H8_MUL = 16.0f, ACT8_MUL = 4.0f, W8_MUL = 512.0f;
__device__ __forceinline__ float clamp_fp8(float v) { return __builtin_amdgcn_fmed3f(v, -448.0f, 448.0f); }
__device__ __forceinline__ unsigned pk4_fp8(float a, float b, float c, float d) {
    int p = __builtin_amdgcn_cvt_pk_fp8_f32(clamp_fp8(a), clamp_fp8(b), 0, false); p = __builtin_amdgcn_cvt_pk_fp8_f32(clamp_fp8(c), clamp_fp8(d), p, true); return (unsigned)p; }
using pg8::f32x2; using pg8::u32x4; using pg8::u32x2; using pg8::cvt_pk_bf16; using pg8::bf_lo; using pg8::bf_hi;

#define XB_TMO      128
#define XB_XCNT(j)  (256  + 64 * (j))
#define XB_XSUB(j)  (1280 + 64 * (j))
#define XB_XGEN(j)  (2304 + 64 * (j))
#define XB_TOP      3328
#define XB_TOPGEN   3392
#define XCD_BAR_WORDS 3456
#define XB_SPIN_CAP (1u << 18)

__device__ __forceinline__ unsigned xb_ld(unsigned* p)              { return __hip_atomic_load(p, __ATOMIC_RELAXED, __HIP_MEMORY_SCOPE_AGENT); }
__device__ __forceinline__ unsigned xb_add(unsigned* p, unsigned v) { return __hip_atomic_fetch_add(p, v, __ATOMIC_RELAXED, __HIP_MEMORY_SCOPE_AGENT); }
__device__ __forceinline__ unsigned xb_xcc_id() { return (unsigned)__builtin_amdgcn_s_getreg((3 << 11) | 20) & 0xFu; }
#define XB_SPIN(cond, bar) do { unsigned _sp = 0; while (cond) { __builtin_amdgcn_s_sleep(1); \
    if ((++_sp & 255u) == 0u) { if (xb_ld(&(bar)[XB_TMO])) break; if (_sp > XB_SPIN_CAP) { atomicAdd(&(bar)[XB_TMO], 1u); break; } } } } while (0)

struct XcdBarrier { unsigned* bar; unsigned x; volatile LAS unsigned* st; };

__device__ __forceinline__ XcdBarrier xcd_barrier_post(unsigned* bar, volatile LAS unsigned* st) {
    XcdBarrier b; b.bar = bar; b.x = xb_xcc_id(); b.st = st;
    if (threadIdx.x == 0) (void)xb_add(&bar[XB_XCNT(b.x)], 1u);
    return b;
}
__device__ __forceinline__ void xcd_barrier_complete(unsigned* bar, unsigned x, unsigned& nloc, unsigned& nx) {
    const unsigned G = gridDim.x * gridDim.y * gridDim.z;
    unsigned sum, cnt, mine, sp = 0u;
    for (;;) {
        sum = 0u; cnt = 0u; mine = 0u;
#pragma unroll
        for (unsigned j = 0; j < 16; ++j) { const unsigned c = xb_ld(&bar[XB_XCNT(j)]); sum += c; cnt += (c > 0u) ? 1u : 0u; mine = (j == x) ? c : mine; }
        if (sum == G) break;
        __builtin_amdgcn_s_sleep(1);
        if ((++sp & 255u) == 0u) { if (xb_ld(&bar[XB_TMO])) break; if (sp > XB_SPIN_CAP) { atomicAdd(&bar[XB_TMO], 1u); break; } }
    }
    nloc = mine > 0u ? mine : 1u; nx = cnt > 0u ? cnt : 1u;
}
__device__ __forceinline__ void xcd_barrier(const XcdBarrier& b) {
    asm volatile("s_waitcnt vmcnt(0)" ::: "memory");
    __syncthreads();
    if (threadIdx.x == 0) {
        unsigned* bar = b.bar;
        __builtin_amdgcn_s_waitcnt(0);
        unsigned nloc = b.st[0], nx = b.st[1];
        if (nloc == 0u) { xcd_barrier_complete(bar, b.x, nloc, nx); b.st[0] = nloc; b.st[1] = nx; }
        const unsigned old = xb_add(&bar[XB_XSUB(b.x)], 1u);
        const unsigned gen = old / nloc;
        if (old + 1u == (gen + 1u) * nloc) {
            __builtin_amdgcn_fence(__ATOMIC_RELEASE, "agent");
            asm volatile("s_waitcnt vmcnt(0)" ::: "memory");
            const unsigned og = xb_add(&bar[XB_TOP], 1u);
            const unsigned tg = og / nx;
            if (og + 1u == (tg + 1u) * nx) xb_add(&bar[XB_TOPGEN], 1u);
            else XB_SPIN(xb_ld(&bar[XB_TOPGEN]) == tg, bar);
            __builtin_amdgcn_fence(__ATOMIC_ACQUIRE, "agent");
            xb_add(&bar[XB_XGEN(b.x)], 1u);
            asm volatile("s_waitcnt vmcnt(0)" ::: "memory");
        } else {
            XB_SPIN(xb_ld(&bar[XB_XGEN(b.x)]) == gen, bar);
            __builtin_amdgcn_fence(__ATOMIC_ACQUIRE, "agent");
            asm volatile("s_waitcnt vmcnt(0)" ::: "memory");
        }
    }
    __syncthreads();
}

constexpr int RING_OFF = 0, RING_BYTES = 131072;
constexpr int LDSCTL_OFF = RING_BYTES, MISC_OFF = LDSCTL_OFF + 320;
constexpr int MOE_OFF = MISC_OFF + 128;
constexpr int LDS_BYTES = 147456;

struct Ctx {
    LAS unsigned char* lds;
    volatile LAS unsigned* MISC;
    gu32* ctl;
    int tid, lane, wave, vcu, G, probe;
    const float *x, *mem; const int* pos; const float *norm_mix, *w_in, *b_forget, *fox_q_norm, *fox_k_norm, *swa_q_norm, *swa_k_norm, *swa_sinks, *xmem_q_norm, *xmem_k_norm, *norm_mem,
        *w_mem_kv, *w_up_fox, *w_up_swa, *w_up_xmem, *w_out, *norm_ffn, *w_router, *b_router, *w_gate_up, *b_gate_up, *w_down, *b_down;
    float* out;
    bf16 *Win_t, *Wmkv_t, *Wup_t, *Wout_t, *Wr_t, *Wgu_t, *Wd_t, *XN, *MN, *QKV, *G_, *MKV, *OALL, *MERGED, *HB, *ACT;
    float *LOGF, *CNEG, *ROPE, *GATEW, *RS, *TGATE; int *TOK, *TSLOT; bf16* Y; unsigned char *XN8, *Win8;
};

#ifndef PROBE_INW
#define PROBE_INW 64
#endif
__constant__ float INV_FREQ[32] = {1.000000000e+00f, 7.498942614e-01f, 5.623413324e-01f, 4.216965139e-01f, 3.162277639e-01f, 2.371373773e-01f, 1.778279394e-01f, 1.333521307e-01f,
    1.000000015e-01f, 7.498941571e-02f, 5.623413250e-02f, 4.216965288e-02f, 3.162277490e-02f, 2.371373773e-02f, 1.778279431e-02f, 1.333521493e-02f, 9.999999776e-03f, 7.498941850e-03f,
    5.623413250e-03f, 4.216964822e-03f, 3.162277630e-03f, 2.371373586e-03f, 1.778279431e-03f, 1.333521446e-03f, 1.000000047e-03f, 7.498942432e-04f, 5.623413017e-04f, 4.216965172e-04f,
    3.162277571e-04f, 2.371373703e-04f, 1.778279402e-04f, 1.333521504e-04f};

struct TItem { const float* src; const float* ksc; bf16* dst; size_t ldw; int f8, gap; };
__device__ __forceinline__ void titem_load(const TItem& I, f32x4 (&v)[8][2], float (&sc)[8][2], int lane) {
    const int rr = lane >> 4, c4 = lane & 15;
#pragma unroll
    for (int p = 0; p < 8; ++p)
#pragma unroll
        for (int h = 0; h < 2; ++h) { const int k = 8 * p + 2 * rr + h; v[p][h] = *(const GAS f32x4*)(I.src + (size_t)k * I.ldw + 4 * c4 + (c4 >= 8 ? I.gap : 0)); sc[p][h] = I.ksc ? I.ksc[k] : 1.0f; }
}
__device__ __forceinline__ void titem_store(const TItem& I, const f32x4 (&v)[8][2], const float (&sc)[8][2], LAS unsigned* tile, int lane) {
    const int rr = lane >> 4, c4 = lane & 15;
#pragma unroll
    for (int p = 0; p < 8; ++p)
#pragma unroll
        for (int q = 0; q < 4; ++q) { const int n = 4 * c4 + q, sw = (n ^ (n >> 3)) & 7;
            tile[n * 32 + 4 * (p ^ sw) + rr] = pg8::cvt_pk_bf16(v[p][0][q] * sc[p][0], v[p][1][q] * sc[p][1]); }
    LDS_WAIT(); asm volatile("" ::: "memory");
#pragma unroll
    for (int j = 0; j < 8; ++j) { const int n = 8 * j + (lane >> 3), c = lane & 7, sw = (n ^ (n >> 3)) & 7;
        const v4u o = *(const LAS v4u*)(tile + n * 32 + 4 * (c ^ sw));
        *(GAS v4u*)(I.dst + (size_t)n * DM + 8 * c) = o; }
    LDS_WAIT(); asm volatile("" ::: "memory");
}
__device__ __forceinline__ size_t tiled8(size_t row, int kt) { return (row >> 8) * (size_t)(256 * 2048) + (size_t)kt * 32768 + (row & 255) * 128; }
__device__ __forceinline__ void titem8_load(const TItem& I, int hf, f32x4 (&v)[8][2], float (&sc)[8][2], int lane) {
    const int rr = lane >> 4, c4 = lane & 15;
#pragma unroll
    for (int p = 0; p < 4; ++p)
#pragma unroll
        for (int h = 0; h < 4; ++h) { const int k = 64 * hf + 16 * p + 4 * rr + h; v[2 * p + (h >> 1)][h & 1] = __builtin_nontemporal_load((const GAS f32x4*)(I.src + (size_t)k * I.ldw + 4 * c4)); sc[2 * p + (h >> 1)][h & 1] = (I.ksc ? I.ksc[k] : 1.0f) * W8_MUL; }
}
__device__ __forceinline__ void titem8_pack(int hf, const f32x4 (&v)[8][2], const float (&sc)[8][2], LAS unsigned* tile, int lane) {
    const int rr = lane >> 4, c4 = lane & 15;
#pragma unroll
    for (int p = 0; p < 4; ++p)
#pragma unroll
        for (int q = 0; q < 4; ++q) { const int n = 4 * c4 + q, sw = (n ^ (n >> 3)) & 7;
            tile[n * 32 + 4 * ((4 * hf + p) ^ sw) + rr] = pk4_fp8(v[2 * p][0][q] * sc[2 * p][0], v[2 * p][1][q] * sc[2 * p][1], v[2 * p + 1][0][q] * sc[2 * p + 1][0], v[2 * p + 1][1][q] * sc[2 * p + 1][1]); }
}
__device__ __forceinline__ void titem8_flush(const TItem& I, LAS unsigned* tile, int lane) {
    LDS_WAIT(); asm volatile("" ::: "memory");
#pragma unroll
    for (int j = 0; j < 8; ++j) { const int n = 8 * j + (lane >> 3), c = lane & 7, sw = (n ^ (n >> 3)) & 7;
        const v4u o = *(const LAS v4u*)(tile + n * 32 + 4 * (c ^ sw));
        *(GAS v4u*)((unsigned char*)I.dst + (size_t)n * 128 + 16 * c) = o; }
    LDS_WAIT(); asm volatile("" ::: "memory");
}
__device__ __forceinline__ void p0_router_item(const float* W, int k0, bf16* WT, const float* ksc, LAS float* scr, int lane) {
#pragma unroll 8
    for (int i = 0; i < 32; ++i) { const int kk = 2 * i + (lane >> 5); scr[kk * 33 + (lane & 31)] = W[(size_t)(k0 + kk) * 32 + (lane & 31)] * ksc[k0 + kk]; }
    LDS_WAIT(); asm volatile("" ::: "memory");
    const int c = lane & 7;
#pragma unroll
    for (int j = 0; j < 4; ++j) { const int n = (lane >> 3) + 8 * j; const LAS float* s = scr + (8 * c) * 33 + n;
        unsigned h[8], l[8];
#pragma unroll
        for (int q = 0; q < 8; ++q) { const float v = s[q * 33]; h[q] = f2bf(v); l[q] = f2bf(v - __uint_as_float(h[q] << 16)); }
        v4u oh, ol; oh.x = h[0] | (h[1] << 16); oh.y = h[2] | (h[3] << 16); oh.z = h[4] | (h[5] << 16); oh.w = h[6] | (h[7] << 16);
        ol.x = l[0] | (l[1] << 16); ol.y = l[2] | (l[3] << 16); ol.z = l[4] | (l[5] << 16); ol.w = l[6] | (l[7] << 16);
        *(GAS v4u*)(WT + (size_t)n * 2048 + k0 + 8 * c) = oh; *(GAS v4u*)(WT + (size_t)(32 + n) * 2048 + k0 + 8 * c) = ol; }
    LDS_WAIT(); asm volatile("" ::: "memory");
}
__device__ __forceinline__ float log_sigmoidf_(float z) { return fminf(z, 0.f) - log1pf(__expf(-fabsf(z))); }

template <bool XROW>
__device__ __forceinline__ void p0_norm_row(const Ctx& C, const float* xrow, const float* gain, bf16* orow, const LAS float* Wf, int m) {
    const GAS f32x4* xr = (const GAS f32x4*)xrow + C.lane; const GAS f32x4* gr = (const GAS f32x4*)gain + C.lane;
    f32x4 v[8]; float s = 0.f;
#pragma unroll
    for (int j = 0; j < 8; ++j) { v[j] = xr[64 * j]; s += (v[j].x * v[j].x + v[j].y * v[j].y) + (v[j].z * v[j].z + v[j].w * v[j].w); }
    const float rstd = 1.0f / sqrtf(wave_sum(s) * (1.f / DM) + NORM_EPS);
    GAS unsigned long long* o8 = (GAS unsigned long long*)orow + C.lane;
#pragma unroll
    for (int j = 0; j < 8; ++j) { const f32x4 g = gr[64 * j]; v[j] = (v[j] * rstd) * g;
        o8[64 * j] = (unsigned long long)pk2(v[j].x, v[j].y) | ((unsigned long long)pk2(v[j].z, v[j].w) << 32);
        if constexpr (XROW) ((GAS unsigned*)(C.XN8 + (size_t)m * DM))[C.lane + 64 * j] = pk4_fp8(v[j].x * H8_MUL, v[j].y * H8_MUL, v[j].z * H8_MUL, v[j].w * H8_MUL); }
    if constexpr (XROW) {
        float mine = 0.f;
#pragma unroll 1
        for (int h = 0; h < 12; ++h) { const LAS f32x4* w = (const LAS f32x4*)(Wf + h * 2048) + C.lane; float d = 0.f;
#pragma unroll
            for (int j = 0; j < 8; ++j) { const f32x4 ww = w[64 * j]; d += (v[j].x * ww.x + v[j].y * ww.y) + (v[j].z * ww.z + v[j].w * ww.w); }
            d = wave_sum(d); if (C.lane == h) mine = d; }
        const int b = m / SEQ, t = m % SEQ;
        if (C.lane < 12) C.LOGF[(size_t)(b * 12 + C.lane) * SEQ + t] = log_sigmoidf_(mine + C.b_forget[C.lane]);
        if (C.lane < 32) { const float ang = (float)C.pos[m] * INV_FREQ[C.lane]; const double rev = (double)ang * 0.15915494309189535; const float fr = (float)(rev - floor(rev));
            C.ROPE[(size_t)m * 64 + C.lane] = __builtin_amdgcn_cosf(fr); C.ROPE[(size_t)m * 64 + 32 + C.lane] = __builtin_amdgcn_sinf(fr); }
    }
}
constexpr int I_GU = 32 * 16 * 64, I_D = 32 * 16 * 32, I_ING = 16 * 96, I_IN = 32 * PROBE_INW, I_MKV = 32 * 16, I_UF = 12 * 32, I_US = 12 * 32, I_UX = 8 * 32, I_O = 32 * 32;
constexpr int NITEMS = I_GU + I_D + I_ING + I_IN + I_MKV + I_UF + I_US + I_UX + I_O;
constexpr int N8 = I_GU + I_D + I_ING;
__device__ __forceinline__ TItem p0_decode(const Ctx& C, int it) {
        TItem I; int r = it; I.ksc = nullptr; I.f8 = 0; I.gap = 0;
        if (r < I_GU) { const int e = r / 1024, q = r % 1024, kb = 2 * (q / 64), pb = q % 64, tl = pb >> 2, jb = pb & 3;
            const int n0 = (jb < 2) ? (128 * tl + 64 * jb) : (2048 + 128 * tl + 64 * (jb - 2));
            I.ldw = 4096; I.src = C.w_gate_up + (size_t)e * DM * 4096 + (size_t)(64 * kb) * 4096 + n0; I.ksc = C.norm_ffn + 64 * kb; I.f8 = 1; I.dst = (bf16*)((unsigned char*)C.Wgu_t + tiled8((size_t)e * 4096 + 64 * pb, kb >> 1)); return I; } r -= I_GU;
        if (r < I_D) { const int e = r / 512, q = r % 512, kb = 2 * (q / 32), nb = q % 32;
            I.ldw = DM; I.src = C.w_down + (size_t)e * DM * DM + (size_t)(64 * kb) * DM + 64 * nb; I.f8 = 1; I.dst = (bf16*)((unsigned char*)C.Wd_t + tiled8((size_t)e * DM + 64 * nb, kb >> 1)); return I; } r -= I_D;
        if (r < I_ING) { const int kb = 2 * (r / 96), pb = r % 96;
            I.ldw = INW; I.src = C.w_in + (size_t)(64 * kb) * INW + 4108 + 64 * pb; I.f8 = 1; I.dst = (bf16*)((unsigned char*)C.Win8 + tiled8((size_t)64 * pb, kb >> 1)); return I; } r -= I_ING;
        if (r < I_IN) { const int kb = r / PROBE_INW, pb = r % PROBE_INW; int p0 = 64 * pb; const int tl = pb >> 2, q4 = pb & 3;
            if (tl == 3 || tl == 4 || tl == 5 || tl == 12) { p0 = 256 * tl + 128 * (q4 & 1) + 32 * (q4 >> 1); I.gap = 32; }
            const int n0 = (p0 < 2304) ? p0 : p0 + 12;
            I.ldw = INW; I.src = C.w_in + (size_t)(64 * kb) * INW + n0; I.dst = C.Win_t + (size_t)(64 * pb) * DM + 64 * kb; return I; } r -= I_IN;
        if (r < I_MKV) { const int kb = r / 16, nb = r % 16; I.ldw = 1024; I.src = C.w_mem_kv + (size_t)(64 * kb) * 1024 + 64 * nb; I.dst = C.Wmkv_t + (size_t)(64 * nb) * DM + 64 * kb; return I; } r -= I_MKV;
        if (r < I_UF) { const int kb = r / 32, nb = r % 32; I.ldw = DM; I.src = C.w_up_fox + (size_t)(64 * kb) * DM + 64 * nb; I.dst = C.Wup_t + (size_t)(64 * nb) * DM + 64 * kb; return I; } r -= I_UF;
        if (r < I_US) { const int kb = r / 32, nb = r % 32; I.ldw = DM; I.src = C.w_up_swa + (size_t)(64 * kb) * DM + 64 * nb; I.dst = C.Wup_t + (size_t)(64 * nb) * DM + 768 + 64 * kb; return I; } r -= I_US;
        if (r < I_UX) { const int kb = r / 32, nb = r % 32; I.ldw = DM; I.src = C.w_up_xmem + (size_t)(64 * kb) * DM + 64 * nb; I.dst = C.Wup_t + (size_t)(64 * nb) * DM + 1536 + 64 * kb; return I; } r -= I_UX;
        { const int kb = r / 32, nb = r % 32; I.ldw = DM; I.src = C.w_out + (size_t)(64 * kb) * DM + 64 * nb; I.dst = C.Wout_t + (size_t)(64 * nb) * DM + 64 * kb; return I; }
}
__device__ __forceinline__ void p0_fp8_loop(const Ctx& C, int first, int cnt, int me, int stride, LAS unsigned* tile) {
    if (me >= cnt) return;
    const int nh = 2 * ((cnt - me + stride - 1) / stride);
    TItem cur = p0_decode(C, first + me); f32x4 va[8][2]; float sa[8][2]; titem8_load(cur, 0, va, sa, C.lane);
    for (int hs = 0; hs < nh; ++hs) {
        const int hf = hs & 1; TItem nxt = cur; f32x4 vb[8][2]; float sb[8][2];
        if (hs + 1 < nh) { if (hf == 1) nxt = p0_decode(C, first + me + ((hs + 1) >> 1) * stride); titem8_load(nxt, hf ^ 1, vb, sb, C.lane); }
        titem8_pack(hf, va, sa, tile, C.lane);
        if (hf == 1) titem8_flush(cur, tile, C.lane);
        cur = nxt;
#pragma unroll
        for (int p = 0; p < 8; ++p)
#pragma unroll
            for (int h = 0; h < 2; ++h) { va[p][h] = vb[p][h]; sa[p][h] = sb[p][h]; }
    }
}
__device__ __forceinline__ void p0_x_rows2(const Ctx& C, const LAS float* Wf, int m0, int m1) {
    const GAS f32x4* gr = (const GAS f32x4*)C.norm_mix + C.lane;
    const int mm[2] = {m0, m1};
    f32x4 v[2][8]; float s[2] = {0.f, 0.f};
#pragma unroll
    for (int r = 0; r < 2; ++r) { const GAS f32x4* xr = (const GAS f32x4*)(C.x + (size_t)mm[r] * DM) + C.lane;
#pragma unroll
        for (int j = 0; j < 8; ++j) v[r][j] = xr[64 * j]; }
#pragma unroll
    for (int r = 0; r < 2; ++r)
#pragma unroll
        for (int j = 0; j < 8; ++j) s[r] += (v[r][j].x * v[r][j].x + v[r][j].y * v[r][j].y) + (v[r][j].z * v[r][j].z + v[r][j].w * v[r][j].w);
    float rstd[2];
#pragma unroll
    for (int r = 0; r < 2; ++r) rstd[r] = 1.0f / sqrtf(wave_sum(s[r]) * (1.f / DM) + NORM_EPS);
#pragma unroll
    for (int j = 0; j < 8; ++j) { const f32x4 g = gr[64 * j];
#pragma unroll
        for (int r = 0; r < 2; ++r) { v[r][j] = (v[r][j] * rstd[r]) * g;
            ((GAS unsigned long long*)(C.XN + (size_t)mm[r] * DM))[C.lane + 64 * j] = (unsigned long long)pk2(v[r][j].x, v[r][j].y) | ((unsigned long long)pk2(v[r][j].z, v[r][j].w) << 32);
            ((GAS unsigned*)(C.XN8 + (size_t)mm[r] * DM))[C.lane + 64 * j] = pk4_fp8(v[r][j].x * H8_MUL, v[r][j].y * H8_MUL, v[r][j].z * H8_MUL, v[r][j].w * H8_MUL); } }
    float mine[2] = {0.f, 0.f};
#pragma unroll 1
    for (int h = 0; h < 12; ++h) { const LAS f32x4* w = (const LAS f32x4*)(Wf + h * 2048) + C.lane; float d0 = 0.f, d1 = 0.f;
#pragma unroll
        for (int j = 0; j < 8; ++j) { const f32x4 ww = w[64 * j];
            d0 += (v[0][j].x * ww.x + v[0][j].y * ww.y) + (v[0][j].z * ww.z + v[0][j].w * ww.w); d1 += (v[1][j].x * ww.x + v[1][j].y * ww.y) + (v[1][j].z * ww.z + v[1][j].w * ww.w); }
        d0 = wave_sum(d0); d1 = wave_sum(d1); if (C.lane == h) { mine[0] = d0; mine[1] = d1; } }
#pragma unroll
    for (int r = 0; r < 2; ++r) { const int m = mm[r], b = m / SEQ, t = m % SEQ;
        if (C.lane < 12) C.LOGF[(size_t)(b * 12 + C.lane) * SEQ + t] = log_sigmoidf_(mine[r] + C.b_forget[C.lane]);
        if (C.lane < 32) { const float ang = (float)C.pos[m] * INV_FREQ[C.lane]; const double rev = (double)ang * 0.15915494309189535; const float fr = (float)(rev - floor(rev));
            C.ROPE[(size_t)m * 64 + C.lane] = __builtin_amdgcn_cosf(fr); C.ROPE[(size_t)m * 64 + 32 + C.lane] = __builtin_amdgcn_sinf(fr); } }
}
__device__ __forceinline__ void phase0(const Ctx& C) {
    const int gw = C.vcu * NWAVES + C.wave, NGW = C.G * NWAVES;
    LAS float* scr = (LAS float*)(C.lds + RING_OFF + C.wave * 16384);
    for (int r = gw; r < 32; r += NGW) p0_router_item(C.w_router, 64 * r, C.Wr_t, C.norm_ffn, scr, C.lane);
    LAS unsigned* tile = (LAS unsigned*)(C.lds + RING_OFF + C.wave * 8192);
    __syncthreads();
    p0_fp8_loop(C, CONV_IN_P3 ? I_GU + I_D : 0, CONV_IN_P3 ? I_ING : N8, gw, NGW, tile);
    if (N8 + gw < NITEMS) {
        TItem cur = p0_decode(C, N8 + gw); f32x4 va[8][2]; float sa[8][2]; titem_load(cur, va, sa, C.lane);
        for (int it = N8 + gw; it < NITEMS; it += NGW) {
            const int nx = it + NGW; TItem nxt = cur; f32x4 vb[8][2]; float sb[8][2];
            if (nx < NITEMS) { nxt = p0_decode(C, nx); titem_load(nxt, vb, sb, C.lane); }
            titem_store(cur, va, sa, tile, C.lane);
            cur = nxt;
#pragma unroll
            for (int p = 0; p < 8; ++p)
#pragma unroll
                for (int h = 0; h < 2; ++h) { va[p][h] = vb[p][h]; sa[p][h] = sb[p][h]; }
        }
    }
    __syncthreads();
    LAS float* Wf = (LAS float*)(C.lds + RING_OFF);
    for (int idx = C.tid; idx < 12 * 2048; idx += NWAVES * 64) { const int k = idx / 12, h = idx - 12 * k; Wf[h * 2048 + k] = C.w_in[(size_t)k * INW + 2304 + h]; }
    __syncthreads();
    { int m = gw; for (; m + NGW < T; m += 2 * NGW) p0_x_rows2(C, Wf, m, m + NGW); if (m < T) p0_norm_row<true>(C, C.x + (size_t)m * DM, C.norm_mix, C.XN + (size_t)m * DM, Wf, m); }
    for (int m = gw; m < MROWS; m += NGW) p0_norm_row<false>(C, C.mem + (size_t)m * DM, C.norm_mem, C.MN + (size_t)m * DM, Wf, m);
    __syncthreads();
}

constexpr int CONV_CHUNK = 32, CONV_NCHUNK = (I_GU + I_D) / CONV_CHUNK;
static_assert((I_GU + I_D) % CONV_CHUNK == 0, "conversion chunks");
__device__ __forceinline__ void conv_chunk(const Ctx& C, int chunk) {
    LAS unsigned* tile = (LAS unsigned*)(C.lds + RING_OFF + C.wave * 8192);
    p0_fp8_loop(C, chunk * CONV_CHUNK, CONV_CHUNK, C.wave, NWAVES, tile);
}

using pg8::Unit;
template <int RB>
struct DenseOrderT {
    const char* A; const char* Bt; int nM, nN, nwg, G, c;
    __device__ __forceinline__ void init(const void* A_, const void* Bt_, int M, int N, int G_, int c_) { A = (const char*)A_; Bt = (const char*)Bt_; nM = M / 256; nN = N / 256; nwg = nM * nN; G = G_; c = c_; }
    __device__ __forceinline__ bool map(long L, Unit& u) const {
        if (L >= nwg) return false;
        int wgid = (int)L; { const int q = nwg / 8, r = nwg % 8, xcd = wgid % 8, off = wgid / 8; wgid = (xcd < r ? xcd * (q + 1) : r * (q + 1) + (xcd - r) * q) + off; }
        const int nig = 8 * nN, gid = wgid / nig, fm = gid * 8, gsz = (nM - fm) < 8 ? (nM - fm) : 8;
        u.pm = fm + ((wgid % nig) % gsz); u.pn = (wgid % nig) / gsz; u.e = 0; u.kind = 0; return true;
    }
    __device__ __forceinline__ bool next(int i, Unit& u) const { return map((long)i * G + c, u); }
    __device__ __forceinline__ const char* a_base(const Unit& u) const { return A + (size_t)u.pm * (256 * RB); }
    __device__ __forceinline__ const char* b_base(const Unit& u) const { return Bt + (size_t)u.pn * (256 * RB); }
    __device__ __forceinline__ void a_offs(const Unit&, const int (&R)[2], const int (&Cc)[2], unsigned (&vo)[2][2]) const {
#pragma unroll
        for (int h = 0; h < 2; ++h)
#pragma unroll
            for (int i = 0; i < 2; ++i) vo[h][i] = (unsigned)((h * 128 + R[i]) * RB + Cc[i] * 2);
    }
};
typedef DenseOrderT<4096> DenseOrder;
struct P1Order {
    DenseOrder d; const char* A1; const char* B1;
    __device__ __forceinline__ bool next(int i, Unit& u) const {
        const long L = (long)i * d.G + d.c;
        if (L < d.nwg) return d.map(L, u);
        const int r = (int)(L - d.nwg); if (r >= 8) return false;
        u.pm = r >> 2; u.pn = r & 3; u.e = 0; u.kind = 1; return true;
    }
    __device__ __forceinline__ const char* a_base(const Unit& u) const { return (u.kind ? A1 : d.A) + (size_t)u.pm * (256 * 2048 * 2); }
    __device__ __forceinline__ const char* b_base(const Unit& u) const { return (u.kind ? B1 : d.Bt) + (size_t)u.pn * (256 * 2048 * 2); }
    __device__ __forceinline__ void a_offs(const Unit& u, const int (&R)[2], const int (&Cc)[2], unsigned (&vo)[2][2]) const { d.a_offs(u, R, Cc, vo); }
};
struct P1bOrder {
    DenseOrderT<2048> d;
    __device__ __forceinline__ bool next(int i, Unit& u) const {
        const int c = d.c;
        if (c < 8) return i < 4 ? d.map((long)i * d.G + c, u) : false;
        if (i < 6) return d.map((long)i * d.G + c, u);
        if (i == 6 && c < 24) { const int idx = c - 8; return d.map((long)(4 + (idx & 1)) * d.G + (idx >> 1), u); }
        return false;
    }
    __device__ __forceinline__ const char* a_base(const Unit& u) const { return d.a_base(u); }
    __device__ __forceinline__ const char* b_base(const Unit& u) const { return d.b_base(u); }
    __device__ __forceinline__ void a_offs(const Unit& u, const int (&R)[2], const int (&Cc)[2], unsigned (&vo)[2][2]) const { d.a_offs(u, R, Cc, vo); }
};
template <bool GATHER, int NT, int RB>
struct MoeOrder {
    const char* A; const char* Bt; const int* tok; const int* cnt; const LAS int* tab; int G, c;
    __device__ __forceinline__ bool next(int i, Unit& u) const {
        const int L = i * G + c; if (L >= __builtin_amdgcn_readfirstlane(tab[32])) return false;
        int e = 0;
#pragma unroll 1
        for (int j = 1; j < 32; ++j) e += (__builtin_amdgcn_readfirstlane(tab[j]) <= L) ? 1 : 0;
        const int j = L - __builtin_amdgcn_readfirstlane(tab[e]), mt = __builtin_amdgcn_readfirstlane(tab[33 + e]), per = mt * 4, ntg = j / per, r = j - ntg * per;
        u.e = e; u.pm = r >> 2; u.pn = ntg * 4 + (r & 3); u.kind = __builtin_amdgcn_readfirstlane(tab[65 + e]) + 256 * u.pm;
        return true;
    }
    __device__ __forceinline__ const char* a_base(const Unit& u) const { return GATHER ? A : A + (size_t)u.kind * RB; }
    __device__ __forceinline__ const char* b_base(const Unit& u) const { return Bt + ((size_t)u.e * NT + u.pn) * (256 * RB); }
    __device__ __forceinline__ void a_offs(const Unit& u, const int (&R)[2], const int (&Cc)[2], unsigned (&vo)[2][2]) const {
#pragma unroll
        for (int h = 0; h < 2; ++h)
#pragma unroll
            for (int i = 0; i < 2; ++i) {
                if constexpr (GATHER) { const int n_e = __builtin_amdgcn_readfirstlane(tab[97 + u.e]); int ri = 256 * u.pm + h * 128 + R[i]; ri = ri < n_e ? ri : n_e - 1;
                    const int row = tok[u.e * CAP + ri]; vo[h][i] = (unsigned)(row * RB + Cc[i] * 2); }
                else vo[h][i] = (unsigned)((h * 128 + R[i]) * RB + Cc[i] * 2);
            }
    }
};

struct EpiInProj {
    static constexpr bool PERM = true, MID = false, FP8 = false, ASM_MFMA = false, BTILED = false; static constexpr int SCALE_A = 0x7f, SCALE_B = 0x7f;
    bf16* QKV; bf16* Gt; bf16* MKV; int noop; const float* gk_fox; const float* gk_swa; const float* rope;
    __device__ __forceinline__ void mid(pg8::f32x4 (&)[2][2][4][2], const Unit&, int, int, int, int, int) const {}
    __device__ __forceinline__ void operator()(const pg8::f32x4 (&acc)[2][2][4][2], const Unit& u, int wr, int wc, int fr, int fq) const {
        asm volatile("" : "+v"(fr), "+v"(fq));
        if (noop) return;
        if (!u.kind && (u.pn == 3 || u.pn == 4 || u.pn == 5 || u.pn == 12)) {
            const bool swa = (u.pn == 12); const float* gp = (swa ? gk_swa : gk_fox) + 8 * fq;
            float gn[2][8];
#pragma unroll
            for (int bj = 0; bj < 2; ++bj) { const pg8::f32x4 a = *(const pg8::f32x4*)(gp + 32 * bj), b = *(const pg8::f32x4*)(gp + 32 * bj + 4);
                gn[bj][0] = a[0]; gn[bj][1] = a[1]; gn[bj][2] = a[2]; gn[bj][3] = a[3]; gn[bj][4] = b[0]; gn[bj][5] = b[1]; gn[bj][6] = b[2]; gn[bj][7] = b[3]; }
#pragma unroll
            for (int ai = 0; ai < 2; ++ai)
#pragma unroll
                for (int m = 0; m < 4; ++m) { const int row = u.pm * 256 + wr * 64 + fr + ai * 128 + m * 16;
                    float x[2][8]; float ss = 0.f;
#pragma unroll
                    for (int bj = 0; bj < 2; ++bj)
#pragma unroll
                        for (int n = 0; n < 2; ++n)
#pragma unroll
                            for (int e = 0; e < 4; ++e) { const float v = acc[ai][bj][m][n][e]; x[bj][4 * n + e] = v; ss += v * v; }
                    ss += __shfl_xor(ss, 16); ss += __shfl_xor(ss, 32);
                    const float rstd = 1.0f / sqrtf(ss * (1.f / 64.f) + NORM_EPS);
#pragma unroll
                    for (int bj = 0; bj < 2; ++bj)
#pragma unroll
                        for (int q = 0; q < 8; ++q) x[bj][q] = (x[bj][q] * rstd) * gn[bj][q];
                    if (swa) { const float* cs = rope + (size_t)row * 64 + 8 * fq;
                        const pg8::f32x4 c0 = *(const pg8::f32x4*)cs, c1 = *(const pg8::f32x4*)(cs + 4), s0 = *(const pg8::f32x4*)(cs + 32), s1 = *(const pg8::f32x4*)(cs + 36);
                        const float cc[8] = {c0[0], c0[1], c0[2], c0[3], c1[0], c1[1], c1[2], c1[3]}, sn[8] = {s0[0], s0[1], s0[2], s0[3], s1[0], s1[1], s1[2], s1[3]};
#pragma unroll
                        for (int q = 0; q < 8; ++q) { const float x1 = x[0][q], x2 = x[1][q]; x[0][q] = x1 * cc[q] - x2 * sn[q]; x[1][q] = x2 * cc[q] + x1 * sn[q]; } }
                    bf16* rowp = QKV + (size_t)row * QKVW + u.pn * 256 + 64 * wc + 8 * fq;
#pragma unroll
                    for (int bj = 0; bj < 2; ++bj) { u32x4 w; w.x = cvt_pk_bf16(x[bj][0], x[bj][1]); w.y = cvt_pk_bf16(x[bj][2], x[bj][3]); w.z = cvt_pk_bf16(x[bj][4], x[bj][5]); w.w = cvt_pk_bf16(x[bj][6], x[bj][7]);
                        *(u32x4*)(rowp + 32 * bj) = w; } }
            return;
        }
        const int row0 = u.pm * 256 + wr * 64 + fr;
        bf16* base; int ldc, colt; bool sg = false;
        if (u.kind) { base = MKV; ldc = 1024; colt = u.pn * 256; }
        else if (u.pn < 16) { base = QKV; ldc = QKVW; colt = u.pn * 256; }
        else { base = Gt; ldc = GW; colt = (u.pn - 16) * 256; sg = true; }
        const int col0 = colt + wc * 32 + 8 * fq;
#pragma unroll
        for (int ai = 0; ai < 2; ++ai)
#pragma unroll
            for (int m = 0; m < 4; ++m) { bf16* rowp = base + (size_t)(row0 + ai * 128 + m * 16) * ldc + col0;
#pragma unroll
                for (int bj = 0; bj < 2; ++bj) { pg8::f32x4 v0 = acc[ai][bj][m][0], v1 = acc[ai][bj][m][1];
                    if (sg) {
#pragma unroll
                        for (int q = 0; q < 4; ++q) { v0[q] = sigmoidf_(fmaxf(v0[q], -30.f)); v1[q] = sigmoidf_(fmaxf(v1[q], -30.f)); } }
                    u32x4 w; w.x = cvt_pk_bf16(v0[0], v0[1]); w.y = cvt_pk_bf16(v0[2], v0[3]); w.z = cvt_pk_bf16(v1[0], v1[1]); w.w = cvt_pk_bf16(v1[2], v1[3]);
                    *(u32x4*)(rowp + bj * 128) = w; } }
    }
};
#ifndef PROBE_GASM
#define PROBE_GASM true
#endif
struct EpiGates {
    static constexpr bool PERM = true, MID = false, FP8 = true, ASM_MFMA = PROBE_GASM, BTILED = true; static constexpr int SCALE_A = 127 - H8_SHIFT, SCALE_B = 127 - W8_SHIFT;
    bf16* Gt;
    __device__ __forceinline__ void mid(pg8::f32x4 (&)[2][2][4][2], const Unit&, int, int, int, int, int) const {}
    __device__ __forceinline__ void operator()(const pg8::f32x4 (&acc)[2][2][4][2], const Unit& u, int wr, int wc, int fr, int fq) const {
        asm volatile("" : "+v"(fr), "+v"(fq));
        const int row0 = u.pm * 256 + wr * 64 + fr, col0 = u.pn * 256 + wc * 32 + 8 * fq;
#pragma unroll
        for (int ai = 0; ai < 2; ++ai)
#pragma unroll
            for (int m = 0; m < 4; ++m) { bf16* rowp = Gt + (size_t)(row0 + ai * 128 + m * 16) * GW + col0;
#pragma unroll
                for (int bj = 0; bj < 2; ++bj) { unsigned wv[4];
#pragma unroll
                    for (int n = 0; n < 2; ++n)
#pragma unroll
                        for (int hq = 0; hq < 2; ++hq) { typedef pg8::f32x2 f2;
                            f2 x = {fmaxf(acc[ai][bj][m][n][2 * hq], -30.f), fmaxf(acc[ai][bj][m][n][2 * hq + 1], -30.f)};
                            const f2 t = x * (-LOG2E); f2 e; e.x = __builtin_amdgcn_exp2f(t.x); e.y = __builtin_amdgcn_exp2f(t.y);
                            const f2 d = e + 1.0f; wv[2 * n + hq] = cvt_pk_bf16(__builtin_amdgcn_rcpf(d.x), __builtin_amdgcn_rcpf(d.y)); }
                    u32x4 w; w.x = wv[0]; w.y = wv[1]; w.z = wv[2]; w.w = wv[3];
                    *(u32x4*)(rowp + bj * 128) = w; } }
    }
};
struct EpiMerge {
    static constexpr bool PERM = true, MID = true, FP8 = false, ASM_MFMA = false, BTILED = false; static constexpr int SCALE_A = 0x7f, SCALE_B = 0x7f;
    const bf16* Gt; bf16* O;
    __device__ __forceinline__ void mid(pg8::f32x4 (&acc)[2][2][4][2], const Unit& u, int which, int wr, int wc, int fr, int fq) const {
        asm volatile("" : "+v"(fr), "+v"(fq));
        const int row0 = u.pm * 256 + wr * 64 + fr, col0 = u.pn * 256 + wc * 32 + 8 * fq;
        const bf16* gn = Gt + (which ? 2048 : 0); const bf16* gd = Gt + (which ? 4096 : 2048);
#pragma unroll
        for (int ai = 0; ai < 2; ++ai)
#pragma unroll
            for (int m = 0; m < 4; ++m) { const size_t ro = (size_t)(row0 + ai * 128 + m * 16) * GW + col0;
#pragma unroll
                for (int bj = 0; bj < 2; ++bj) { const u32x4 a = *(const u32x4*)(gn + ro + bj * 128), b = *(const u32x4*)(gd + ro + bj * 128);
                    pg8::f32x4 r0, r1;
                    r0[0] = bf_lo(a.x) * __builtin_amdgcn_rcpf(bf_lo(b.x)); r0[1] = bf_hi(a.x) * __builtin_amdgcn_rcpf(bf_hi(b.x)); r0[2] = bf_lo(a.y) * __builtin_amdgcn_rcpf(bf_lo(b.y)); r0[3] = bf_hi(a.y) * __builtin_amdgcn_rcpf(bf_hi(b.y));
                    r1[0] = bf_lo(a.z) * __builtin_amdgcn_rcpf(bf_lo(b.z)); r1[1] = bf_hi(a.z) * __builtin_amdgcn_rcpf(bf_hi(b.z)); r1[2] = bf_lo(a.w) * __builtin_amdgcn_rcpf(bf_lo(b.w)); r1[3] = bf_hi(a.w) * __builtin_amdgcn_rcpf(bf_hi(b.w));
                    acc[ai][bj][m][0] *= r0; acc[ai][bj][m][1] *= r1; }
                asm volatile("" : "+v"(acc[ai][0][m][0]), "+v"(acc[ai][0][m][1]), "+v"(acc[ai][1][m][0]), "+v"(acc[ai][1][m][1]));
                asm volatile("" ::: "memory"); }
    }
    __device__ __forceinline__ void operator()(const pg8::f32x4 (&acc)[2][2][4][2], const Unit& u, int wr, int wc, int fr, int fq) const {
        asm volatile("" : "+v"(fr), "+v"(fq));
        const int row0 = u.pm * 256 + wr * 64 + fr, col0 = u.pn * 256 + wc * 32 + 8 * fq;
#pragma unroll
        for (int ai = 0; ai < 2; ++ai)
#pragma unroll
            for (int m = 0; m < 4; ++m) { const size_t rr = (size_t)(row0 + ai * 128 + m * 16);
#pragma unroll
                for (int bj = 0; bj < 2; ++bj) { const u32x4 g = *(const u32x4*)(Gt + rr * GW + 4096 + col0 + bj * 128);
                    const pg8::f32x4 v0 = acc[ai][bj][m][0], v1 = acc[ai][bj][m][1];
                    u32x4 w; w.x = cvt_pk_bf16(v0[0] * bf_lo(g.x), v0[1] * bf_hi(g.x)); w.y = cvt_pk_bf16(v0[2] * bf_lo(g.y), v0[3] * bf_hi(g.y));
                    w.z = cvt_pk_bf16(v1[0] * bf_lo(g.z), v1[1] * bf_hi(g.z)); w.w = cvt_pk_bf16(v1[2] * bf_lo(g.w), v1[3] * bf_hi(g.w));
                    *(u32x4*)(O + rr * DM + col0 + bj * 128) = w; }
                asm volatile("" ::: "memory"); }
    }
};
struct EpiOut {
    static constexpr bool PERM = true, MID = false, FP8 = false, ASM_MFMA = false, BTILED = false; static constexpr int SCALE_A = 0x7f, SCALE_B = 0x7f;
    const float* X; float* out; unsigned char* HB8; int noop;
    __device__ __forceinline__ void mid(pg8::f32x4 (&)[2][2][4][2], const Unit&, int, int, int, int, int) const {}
    __device__ __forceinline__ void operator()(const pg8::f32x4 (&acc)[2][2][4][2], const Unit& u, int wr, int wc, int fr, int fq) const {
        asm volatile("" : "+v"(fr), "+v"(fq));
        if (noop) return;
        const int row0 = u.pm * 256 + wr * 64 + fr, col0 = u.pn * 256 + wc * 32 + 8 * fq;
#pragma unroll
        for (int ai = 0; ai < 2; ++ai)
#pragma unroll
            for (int mp = 0; mp < 2; ++mp) {
                pg8::f32x4 xv[2][2][2];
#pragma unroll
                for (int mm = 0; mm < 2; ++mm) { const size_t off = (size_t)(row0 + ai * 128 + (2 * mp + mm) * 16) * DM + col0;
#pragma unroll
                    for (int bj = 0; bj < 2; ++bj) { xv[mm][bj][0] = *(const pg8::f32x4*)(X + off + bj * 128); xv[mm][bj][1] = *(const pg8::f32x4*)(X + off + bj * 128 + 4); } }
#pragma unroll
                for (int mm = 0; mm < 2; ++mm) { const int m = 2 * mp + mm; const size_t off = (size_t)(row0 + ai * 128 + m * 16) * DM + col0;
#pragma unroll
                    for (int bj = 0; bj < 2; ++bj) { const pg8::f32x4 h0 = xv[mm][bj][0] + acc[ai][bj][m][0], h1 = xv[mm][bj][1] + acc[ai][bj][m][1];
                        *(pg8::f32x4*)(out + off + bj * 128) = h0; *(pg8::f32x4*)(out + off + bj * 128 + 4) = h1;
                        u32x2 w; w.x = pk4_fp8(h0[0] * H8_MUL, h0[1] * H8_MUL, h0[2] * H8_MUL, h0[3] * H8_MUL); w.y = pk4_fp8(h1[0] * H8_MUL, h1[1] * H8_MUL, h1[2] * H8_MUL, h1[3] * H8_MUL);
                        *(u32x2*)(HB8 + off + bj * 128) = w; } }
                asm volatile("" ::: "memory");
            }
    }
};
struct EpiGateUp {
    static constexpr bool PERM = true, MID = false, FP8 = true, ASM_MFMA = true, BTILED = true; static constexpr int SCALE_A = 127 - H8_SHIFT, SCALE_B = 127 - W8_SHIFT;
    const float* RS; const float* bgu; unsigned char* ACT8;
    __device__ __forceinline__ void mid(pg8::f32x4 (&)[2][2][4][2], const Unit&, int, int, int, int, int) const {}
    __device__ __forceinline__ void operator()(const pg8::f32x4 (&acc)[2][2][4][2], const Unit& u, int wr, int wc, int fr, int fq) const {
        asm volatile("" : "+v"(fr), "+v"(fq));
        const int r0 = wr * 64 + fr, hc0 = u.pn * 128 + wc * 32 + 8 * fq;
        const float* bg = bgu + (size_t)u.e * 4096 + hc0;
        const pg8::f32x4 bg0 = *(const pg8::f32x4*)(bg), bg1 = *(const pg8::f32x4*)(bg + 4), bu0 = *(const pg8::f32x4*)(bg + 2048), bu1 = *(const pg8::f32x4*)(bg + 2052);
        float rsv[2][4];
#pragma unroll
        for (int ai = 0; ai < 2; ++ai)
#pragma unroll
            for (int m = 0; m < 4; ++m) rsv[ai][m] = RS[u.e * CAP + 256 * u.pm + r0 + ai * 128 + m * 16];
#pragma unroll
        for (int ai = 0; ai < 2; ++ai)
#pragma unroll
            for (int m = 0; m < 4; ++m) { const int rl = r0 + ai * 128 + m * 16;
                const float rs = rsv[ai][m];
                typedef pg8::f32x2 f2;
                f2 a2[4];
#pragma unroll
                for (int n = 0; n < 2; ++n)
#pragma unroll
                    for (int hq = 0; hq < 2; ++hq) {
                        const f2 ag = {acc[ai][0][m][n][2 * hq], acc[ai][0][m][n][2 * hq + 1]}, au = {acc[ai][1][m][n][2 * hq], acc[ai][1][m][n][2 * hq + 1]};
                        const f2 bgv = n ? (f2){bg1[2 * hq], bg1[2 * hq + 1]} : (f2){bg0[2 * hq], bg0[2 * hq + 1]}, buv = n ? (f2){bu1[2 * hq], bu1[2 * hq + 1]} : (f2){bu0[2 * hq], bu0[2 * hq + 1]};
                        f2 g = ag * rs + bgv, up = au * rs + buv;
                        g.x = fminf(g.x, SWIGLU_LIMIT); g.y = fminf(g.y, SWIGLU_LIMIT);
                        up.x = __builtin_amdgcn_fmed3f(up.x, -SWIGLU_LIMIT, SWIGLU_LIMIT); up.y = __builtin_amdgcn_fmed3f(up.y, -SWIGLU_LIMIT, SWIGLU_LIMIT);
                        const f2 t = g * (-SWIGLU_ALPHA * LOG2E);
                        f2 e; e.x = __builtin_amdgcn_exp2f(t.x); e.y = __builtin_amdgcn_exp2f(t.y);
                        const f2 d = e + 1.0f;
                        f2 r; r.x = __builtin_amdgcn_rcpf(d.x); r.y = __builtin_amdgcn_rcpf(d.y);
                        const f2 sg = (g * ACT8_MUL) * r;
                        a2[2 * n + hq] = up * sg + sg;
                    }
                u32x2 w;
                { int p0 = __builtin_amdgcn_cvt_pk_fp8_f32(a2[0].x, a2[0].y, 0, false); p0 = __builtin_amdgcn_cvt_pk_fp8_f32(a2[1].x, a2[1].y, p0, true); w.x = (unsigned)p0;
                  int p1 = __builtin_amdgcn_cvt_pk_fp8_f32(a2[2].x, a2[2].y, 0, false); p1 = __builtin_amdgcn_cvt_pk_fp8_f32(a2[3].x, a2[3].y, p1, true); w.y = (unsigned)p1; }
                *(u32x2*)(ACT8 + (size_t)(u.kind + rl) * DM + hc0) = w; }
    }
};
struct EpiDown {
    static constexpr bool PERM = true, MID = false, FP8 = true, ASM_MFMA = true, BTILED = true; static constexpr int SCALE_A = 127 - ACT8_SHIFT, SCALE_B = 127 - W8_SHIFT;
    const float* bd; bf16* Y; int noop;
    __device__ __forceinline__ void mid(pg8::f32x4 (&)[2][2][4][2], const Unit&, int, int, int, int, int) const {}
    __device__ __forceinline__ void operator()(const pg8::f32x4 (&acc)[2][2][4][2], const Unit& u, int wr, int wc, int fr, int fq) const {
        asm volatile("" : "+v"(fr), "+v"(fq));
        if (noop) return;
        const int r0 = wr * 64 + fr, col0 = u.pn * 256 + wc * 32 + 8 * fq;
        const float* bb = bd + (size_t)u.e * DM + col0;
        pg8::f32x4 bv[2][2];
#pragma unroll
        for (int bj = 0; bj < 2; ++bj)
#pragma unroll
            for (int n = 0; n < 2; ++n) bv[bj][n] = *(const pg8::f32x4*)(bb + bj * 128 + n * 4);
#pragma unroll
        for (int ai = 0; ai < 2; ++ai)
#pragma unroll
            for (int m = 0; m < 4; ++m) { bf16* rowp = Y + (size_t)(u.kind + r0 + ai * 128 + m * 16) * DM + col0;
#pragma unroll
                for (int bj = 0; bj < 2; ++bj) { const pg8::f32x4 v0 = acc[ai][bj][m][0] + bv[bj][0], v1 = acc[ai][bj][m][1] + bv[bj][1];
                    u32x4 w; w.x = cvt_pk_bf16(v0[0], v0[1]); w.y = cvt_pk_bf16(v0[2], v0[3]); w.z = cvt_pk_bf16(v1[0], v1[1]); w.w = cvt_pk_bf16(v1[2], v1[3]);
                    *(u32x4*)(rowp + bj * 128) = w; } }
    }
};

__device__ __forceinline__ void logf_cumsum(const Ctx& C) {
    LAS float* wt = (LAS float*)(C.lds + RING_OFF);
    for (int sq = (int)blockIdx.x; sq < BATCH * 12; sq += C.G) {
        const float* src = C.LOGF + (size_t)sq * SEQ + C.tid * 16; float* dst = C.CNEG + (size_t)sq * SEQ + C.tid * 16;
        f32x4 a[4]; float tot = 0.f;
#pragma unroll
        for (int j = 0; j < 4; ++j) { a[j] = *(const GAS f32x4*)(src + 4 * j); tot += (a[j].x + a[j].y) + (a[j].z + a[j].w); }
        float incl = tot;
#pragma unroll
        for (int o = 1; o < 64; o <<= 1) { const float n = __shfl_up(incl, o); if (C.lane >= o) incl += n; }
        if (C.lane == 63) wt[C.wave] = incl;
        __syncthreads();
        float run = incl - tot;
        for (int w = 0; w < C.wave; ++w) run += wt[w];
#pragma unroll
        for (int j = 0; j < 4; ++j) { f32x4 c; run += a[j].x; c.x = -run * LOG2E; run += a[j].y; c.y = -run * LOG2E; run += a[j].z; c.z = -run * LOG2E; run += a[j].w; c.w = -run * LOG2E; *(GAS f32x4*)(dst + 4 * j) = c; }
        __syncthreads();
    }
}

namespace att {
typedef __attribute__((address_space(3))) const char* lds_cptr;
__device__ __forceinline__ void glds16(const void* gsrc, unsigned lds_dst) { unsigned keep;
    asm volatile("s_mov_b32 %0, m0\n\ts_mov_b32 m0, %2\n\ts_nop 0\n\tglobal_load_lds_dwordx4 %1, off\n\ts_mov_b32 m0, %0" : "=&s"(keep) : "v"(gsrc), "s"(lds_dst) : "memory"); }
typedef float f32x2_t __attribute__((ext_vector_type(2))); typedef __bf16 bf16x2_t __attribute__((ext_vector_type(2)));
__device__ __forceinline__ unsigned cvtpk_s(float lo, float hi) { f32x2_t v = {lo, hi}; bf16x2_t b = __builtin_convertvector(v, bf16x2_t); return __builtin_bit_cast(unsigned, b); }
__device__ __forceinline__ int crow(int r, int hi) { return (r & 3) + 8 * (r >> 2) + 4 * hi; }

template <int D> struct Geo {
    static constexpr int SLOTB = 64 * D * 2, NSLOT = (D == 64) ? 3 : 2, PPT = (D == 64) ? 2 : 4;
    static constexpr int LDS_K = 0, LDS_V = NSLOT * SLOTB, LDS_WS = 2 * NSLOT * SLOTB, LDS_WMIN = LDS_WS + 2048, LDS_OST = LDS_WMIN + 64, LDS_CB = LDS_OST + 8 * 4096, LDS_END = LDS_CB + 32768;
};

template <int D>
__device__ __forceinline__ void qkt(f32x16& p0, f32x16& p1, lds_cptr Kslot, const bf16x8* qr, int r32, int hi) {
    lds_cptr kb = Kslot + hi * 1024 + r32 * 16;
    p0 = f32x16{}; p1 = f32x16{};
#pragma unroll
    for (int d0 = 0; d0 < D / 16; ++d0) {
        const bf16x8 b0 = *(const LAS bf16x8*)(kb + d0 * 2048);
        const bf16x8 b1 = *(const LAS bf16x8*)(kb + d0 * 2048 + 512);
        p0 = __builtin_amdgcn_mfma_f32_32x32x16_bf16(b0, qr[d0], p0, 0, 0, 0); p1 = __builtin_amdgcn_mfma_f32_32x32x16_bf16(b1, qr[d0], p1, 0, 0, 0); }
}
template <int D>
__device__ __forceinline__ void pv(f32x16* o, int vb, bf16x8 pa0, bf16x8 pa1, bf16x8 pa2, bf16x8 pa3) {
#pragma unroll
    for (int d0 = 0; d0 < D / 32; ++d0) { s16x4 lo[4], hi[4];
#pragma unroll
        for (int ks = 0; ks < 4; ++ks) {
            asm volatile("ds_read_b64_tr_b16 %0,%1 offset:%c2" : "=&v"(lo[ks]) : "v"(vb), "i"(d0 * 4096 + ks * 1024) : "memory");
            asm volatile("ds_read_b64_tr_b16 %0,%1 offset:%c2" : "=&v"(hi[ks]) : "v"(vb), "i"(d0 * 4096 + ks * 1024 + 512) : "memory"); }
        asm volatile("s_waitcnt lgkmcnt(0)" ::: "memory"); __builtin_amdgcn_sched_barrier(0);
#define ATT_PK(k) (bf16x8){lo[k][0], lo[k][1], lo[k][2], lo[k][3], hi[k][0], hi[k][1], hi[k][2], hi[k][3]}
        o[d0] = __builtin_amdgcn_mfma_f32_32x32x16_bf16(pa0, ATT_PK(0), o[d0], 0, 0, 0);
        o[d0] = __builtin_amdgcn_mfma_f32_32x32x16_bf16(pa1, ATT_PK(1), o[d0], 0, 0, 0);
        o[d0] = __builtin_amdgcn_mfma_f32_32x32x16_bf16(pa2, ATT_PK(2), o[d0], 0, 0, 0);
        o[d0] = __builtin_amdgcn_mfma_f32_32x32x16_bf16(pa3, ATT_PK(3), o[d0], 0, 0, 0);
#undef ATT_PK
    }
}

template <int D, int MODE>
__device__ __forceinline__ void attn_unit(LAS unsigned char* shm, const bf16* Q, int pitchQ, const bf16* K, const bf16* V, int pitchKV, bf16* O, const float* cneg, float sink2, int qb, const float* qgain, const float* kgain, const float* ropet, float bqk = 0.f) {
    typedef Geo<D> G;
    int tid = threadIdx.x; asm volatile("" : "+v"(tid));
    const int lane = tid & 63, r32 = lane & 31, hi = lane >> 5; const int wid = __builtin_amdgcn_readfirstlane(tid >> 6);
    const int q0 = qb * 256, q0w = q0 + wid * 32;
    const unsigned lds0 = (unsigned)(uintptr_t)shm;
    LAS float* wsf = (LAS float*)(shm + G::LDS_WS) + wid * 64;
    LAS float* cb = (LAS float*)(shm + G::LDS_CB);
    const int j_lo = (MODE == 1) ? (qb > 0 ? 4 * qb - 2 : 0) : 0, j_hi = (MODE == 2) ? 4 : 4 * qb + 4;
    bf16x8 qr[D / 16];
    { const bf16* Qw = Q + (size_t)(q0w + r32) * pitchQ + hi * 8;
#pragma unroll
      for (int d0 = 0; d0 < D / 16; ++d0) qr[d0] = *(const GAS bf16x8*)(Qw + d0 * 16); }
    {
#define ATT_UNPK(dst, src) do { const v4u w_ = __builtin_bit_cast(v4u, src); dst[0] = pg8::bf_lo(w_.x); dst[1] = pg8::bf_hi(w_.x); dst[2] = pg8::bf_lo(w_.y); dst[3] = pg8::bf_hi(w_.y); dst[4] = pg8::bf_lo(w_.z); dst[5] = pg8::bf_hi(w_.z); dst[6] = pg8::bf_lo(w_.w); dst[7] = pg8::bf_hi(w_.w); } while (0)
#define ATT_PK8(dst, src) do { v4u w_; w_.x = cvtpk_s(src[0], src[1]); w_.y = cvtpk_s(src[2], src[3]); w_.z = cvtpk_s(src[4], src[5]); w_.w = cvtpk_s(src[6], src[7]); dst = __builtin_bit_cast(bf16x8, w_); } while (0)
        float ss = 0.f;
#pragma unroll
        for (int d0 = 0; d0 < D / 16; ++d0) { float t[8]; ATT_UNPK(t, qr[d0]);
#pragma unroll
            for (int j = 0; j < 8; ++j) ss += t[j] * t[j]; }
        { auto rr = __builtin_amdgcn_permlane32_swap(__float_as_uint(ss), __float_as_uint(ss), false, false); ss = __uint_as_float(rr[0]) + __uint_as_float(rr[1]); }
        const float rq = (1.0f / sqrtf(ss * (1.f / D) + NORM_EPS)) * ((D == 64 ? 0.125f : 0.08838834764831845f) * LOG2E);
        if constexpr (MODE == 1) {
            const float* cs = ropet + (size_t)(q0w + r32) * 64 + 8 * hi;
#pragma unroll
            for (int d0 = 0; d0 < 2; ++d0) { float x1[8], x2[8]; ATT_UNPK(x1, qr[d0]); ATT_UNPK(x2, qr[d0 + 2]);
                const float* g1 = qgain + 16 * d0 + 8 * hi;
                const f32x4 ga = *(const GAS f32x4*)g1, gb = *(const GAS f32x4*)(g1 + 4), gc = *(const GAS f32x4*)(g1 + 32), gd = *(const GAS f32x4*)(g1 + 36);
                const f32x4 c0 = *(const GAS f32x4*)(cs + 16 * d0), c1 = *(const GAS f32x4*)(cs + 16 * d0 + 4), s0 = *(const GAS f32x4*)(cs + 32 + 16 * d0), s1 = *(const GAS f32x4*)(cs + 36 + 16 * d0);
                const float gg1[8] = {ga.x, ga.y, ga.z, ga.w, gb.x, gb.y, gb.z, gb.w}, gg2[8] = {gc.x, gc.y, gc.z, gc.w, gd.x, gd.y, gd.z, gd.w};
                const float cc[8] = {c0.x, c0.y, c0.z, c0.w, c1.x, c1.y, c1.z, c1.w}, sn[8] = {s0.x, s0.y, s0.z, s0.w, s1.x, s1.y, s1.z, s1.w};
#pragma unroll
                for (int j = 0; j < 8; ++j) { const float a = (x1[j] * rq) * gg1[j], b = (x2[j] * rq) * gg2[j]; x1[j] = a * cc[j] - b * sn[j]; x2[j] = b * cc[j] + a * sn[j]; }
                ATT_PK8(qr[d0], x1); ATT_PK8(qr[d0 + 2], x2); asm volatile("" ::: "memory"); }
        } else {
#pragma unroll
            for (int d0 = 0; d0 < D / 16; ++d0) { float t[8]; ATT_UNPK(t, qr[d0]);
                const float* gp = qgain + 16 * d0 + 8 * hi; f32x4 ga = *(const GAS f32x4*)gp, gb = *(const GAS f32x4*)(gp + 4);
                if constexpr (MODE == 2) { ga = ga * *(const GAS f32x4*)(kgain + 16 * d0 + 8 * hi); gb = gb * *(const GAS f32x4*)(kgain + 16 * d0 + 8 * hi + 4); }
                t[0] = (t[0] * rq) * ga.x; t[1] = (t[1] * rq) * ga.y; t[2] = (t[2] * rq) * ga.z; t[3] = (t[3] * rq) * ga.w; t[4] = (t[4] * rq) * gb.x; t[5] = (t[5] * rq) * gb.y; t[6] = (t[6] * rq) * gb.z; t[7] = (t[7] * rq) * gb.w;
                ATT_PK8(qr[d0], t); asm volatile("" ::: "memory"); }
        }
#undef ATT_UNPK
#undef ATT_PK8
    }
    if constexpr (MODE == 2) {
        const int key = tid >> 1, hf = tid & 1; const bf16* kp = K + (size_t)key * pitchKV + 64 * hf; float ss = 0.f;
#pragma unroll
        for (int c = 0; c < 8; ++c) { const v4u w = *(const GAS v4u*)(kp + 8 * c); const float a0 = pg8::bf_lo(w.x), a1 = pg8::bf_hi(w.x), a2 = pg8::bf_lo(w.y), a3 = pg8::bf_hi(w.y), a4 = pg8::bf_lo(w.z), a5 = pg8::bf_hi(w.z), a6 = pg8::bf_lo(w.w), a7 = pg8::bf_hi(w.w);
            ss += (a0 * a0 + a1 * a1) + (a2 * a2 + a3 * a3) + (a4 * a4 + a5 * a5) + (a6 * a6 + a7 * a7); }
        ss += __shfl_xor(ss, 1);
        if (hf == 0) cb[key] = 1.0f / sqrtf(ss * (1.f / 128.f) + NORM_EPS);
    }
    if constexpr (MODE == 0) {
        const int nch = (q0 + 256) / 4;
        for (int c = tid; c < nch; c += 512) { const f32x4 v = *(const GAS f32x4*)(cneg + 4 * c); *(LAS f32x4*)(cb + 4 * c) = v; }
    }
#define ATT_DMA(j, slot) do { const int _s = (slot) * G::SLOTB; \
        if constexpr (D == 64) { \
            glds16(K + (size_t)(64 * (j) + lane) * pitchKV + wid * 8, (unsigned)__builtin_amdgcn_readfirstlane(lds0 + G::LDS_K + _s + wid * 1024)); \
            glds16(V + (size_t)(64 * (j) + 16 * (wid & 3) + (lane >> 2)) * pitchKV + (wid >> 2) * 32 + (lane & 3) * 8, (unsigned)__builtin_amdgcn_readfirstlane(lds0 + G::LDS_V + _s + wid * 1024)); \
        } else { \
            _Pragma("unroll") for (int _p = 0; _p < 2; ++_p) { const int _c = wid + 8 * _p; \
                glds16(K + (size_t)(64 * (j) + lane) * pitchKV + _c * 8, (unsigned)__builtin_amdgcn_readfirstlane(lds0 + G::LDS_K + _s + _c * 1024)); } \
            _Pragma("unroll") for (int _p = 0; _p < 2; ++_p) { const int _c = wid + 8 * _p; \
                glds16(V + (size_t)(64 * (j) + 16 * (_c & 3) + (lane >> 2)) * pitchKV + (_c >> 2) * 32 + (lane & 3) * 8, (unsigned)__builtin_amdgcn_readfirstlane(lds0 + G::LDS_V + _s + _c * 1024)); } \
        } } while (0)
    int slot_i = 0;
    constexpr bool REV = (MODE == 0);
    const int nst = j_hi - j_lo;
#define ATT_TILE(st_) (REV ? (j_hi - 1 - (st_)) : (j_lo + (st_)))
#pragma unroll
    for (int p = 0; p < G::NSLOT - 1; ++p) if (p < nst) ATT_DMA(ATT_TILE(p), p);
    float mhat = -1e30f, l_reg = 0.f; f32x16 o[D / 32];
#pragma unroll
    for (int d0 = 0; d0 < D / 32; ++d0) o[d0] = f32x16{};
    const lds_cptr shm3 = (lds_cptr)shm;
    const int vb0 = (int)(lds0 + G::LDS_V) + ((lane >> 4) & 1) * 32 + (lane & 3) * 8 + (4 * hi + ((lane & 15) >> 2)) * 64;
    const int qabs = q0w + r32;
    LAS float* wmin = (LAS float*)(shm + G::LDS_WMIN);
    for (int st = 0; st < nst; ++st) {
        const int j = ATT_TILE(st);
        if (G::NSLOT == 3 && st + 1 < nst) { if constexpr (G::PPT == 2) asm volatile("s_waitcnt vmcnt(2) lgkmcnt(0)\n\ts_barrier" ::: "memory"); else asm volatile("s_waitcnt vmcnt(4) lgkmcnt(0)\n\ts_barrier" ::: "memory"); }
        else asm volatile("s_waitcnt vmcnt(0) lgkmcnt(0)\n\ts_barrier" ::: "memory");
        if constexpr (MODE == 0) { if (st >= 5) {
            const LAS float* wm = wmin + ((st - 1) & 1) * 8; const f32x4 a = *(const LAS f32x4*)wm, b = *(const LAS f32x4*)(wm + 4);
            const float gmin = fminf(fminf(fminf(a.x, a.y), fminf(a.z, a.w)), fminf(fminf(b.x, b.y), fminf(b.z, b.w)));
            if (cb[64 * j + 63] + bqk < gmin - 40.0f) break; } }
        { const int sn_ = st + G::NSLOT - 1; if (sn_ < nst) { int sn = slot_i + G::NSLOT - 1; if (sn >= G::NSLOT) sn -= G::NSLOT; ATT_DMA(ATT_TILE(sn_), sn); } }
        bool need = true;
        if constexpr (MODE == 0) need = (64 * j <= q0w + 31);
        if constexpr (MODE == 1) need = (64 * j <= q0w + 31) && (64 * j + 63 >= q0w - 127);
        if (need) {
            f32x16 p0, p1;
            qkt<D>(p0, p1, shm3 + G::LDS_K + slot_i * G::SLOTB, qr, r32, hi);
            if constexpr (MODE == 2) {
                const LAS float* rkp = cb + 64 * j + 4 * hi;
#pragma unroll
                for (int g = 0; g < 4; ++g) { const f32x4 b0 = *(const LAS f32x4*)(rkp + 8 * g), b1 = *(const LAS f32x4*)(rkp + 32 + 8 * g);
#pragma unroll
                    for (int e = 0; e < 4; ++e) { p0[4 * g + e] *= b0[e]; p1[4 * g + e] *= b1[e]; } }
            }
            if constexpr (MODE == 0) {
                const LAS float* cbp = cb + 64 * j + 4 * hi;
#pragma unroll
                for (int g = 0; g < 4; ++g) { const f32x4 b0 = *(const LAS f32x4*)(cbp + 8 * g), b1 = *(const LAS f32x4*)(cbp + 32 + 8 * g);
#pragma unroll
                    for (int e = 0; e < 4; ++e) { p0[4 * g + e] += b0[e]; p1[4 * g + e] += b1[e]; } }
                if (64 * j + 63 > q0w) {
#pragma unroll
                    for (int r = 0; r < 16; ++r) { const int kv = 64 * j + crow(r, hi); if (kv > qabs) p0[r] = -INFINITY; if (kv + 32 > qabs) p1[r] = -INFINITY; } }
            }
            if constexpr (MODE == 1) {
#pragma unroll
                for (int r = 0; r < 16; ++r) { const int kv = 64 * j + crow(r, hi); const int d0_ = qabs - kv, d1_ = d0_ - 32;
                    if (d0_ < 0 || d0_ >= 128) p0[r] = -INFINITY; if (d1_ < 0 || d1_ >= 128) p1[r] = -INFINITY; }
            }
            float rm = fmaxf(p0[0], p1[0]);
#pragma unroll
            for (int r = 1; r < 16; ++r) rm = fmaxf(rm, fmaxf(p0[r], p1[r]));
            { auto rr = __builtin_amdgcn_permlane32_swap(__float_as_uint(rm), __float_as_uint(rm), false, false); rm = fmaxf(__uint_as_float(rr[0]), __uint_as_float(rr[1])); }
            if (__any(rm > mhat)) {
                const float mn = fmaxf(mhat, rm); const float f = __builtin_amdgcn_exp2f(mhat - mn); mhat = mn; l_reg *= f;
                if (hi == 0) wsf[r32] = f;
                asm volatile("s_waitcnt lgkmcnt(0)" ::: "memory");
#pragma unroll
                for (int g = 0; g < 4; ++g) { const f32x4 fv = *(const LAS f32x4*)(wsf + 8 * g + 4 * hi);
#pragma unroll
                    for (int d_ = 0; d_ < D / 32; ++d_)
#pragma unroll
                        for (int e = 0; e < 4; ++e) o[d_][4 * g + e] *= fv[e]; }
            }
            float sacc = 0.f;
#pragma unroll
            for (int r = 0; r < 16; ++r) { p0[r] = __builtin_amdgcn_exp2f(p0[r] - mhat); p1[r] = __builtin_amdgcn_exp2f(p1[r] - mhat); sacc += p0[r] + p1[r]; }
            l_reg += sacc;
            u32x4 pw0, pw1, pw2, pw3;
            pw0 = (u32x4){cvtpk_s(p0[0], p0[1]), cvtpk_s(p0[2], p0[3]), cvtpk_s(p0[4], p0[5]), cvtpk_s(p0[6], p0[7])};
            pw1 = (u32x4){cvtpk_s(p0[8], p0[9]), cvtpk_s(p0[10], p0[11]), cvtpk_s(p0[12], p0[13]), cvtpk_s(p0[14], p0[15])};
            pw2 = (u32x4){cvtpk_s(p1[0], p1[1]), cvtpk_s(p1[2], p1[3]), cvtpk_s(p1[4], p1[5]), cvtpk_s(p1[6], p1[7])};
            pw3 = (u32x4){cvtpk_s(p1[8], p1[9]), cvtpk_s(p1[10], p1[11]), cvtpk_s(p1[12], p1[13]), cvtpk_s(p1[14], p1[15])};
            pv<D>(o, vb0 + slot_i * G::SLOTB, __builtin_bit_cast(bf16x8, pw0), __builtin_bit_cast(bf16x8, pw1), __builtin_bit_cast(bf16x8, pw2), __builtin_bit_cast(bf16x8, pw3));
        }
        if constexpr (MODE == 0) { float mn = mhat;
#pragma unroll
            for (int of = 1; of < 32; of <<= 1) mn = fminf(mn, __shfl_xor(mn, of));
            if (lane == 0) wmin[(st & 1) * 8 + wid] = mn; }
        ++slot_i; if (slot_i == G::NSLOT) slot_i = 0;
    }
#undef ATT_DMA
#undef ATT_TILE
    if constexpr (MODE == 0) asm volatile("s_waitcnt vmcnt(0)" ::: "memory");
    { auto rr = __builtin_amdgcn_permlane32_swap(__float_as_uint(l_reg), __float_as_uint(l_reg), false, false); l_reg = __uint_as_float(rr[0]) + __uint_as_float(rr[1]); }
    if constexpr (MODE == 1) l_reg += __builtin_amdgcn_exp2f(sink2 - mhat);
    if (hi == 0) wsf[32 + r32] = l_reg;
    asm volatile("s_waitcnt lgkmcnt(0)" ::: "memory");
    float rli[16];
#pragma unroll
    for (int g = 0; g < 4; ++g) { const f32x4 lv = *(const LAS f32x4*)(wsf + 32 + 8 * g + 4 * hi);
#pragma unroll
        for (int e = 0; e < 4; ++e) rli[4 * g + e] = __builtin_amdgcn_rcpf(lv[e]); }
    bf16* Ow = O + (size_t)q0w * 2048;
    LAS bf16* stg = (LAS bf16*)(shm + G::LDS_OST) + wid * 2048;
#pragma unroll
    for (int ps = 0; ps < D / 64; ++ps) {
#pragma unroll
        for (int r = 0; r < 16; ++r) { const int orow = crow(r, hi);
#pragma unroll
            for (int dl = 0; dl < 2; ++dl) stg[orow * 64 + dl * 32 + r32] = (bf16)f2bf(o[2 * ps + dl][r] * rli[r]); }
        asm volatile("s_waitcnt lgkmcnt(0)" ::: "memory");
#pragma unroll
        for (int i = 0; i < 4; ++i) { const int row = i * 8 + (lane >> 3), ch = lane & 7; const v4u v = *(const LAS v4u*)(stg + row * 64 + ch * 8); *(GAS v4u*)(Ow + (size_t)row * 2048 + ps * 64 + ch * 8) = v; }
        asm volatile("s_waitcnt lgkmcnt(0)" ::: "memory");
    }
    asm volatile("s_waitcnt lgkmcnt(0)\n\ts_barrier" ::: "memory");
}
}

constexpr int NU_FOX = BATCH * 12 * 32, NU_SWA = BATCH * 12 * 32, NU_XM = BATCH * 4 * 32;
__device__ __forceinline__ int att_fetch(const Ctx& C, int q) {
    int v = 0; if (C.tid == 0) v = (int)__hip_atomic_fetch_add((unsigned*)(C.ctl + CW_QHEAD + 64 * q), 1u, RLX_AGENT); return v;
}
__device__ __forceinline__ void phase3(const Ctx& C, int sel = 0) {
    LAS unsigned char* shm = C.lds + RING_OFF;
    volatile LAS int* nxtw = (volatile LAS int*)(C.MISC + 12);
    const bool conv_first = CONV_IN_P3 && sel == 0 && ((blockIdx.x >> 3) & 1);
    auto run_conv = [&]() {
        if (!(CONV_IN_P3 && sel == 0)) return;
        int pre = att_fetch(C, 3);
        if (C.tid == 0) *nxtw = pre;
        __syncthreads();
        int cur = __builtin_amdgcn_readfirstlane(*nxtw);
        __syncthreads();
        while (cur < CONV_NCHUNK) {
            pre = att_fetch(C, 3);
            conv_chunk(C, cur);
            if (C.tid == 0) *nxtw = pre;
            __syncthreads();
            cur = __builtin_amdgcn_readfirstlane(*nxtw);
            __syncthreads();
        }
    };
    if (conv_first) run_conv();
    if (sel == 0 || sel == 4) {
        float gq = fabsf(C.fox_q_norm[C.lane]), gk = fabsf(C.fox_k_norm[C.lane]);
#pragma unroll
        for (int of = 1; of < 64; of <<= 1) { gq = fmaxf(gq, __shfl_xor(gq, of)); gk = fmaxf(gk, __shfl_xor(gk, of)); }
        const float bqk = 64.0f * gq * gk * (0.125f * LOG2E) * 1.02f;
        int pre = att_fetch(C, 0);
        if (C.tid == 0) *nxtw = pre;
        __syncthreads();
        int cur = __builtin_amdgcn_readfirstlane(*nxtw);
        __syncthreads();
        while (cur < NU_FOX) {
            pre = att_fetch(C, 0);
            const int qb = 31 - cur / 24, bh = cur % 24, b = bh / 12, h = bh % 12;
            const bf16* base = C.QKV + (size_t)b * SEQ * QKVW + h * 64;
            att::attn_unit<64, 0>(shm, base + C_FQ, QKVW, base + C_FK, base + C_FV, QKVW, C.OALL + (size_t)b * SEQ * 2048 + h * 64, C.CNEG + (size_t)(b * 12 + h) * SEQ, 0.f, qb, C.fox_q_norm, nullptr, nullptr, bqk);
            if (C.tid == 0) *nxtw = pre;
            __syncthreads();
            cur = __builtin_amdgcn_readfirstlane(*nxtw);
            __syncthreads();
        }
    }
    if (sel == 0 || sel == 5) {
        int pre = att_fetch(C, 1);
        if (C.tid == 0) *nxtw = pre;
        __syncthreads();
        int cur = __builtin_amdgcn_readfirstlane(*nxtw);
        __syncthreads();
        while (cur < NU_SWA) {
            pre = att_fetch(C, 1);
            const int qb = cur / 24, bh = cur % 24, b = bh / 12, h = bh % 12, kvh = h / 3;
            const bf16* base = C.QKV + (size_t)b * SEQ * QKVW;
            att::attn_unit<64, 1>(shm, base + C_SQ + h * 64, QKVW, base + C_SK + kvh * 64, base + C_SV + kvh * 64, QKVW, C.OALL + (size_t)b * SEQ * 2048 + 768 + h * 64, nullptr, C.swa_sinks[h] * LOG2E, qb, C.swa_q_norm, nullptr, C.ROPE + (size_t)b * SEQ * 64);
            if (C.tid == 0) *nxtw = pre;
            __syncthreads();
            cur = __builtin_amdgcn_readfirstlane(*nxtw);
            __syncthreads();
        }
    }
    if (sel == 0 || sel == 6) {
        int pre = att_fetch(C, 2);
        if (C.tid == 0) *nxtw = pre;
        __syncthreads();
        int cur = __builtin_amdgcn_readfirstlane(*nxtw);
        __syncthreads();
        while (cur < NU_XM) {
            pre = att_fetch(C, 2);
            const int qb = cur / 8, bh = cur % 8, b = bh / 4, h = bh % 4;
            const bf16* kb = C.MKV + (size_t)b * NMEM * 1024 + h * 128;
            att::attn_unit<128, 2>(shm, C.QKV + (size_t)b * SEQ * QKVW + C_MQ + h * 128, QKVW, kb, kb + 512, 1024, C.OALL + (size_t)b * SEQ * 2048 + 1536 + h * 128, nullptr, 0.f, qb, C.xmem_q_norm, C.xmem_k_norm, nullptr);
            if (C.tid == 0) *nxtw = pre;
            __syncthreads();
            cur = __builtin_amdgcn_readfirstlane(*nxtw);
            __syncthreads();
        }
    }
    if (!conv_first) run_conv();
}

__device__ __forceinline__ void phase6(const Ctx& C) {
    LAS float* PL = (LAS float*)(C.lds + RING_OFF);
    LAS float* SS = PL + 4 * 64 * 33;
    LAS int* hist = (LAS int*)(SS + 512);
    LAS int* gb = hist + 32;
    const int rg = C.wave & 1, kq = C.wave >> 1, r32 = C.lane & 31, hi = C.lane >> 5;
    const bf16* wh = C.Wr_t + (size_t)r32 * 2048 + 512 * kq + 16 * hi; const bf16* wl = wh + 32 * 2048;
    for (int blk = C.vcu; blk < T / 64; blk += C.G) {
        if (C.tid < 32) hist[C.tid] = 0;
        const int tok = blk * 64 + 32 * rg + r32;
        const float* hr = C.out + (size_t)tok * DM + 512 * kq + 16 * hi;
        f32x16 acc = f32x16{}; float ss = 0.f;
#pragma unroll 2
        for (int kb = 0; kb < 16; ++kb) {
            float f[16];
#pragma unroll
            for (int q = 0; q < 4; ++q) { const f32x4 t = *(const GAS f32x4*)(hr + 32 * kb + 4 * q); f[4 * q] = t.x; f[4 * q + 1] = t.y; f[4 * q + 2] = t.z; f[4 * q + 3] = t.w; }
            unsigned hb[16], lb[16];
#pragma unroll
            for (int q = 0; q < 16; ++q) { ss += f[q] * f[q]; hb[q] = f2bf(f[q]); lb[q] = f2bf(f[q] - __uint_as_float(hb[q] << 16)); }
#pragma unroll
            for (int s = 0; s < 2; ++s) {
                const bf16x8 ah = *(const GAS bf16x8*)(wh + 32 * kb + 8 * s), al = *(const GAS bf16x8*)(wl + 32 * kb + 8 * s);
                v4u bh, bl;
                bh.x = hb[8 * s] | (hb[8 * s + 1] << 16); bh.y = hb[8 * s + 2] | (hb[8 * s + 3] << 16); bh.z = hb[8 * s + 4] | (hb[8 * s + 5] << 16); bh.w = hb[8 * s + 6] | (hb[8 * s + 7] << 16);
                bl.x = lb[8 * s] | (lb[8 * s + 1] << 16); bl.y = lb[8 * s + 2] | (lb[8 * s + 3] << 16); bl.z = lb[8 * s + 4] | (lb[8 * s + 5] << 16); bl.w = lb[8 * s + 6] | (lb[8 * s + 7] << 16);
                acc = __builtin_amdgcn_mfma_f32_32x32x16_bf16(ah, __builtin_bit_cast(bf16x8, bh), acc, 0, 0, 0);
                acc = __builtin_amdgcn_mfma_f32_32x32x16_bf16(ah, __builtin_bit_cast(bf16x8, bl), acc, 0, 0, 0);
                acc = __builtin_amdgcn_mfma_f32_32x32x16_bf16(al, __builtin_bit_cast(bf16x8, bh), acc, 0, 0, 0);
            }
        }
        { LAS float* pr = PL + (size_t)(kq * 64 + 32 * rg + r32) * 33;
#pragma unroll
          for (int r = 0; r < 16; ++r) pr[att::crow(r, hi)] = acc[r];
          SS[(kq * 2 + hi) * 64 + 32 * rg + r32] = ss; }
        __syncthreads();
        int sel[4]; float gt[4]; float rstd = 0.f; int lr[4];
        if (C.tid < 64) {
            float lv[32]; float s2 = 0.f;
#pragma unroll
            for (int q = 0; q < 8; ++q) s2 += SS[q * 64 + C.tid];
            rstd = 1.0f / sqrtf(s2 * (1.f / DM) + NORM_EPS);
#pragma unroll
            for (int e = 0; e < 32; ++e) { const float a = (PL[(0 * 64 + C.tid) * 33 + e] + PL[(1 * 64 + C.tid) * 33 + e]) + (PL[(2 * 64 + C.tid) * 33 + e] + PL[(3 * 64 + C.tid) * 33 + e]); lv[e] = a * rstd + C.b_router[e]; }
            float val[4];
#pragma unroll
            for (int k = 0; k < 4; ++k) { float best = lv[0]; int bi = 0;
#pragma unroll
                for (int e = 1; e < 32; ++e) if (lv[e] > best) { best = lv[e]; bi = e; }
                sel[k] = bi; val[k] = best;
#pragma unroll
                for (int e = 0; e < 32; ++e) lv[e] = (e == bi) ? -INFINITY : lv[e]; }
            float den = 0.f;
#pragma unroll
            for (int k = 0; k < 4; ++k) { gt[k] = __expf(val[k] - val[0]); den += gt[k]; }
            const float inv = 1.0f / den;
#pragma unroll
            for (int k = 0; k < 4; ++k) { gt[k] *= inv; lr[k] = __hip_atomic_fetch_add((LAS int*)(hist + sel[k]), 1, __ATOMIC_RELAXED, __HIP_MEMORY_SCOPE_WORKGROUP); }
        }
        __syncthreads();
        if (C.tid < 32) gb[C.tid] = (int)__hip_atomic_fetch_add((unsigned*)(C.ctl + CW_CNT + C.tid), (unsigned)hist[C.tid], RLX_AGENT);
        __syncthreads();
        if (C.tid < 64) {
            const int t = blk * 64 + C.tid;
#pragma unroll
            for (int k = 0; k < 4; ++k) { const int sl = sel[k] * CAP + gb[sel[k]] + lr[k]; C.TOK[sl] = t; C.RS[sl] = rstd; C.TSLOT[t * 4 + k] = sl; C.TGATE[t * 4 + k] = gt[k]; }
        }
        __syncthreads();
    }
}
template <int NT>
__device__ __forceinline__ void moe_table(const Ctx& C, LAS int* tab) {
    __syncthreads();
    if (C.tid == 0) { int us = 0, rb = 0;
        for (int e = 0; e < 32; ++e) { const int n = (int)__hip_atomic_load((unsigned*)(C.ctl + CW_CNT + e), RLX_AGENT); const int mt = (n + 255) >> 8; tab[e] = us; tab[33 + e] = mt; tab[65 + e] = rb; tab[97 + e] = n; us += mt * NT; rb += mt * 256; }
        tab[32] = us; }
    __syncthreads();
}


__device__ __forceinline__ void phase9(const Ctx& C, const LAS int* tab) {
    const int gw = C.vcu * NWAVES + C.wave, NGW = C.G * NWAVES;
    for (int t = gw; t < T; t += NGW) {
        typedef int v4i_ __attribute__((ext_vector_type(4))); const v4i_ sl = *(const GAS v4i_*)(C.TSLOT + 4 * t); const f32x4 g = *(const GAS f32x4*)(C.TGATE + 4 * t);
        const int s[4] = {sl.x, sl.y, sl.z, sl.w}; const float gg[4] = {g.x, g.y, g.z, g.w};
        const bf16* yr[4];
#pragma unroll
        for (int k = 0; k < 4; ++k) { const int e = s[k] >> 14, rk = s[k] & (CAP - 1); yr[k] = C.Y + (size_t)(tab[65 + e] + rk) * DM + 8 * C.lane; }
        float* orow = C.out + (size_t)t * DM + 8 * C.lane;
#pragma unroll
        for (int j = 0; j < 4; ++j) {
            f32x4 a0 = *(const GAS f32x4*)(orow + 512 * j), a1 = *(const GAS f32x4*)(orow + 512 * j + 4);
#pragma unroll
            for (int k = 0; k < 4; ++k) { const v4u y = *(const GAS v4u*)(yr[k] + 512 * j);
                a0.x += gg[k] * pg8::bf_lo(y.x); a0.y += gg[k] * pg8::bf_hi(y.x); a0.z += gg[k] * pg8::bf_lo(y.y); a0.w += gg[k] * pg8::bf_hi(y.y);
                a1.x += gg[k] * pg8::bf_lo(y.z); a1.y += gg[k] * pg8::bf_hi(y.z); a1.z += gg[k] * pg8::bf_lo(y.w); a1.w += gg[k] * pg8::bf_hi(y.w); }
            *(GAS f32x4*)(orow + 512 * j) = a0; *(GAS f32x4*)(orow + 512 * j + 4) = a1;
        }
    }
}

struct Args { const void* in[26]; float* out; unsigned char* ws; int ph_lo, ph_hi, probe, pad; };
__global__ void __launch_bounds__(NWAVES * 64, 2) mk_fwd(Args args) {
    extern __shared__ __attribute__((aligned(16))) unsigned char lds_raw[];
    Ctx C;
    C.lds = (LAS unsigned char*)lds_raw;
    C.MISC = (volatile LAS unsigned*)(C.lds + MISC_OFF);
    C.tid = threadIdx.x; C.lane = C.tid & 63; C.wave = __builtin_amdgcn_readfirstlane(C.tid >> 6);
    C.probe = args.probe; C.G = gridDim.x; { const int bx = blockIdx.x; C.vcu = (C.G % 8 == 0) ? (bx % 8) * (C.G / 8) + bx / 8 : bx; }
    unsigned char* ws = args.ws;
    C.ctl = (gu32*)(ws + WS_CTL);
    C.x = (const float*)args.in[0]; C.mem = (const float*)args.in[1]; C.pos = (const int*)args.in[2]; C.norm_mix = (const float*)args.in[3]; C.w_in = (const float*)args.in[4];
    C.b_forget = (const float*)args.in[5]; C.fox_q_norm = (const float*)args.in[6]; C.fox_k_norm = (const float*)args.in[7]; C.swa_q_norm = (const float*)args.in[8]; C.swa_k_norm = (const float*)args.in[9];
    C.swa_sinks = (const float*)args.in[10]; C.xmem_q_norm = (const float*)args.in[11]; C.xmem_k_norm = (const float*)args.in[12]; C.norm_mem = (const float*)args.in[13]; C.w_mem_kv = (const float*)args.in[14];
    C.w_up_fox = (const float*)args.in[15]; C.w_up_swa = (const float*)args.in[16]; C.w_up_xmem = (const float*)args.in[17]; C.w_out = (const float*)args.in[18]; C.norm_ffn = (const float*)args.in[19];
    C.w_router = (const float*)args.in[20]; C.b_router = (const float*)args.in[21]; C.w_gate_up = (const float*)args.in[22]; C.b_gate_up = (const float*)args.in[23]; C.w_down = (const float*)args.in[24]; C.b_down = (const float*)args.in[25];
    C.out = args.out;
#define WS_PTRS() do { unsigned char* w_ = args.ws; asm volatile("" : "+s"(w_)); \
    C.ctl = (gu32*)(w_ + WS_CTL); C.Win_t = (bf16*)(w_ + WS_WIN); C.Wmkv_t = (bf16*)(w_ + WS_WMKV); C.Wup_t = (bf16*)(w_ + WS_WUP); C.Wout_t = (bf16*)(w_ + WS_WOUT); C.Wr_t = (bf16*)(w_ + WS_WRT); C.Wgu_t = (bf16*)(w_ + WS_WGU); C.Wd_t = (bf16*)(w_ + WS_WD); \
    C.XN = (bf16*)(w_ + WS_XN); C.MN = (bf16*)(w_ + WS_MN); C.QKV = (bf16*)(w_ + WS_QKV); C.G_ = (bf16*)(w_ + WS_G); C.MKV = (bf16*)(w_ + WS_MKV); C.OALL = (bf16*)(w_ + WS_OALL); C.MERGED = (bf16*)(w_ + WS_MERGED); \
    C.HB = (bf16*)(w_ + WS_HB); C.ACT = (bf16*)(w_ + WS_ACT); C.LOGF = (float*)(w_ + WS_LOGF); C.CNEG = (float*)(w_ + WS_CNEG); C.ROPE = (float*)(w_ + WS_ROPE); C.GATEW = (float*)(w_ + WS_GATE); C.RS = (float*)(w_ + WS_RS); \
    C.TOK = (int*)(w_ + WS_TOK); C.TSLOT = (int*)(w_ + WS_TSLOT); C.TGATE = (float*)(w_ + WS_TGATE); C.Y = (bf16*)(w_ + WS_Y); C.XN8 = w_ + WS_XN8; C.Win8 = w_ + WS_WIN8; } while (0)
    WS_PTRS();
    for (int u = C.tid; u < (LDS_BYTES - LDSCTL_OFF) / 4; u += NWAVES * 64) ((LAS unsigned*)(C.lds + LDSCTL_OFF))[u] = 0u;
    __syncthreads();
    XcdBarrier bar; bar.bar = (unsigned*)(C.ctl + CW_BAR); bar.x = 0; bar.st = nullptr;
    if (N_LAUNCHES == 1) bar = xcd_barrier_post((unsigned*)(C.ctl + CW_BAR), C.MISC + 8);
    const int lo = args.ph_lo, hi = args.ph_hi;
#ifndef MK_PHASE_MASK
#define MK_PHASE_MASK 0x3FF
#endif
#define IN(k) ((((MK_PHASE_MASK) >> (k)) & 1) && lo <= (k) && (k) < hi)
#define SEAM(k) do { if (IN(k) && IN((k) + 1)) xcd_barrier(bar); } while (0)
    LAS int* tab = (LAS int*)(C.lds + MOE_OFF);

    if (IN(0)) { WS_PTRS(); phase0(C); }
    SEAM(0);
    if (IN(1)) { WS_PTRS();
        logf_cumsum(C);
        P1Order S; S.d.init(C.XN, C.Win_t, T, PROBE_INW * 64, C.G, (int)blockIdx.x); S.A1 = (const char*)C.MN; S.B1 = (const char*)C.Wmkv_t;
        EpiInProj E{C.QKV, C.G_, C.MKV, args.probe == 1, C.fox_k_norm, C.swa_k_norm, C.ROPE};
        if (args.probe != 3) pg8::gemm_phase<EpiInProj, P1Order>(C.lds + RING_OFF, S, E);
        P1bOrder S8; S8.d.init(C.XN8, C.Win8, T, 6144, C.G, (int)blockIdx.x);
#ifdef PROBE_DET
#pragma unroll 1
        for (int rep = 0; rep < 2; ++rep) { EpiGates E8{rep ? C.Y : C.ACT}; pg8::gemm_phase<EpiGates, P1bOrder>(C.lds + RING_OFF, S8, E8); }
#else
#ifdef PROBE_GDUMMY
        EpiGates E8{C.ACT};
#else
        EpiGates E8{C.G_};
#endif
        if (args.probe != 2) pg8::gemm_phase<EpiGates, P1bOrder>(C.lds + RING_OFF, S8, E8);
#endif
    }
    SEAM(1);
    if (IN(3)) { WS_PTRS(); phase3(C, args.probe >= 4 ? args.probe : 0); }
    SEAM(3);
    if (IN(4)) { WS_PTRS();
        DenseOrder S; S.init(C.OALL, C.Wup_t, T, DM, C.G, (int)blockIdx.x);
        EpiMerge E{C.G_, C.MERGED};
        pg8::gemm_phase<EpiMerge, DenseOrder>(C.lds + RING_OFF, S, E);
    }
    SEAM(4);
    if (IN(5)) { WS_PTRS();
        DenseOrder S; S.init(C.MERGED, C.Wout_t, T, DM, C.G, (int)blockIdx.x);
        EpiOut E{C.x, C.out, (unsigned char*)C.HB, args.probe == 1};
        pg8::gemm_phase<EpiOut, DenseOrder, false>(C.lds + RING_OFF, S, E);
    }
    SEAM(5);
    if (IN(6)) { WS_PTRS(); phase6(C); }
    SEAM(6);
    if (IN(7)) { WS_PTRS();
        moe_table<16>(C, tab);
        MoeOrder<true, 16, 2048> S{(const char*)C.HB, (const char*)C.Wgu_t, C.TOK, (const int*)(C.ctl + CW_CNT), tab, C.G, C.vcu};
        EpiGateUp E{C.RS, C.b_gate_up, (unsigned char*)C.ACT};
        pg8::gemm_phase<EpiGateUp, MoeOrder<true, 16, 2048>>(C.lds + RING_OFF, S, E);
    }
    SEAM(7);
    if (IN(8)) { WS_PTRS();
        moe_table<8>(C, tab);
        MoeOrder<false, 8, 2048> S{(const char*)C.ACT, (const char*)C.Wd_t, C.TOK, (const int*)(C.ctl + CW_CNT), tab, C.G, C.vcu};
        EpiDown E{C.b_down, C.Y, args.probe == 1};
        pg8::gemm_phase<EpiDown, MoeOrder<false, 8, 2048>>(C.lds + RING_OFF, S, E);
    }
    SEAM(8);
    if (IN(9)) { WS_PTRS(); moe_table<8>(C, tab); phase9(C, tab);
#ifdef PROBE_DET
        if (blockIdx.x == 0 && C.tid == 0 && __hip_atomic_load((unsigned*)(C.ctl + 2048), RLX_AGENT) != 0u) C.out[12345] = __builtin_nanf("");
#endif
    }
#undef IN
#undef SEAM
}

extern "C" void kernel_launch(void* const* d_in, const int* in_sizes, int n_in, void* d_out, int out_size, void* d_ws, size_t ws_size, hipStream_t stream) {
    static int grid = 0;
    if (grid == 0) {
        if (n_in != 26 || out_size != T * DM || ws_size < WS_END) { fprintf(stderr, "kernel_launch: unexpected problem (n_in %d, out %d, ws %zu < %zu); nothing launched\n", n_in, out_size, ws_size, (size_t)WS_END); grid = -1; return; }
        int dev = 0, cus = 0, per_cu = 0;
        if (hipGetDevice(&dev) != hipSuccess || hipDeviceGetAttribute(&cus, hipDeviceAttributeMultiprocessorCount, dev) != hipSuccess) { grid = -1; return; }
        if (hipFuncSetAttribute((const void*)mk_fwd, hipFuncAttributeMaxDynamicSharedMemorySize, LDS_BYTES) != hipSuccess) { fprintf(stderr, "kernel_launch: hipFuncSetAttribute failed\n"); grid = -1; return; }
        if (hipOccupancyMaxActiveBlocksPerMultiprocessor(&per_cu, (const void*)mk_fwd, NWAVES * 64, LDS_BYTES) != hipSuccess || per_cu < 1) { fprintf(stderr, "kernel_launch: occupancy query says %d\n", per_cu); }
        (void)hipGetLastError();
        grid = cus;
    }
    if (grid < 0) return;
    if (hipMemsetAsync((char*)d_ws + WS_CTL, 0, CTL_ZERO_BYTES, stream) != hipSuccess) return;
#ifdef PROBE_MEMSET8
    hipMemsetAsync((char*)d_ws + WS_XN8, 0, 44 * MiB, stream);
#endif
    Args a{};
    for (int i = 0; i < 26; ++i) a.in[i] = d_in[i];
    a.out = (float*)d_out; a.ws = (unsigned char*)d_ws;
    if (N_LAUNCHES == 1) { a.ph_lo = 0; a.ph_hi = PER_PHASE; hipLaunchKernelGGL(mk_fwd, dim3(grid), dim3(NWAVES * 64), LDS_BYTES, stream, a); }
    else for (int oi = 0; oi < PER_PHASE; ++oi) { static const int order[PER_PHASE] = {0, 1, 2, 3, 4, 5, 6, 7, 8, 9}; const int li = order[oi]; a.ph_lo = li; a.ph_hi = li + 1;
#ifdef PROBE_SPLIT_P1
        if (li == 1) { a.probe = 2; hipLaunchKernelGGL(mk_fwd, dim3(grid), dim3(NWAVES * 64), LDS_BYTES, stream, a); a.probe = 3; hipLaunchKernelGGL(mk_fwd, dim3(grid), dim3(NWAVES * 64), LDS_BYTES, stream, a); a.probe = 0; continue; }
#endif
        hipLaunchKernelGGL(mk_fwd, dim3(grid), dim3(NWAVES * 64), LDS_BYTES, stream, a);
#ifdef PROBE_DUP
        if (li == PROBE_DUP) { if (PROBE_DUP == 3 || PROBE_DUP == 6) hipMemsetAsync((char*)d_ws + WS_CTL, 0, CTL_ZERO_BYTES / 2, stream);
#ifdef PROBE_FLAG
            a.probe = PROBE_FLAG;
#endif
            hipLaunchKernelGGL(mk_fwd, dim3(grid), dim3(NWAVES * 64), LDS_BYTES, stream, a); a.probe = 0; }
#endif
    }
    const hipError_t le = hipPeekAtLastError();
    if (le != hipSuccess) fprintf(stderr, "kernel_launch: launch failed: %s\n", hipGetErrorName(le));
}
```

```cpp
#include <hip/hip_runtime.h>
#include <cstdio>
#include <cstdint>

#define LAS __attribute__((address_space(3)))
#define GAS __attribute__((address_space(1)))

namespace pg8 {
typedef unsigned short bf16_t;
typedef short bf16x8 __attribute__((ext_vector_type(8)));
typedef float f32x4 __attribute__((ext_vector_type(4)));
typedef float f32x2 __attribute__((ext_vector_type(2)));
typedef unsigned u32x4 __attribute__((ext_vector_type(4)));
typedef unsigned u32x2 __attribute__((ext_vector_type(2)));
constexpr int BM = 256, BK = 64, HALF = 128, HTB = HALF * BK * 2, STAGE_BYTES = 8 * HTB, NXCD = 8, WGM = 8;
constexpr int KD = 2048;
typedef int v8i __attribute__((ext_vector_type(8))); typedef int v4i __attribute__((ext_vector_type(4)));
__device__ __forceinline__ v8i cat8(bf16x8 lo, bf16x8 hi) { const v4i a = __builtin_bit_cast(v4i, lo), b = __builtin_bit_cast(v4i, hi); return __builtin_shufflevector(a, b, 0, 1, 2, 3, 4, 5, 6, 7); }
__device__ __forceinline__ bf16x8 lo8(v8i v) { return __builtin_bit_cast(bf16x8, (v4i)__builtin_shufflevector(v, v, 0, 1, 2, 3)); }
__device__ __forceinline__ bf16x8 hi8(v8i v) { return __builtin_bit_cast(bf16x8, (v4i)__builtin_shufflevector(v, v, 4, 5, 6, 7)); }

__host__ __device__ __forceinline__ int lds_byte(int r, int c) { const int st = (r >> 4) * 2 + (c >> 5), rr = r & 15, cc = c & 31, ob = rr * 64 + cc * 2; return st * 1024 + (ob ^ (((ob >> 9) & 1) << 5)); }
__host__ __device__ __forceinline__ void stage_rc(int b, int& R, int& C) { const int st = b / 1024, sb = b % 1024, swz = sb ^ (((sb >> 9) & 1) << 5); R = (st >> 1) * 16 + swz / 64; C = (st & 1) * 32 + (swz % 64) / 2; }
__host__ __device__ __forceinline__ int perm32(int rho) { const int n = rho >> 4, i = rho & 15; return 8 * (i >> 2) + 4 * n + (i & 3); }

__device__ __forceinline__ void glds_s(const char* sbase, unsigned voff, unsigned lds_dst) { unsigned keep;
    asm volatile("s_mov_b32 %0, m0\n\ts_mov_b32 m0, %3\n\ts_nop 0\n\tglobal_load_lds_dwordx4 %1, %2\n\ts_mov_b32 m0, %0" : "=&s"(keep) : "v"(voff), "s"(sbase), "s"(lds_dst) : "memory"); }

#define PG8_PIN4(a, b, c, d, txt) asm volatile(txt : "+v"(a), "+v"(b), "+v"(c), "+v"(d))
#define PG8_PIN_ACC(txt) do { _Pragma("unroll") for (int _a = 0; _a < 2; ++_a) _Pragma("unroll") for (int _b = 0; _b < 2; ++_b) { \
        PG8_PIN4(acc[_a][_b][0][0], acc[_a][_b][0][1], acc[_a][_b][1][0], acc[_a][_b][1][1], ""); PG8_PIN4(acc[_a][_b][2][0], acc[_a][_b][2][1], acc[_a][_b][3][0], acc[_a][_b][3][1], ""); } \
        PG8_PIN4(acc[0][0][0][0], acc[0][1][0][0], acc[1][0][0][0], acc[1][1][0][0], txt); \
        _Pragma("unroll") for (int _a = 0; _a < 2; ++_a) _Pragma("unroll") for (int _b = 0; _b < 2; ++_b) { \
        PG8_PIN4(acc[_a][_b][0][0], acc[_a][_b][0][1], acc[_a][_b][1][0], acc[_a][_b][1][1], ""); PG8_PIN4(acc[_a][_b][2][0], acc[_a][_b][2][1], acc[_a][_b][3][0], acc[_a][_b][3][1], ""); } } while (0)

struct Unit { int pm, pn, e, kind; };

typedef float f32x2_cv __attribute__((ext_vector_type(2))); typedef __bf16 bf16x2_cv __attribute__((ext_vector_type(2)));
__device__ __forceinline__ unsigned cvt_pk_bf16(float lo, float hi) { const f32x2_cv v = {lo, hi}; const bf16x2_cv b = __builtin_convertvector(v, bf16x2_cv); return __builtin_bit_cast(unsigned, b); }
__device__ __forceinline__ float bf_lo(unsigned w) { return __uint_as_float(w << 16); }
__device__ __forceinline__ float bf_hi(unsigned w) { return __uint_as_float(w & 0xffff0000u); }

template <class Epi, class Sched, bool ALIGN_EPI = true, bool SP2 = true>
__device__ __forceinline__ void gemm_phase(LAS unsigned char* lds, const Sched& S, const Epi& E) {
    const int tid = threadIdx.x, wid = __builtin_amdgcn_readfirstlane(tid >> 6), lane = tid & 63, wr = wid >> 2, wc = wid & 3, fr = lane & 15, fq = lane >> 4;
    constexpr bool FP8 = Epi::FP8; constexpr int RB = FP8 ? 2048 : 4096, nt = RB / 128;
    unsigned voffB[2]; int RA[2], CA[2];
#pragma unroll
    for (int i = 0; i < 2; ++i) { int R, C; stage_rc(tid * 16 + i * 8192, R, C); const int Rb = Epi::PERM ? ((R & ~31) + perm32(R & 31)) : R;
        voffB[i] = (unsigned)(Rb * (Epi::BTILED ? 128 : RB) + C * 2); RA[i] = R; CA[i] = C; }
    constexpr size_t kstep = (size_t)(BK * 2);
    constexpr size_t hstep = (size_t)HALF * RB;
    constexpr size_t bkstep = Epi::BTILED ? (size_t)32768 : kstep, bhstep = Epi::BTILED ? (size_t)16384 : hstep;
    const unsigned ldsbase = (unsigned)__builtin_amdgcn_readfirstlane((unsigned)(uintptr_t)lds + (unsigned)wid * 1024u);
    const int aoff = lds_byte(wr * 64 + fr, fq * 8), boff = lds_byte(wc * 32 + fr, fq * 8);
#define PG8_SA(b, h) (((b) * 2 + (h)) * HTB)
#define PG8_SB(b, h) ((4 + (b) * 2 + (h)) * HTB)
#define PG8_STAGE(bufoff, gbase, voff) do { _Pragma("unroll") for (int _i = 0; _i < 2; ++_i) \
        glds_s((const char*)(gbase), (voff)[_i], ldsbase + (unsigned)((bufoff) + _i * 8192)); } while (0)
#define PG8_LDA(dst, b, h) do { _Pragma("unroll") for (int m = 0; m < 4; ++m) dst[m] = cat8(*(const LAS bf16x8*)(lds + PG8_SA(b, h) + aoff + m * 2048), *(const LAS bf16x8*)(lds + PG8_SA(b, h) + aoff + m * 2048 + 1024)); } while (0)
#define PG8_LDB(dst, b, h) do { _Pragma("unroll") for (int n = 0; n < 2; ++n) dst[n] = cat8(*(const LAS bf16x8*)(lds + PG8_SB(b, h) + boff + n * 2048), *(const LAS bf16x8*)(lds + PG8_SB(b, h) + boff + n * 2048 + 1024)); } while (0)
#define PG8_MMA(ai, bj, At, Bt) do { __builtin_amdgcn_s_setprio(1); _Pragma("unroll") for (int m = 0; m < 4; ++m) _Pragma("unroll") for (int n = 0; n < 2; ++n) { \
        if constexpr (FP8 && Epi::ASM_MFMA) asm volatile("v_mfma_scale_f32_16x16x128_f8f6f4 %0, %1, %2, %0, %3, %4 op_sel_hi:[0,0,0]" : "+v"(acc[ai][bj][m][n]) : "v"(Bt[n]), "v"(At[m]), "v"(scl_b), "v"(scl_a)); \
        else if constexpr (FP8) acc[ai][bj][m][n] = __builtin_amdgcn_mfma_scale_f32_16x16x128_f8f6f4(Bt[n], At[m], acc[ai][bj][m][n], 0, 0, 0, Epi::SCALE_B, 0, Epi::SCALE_A); \
        else { acc[ai][bj][m][n] = __builtin_amdgcn_mfma_f32_16x16x32_bf16(lo8(Bt[n]), lo8(At[m]), acc[ai][bj][m][n], 0, 0, 0); \
               acc[ai][bj][m][n] = __builtin_amdgcn_mfma_f32_16x16x32_bf16(hi8(Bt[n]), hi8(At[m]), acc[ai][bj][m][n], 0, 0, 0); } } \
        __builtin_amdgcn_s_setprio(0); } while (0)
#ifdef PROBE_DRAIN8
#define PG8_WAIT_V(n) do { if constexpr (FP8 && !Epi::ASM_MFMA) asm volatile("s_waitcnt vmcnt(0)" ::: "memory"); else asm volatile("s_waitcnt vmcnt(" #n ")" ::: "memory"); } while (0)
#else
#define PG8_WAIT_V(n) asm volatile("s_waitcnt vmcnt(" #n ")" ::: "memory")
#endif
#define PG8_WAIT_L(n) asm volatile("s_waitcnt lgkmcnt(" #n ")" ::: "memory")
#define PG8_BAR __builtin_amdgcn_s_barrier()
#define PG8_SCHED __builtin_amdgcn_sched_barrier(0)
    Unit cur, nxt; int ui = 0;
    int scl_a = Epi::SCALE_A, scl_b = Epi::SCALE_B; asm volatile("" : "+v"(scl_a), "+v"(scl_b));
    if (!S.next(0, cur)) return;
    f32x4 acc[2][2][4][2];
#pragma unroll
    for (int a = 0; a < 2; ++a)
#pragma unroll
        for (int b = 0; b < 2; ++b)
#pragma unroll
            for (int m = 0; m < 4; ++m)
#pragma unroll
                for (int n = 0; n < 2; ++n) acc[a][b][m][n] = (f32x4){0.f, 0.f, 0.f, 0.f};
    if constexpr (Epi::FP8) PG8_PIN_ACC("s_nop 7");
    v8i At[4], B0[2], B1[2];
    const char* cA = S.a_base(cur); const char* cB = S.b_base(cur);
    unsigned vo[2][2], nvo[2][2];
    S.a_offs(cur, RA, CA, vo);
    bool has_next = S.next(1, nxt);
    if (has_next) S.a_offs(nxt, RA, CA, nvo); else { nvo[0][0] = vo[0][0]; nvo[0][1] = vo[0][1]; nvo[1][0] = vo[1][0]; nvo[1][1] = vo[1][1]; }
    if constexpr (SP2) {
        PG8_STAGE(PG8_SB(0, 0), cB, voffB); PG8_STAGE(PG8_SB(0, 1), cB + bhstep, voffB); PG8_STAGE(PG8_SA(0, 0), cA, vo[0]); PG8_STAGE(PG8_SA(0, 1), cA, vo[1]);
        if (wr == 1) PG8_BAR;
        PG8_WAIT_V(2); PG8_BAR;
        PG8_STAGE(PG8_SB(1, 0), cB + bkstep, voffB); PG8_STAGE(PG8_SA(1, 0), cA + kstep, vo[0]); PG8_STAGE(PG8_SB(1, 1), cB + bhstep + bkstep, voffB);
        PG8_WAIT_V(6); PG8_BAR;
    } else {
        PG8_STAGE(PG8_SB(0, 0), cB, voffB); PG8_STAGE(PG8_SA(0, 0), cA, vo[0]); PG8_STAGE(PG8_SB(0, 1), cB + bhstep, voffB); PG8_STAGE(PG8_SA(0, 1), cA, vo[1]);
        if (wr == 1) PG8_BAR;
        PG8_WAIT_V(4); PG8_BAR;
        PG8_STAGE(PG8_SB(1, 0), cB + bkstep, voffB); PG8_STAGE(PG8_SA(1, 0), cA + kstep, vo[0]); PG8_STAGE(PG8_SB(1, 1), cB + bhstep + bkstep, voffB);
        PG8_WAIT_V(6); PG8_BAR;
    }
    for (;;) {
        const char* nA = has_next ? S.a_base(nxt) : cA; const char* nB = has_next ? S.b_base(nxt) : cB;
        for (int t = 0; t < nt; t += 2) {
            const bool last = (t == nt - 2);
            const char* a1 = cA + (size_t)(t + 1) * kstep;
            const char* a2 = last ? nA : cA + (size_t)(t + 2) * kstep; const char* b2 = last ? nB : cB + (size_t)(t + 2) * bkstep;
            const char* a3 = a2 + kstep; const char* b3 = b2 + bkstep;
            unsigned v2[2][2];
            v2[0][0] = last ? nvo[0][0] : vo[0][0]; v2[0][1] = last ? nvo[0][1] : vo[0][1]; v2[1][0] = last ? nvo[1][0] : vo[1][0]; v2[1][1] = last ? nvo[1][1] : vo[1][1];
            if constexpr (SP2) {
            PG8_LDB(B0, 0, 0); PG8_LDB(B1, 0, 1); PG8_SCHED; PG8_LDA(At, 0, 0); PG8_STAGE(PG8_SA(1, 1), a1, vo[1]);
            PG8_WAIT_V(8); PG8_WAIT_L(0); PG8_BAR; PG8_MMA(0, 0, At, B0); PG8_MMA(0, 1, At, B1); PG8_BAR; PG8_SCHED;
            PG8_LDA(At, 0, 1); PG8_STAGE(PG8_SB(0, 0), b2, voffB); PG8_STAGE(PG8_SB(0, 1), b2 + bhstep, voffB); PG8_STAGE(PG8_SA(0, 0), a2, v2[0]);
            PG8_WAIT_V(8); PG8_WAIT_L(0); PG8_BAR; PG8_MMA(1, 0, At, B0); PG8_MMA(1, 1, At, B1); PG8_BAR; PG8_SCHED;
            PG8_LDB(B0, 1, 0); PG8_LDB(B1, 1, 1); PG8_SCHED; PG8_LDA(At, 1, 0); PG8_STAGE(PG8_SA(0, 1), a2, v2[1]);
            PG8_WAIT_V(8); PG8_WAIT_L(0); PG8_BAR; PG8_MMA(0, 0, At, B0); PG8_MMA(0, 1, At, B1); PG8_BAR; PG8_SCHED;
            PG8_LDA(At, 1, 1); PG8_STAGE(PG8_SB(1, 0), b3, voffB); PG8_STAGE(PG8_SB(1, 1), b3 + bhstep, voffB); PG8_STAGE(PG8_SA(1, 0), a3, v2[0]);
            PG8_WAIT_V(8); PG8_WAIT_L(0); PG8_BAR; PG8_MMA(1, 0, At, B0); PG8_MMA(1, 1, At, B1); PG8_BAR; PG8_SCHED;
            } else {
            PG8_LDB(B0, 0, 0); PG8_SCHED; PG8_LDA(At, 0, 0); PG8_STAGE(PG8_SA(1, 1), a1, vo[1]);
            PG8_WAIT_L(8); PG8_BAR; PG8_WAIT_L(0); PG8_MMA(0, 0, At, B0); PG8_BAR; PG8_SCHED;
            PG8_LDB(B1, 0, 1); PG8_STAGE(PG8_SB(0, 0), b2, voffB);
            PG8_BAR; PG8_WAIT_L(0); PG8_MMA(0, 1, At, B1); PG8_BAR;
            PG8_LDA(At, 0, 1); PG8_STAGE(PG8_SA(0, 0), a2, v2[0]);
            PG8_BAR; PG8_WAIT_L(0); PG8_MMA(1, 0, At, B0); PG8_BAR; PG8_SCHED;
            PG8_STAGE(PG8_SB(0, 1), b2 + bhstep, voffB);
            PG8_WAIT_V(6); PG8_BAR; PG8_MMA(1, 1, At, B1); PG8_BAR;
            PG8_LDB(B0, 1, 0); PG8_SCHED; PG8_LDA(At, 1, 0); PG8_STAGE(PG8_SA(0, 1), a2, v2[1]);
            PG8_WAIT_L(8); PG8_BAR; PG8_WAIT_L(0); PG8_MMA(0, 0, At, B0); PG8_BAR; PG8_SCHED;
            PG8_LDB(B1, 1, 1); PG8_STAGE(PG8_SB(1, 0), b3, voffB);
            PG8_BAR; PG8_WAIT_L(0); PG8_MMA(0, 1, At, B1); PG8_BAR;
            PG8_LDA(At, 1, 1); PG8_STAGE(PG8_SA(1, 0), a3, v2[0]);
            PG8_BAR; PG8_WAIT_L(0); PG8_MMA(1, 0, At, B0); PG8_BAR; PG8_SCHED;
            PG8_STAGE(PG8_SB(1, 1), b3 + bhstep, voffB);
            PG8_WAIT_V(6); PG8_BAR; PG8_MMA(1, 1, At, B1); PG8_BAR;
            }
            if constexpr (Epi::MID) { if (t == 10 || t == 22) E.mid(acc, cur, t == 22 ? 1 : 0, wr, wc, fr, fq); }
        }
        Unit nn; const bool has_nn = has_next && S.next(ui + 2, nn); unsigned nnvo[2][2];
        if (has_nn) S.a_offs(nn, RA, CA, nnvo); else { nnvo[0][0] = nvo[0][0]; nnvo[0][1] = nvo[0][1]; nnvo[1][0] = nvo[1][0]; nnvo[1][1] = nvo[1][1]; }
        if constexpr (ALIGN_EPI) { if (wr == 0) PG8_BAR; }
        if constexpr (FP8) PG8_PIN_ACC("s_nop 15\n\ts_nop 7");
        E(acc, cur, wr, wc, fr, fq);
        if (!has_next) break;
#pragma unroll
        for (int a = 0; a < 2; ++a)
#pragma unroll
            for (int b = 0; b < 2; ++b)
#pragma unroll
                for (int m = 0; m < 4; ++m)
#pragma unroll
                    for (int n = 0; n < 2; ++n) acc[a][b][m][n] = (f32x4){0.f, 0.f, 0.f, 0.f};
        if constexpr (FP8) PG8_PIN_ACC("s_nop 7");
        cur = nxt; cA = nA; cB = nB; ++ui; nxt = nn; has_next = has_nn;
        vo[0][0] = nvo[0][0]; vo[0][1] = nvo[0][1]; vo[1][0] = nvo[1][0]; vo[1][1] = nvo[1][1];
        nvo[0][0] = nnvo[0][0]; nvo[0][1] = nnvo[0][1]; nvo[1][0] = nnvo[1][0]; nvo[1][1] = nnvo[1][1];
        if constexpr (ALIGN_EPI) { if (wr == 1) PG8_BAR; }
    }
    PG8_WAIT_V(0);
    if constexpr (!ALIGN_EPI) { if (wr == 0) PG8_BAR; }
    PG8_BAR;
#undef PG8_SA
#undef PG8_SB
#undef PG8_STAGE
#undef PG8_LDA
#undef PG8_LDB
#undef PG8_MMA
#undef PG8_WAIT_V
#undef PG8_WAIT_L
#undef PG8_BAR
#undef PG8_SCHED
}
}

constexpr int NWAVES = 8;
constexpr int BATCH = 2, SEQ = 8192, DM = 2048, T = BATCH * SEQ;
constexpr int NMEM = 256, MROWS = BATCH * NMEM;
constexpr int INW = 10252;
constexpr int NEXP = 32, TOPK = 4, CAP = T;
constexpr int QKVW = 4096;
constexpr int C_FQ = 0, C_FK = 768, C_FV = 1536, C_SQ = 2304, C_SK = 3072, C_SV = 3328, C_MQ = 3584;
constexpr int GW = 6144;
constexpr float NORM_EPS = 1e-6f;
constexpr float LOG2E = 1.4426950408889634f;
constexpr float SWIGLU_LIMIT = 7.0f, SWIGLU_ALPHA = 1.702f;
constexpr int PER_PHASE = 10;
#ifndef MK_LATE_WD
#define MK_LATE_WD 0
#endif
constexpr bool LATE_WD = false;
#ifndef MK_CONV_IN_P3
#define MK_CONV_IN_P3 1
#endif
constexpr bool CONV_IN_P3 = MK_CONV_IN_P3;
#ifndef MK_N_LAUNCHES
#define MK_N_LAUNCHES 1
#endif
constexpr int N_LAUNCHES = MK_N_LAUNCHES;

constexpr size_t MiB = 1u << 20;
constexpr size_t WS_CTL = 0, CTL_ZERO_BYTES = 1 * MiB;
constexpr size_t WS_WIN   = 2 * MiB;
constexpr size_t WS_WMKV  = WS_WIN + 40 * MiB;
constexpr size_t WS_WUP   = WS_WMKV + 4 * MiB;
constexpr size_t WS_WOUT  = WS_WUP + 8 * MiB;
constexpr size_t WS_WRT   = WS_WOUT + 8 * MiB;
constexpr size_t WS_WGU   = WS_WRT + 1 * MiB;
constexpr size_t WS_WD    = WS_WGU + 512 * MiB;
constexpr size_t WS_XN    = WS_WD + 256 * MiB;
constexpr size_t WS_MN    = WS_XN + 64 * MiB;
constexpr size_t WS_LOGF  = WS_MN + 2 * MiB;
constexpr size_t WS_CNEG  = WS_LOGF + 1 * MiB;
constexpr size_t WS_ROPE  = WS_CNEG + 1 * MiB;
constexpr size_t WS_QKV   = WS_ROPE + 4 * MiB;
constexpr size_t WS_G     = WS_QKV + 128 * MiB;
constexpr size_t WS_MKV   = WS_G + 192 * MiB;
constexpr size_t WS_OALL  = WS_MKV + 1 * MiB;
constexpr size_t WS_MERGED= WS_OALL + 64 * MiB;
constexpr size_t WS_HB    = WS_MERGED + 64 * MiB;
constexpr size_t WS_TOK   = WS_HB + 64 * MiB;
constexpr size_t WS_GATE  = WS_TOK + 2 * MiB;
constexpr size_t WS_RS    = WS_GATE + 2 * MiB;
constexpr size_t WS_ACT   = WS_RS + 2 * MiB;
constexpr size_t WS_Y     = WS_ACT + 288 * MiB;
constexpr size_t WS_TSLOT = WS_Y + 288 * MiB;
constexpr size_t WS_TGATE = WS_TSLOT + 1 * MiB;
constexpr size_t WS_XN8   = WS_TGATE + 1 * MiB;
constexpr size_t WS_WIN8  = WS_XN8 + 32 * MiB;
constexpr size_t WS_END   = WS_WIN8 + 12 * MiB;
constexpr int CW_BAR = 4096;
constexpr int CW_QHEAD = 64;
constexpr int CW_CNT = 512;

typedef unsigned short bf16;
typedef unsigned v4u __attribute__((ext_vector_type(4)));
typedef unsigned v2u __attribute__((ext_vector_type(2)));
typedef float f32x4 __attribute__((ext_vector_type(4)));
typedef float f32x16 __attribute__((ext_vector_type(16)));
typedef short bf16x8 __attribute__((ext_vector_type(8)));
typedef short s16x4 __attribute__((ext_vector_type(4)));
typedef GAS unsigned gu32;
#define RLX_AGENT __ATOMIC_RELAXED, __HIP_MEMORY_SCOPE_AGENT
#define LDS_WAIT() asm volatile("s_waitcnt lgkmcnt(0)" ::: "memory")
#define VM_WAIT() asm volatile("s_waitcnt vmcnt(0)" ::: "memory")
__device__ __forceinline__ unsigned f2bf(float f) { unsigned u = __builtin_bit_cast(unsigned, f); return (u + 0x7fffu + ((u >> 16) & 1u)) >> 16; }
__device__ __forceinline__ unsigned pk2(float lo, float hi) { return f2bf(lo) | (f2bf(hi) << 16); }
__device__ __forceinline__ float bf2f(unsigned short b) { return __uint_as_float(((unsigned)b) << 16); }
__device__ __forceinline__ float wave_sum(float v) {
#pragma unroll
    for (int o = 1; o < 64; o <<= 1) v += __shfl_xor(v, o);
    return v;
}
__device__ __forceinline__ float sigmoidf_(float x) { return __builtin_amdgcn_rcpf(1.0f + __builtin_amdgcn_exp2f(x * (-LOG2E))); }

constexpr int H8_SHIFT = 4, ACT8_SHIFT = 2, W8_SHIFT = 9;
constexpr float H8_MUL = 16.0f, ACT8_MUL = 4.0f, W8_MUL = 512.0f;
__device__ __forceinline__ float clamp_fp8(float v) { return __builtin_amdgcn_fmed3f(v, -448.0f, 448.0f); }
__device__ __forceinline__ unsigned pk4_fp8(float a, float b, float c, float d) {
    int p = __builtin_amdgcn_cvt_pk_fp8_f32(clamp_fp8(a), clamp_fp8(b), 0, false); p = __builtin_amdgcn_cvt_pk_fp8_f32(clamp_fp8(c), clamp_fp8(d), p, true); return (unsigned)p; }
using pg8::f32x2; using pg8::u32x4; using pg8::u32x2; using pg8::cvt_pk_bf16; using pg8::bf_lo; using pg8::bf_hi;

#define XB_TMO      128
#define XB_XCNT(j)  (256  + 64 * (j))
#define XB_XSUB(j)  (1280 + 64 * (j))
#define XB_XGEN(j)  (2304 + 64 * (j))
#define XB_TOP      3328
#define XB_TOPGEN   3392
#define XCD_BAR_WORDS 3456
#define XB_SPIN_CAP (1u << 18)

__device__ __forceinline__ unsigned xb_ld(unsigned* p)              { return __hip_atomic_load(p, __ATOMIC_RELAXED, __HIP_MEMORY_SCOPE_AGENT); }
__device__ __forceinline__ unsigned xb_add(unsigned* p, unsigned v) { return __hip_atomic_fetch_add(p, v, __ATOMIC_RELAXED, __HIP_MEMORY_SCOPE_AGENT); }
__device__ __forceinline__ unsigned xb_xcc_id() { return (unsigned)__builtin_amdgcn_s_getreg((3 << 11) | 20) & 0xFu; }
#define XB_SPIN(cond, bar) do { unsigned _sp = 0; while (cond) { __builtin_amdgcn_s_sleep(1); \
    if ((++_sp & 255u) == 0u) { if (xb_ld(&(bar)[XB_TMO])) break; if (_sp > XB_SPIN_CAP) { atomicAdd(&(bar)[XB_TMO], 1u); break; } } } } while (0)

struct XcdBarrier { unsigned* bar; unsigned x; volatile LAS unsigned* st; };

__device__ __forceinline__ XcdBarrier xcd_barrier_post(unsigned* bar, volatile LAS unsigned* st) {
    XcdBarrier b; b.bar = bar; b.x = xb_xcc_id(); b.st = st;
    if (threadIdx.x == 0) (void)xb_add(&bar[XB_XCNT(b.x)], 1u);
    return b;
}
__device__ __forceinline__ void xcd_barrier_complete(unsigned* bar, unsigned x, unsigned& nloc, unsigned& nx) {
    const unsigned G = gridDim.x * gridDim.y * gridDim.z;
    unsigned sum, cnt, mine, sp = 0u;
    for (;;) {
        sum = 0u; cnt = 0u; mine = 0u;
#pragma unroll
        for (unsigned j = 0; j < 16; ++j) { const unsigned c = xb_ld(&bar[XB_XCNT(j)]); sum += c; cnt += (c > 0u) ? 1u : 0u; mine = (j == x) ? c : mine; }
        if (sum == G) break;
        __builtin_amdgcn_s_sleep(1);
        if ((++sp & 255u) == 0u) { if (xb_ld(&bar[XB_TMO])) break; if (sp > XB_SPIN_CAP) { atomicAdd(&bar[XB_TMO], 1u); break; } }
    }
    nloc = mine > 0u ? mine : 1u; nx = cnt > 0u ? cnt : 1u;
}
__device__ __forceinline__ void xcd_barrier(const XcdBarrier& b) {
    asm volatile("s_waitcnt vmcnt(0)" ::: "memory");
    __syncthreads();
    if (threadIdx.x == 0) {
        unsigned* bar = b.bar;
        __builtin_amdgcn_s_waitcnt(0);
        unsigned nloc = b.st[0], nx = b.st[1];
        if (nloc == 0u) { xcd_barrier_complete(bar, b.x, nloc, nx); b.st[0] = nloc; b.st[1] = nx; }
        const unsigned old = xb_add(&bar[XB_XSUB(b.x)], 1u);
        const unsigned gen = old / nloc;
        if (old + 1u == (gen + 1u) * nloc) {
            __builtin_amdgcn_fence(__ATOMIC_RELEASE, "agent");
            asm volatile("s_waitcnt vmcnt(0)" ::: "memory");
            const unsigned og = xb_add(&bar[XB_TOP], 1u);
            const unsigned tg = og / nx;
            if (og + 1u == (tg + 1u) * nx) xb_add(&bar[XB_TOPGEN], 1u);
            else XB_SPIN(xb_ld(&bar[XB_TOPGEN]) == tg, bar);
            __builtin_amdgcn_fence(__ATOMIC_ACQUIRE, "agent");
            xb_add(&bar[XB_XGEN(b.x)], 1u);
            asm volatile("s_waitcnt vmcnt(0)" ::: "memory");
        } else {
            XB_SPIN(xb_ld(&bar[XB_XGEN(b.x)]) == gen, bar);
            __builtin_amdgcn_fence(__ATOMIC_ACQUIRE, "agent");
            asm volatile("s_waitcnt vmcnt(0)" ::: "memory");
        }
    }
    __syncthreads();
}

constexpr int RING_OFF = 0, RING_BYTES = 131072;
constexpr int LDSCTL_OFF = RING_BYTES, MISC_OFF = LDSCTL_OFF + 320;
constexpr int MOE_OFF = MISC_OFF + 128;
constexpr int LDS_BYTES = 147456;

struct Ctx {
    LAS unsigned char* lds;
    volatile LAS unsigned* MISC;
    gu32* ctl;
    int tid, lane, wave, vcu, G, probe;
    const float *x, *mem; const int* pos; const float *norm_mix, *w_in, *b_forget, *fox_q_norm, *fox_k_norm, *swa_q_norm, *swa_k_norm, *swa_sinks, *xmem_q_norm, *xmem_k_norm, *norm_mem,
        *w_mem_kv, *w_up_fox, *w_up_swa, *w_up_xmem, *w_out, *norm_ffn, *w_router, *b_router, *w_gate_up, *b_gate_up, *w_down, *b_down;
    float* out;
    bf16 *Win_t, *Wmkv_t, *Wup_t, *Wout_t, *Wr_t, *Wgu_t, *Wd_t, *XN, *MN, *QKV, *G_, *MKV, *OALL, *MERGED, *HB, *ACT;
    float *LOGF, *CNEG, *ROPE, *GATEW, *RS, *TGATE; int *TOK, *TSLOT; bf16* Y; unsigned char *XN8, *Win8;
};

#ifndef PROBE_INW
#define PROBE_INW 64
#endif
__constant__ float INV_FREQ[32] = {1.000000000e+00f, 7.498942614e-01f, 5.623413324e-01f, 4.216965139e-01f, 3.162277639e-01f, 2.371373773e-01f, 1.778279394e-01f, 1.333521307e-01f,
    1.000000015e-01f, 7.498941571e-02f, 5.623413250e-02f, 4.216965288e-02f, 3.162277490e-02f, 2.371373773e-02f, 1.778279431e-02f, 1.333521493e-02f, 9.999999776e-03f, 7.498941850e-03f,
    5.623413250e-03f, 4.216964822e-03f, 3.162277630e-03f, 2.371373586e-03f, 1.778279431e-03f, 1.333521446e-03f, 1.000000047e-03f, 7.498942432e-04f, 5.623413017e-04f, 4.216965172e-04f,
    3.162277571e-04f, 2.371373703e-04f, 1.778279402e-04f, 1.333521504e-04f};

struct TItem { const float* src; const float* ksc; bf16* dst; size_t ldw; int f8, gap; };
__device__ __forceinline__ void titem_load(const TItem& I, f32x4 (&v)[8][2], float (&sc)[8][2], int lane) {
    const int rr = lane >> 4, c4 = lane & 15;
#pragma unroll
    for (int p = 0; p < 8; ++p)
#pragma unroll
        for (int h = 0; h < 2; ++h) { const int k = 8 * p + 2 * rr + h; v[p][h] = *(const GAS f32x4*)(I.src + (size_t)k * I.ldw + 4 * c4 + (c4 >= 8 ? I.gap : 0)); sc[p][h] = I.ksc ? I.ksc[k] : 1.0f; }
}
__device__ __forceinline__ void titem_store(const TItem& I, const f32x4 (&v)[8][2], const float (&sc)[8][2], LAS unsigned* tile, int lane) {
    const int rr = lane >> 4, c4 = lane & 15;
#pragma unroll
    for (int p = 0; p < 8; ++p)
#pragma unroll
        for (int q = 0; q < 4; ++q) { const int n = 4 * c4 + q, sw = (n ^ (n >> 3)) & 7;
            tile[n * 32 + 4 * (p ^ sw) + rr] = pg8::cvt_pk_bf16(v[p][0][q] * sc[p][0], v[p][1][q] * sc[p][1]); }
    LDS_WAIT(); asm volatile("" ::: "memory");
#pragma unroll
    for (int j = 0; j < 8; ++j) { const int n = 8 * j + (lane >> 3), c = lane & 7, sw = (n ^ (n >> 3)) & 7;
        const v4u o = *(const LAS v4u*)(tile + n * 32 + 4 * (c ^ sw));
        *(GAS v4u*)(I.dst + (size_t)n * DM + 8 * c) = o; }
    LDS_WAIT(); asm volatile("" ::: "memory");
}
__device__ __forceinline__ size_t tiled8(size_t row, int kt) { return (row >> 8) * (size_t)(256 * 2048) + (size_t)kt * 32768 + (row & 255) * 128; }
__device__ __forceinline__ void titem8_load(const TItem& I, int qh, f32x4 (&v)[4][2], int lane) {
    const int rr = lane >> 4, c4 = lane & 15;
#pragma unroll
    for (int pp = 0; pp < 2; ++pp)
#pragma unroll
        for (int h = 0; h < 4; ++h) { const int k = 32 * qh + 16 * pp + 4 * rr + h; v[2 * pp + (h >> 1)][h & 1] = __builtin_nontemporal_load((const GAS f32x4*)(I.src + (size_t)k * I.ldw + 4 * c4)); }
}
__device__ __forceinline__ void titem8_pack(const TItem& I, const float* nbase, int qh, const f32x4 (&v)[4][2], LAS unsigned* tile, const LAS float* lnorm, int lane) {
    const int rr = lane >> 4, c4 = lane & 15;
    const int kofs = I.ksc ? (int)(I.ksc - nbase) + 32 * qh + 4 * rr : -1;
#pragma unroll
    for (int pp = 0; pp < 2; ++pp) {
        f32x4 sc = {W8_MUL, W8_MUL, W8_MUL, W8_MUL}; if (kofs >= 0) sc = *(const LAS f32x4*)(lnorm + kofs + 16 * pp);
#pragma unroll
        for (int q = 0; q < 4; ++q) { const int n = 4 * c4 + q, sw = (n ^ (n >> 3)) & 7;
            tile[n * 32 + 4 * ((2 * qh + pp) ^ sw) + rr] = pk4_fp8(v[2 * pp][0][q] * sc.x, v[2 * pp][1][q] * sc.y, v[2 * pp + 1][0][q] * sc.z, v[2 * pp + 1][1][q] * sc.w); } }
}
__device__ __forceinline__ void titem8_flush(const TItem& I, LAS unsigned* tile, int lane) {
    LDS_WAIT(); asm volatile("" ::: "memory");
#pragma unroll
    for (int j = 0; j < 8; ++j) { const int n = 8 * j + (lane >> 3), c = lane & 7, sw = (n ^ (n >> 3)) & 7;
        const v4u o = *(const LAS v4u*)(tile + n * 32 + 4 * (c ^ sw));
        *(GAS v4u*)((unsigned char*)I.dst + (size_t)n * 128 + 16 * c) = o; }
    LDS_WAIT(); asm volatile("" ::: "memory");
}
__device__ __forceinline__ void p0_router_item(const float* W, int k0, bf16* WT, const float* ksc, LAS float* scr, int lane) {
#pragma unroll 8
    for (int i = 0; i < 32; ++i) { const int kk = 2 * i + (lane >> 5); scr[kk * 33 + (lane & 31)] = W[(size_t)(k0 + kk) * 32 + (lane & 31)] * ksc[k0 + kk]; }
    LDS_WAIT(); asm volatile("" ::: "memory");
    const int c = lane & 7;
#pragma unroll
    for (int j = 0; j < 4; ++j) { const int n = (lane >> 3) + 8 * j; const LAS float* s = scr + (8 * c) * 33 + n;
        unsigned h[8], l[8];
#pragma unroll
        for (int q = 0; q < 8; ++q) { const float v = s[q * 33]; h[q] = f2bf(v); l[q] = f2bf(v - __uint_as_float(h[q] << 16)); }
        v4u oh, ol; oh.x = h[0] | (h[1] << 16); oh.y = h[2] | (h[3] << 16); oh.z = h[4] | (h[5] << 16); oh.w = h[6] | (h[7] << 16);
        ol.x = l[0] | (l[1] << 16); ol.y = l[2] | (l[3] << 16); ol.z = l[4] | (l[5] << 16); ol.w = l[6] | (l[7] << 16);
        *(GAS v4u*)(WT + (size_t)n * 2048 + k0 + 8 * c) = oh; *(GAS v4u*)(WT + (size_t)(32 + n) * 2048 + k0 + 8 * c) = ol; }
    LDS_WAIT(); asm volatile("" ::: "memory");
}
__device__ __forceinline__ float log_sigmoidf_(float z) { return fminf(z, 0.f) - log1pf(__expf(-fabsf(z))); }

template <bool XROW>
__device__ __forceinline__ void p0_norm_row(const Ctx& C, const float* xrow, const float* gain, bf16* orow, const LAS float* Wf, int m) {
    const GAS f32x4* xr = (const GAS f32x4*)xrow + C.lane; const GAS f32x4* gr = (const GAS f32x4*)gain + C.lane;
    f32x4 v[8]; float s = 0.f;
#pragma unroll
    for (int j = 0; j < 8; ++j) { v[j] = xr[64 * j]; s += (v[j].x * v[j].x + v[j].y * v[j].y) + (v[j].z * v[j].z + v[j].w * v[j].w); }
    const float rstd = 1.0f / sqrtf(wave_sum(s) * (1.f / DM) + NORM_EPS);
    GAS unsigned long long* o8 = (GAS unsigned long long*)orow + C.lane;
#pragma unroll
    for (int j = 0; j < 8; ++j) { const f32x4 g = gr[64 * j]; v[j] = (v[j] * rstd) * g;
        o8[64 * j] = (unsigned long long)pk2(v[j].x, v[j].y) | ((unsigned long long)pk2(v[j].z, v[j].w) << 32);
        if constexpr (XROW) ((GAS unsigned*)(C.XN8 + (size_t)m * DM))[C.lane + 64 * j] = pk4_fp8(v[j].x * H8_MUL, v[j].y * H8_MUL, v[j].z * H8_MUL, v[j].w * H8_MUL); }
    if constexpr (XROW) {
        float mine = 0.f;
#pragma unroll 1
        for (int h = 0; h < 12; ++h) { const LAS f32x4* w = (const LAS f32x4*)(Wf + h * 2048) + C.lane; float d = 0.f;
#pragma unroll
            for (int j = 0; j < 8; ++j) { const f32x4 ww = w[64 * j]; d += (v[j].x * ww.x + v[j].y * ww.y) + (v[j].z * ww.z + v[j].w * ww.w); }
            d = wave_sum(d); if (C.lane == h) mine = d; }
        const int b = m / SEQ, t = m % SEQ;
        if (C.lane < 12) C.LOGF[(size_t)(b * 12 + C.lane) * SEQ + t] = log_sigmoidf_(mine + C.b_forget[C.lane]);
        if (C.lane < 32) { const float ang = (float)C.pos[m] * INV_FREQ[C.lane]; const double rev = (double)ang * 0.15915494309189535; const float fr = (float)(rev - floor(rev));
            C.ROPE[(size_t)m * 64 + C.lane] = __builtin_amdgcn_cosf(fr); C.ROPE[(size_t)m * 64 + 32 + C.lane] = __builtin_amdgcn_sinf(fr); }
    }
}
constexpr int I_GU = 32 * 16 * 64, I_D = 32 * 16 * 32, I_ING = 16 * 96, I_IN = 32 * PROBE_INW, I_MKV = 32 * 16, I_UF = 12 * 32, I_US = 12 * 32, I_UX = 8 * 32, I_O = 32 * 32;
constexpr int NITEMS = I_GU + I_D + I_ING + I_IN + I_MKV + I_UF + I_US + I_UX + I_O;
constexpr int N8 = I_GU + I_D + I_ING;
__device__ __forceinline__ TItem p0_decode(const Ctx& C, int it) {
        TItem I; int r = it; I.ksc = nullptr; I.f8 = 0; I.gap = 0;
        if (r < I_GU) { const int e = r / 1024, q = r % 1024, kb = 2 * (q / 64), pb = q % 64, tl = pb >> 2, jb = pb & 3;
            const int n0 = (jb < 2) ? (128 * tl + 64 * jb) : (2048 + 128 * tl + 64 * (jb - 2));
            I.ldw = 4096; I.src = C.w_gate_up + (size_t)e * DM * 4096 + (size_t)(64 * kb) * 4096 + n0; I.ksc = C.norm_ffn + 64 * kb; I.f8 = 1; I.dst = (bf16*)((unsigned char*)C.Wgu_t + tiled8((size_t)e * 4096 + 64 * pb, kb >> 1)); return I; } r -= I_GU;
        if (r < I_D) { const int e = r / 512, q = r % 512, kb = 2 * (q / 32), nb = q % 32;
            I.ldw = DM; I.src = C.w_down + (size_t)e * DM * DM + (size_t)(64 * kb) * DM + 64 * nb; I.f8 = 1; I.dst = (bf16*)((unsigned char*)C.Wd_t + tiled8((size_t)e * DM + 64 * nb, kb >> 1)); return I; } r -= I_D;
        if (r < I_ING) { const int kb = 2 * (r / 96), pb = r % 96;
            I.ldw = INW; I.src = C.w_in + (size_t)(64 * kb) * INW + 4108 + 64 * pb; I.f8 = 1; I.dst = (bf16*)((unsigned char*)C.Win8 + tiled8((size_t)64 * pb, kb >> 1)); return I; } r -= I_ING;
        if (r < I_IN) { const int kb = r / PROBE_INW, pb = r % PROBE_INW; int p0 = 64 * pb; const int tl = pb >> 2, q4 = pb & 3;
            if (tl == 3 || tl == 4 || tl == 5 || tl == 12) { p0 = 256 * tl + 128 * (q4 & 1) + 32 * (q4 >> 1); I.gap = 32; }
            const int n0 = (p0 < 2304) ? p0 : p0 + 12;
            I.ldw = INW; I.src = C.w_in + (size_t)(64 * kb) * INW + n0; I.dst = C.Win_t + (size_t)(64 * pb) * DM + 64 * kb; return I; } r -= I_IN;
        if (r < I_MKV) { const int kb = r / 16, nb = r % 16; I.ldw = 1024; I.src = C.w_mem_kv + (size_t)(64 * kb) * 1024 + 64 * nb; I.dst = C.Wmkv_t + (size_t)(64 * nb) * DM + 64 * kb; return I; } r -= I_MKV;
        if (r < I_UF) { const int kb = r / 32, nb = r % 32; I.ldw = DM; I.src = C.w_up_fox + (size_t)(64 * kb) * DM + 64 * nb; I.dst = C.Wup_t + (size_t)(64 * nb) * DM + 64 * kb; return I; } r -= I_UF;
        if (r < I_US) { const int kb = r / 32, nb = r % 32; I.ldw = DM; I.src = C.w_up_swa + (size_t)(64 * kb) * DM + 64 * nb; I.dst = C.Wup_t + (size_t)(64 * nb) * DM + 768 + 64 * kb; return I; } r -= I_US;
        if (r < I_UX) { const int kb = r / 32, nb = r % 32; I.ldw = DM; I.src = C.w_up_xmem + (size_t)(64 * kb) * DM + 64 * nb; I.dst = C.Wup_t + (size_t)(64 * nb) * DM + 1536 + 64 * kb; return I; } r -= I_UX;
        { const int kb = r / 32, nb = r % 32; I.ldw = DM; I.src = C.w_out + (size_t)(64 * kb) * DM + 64 * nb; I.dst = C.Wout_t + (size_t)(64 * nb) * DM + 64 * kb; return I; }
}
__device__ __forceinline__ void p0_fp8_loop(const Ctx& C, int first, int cnt, int me, int stride, LAS unsigned* tile, const LAS float* lnorm) {
    if (me >= cnt) return;
    const int nq = 4 * ((cnt - me + stride - 1) / stride);
    f32x4 b0[4][2], b1[4][2], b2[4][2], b3[4][2], b4[4][2];
#define P0_ITEM(q_) p0_decode(C, first + me + ((q_) >> 2) * stride)
#define P0_STEP(q_, cur_, pre_) do { const int qq = (q_); if (qq < nq) { \
        if (qq + 4 < nq) { const TItem J = P0_ITEM(qq + 4); titem8_load(J, (qq + 4) & 3, pre_, C.lane); } \
        const TItem I = P0_ITEM(qq); titem8_pack(I, C.norm_ffn, qq & 3, cur_, tile, lnorm, C.lane); \
        if ((qq & 3) == 3) titem8_flush(I, tile, C.lane); } } while (0)
    { const TItem I = P0_ITEM(0); titem8_load(I, 0, b0, C.lane); titem8_load(I, 1, b1, C.lane); titem8_load(I, 2, b2, C.lane); titem8_load(I, 3, b3, C.lane); }
    for (int qs = 0; qs < nq; qs += 5) { P0_STEP(qs, b0, b4); P0_STEP(qs + 1, b1, b0); P0_STEP(qs + 2, b2, b1); P0_STEP(qs + 3, b3, b2); P0_STEP(qs + 4, b4, b3); }
#undef P0_ITEM
#undef P0_STEP
}
__device__ __forceinline__ void p0_fill_lnorm(const Ctx& C, LAS float* lnorm) { for (int k = C.tid; k < DM; k += NWAVES * 64) lnorm[k] = C.norm_ffn[k] * W8_MUL; }
__device__ __forceinline__ void p0_x_rows2(const Ctx& C, const LAS float* Wf, int m0, int m1) {
    const GAS f32x4* gr = (const GAS f32x4*)C.norm_mix + C.lane;
    const int mm[2] = {m0, m1};
    f32x4 v[2][8]; float s[2] = {0.f, 0.f};
#pragma unroll
    for (int r = 0; r < 2; ++r) { const GAS f32x4* xr = (const GAS f32x4*)(C.x + (size_t)mm[r] * DM) + C.lane;
#pragma unroll
        for (int j = 0; j < 8; ++j) v[r][j] = xr[64 * j]; }
#pragma unroll
    for (int r = 0; r < 2; ++r)
#pragma unroll
        for (int j = 0; j < 8; ++j) s[r] += (v[r][j].x * v[r][j].x + v[r][j].y * v[r][j].y) + (v[r][j].z * v[r][j].z + v[r][j].w * v[r][j].w);
    float rstd[2];
#pragma unroll
    for (int r = 0; r < 2; ++r) rstd[r] = 1.0f / sqrtf(wave_sum(s[r]) * (1.f / DM) + NORM_EPS);
#pragma unroll
    for (int j = 0; j < 8; ++j) { const f32x4 g = gr[64 * j];
#pragma unroll
        for (int r = 0; r < 2; ++r) { v[r][j] = (v[r][j] * rstd[r]) * g;
            ((GAS unsigned long long*)(C.XN + (size_t)mm[r] * DM))[C.lane + 64 * j] = (unsigned long long)pk2(v[r][j].x, v[r][j].y) | ((unsigned long long)pk2(v[r][j].z, v[r][j].w) << 32);
            ((GAS unsigned*)(C.XN8 + (size_t)mm[r] * DM))[C.lane + 64 * j] = pk4_fp8(v[r][j].x * H8_MUL, v[r][j].y * H8_MUL, v[r][j].z * H8_MUL, v[r][j].w * H8_MUL); } }
    float mine[2] = {0.f, 0.f};
#pragma unroll 1
    for (int h = 0; h < 12; ++h) { const LAS f32x4* w = (const LAS f32x4*)(Wf + h * 2048) + C.lane; float d0 = 0.f, d1 = 0.f;
#pragma unroll
        for (int j = 0; j < 8; ++j) { const f32x4 ww = w[64 * j];
            d0 += (v[0][j].x * ww.x + v[0][j].y * ww.y) + (v[0][j].z * ww.z + v[0][j].w * ww.w); d1 += (v[1][j].x * ww.x + v[1][j].y * ww.y) + (v[1][j].z * ww.z + v[1][j].w * ww.w); }
        d0 = wave_sum(d0); d1 = wave_sum(d1); if (C.lane == h) { mine[0] = d0; mine[1] = d1; } }
#pragma unroll
    for (int r = 0; r < 2; ++r) { const int m = mm[r], b = m / SEQ, t = m % SEQ;
        if (C.lane < 12) C.LOGF[(size_t)(b * 12 + C.lane) * SEQ + t] = log_sigmoidf_(mine[r] + C.b_forget[C.lane]);
        if (C.lane < 32) { const float ang = (float)C.pos[m] * INV_FREQ[C.lane]; const double rev = (double)ang * 0.15915494309189535; const float fr = (float)(rev - floor(rev));
            C.ROPE[(size_t)m * 64 + C.lane] = __builtin_amdgcn_cosf(fr); C.ROPE[(size_t)m * 64 + 32 + C.lane] = __builtin_amdgcn_sinf(fr); } }
}
__device__ __forceinline__ void phase0(const Ctx& C) {
    const int gw = C.vcu * NWAVES + C.wave, NGW = C.G * NWAVES;
    LAS float* scr = (LAS float*)(C.lds + RING_OFF + C.wave * 16384);
    for (int r = gw; r < 32; r += NGW) p0_router_item(C.w_router, 64 * r, C.Wr_t, C.norm_ffn, scr, C.lane);
    LAS unsigned* tile = (LAS unsigned*)(C.lds + RING_OFF + C.wave * 8192);
    __syncthreads();
    LAS float* lnorm = (LAS float*)(C.lds + RING_OFF + 65536);
    p0_fill_lnorm(C, lnorm); __syncthreads();
    p0_fp8_loop(C, CONV_IN_P3 ? I_GU + I_D : 0, CONV_IN_P3 ? I_ING : N8, gw, NGW, tile, lnorm);
    if (N8 + gw < NITEMS) {
        TItem cur = p0_decode(C, N8 + gw); f32x4 va[8][2]; float sa[8][2]; titem_load(cur, va, sa, C.lane);
        for (int it = N8 + gw; it < NITEMS; it += NGW) {
            const int nx = it + NGW; TItem nxt = cur; f32x4 vb[8][2]; float sb[8][2];
            if (nx < NITEMS) { nxt = p0_decode(C, nx); titem_load(nxt, vb, sb, C.lane); }
            titem_store(cur, va, sa, tile, C.lane);
            cur = nxt;
#pragma unroll
            for (int p = 0; p < 8; ++p)
#pragma unroll
                for (int h = 0; h < 2; ++h) { va[p][h] = vb[p][h]; sa[p][h] = sb[p][h]; }
        }
    }
    __syncthreads();
    LAS float* Wf = (LAS float*)(C.lds + RING_OFF);
    for (int idx = C.tid; idx < 12 * 2048; idx += NWAVES * 64) { const int k = idx / 12, h = idx - 12 * k; Wf[h * 2048 + k] = C.w_in[(size_t)k * INW + 2304 + h]; }
    __syncthreads();
    { int m = gw; for (; m + NGW < T; m += 2 * NGW) p0_x_rows2(C, Wf, m, m + NGW); if (m < T) p0_norm_row<true>(C, C.x + (size_t)m * DM, C.norm_mix, C.XN + (size_t)m * DM, Wf, m); }
    for (int m = gw; m < MROWS; m += NGW) p0_norm_row<false>(C, C.mem + (size_t)m * DM, C.norm_mem, C.MN + (size_t)m * DM, Wf, m);
    __syncthreads();
}

constexpr int CONV_CHUNK = 128, CONV_NCHUNK = (I_GU + I_D) / CONV_CHUNK;
static_assert((I_GU + I_D) % CONV_CHUNK == 0, "conversion chunks");
__device__ __forceinline__ void conv_chunk(const Ctx& C, int chunk) {
    LAS unsigned* tile = (LAS unsigned*)(C.lds + RING_OFF + C.wave * 8192);
    p0_fp8_loop(C, chunk * CONV_CHUNK, CONV_CHUNK, C.wave, NWAVES, tile, (const LAS float*)(C.lds + RING_OFF + 65536));
}

using pg8::Unit;
template <int RB>
struct DenseOrderT {
    const char* A; const char* Bt; int nM, nN, nwg, G, c;
    __device__ __forceinline__ void init(const void* A_, const void* Bt_, int M, int N, int G_, int c_) { A = (const char*)A_; Bt = (const char*)Bt_; nM = M / 256; nN = N / 256; nwg = nM * nN; G = G_; c = c_; }
    __device__ __forceinline__ bool map(long L, Unit& u) const {
        if (L >= nwg) return false;
        int wgid = (int)L; { const int q = nwg / 8, r = nwg % 8, xcd = wgid % 8, off = wgid / 8; wgid = (xcd < r ? xcd * (q + 1) : r * (q + 1) + (xcd - r) * q) + off; }
        const int nig = 8 * nN, gid = wgid / nig, fm = gid * 8, gsz = (nM - fm) < 8 ? (nM - fm) : 8;
        u.pm = fm + ((wgid % nig) % gsz); u.pn = (wgid % nig) / gsz; u.e = 0; u.kind = 0; return true;
    }
    __device__ __forceinline__ bool next(int i, Unit& u) const { return map((long)i * G + c, u); }
    __device__ __forceinline__ const char* a_base(const Unit& u) const { return A + (size_t)u.pm * (256 * RB); }
    __device__ __forceinline__ const char* b_base(const Unit& u) const { return Bt + (size_t)u.pn * (256 * RB); }
    __device__ __forceinline__ void a_offs(const Unit&, const int (&R)[2], const int (&Cc)[2], unsigned (&vo)[2][2]) const {
#pragma unroll
        for (int h = 0; h < 2; ++h)
#pragma unroll
            for (int i = 0; i < 2; ++i) vo[h][i] = (unsigned)((h * 128 + R[i]) * RB + Cc[i] * 2);
    }
};
typedef DenseOrderT<4096> DenseOrder;
struct P1Order {
    DenseOrder d; const char* A1; const char* B1;
    __device__ __forceinline__ bool next(int i, Unit& u) const {
        const long L = (long)i * d.G + d.c;
        if (L < d.nwg) return d.map(L, u);
        const int r = (int)(L - d.nwg); if (r >= 8) return false;
        u.pm = r >> 2; u.pn = r & 3; u.e = 0; u.kind = 1; return true;
    }
    __device__ __forceinline__ const char* a_base(const Unit& u) const { return (u.kind ? A1 : d.A) + (size_t)u.pm * (256 * 2048 * 2); }
    __device__ __forceinline__ const char* b_base(const Unit& u) const { return (u.kind ? B1 : d.Bt) + (size_t)u.pn * (256 * 2048 * 2); }
    __device__ __forceinline__ void a_offs(const Unit& u, const int (&R)[2], const int (&Cc)[2], unsigned (&vo)[2][2]) const { d.a_offs(u, R, Cc, vo); }
};
struct P1bOrder {
    DenseOrderT<2048> d;
    __device__ __forceinline__ bool next(int i, Unit& u) const {
        const int c = d.c;
        if (c < 8) return i < 4 ? d.map((long)i * d.G + c, u) : false;
        if (i < 6) return d.map((long)i * d.G + c, u);
        if (i == 6 && c < 24) { const int idx = c - 8; return d.map((long)(4 + (idx & 1)) * d.G + (idx >> 1), u); }
        return false;
    }
    __device__ __forceinline__ const char* a_base(const Unit& u) const { return d.a_base(u); }
    __device__ __forceinline__ const char* b_base(const Unit& u) const { return d.b_base(u); }
    __device__ __forceinline__ void a_offs(const Unit& u, const int (&R)[2], const int (&Cc)[2], unsigned (&vo)[2][2]) const { d.a_offs(u, R, Cc, vo); }
};
template <bool GATHER, int NT, int RB>
struct MoeOrder {
    const char* A; const char* Bt; const int* tok; const int* cnt; const LAS int* tab; int G, c;
    __device__ __forceinline__ bool next(int i, Unit& u) const {
        const int L = i * G + c; if (L >= __builtin_amdgcn_readfirstlane(tab[32])) return false;
        int e = 0;
#pragma unroll 1
        for (int j = 1; j < 32; ++j) e += (__builtin_amdgcn_readfirstlane(tab[j]) <= L) ? 1 : 0;
        const int j = L - __builtin_amdgcn_readfirstlane(tab[e]), mt = __builtin_amdgcn_readfirstlane(tab[33 + e]), per = mt * 4, ntg = j / per, r = j - ntg * per;
        u.e = e; u.pm = r >> 2; u.pn = ntg * 4 + (r & 3); u.kind = __builtin_amdgcn_readfirstlane(tab[65 + e]) + 256 * u.pm;
        return true;
    }
    __device__ __forceinline__ const char* a_base(const Unit& u) const { return GATHER ? A : A + (size_t)u.kind * RB; }
    __device__ __forceinline__ const char* b_base(const Unit& u) const { return Bt + ((size_t)u.e * NT + u.pn) * (256 * RB); }
    __device__ __forceinline__ void a_offs(const Unit& u, const int (&R)[2], const int (&Cc)[2], unsigned (&vo)[2][2]) const {
#pragma unroll
        for (int h = 0; h < 2; ++h)
#pragma unroll
            for (int i = 0; i < 2; ++i) {
                if constexpr (GATHER) { const int n_e = __builtin_amdgcn_readfirstlane(tab[97 + u.e]); int ri = 256 * u.pm + h * 128 + R[i]; ri = ri < n_e ? ri : n_e - 1;
                    const int row = tok[u.e * CAP + ri]; vo[h][i] = (unsigned)(row * RB + Cc[i] * 2); }
                else vo[h][i] = (unsigned)((h * 128 + R[i]) * RB + Cc[i] * 2);
            }
    }
};

struct EpiInProj {
    static constexpr bool PERM = true, MID = false, FP8 = false, ASM_MFMA = false, BTILED = false; static constexpr int SCALE_A = 0x7f, SCALE_B = 0x7f;
    bf16* QKV; bf16* Gt; bf16* MKV; int noop; const float* gk_fox; const float* gk_swa; const float* rope;
    __device__ __forceinline__ void mid(pg8::f32x4 (&)[2][2][4][2], const Unit&, int, int, int, int, int) const {}
    __device__ __forceinline__ void operator()(const pg8::f32x4 (&acc)[2][2][4][2], const Unit& u, int wr, int wc, int fr, int fq) const {
        asm volatile("" : "+v"(fr), "+v"(fq));
        if (noop) return;
        if (!u.kind && (u.pn == 3 || u.pn == 4 || u.pn == 5 || u.pn == 12)) {
            const bool swa = (u.pn == 12); const float* gp = (swa ? gk_swa : gk_fox) + 8 * fq;
            float gn[2][8];
#pragma unroll
            for (int bj = 0; bj < 2; ++bj) { const pg8::f32x4 a = *(const pg8::f32x4*)(gp + 32 * bj), b = *(const pg8::f32x4*)(gp + 32 * bj + 4);
                gn[bj][0] = a[0]; gn[bj][1] = a[1]; gn[bj][2] = a[2]; gn[bj][3] = a[3]; gn[bj][4] = b[0]; gn[bj][5] = b[1]; gn[bj][6] = b[2]; gn[bj][7] = b[3]; }
#pragma unroll
            for (int ai = 0; ai < 2; ++ai)
#pragma unroll
                for (int m = 0; m < 4; ++m) { const int row = u.pm * 256 + wr * 64 + fr + ai * 128 + m * 16;
                    float x[2][8]; float ss = 0.f;
#pragma unroll
                    for (int bj = 0; bj < 2; ++bj)
#pragma unroll
                        for (int n = 0; n < 2; ++n)
#pragma unroll
                            for (int e = 0; e < 4; ++e) { const float v = acc[ai][bj][m][n][e]; x[bj][4 * n + e] = v; ss += v * v; }
                    ss += __shfl_xor(ss, 16); ss += __shfl_xor(ss, 32);
                    const float rstd = 1.0f / sqrtf(ss * (1.f / 64.f) + NORM_EPS);
#pragma unroll
                    for (int bj = 0; bj < 2; ++bj)
#pragma unroll
                        for (int q = 0; q < 8; ++q) x[bj][q] = (x[bj][q] * rstd) * gn[bj][q];
                    if (swa) { const float* cs = rope + (size_t)row * 64 + 8 * fq;
                        const pg8::f32x4 c0 = *(const pg8::f32x4*)cs, c1 = *(const pg8::f32x4*)(cs + 4), s0 = *(const pg8::f32x4*)(cs + 32), s1 = *(const pg8::f32x4*)(cs + 36);
                        const float cc[8] = {c0[0], c0[1], c0[2], c0[3], c1[0], c1[1], c1[2], c1[3]}, sn[8] = {s0[0], s0[1], s0[2], s0[3], s1[0], s1[1], s1[2], s1[3]};
#pragma unroll
                        for (int q = 0; q < 8; ++q) { const float x1 = x[0][q], x2 = x[1][q]; x[0][q] = x1 * cc[q] - x2 * sn[q]; x[1][q] = x2 * cc[q] + x1 * sn[q]; } }
                    bf16* rowp = QKV + (size_t)row * QKVW + u.pn * 256 + 64 * wc + 8 * fq;
#pragma unroll
                    for (int bj = 0; bj < 2; ++bj) { u32x4 w; w.x = cvt_pk_bf16(x[bj][0], x[bj][1]); w.y = cvt_pk_bf16(x[bj][2], x[bj][3]); w.z = cvt_pk_bf16(x[bj][4], x[bj][5]); w.w = cvt_pk_bf16(x[bj][6], x[bj][7]);
                        *(u32x4*)(rowp + 32 * bj) = w; } }
            return;
        }
        const int row0 = u.pm * 256 + wr * 64 + fr;
        bf16* base; int ldc, colt; bool sg = false;
        if (u.kind) { base = MKV; ldc = 1024; colt = u.pn * 256; }
        else if (u.pn < 16) { base = QKV; ldc = QKVW; colt = u.pn * 256; }
        else { base = Gt; ldc = GW; colt = (u.pn - 16) * 256; sg = true; }
        const int col0 = colt + wc * 32 + 8 * fq;
#pragma unroll
        for (int ai = 0; ai < 2; ++ai)
#pragma unroll
            for (int m = 0; m < 4; ++m) { bf16* rowp = base + (size_t)(row0 + ai * 128 + m * 16) * ldc + col0;
#pragma unroll
                for (int bj = 0; bj < 2; ++bj) { pg8::f32x4 v0 = acc[ai][bj][m][0], v1 = acc[ai][bj][m][1];
                    if (sg) {
#pragma unroll
                        for (int q = 0; q < 4; ++q) { v0[q] = sigmoidf_(fmaxf(v0[q], -30.f)); v1[q] = sigmoidf_(fmaxf(v1[q], -30.f)); } }
                    u32x4 w; w.x = cvt_pk_bf16(v0[0], v0[1]); w.y = cvt_pk_bf16(v0[2], v0[3]); w.z = cvt_pk_bf16(v1[0], v1[1]); w.w = cvt_pk_bf16(v1[2], v1[3]);
                    *(u32x4*)(rowp + bj * 128) = w; } }
    }
};
#ifndef PROBE_GASM
#define PROBE_GASM true
#endif
struct EpiGates {
    static constexpr bool PERM = true, MID = false, FP8 = true, ASM_MFMA = PROBE_GASM, BTILED = true; static constexpr int SCALE_A = 127 - H8_SHIFT, SCALE_B = 127 - W8_SHIFT;
    bf16* Gt;
    __device__ __forceinline__ void mid(pg8::f32x4 (&)[2][2][4][2], const Unit&, int, int, int, int, int) const {}
    __device__ __forceinline__ void operator()(const pg8::f32x4 (&acc)[2][2][4][2], const Unit& u, int wr, int wc, int fr, int fq) const {
        asm volatile("" : "+v"(fr), "+v"(fq));
        const int row0 = u.pm * 256 + wr * 64 + fr, col0 = u.pn * 256 + wc * 32 + 8 * fq;
#pragma unroll
        for (int ai = 0; ai < 2; ++ai)
#pragma unroll
            for (int m = 0; m < 4; ++m) { bf16* rowp = Gt + (size_t)(row0 + ai * 128 + m * 16) * GW + col0;
#pragma unroll
                for (int bj = 0; bj < 2; ++bj) { unsigned wv[4];
#pragma unroll
                    for (int n = 0; n < 2; ++n)
#pragma unroll
                        for (int hq = 0; hq < 2; ++hq) { typedef pg8::f32x2 f2;
                            f2 x = {fmaxf(acc[ai][bj][m][n][2 * hq], -30.f), fmaxf(acc[ai][bj][m][n][2 * hq + 1], -30.f)};
                            const f2 t = x * (-LOG2E); f2 e; e.x = __builtin_amdgcn_exp2f(t.x); e.y = __builtin_amdgcn_exp2f(t.y);
                            const f2 d = e + 1.0f; wv[2 * n + hq] = cvt_pk_bf16(__builtin_amdgcn_rcpf(d.x), __builtin_amdgcn_rcpf(d.y)); }
                    u32x4 w; w.x = wv[0]; w.y = wv[1]; w.z = wv[2]; w.w = wv[3];
                    *(u32x4*)(rowp + bj * 128) = w; } }
    }
};
struct EpiMerge {
    static constexpr bool PERM = true, MID = true, FP8 = false, ASM_MFMA = false, BTILED = false; static constexpr int SCALE_A = 0x7f, SCALE_B = 0x7f;
    const bf16* Gt; bf16* O;
    __device__ __forceinline__ void mid(pg8::f32x4 (&acc)[2][2][4][2], const Unit& u, int which, int wr, int wc, int fr, int fq) const {
        asm volatile("" : "+v"(fr), "+v"(fq));
        const int row0 = u.pm * 256 + wr * 64 + fr, col0 = u.pn * 256 + wc * 32 + 8 * fq;
        const bf16* gn = Gt + (which ? 2048 : 0); const bf16* gd = Gt + (which ? 4096 : 2048);
#pragma unroll
        for (int ai = 0; ai < 2; ++ai)
#pragma unroll
            for (int m = 0; m < 4; ++m) { const size_t ro = (size_t)(row0 + ai * 128 + m * 16) * GW + col0;
#pragma unroll
                for (int bj = 0; bj < 2; ++bj) { const u32x4 a = *(const u32x4*)(gn + ro + bj * 128), b = *(const u32x4*)(gd + ro + bj * 128);
                    pg8::f32x4 r0, r1;
                    r0[0] = bf_lo(a.x) * __builtin_amdgcn_rcpf(bf_lo(b.x)); r0[1] = bf_hi(a.x) * __builtin_amdgcn_rcpf(bf_hi(b.x)); r0[2] = bf_lo(a.y) * __builtin_amdgcn_rcpf(bf_lo(b.y)); r0[3] = bf_hi(a.y) * __builtin_amdgcn_rcpf(bf_hi(b.y));
                    r1[0] = bf_lo(a.z) * __builtin_amdgcn_rcpf(bf_lo(b.z)); r1[1] = bf_hi(a.z) * __builtin_amdgcn_rcpf(bf_hi(b.z)); r1[2] = bf_lo(a.w) * __builtin_amdgcn_rcpf(bf_lo(b.w)); r1[3] = bf_hi(a.w) * __builtin_amdgcn_rcpf(bf_hi(b.w));
                    acc[ai][bj][m][0] *= r0; acc[ai][bj][m][1] *= r1; }
                asm volatile("" : "+v"(acc[ai][0][m][0]), "+v"(acc[ai][0][m][1]), "+v"(acc[ai][1][m][0]), "+v"(acc[ai][1][m][1]));
                asm volatile("" ::: "memory"); }
    }
    __device__ __forceinline__ void operator()(const pg8::f32x4 (&acc)[2][2][4][2], const Unit& u, int wr, int wc, int fr, int fq) const {
        asm volatile("" : "+v"(fr), "+v"(fq));
        const int row0 = u.pm * 256 + wr * 64 + fr, col0 = u.pn * 256 + wc * 32 + 8 * fq;
#pragma unroll
        for (int ai = 0; ai < 2; ++ai)
#pragma unroll
            for (int m = 0; m < 4; ++m) { const size_t rr = (size_t)(row0 + ai * 128 + m * 16);
#pragma unroll
                for (int bj = 0; bj < 2; ++bj) { const u32x4 g = *(const u32x4*)(Gt + rr * GW + 4096 + col0 + bj * 128);
                    const pg8::f32x4 v0 = acc[ai][bj][m][0], v1 = acc[ai][bj][m][1];
                    u32x4 w; w.x = cvt_pk_bf16(v0[0] * bf_lo(g.x), v0[1] * bf_hi(g.x)); w.y = cvt_pk_bf16(v0[2] * bf_lo(g.y), v0[3] * bf_hi(g.y));
                    w.z = cvt_pk_bf16(v1[0] * bf_lo(g.z), v1[1] * bf_hi(g.z)); w.w = cvt_pk_bf16(v1[2] * bf_lo(g.w), v1[3] * bf_hi(g.w));
                    *(u32x4*)(O + rr * DM + col0 + bj * 128) = w; }
                asm volatile("" ::: "memory"); }
    }
};
struct EpiOut {
    static constexpr bool PERM = true, MID = false, FP8 = false, ASM_MFMA = false, BTILED = false; static constexpr int SCALE_A = 0x7f, SCALE_B = 0x7f;
    const float* X; float* out; unsigned char* HB8; int noop;
    __device__ __forceinline__ void mid(pg8::f32x4 (&)[2][2][4][2], const Unit&, int, int, int, int, int) const {}
    __device__ __forceinline__ void operator()(const pg8::f32x4 (&acc)[2][2][4][2], const Unit& u, int wr, int wc, int fr, int fq) const {
        asm volatile("" : "+v"(fr), "+v"(fq));
        if (noop) return;
        const int row0 = u.pm * 256 + wr * 64 + fr, col0 = u.pn * 256 + wc * 32 + 8 * fq;
#pragma unroll
        for (int ai = 0; ai < 2; ++ai)
#pragma unroll
            for (int mp = 0; mp < 2; ++mp) {
                pg8::f32x4 xv[2][2][2];
#pragma unroll
                for (int mm = 0; mm < 2; ++mm) { const size_t off = (size_t)(row0 + ai * 128 + (2 * mp + mm) * 16) * DM + col0;
#pragma unroll
                    for (int bj = 0; bj < 2; ++bj) { xv[mm][bj][0] = *(const pg8::f32x4*)(X + off + bj * 128); xv[mm][bj][1] = *(const pg8::f32x4*)(X + off + bj * 128 + 4); } }
#pragma unroll
                for (int mm = 0; mm < 2; ++mm) { const int m = 2 * mp + mm; const size_t off = (size_t)(row0 + ai * 128 + m * 16) * DM + col0;
#pragma unroll
                    for (int bj = 0; bj < 2; ++bj) { const pg8::f32x4 h0 = xv[mm][bj][0] + acc[ai][bj][m][0], h1 = xv[mm][bj][1] + acc[ai][bj][m][1];
                        *(pg8::f32x4*)(out + off + bj * 128) = h0; *(pg8::f32x4*)(out + off + bj * 128 + 4) = h1;
                        u32x2 w; w.x = pk4_fp8(h0[0] * H8_MUL, h0[1] * H8_MUL, h0[2] * H8_MUL, h0[3] * H8_MUL); w.y = pk4_fp8(h1[0] * H8_MUL, h1[1] * H8_MUL, h1[2] * H8_MUL, h1[3] * H8_MUL);
                        *(u32x2*)(HB8 + off + bj * 128) = w; } }
                asm volatile("" ::: "memory");
            }
    }
};
struct EpiGateUp {
    static constexpr bool PERM = true, MID = false, FP8 = true, ASM_MFMA = true, BTILED = true; static constexpr int SCALE_A = 127 - H8_SHIFT, SCALE_B = 127 - W8_SHIFT;
    const float* RS; const float* bgu; unsigned char* ACT8;
    __device__ __forceinline__ void mid(pg8::f32x4 (&)[2][2][4][2], const Unit&, int, int, int, int, int) const {}
    __device__ __forceinline__ void operator()(const pg8::f32x4 (&acc)[2][2][4][2], const Unit& u, int wr, int wc, int fr, int fq) const {
        asm volatile("" : "+v"(fr), "+v"(fq));
        const int r0 = wr * 64 + fr, hc0 = u.pn * 128 + wc * 32 + 8 * fq;
        const float* bg = bgu + (size_t)u.e * 4096 + hc0;
        const pg8::f32x4 bg0 = *(const pg8::f32x4*)(bg), bg1 = *(const pg8::f32x4*)(bg + 4), bu0 = *(const pg8::f32x4*)(bg + 2048), bu1 = *(const pg8::f32x4*)(bg + 2052);
        float rsv[2][4];
#pragma unroll
        for (int ai = 0; ai < 2; ++ai)
#pragma unroll
            for (int m = 0; m < 4; ++m) rsv[ai][m] = RS[u.e * CAP + 256 * u.pm + r0 + ai * 128 + m * 16];
#pragma unroll
        for (int ai = 0; ai < 2; ++ai)
#pragma unroll
            for (int m = 0; m < 4; ++m) { const int rl = r0 + ai * 128 + m * 16;
                const float rs = rsv[ai][m];
                typedef pg8::f32x2 f2;
                f2 a2[4];
#pragma unroll
                for (int n = 0; n < 2; ++n)
#pragma unroll
                    for (int hq = 0; hq < 2; ++hq) {
                        const f2 ag = {acc[ai][0][m][n][2 * hq], acc[ai][0][m][n][2 * hq + 1]}, au = {acc[ai][1][m][n][2 * hq], acc[ai][1][m][n][2 * hq + 1]};
                        const f2 bgv = n ? (f2){bg1[2 * hq], bg1[2 * hq + 1]} : (f2){bg0[2 * hq], bg0[2 * hq + 1]}, buv = n ? (f2){bu1[2 * hq], bu1[2 * hq + 1]} : (f2){bu0[2 * hq], bu0[2 * hq + 1]};
                        f2 g = ag * rs + bgv, up = au * rs + buv;
                        g.x = fminf(g.x, SWIGLU_LIMIT); g.y = fminf(g.y, SWIGLU_LIMIT);
                        up.x = __builtin_amdgcn_fmed3f(up.x, -SWIGLU_LIMIT, SWIGLU_LIMIT); up.y = __builtin_amdgcn_fmed3f(up.y, -SWIGLU_LIMIT, SWIGLU_LIMIT);
                        const f2 t = g * (-SWIGLU_ALPHA * LOG2E);
                        f2 e; e.x = __builtin_amdgcn_exp2f(t.x); e.y = __builtin_amdgcn_exp2f(t.y);
                        const f2 d = e + 1.0f;
                        f2 r; r.x = __builtin_amdgcn_rcpf(d.x); r.y = __builtin_amdgcn_rcpf(d.y);
                        const f2 sg = (g * ACT8_MUL) * r;
                        a2[2 * n + hq] = up * sg + sg;
                    }
                u32x2 w;
                { int p0 = __builtin_amdgcn_cvt_pk_fp8_f32(a2[0].x, a2[0].y, 0, false); p0 = __builtin_amdgcn_cvt_pk_fp8_f32(a2[1].x, a2[1].y, p0, true); w.x = (unsigned)p0;
                  int p1 = __builtin_amdgcn_cvt_pk_fp8_f32(a2[2].x, a2[2].y, 0, false); p1 = __builtin_amdgcn_cvt_pk_fp8_f32(a2[3].x, a2[3].y, p1, true); w.y = (unsigned)p1; }
                *(u32x2*)(ACT8 + (size_t)(u.kind + rl) * DM + hc0) = w; }
    }
};
struct EpiDown {
    static constexpr bool PERM = true, MID = false, FP8 = true, ASM_MFMA = true, BTILED = true; static constexpr int SCALE_A = 127 - ACT8_SHIFT, SCALE_B = 127 - W8_SHIFT;
    const float* bd; bf16* Y; int noop;
    __device__ __forceinline__ void mid(pg8::f32x4 (&)[2][2][4][2], const Unit&, int, int, int, int, int) const {}
    __device__ __forceinline__ void operator()(const pg8::f32x4 (&acc)[2][2][4][2], const Unit& u, int wr, int wc, int fr, int fq) const {
        asm volatile("" : "+v"(fr), "+v"(fq));
        if (noop) return;
        const int r0 = wr * 64 + fr, col0 = u.pn * 256 + wc * 32 + 8 * fq;
        const float* bb = bd + (size_t)u.e * DM + col0;
        pg8::f32x4 bv[2][2];
#pragma unroll
        for (int bj = 0; bj < 2; ++bj)
#pragma unroll
            for (int n = 0; n < 2; ++n) bv[bj][n] = *(const pg8::f32x4*)(bb + bj * 128 + n * 4);
#pragma unroll
        for (int ai = 0; ai < 2; ++ai)
#pragma unroll
            for (int m = 0; m < 4; ++m) { bf16* rowp = Y + (size_t)(u.kind + r0 + ai * 128 + m * 16) * DM + col0;
#pragma unroll
                for (int bj = 0; bj < 2; ++bj) { const pg8::f32x4 v0 = acc[ai][bj][m][0] + bv[bj][0], v1 = acc[ai][bj][m][1] + bv[bj][1];
                    u32x4 w; w.x = cvt_pk_bf16(v0[0], v0[1]); w.y = cvt_pk_bf16(v0[2], v0[3]); w.z = cvt_pk_bf16(v1[0], v1[1]); w.w = cvt_pk_bf16(v1[2], v1[3]);
                    *(u32x4*)(rowp + bj * 128) = w; } }
    }
};

__device__ __forceinline__ void logf_cumsum(const Ctx& C) {
    LAS float* wt = (LAS float*)(C.lds + RING_OFF);
    for (int sq = (int)blockIdx.x; sq < BATCH * 12; sq += C.G) {
        const float* src = C.LOGF + (size_t)sq * SEQ + C.tid * 16; float* dst = C.CNEG + (size_t)sq * SEQ + C.tid * 16;
        f32x4 a[4]; float tot = 0.f;
#pragma unroll
        for (int j = 0; j < 4; ++j) { a[j] = *(const GAS f32x4*)(src + 4 * j); tot += (a[j].x + a[j].y) + (a[j].z + a[j].w); }
        float incl = tot;
#pragma unroll
        for (int o = 1; o < 64; o <<= 1) { const float n = __shfl_up(incl, o); if (C.lane >= o) incl += n; }
        if (C.lane == 63) wt[C.wave] = incl;
        __syncthreads();
        float run = incl - tot;
        for (int w = 0; w < C.wave; ++w) run += wt[w];
#pragma unroll
        for (int j = 0; j < 4; ++j) { f32x4 c; run += a[j].x; c.x = -run * LOG2E; run += a[j].y; c.y = -run * LOG2E; run += a[j].z; c.z = -run * LOG2E; run += a[j].w; c.w = -run * LOG2E; *(GAS f32x4*)(dst + 4 * j) = c; }
        __syncthreads();
    }
}

#ifndef CONV_FIRST_QUARTERS
#define CONV_FIRST_QUARTERS 2
#endif
namespace att {
typedef __attribute__((address_space(3))) const char* lds_cptr;
__device__ __forceinline__ void glds16(const void* gsrc, unsigned lds_dst) { unsigned keep;
    asm volatile("s_mov_b32 %0, m0\n\ts_mov_b32 m0, %2\n\ts_nop 0\n\tglobal_load_lds_dwordx4 %1, off\n\ts_mov_b32 m0, %0" : "=&s"(keep) : "v"(gsrc), "s"(lds_dst) : "memory"); }
typedef float f32x2_t __attribute__((ext_vector_type(2))); typedef __bf16 bf16x2_t __attribute__((ext_vector_type(2)));
__device__ __forceinline__ unsigned cvtpk_s(float lo, float hi) { f32x2_t v = {lo, hi}; bf16x2_t b = __builtin_convertvector(v, bf16x2_t); return __builtin_bit_cast(unsigned, b); }
__device__ __forceinline__ int crow(int r, int hi) { return (r & 3) + 8 * (r >> 2) + 4 * hi; }

template <int D> struct Geo {
    static constexpr int SLOTB = 64 * D * 2, NSLOT = (D == 64) ? 3 : 2, PPT = (D == 64) ? 2 : 4;
    static constexpr int LDS_K = 0, LDS_V = NSLOT * SLOTB, LDS_WS = 2 * NSLOT * SLOTB, LDS_WMIN = LDS_WS + 2048, LDS_OST = LDS_WMIN + 64, LDS_CB = LDS_OST + 8 * 4096, LDS_END = LDS_CB + 32768;
};

template <int D>
__device__ __forceinline__ void qkt(f32x16& p0, f32x16& p1, lds_cptr Kslot, const bf16x8* qr, int r32, int hi) {
    lds_cptr kb = Kslot + hi * 1024 + r32 * 16;
    p0 = f32x16{}; p1 = f32x16{};
#pragma unroll
    for (int d0 = 0; d0 < D / 16; ++d0) {
        const bf16x8 b0 = *(const LAS bf16x8*)(kb + d0 * 2048);
        const bf16x8 b1 = *(const LAS bf16x8*)(kb + d0 * 2048 + 512);
        p0 = __builtin_amdgcn_mfma_f32_32x32x16_bf16(b0, qr[d0], p0, 0, 0, 0); p1 = __builtin_amdgcn_mfma_f32_32x32x16_bf16(b1, qr[d0], p1, 0, 0, 0); }
}
template <int D>
__device__ __forceinline__ void pv(f32x16* o, int vb, bf16x8 pa0, bf16x8 pa1, bf16x8 pa2, bf16x8 pa3) {
#pragma unroll
    for (int d0 = 0; d0 < D / 32; ++d0) { s16x4 lo[4], hi[4];
#pragma unroll
        for (int ks = 0; ks < 4; ++ks) {
            asm volatile("ds_read_b64_tr_b16 %0,%1 offset:%c2" : "=&v"(lo[ks]) : "v"(vb), "i"(d0 * 4096 + ks * 1024) : "memory");
            asm volatile("ds_read_b64_tr_b16 %0,%1 offset:%c2" : "=&v"(hi[ks]) : "v"(vb), "i"(d0 * 4096 + ks * 1024 + 512) : "memory"); }
        asm volatile("s_waitcnt lgkmcnt(0)" ::: "memory"); __builtin_amdgcn_sched_barrier(0);
#define ATT_PK(k) (bf16x8){lo[k][0], lo[k][1], lo[k][2], lo[k][3], hi[k][0], hi[k][1], hi[k][2], hi[k][3]}
        o[d0] = __builtin_amdgcn_mfma_f32_32x32x16_bf16(pa0, ATT_PK(0), o[d0], 0, 0, 0);
        o[d0] = __builtin_amdgcn_mfma_f32_32x32x16_bf16(pa1, ATT_PK(1), o[d0], 0, 0, 0);
        o[d0] = __builtin_amdgcn_mfma_f32_32x32x16_bf16(pa2, ATT_PK(2), o[d0], 0, 0, 0);
        o[d0] = __builtin_amdgcn_mfma_f32_32x32x16_bf16(pa3, ATT_PK(3), o[d0], 0, 0, 0);
#undef ATT_PK
    }
}

template <int D, int MODE>
__device__ __forceinline__ void attn_unit(LAS unsigned char* shm, const bf16* Q, int pitchQ, const bf16* K, const bf16* V, int pitchKV, bf16* O, const float* cneg, float sink2, int qb, const float* qgain, const float* kgain, const float* ropet, float bqk = 0.f) {
    typedef Geo<D> G;
    int tid = threadIdx.x; asm volatile("" : "+v"(tid));
    const int lane = tid & 63, r32 = lane & 31, hi = lane >> 5; const int wid = __builtin_amdgcn_readfirstlane(tid >> 6);
    const int q0 = qb * 256, q0w = q0 + wid * 32;
    const unsigned lds0 = (unsigned)(uintptr_t)shm;
    LAS float* wsf = (LAS float*)(shm + G::LDS_WS) + wid * 64;
    LAS float* cb = (LAS float*)(shm + G::LDS_CB);
    const int j_lo = (MODE == 1) ? (qb > 0 ? 4 * qb - 2 : 0) : 0, j_hi = (MODE == 2) ? 4 : 4 * qb + 4;
    bf16x8 qr[D / 16];
    { const bf16* Qw = Q + (size_t)(q0w + r32) * pitchQ + hi * 8;
#pragma unroll
      for (int d0 = 0; d0 < D / 16; ++d0) qr[d0] = *(const GAS bf16x8*)(Qw + d0 * 16); }
    {
#define ATT_UNPK(dst, src) do { const v4u w_ = __builtin_bit_cast(v4u, src); dst[0] = pg8::bf_lo(w_.x); dst[1] = pg8::bf_hi(w_.x); dst[2] = pg8::bf_lo(w_.y); dst[3] = pg8::bf_hi(w_.y); dst[4] = pg8::bf_lo(w_.z); dst[5] = pg8::bf_hi(w_.z); dst[6] = pg8::bf_lo(w_.w); dst[7] = pg8::bf_hi(w_.w); } while (0)
#define ATT_PK8(dst, src) do { v4u w_; w_.x = cvtpk_s(src[0], src[1]); w_.y = cvtpk_s(src[2], src[3]); w_.z = cvtpk_s(src[4], src[5]); w_.w = cvtpk_s(src[6], src[7]); dst = __builtin_bit_cast(bf16x8, w_); } while (0)
        float ss = 0.f;
#pragma unroll
        for (int d0 = 0; d0 < D / 16; ++d0) { float t[8]; ATT_UNPK(t, qr[d0]);
#pragma unroll
            for (int j = 0; j < 8; ++j) ss += t[j] * t[j]; }
        { auto rr = __builtin_amdgcn_permlane32_swap(__float_as_uint(ss), __float_as_uint(ss), false, false); ss = __uint_as_float(rr[0]) + __uint_as_float(rr[1]); }
        const float rq = (1.0f / sqrtf(ss * (1.f / D) + NORM_EPS)) * ((D == 64 ? 0.125f : 0.08838834764831845f) * LOG2E);
        if constexpr (MODE == 1) {
            const float* cs = ropet + (size_t)(q0w + r32) * 64 + 8 * hi;
#pragma unroll
            for (int d0 = 0; d0 < 2; ++d0) { float x1[8], x2[8]; ATT_UNPK(x1, qr[d0]); ATT_UNPK(x2, qr[d0 + 2]);
                const float* g1 = qgain + 16 * d0 + 8 * hi;
                const f32x4 ga = *(const GAS f32x4*)g1, gb = *(const GAS f32x4*)(g1 + 4), gc = *(const GAS f32x4*)(g1 + 32), gd = *(const GAS f32x4*)(g1 + 36);
                const f32x4 c0 = *(const GAS f32x4*)(cs + 16 * d0), c1 = *(const GAS f32x4*)(cs + 16 * d0 + 4), s0 = *(const GAS f32x4*)(cs + 32 + 16 * d0), s1 = *(const GAS f32x4*)(cs + 36 + 16 * d0);
                const float gg1[8] = {ga.x, ga.y, ga.z, ga.w, gb.x, gb.y, gb.z, gb.w}, gg2[8] = {gc.x, gc.y, gc.z, gc.w, gd.x, gd.y, gd.z, gd.w};
                const float cc[8] = {c0.x, c0.y, c0.z, c0.w, c1.x, c1.y, c1.z, c1.w}, sn[8] = {s0.x, s0.y, s0.z, s0.w, s1.x, s1.y, s1.z, s1.w};
#pragma unroll
                for (int j = 0; j < 8; ++j) { const float a = (x1[j] * rq) * gg1[j], b = (x2[j] * rq) * gg2[j]; x1[j] = a * cc[j] - b * sn[j]; x2[j] = b * cc[j] + a * sn[j]; }
                ATT_PK8(qr[d0], x1); ATT_PK8(qr[d0 + 2], x2); asm volatile("" ::: "memory"); }
        } else {
#pragma unroll
            for (int d0 = 0; d0 < D / 16; ++d0) { float t[8]; ATT_UNPK(t, qr[d0]);
                const float* gp = qgain + 16 * d0 + 8 * hi; f32x4 ga = *(const GAS f32x4*)gp, gb = *(const GAS f32x4*)(gp + 4);
                if constexpr (MODE == 2) { ga = ga * *(const GAS f32x4*)(kgain + 16 * d0 + 8 * hi); gb = gb * *(const GAS f32x4*)(kgain + 16 * d0 + 8 * hi + 4); }
                t[0] = (t[0] * rq) * ga.x; t[1] = (t[1] * rq) * ga.y; t[2] = (t[2] * rq) * ga.z; t[3] = (t[3] * rq) * ga.w; t[4] = (t[4] * rq) * gb.x; t[5] = (t[5] * rq) * gb.y; t[6] = (t[6] * rq) * gb.z; t[7] = (t[7] * rq) * gb.w;
                ATT_PK8(qr[d0], t); asm volatile("" ::: "memory"); }
        }
#undef ATT_UNPK
#undef ATT_PK8
    }
    if constexpr (MODE == 2) {
        const int key = tid >> 1, hf = tid & 1; const bf16* kp = K + (size_t)key * pitchKV + 64 * hf; float ss = 0.f;
#pragma unroll
        for (int c = 0; c < 8; ++c) { const v4u w = *(const GAS v4u*)(kp + 8 * c); const float a0 = pg8::bf_lo(w.x), a1 = pg8::bf_hi(w.x), a2 = pg8::bf_lo(w.y), a3 = pg8::bf_hi(w.y), a4 = pg8::bf_lo(w.z), a5 = pg8::bf_hi(w.z), a6 = pg8::bf_lo(w.w), a7 = pg8::bf_hi(w.w);
            ss += (a0 * a0 + a1 * a1) + (a2 * a2 + a3 * a3) + (a4 * a4 + a5 * a5) + (a6 * a6 + a7 * a7); }
        ss += __shfl_xor(ss, 1);
        if (hf == 0) cb[key] = 1.0f / sqrtf(ss * (1.f / 128.f) + NORM_EPS);
    }
    if constexpr (MODE == 0) {
        const int nch = (q0 + 256) / 4;
        for (int c = tid; c < nch; c += 512) { const f32x4 v = *(const GAS f32x4*)(cneg + 4 * c); *(LAS f32x4*)(cb + 4 * c) = v; }
    }
#define ATT_DMA(j, slot) do { const int _s = (slot) * G::SLOTB; \
        if constexpr (D == 64) { \
            glds16(K + (size_t)(64 * (j) + lane) * pitchKV + wid * 8, (unsigned)__builtin_amdgcn_readfirstlane(lds0 + G::LDS_K + _s + wid * 1024)); \
            glds16(V + (size_t)(64 * (j) + 16 * (wid & 3) + (lane >> 2)) * pitchKV + (wid >> 2) * 32 + (lane & 3) * 8, (unsigned)__builtin_amdgcn_readfirstlane(lds0 + G::LDS_V + _s + wid * 1024)); \
        } else { \
            _Pragma("unroll") for (int _p = 0; _p < 2; ++_p) { const int _c = wid + 8 * _p; \
                glds16(K + (size_t)(64 * (j) + lane) * pitchKV + _c * 8, (unsigned)__builtin_amdgcn_readfirstlane(lds0 + G::LDS_K + _s + _c * 1024)); } \
            _Pragma("unroll") for (int _p = 0; _p < 2; ++_p) { const int _c = wid + 8 * _p; \
                glds16(V + (size_t)(64 * (j) + 16 * (_c & 3) + (lane >> 2)) * pitchKV + (_c >> 2) * 32 + (lane & 3) * 8, (unsigned)__builtin_amdgcn_readfirstlane(lds0 + G::LDS_V + _s + _c * 1024)); } \
        } } while (0)
    int slot_i = 0;
    constexpr bool REV = (MODE == 0);
    const int nst = j_hi - j_lo;
#define ATT_TILE(st_) (REV ? (j_hi - 1 - (st_)) : (j_lo + (st_)))
#pragma unroll
    for (int p = 0; p < G::NSLOT - 1; ++p) if (p < nst) ATT_DMA(ATT_TILE(p), p);
    float mhat = -1e30f, l_reg = 0.f; f32x16 o[D / 32];
#pragma unroll
    for (int d0 = 0; d0 < D / 32; ++d0) o[d0] = f32x16{};
    const lds_cptr shm3 = (lds_cptr)shm;
    const int vb0 = (int)(lds0 + G::LDS_V) + ((lane >> 4) & 1) * 32 + (lane & 3) * 8 + (4 * hi + ((lane & 15) >> 2)) * 64;
    const int qabs = q0w + r32;
    LAS float* wmin = (LAS float*)(shm + G::LDS_WMIN);
    for (int st = 0; st < nst; ++st) {
        const int j = ATT_TILE(st);
        if (G::NSLOT == 3 && st + 1 < nst) { if constexpr (G::PPT == 2) asm volatile("s_waitcnt vmcnt(2) lgkmcnt(0)\n\ts_barrier" ::: "memory"); else asm volatile("s_waitcnt vmcnt(4) lgkmcnt(0)\n\ts_barrier" ::: "memory"); }
        else asm volatile("s_waitcnt vmcnt(0) lgkmcnt(0)\n\ts_barrier" ::: "memory");
        if constexpr (MODE == 0) { if (st >= 5) {
            const LAS float* wm = wmin + ((st - 1) & 1) * 8; const f32x4 a = *(const LAS f32x4*)wm, b = *(const LAS f32x4*)(wm + 4);
            const float gmin = fminf(fminf(fminf(a.x, a.y), fminf(a.z, a.w)), fminf(fminf(b.x, b.y), fminf(b.z, b.w)));
            if (cb[64 * j + 63] + bqk < gmin - 40.0f) break; } }
        { const int sn_ = st + G::NSLOT - 1; if (sn_ < nst) { int sn = slot_i + G::NSLOT - 1; if (sn >= G::NSLOT) sn -= G::NSLOT; ATT_DMA(ATT_TILE(sn_), sn); } }
        bool need = true;
        if constexpr (MODE == 0) need = (64 * j <= q0w + 31);
        if constexpr (MODE == 1) need = (64 * j <= q0w + 31) && (64 * j + 63 >= q0w - 127);
        if (need) {
            f32x16 p0, p1;
            qkt<D>(p0, p1, shm3 + G::LDS_K + slot_i * G::SLOTB, qr, r32, hi);
            if constexpr (MODE == 2) {
                const LAS float* rkp = cb + 64 * j + 4 * hi;
#pragma unroll
                for (int g = 0; g < 4; ++g) { const f32x4 b0 = *(const LAS f32x4*)(rkp + 8 * g), b1 = *(const LAS f32x4*)(rkp + 32 + 8 * g);
#pragma unroll
                    for (int e = 0; e < 4; ++e) { p0[4 * g + e] *= b0[e]; p1[4 * g + e] *= b1[e]; } }
            }
            if constexpr (MODE == 0) {
                const LAS float* cbp = cb + 64 * j + 4 * hi;
#pragma unroll
                for (int g = 0; g < 4; ++g) { const f32x4 b0 = *(const LAS f32x4*)(cbp + 8 * g), b1 = *(const LAS f32x4*)(cbp + 32 + 8 * g);
#pragma unroll
                    for (int e = 0; e < 4; ++e) { p0[4 * g + e] += b0[e]; p1[4 * g + e] += b1[e]; } }
                if (64 * j + 63 > q0w) {
#pragma unroll
                    for (int r = 0; r < 16; ++r) { const int kv = 64 * j + crow(r, hi); if (kv > qabs) p0[r] = -INFINITY; if (kv + 32 > qabs) p1[r] = -INFINITY; } }
            }
            if constexpr (MODE == 1) {
#pragma unroll
                for (int r = 0; r < 16; ++r) { const int kv = 64 * j + crow(r, hi); const int d0_ = qabs - kv, d1_ = d0_ - 32;
                    if (d0_ < 0 || d0_ >= 128) p0[r] = -INFINITY; if (d1_ < 0 || d1_ >= 128) p1[r] = -INFINITY; }
            }
            float rm = fmaxf(p0[0], p1[0]);
#pragma unroll
            for (int r = 1; r < 16; ++r) rm = fmaxf(rm, fmaxf(p0[r], p1[r]));
            { auto rr = __builtin_amdgcn_permlane32_swap(__float_as_uint(rm), __float_as_uint(rm), false, false); rm = fmaxf(__uint_as_float(rr[0]), __uint_as_float(rr[1])); }
            if (__any(rm > mhat)) {
                const float mn = fmaxf(mhat, rm); const float f = __builtin_amdgcn_exp2f(mhat - mn); mhat = mn; l_reg *= f;
                if (hi == 0) wsf[r32] = f;
                asm volatile("s_waitcnt lgkmcnt(0)" ::: "memory");
#pragma unroll
                for (int g = 0; g < 4; ++g) { const f32x4 fv = *(const LAS f32x4*)(wsf + 8 * g + 4 * hi);
#pragma unroll
                    for (int d_ = 0; d_ < D / 32; ++d_)
#pragma unroll
                        for (int e = 0; e < 4; ++e) o[d_][4 * g + e] *= fv[e]; }
            }
            float sacc = 0.f;
#pragma unroll
            for (int r = 0; r < 16; ++r) { p0[r] = __builtin_amdgcn_exp2f(p0[r] - mhat); p1[r] = __builtin_amdgcn_exp2f(p1[r] - mhat); sacc += p0[r] + p1[r]; }
            l_reg += sacc;
            u32x4 pw0, pw1, pw2, pw3;
            pw0 = (u32x4){cvtpk_s(p0[0], p0[1]), cvtpk_s(p0[2], p0[3]), cvtpk_s(p0[4], p0[5]), cvtpk_s(p0[6], p0[7])};
            pw1 = (u32x4){cvtpk_s(p0[8], p0[9]), cvtpk_s(p0[10], p0[11]), cvtpk_s(p0[12], p0[13]), cvtpk_s(p0[14], p0[15])};
            pw2 = (u32x4){cvtpk_s(p1[0], p1[1]), cvtpk_s(p1[2], p1[3]), cvtpk_s(p1[4], p1[5]), cvtpk_s(p1[6], p1[7])};
            pw3 = (u32x4){cvtpk_s(p1[8], p1[9]), cvtpk_s(p1[10], p1[11]), cvtpk_s(p1[12], p1[13]), cvtpk_s(p1[14], p1[15])};
            pv<D>(o, vb0 + slot_i * G::SLOTB, __builtin_bit_cast(bf16x8, pw0), __builtin_bit_cast(bf16x8, pw1), __builtin_bit_cast(bf16x8, pw2), __builtin_bit_cast(bf16x8, pw3));
        }
        if constexpr (MODE == 0) { float mn = mhat;
#pragma unroll
            for (int of = 1; of < 32; of <<= 1) mn = fminf(mn, __shfl_xor(mn, of));
            if (lane == 0) wmin[(st & 1) * 8 + wid] = mn; }
        ++slot_i; if (slot_i == G::NSLOT) slot_i = 0;
    }
#undef ATT_DMA
#undef ATT_TILE
    if constexpr (MODE == 0) asm volatile("s_waitcnt vmcnt(0)" ::: "memory");
    { auto rr = __builtin_amdgcn_permlane32_swap(__float_as_uint(l_reg), __float_as_uint(l_reg), false, false); l_reg = __uint_as_float(rr[0]) + __uint_as_float(rr[1]); }
    if constexpr (MODE == 1) l_reg += __builtin_amdgcn_exp2f(sink2 - mhat);
    if (hi == 0) wsf[32 + r32] = l_reg;
    asm volatile("s_waitcnt lgkmcnt(0)" ::: "memory");
    float rli[16];
#pragma unroll
    for (int g = 0; g < 4; ++g) { const f32x4 lv = *(const LAS f32x4*)(wsf + 32 + 8 * g + 4 * hi);
#pragma unroll
        for (int e = 0; e < 4; ++e) rli[4 * g + e] = __builtin_amdgcn_rcpf(lv[e]); }
    bf16* Ow = O + (size_t)q0w * 2048;
    LAS bf16* stg = (LAS bf16*)(shm + G::LDS_OST) + wid * 2048;
#pragma unroll
    for (int ps = 0; ps < D / 64; ++ps) {
#pragma unroll
        for (int r = 0; r < 16; ++r) { const int orow = crow(r, hi);
#pragma unroll
            for (int dl = 0; dl < 2; ++dl) stg[orow * 64 + dl * 32 + r32] = (bf16)f2bf(o[2 * ps + dl][r] * rli[r]); }
        asm volatile("s_waitcnt lgkmcnt(0)" ::: "memory");
#pragma unroll
        for (int i = 0; i < 4; ++i) { const int row = i * 8 + (lane >> 3), ch = lane & 7; const v4u v = *(const LAS v4u*)(stg + row * 64 + ch * 8); *(GAS v4u*)(Ow + (size_t)row * 2048 + ps * 64 + ch * 8) = v; }
        asm volatile("s_waitcnt lgkmcnt(0)" ::: "memory");
    }
    asm volatile("s_waitcnt lgkmcnt(0)\n\ts_barrier" ::: "memory");
}
}

constexpr int NU_FOX = BATCH * 12 * 32, NU_SWA = BATCH * 12 * 32, NU_XM = BATCH * 4 * 32;
__device__ __forceinline__ int att_fetch(const Ctx& C, int q) {
    int v = 0; if (C.tid == 0) v = (int)__hip_atomic_fetch_add((unsigned*)(C.ctl + CW_QHEAD + 64 * q), 1u, RLX_AGENT); return v;
}
__device__ __forceinline__ void phase3(const Ctx& C, int sel = 0) {
    LAS unsigned char* shm = C.lds + RING_OFF;
    volatile LAS int* nxtw = (volatile LAS int*)(C.MISC + 12);
    const bool conv_first = CONV_IN_P3 && sel == 0 && (((blockIdx.x >> 3) & 3) < CONV_FIRST_QUARTERS);
    auto run_conv = [&]() {
        if (!(CONV_IN_P3 && (sel == 0 || sel == 8 || (sel == 9 && ((blockIdx.x >> 3) & 1))))) return;
        int pre = att_fetch(C, 3);
        if (C.tid == 0) *nxtw = pre;
        p0_fill_lnorm(C, (LAS float*)(C.lds + RING_OFF + 65536));
        __syncthreads();
        int cur = __builtin_amdgcn_readfirstlane(*nxtw);
        __syncthreads();
        while (cur < CONV_NCHUNK) {
            pre = att_fetch(C, 3);
            conv_chunk(C, cur);
            if (C.tid == 0) *nxtw = pre;
            __syncthreads();
            cur = __builtin_amdgcn_readfirstlane(*nxtw);
            __syncthreads();
        }
    };
    if (conv_first) run_conv();
    if (sel == 0 || sel == 4) {
        float gq = fabsf(C.fox_q_norm[C.lane]), gk = fabsf(C.fox_k_norm[C.lane]);
#pragma unroll
        for (int of = 1; of < 64; of <<= 1) { gq = fmaxf(gq, __shfl_xor(gq, of)); gk = fmaxf(gk, __shfl_xor(gk, of)); }
        const float bqk = 64.0f * gq * gk * (0.125f * LOG2E) * 1.02f;
        int pre = att_fetch(C, 0);
        if (C.tid == 0) *nxtw = pre;
        __syncthreads();
        int cur = __builtin_amdgcn_readfirstlane(*nxtw);
        __syncthreads();
        while (cur < NU_FOX) {
            pre = att_fetch(C, 0);
            const int qb = 31 - cur / 24, bh = cur % 24, b = bh / 12, h = bh % 12;
            const bf16* base = C.QKV + (size_t)b * SEQ * QKVW + h * 64;
            att::attn_unit<64, 0>(shm, base + C_FQ, QKVW, base + C_FK, base + C_FV, QKVW, C.OALL + (size_t)b * SEQ * 2048 + h * 64, C.CNEG + (size_t)(b * 12 + h) * SEQ, 0.f, qb, C.fox_q_norm, nullptr, nullptr, bqk);
            if (C.tid == 0) *nxtw = pre;
            __syncthreads();
            cur = __builtin_amdgcn_readfirstlane(*nxtw);
            __syncthreads();
        }
    }
    if (sel == 0 || sel == 5) {
        int pre = att_fetch(C, 1);
        if (C.tid == 0) *nxtw = pre;
        __syncthreads();
        int cur = __builtin_amdgcn_readfirstlane(*nxtw);
        __syncthreads();
        while (cur < NU_SWA) {
            pre = att_fetch(C, 1);
            const int qb = cur / 24, bh = cur % 24, b = bh / 12, h = bh % 12, kvh = h / 3;
            const bf16* base = C.QKV + (size_t)b * SEQ * QKVW;
            att::attn_unit<64, 1>(shm, base + C_SQ + h * 64, QKVW, base + C_SK + kvh * 64, base + C_SV + kvh * 64, QKVW, C.OALL + (size_t)b * SEQ * 2048 + 768 + h * 64, nullptr, C.swa_sinks[h] * LOG2E, qb, C.swa_q_norm, nullptr, C.ROPE + (size_t)b * SEQ * 64);
            if (C.tid == 0) *nxtw = pre;
            __syncthreads();
            cur = __builtin_amdgcn_readfirstlane(*nxtw);
            __syncthreads();
        }
    }
    if (sel == 0 || sel == 6) {
        int pre = att_fetch(C, 2);
        if (C.tid == 0) *nxtw = pre;
        __syncthreads();
        int cur = __builtin_amdgcn_readfirstlane(*nxtw);
        __syncthreads();
        while (cur < NU_XM) {
            pre = att_fetch(C, 2);
            const int qb = cur / 8, bh = cur % 8, b = bh / 4, h = bh % 4;
            const bf16* kb = C.MKV + (size_t)b * NMEM * 1024 + h * 128;
            att::attn_unit<128, 2>(shm, C.QKV + (size_t)b * SEQ * QKVW + C_MQ + h * 128, QKVW, kb, kb + 512, 1024, C.OALL + (size_t)b * SEQ * 2048 + 1536 + h * 128, nullptr, 0.f, qb, C.xmem_q_norm, C.xmem_k_norm, nullptr);
            if (C.tid == 0) *nxtw = pre;
            __syncthreads();
            cur = __builtin_amdgcn_readfirstlane(*nxtw);
            __syncthreads();
        }
    }
    if (!conv_first) run_conv();
}

__device__ __forceinline__ void phase6(const Ctx& C) {
    LAS float* PL = (LAS float*)(C.lds + RING_OFF);
    LAS float* SS = PL + 4 * 64 * 33;
    LAS int* hist = (LAS int*)(SS + 512);
    LAS int* gb = hist + 32;
    const int rg = C.wave & 1, kq = C.wave >> 1, r32 = C.lane & 31, hi = C.lane >> 5;
    const bf16* wh = C.Wr_t + (size_t)r32 * 2048 + 512 * kq + 16 * hi; const bf16* wl = wh + 32 * 2048;
    for (int blk = C.vcu; blk < T / 64; blk += C.G) {
        if (C.tid < 32) hist[C.tid] = 0;
        const int tok = blk * 64 + 32 * rg + r32;
        const float* hr = C.out + (size_t)tok * DM + 512 * kq + 16 * hi;
        f32x16 acc = f32x16{}; float ss = 0.f;
#pragma unroll 2
        for (int kb = 0; kb < 16; ++kb) {
            float f[16];
#pragma unroll
            for (int q = 0; q < 4; ++q) { const f32x4 t = *(const GAS f32x4*)(hr + 32 * kb + 4 * q); f[4 * q] = t.x; f[4 * q + 1] = t.y; f[4 * q + 2] = t.z; f[4 * q + 3] = t.w; }
            unsigned hb[16], lb[16];
#pragma unroll
            for (int q = 0; q < 16; ++q) { ss += f[q] * f[q]; hb[q] = f2bf(f[q]); lb[q] = f2bf(f[q] - __uint_as_float(hb[q] << 16)); }
#pragma unroll
            for (int s = 0; s < 2; ++s) {
                const bf16x8 ah = *(const GAS bf16x8*)(wh + 32 * kb + 8 * s), al = *(const GAS bf16x8*)(wl + 32 * kb + 8 * s);
                v4u bh, bl;
                bh.x = hb[8 * s] | (hb[8 * s + 1] << 16); bh.y = hb[8 * s + 2] | (hb[8 * s + 3] << 16); bh.z = hb[8 * s + 4] | (hb[8 * s + 5] << 16); bh.w = hb[8 * s + 6] | (hb[8 * s + 7] << 16);
                bl.x = lb[8 * s] | (lb[8 * s + 1] << 16); bl.y = lb[8 * s + 2] | (lb[8 * s + 3] << 16); bl.z = lb[8 * s + 4] | (lb[8 * s + 5] << 16); bl.w = lb[8 * s + 6] | (lb[8 * s + 7] << 16);
                acc = __builtin_amdgcn_mfma_f32_32x32x16_bf16(ah, __builtin_bit_cast(bf16x8, bh), acc, 0, 0, 0);
                acc = __builtin_amdgcn_mfma_f32_32x32x16_bf16(ah, __builtin_bit_cast(bf16x8, bl), acc, 0, 0, 0);
                acc = __builtin_amdgcn_mfma_f32_32x32x16_bf16(al, __builtin_bit_cast(bf16x8, bh), acc, 0, 0, 0);
            }
        }
        { LAS float* pr = PL + (size_t)(kq * 64 + 32 * rg + r32) * 33;
#pragma unroll
          for (int r = 0; r < 16; ++r) pr[att::crow(r, hi)] = acc[r];
          SS[(kq * 2 + hi) * 64 + 32 * rg + r32] = ss; }
        __syncthreads();
        int sel[4]; float gt[4]; float rstd = 0.f; int lr[4];
        if (C.tid < 64) {
            float lv[32]; float s2 = 0.f;
#pragma unroll
            for (int q = 0; q < 8; ++q) s2 += SS[q * 64 + C.tid];
            rstd = 1.0f / sqrtf(s2 * (1.f / DM) + NORM_EPS);
#pragma unroll
            for (int e = 0; e < 32; ++e) { const float a = (PL[(0 * 64 + C.tid) * 33 + e] + PL[(1 * 64 + C.tid) * 33 + e]) + (PL[(2 * 64 + C.tid) * 33 + e] + PL[(3 * 64 + C.tid) * 33 + e]); lv[e] = a * rstd + C.b_router[e]; }
            float val[4];
#pragma unroll
            for (int k = 0; k < 4; ++k) { float best = lv[0]; int bi = 0;
#pragma unroll
                for (int e = 1; e < 32; ++e) if (lv[e] > best) { best = lv[e]; bi = e; }
                sel[k] = bi; val[k] = best;
#pragma unroll
                for (int e = 0; e < 32; ++e) lv[e] = (e == bi) ? -INFINITY : lv[e]; }
            float den = 0.f;
#pragma unroll
            for (int k = 0; k < 4; ++k) { gt[k] = __expf(val[k] - val[0]); den += gt[k]; }
            const float inv = 1.0f / den;
#pragma unroll
            for (int k = 0; k < 4; ++k) { gt[k] *= inv; lr[k] = __hip_atomic_fetch_add((LAS int*)(hist + sel[k]), 1, __ATOMIC_RELAXED, __HIP_MEMORY_SCOPE_WORKGROUP); }
        }
        __syncthreads();
        if (C.tid < 32) gb[C.tid] = (int)__hip_atomic_fetch_add((unsigned*)(C.ctl + CW_CNT + C.tid), (unsigned)hist[C.tid], RLX_AGENT);
        __syncthreads();
        if (C.tid < 64) {
            const int t = blk * 64 + C.tid;
#pragma unroll
            for (int k = 0; k < 4; ++k) { const int sl = sel[k] * CAP + gb[sel[k]] + lr[k]; C.TOK[sl] = t; C.RS[sl] = rstd; C.TSLOT[t * 4 + k] = sl; C.TGATE[t * 4 + k] = gt[k]; }
        }
        __syncthreads();
    }
}
template <int NT>
__device__ __forceinline__ void moe_table(const Ctx& C, LAS int* tab) {
    __syncthreads();
    if (C.tid == 0) { int us = 0, rb = 0;
        for (int e = 0; e < 32; ++e) { const int n = (int)__hip_atomic_load((unsigned*)(C.ctl + CW_CNT + e), RLX_AGENT); const int mt = (n + 255) >> 8; tab[e] = us; tab[33 + e] = mt; tab[65 + e] = rb; tab[97 + e] = n; us += mt * NT; rb += mt * 256; }
        tab[32] = us; }
    __syncthreads();
}


__device__ __forceinline__ void phase9(const Ctx& C, const LAS int* tab) {
    const int gw = C.vcu * NWAVES + C.wave, NGW = C.G * NWAVES;
    for (int t = gw; t < T; t += NGW) {
        typedef int v4i_ __attribute__((ext_vector_type(4))); const v4i_ sl = *(const GAS v4i_*)(C.TSLOT + 4 * t); const f32x4 g = *(const GAS f32x4*)(C.TGATE + 4 * t);
        const int s[4] = {sl.x, sl.y, sl.z, sl.w}; const float gg[4] = {g.x, g.y, g.z, g.w};
        const bf16* yr[4];
#pragma unroll
        for (int k = 0; k < 4; ++k) { const int e = s[k] >> 14, rk = s[k] & (CAP - 1); yr[k] = C.Y + (size_t)(tab[65 + e] + rk) * DM + 8 * C.lane; }
        float* orow = C.out + (size_t)t * DM + 8 * C.lane;
#pragma unroll
        for (int j = 0; j < 4; ++j) {
            f32x4 a0 = *(const GAS f32x4*)(orow + 512 * j), a1 = *(const GAS f32x4*)(orow + 512 * j + 4);
#pragma unroll
            for (int k = 0; k < 4; ++k) { const v4u y = *(const GAS v4u*)(yr[k] + 512 * j);
                a0.x += gg[k] * pg8::bf_lo(y.x); a0.y += gg[k] * pg8::bf_hi(y.x); a0.z += gg[k] * pg8::bf_lo(y.y); a0.w += gg[k] * pg8::bf_hi(y.y);
                a1.x += gg[k] * pg8::bf_lo(y.z); a1.y += gg[k] * pg8::bf_hi(y.z); a1.z += gg[k] * pg8::bf_lo(y.w); a1.w += gg[k] * pg8::bf_hi(y.w); }
            *(GAS f32x4*)(orow + 512 * j) = a0; *(GAS f32x4*)(orow + 512 * j + 4) = a1;
        }
    }
}

struct Args { const void* in[26]; float* out; unsigned char* ws; int ph_lo, ph_hi, probe, pad; };
__global__ void __launch_bounds__(NWAVES * 64, 2) mk_fwd(Args args) {
    extern __shared__ __attribute__((aligned(16))) unsigned char lds_raw[];
    Ctx C;
    C.lds = (LAS unsigned char*)lds_raw;
    C.MISC = (volatile LAS unsigned*)(C.lds + MISC_OFF);
    C.tid = threadIdx.x; C.lane = C.tid & 63; C.wave = __builtin_amdgcn_readfirstlane(C.tid >> 6);
    C.probe = args.probe; C.G = gridDim.x; { const int bx = blockIdx.x; C.vcu = (C.G % 8 == 0) ? (bx % 8) * (C.G / 8) + bx / 8 : bx; }
    unsigned char* ws = args.ws;
    C.ctl = (gu32*)(ws + WS_CTL);
    C.x = (const float*)args.in[0]; C.mem = (const float*)args.in[1]; C.pos = (const int*)args.in[2]; C.norm_mix = (const float*)args.in[3]; C.w_in = (const float*)args.in[4];
    C.b_forget = (const float*)args.in[5]; C.fox_q_norm = (const float*)args.in[6]; C.fox_k_norm = (const float*)args.in[7]; C.swa_q_norm = (const float*)args.in[8]; C.swa_k_norm = (const float*)args.in[9];
    C.swa_sinks = (const float*)args.in[10]; C.xmem_q_norm = (const float*)args.in[11]; C.xmem_k_norm = (const float*)args.in[12]; C.norm_mem = (const float*)args.in[13]; C.w_mem_kv = (const float*)args.in[14];
    C.w_up_fox = (const float*)args.in[15]; C.w_up_swa = (const float*)args.in[16]; C.w_up_xmem = (const float*)args.in[17]; C.w_out = (const float*)args.in[18]; C.norm_ffn = (const float*)args.in[19];
    C.w_router = (const float*)args.in[20]; C.b_router = (const float*)args.in[21]; C.w_gate_up = (const float*)args.in[22]; C.b_gate_up = (const float*)args.in[23]; C.w_down = (const float*)args.in[24]; C.b_down = (const float*)args.in[25];
    C.out = args.out;
#define WS_PTRS() do { unsigned char* w_ = args.ws; asm volatile("" : "+s"(w_)); \
    C.ctl = (gu32*)(w_ + WS_CTL); C.Win_t = (bf16*)(w_ + WS_WIN); C.Wmkv_t = (bf16*)(w_ + WS_WMKV); C.Wup_t = (bf16*)(w_ + WS_WUP); C.Wout_t = (bf16*)(w_ + WS_WOUT); C.Wr_t = (bf16*)(w_ + WS_WRT); C.Wgu_t = (bf16*)(w_ + WS_WGU); C.Wd_t = (bf16*)(w_ + WS_WD); \
    C.XN = (bf16*)(w_ + WS_XN); C.MN = (bf16*)(w_ + WS_MN); C.QKV = (bf16*)(w_ + WS_QKV); C.G_ = (bf16*)(w_ + WS_G); C.MKV = (bf16*)(w_ + WS_MKV); C.OALL = (bf16*)(w_ + WS_OALL); C.MERGED = (bf16*)(w_ + WS_MERGED); \
    C.HB = (bf16*)(w_ + WS_HB); C.ACT = (bf16*)(w_ + WS_ACT); C.LOGF = (float*)(w_ + WS_LOGF); C.CNEG = (float*)(w_ + WS_CNEG); C.ROPE = (float*)(w_ + WS_ROPE); C.GATEW = (float*)(w_ + WS_GATE); C.RS = (float*)(w_ + WS_RS); \
    C.TOK = (int*)(w_ + WS_TOK); C.TSLOT = (int*)(w_ + WS_TSLOT); C.TGATE = (float*)(w_ + WS_TGATE); C.Y = (bf16*)(w_ + WS_Y); C.XN8 = w_ + WS_XN8; C.Win8 = w_ + WS_WIN8; } while (0)
    WS_PTRS();
    for (int u = C.tid; u < (LDS_BYTES - LDSCTL_OFF) / 4; u += NWAVES * 64) ((LAS unsigned*)(C.lds + LDSCTL_OFF))[u] = 0u;
    __syncthreads();
    XcdBarrier bar; bar.bar = (unsigned*)(C.ctl + CW_BAR); bar.x = 0; bar.st = nullptr;
    if (N_LAUNCHES == 1) bar = xcd_barrier_post((unsigned*)(C.ctl + CW_BAR), C.MISC + 8);
    const int lo = args.ph_lo, hi = args.ph_hi;
#ifndef MK_PHASE_MASK
#define MK_PHASE_MASK 0x3FF
#endif
#define IN(k) ((((MK_PHASE_MASK) >> (k)) & 1) && lo <= (k) && (k) < hi)
#define SEAM(k) do { if (IN(k) && IN((k) + 1)) xcd_barrier(bar); } while (0)
    LAS int* tab = (LAS int*)(C.lds + MOE_OFF);

    if (IN(0)) { WS_PTRS(); phase0(C); }
    SEAM(0);
    if (IN(1)) { WS_PTRS();
        logf_cumsum(C);
        P1Order S; S.d.init(C.XN, C.Win_t, T, PROBE_INW * 64, C.G, (int)blockIdx.x); S.A1 = (const char*)C.MN; S.B1 = (const char*)C.Wmkv_t;
        EpiInProj E{C.QKV, C.G_, C.MKV, args.probe == 1, C.fox_k_norm, C.swa_k_norm, C.ROPE};
        if (args.probe != 3) pg8::gemm_phase<EpiInProj, P1Order>(C.lds + RING_OFF, S, E);
        P1bOrder S8; S8.d.init(C.XN8, C.Win8, T, 6144, C.G, (int)blockIdx.x);
#ifdef PROBE_DET
#pragma unroll 1
        for (int rep = 0; rep < 2; ++rep) { EpiGates E8{rep ? C.Y : C.ACT}; pg8::gemm_phase<EpiGates, P1bOrder>(C.lds + RING_OFF, S8, E8); }
#else
#ifdef PROBE_GDUMMY
        EpiGates E8{C.ACT};
#else
        EpiGates E8{C.G_};
#endif
        if (args.probe != 2) pg8::gemm_phase<EpiGates, P1bOrder>(C.lds + RING_OFF, S8, E8);
#endif
    }
    SEAM(1);
    if (IN(3)) { WS_PTRS(); phase3(C, args.probe >= 4 ? args.probe : 0); }
    SEAM(3);
    if (IN(4)) { WS_PTRS();
        DenseOrder S; S.init(C.OALL, C.Wup_t, T, DM, C.G, (int)blockIdx.x);
        EpiMerge E{C.G_, C.MERGED};
        pg8::gemm_phase<EpiMerge, DenseOrder>(C.lds + RING_OFF, S, E);
    }
    SEAM(4);
    if (IN(5)) { WS_PTRS();
        DenseOrder S; S.init(C.MERGED, C.Wout_t, T, DM, C.G, (int)blockIdx.x);
        EpiOut E{C.x, C.out, (unsigned char*)C.HB, args.probe == 1};
        pg8::gemm_phase<EpiOut, DenseOrder, false>(C.lds + RING_OFF, S, E);
    }
    SEAM(5);
    if (IN(6)) { WS_PTRS(); phase6(C); }
    SEAM(6);
    if (IN(7)) { WS_PTRS();
        moe_table<16>(C, tab);
        MoeOrder<true, 16, 2048> S{(const char*)C.HB, (const char*)C.Wgu_t, C.TOK, (const int*)(C.ctl + CW_CNT), tab, C.G, C.vcu};
        EpiGateUp E{C.RS, C.b_gate_up, (unsigned char*)C.ACT};
        pg8::gemm_phase<EpiGateUp, MoeOrder<true, 16, 2048>>(C.lds + RING_OFF, S, E);
    }
    SEAM(7);
    if (IN(8)) { WS_PTRS();
        moe_table<8>(C, tab);
        MoeOrder<false, 8, 2048> S{(const char*)C.ACT, (const char*)C.Wd_t, C.TOK, (const int*)(C.ctl + CW_CNT), tab, C.G, C.vcu};
        EpiDown E{C.b_down, C.Y, args.probe == 1};
        pg8::gemm_phase<EpiDown, MoeOrder<false, 8, 2048>>(C.lds + RING_OFF, S, E);
    }
    SEAM(8);
    if (IN(9)) { WS_PTRS(); moe_table<8>(C, tab); phase9(C, tab);
#ifdef PROBE_DET
        if (blockIdx.x == 0 && C.tid == 0 && __hip_atomic_load((unsigned*)(C.ctl + 2048), RLX_AGENT) != 0u) C.out[12345] = __builtin_nanf("");
#endif
    }
#undef IN
#undef SEAM
}

extern "C" void kernel_launch(void* const* d_in, const int* in_sizes, int n_in, void* d_out, int out_size, void* d_ws, size_t ws_size, hipStream_t stream) {
    static int grid = 0;
    if (grid == 0) {
        if (n_in != 26 || out_size != T * DM || ws_size < WS_END) { fprintf(stderr, "kernel_launch: unexpected problem (n_in %d, out %d, ws %zu < %zu); nothing launched\n", n_in, out_size, ws_size, (size_t)WS_END); grid = -1; return; }
        int dev = 0, cus = 0, per_cu = 0;
        if (hipGetDevice(&dev) != hipSuccess || hipDeviceGetAttribute(&cus, hipDeviceAttributeMultiprocessorCount, dev) != hipSuccess) { grid = -1; return; }
        if (hipFuncSetAttribute((const void*)mk_fwd, hipFuncAttributeMaxDynamicSharedMemorySize, LDS_BYTES) != hipSuccess) { fprintf(stderr, "kernel_launch: hipFuncSetAttribute failed\n"); grid = -1; return; }
        if (hipOccupancyMaxActiveBlocksPerMultiprocessor(&per_cu, (const void*)mk_fwd, NWAVES * 64, LDS_BYTES) != hipSuccess || per_cu < 1) { fprintf(stderr, "kernel_launch: occupancy query says %d\n", per_cu); }
        (void)hipGetLastError();
        grid = cus;
    }
    if (grid < 0) return;
    if (hipMemsetAsync((char*)d_ws + WS_CTL, 0, CTL_ZERO_BYTES, stream) != hipSuccess) return;
#ifdef PROBE_MEMSET8
    hipMemsetAsync((char*)d_ws + WS_XN8, 0, 44 * MiB, stream);
#endif
    Args a{};
    for (int i = 0; i < 26; ++i) a.in[i] = d_in[i];
    a.out = (float*)d_out; a.ws = (unsigned char*)d_ws;
    if (N_LAUNCHES == 1) { a.ph_lo = 0; a.ph_hi = PER_PHASE; hipLaunchKernelGGL(mk_fwd, dim3(grid), dim3(NWAVES * 64), LDS_BYTES, stream, a); }
    else for (int oi = 0; oi < PER_PHASE; ++oi) { static const int order[PER_PHASE] = {0, 1, 2, 3, 4, 5, 6, 7, 8, 9}; const int li = order[oi]; a.ph_lo = li; a.ph_hi = li + 1;
#ifdef PROBE_SPLIT_P1
        if (li == 1) { a.probe = 2; hipLaunchKernelGGL(mk_fwd, dim3(grid), dim3(NWAVES * 64), LDS_BYTES, stream, a); a.probe = 3; hipLaunchKernelGGL(mk_fwd, dim3(grid), dim3(NWAVES * 64), LDS_BYTES, stream, a); a.probe = 0; continue; }
#endif
        hipLaunchKernelGGL(mk_fwd, dim3(grid), dim3(NWAVES * 64), LDS_BYTES, stream, a);
#ifdef PROBE_DUP
        if (li == PROBE_DUP) { if (PROBE_DUP == 3 || PROBE_DUP == 6) hipMemsetAsync((char*)d_ws + WS_CTL, 0, CTL_ZERO_BYTES / 2, stream);
#ifdef PROBE_FLAG
            a.probe = PROBE_FLAG;
#endif
            hipLaunchKernelGGL(mk_fwd, dim3(grid), dim3(NWAVES * 64), LDS_BYTES, stream, a); a.probe = 0; }
#endif
    }
    const hipError_t le = hipPeekAtLastError();
    if (le != hipSuccess) fprintf(stderr, "kernel_launch: launch failed: %s\n", hipGetErrorName(le));
}
```

```cpp
#include <hip/hip_runtime.h>
#include <cstdio>
#include <cstdint>

#define LAS __attribute__((address_space(3)))
#define GAS __attribute__((address_space(1)))

namespace pg8 {
typedef unsigned short bf16_t;
typedef short bf16x8 __attribute__((ext_vector_type(8)));
typedef float f32x4 __attribute__((ext_vector_type(4)));
typedef float f32x2 __attribute__((ext_vector_type(2)));
typedef unsigned u32x4 __attribute__((ext_vector_type(4)));
typedef unsigned u32x2 __attribute__((ext_vector_type(2)));
constexpr int BM = 256, BK = 64, HALF = 128, HTB = HALF * BK * 2, STAGE_BYTES = 8 * HTB, NXCD = 8, WGM = 8;
constexpr int KD = 2048;
typedef int v8i __attribute__((ext_vector_type(8))); typedef int v4i __attribute__((ext_vector_type(4)));
__device__ __forceinline__ v8i cat8(bf16x8 lo, bf16x8 hi) { const v4i a = __builtin_bit_cast(v4i, lo), b = __builtin_bit_cast(v4i, hi); return __builtin_shufflevector(a, b, 0, 1, 2, 3, 4, 5, 6, 7); }
__device__ __forceinline__ bf16x8 lo8(v8i v) { return __builtin_bit_cast(bf16x8, (v4i)__builtin_shufflevector(v, v, 0, 1, 2, 3)); }
__device__ __forceinline__ bf16x8 hi8(v8i v) { return __builtin_bit_cast(bf16x8, (v4i)__builtin_shufflevector(v, v, 4, 5, 6, 7)); }

__host__ __device__ __forceinline__ int lds_byte(int r, int c) { const int st = (r >> 4) * 2 + (c >> 5), rr = r & 15, cc = c & 31, ob = rr * 64 + cc * 2; return st * 1024 + (ob ^ (((ob >> 9) & 1) << 5)); }
__host__ __device__ __forceinline__ void stage_rc(int b, int& R, int& C) { const int st = b / 1024, sb = b % 1024, swz = sb ^ (((sb >> 9) & 1) << 5); R = (st >> 1) * 16 + swz / 64; C = (st & 1) * 32 + (swz % 64) / 2; }
__host__ __device__ __forceinline__ int perm32(int rho) { const int n = rho >> 4, i = rho & 15; return 8 * (i >> 2) + 4 * n + (i & 3); }

__device__ __forceinline__ void glds_s(const char* sbase, unsigned voff, unsigned lds_dst) { unsigned keep;
    asm volatile("s_mov_b32 %0, m0\n\ts_mov_b32 m0, %3\n\ts_nop 0\n\tglobal_load_lds_dwordx4 %1, %2\n\ts_mov_b32 m0, %0" : "=&s"(keep) : "v"(voff), "s"(sbase), "s"(lds_dst) : "memory"); }

#define PG8_PIN4(a, b, c, d, txt) asm volatile(txt : "+v"(a), "+v"(b), "+v"(c), "+v"(d))
#define PG8_PIN_ACC(txt) do { _Pragma("unroll") for (int _a = 0; _a < 2; ++_a) _Pragma("unroll") for (int _b = 0; _b < 2; ++_b) { \
        PG8_PIN4(acc[_a][_b][0][0], acc[_a][_b][0][1], acc[_a][_b][1][0], acc[_a][_b][1][1], ""); PG8_PIN4(acc[_a][_b][2][0], acc[_a][_b][2][1], acc[_a][_b][3][0], acc[_a][_b][3][1], ""); } \
        PG8_PIN4(acc[0][0][0][0], acc[0][1][0][0], acc[1][0][0][0], acc[1][1][0][0], txt); \
        _Pragma("unroll") for (int _a = 0; _a < 2; ++_a) _Pragma("unroll") for (int _b = 0; _b < 2; ++_b) { \
        PG8_PIN4(acc[_a][_b][0][0], acc[_a][_b][0][1], acc[_a][_b][1][0], acc[_a][_b][1][1], ""); PG8_PIN4(acc[_a][_b][2][0], acc[_a][_b][2][1], acc[_a][_b][3][0], acc[_a][_b][3][1], ""); } } while (0)

struct Unit { int pm, pn, e, kind; };

typedef float f32x2_cv __attribute__((ext_vector_type(2))); typedef __bf16 bf16x2_cv __attribute__((ext_vector_type(2)));
__device__ __forceinline__ unsigned cvt_pk_bf16(float lo, float hi) { const f32x2_cv v = {lo, hi}; const bf16x2_cv b = __builtin_convertvector(v, bf16x2_cv); return __builtin_bit_cast(unsigned, b); }
__device__ __forceinline__ float bf_lo(unsigned w) { return __uint_as_float(w << 16); }
__device__ __forceinline__ float bf_hi(unsigned w) { return __uint_as_float(w & 0xffff0000u); }

template <class Epi, class Sched, bool ALIGN_EPI = true, bool SP2 = true>
__device__ __forceinline__ void gemm_phase(LAS unsigned char* lds, const Sched& S, const Epi& E) {
    const int tid = threadIdx.x, wid = __builtin_amdgcn_readfirstlane(tid >> 6), lane = tid & 63, wr = wid >> 2, wc = wid & 3, fr = lane & 15, fq = lane >> 4;
    constexpr bool FP8 = Epi::FP8; constexpr int RB = FP8 ? 2048 : 4096, nt = RB / 128;
    unsigned voffB[2]; int RA[2], CA[2];
#pragma unroll
    for (int i = 0; i < 2; ++i) { int R, C; stage_rc(tid * 16 + i * 8192, R, C); const int Rb = Epi::PERM ? ((R & ~31) + perm32(R & 31)) : R;
        voffB[i] = (unsigned)(Rb * (Epi::BTILED ? 128 : RB) + C * 2); RA[i] = R; CA[i] = C; }
    constexpr size_t kstep = (size_t)(BK * 2);
    constexpr size_t hstep = (size_t)HALF * RB;
    constexpr size_t bkstep = Epi::BTILED ? (size_t)32768 : kstep, bhstep = Epi::BTILED ? (size_t)16384 : hstep;
    const unsigned ldsbase = (unsigned)__builtin_amdgcn_readfirstlane((unsigned)(uintptr_t)lds + (unsigned)wid * 1024u);
    const int aoff = lds_byte(wr * 64 + fr, fq * 8), boff = lds_byte(wc * 32 + fr, fq * 8);
#define PG8_SA(b, h) (((b) * 2 + (h)) * HTB)
#define PG8_SB(b, h) ((4 + (b) * 2 + (h)) * HTB)
#define PG8_STAGE(bufoff, gbase, voff) do { _Pragma("unroll") for (int _i = 0; _i < 2; ++_i) \
        glds_s((const char*)(gbase), (voff)[_i], ldsbase + (unsigned)((bufoff) + _i * 8192)); } while (0)
#define PG8_LDA(dst, b, h) do { _Pragma("unroll") for (int m = 0; m < 4; ++m) dst[m] = cat8(*(const LAS bf16x8*)(lds + PG8_SA(b, h) + aoff + m * 2048), *(const LAS bf16x8*)(lds + PG8_SA(b, h) + aoff + m * 2048 + 1024)); } while (0)
#define PG8_LDB(dst, b, h) do { _Pragma("unroll") for (int n = 0; n < 2; ++n) dst[n] = cat8(*(const LAS bf16x8*)(lds + PG8_SB(b, h) + boff + n * 2048), *(const LAS bf16x8*)(lds + PG8_SB(b, h) + boff + n * 2048 + 1024)); } while (0)
#define PG8_MMA(ai, bj, At, Bt) do { __builtin_amdgcn_s_setprio(1); _Pragma("unroll") for (int m = 0; m < 4; ++m) _Pragma("unroll") for (int n = 0; n < 2; ++n) { \
        if constexpr (FP8 && Epi::ASM_MFMA) asm volatile("v_mfma_scale_f32_16x16x128_f8f6f4 %0, %1, %2, %0, %3, %4 op_sel_hi:[0,0,0]" : "+v"(acc[ai][bj][m][n]) : "v"(Bt[n]), "v"(At[m]), "v"(scl_b), "v"(scl_a)); \
        else if constexpr (FP8) acc[ai][bj][m][n] = __builtin_amdgcn_mfma_scale_f32_16x16x128_f8f6f4(Bt[n], At[m], acc[ai][bj][m][n], 0, 0, 0, Epi::SCALE_B, 0, Epi::SCALE_A); \
        else { acc[ai][bj][m][n] = __builtin_amdgcn_mfma_f32_16x16x32_bf16(lo8(Bt[n]), lo8(At[m]), acc[ai][bj][m][n], 0, 0, 0); \
               acc[ai][bj][m][n] = __builtin_amdgcn_mfma_f32_16x16x32_bf16(hi8(Bt[n]), hi8(At[m]), acc[ai][bj][m][n], 0, 0, 0); } } \
        __builtin_amdgcn_s_setprio(0); } while (0)
#ifdef PROBE_DRAIN8
#define PG8_WAIT_V(n) do { if constexpr (FP8 && !Epi::ASM_MFMA) asm volatile("s_waitcnt vmcnt(0)" ::: "memory"); else asm volatile("s_waitcnt vmcnt(" #n ")" ::: "memory"); } while (0)
#else
#define PG8_WAIT_V(n) asm volatile("s_waitcnt vmcnt(" #n ")" ::: "memory")
#endif
#define PG8_WAIT_L(n) asm volatile("s_waitcnt lgkmcnt(" #n ")" ::: "memory")
#define PG8_BAR __builtin_amdgcn_s_barrier()
#define PG8_SCHED __builtin_amdgcn_sched_barrier(0)
    Unit cur, nxt; int ui = 0;
    int scl_a = Epi::SCALE_A, scl_b = Epi::SCALE_B; asm volatile("" : "+v"(scl_a), "+v"(scl_b));
    if (!S.next(0, cur)) return;
    f32x4 acc[2][2][4][2];
#pragma unroll
    for (int a = 0; a < 2; ++a)
#pragma unroll
        for (int b = 0; b < 2; ++b)
#pragma unroll
            for (int m = 0; m < 4; ++m)
#pragma unroll
                for (int n = 0; n < 2; ++n) acc[a][b][m][n] = (f32x4){0.f, 0.f, 0.f, 0.f};
    if constexpr (Epi::FP8) PG8_PIN_ACC("s_nop 7");
    v8i At[4], B0[2], B1[2];
    const char* cA = S.a_base(cur); const char* cB = S.b_base(cur);
    unsigned vo[2][2], nvo[2][2];
    S.a_offs(cur, RA, CA, vo);
    bool has_next = S.next(1, nxt);
    if (has_next) S.a_offs(nxt, RA, CA, nvo); else { nvo[0][0] = vo[0][0]; nvo[0][1] = vo[0][1]; nvo[1][0] = vo[1][0]; nvo[1][1] = vo[1][1]; }
    if constexpr (SP2) {
        PG8_STAGE(PG8_SB(0, 0), cB, voffB); PG8_STAGE(PG8_SB(0, 1), cB + bhstep, voffB); PG8_STAGE(PG8_SA(0, 0), cA, vo[0]); PG8_STAGE(PG8_SA(0, 1), cA, vo[1]);
        if (wr == 1) PG8_BAR;
        PG8_WAIT_V(2); PG8_BAR;
        PG8_STAGE(PG8_SB(1, 0), cB + bkstep, voffB); PG8_STAGE(PG8_SA(1, 0), cA + kstep, vo[0]); PG8_STAGE(PG8_SB(1, 1), cB + bhstep + bkstep, voffB);
        PG8_WAIT_V(6); PG8_BAR;
    } else {
        PG8_STAGE(PG8_SB(0, 0), cB, voffB); PG8_STAGE(PG8_SA(0, 0), cA, vo[0]); PG8_STAGE(PG8_SB(0, 1), cB + bhstep, voffB); PG8_STAGE(PG8_SA(0, 1), cA, vo[1]);
        if (wr == 1) PG8_BAR;
        PG8_WAIT_V(4); PG8_BAR;
        PG8_STAGE(PG8_SB(1, 0), cB + bkstep, voffB); PG8_STAGE(PG8_SA(1, 0), cA + kstep, vo[0]); PG8_STAGE(PG8_SB(1, 1), cB + bhstep + bkstep, voffB);
        PG8_WAIT_V(6); PG8_BAR;
    }
    for (;;) {
        const char* nA = has_next ? S.a_base(nxt) : cA; const char* nB = has_next ? S.b_base(nxt) : cB;
        for (int t = 0; t < nt; t += 2) {
            const bool last = (t == nt - 2);
            const char* a1 = cA + (size_t)(t + 1) * kstep;
            const char* a2 = last ? nA : cA + (size_t)(t + 2) * kstep; const char* b2 = last ? nB : cB + (size_t)(t + 2) * bkstep;
            const char* a3 = a2 + kstep; const char* b3 = b2 + bkstep;
            unsigned v2[2][2];
            v2[0][0] = last ? nvo[0][0] : vo[0][0]; v2[0][1] = last ? nvo[0][1] : vo[0][1]; v2[1][0] = last ? nvo[1][0] : vo[1][0]; v2[1][1] = last ? nvo[1][1] : vo[1][1];
            if constexpr (SP2) {
            PG8_LDB(B0, 0, 0); PG8_LDB(B1, 0, 1); PG8_SCHED; PG8_LDA(At, 0, 0); PG8_STAGE(PG8_SA(1, 1), a1, vo[1]);
            PG8_WAIT_V(8); PG8_WAIT_L(0); PG8_BAR; PG8_MMA(0, 0, At, B0); PG8_MMA(0, 1, At, B1); PG8_BAR; PG8_SCHED;
            PG8_LDA(At, 0, 1); PG8_STAGE(PG8_SB(0, 0), b2, voffB); PG8_STAGE(PG8_SB(0, 1), b2 + bhstep, voffB); PG8_STAGE(PG8_SA(0, 0), a2, v2[0]);
            PG8_WAIT_V(8); PG8_WAIT_L(0); PG8_BAR; PG8_MMA(1, 0, At, B0); PG8_MMA(1, 1, At, B1); PG8_BAR; PG8_SCHED;
            PG8_LDB(B0, 1, 0); PG8_LDB(B1, 1, 1); PG8_SCHED; PG8_LDA(At, 1, 0); PG8_STAGE(PG8_SA(0, 1), a2, v2[1]);
            PG8_WAIT_V(8); PG8_WAIT_L(0); PG8_BAR; PG8_MMA(0, 0, At, B0); PG8_MMA(0, 1, At, B1); PG8_BAR; PG8_SCHED;
            PG8_LDA(At, 1, 1); PG8_STAGE(PG8_SB(1, 0), b3, voffB); PG8_STAGE(PG8_SB(1, 1), b3 + bhstep, voffB); PG8_STAGE(PG8_SA(1, 0), a3, v2[0]);
            PG8_WAIT_V(8); PG8_WAIT_L(0); PG8_BAR; PG8_MMA(1, 0, At, B0); PG8_MMA(1, 1, At, B1); PG8_BAR; PG8_SCHED;
            } else {
            PG8_LDB(B0, 0, 0); PG8_SCHED; PG8_LDA(At, 0, 0); PG8_STAGE(PG8_SA(1, 1), a1, vo[1]);
            PG8_WAIT_L(8); PG8_BAR; PG8_WAIT_L(0); PG8_MMA(0, 0, At, B0); PG8_BAR; PG8_SCHED;
            PG8_LDB(B1, 0, 1); PG8_STAGE(PG8_SB(0, 0), b2, voffB);
            PG8_BAR; PG8_WAIT_L(0); PG8_MMA(0, 1, At, B1); PG8_BAR;
            PG8_LDA(At, 0, 1); PG8_STAGE(PG8_SA(0, 0), a2, v2[0]);
            PG8_BAR; PG8_WAIT_L(0); PG8_MMA(1, 0, At, B0); PG8_BAR; PG8_SCHED;
            PG8_STAGE(PG8_SB(0, 1), b2 + bhstep, voffB);
            PG8_WAIT_V(6); PG8_BAR; PG8_MMA(1, 1, At, B1); PG8_BAR;
            PG8_LDB(B0, 1, 0); PG8_SCHED; PG8_LDA(At, 1, 0); PG8_STAGE(PG8_SA(0, 1), a2, v2[1]);
            PG8_WAIT_L(8); PG8_BAR; PG8_WAIT_L(0); PG8_MMA(0, 0, At, B0); PG8_BAR; PG8_SCHED;
            PG8_LDB(B1, 1, 1); PG8_STAGE(PG8_SB(1, 0), b3, voffB);
            PG8_BAR; PG8_WAIT_L(0); PG8_MMA(0, 1, At, B1); PG8_BAR;
            PG8_LDA(At, 1, 1); PG8_STAGE(PG8_SA(1, 0), a3, v2[0]);
            PG8_BAR; PG8_WAIT_L(0); PG8_MMA(1, 0, At, B0); PG8_BAR; PG8_SCHED;
            PG8_STAGE(PG8_SB(1, 1), b3 + bhstep, voffB);
            PG8_WAIT_V(6); PG8_BAR; PG8_MMA(1, 1, At, B1); PG8_BAR;
            }
            if constexpr (Epi::MID) { if (t == 10 || t == 22) E.mid(acc, cur, t == 22 ? 1 : 0, wr, wc, fr, fq); }
        }
        Unit nn; const bool has_nn = has_next && S.next(ui + 2, nn); unsigned nnvo[2][2];
        if (has_nn) S.a_offs(nn, RA, CA, nnvo); else { nnvo[0][0] = nvo[0][0]; nnvo[0][1] = nvo[0][1]; nnvo[1][0] = nvo[1][0]; nnvo[1][1] = nvo[1][1]; }
        if constexpr (ALIGN_EPI) { if (wr == 0) PG8_BAR; }
        if constexpr (FP8) PG8_PIN_ACC("s_nop 15\n\ts_nop 7");
        E(acc, cur, wr, wc, fr, fq);
        if (!has_next) break;
#pragma unroll
        for (int a = 0; a < 2; ++a)
#pragma unroll
            for (int b = 0; b < 2; ++b)
#pragma unroll
                for (int m = 0; m < 4; ++m)
#pragma unroll
                    for (int n = 0; n < 2; ++n) acc[a][b][m][n] = (f32x4){0.f, 0.f, 0.f, 0.f};
        if constexpr (FP8) PG8_PIN_ACC("s_nop 7");
        cur = nxt; cA = nA; cB = nB; ++ui; nxt = nn; has_next = has_nn;
        vo[0][0] = nvo[0][0]; vo[0][1] = nvo[0][1]; vo[1][0] = nvo[1][0]; vo[1][1] = nvo[1][1];
        nvo[0][0] = nnvo[0][0]; nvo[0][1] = nnvo[0][1]; nvo[1][0] = nnvo[1][0]; nvo[1][1] = nnvo[1][1];
        if constexpr (ALIGN_EPI) { if (wr == 1) PG8_BAR; }
    }
    PG8_WAIT_V(0);
    if constexpr (!ALIGN_EPI) { if (wr == 0) PG8_BAR; }
    PG8_BAR;
#undef PG8_SA
#undef PG8_SB
#undef PG8_STAGE
#undef PG8_LDA
#undef PG8_LDB
#undef PG8_MMA
#undef PG8_WAIT_V
#undef PG8_WAIT_L
#undef PG8_BAR
#undef PG8_SCHED
}
}

constexpr int NWAVES = 8;
constexpr int BATCH = 2, SEQ = 8192, DM = 2048, T = BATCH * SEQ;
constexpr int NMEM = 256, MROWS = BATCH * NMEM;
constexpr int INW = 10252;
constexpr int NEXP = 32, TOPK = 4, CAP = T;
constexpr int QKVW = 4096;
constexpr int C_FQ = 0, C_FK = 768, C_FV = 1536, C_SQ = 2304, C_SK = 3072, C_SV = 3328, C_MQ = 3584;
constexpr int GW = 6144;
constexpr float NORM_EPS = 1e-6f;
constexpr float LOG2E = 1.4426950408889634f;
constexpr float SWIGLU_LIMIT = 7.0f, SWIGLU_ALPHA = 1.702f;
constexpr int PER_PHASE = 10;
#ifndef MK_LATE_WD
#define MK_LATE_WD 0
#endif
constexpr bool LATE_WD = false;
#ifndef MK_CONV_IN_P3
#define MK_CONV_IN_P3 1
#endif
constexpr bool CONV_IN_P3 = MK_CONV_IN_P3;
#ifndef MK_N_LAUNCHES
#define MK_N_LAUNCHES 1
#endif
constexpr int N_LAUNCHES = MK_N_LAUNCHES;

constexpr size_t MiB = 1u << 20;
constexpr size_t WS_CTL = 0, CTL_ZERO_BYTES = 1 * MiB;
constexpr size_t WS_WIN   = 2 * MiB;
constexpr size_t WS_WMKV  = WS_WIN + 40 * MiB;
constexpr size_t WS_WUP   = WS_WMKV + 4 * MiB;
constexpr size_t WS_WOUT  = WS_WUP + 8 * MiB;
constexpr size_t WS_WRT   = WS_WOUT + 8 * MiB;
constexpr size_t WS_WGU   = WS_WRT + 1 * MiB;
constexpr size_t WS_WD    = WS_WGU + 512 * MiB;
constexpr size_t WS_XN    = WS_WD + 256 * MiB;
constexpr size_t WS_MN    = WS_XN + 64 * MiB;
constexpr size_t WS_LOGF  = WS_MN + 2 * MiB;
constexpr size_t WS_CNEG  = WS_LOGF + 1 * MiB;
constexpr size_t WS_ROPE  = WS_CNEG + 1 * MiB;
constexpr size_t WS_QKV   = WS_ROPE + 4 * MiB;
constexpr size_t WS_G     = WS_QKV + 128 * MiB;
constexpr size_t WS_MKV   = WS_G + 192 * MiB;
constexpr size_t WS_OALL  = WS_MKV + 1 * MiB;
constexpr size_t WS_MERGED= WS_OALL + 64 * MiB;
constexpr size_t WS_HB    = WS_MERGED + 64 * MiB;
constexpr size_t WS_TOK   = WS_HB + 64 * MiB;
constexpr size_t WS_GATE  = WS_TOK + 2 * MiB;
constexpr size_t WS_RS    = WS_GATE + 2 * MiB;
constexpr size_t WS_ACT   = WS_RS + 2 * MiB;
constexpr size_t WS_Y     = WS_ACT + 288 * MiB;
constexpr size_t WS_TSLOT = WS_Y + 288 * MiB;
constexpr size_t WS_TGATE = WS_TSLOT + 1 * MiB;
constexpr size_t WS_XN8   = WS_TGATE + 1 * MiB;
constexpr size_t WS_WIN8  = WS_XN8 + 32 * MiB;
constexpr size_t WS_END   = WS_WIN8 + 12 * MiB;
constexpr int CW_BAR = 4096;
constexpr int CW_QHEAD = 64;
constexpr int CW_CNT = 512;

typedef unsigned short bf16;
typedef unsigned v4u __attribute__((ext_vector_type(4)));
typedef unsigned v2u __attribute__((ext_vector_type(2)));
typedef float f32x4 __attribute__((ext_vector_type(4)));
typedef float f32x16 __attribute__((ext_vector_type(16)));
typedef short bf16x8 __attribute__((ext_vector_type(8)));
typedef short s16x4 __attribute__((ext_vector_type(4)));
typedef GAS unsigned gu32;
#define RLX_AGENT __ATOMIC_RELAXED, __HIP_MEMORY_SCOPE_AGENT
#define LDS_WAIT() asm volatile("s_waitcnt lgkmcnt(0)" ::: "memory")
#define VM_WAIT() asm volatile("s_waitcnt vmcnt(0)" ::: "memory")
__device__ __forceinline__ unsigned f2bf(float f) { unsigned u = __builtin_bit_cast(unsigned, f); return (u + 0x7fffu + ((u >> 16) & 1u)) >> 16; }
__device__ __forceinline__ unsigned pk2(float lo, float hi) { return f2bf(lo) | (f2bf(hi) << 16); }
__device__ __forceinline__ float bf2f(unsigned short b) { return __uint_as_float(((unsigned)b) << 16); }
__device__ __forceinline__ float wave_sum(float v) {
#pragma unroll
    for (int o = 1; o < 64; o <<= 1) v += __shfl_xor(v, o);
    return v;
}
__device__ __forceinline__ float sigmoidf_(float x) { return __builtin_amdgcn_rcpf(1.0f + __builtin_amdgcn_exp2f(x * (-LOG2E))); }

constexpr int H8_SHIFT = 4, ACT8_SHIFT = 2, W8_SHIFT = 9;
constexpr float H8_MUL = 16.0f, ACT8_MUL = 4.0f, W8_MUL = 512.0f;
__device__ __forceinline__ float clamp_fp8(float v) { return __builtin_amdgcn_fmed3f(v, -448.0f, 448.0f); }
__device__ __forceinline__ unsigned pk4_fp8(float a, float b, float c, float d) {
    int p = __builtin_amdgcn_cvt_pk_fp8_f32(clamp_fp8(a), clamp_fp8(b), 0, false); p = __builtin_amdgcn_cvt_pk_fp8_f32(clamp_fp8(c), clamp_fp8(d), p, true); return (unsigned)p; }
using pg8::f32x2; using pg8::u32x4; using pg8::u32x2; using pg8::cvt_pk_bf16; using pg8::bf_lo; using pg8::bf_hi;

#define XB_TMO      128
#define XB_XCNT(j)  (256  + 64 * (j))
#define XB_XSUB(j)  (1280 + 64 * (j))
#define XB_XGEN(j)  (2304 + 64 * (j))
#define XB_TOP      3328
#define XB_TOPGEN   3392
#define XCD_BAR_WORDS 3456
#define XB_SPIN_CAP (1u << 18)

__device__ __forceinline__ unsigned xb_ld(unsigned* p)              { return __hip_atomic_load(p, __ATOMIC_RELAXED, __HIP_MEMORY_SCOPE_AGENT); }
__device__ __forceinline__ unsigned xb_add(unsigned* p, unsigned v) { return __hip_atomic_fetch_add(p, v, __ATOMIC_RELAXED, __HIP_MEMORY_SCOPE_AGENT); }
__device__ __forceinline__ unsigned xb_xcc_id() { return (unsigned)__builtin_amdgcn_s_getreg((3 << 11) | 20) & 0xFu; }
#define XB_SPIN(cond, bar) do { unsigned _sp = 0; while (cond) { __builtin_amdgcn_s_sleep(1); \
    if ((++_sp & 255u) == 0u) { if (xb_ld(&(bar)[XB_TMO])) break; if (_sp > XB_SPIN_CAP) { atomicAdd(&(bar)[XB_TMO], 1u); break; } } } } while (0)

struct XcdBarrier { unsigned* bar; unsigned x; volatile LAS unsigned* st; };

__device__ __forceinline__ XcdBarrier xcd_barrier_post(unsigned* bar, volatile LAS unsigned* st) {
    XcdBarrier b; b.bar = bar; b.x = xb_xcc_id(); b.st = st;
    if (threadIdx.x == 0) (void)xb_add(&bar[XB_XCNT(b.x)], 1u);
    return b;
}
__device__ __forceinline__ void xcd_barrier_complete(unsigned* bar, unsigned x, unsigned& nloc, unsigned& nx) {
    const unsigned G = gridDim.x * gridDim.y * gridDim.z;
    unsigned sum, cnt, mine, sp = 0u;
    for (;;) {
        sum = 0u; cnt = 0u; mine = 0u;
#pragma unroll
        for (unsigned j = 0; j < 16; ++j) { const unsigned c = xb_ld(&bar[XB_XCNT(j)]); sum += c; cnt += (c > 0u) ? 1u : 0u; mine = (j == x) ? c : mine; }
        if (sum == G) break;
        __builtin_amdgcn_s_sleep(1);
        if ((++sp & 255u) == 0u) { if (xb_ld(&bar[XB_TMO])) break; if (sp > XB_SPIN_CAP) { atomicAdd(&bar[XB_TMO], 1u); break; } }
    }
    nloc = mine > 0u ? mine : 1u; nx = cnt > 0u ? cnt : 1u;
}
__device__ __forceinline__ void xcd_barrier(const XcdBarrier& b) {
    asm volatile("s_waitcnt vmcnt(0)" ::: "memory");
    __syncthreads();
    if (threadIdx.x == 0) {
        unsigned* bar = b.bar;
        __builtin_amdgcn_s_waitcnt(0);
        unsigned nloc = b.st[0], nx = b.st[1];
        if (nloc == 0u) { xcd_barrier_complete(bar, b.x, nloc, nx); b.st[0] = nloc; b.st[1] = nx; }
        const unsigned old = xb_add(&bar[XB_XSUB(b.x)], 1u);
        const unsigned gen = old / nloc;
        if (old + 1u == (gen + 1u) * nloc) {
            __builtin_amdgcn_fence(__ATOMIC_RELEASE, "agent");
            asm volatile("s_waitcnt vmcnt(0)" ::: "memory");
            const unsigned og = xb_add(&bar[XB_TOP], 1u);
            const unsigned tg = og / nx;
            if (og + 1u == (tg + 1u) * nx) xb_add(&bar[XB_TOPGEN], 1u);
            else XB_SPIN(xb_ld(&bar[XB_TOPGEN]) == tg, bar);
            __builtin_amdgcn_fence(__ATOMIC_ACQUIRE, "agent");
            xb_add(&bar[XB_XGEN(b.x)], 1u);
            asm volatile("s_waitcnt vmcnt(0)" ::: "memory");
        } else {
            XB_SPIN(xb_ld(&bar[XB_XGEN(b.x)]) == gen, bar);
            __builtin_amdgcn_fence(__ATOMIC_ACQUIRE, "agent");
            asm volatile("s_waitcnt vmcnt(0)" ::: "memory");
        }
    }
    __syncthreads();
}

constexpr int RING_OFF = 0, RING_BYTES = 131072;
constexpr int LDSCTL_OFF = RING_BYTES, MISC_OFF = LDSCTL_OFF + 320;
constexpr int MOE_OFF = MISC_OFF + 128;
constexpr int LDS_BYTES = 147456;

struct Ctx {
    LAS unsigned char* lds;
    volatile LAS unsigned* MISC;
    gu32* ctl;
    int tid, lane, wave, vcu, G, probe;
    const float *x, *mem; const int* pos; const float *norm_mix, *w_in, *b_forget, *fox_q_norm, *fox_k_norm, *swa_q_norm, *swa_k_norm, *swa_sinks, *xmem_q_norm, *xmem_k_norm, *norm_mem,
        *w_mem_kv, *w_up_fox, *w_up_swa, *w_up_xmem, *w_out, *norm_ffn, *w_router, *b_router, *w_gate_up, *b_gate_up, *w_down, *b_down;
    float* out;
    bf16 *Win_t, *Wmkv_t, *Wup_t, *Wout_t, *Wr_t, *Wgu_t, *Wd_t, *XN, *MN, *QKV, *G_, *MKV, *OALL, *MERGED, *HB, *ACT;
    float *LOGF, *CNEG, *ROPE, *GATEW, *RS, *TGATE; int *TOK, *TSLOT; bf16* Y; unsigned char *XN8, *Win8;
};

#ifndef PROBE_INW
#define PROBE_INW 64
#endif
__constant__ float INV_FREQ[32] = {1.000000000e+00f, 7.498942614e-01f, 5.623413324e-01f, 4.216965139e-01f, 3.162277639e-01f, 2.371373773e-01f, 1.778279394e-01f, 1.333521307e-01f,
    1.000000015e-01f, 7.498941571e-02f, 5.623413250e-02f, 4.216965288e-02f, 3.162277490e-02f, 2.371373773e-02f, 1.778279431e-02f, 1.333521493e-02f, 9.999999776e-03f, 7.498941850e-03f,
    5.623413250e-03f, 4.216964822e-03f, 3.162277630e-03f, 2.371373586e-03f, 1.778279431e-03f, 1.333521446e-03f, 1.000000047e-03f, 7.498942432e-04f, 5.623413017e-04f, 4.216965172e-04f,
    3.162277571e-04f, 2.371373703e-04f, 1.778279402e-04f, 1.333521504e-04f};

struct TItem { const float* src; const float* ksc; bf16* dst; size_t ldw; int f8, gap; };
__device__ __forceinline__ void titem_load(const TItem& I, f32x4 (&v)[8][2], float (&sc)[8][2], int lane) {
    const int rr = lane >> 4, c4 = lane & 15;
#pragma unroll
    for (int p = 0; p < 8; ++p)
#pragma unroll
        for (int h = 0; h < 2; ++h) { const int k = 8 * p + 2 * rr + h; v[p][h] = *(const GAS f32x4*)(I.src + (size_t)k * I.ldw + 4 * c4 + (c4 >= 8 ? I.gap : 0)); sc[p][h] = I.ksc ? I.ksc[k] : 1.0f; }
}
__device__ __forceinline__ void titem_store(const TItem& I, const f32x4 (&v)[8][2], const float (&sc)[8][2], LAS unsigned* tile, int lane) {
    const int rr = lane >> 4, c4 = lane & 15;
#pragma unroll
    for (int p = 0; p < 8; ++p)
#pragma unroll
        for (int q = 0; q < 4; ++q) { const int n = 4 * c4 + q, sw = (n ^ (n >> 3)) & 7;
            tile[n * 32 + 4 * (p ^ sw) + rr] = pg8::cvt_pk_bf16(v[p][0][q] * sc[p][0], v[p][1][q] * sc[p][1]); }
    LDS_WAIT(); asm volatile("" ::: "memory");
#pragma unroll
    for (int j = 0; j < 8; ++j) { const int n = 8 * j + (lane >> 3), c = lane & 7, sw = (n ^ (n >> 3)) & 7;
        const v4u o = *(const LAS v4u*)(tile + n * 32 + 4 * (c ^ sw));
        *(GAS v4u*)(I.dst + (size_t)n * DM + 8 * c) = o; }
    LDS_WAIT(); asm volatile("" ::: "memory");
}
__device__ __forceinline__ size_t tiled8(size_t row, int kt) { return (row >> 8) * (size_t)(256 * 2048) + (size_t)kt * 32768 + (row & 255) * 128; }
#ifndef CONV_NT
#define CONV_NT 1
#endif
#if CONV_NT
#define CONV_LOAD(p) __builtin_nontemporal_load(p)
#else
#define CONV_LOAD(p) (*(p))
#endif
__device__ __forceinline__ void titem8_load(const TItem& I, int qh, f32x4 (&v)[4][2], int lane) {
    const int rr = lane >> 4, c4 = lane & 15;
#pragma unroll
    for (int pp = 0; pp < 2; ++pp)
#pragma unroll
        for (int h = 0; h < 4; ++h) { const int k = 32 * qh + 16 * pp + 4 * rr + h; v[2 * pp + (h >> 1)][h & 1] = CONV_LOAD((const GAS f32x4*)(I.src + (size_t)k * I.ldw + 4 * c4)); }
}
__device__ __forceinline__ void titem8_pack(const TItem& I, const float* nbase, int qh, const f32x4 (&v)[4][2], LAS unsigned* tile, const LAS float* lnorm, int lane) {
    const int rr = lane >> 4, c4 = lane & 15;
    const int kofs = I.ksc ? (int)(I.ksc - nbase) + 32 * qh + 4 * rr : -1;
#pragma unroll
    for (int pp = 0; pp < 2; ++pp) {
        f32x4 sc = {W8_MUL, W8_MUL, W8_MUL, W8_MUL}; if (kofs >= 0) sc = *(const LAS f32x4*)(lnorm + kofs + 16 * pp);
#pragma unroll
        for (int q = 0; q < 4; ++q) { const int n = 4 * c4 + q, sw = (n ^ (n >> 3)) & 7;
            tile[n * 32 + 4 * ((2 * qh + pp) ^ sw) + rr] = pk4_fp8(v[2 * pp][0][q] * sc.x, v[2 * pp][1][q] * sc.y, v[2 * pp + 1][0][q] * sc.z, v[2 * pp + 1][1][q] * sc.w); } }
}
__device__ __forceinline__ void titem8_flush(const TItem& I, LAS unsigned* tile, int lane) {
    LDS_WAIT(); asm volatile("" ::: "memory");
#pragma unroll
    for (int j = 0; j < 8; ++j) { const int n = 8 * j + (lane >> 3), c = lane & 7, sw = (n ^ (n >> 3)) & 7;
        const v4u o = *(const LAS v4u*)(tile + n * 32 + 4 * (c ^ sw));
        *(GAS v4u*)((unsigned char*)I.dst + (size_t)n * 128 + 16 * c) = o; }
    LDS_WAIT(); asm volatile("" ::: "memory");
}
__device__ __forceinline__ void p0_router_item(const float* W, int k0, bf16* WT, const float* ksc, LAS float* scr, int lane) {
#pragma unroll 8
    for (int i = 0; i < 32; ++i) { const int kk = 2 * i + (lane >> 5); scr[kk * 33 + (lane & 31)] = W[(size_t)(k0 + kk) * 32 + (lane & 31)] * ksc[k0 + kk]; }
    LDS_WAIT(); asm volatile("" ::: "memory");
    const int c = lane & 7;
#pragma unroll
    for (int j = 0; j < 4; ++j) { const int n = (lane >> 3) + 8 * j; const LAS float* s = scr + (8 * c) * 33 + n;
        unsigned h[8], l[8];
#pragma unroll
        for (int q = 0; q < 8; ++q) { const float v = s[q * 33]; h[q] = f2bf(v); l[q] = f2bf(v - __uint_as_float(h[q] << 16)); }
        v4u oh, ol; oh.x = h[0] | (h[1] << 16); oh.y = h[2] | (h[3] << 16); oh.z = h[4] | (h[5] << 16); oh.w = h[6] | (h[7] << 16);
        ol.x = l[0] | (l[1] << 16); ol.y = l[2] | (l[3] << 16); ol.z = l[4] | (l[5] << 16); ol.w = l[6] | (l[7] << 16);
        *(GAS v4u*)(WT + (size_t)n * 2048 + k0 + 8 * c) = oh; *(GAS v4u*)(WT + (size_t)(32 + n) * 2048 + k0 + 8 * c) = ol; }
    LDS_WAIT(); asm volatile("" ::: "memory");
}
__device__ __forceinline__ float log_sigmoidf_(float z) { return fminf(z, 0.f) - log1pf(__expf(-fabsf(z))); }

template <bool XROW>
__device__ __forceinline__ void p0_norm_row(const Ctx& C, const float* xrow, const float* gain, bf16* orow, const LAS float* Wf, int m) {
    const GAS f32x4* xr = (const GAS f32x4*)xrow + C.lane; const GAS f32x4* gr = (const GAS f32x4*)gain + C.lane;
    f32x4 v[8]; float s = 0.f;
#pragma unroll
    for (int j = 0; j < 8; ++j) { v[j] = xr[64 * j]; s += (v[j].x * v[j].x + v[j].y * v[j].y) + (v[j].z * v[j].z + v[j].w * v[j].w); }
    const float rstd = 1.0f / sqrtf(wave_sum(s) * (1.f / DM) + NORM_EPS);
    GAS unsigned long long* o8 = (GAS unsigned long long*)orow + C.lane;
#pragma unroll
    for (int j = 0; j < 8; ++j) { const f32x4 g = gr[64 * j]; v[j] = (v[j] * rstd) * g;
        o8[64 * j] = (unsigned long long)pk2(v[j].x, v[j].y) | ((unsigned long long)pk2(v[j].z, v[j].w) << 32);
        if constexpr (XROW) ((GAS unsigned*)(C.XN8 + (size_t)m * DM))[C.lane + 64 * j] = pk4_fp8(v[j].x * H8_MUL, v[j].y * H8_MUL, v[j].z * H8_MUL, v[j].w * H8_MUL); }
    if constexpr (XROW) {
        float mine = 0.f;
#pragma unroll 1
        for (int h = 0; h < 12; ++h) { const LAS f32x4* w = (const LAS f32x4*)(Wf + h * 2048) + C.lane; float d = 0.f;
#pragma unroll
            for (int j = 0; j < 8; ++j) { const f32x4 ww = w[64 * j]; d += (v[j].x * ww.x + v[j].y * ww.y) + (v[j].z * ww.z + v[j].w * ww.w); }
            d = wave_sum(d); if (C.lane == h) mine = d; }
        const int b = m / SEQ, t = m % SEQ;
        if (C.lane < 12) C.LOGF[(size_t)(b * 12 + C.lane) * SEQ + t] = log_sigmoidf_(mine + C.b_forget[C.lane]);
        if (C.lane < 32) { const float ang = (float)C.pos[m] * INV_FREQ[C.lane]; const double rev = (double)ang * 0.15915494309189535; const float fr = (float)(rev - floor(rev));
            C.ROPE[(size_t)m * 64 + C.lane] = __builtin_amdgcn_cosf(fr); C.ROPE[(size_t)m * 64 + 32 + C.lane] = __builtin_amdgcn_sinf(fr); }
    }
}
constexpr int I_GU = 32 * 16 * 64, I_D = 32 * 16 * 32, I_ING = 16 * 96, I_IN = 32 * PROBE_INW, I_MKV = 32 * 16, I_UF = 12 * 32, I_US = 12 * 32, I_UX = 8 * 32, I_O = 32 * 32;
constexpr int NITEMS = I_GU + I_D + I_ING + I_IN + I_MKV + I_UF + I_US + I_UX + I_O;
constexpr int N8 = I_GU + I_D + I_ING;
__device__ __forceinline__ TItem p0_decode(const Ctx& C, int it) {
        TItem I; int r = it; I.ksc = nullptr; I.f8 = 0; I.gap = 0;
        if (r < I_GU) { const int e = r / 1024, q = r % 1024, kb = 2 * (q / 64), pb = q % 64, tl = pb >> 2, jb = pb & 3;
            const int n0 = (jb < 2) ? (128 * tl + 64 * jb) : (2048 + 128 * tl + 64 * (jb - 2));
            I.ldw = 4096; I.src = C.w_gate_up + (size_t)e * DM * 4096 + (size_t)(64 * kb) * 4096 + n0; I.ksc = C.norm_ffn + 64 * kb; I.f8 = 1; I.dst = (bf16*)((unsigned char*)C.Wgu_t + tiled8((size_t)e * 4096 + 64 * pb, kb >> 1)); return I; } r -= I_GU;
        if (r < I_D) { const int e = r / 512, q = r % 512, kb = 2 * (q / 32), nb = q % 32;
            I.ldw = DM; I.src = C.w_down + (size_t)e * DM * DM + (size_t)(64 * kb) * DM + 64 * nb; I.f8 = 1; I.dst = (bf16*)((unsigned char*)C.Wd_t + tiled8((size_t)e * DM + 64 * nb, kb >> 1)); return I; } r -= I_D;
        if (r < I_ING) { const int kb = 2 * (r / 96), pb = r % 96;
            I.ldw = INW; I.src = C.w_in + (size_t)(64 * kb) * INW + 4108 + 64 * pb; I.f8 = 1; I.dst = (bf16*)((unsigned char*)C.Win8 + tiled8((size_t)64 * pb, kb >> 1)); return I; } r -= I_ING;
        if (r < I_IN) { const int kb = r / PROBE_INW, pb = r % PROBE_INW; int p0 = 64 * pb; const int tl = pb >> 2, q4 = pb & 3;
            if (tl == 3 || tl == 4 || tl == 5 || tl == 12) { p0 = 256 * tl + 128 * (q4 & 1) + 32 * (q4 >> 1); I.gap = 32; }
            const int n0 = (p0 < 2304) ? p0 : p0 + 12;
            I.ldw = INW; I.src = C.w_in + (size_t)(64 * kb) * INW + n0; I.dst = C.Win_t + (size_t)(64 * pb) * DM + 64 * kb; return I; } r -= I_IN;
        if (r < I_MKV) { const int kb = r / 16, nb = r % 16; I.ldw = 1024; I.src = C.w_mem_kv + (size_t)(64 * kb) * 1024 + 64 * nb; I.dst = C.Wmkv_t + (size_t)(64 * nb) * DM + 64 * kb; return I; } r -= I_MKV;
        if (r < I_UF) { const int kb = r / 32, nb = r % 32; I.ldw = DM; I.src = C.w_up_fox + (size_t)(64 * kb) * DM + 64 * nb; I.dst = C.Wup_t + (size_t)(64 * nb) * DM + 64 * kb; return I; } r -= I_UF;
        if (r < I_US) { const int kb = r / 32, nb = r % 32; I.ldw = DM; I.src = C.w_up_swa + (size_t)(64 * kb) * DM + 64 * nb; I.dst = C.Wup_t + (size_t)(64 * nb) * DM + 768 + 64 * kb; return I; } r -= I_US;
        if (r < I_UX) { const int kb = r / 32, nb = r % 32; I.ldw = DM; I.src = C.w_up_xmem + (size_t)(64 * kb) * DM + 64 * nb; I.dst = C.Wup_t + (size_t)(64 * nb) * DM + 1536 + 64 * kb; return I; } r -= I_UX;
        { const int kb = r / 32, nb = r % 32; I.ldw = DM; I.src = C.w_out + (size_t)(64 * kb) * DM + 64 * nb; I.dst = C.Wout_t + (size_t)(64 * nb) * DM + 64 * kb; return I; }
}
__device__ __forceinline__ void p0_fp8_loop(const Ctx& C, int first, int cnt, int me, int stride, LAS unsigned* tile, const LAS float* lnorm) {
    if (me >= cnt) return;
    const int nq = 4 * ((cnt - me + stride - 1) / stride);
    f32x4 b0[4][2], b1[4][2], b2[4][2], b3[4][2], b4[4][2];
#define P0_ITEM(q_) p0_decode(C, first + me + ((q_) >> 2) * stride)
#define P0_STEP(q_, cur_, pre_) do { const int qq = (q_); if (qq < nq) { \
        if (qq + 4 < nq) { const TItem J = P0_ITEM(qq + 4); titem8_load(J, (qq + 4) & 3, pre_, C.lane); } \
        const TItem I = P0_ITEM(qq); titem8_pack(I, C.norm_ffn, qq & 3, cur_, tile, lnorm, C.lane); \
        if ((qq & 3) == 3) titem8_flush(I, tile, C.lane); } } while (0)
    { const TItem I = P0_ITEM(0); titem8_load(I, 0, b0, C.lane); titem8_load(I, 1, b1, C.lane); titem8_load(I, 2, b2, C.lane); titem8_load(I, 3, b3, C.lane); }
    for (int qs = 0; qs < nq; qs += 5) { P0_STEP(qs, b0, b4); P0_STEP(qs + 1, b1, b0); P0_STEP(qs + 2, b2, b1); P0_STEP(qs + 3, b3, b2); P0_STEP(qs + 4, b4, b3); }
#undef P0_ITEM
#undef P0_STEP
}
__device__ __forceinline__ void p0_fill_lnorm(const Ctx& C, LAS float* lnorm) { for (int k = C.tid; k < DM; k += NWAVES * 64) lnorm[k] = C.norm_ffn[k] * W8_MUL; }
__device__ __forceinline__ void p0_x_rows2(const Ctx& C, const LAS float* Wf, int m0, int m1) {
    const GAS f32x4* gr = (const GAS f32x4*)C.norm_mix + C.lane;
    const int mm[2] = {m0, m1};
    f32x4 v[2][8]; float s[2] = {0.f, 0.f};
#pragma unroll
    for (int r = 0; r < 2; ++r) { const GAS f32x4* xr = (const GAS f32x4*)(C.x + (size_t)mm[r] * DM) + C.lane;
#pragma unroll
        for (int j = 0; j < 8; ++j) v[r][j] = xr[64 * j]; }
#pragma unroll
    for (int r = 0; r < 2; ++r)
#pragma unroll
        for (int j = 0; j < 8; ++j) s[r] += (v[r][j].x * v[r][j].x + v[r][j].y * v[r][j].y) + (v[r][j].z * v[r][j].z + v[r][j].w * v[r][j].w);
    float rstd[2];
#pragma unroll
    for (int r = 0; r < 2; ++r) rstd[r] = 1.0f / sqrtf(wave_sum(s[r]) * (1.f / DM) + NORM_EPS);
#pragma unroll
    for (int j = 0; j < 8; ++j) { const f32x4 g = gr[64 * j];
#pragma unroll
        for (int r = 0; r < 2; ++r) { v[r][j] = (v[r][j] * rstd[r]) * g;
            ((GAS unsigned long long*)(C.XN + (size_t)mm[r] * DM))[C.lane + 64 * j] = (unsigned long long)pk2(v[r][j].x, v[r][j].y) | ((unsigned long long)pk2(v[r][j].z, v[r][j].w) << 32);
            ((GAS unsigned*)(C.XN8 + (size_t)mm[r] * DM))[C.lane + 64 * j] = pk4_fp8(v[r][j].x * H8_MUL, v[r][j].y * H8_MUL, v[r][j].z * H8_MUL, v[r][j].w * H8_MUL); } }
    float mine[2] = {0.f, 0.f};
#pragma unroll 1
    for (int h = 0; h < 12; ++h) { const LAS f32x4* w = (const LAS f32x4*)(Wf + h * 2048) + C.lane; float d0 = 0.f, d1 = 0.f;
#pragma unroll
        for (int j = 0; j < 8; ++j) { const f32x4 ww = w[64 * j];
            d0 += (v[0][j].x * ww.x + v[0][j].y * ww.y) + (v[0][j].z * ww.z + v[0][j].w * ww.w); d1 += (v[1][j].x * ww.x + v[1][j].y * ww.y) + (v[1][j].z * ww.z + v[1][j].w * ww.w); }
        d0 = wave_sum(d0); d1 = wave_sum(d1); if (C.lane == h) { mine[0] = d0; mine[1] = d1; } }
#pragma unroll
    for (int r = 0; r < 2; ++r) { const int m = mm[r], b = m / SEQ, t = m % SEQ;
        if (C.lane < 12) C.LOGF[(size_t)(b * 12 + C.lane) * SEQ + t] = log_sigmoidf_(mine[r] + C.b_forget[C.lane]);
        if (C.lane < 32) { const float ang = (float)C.pos[m] * INV_FREQ[C.lane]; const double rev = (double)ang * 0.15915494309189535; const float fr = (float)(rev - floor(rev));
            C.ROPE[(size_t)m * 64 + C.lane] = __builtin_amdgcn_cosf(fr); C.ROPE[(size_t)m * 64 + 32 + C.lane] = __builtin_amdgcn_sinf(fr); } }
}
__device__ __forceinline__ void phase0(const Ctx& C) {
    const int gw = C.vcu * NWAVES + C.wave, NGW = C.G * NWAVES;
    LAS float* scr = (LAS float*)(C.lds + RING_OFF + C.wave * 16384);
    for (int r = gw; r < 32; r += NGW) p0_router_item(C.w_router, 64 * r, C.Wr_t, C.norm_ffn, scr, C.lane);
    LAS unsigned* tile = (LAS unsigned*)(C.lds + RING_OFF + C.wave * 8192);
    __syncthreads();
    LAS float* lnorm = (LAS float*)(C.lds + RING_OFF + 65536);
    p0_fill_lnorm(C, lnorm); __syncthreads();
    p0_fp8_loop(C, CONV_IN_P3 ? I_GU + I_D : 0, CONV_IN_P3 ? I_ING : N8, gw, NGW, tile, lnorm);
    if (N8 + gw < NITEMS) {
        TItem cur = p0_decode(C, N8 + gw); f32x4 va[8][2]; float sa[8][2]; titem_load(cur, va, sa, C.lane);
        for (int it = N8 + gw; it < NITEMS; it += NGW) {
            const int nx = it + NGW; TItem nxt = cur; f32x4 vb[8][2]; float sb[8][2];
            if (nx < NITEMS) { nxt = p0_decode(C, nx); titem_load(nxt, vb, sb, C.lane); }
            titem_store(cur, va, sa, tile, C.lane);
            cur = nxt;
#pragma unroll
            for (int p = 0; p < 8; ++p)
#pragma unroll
                for (int h = 0; h < 2; ++h) { va[p][h] = vb[p][h]; sa[p][h] = sb[p][h]; }
        }
    }
    __syncthreads();
    LAS float* Wf = (LAS float*)(C.lds + RING_OFF);
    for (int idx = C.tid; idx < 12 * 2048; idx += NWAVES * 64) { const int k = idx / 12, h = idx - 12 * k; Wf[h * 2048 + k] = C.w_in[(size_t)k * INW + 2304 + h]; }
    __syncthreads();
    { int m = gw; for (; m + NGW < T; m += 2 * NGW) p0_x_rows2(C, Wf, m, m + NGW); if (m < T) p0_norm_row<true>(C, C.x + (size_t)m * DM, C.norm_mix, C.XN + (size_t)m * DM, Wf, m); }
    for (int m = gw; m < MROWS; m += NGW) p0_norm_row<false>(C, C.mem + (size_t)m * DM, C.norm_mem, C.MN + (size_t)m * DM, Wf, m);
    __syncthreads();
}

constexpr int CONV_CHUNK = 128, CONV_NCHUNK = (I_GU + I_D) / CONV_CHUNK;
static_assert((I_GU + I_D) % CONV_CHUNK == 0, "conversion chunks");
__device__ __forceinline__ void conv_chunk(const Ctx& C, int chunk) {
    LAS unsigned* tile = (LAS unsigned*)(C.lds + RING_OFF + C.wave * 8192);
    p0_fp8_loop(C, chunk * CONV_CHUNK, CONV_CHUNK, C.wave, NWAVES, tile, (const LAS float*)(C.lds + RING_OFF + 65536));
}

using pg8::Unit;
template <int RB>
struct DenseOrderT {
    const char* A; const char* Bt; int nM, nN, nwg, G, c;
    __device__ __forceinline__ void init(const void* A_, const void* Bt_, int M, int N, int G_, int c_) { A = (const char*)A_; Bt = (const char*)Bt_; nM = M / 256; nN = N / 256; nwg = nM * nN; G = G_; c = c_; }
    __device__ __forceinline__ bool map(long L, Unit& u) const {
        if (L >= nwg) return false;
        int wgid = (int)L; { const int q = nwg / 8, r = nwg % 8, xcd = wgid % 8, off = wgid / 8; wgid = (xcd < r ? xcd * (q + 1) : r * (q + 1) + (xcd - r) * q) + off; }
        const int nig = 8 * nN, gid = wgid / nig, fm = gid * 8, gsz = (nM - fm) < 8 ? (nM - fm) : 8;
        u.pm = fm + ((wgid % nig) % gsz); u.pn = (wgid % nig) / gsz; u.e = 0; u.kind = 0; return true;
    }
    __device__ __forceinline__ bool next(int i, Unit& u) const { return map((long)i * G + c, u); }
    __device__ __forceinline__ const char* a_base(const Unit& u) const { return A + (size_t)u.pm * (256 * RB); }
    __device__ __forceinline__ const char* b_base(const Unit& u) const { return Bt + (size_t)u.pn * (256 * RB); }
    __device__ __forceinline__ void a_offs(const Unit&, const int (&R)[2], const int (&Cc)[2], unsigned (&vo)[2][2]) const {
#pragma unroll
        for (int h = 0; h < 2; ++h)
#pragma unroll
            for (int i = 0; i < 2; ++i) vo[h][i] = (unsigned)((h * 128 + R[i]) * RB + Cc[i] * 2);
    }
};
typedef DenseOrderT<4096> DenseOrder;
struct P1Order {
    DenseOrder d; const char* A1; const char* B1;
    __device__ __forceinline__ bool next(int i, Unit& u) const {
        const long L = (long)i * d.G + d.c;
        if (L < d.nwg) return d.map(L, u);
        const int r = (int)(L - d.nwg); if (r >= 8) return false;
        u.pm = r >> 2; u.pn = r & 3; u.e = 0; u.kind = 1; return true;
    }
    __device__ __forceinline__ const char* a_base(const Unit& u) const { return (u.kind ? A1 : d.A) + (size_t)u.pm * (256 * 2048 * 2); }
    __device__ __forceinline__ const char* b_base(const Unit& u) const { return (u.kind ? B1 : d.Bt) + (size_t)u.pn * (256 * 2048 * 2); }
    __device__ __forceinline__ void a_offs(const Unit& u, const int (&R)[2], const int (&Cc)[2], unsigned (&vo)[2][2]) const { d.a_offs(u, R, Cc, vo); }
};
struct P1bOrder {
    DenseOrderT<2048> d;
    __device__ __forceinline__ bool next(int i, Unit& u) const {
        const int c = d.c;
        if (c < 8) return i < 4 ? d.map((long)i * d.G + c, u) : false;
        if (i < 6) return d.map((long)i * d.G + c, u);
        if (i == 6 && c < 24) { const int idx = c - 8; return d.map((long)(4 + (idx & 1)) * d.G + (idx >> 1), u); }
        return false;
    }
    __device__ __forceinline__ const char* a_base(const Unit& u) const { return d.a_base(u); }
    __device__ __forceinline__ const char* b_base(const Unit& u) const { return d.b_base(u); }
    __device__ __forceinline__ void a_offs(const Unit& u, const int (&R)[2], const int (&Cc)[2], unsigned (&vo)[2][2]) const { d.a_offs(u, R, Cc, vo); }
};
template <bool GATHER, int NT, int RB>
struct MoeOrder {
    const char* A; const char* Bt; const int* tok; const int* cnt; const LAS int* tab; int G, c;
    __device__ __forceinline__ bool next(int i, Unit& u) const {
        const int L = i * G + c; if (L >= __builtin_amdgcn_readfirstlane(tab[32])) return false;
        int e = 0;
#pragma unroll 1
        for (int j = 1; j < 32; ++j) e += (__builtin_amdgcn_readfirstlane(tab[j]) <= L) ? 1 : 0;
        const int j = L - __builtin_amdgcn_readfirstlane(tab[e]), mt = __builtin_amdgcn_readfirstlane(tab[33 + e]), per = mt * 4, ntg = j / per, r = j - ntg * per;
        u.e = e; u.pm = r >> 2; u.pn = ntg * 4 + (r & 3); u.kind = __builtin_amdgcn_readfirstlane(tab[65 + e]) + 256 * u.pm;
        return true;
    }
    __device__ __forceinline__ const char* a_base(const Unit& u) const { return GATHER ? A : A + (size_t)u.kind * RB; }
    __device__ __forceinline__ const char* b_base(const Unit& u) const { return Bt + ((size_t)u.e * NT + u.pn) * (256 * RB); }
    __device__ __forceinline__ void a_offs(const Unit& u, const int (&R)[2], const int (&Cc)[2], unsigned (&vo)[2][2]) const {
#pragma unroll
        for (int h = 0; h < 2; ++h)
#pragma unroll
            for (int i = 0; i < 2; ++i) {
                if constexpr (GATHER) { const int n_e = __builtin_amdgcn_readfirstlane(tab[97 + u.e]); int ri = 256 * u.pm + h * 128 + R[i]; ri = ri < n_e ? ri : n_e - 1;
                    const int row = tok[u.e * CAP + ri]; vo[h][i] = (unsigned)(row * RB + Cc[i] * 2); }
                else vo[h][i] = (unsigned)((h * 128 + R[i]) * RB + Cc[i] * 2);
            }
    }
};

struct EpiInProj {
    static constexpr bool PERM = true, MID = false, FP8 = false, ASM_MFMA = false, BTILED = false; static constexpr int SCALE_A = 0x7f, SCALE_B = 0x7f;
    bf16* QKV; bf16* Gt; bf16* MKV; int noop; const float* gk_fox; const float* gk_swa; const float* rope;
    __device__ __forceinline__ void mid(pg8::f32x4 (&)[2][2][4][2], const Unit&, int, int, int, int, int) const {}
    __device__ __forceinline__ void operator()(const pg8::f32x4 (&acc)[2][2][4][2], const Unit& u, int wr, int wc, int fr, int fq) const {
        asm volatile("" : "+v"(fr), "+v"(fq));
        if (noop) return;
        if (!u.kind && (u.pn == 3 || u.pn == 4 || u.pn == 5 || u.pn == 12)) {
            const bool swa = (u.pn == 12); const float* gp = (swa ? gk_swa : gk_fox) + 8 * fq;
            float gn[2][8];
#pragma unroll
            for (int bj = 0; bj < 2; ++bj) { const pg8::f32x4 a = *(const pg8::f32x4*)(gp + 32 * bj), b = *(const pg8::f32x4*)(gp + 32 * bj + 4);
                gn[bj][0] = a[0]; gn[bj][1] = a[1]; gn[bj][2] = a[2]; gn[bj][3] = a[3]; gn[bj][4] = b[0]; gn[bj][5] = b[1]; gn[bj][6] = b[2]; gn[bj][7] = b[3]; }
#pragma unroll
            for (int ai = 0; ai < 2; ++ai)
#pragma unroll
                for (int m = 0; m < 4; ++m) { const int row = u.pm * 256 + wr * 64 + fr + ai * 128 + m * 16;
                    float x[2][8]; float ss = 0.f;
#pragma unroll
                    for (int bj = 0; bj < 2; ++bj)
#pragma unroll
                        for (int n = 0; n < 2; ++n)
#pragma unroll
                            for (int e = 0; e < 4; ++e) { const float v = acc[ai][bj][m][n][e]; x[bj][4 * n + e] = v; ss += v * v; }
                    ss += __shfl_xor(ss, 16); ss += __shfl_xor(ss, 32);
                    const float rstd = 1.0f / sqrtf(ss * (1.f / 64.f) + NORM_EPS);
#pragma unroll
                    for (int bj = 0; bj < 2; ++bj)
#pragma unroll
                        for (int q = 0; q < 8; ++q) x[bj][q] = (x[bj][q] * rstd) * gn[bj][q];
                    if (swa) { const float* cs = rope + (size_t)row * 64 + 8 * fq;
                        const pg8::f32x4 c0 = *(const pg8::f32x4*)cs, c1 = *(const pg8::f32x4*)(cs + 4), s0 = *(const pg8::f32x4*)(cs + 32), s1 = *(const pg8::f32x4*)(cs + 36);
                        const float cc[8] = {c0[0], c0[1], c0[2], c0[3], c1[0], c1[1], c1[2], c1[3]}, sn[8] = {s0[0], s0[1], s0[2], s0[3], s1[0], s1[1], s1[2], s1[3]};
#pragma unroll
                        for (int q = 0; q < 8; ++q) { const float x1 = x[0][q], x2 = x[1][q]; x[0][q] = x1 * cc[q] - x2 * sn[q]; x[1][q] = x2 * cc[q] + x1 * sn[q]; } }
                    bf16* rowp = QKV + (size_t)row * QKVW + u.pn * 256 + 64 * wc + 8 * fq;
#pragma unroll
                    for (int bj = 0; bj < 2; ++bj) { u32x4 w; w.x = cvt_pk_bf16(x[bj][0], x[bj][1]); w.y = cvt_pk_bf16(x[bj][2], x[bj][3]); w.z = cvt_pk_bf16(x[bj][4], x[bj][5]); w.w = cvt_pk_bf16(x[bj][6], x[bj][7]);
                        *(u32x4*)(rowp + 32 * bj) = w; } }
            return;
        }
        const int row0 = u.pm * 256 + wr * 64 + fr;
        bf16* base; int ldc, colt; bool sg = false;
        if (u.kind) { base = MKV; ldc = 1024; colt = u.pn * 256; }
        else if (u.pn < 16) { base = QKV; ldc = QKVW; colt = u.pn * 256; }
        else { base = Gt; ldc = GW; colt = (u.pn - 16) * 256; sg = true; }
        const int col0 = colt + wc * 32 + 8 * fq;
#pragma unroll
        for (int ai = 0; ai < 2; ++ai)
#pragma unroll
            for (int m = 0; m < 4; ++m) { bf16* rowp = base + (size_t)(row0 + ai * 128 + m * 16) * ldc + col0;
#pragma unroll
                for (int bj = 0; bj < 2; ++bj) { pg8::f32x4 v0 = acc[ai][bj][m][0], v1 = acc[ai][bj][m][1];
                    if (sg) {
#pragma unroll
                        for (int q = 0; q < 4; ++q) { v0[q] = sigmoidf_(fmaxf(v0[q], -30.f)); v1[q] = sigmoidf_(fmaxf(v1[q], -30.f)); } }
                    u32x4 w; w.x = cvt_pk_bf16(v0[0], v0[1]); w.y = cvt_pk_bf16(v0[2], v0[3]); w.z = cvt_pk_bf16(v1[0], v1[1]); w.w = cvt_pk_bf16(v1[2], v1[3]);
                    *(u32x4*)(rowp + bj * 128) = w; } }
    }
};
#ifndef PROBE_GASM
#define PROBE_GASM true
#endif
struct EpiGates {
    static constexpr bool PERM = true, MID = false, FP8 = true, ASM_MFMA = PROBE_GASM, BTILED = true; static constexpr int SCALE_A = 127 - H8_SHIFT, SCALE_B = 127 - W8_SHIFT;
    bf16* Gt;
    __device__ __forceinline__ void mid(pg8::f32x4 (&)[2][2][4][2], const Unit&, int, int, int, int, int) const {}
    __device__ __forceinline__ void operator()(const pg8::f32x4 (&acc)[2][2][4][2], const Unit& u, int wr, int wc, int fr, int fq) const {
        asm volatile("" : "+v"(fr), "+v"(fq));
        const int row0 = u.pm * 256 + wr * 64 + fr, col0 = u.pn * 256 + wc * 32 + 8 * fq;
#pragma unroll
        for (int ai = 0; ai < 2; ++ai)
#pragma unroll
            for (int m = 0; m < 4; ++m) { bf16* rowp = Gt + (size_t)(row0 + ai * 128 + m * 16) * GW + col0;
#pragma unroll
                for (int bj = 0; bj < 2; ++bj) { unsigned wv[4];
#pragma unroll
                    for (int n = 0; n < 2; ++n)
#pragma unroll
                        for (int hq = 0; hq < 2; ++hq) { typedef pg8::f32x2 f2;
                            f2 x = {fmaxf(acc[ai][bj][m][n][2 * hq], -30.f), fmaxf(acc[ai][bj][m][n][2 * hq + 1], -30.f)};
                            const f2 t = x * (-LOG2E); f2 e; e.x = __builtin_amdgcn_exp2f(t.x); e.y = __builtin_amdgcn_exp2f(t.y);
                            const f2 d = e + 1.0f; wv[2 * n + hq] = cvt_pk_bf16(__builtin_amdgcn_rcpf(d.x), __builtin_amdgcn_rcpf(d.y)); }
                    u32x4 w; w.x = wv[0]; w.y = wv[1]; w.z = wv[2]; w.w = wv[3];
                    *(u32x4*)(rowp + bj * 128) = w; } }
    }
};
struct EpiMerge {
    static constexpr bool PERM = true, MID = true, FP8 = false, ASM_MFMA = false, BTILED = false; static constexpr int SCALE_A = 0x7f, SCALE_B = 0x7f;
    const bf16* Gt; bf16* O;
    __device__ __forceinline__ void mid(pg8::f32x4 (&acc)[2][2][4][2], const Unit& u, int which, int wr, int wc, int fr, int fq) const {
        asm volatile("" : "+v"(fr), "+v"(fq));
        const int row0 = u.pm * 256 + wr * 64 + fr, col0 = u.pn * 256 + wc * 32 + 8 * fq;
        const bf16* gn = Gt + (which ? 2048 : 0); const bf16* gd = Gt + (which ? 4096 : 2048);
#pragma unroll
        for (int ai = 0; ai < 2; ++ai)
#pragma unroll
            for (int m = 0; m < 4; ++m) { const size_t ro = (size_t)(row0 + ai * 128 + m * 16) * GW + col0;
#pragma unroll
                for (int bj = 0; bj < 2; ++bj) { const u32x4 a = *(const u32x4*)(gn + ro + bj * 128), b = *(const u32x4*)(gd + ro + bj * 128);
                    pg8::f32x4 r0, r1;
                    r0[0] = bf_lo(a.x) * __builtin_amdgcn_rcpf(bf_lo(b.x)); r0[1] = bf_hi(a.x) * __builtin_amdgcn_rcpf(bf_hi(b.x)); r0[2] = bf_lo(a.y) * __builtin_amdgcn_rcpf(bf_lo(b.y)); r0[3] = bf_hi(a.y) * __builtin_amdgcn_rcpf(bf_hi(b.y));
                    r1[0] = bf_lo(a.z) * __builtin_amdgcn_rcpf(bf_lo(b.z)); r1[1] = bf_hi(a.z) * __builtin_amdgcn_rcpf(bf_hi(b.z)); r1[2] = bf_lo(a.w) * __builtin_amdgcn_rcpf(bf_lo(b.w)); r1[3] = bf_hi(a.w) * __builtin_amdgcn_rcpf(bf_hi(b.w));
                    acc[ai][bj][m][0] *= r0; acc[ai][bj][m][1] *= r1; }
                asm volatile("" : "+v"(acc[ai][0][m][0]), "+v"(acc[ai][0][m][1]), "+v"(acc[ai][1][m][0]), "+v"(acc[ai][1][m][1]));
                asm volatile("" ::: "memory"); }
    }
    __device__ __forceinline__ void operator()(const pg8::f32x4 (&acc)[2][2][4][2], const Unit& u, int wr, int wc, int fr, int fq) const {
        asm volatile("" : "+v"(fr), "+v"(fq));
        const int row0 = u.pm * 256 + wr * 64 + fr, col0 = u.pn * 256 + wc * 32 + 8 * fq;
#pragma unroll
        for (int ai = 0; ai < 2; ++ai)
#pragma unroll
            for (int m = 0; m < 4; ++m) { const size_t rr = (size_t)(row0 + ai * 128 + m * 16);
#pragma unroll
                for (int bj = 0; bj < 2; ++bj) { const u32x4 g = *(const u32x4*)(Gt + rr * GW + 4096 + col0 + bj * 128);
                    const pg8::f32x4 v0 = acc[ai][bj][m][0], v1 = acc[ai][bj][m][1];
                    u32x4 w; w.x = cvt_pk_bf16(v0[0] * bf_lo(g.x), v0[1] * bf_hi(g.x)); w.y = cvt_pk_bf16(v0[2] * bf_lo(g.y), v0[3] * bf_hi(g.y));
                    w.z = cvt_pk_bf16(v1[0] * bf_lo(g.z), v1[1] * bf_hi(g.z)); w.w = cvt_pk_bf16(v1[2] * bf_lo(g.w), v1[3] * bf_hi(g.w));
                    *(u32x4*)(O + rr * DM + col0 + bj * 128) = w; }
                asm volatile("" ::: "memory"); }
    }
};
struct EpiOut {
    static constexpr bool PERM = true, MID = false, FP8 = false, ASM_MFMA = false, BTILED = false; static constexpr int SCALE_A = 0x7f, SCALE_B = 0x7f;
    const float* X; float* out; unsigned char* HB8; int noop;
    __device__ __forceinline__ void mid(pg8::f32x4 (&)[2][2][4][2], const Unit&, int, int, int, int, int) const {}
    __device__ __forceinline__ void operator()(const pg8::f32x4 (&acc)[2][2][4][2], const Unit& u, int wr, int wc, int fr, int fq) const {
        asm volatile("" : "+v"(fr), "+v"(fq));
        if (noop) return;
        const int row0 = u.pm * 256 + wr * 64 + fr, col0 = u.pn * 256 + wc * 32 + 8 * fq;
#pragma unroll
        for (int ai = 0; ai < 2; ++ai)
#pragma unroll
            for (int mp = 0; mp < 2; ++mp) {
                pg8::f32x4 xv[2][2][2];
#pragma unroll
                for (int mm = 0; mm < 2; ++mm) { const size_t off = (size_t)(row0 + ai * 128 + (2 * mp + mm) * 16) * DM + col0;
#pragma unroll
                    for (int bj = 0; bj < 2; ++bj) { xv[mm][bj][0] = *(const pg8::f32x4*)(X + off + bj * 128); xv[mm][bj][1] = *(const pg8::f32x4*)(X + off + bj * 128 + 4); } }
#pragma unroll
                for (int mm = 0; mm < 2; ++mm) { const int m = 2 * mp + mm; const size_t off = (size_t)(row0 + ai * 128 + m * 16) * DM + col0;
#pragma unroll
                    for (int bj = 0; bj < 2; ++bj) { const pg8::f32x4 h0 = xv[mm][bj][0] + acc[ai][bj][m][0], h1 = xv[mm][bj][1] + acc[ai][bj][m][1];
                        *(pg8::f32x4*)(out + off + bj * 128) = h0; *(pg8::f32x4*)(out + off + bj * 128 + 4) = h1;
                        u32x2 w; w.x = pk4_fp8(h0[0] * H8_MUL, h0[1] * H8_MUL, h0[2] * H8_MUL, h0[3] * H8_MUL); w.y = pk4_fp8(h1[0] * H8_MUL, h1[1] * H8_MUL, h1[2] * H8_MUL, h1[3] * H8_MUL);
                        *(u32x2*)(HB8 + off + bj * 128) = w; } }
                asm volatile("" ::: "memory");
            }
    }
};
struct EpiGateUp {
    static constexpr bool PERM = true, MID = false, FP8 = true, ASM_MFMA = true, BTILED = true; static constexpr int SCALE_A = 127 - H8_SHIFT, SCALE_B = 127 - W8_SHIFT;
    const float* RS; const float* bgu; unsigned char* ACT8;
    __device__ __forceinline__ void mid(pg8::f32x4 (&)[2][2][4][2], const Unit&, int, int, int, int, int) const {}
    __device__ __forceinline__ void operator()(const pg8::f32x4 (&acc)[2][2][4][2], const Unit& u, int wr, int wc, int fr, int fq) const {
        asm volatile("" : "+v"(fr), "+v"(fq));
        const int r0 = wr * 64 + fr, hc0 = u.pn * 128 + wc * 32 + 8 * fq;
        const float* bg = bgu + (size_t)u.e * 4096 + hc0;
        const pg8::f32x4 bg0 = *(const pg8::f32x4*)(bg), bg1 = *(const pg8::f32x4*)(bg + 4), bu0 = *(const pg8::f32x4*)(bg + 2048), bu1 = *(const pg8::f32x4*)(bg + 2052);
        float rsv[2][4];
#pragma unroll
        for (int ai = 0; ai < 2; ++ai)
#pragma unroll
            for (int m = 0; m < 4; ++m) rsv[ai][m] = RS[u.e * CAP + 256 * u.pm + r0 + ai * 128 + m * 16];
#pragma unroll
        for (int ai = 0; ai < 2; ++ai)
#pragma unroll
            for (int m = 0; m < 4; ++m) { const int rl = r0 + ai * 128 + m * 16;
                const float rs = rsv[ai][m];
                typedef pg8::f32x2 f2;
                f2 a2[4];
#pragma unroll
                for (int n = 0; n < 2; ++n)
#pragma unroll
                    for (int hq = 0; hq < 2; ++hq) {
                        const f2 ag = {acc[ai][0][m][n][2 * hq], acc[ai][0][m][n][2 * hq + 1]}, au = {acc[ai][1][m][n][2 * hq], acc[ai][1][m][n][2 * hq + 1]};
                        const f2 bgv = n ? (f2){bg1[2 * hq], bg1[2 * hq + 1]} : (f2){bg0[2 * hq], bg0[2 * hq + 1]}, buv = n ? (f2){bu1[2 * hq], bu1[2 * hq + 1]} : (f2){bu0[2 * hq], bu0[2 * hq + 1]};
                        f2 g = ag * rs + bgv, up = au * rs + buv;
                        g.x = fminf(g.x, SWIGLU_LIMIT); g.y = fminf(g.y, SWIGLU_LIMIT);
                        up.x = __builtin_amdgcn_fmed3f(up.x, -SWIGLU_LIMIT, SWIGLU_LIMIT); up.y = __builtin_amdgcn_fmed3f(up.y, -SWIGLU_LIMIT, SWIGLU_LIMIT);
                        const f2 t = g * (-SWIGLU_ALPHA * LOG2E);
                        f2 e; e.x = __builtin_amdgcn_exp2f(t.x); e.y = __builtin_amdgcn_exp2f(t.y);
                        const f2 d = e + 1.0f;
                        f2 r; r.x = __builtin_amdgcn_rcpf(d.x); r.y = __builtin_amdgcn_rcpf(d.y);
                        const f2 sg = (g * ACT8_MUL) * r;
                        a2[2 * n + hq] = up * sg + sg;
                    }
                u32x2 w;
                { int p0 = __builtin_amdgcn_cvt_pk_fp8_f32(a2[0].x, a2[0].y, 0, false); p0 = __builtin_amdgcn_cvt_pk_fp8_f32(a2[1].x, a2[1].y, p0, true); w.x = (unsigned)p0;
                  int p1 = __builtin_amdgcn_cvt_pk_fp8_f32(a2[2].x, a2[2].y, 0, false); p1 = __builtin_amdgcn_cvt_pk_fp8_f32(a2[3].x, a2[3].y, p1, true); w.y = (unsigned)p1; }
                *(u32x2*)(ACT8 + (size_t)(u.kind + rl) * DM + hc0) = w; }
    }
};
struct EpiDown {
    static constexpr bool PERM = true, MID = false, FP8 = true, ASM_MFMA = true, BTILED = true; static constexpr int SCALE_A = 127 - ACT8_SHIFT, SCALE_B = 127 - W8_SHIFT;
    const float* bd; bf16* Y; int noop;
    __device__ __forceinline__ void mid(pg8::f32x4 (&)[2][2][4][2], const Unit&, int, int, int, int, int) const {}
    __device__ __forceinline__ void operator()(const pg8::f32x4 (&acc)[2][2][4][2], const Unit& u, int wr, int wc, int fr, int fq) const {
        asm volatile("" : "+v"(fr), "+v"(fq));
        if (noop) return;
        const int r0 = wr * 64 + fr, col0 = u.pn * 256 + wc * 32 + 8 * fq;
        const float* bb = bd + (size_t)u.e * DM + col0;
        pg8::f32x4 bv[2][2];
#pragma unroll
        for (int bj = 0; bj < 2; ++bj)
#pragma unroll
            for (int n = 0; n < 2; ++n) bv[bj][n] = *(const pg8::f32x4*)(bb + bj * 128 + n * 4);
#pragma unroll
        for (int ai = 0; ai < 2; ++ai)
#pragma unroll
            for (int m = 0; m < 4; ++m) { bf16* rowp = Y + (size_t)(u.kind + r0 + ai * 128 + m * 16) * DM + col0;
#pragma unroll
                for (int bj = 0; bj < 2; ++bj) { const pg8::f32x4 v0 = acc[ai][bj][m][0] + bv[bj][0], v1 = acc[ai][bj][m][1] + bv[bj][1];
                    u32x4 w; w.x = cvt_pk_bf16(v0[0], v0[1]); w.y = cvt_pk_bf16(v0[2], v0[3]); w.z = cvt_pk_bf16(v1[0], v1[1]); w.w = cvt_pk_bf16(v1[2], v1[3]);
                    *(u32x4*)(rowp + bj * 128) = w; } }
    }
};

__device__ __forceinline__ void logf_cumsum(const Ctx& C) {
    LAS float* wt = (LAS float*)(C.lds + RING_OFF);
    for (int sq = (int)blockIdx.x; sq < BATCH * 12; sq += C.G) {
        const float* src = C.LOGF + (size_t)sq * SEQ + C.tid * 16; float* dst = C.CNEG + (size_t)sq * SEQ + C.tid * 16;
        f32x4 a[4]; float tot = 0.f;
#pragma unroll
        for (int j = 0; j < 4; ++j) { a[j] = *(const GAS f32x4*)(src + 4 * j); tot += (a[j].x + a[j].y) + (a[j].z + a[j].w); }
        float incl = tot;
#pragma unroll
        for (int o = 1; o < 64; o <<= 1) { const float n = __shfl_up(incl, o); if (C.lane >= o) incl += n; }
        if (C.lane == 63) wt[C.wave] = incl;
        __syncthreads();
        float run = incl - tot;
        for (int w = 0; w < C.wave; ++w) run += wt[w];
#pragma unroll
        for (int j = 0; j < 4; ++j) { f32x4 c; run += a[j].x; c.x = -run * LOG2E; run += a[j].y; c.y = -run * LOG2E; run += a[j].z; c.z = -run * LOG2E; run += a[j].w; c.w = -run * LOG2E; *(GAS f32x4*)(dst + 4 * j) = c; }
        __syncthreads();
    }
}

#ifndef CONV_FIRST_QUARTERS
#define CONV_FIRST_QUARTERS 2
#endif
namespace att {
typedef __attribute__((address_space(3))) const char* lds_cptr;
__device__ __forceinline__ void glds16(const void* gsrc, unsigned lds_dst) { unsigned keep;
    asm volatile("s_mov_b32 %0, m0\n\ts_mov_b32 m0, %2\n\ts_nop 0\n\tglobal_load_lds_dwordx4 %1, off\n\ts_mov_b32 m0, %0" : "=&s"(keep) : "v"(gsrc), "s"(lds_dst) : "memory"); }
typedef float f32x2_t __attribute__((ext_vector_type(2))); typedef __bf16 bf16x2_t __attribute__((ext_vector_type(2)));
__device__ __forceinline__ unsigned cvtpk_s(float lo, float hi) { f32x2_t v = {lo, hi}; bf16x2_t b = __builtin_convertvector(v, bf16x2_t); return __builtin_bit_cast(unsigned, b); }
__device__ __forceinline__ int crow(int r, int hi) { return (r & 3) + 8 * (r >> 2) + 4 * hi; }

template <int D> struct Geo {
    static constexpr int SLOTB = 64 * D * 2, NSLOT = (D == 64) ? 3 : 2, PPT = (D == 64) ? 2 : 4;
    static constexpr int LDS_K = 0, LDS_V = NSLOT * SLOTB, LDS_WS = 2 * NSLOT * SLOTB, LDS_WMIN = LDS_WS + 2048, LDS_OST = LDS_WMIN + 64, LDS_CB = LDS_OST + 8 * 4096, LDS_END = LDS_CB + 32768;
};

template <int D>
__device__ __forceinline__ void qkt(f32x16& p0, f32x16& p1, lds_cptr Kslot, const bf16x8* qr, int r32, int hi) {
    lds_cptr kb = Kslot + hi * 1024 + r32 * 16;
    p0 = f32x16{}; p1 = f32x16{};
#pragma unroll
    for (int d0 = 0; d0 < D / 16; ++d0) {
        const bf16x8 b0 = *(const LAS bf16x8*)(kb + d0 * 2048);
        const bf16x8 b1 = *(const LAS bf16x8*)(kb + d0 * 2048 + 512);
        p0 = __builtin_amdgcn_mfma_f32_32x32x16_bf16(b0, qr[d0], p0, 0, 0, 0); p1 = __builtin_amdgcn_mfma_f32_32x32x16_bf16(b1, qr[d0], p1, 0, 0, 0); }
}
template <int D>
__device__ __forceinline__ void pv(f32x16* o, int vb, bf16x8 pa0, bf16x8 pa1, bf16x8 pa2, bf16x8 pa3) {
#pragma unroll
    for (int d0 = 0; d0 < D / 32; ++d0) { s16x4 lo[4], hi[4];
#pragma unroll
        for (int ks = 0; ks < 4; ++ks) {
            asm volatile("ds_read_b64_tr_b16 %0,%1 offset:%c2" : "=&v"(lo[ks]) : "v"(vb), "i"(d0 * 4096 + ks * 1024) : "memory");
            asm volatile("ds_read_b64_tr_b16 %0,%1 offset:%c2" : "=&v"(hi[ks]) : "v"(vb), "i"(d0 * 4096 + ks * 1024 + 512) : "memory"); }
        asm volatile("s_waitcnt lgkmcnt(0)" ::: "memory"); __builtin_amdgcn_sched_barrier(0);
#define ATT_PK(k) (bf16x8){lo[k][0], lo[k][1], lo[k][2], lo[k][3], hi[k][0], hi[k][1], hi[k][2], hi[k][3]}
        o[d0] = __builtin_amdgcn_mfma_f32_32x32x16_bf16(pa0, ATT_PK(0), o[d0], 0, 0, 0);
        o[d0] = __builtin_amdgcn_mfma_f32_32x32x16_bf16(pa1, ATT_PK(1), o[d0], 0, 0, 0);
        o[d0] = __builtin_amdgcn_mfma_f32_32x32x16_bf16(pa2, ATT_PK(2), o[d0], 0, 0, 0);
        o[d0] = __builtin_amdgcn_mfma_f32_32x32x16_bf16(pa3, ATT_PK(3), o[d0], 0, 0, 0);
#undef ATT_PK
    }
}

template <int D, int MODE>
__device__ __forceinline__ void attn_unit(LAS unsigned char* shm, const bf16* Q, int pitchQ, const bf16* K, const bf16* V, int pitchKV, bf16* O, const float* cneg, float sink2, int qb, const float* qgain, const float* kgain, const float* ropet, float bqk = 0.f) {
    typedef Geo<D> G;
    int tid = threadIdx.x; asm volatile("" : "+v"(tid));
    const int lane = tid & 63, r32 = lane & 31, hi = lane >> 5; const int wid = __builtin_amdgcn_readfirstlane(tid >> 6);
    const int q0 = qb * 256, q0w = q0 + wid * 32;
    const unsigned lds0 = (unsigned)(uintptr_t)shm;
    LAS float* wsf = (LAS float*)(shm + G::LDS_WS) + wid * 64;
    LAS float* cb = (LAS float*)(shm + G::LDS_CB);
    const int j_lo = (MODE == 1) ? (qb > 0 ? 4 * qb - 2 : 0) : 0, j_hi = (MODE == 2) ? 4 : 4 * qb + 4;
    bf16x8 qr[D / 16];
    { const bf16* Qw = Q + (size_t)(q0w + r32) * pitchQ + hi * 8;
#pragma unroll
      for (int d0 = 0; d0 < D / 16; ++d0) qr[d0] = *(const GAS bf16x8*)(Qw + d0 * 16); }
    {
#define ATT_UNPK(dst, src) do { const v4u w_ = __builtin_bit_cast(v4u, src); dst[0] = pg8::bf_lo(w_.x); dst[1] = pg8::bf_hi(w_.x); dst[2] = pg8::bf_lo(w_.y); dst[3] = pg8::bf_hi(w_.y); dst[4] = pg8::bf_lo(w_.z); dst[5] = pg8::bf_hi(w_.z); dst[6] = pg8::bf_lo(w_.w); dst[7] = pg8::bf_hi(w_.w); } while (0)
#define ATT_PK8(dst, src) do { v4u w_; w_.x = cvtpk_s(src[0], src[1]); w_.y = cvtpk_s(src[2], src[3]); w_.z = cvtpk_s(src[4], src[5]); w_.w = cvtpk_s(src[6], src[7]); dst = __builtin_bit_cast(bf16x8, w_); } while (0)
        float ss = 0.f;
#pragma unroll
        for (int d0 = 0; d0 < D / 16; ++d0) { float t[8]; ATT_UNPK(t, qr[d0]);
#pragma unroll
            for (int j = 0; j < 8; ++j) ss += t[j] * t[j]; }
        { auto rr = __builtin_amdgcn_permlane32_swap(__float_as_uint(ss), __float_as_uint(ss), false, false); ss = __uint_as_float(rr[0]) + __uint_as_float(rr[1]); }
        const float rq = (1.0f / sqrtf(ss * (1.f / D) + NORM_EPS)) * ((D == 64 ? 0.125f : 0.08838834764831845f) * LOG2E);
        if constexpr (MODE == 1) {
            const float* cs = ropet + (size_t)(q0w + r32) * 64 + 8 * hi;
#pragma unroll
            for (int d0 = 0; d0 < 2; ++d0) { float x1[8], x2[8]; ATT_UNPK(x1, qr[d0]); ATT_UNPK(x2, qr[d0 + 2]);
                const float* g1 = qgain + 16 * d0 + 8 * hi;
                const f32x4 ga = *(const GAS f32x4*)g1, gb = *(const GAS f32x4*)(g1 + 4), gc = *(const GAS f32x4*)(g1 + 32), gd = *(const GAS f32x4*)(g1 + 36);
                const f32x4 c0 = *(const GAS f32x4*)(cs + 16 * d0), c1 = *(const GAS f32x4*)(cs + 16 * d0 + 4), s0 = *(const GAS f32x4*)(cs + 32 + 16 * d0), s1 = *(const GAS f32x4*)(cs + 36 + 16 * d0);
                const float gg1[8] = {ga.x, ga.y, ga.z, ga.w, gb.x, gb.y, gb.z, gb.w}, gg2[8] = {gc.x, gc.y, gc.z, gc.w, gd.x, gd.y, gd.z, gd.w};
                const float cc[8] = {c0.x, c0.y, c0.z, c0.w, c1.x, c1.y, c1.z, c1.w}, sn[8] = {s0.x, s0.y, s0.z, s0.w, s1.x, s1.y, s1.z, s1.w};
#pragma unroll
                for (int j = 0; j < 8; ++j) { const float a = (x1[j] * rq) * gg1[j], b = (x2[j] * rq) * gg2[j]; x1[j] = a * cc[j] - b * sn[j]; x2[j] = b * cc[j] + a * sn[j]; }
                ATT_PK8(qr[d0], x1); ATT_PK8(qr[d0 + 2], x2); asm volatile("" ::: "memory"); }
        } else {
#pragma unroll
            for (int d0 = 0; d0 < D / 16; ++d0) { float t[8]; ATT_UNPK(t, qr[d0]);
                const float* gp = qgain + 16 * d0 + 8 * hi; f32x4 ga = *(const GAS f32x4*)gp, gb = *(const GAS f32x4*)(gp + 4);
                if constexpr (MODE == 2) { ga = ga * *(const GAS f32x4*)(kgain + 16 * d0 + 8 * hi); gb = gb * *(const GAS f32x4*)(kgain + 16 * d0 + 8 * hi + 4); }
                t[0] = (t[0] * rq) * ga.x; t[1] = (t[1] * rq) * ga.y; t[2] = (t[2] * rq) * ga.z; t[3] = (t[3] * rq) * ga.w; t[4] = (t[4] * rq) * gb.x; t[5] = (t[5] * rq) * gb.y; t[6] = (t[6] * rq) * gb.z; t[7] = (t[7] * rq) * gb.w;
                ATT_PK8(qr[d0], t); asm volatile("" ::: "memory"); }
        }
#undef ATT_UNPK
#undef ATT_PK8
    }
    if constexpr (MODE == 2) {
        const int key = tid >> 1, hf = tid & 1; const bf16* kp = K + (size_t)key * pitchKV + 64 * hf; float ss = 0.f;
#pragma unroll
        for (int c = 0; c < 8; ++c) { const v4u w = *(const GAS v4u*)(kp + 8 * c); const float a0 = pg8::bf_lo(w.x), a1 = pg8::bf_hi(w.x), a2 = pg8::bf_lo(w.y), a3 = pg8::bf_hi(w.y), a4 = pg8::bf_lo(w.z), a5 = pg8::bf_hi(w.z), a6 = pg8::bf_lo(w.w), a7 = pg8::bf_hi(w.w);
            ss += (a0 * a0 + a1 * a1) + (a2 * a2 + a3 * a3) + (a4 * a4 + a5 * a5) + (a6 * a6 + a7 * a7); }
        ss += __shfl_xor(ss, 1);
        if (hf == 0) cb[key] = 1.0f / sqrtf(ss * (1.f / 128.f) + NORM_EPS);
    }
    if constexpr (MODE == 0) {
        const int nch = (q0 + 256) / 4;
        for (int c = tid; c < nch; c += 512) { const f32x4 v = *(const GAS f32x4*)(cneg + 4 * c); *(LAS f32x4*)(cb + 4 * c) = v; }
    }
#define ATT_DMA(j, slot) do { const int _s = (slot) * G::SLOTB; \
        if constexpr (D == 64) { \
            glds16(K + (size_t)(64 * (j) + lane) * pitchKV + wid * 8, (unsigned)__builtin_amdgcn_readfirstlane(lds0 + G::LDS_K + _s + wid * 1024)); \
            glds16(V + (size_t)(64 * (j) + 16 * (wid & 3) + (lane >> 2)) * pitchKV + (wid >> 2) * 32 + (lane & 3) * 8, (unsigned)__builtin_amdgcn_readfirstlane(lds0 + G::LDS_V + _s + wid * 1024)); \
        } else { \
            _Pragma("unroll") for (int _p = 0; _p < 2; ++_p) { const int _c = wid + 8 * _p; \
                glds16(K + (size_t)(64 * (j) + lane) * pitchKV + _c * 8, (unsigned)__builtin_amdgcn_readfirstlane(lds0 + G::LDS_K + _s + _c * 1024)); } \
            _Pragma("unroll") for (int _p = 0; _p < 2; ++_p) { const int _c = wid + 8 * _p; \
                glds16(V + (size_t)(64 * (j) + 16 * (_c & 3) + (lane >> 2)) * pitchKV + (_c >> 2) * 32 + (lane & 3) * 8, (unsigned)__builtin_amdgcn_readfirstlane(lds0 + G::LDS_V + _s + _c * 1024)); } \
        } } while (0)
    int slot_i = 0;
    constexpr bool REV = (MODE == 0);
    const int nst = j_hi - j_lo;
#define ATT_TILE(st_) (REV ? (j_hi - 1 - (st_)) : (j_lo + (st_)))
#pragma unroll
    for (int p = 0; p < G::NSLOT - 1; ++p) if (p < nst) ATT_DMA(ATT_TILE(p), p);
    float mhat = -1e30f, l_reg = 0.f; f32x16 o[D / 32];
#pragma unroll
    for (int d0 = 0; d0 < D / 32; ++d0) o[d0] = f32x16{};
    const lds_cptr shm3 = (lds_cptr)shm;
    const int vb0 = (int)(lds0 + G::LDS_V) + ((lane >> 4) & 1) * 32 + (lane & 3) * 8 + (4 * hi + ((lane & 15) >> 2)) * 64;
    const int qabs = q0w + r32;
    LAS float* wmin = (LAS float*)(shm + G::LDS_WMIN);
    for (int st = 0; st < nst; ++st) {
        const int j = ATT_TILE(st);
        if (G::NSLOT == 3 && st + 1 < nst) { if constexpr (G::PPT == 2) asm volatile("s_waitcnt vmcnt(2) lgkmcnt(0)\n\ts_barrier" ::: "memory"); else asm volatile("s_waitcnt vmcnt(4) lgkmcnt(0)\n\ts_barrier" ::: "memory"); }
        else asm volatile("s_waitcnt vmcnt(0) lgkmcnt(0)\n\ts_barrier" ::: "memory");
        if constexpr (MODE == 0) { if (st >= 5) {
            const LAS float* wm = wmin + ((st - 1) & 1) * 8; const f32x4 a = *(const LAS f32x4*)wm, b = *(const LAS f32x4*)(wm + 4);
            const float gmin = fminf(fminf(fminf(a.x, a.y), fminf(a.z, a.w)), fminf(fminf(b.x, b.y), fminf(b.z, b.w)));
            if (cb[64 * j + 63] + bqk < gmin - 40.0f) break; } }
        { const int sn_ = st + G::NSLOT - 1; if (sn_ < nst) { int sn = slot_i + G::NSLOT - 1; if (sn >= G::NSLOT) sn -= G::NSLOT; ATT_DMA(ATT_TILE(sn_), sn); } }
        bool need = true;
        if constexpr (MODE == 0) need = (64 * j <= q0w + 31);
        if constexpr (MODE == 1) need = (64 * j <= q0w + 31) && (64 * j + 63 >= q0w - 127);
        if (need) {
            f32x16 p0, p1;
            qkt<D>(p0, p1, shm3 + G::LDS_K + slot_i * G::SLOTB, qr, r32, hi);
            if constexpr (MODE == 2) {
                const LAS float* rkp = cb + 64 * j + 4 * hi;
#pragma unroll
                for (int g = 0; g < 4; ++g) { const f32x4 b0 = *(const LAS f32x4*)(rkp + 8 * g), b1 = *(const LAS f32x4*)(rkp + 32 + 8 * g);
#pragma unroll
                    for (int e = 0; e < 4; ++e) { p0[4 * g + e] *= b0[e]; p1[4 * g + e] *= b1[e]; } }
            }
            if constexpr (MODE == 0) {
                const LAS float* cbp = cb + 64 * j + 4 * hi;
#pragma unroll
                for (int g = 0; g < 4; ++g) { const f32x4 b0 = *(const LAS f32x4*)(cbp + 8 * g), b1 = *(const LAS f32x4*)(cbp + 32 + 8 * g);
#pragma unroll
                    for (int e = 0; e < 4; ++e) { p0[4 * g + e] += b0[e]; p1[4 * g + e] += b1[e]; } }
                if (64 * j + 63 > q0w) {
#pragma unroll
                    for (int r = 0; r < 16; ++r) { const int kv = 64 * j + crow(r, hi); if (kv > qabs) p0[r] = -INFINITY; if (kv + 32 > qabs) p1[r] = -INFINITY; } }
            }
            if constexpr (MODE == 1) {
#pragma unroll
                for (int r = 0; r < 16; ++r) { const int kv = 64 * j + crow(r, hi); const int d0_ = qabs - kv, d1_ = d0_ - 32;
                    if (d0_ < 0 || d0_ >= 128) p0[r] = -INFINITY; if (d1_ < 0 || d1_ >= 128) p1[r] = -INFINITY; }
            }
            float rm = fmaxf(p0[0], p1[0]);
#pragma unroll
            for (int r = 1; r < 16; ++r) rm = fmaxf(rm, fmaxf(p0[r], p1[r]));
            { auto rr = __builtin_amdgcn_permlane32_swap(__float_as_uint(rm), __float_as_uint(rm), false, false); rm = fmaxf(__uint_as_float(rr[0]), __uint_as_float(rr[1])); }
            if (__any(rm > mhat)) {
                const float mn = fmaxf(mhat, rm); const float f = __builtin_amdgcn_exp2f(mhat - mn); mhat = mn; l_reg *= f;
                if (hi == 0) wsf[r32] = f;
                asm volatile("s_waitcnt lgkmcnt(0)" ::: "memory");
#pragma unroll
                for (int g = 0; g < 4; ++g) { const f32x4 fv = *(const LAS f32x4*)(wsf + 8 * g + 4 * hi);
#pragma unroll
                    for (int d_ = 0; d_ < D / 32; ++d_)
#pragma unroll
                        for (int e = 0; e < 4; ++e) o[d_][4 * g + e] *= fv[e]; }
            }
            float sacc = 0.f;
#pragma unroll
            for (int r = 0; r < 16; ++r) { p0[r] = __builtin_amdgcn_exp2f(p0[r] - mhat); p1[r] = __builtin_amdgcn_exp2f(p1[r] - mhat); sacc += p0[r] + p1[r]; }
            l_reg += sacc;
            u32x4 pw0, pw1, pw2, pw3;
            pw0 = (u32x4){cvtpk_s(p0[0], p0[1]), cvtpk_s(p0[2], p0[3]), cvtpk_s(p0[4], p0[5]), cvtpk_s(p0[6], p0[7])};
            pw1 = (u32x4){cvtpk_s(p0[8], p0[9]), cvtpk_s(p0[10], p0[11]), cvtpk_s(p0[12], p0[13]), cvtpk_s(p0[14], p0[15])};
            pw2 = (u32x4){cvtpk_s(p1[0], p1[1]), cvtpk_s(p1[2], p1[3]), cvtpk_s(p1[4], p1[5]), cvtpk_s(p1[6], p1[7])};
            pw3 = (u32x4){cvtpk_s(p1[8], p1[9]), cvtpk_s(p1[10], p1[11]), cvtpk_s(p1[12], p1[13]), cvtpk_s(p1[14], p1[15])};
            pv<D>(o, vb0 + slot_i * G::SLOTB, __builtin_bit_cast(bf16x8, pw0), __builtin_bit_cast(bf16x8, pw1), __builtin_bit_cast(bf16x8, pw2), __builtin_bit_cast(bf16x8, pw3));
        }
        if constexpr (MODE == 0) { float mn = mhat;
#pragma unroll
            for (int of = 1; of < 32; of <<= 1) mn = fminf(mn, __shfl_xor(mn, of));
            if (lane == 0) wmin[(st & 1) * 8 + wid] = mn; }
        ++slot_i; if (slot_i == G::NSLOT) slot_i = 0;
    }
#undef ATT_DMA
#undef ATT_TILE
    if constexpr (MODE == 0) asm volatile("s_waitcnt vmcnt(0)" ::: "memory");
    { auto rr = __builtin_amdgcn_permlane32_swap(__float_as_uint(l_reg), __float_as_uint(l_reg), false, false); l_reg = __uint_as_float(rr[0]) + __uint_as_float(rr[1]); }
    if constexpr (MODE == 1) l_reg += __builtin_amdgcn_exp2f(sink2 - mhat);
    if (hi == 0) wsf[32 + r32] = l_reg;
    asm volatile("s_waitcnt lgkmcnt(0)" ::: "memory");
    float rli[16];
#pragma unroll
    for (int g = 0; g < 4; ++g) { const f32x4 lv = *(const LAS f32x4*)(wsf + 32 + 8 * g + 4 * hi);
#pragma unroll
        for (int e = 0; e < 4; ++e) rli[4 * g + e] = __builtin_amdgcn_rcpf(lv[e]); }
    bf16* Ow = O + (size_t)q0w * 2048;
    LAS bf16* stg = (LAS bf16*)(shm + G::LDS_OST) + wid * 2048;
#pragma unroll
    for (int ps = 0; ps < D / 64; ++ps) {
#pragma unroll
        for (int r = 0; r < 16; ++r) { const int orow = crow(r, hi);
#pragma unroll
            for (int dl = 0; dl < 2; ++dl) stg[orow * 64 + dl * 32 + r32] = (bf16)f2bf(o[2 * ps + dl][r] * rli[r]); }
        asm volatile("s_waitcnt lgkmcnt(0)" ::: "memory");
#pragma unroll
        for (int i = 0; i < 4; ++i) { const int row = i * 8 + (lane >> 3), ch = lane & 7; const v4u v = *(const LAS v4u*)(stg + row * 64 + ch * 8); *(GAS v4u*)(Ow + (size_t)row * 2048 + ps * 64 + ch * 8) = v; }
        asm volatile("s_waitcnt lgkmcnt(0)" ::: "memory");
    }
    asm volatile("s_waitcnt lgkmcnt(0)\n\ts_barrier" ::: "memory");
}
}

constexpr int NU_FOX = BATCH * 12 * 32, NU_SWA = BATCH * 12 * 32, NU_XM = BATCH * 4 * 32;
__device__ __forceinline__ int att_fetch(const Ctx& C, int q) {
    int v = 0; if (C.tid == 0) v = (int)__hip_atomic_fetch_add((unsigned*)(C.ctl + CW_QHEAD + 64 * q), 1u, RLX_AGENT); return v;
}
__device__ __forceinline__ void phase3(const Ctx& C, int sel = 0) {
    LAS unsigned char* shm = C.lds + RING_OFF;
    volatile LAS int* nxtw = (volatile LAS int*)(C.MISC + 12);
    const bool conv_first = CONV_IN_P3 && sel == 0 && (((blockIdx.x >> 3) & 3) < CONV_FIRST_QUARTERS);
    auto run_conv = [&]() {
        if (!(CONV_IN_P3 && (sel == 0 || sel == 8 || (sel == 9 && ((blockIdx.x >> 3) & 1))))) return;
        int pre = att_fetch(C, 3);
        if (C.tid == 0) *nxtw = pre;
        p0_fill_lnorm(C, (LAS float*)(C.lds + RING_OFF + 65536));
        __syncthreads();
        int cur = __builtin_amdgcn_readfirstlane(*nxtw);
        __syncthreads();
        while (cur < CONV_NCHUNK) {
            pre = att_fetch(C, 3);
            conv_chunk(C, cur);
            if (C.tid == 0) *nxtw = pre;
            __syncthreads();
            cur = __builtin_amdgcn_readfirstlane(*nxtw);
            __syncthreads();
        }
    };
    if (conv_first) run_conv();
    if (sel == 0 || sel == 4) {
        float gq = fabsf(C.fox_q_norm[C.lane]), gk = fabsf(C.fox_k_norm[C.lane]);
#pragma unroll
        for (int of = 1; of < 64; of <<= 1) { gq = fmaxf(gq, __shfl_xor(gq, of)); gk = fmaxf(gk, __shfl_xor(gk, of)); }
        const float bqk = 64.0f * gq * gk * (0.125f * LOG2E) * 1.02f;
        int pre = att_fetch(C, 0);
        if (C.tid == 0) *nxtw = pre;
        __syncthreads();
        int cur = __builtin_amdgcn_readfirstlane(*nxtw);
        __syncthreads();
        while (cur < NU_FOX) {
            pre = att_fetch(C, 0);
            const int qb = 31 - cur / 24, bh = cur % 24, b = bh / 12, h = bh % 12;
            const bf16* base = C.QKV + (size_t)b * SEQ * QKVW + h * 64;
            att::attn_unit<64, 0>(shm, base + C_FQ, QKVW, base + C_FK, base + C_FV, QKVW, C.OALL + (size_t)b * SEQ * 2048 + h * 64, C.CNEG + (size_t)(b * 12 + h) * SEQ, 0.f, qb, C.fox_q_norm, nullptr, nullptr, bqk);
            if (C.tid == 0) *nxtw = pre;
            __syncthreads();
            cur = __builtin_amdgcn_readfirstlane(*nxtw);
            __syncthreads();
        }
    }
    if (sel == 0 || sel == 5) {
        int pre = att_fetch(C, 1);
        if (C.tid == 0) *nxtw = pre;
        __syncthreads();
        int cur = __builtin_amdgcn_readfirstlane(*nxtw);
        __syncthreads();
        while (cur < NU_SWA) {
            pre = att_fetch(C, 1);
            const int qb = cur / 24, bh = cur % 24, b = bh / 12, h = bh % 12, kvh = h / 3;
            const bf16* base = C.QKV + (size_t)b * SEQ * QKVW;
            att::attn_unit<64, 1>(shm, base + C_SQ + h * 64, QKVW, base + C_SK + kvh * 64, base + C_SV + kvh * 64, QKVW, C.OALL + (size_t)b * SEQ * 2048 + 768 + h * 64, nullptr, C.swa_sinks[h] * LOG2E, qb, C.swa_q_norm, nullptr, C.ROPE + (size_t)b * SEQ * 64);
            if (C.tid == 0) *nxtw = pre;
            __syncthreads();
            cur = __builtin_amdgcn_readfirstlane(*nxtw);
            __syncthreads();
        }
    }
    if (sel == 0 || sel == 6) {
        int pre = att_fetch(C, 2);
        if (C.tid == 0) *nxtw = pre;
        __syncthreads();
        int cur = __builtin_amdgcn_readfirstlane(*nxtw);
        __syncthreads();
        while (cur < NU_XM) {
            pre = att_fetch(C, 2);
            const int qb = cur / 8, bh = cur % 8, b = bh / 4, h = bh % 4;
            const bf16* kb = C.MKV + (size_t)b * NMEM * 1024 + h * 128;
            att::attn_unit<128, 2>(shm, C.QKV + (size_t)b * SEQ * QKVW + C_MQ + h * 128, QKVW, kb, kb + 512, 1024, C.OALL + (size_t)b * SEQ * 2048 + 1536 + h * 128, nullptr, 0.f, qb, C.xmem_q_norm, C.xmem_k_norm, nullptr);
            if (C.tid == 0) *nxtw = pre;
            __syncthreads();
            cur = __builtin_amdgcn_readfirstlane(*nxtw);
            __syncthreads();
        }
    }
    if (!conv_first) run_conv();
}

__device__ __forceinline__ void phase6(const Ctx& C) {
    LAS float* PL = (LAS float*)(C.lds + RING_OFF);
    LAS float* SS = PL + 4 * 64 * 33;
    LAS int* hist = (LAS int*)(SS + 512);
    LAS int* gb = hist + 32;
    const int rg = C.wave & 1, kq = C.wave >> 1, r32 = C.lane & 31, hi = C.lane >> 5;
    const bf16* wh = C.Wr_t + (size_t)r32 * 2048 + 512 * kq + 16 * hi; const bf16* wl = wh + 32 * 2048;
    for (int blk = C.vcu; blk < T / 64; blk += C.G) {
        if (C.tid < 32) hist[C.tid] = 0;
        const int tok = blk * 64 + 32 * rg + r32;
        const float* hr = C.out + (size_t)tok * DM + 512 * kq + 16 * hi;
        f32x16 acc = f32x16{}; float ss = 0.f;
#pragma unroll 2
        for (int kb = 0; kb < 16; ++kb) {
            float f[16];
#pragma unroll
            for (int q = 0; q < 4; ++q) { const f32x4 t = *(const GAS f32x4*)(hr + 32 * kb + 4 * q); f[4 * q] = t.x; f[4 * q + 1] = t.y; f[4 * q + 2] = t.z; f[4 * q + 3] = t.w; }
            unsigned hb[16], lb[16];
#pragma unroll
            for (int q = 0; q < 16; ++q) { ss += f[q] * f[q]; hb[q] = f2bf(f[q]); lb[q] = f2bf(f[q] - __uint_as_float(hb[q] << 16)); }
#pragma unroll
            for (int s = 0; s < 2; ++s) {
                const bf16x8 ah = *(const GAS bf16x8*)(wh + 32 * kb + 8 * s), al = *(const GAS bf16x8*)(wl + 32 * kb + 8 * s);
                v4u bh, bl;
                bh.x = hb[8 * s] | (hb[8 * s + 1] << 16); bh.y = hb[8 * s + 2] | (hb[8 * s + 3] << 16); bh.z = hb[8 * s + 4] | (hb[8 * s + 5] << 16); bh.w = hb[8 * s + 6] | (hb[8 * s + 7] << 16);
                bl.x = lb[8 * s] | (lb[8 * s + 1] << 16); bl.y = lb[8 * s + 2] | (lb[8 * s + 3] << 16); bl.z = lb[8 * s + 4] | (lb[8 * s + 5] << 16); bl.w = lb[8 * s + 6] | (lb[8 * s + 7] << 16);
                acc = __builtin_amdgcn_mfma_f32_32x32x16_bf16(ah, __builtin_bit_cast(bf16x8, bh), acc, 0, 0, 0);
                acc = __builtin_amdgcn_mfma_f32_32x32x16_bf16(ah, __builtin_bit_cast(bf16x8, bl), acc, 0, 0, 0);
                acc = __builtin_amdgcn_mfma_f32_32x32x16_bf16(al, __builtin_bit_cast(bf16x8, bh), acc, 0, 0, 0);
            }
        }
        { LAS float* pr = PL + (size_t)(kq * 64 + 32 * rg + r32) * 33;
#pragma unroll
          for (int r = 0; r < 16; ++r) pr[att::crow(r, hi)] = acc[r];
          SS[(kq * 2 + hi) * 64 + 32 * rg + r32] = ss; }
        __syncthreads();
        int sel[4]; float gt[4]; float rstd = 0.f; int lr[4];
        if (C.tid < 64) {
            float lv[32]; float s2 = 0.f;
#pragma unroll
            for (int q = 0; q < 8; ++q) s2 += SS[q * 64 + C.tid];
            rstd = 1.0f / sqrtf(s2 * (1.f / DM) + NORM_EPS);
#pragma unroll
            for (int e = 0; e < 32; ++e) { const float a = (PL[(0 * 64 + C.tid) * 33 + e] + PL[(1 * 64 + C.tid) * 33 + e]) + (PL[(2 * 64 + C.tid) * 33 + e] + PL[(3 * 64 + C.tid) * 33 + e]); lv[e] = a * rstd + C.b_router[e]; }
            float val[4];
#pragma unroll
            for (int k = 0; k < 4; ++k) { float best = lv[0]; int bi = 0;
#pragma unroll
                for (int e = 1; e < 32; ++e) if (lv[e] > best) { best = lv[e]; bi = e; }
                sel[k] = bi; val[k] = best;
#pragma unroll
                for (int e = 0; e < 32; ++e) lv[e] = (e == bi) ? -INFINITY : lv[e]; }
            float den = 0.f;
#pragma unroll
            for (int k = 0; k < 4; ++k) { gt[k] = __expf(val[k] - val[0]); den += gt[k]; }
            const float inv = 1.0f / den;
#pragma unroll
            for (int k = 0; k < 4; ++k) { gt[k] *= inv; lr[k] = __hip_atomic_fetch_add((LAS int*)(hist + sel[k]), 1, __ATOMIC_RELAXED, __HIP_MEMORY_SCOPE_WORKGROUP); }
        }
        __syncthreads();
        if (C.tid < 32) gb[C.tid] = (int)__hip_atomic_fetch_add((unsigned*)(C.ctl + CW_CNT + C.tid), (unsigned)hist[C.tid], RLX_AGENT);
        __syncthreads();
        if (C.tid < 64) {
            const int t = blk * 64 + C.tid;
#pragma unroll
            for (int k = 0; k < 4; ++k) { const int sl = sel[k] * CAP + gb[sel[k]] + lr[k]; C.TOK[sl] = t; C.RS[sl] = rstd; C.TSLOT[t * 4 + k] = sl; C.TGATE[t * 4 + k] = gt[k]; }
        }
        __syncthreads();
    }
}
template <int NT>
__device__ __forceinline__ void moe_table(const Ctx& C, LAS int* tab) {
    __syncthreads();
    if (C.tid == 0) { int us = 0, rb = 0;
        for (int e = 0; e < 32; ++e) { const int n = (int)__hip_atomic_load((unsigned*)(C.ctl + CW_CNT + e), RLX_AGENT); const int mt = (n + 255) >> 8; tab[e] = us; tab[33 + e] = mt; tab[65 + e] = rb; tab[97 + e] = n; us += mt * NT; rb += mt * 256; }
        tab[32] = us; }
    __syncthreads();
}


__device__ __forceinline__ void phase9(const Ctx& C, const LAS int* tab) {
    const int gw = C.vcu * NWAVES + C.wave, NGW = C.G * NWAVES;
    for (int t = gw; t < T; t += NGW) {
        typedef int v4i_ __attribute__((ext_vector_type(4))); const v4i_ sl = *(const GAS v4i_*)(C.TSLOT + 4 * t); const f32x4 g = *(const GAS f32x4*)(C.TGATE + 4 * t);
        const int s[4] = {sl.x, sl.y, sl.z, sl.w}; const float gg[4] = {g.x, g.y, g.z, g.w};
        const bf16* yr[4];
#pragma unroll
        for (int k = 0; k < 4; ++k) { const int e = s[k] >> 14, rk = s[k] & (CAP - 1); yr[k] = C.Y + (size_t)(tab[65 + e] + rk) * DM + 8 * C.lane; }
        float* orow = C.out + (size_t)t * DM + 8 * C.lane;
#pragma unroll
        for (int j = 0; j < 4; ++j) {
            f32x4 a0 = *(const GAS f32x4*)(orow + 512 * j), a1 = *(const GAS f32x4*)(orow + 512 * j + 4);
#pragma unroll
            for (int k = 0; k < 4; ++k) { const v4u y = *(const GAS v4u*)(yr[k] + 512 * j);
                a0.x += gg[k] * pg8::bf_lo(y.x); a0.y += gg[k] * pg8::bf_hi(y.x); a0.z += gg[k] * pg8::bf_lo(y.y); a0.w += gg[k] * pg8::bf_hi(y.y);
                a1.x += gg[k] * pg8::bf_lo(y.z); a1.y += gg[k] * pg8::bf_hi(y.z); a1.z += gg[k] * pg8::bf_lo(y.w); a1.w += gg[k] * pg8::bf_hi(y.w); }
            *(GAS f32x4*)(orow + 512 * j) = a0; *(GAS f32x4*)(orow + 512 * j + 4) = a1;
        }
    }
}

struct Args { const void* in[26]; float* out; unsigned char* ws; int ph_lo, ph_hi, probe, pad; };
__global__ void __launch_bounds__(NWAVES * 64, 2) mk_fwd(Args args) {
    extern __shared__ __attribute__((aligned(16))) unsigned char lds_raw[];
    Ctx C;
    C.lds = (LAS unsigned char*)lds_raw;
    C.MISC = (volatile LAS unsigned*)(C.lds + MISC_OFF);
    C.tid = threadIdx.x; C.lane = C.tid & 63; C.wave = __builtin_amdgcn_readfirstlane(C.tid >> 6);
    C.probe = args.probe; C.G = gridDim.x; { const int bx = blockIdx.x; C.vcu = (C.G % 8 == 0) ? (bx % 8) * (C.G / 8) + bx / 8 : bx; }
    unsigned char* ws = args.ws;
    C.ctl = (gu32*)(ws + WS_CTL);
    C.x = (const float*)args.in[0]; C.mem = (const float*)args.in[1]; C.pos = (const int*)args.in[2]; C.norm_mix = (const float*)args.in[3]; C.w_in = (const float*)args.in[4];
    C.b_forget = (const float*)args.in[5]; C.fox_q_norm = (const float*)args.in[6]; C.fox_k_norm = (const float*)args.in[7]; C.swa_q_norm = (const float*)args.in[8]; C.swa_k_norm = (const float*)args.in[9];
    C.swa_sinks = (const float*)args.in[10]; C.xmem_q_norm = (const float*)args.in[11]; C.xmem_k_norm = (const float*)args.in[12]; C.norm_mem = (const float*)args.in[13]; C.w_mem_kv = (const float*)args.in[14];
    C.w_up_fox = (const float*)args.in[15]; C.w_up_swa = (const float*)args.in[16]; C.w_up_xmem = (const float*)args.in[17]; C.w_out = (const float*)args.in[18]; C.norm_ffn = (const float*)args.in[19];
    C.w_router = (const float*)args.in[20]; C.b_router = (const float*)args.in[21]; C.w_gate_up = (const float*)args.in[22]; C.b_gate_up = (const float*)args.in[23]; C.w_down = (const float*)args.in[24]; C.b_down = (const float*)args.in[25];
    C.out = args.out;
#define WS_PTRS() do { unsigned char* w_ = args.ws; asm volatile("" : "+s"(w_)); \
    C.ctl = (gu32*)(w_ + WS_CTL); C.Win_t = (bf16*)(w_ + WS_WIN); C.Wmkv_t = (bf16*)(w_ + WS_WMKV); C.Wup_t = (bf16*)(w_ + WS_WUP); C.Wout_t = (bf16*)(w_ + WS_WOUT); C.Wr_t = (bf16*)(w_ + WS_WRT); C.Wgu_t = (bf16*)(w_ + WS_WGU); C.Wd_t = (bf16*)(w_ + WS_WD); \
    C.XN = (bf16*)(w_ + WS_XN); C.MN = (bf16*)(w_ + WS_MN); C.QKV = (bf16*)(w_ + WS_QKV); C.G_ = (bf16*)(w_ + WS_G); C.MKV = (bf16*)(w_ + WS_MKV); C.OALL = (bf16*)(w_ + WS_OALL); C.MERGED = (bf16*)(w_ + WS_MERGED); \
    C.HB = (bf16*)(w_ + WS_HB); C.ACT = (bf16*)(w_ + WS_ACT); C.LOGF = (float*)(w_ + WS_LOGF); C.CNEG = (float*)(w_ + WS_CNEG); C.ROPE = (float*)(w_ + WS_ROPE); C.GATEW = (float*)(w_ + WS_GATE); C.RS = (float*)(w_ + WS_RS); \
    C.TOK = (int*)(w_ + WS_TOK); C.TSLOT = (int*)(w_ + WS_TSLOT); C.TGATE = (float*)(w_ + WS_TGATE); C.Y = (bf16*)(w_ + WS_Y); C.XN8 = w_ + WS_XN8; C.Win8 = w_ + WS_WIN8; } while (0)
    WS_PTRS();
    for (int u = C.tid; u < (LDS_BYTES - LDSCTL_OFF) / 4; u += NWAVES * 64) ((LAS unsigned*)(C.lds + LDSCTL_OFF))[u] = 0u;
    __syncthreads();
    XcdBarrier bar; bar.bar = (unsigned*)(C.ctl + CW_BAR); bar.x = 0; bar.st = nullptr;
    if (N_LAUNCHES == 1) bar = xcd_barrier_post((unsigned*)(C.ctl + CW_BAR), C.MISC + 8);
    const int lo = args.ph_lo, hi = args.ph_hi;
#ifndef MK_PHASE_MASK
#define MK_PHASE_MASK 0x3FF
#endif
#define IN(k) ((((MK_PHASE_MASK) >> (k)) & 1) && lo <= (k) && (k) < hi)
#define SEAM(k) do { if (IN(k) && IN((k) + 1)) xcd_barrier(bar); } while (0)
    LAS int* tab = (LAS int*)(C.lds + MOE_OFF);

    if (IN(0)) { WS_PTRS(); phase0(C); }
    SEAM(0);
    if (IN(1)) { WS_PTRS();
        logf_cumsum(C);
        P1Order S; S.d.init(C.XN, C.Win_t, T, PROBE_INW * 64, C.G, (int)blockIdx.x); S.A1 = (const char*)C.MN; S.B1 = (const char*)C.Wmkv_t;
        EpiInProj E{C.QKV, C.G_, C.MKV, args.probe == 1, C.fox_k_norm, C.swa_k_norm, C.ROPE};
        if (args.probe != 3) pg8::gemm_phase<EpiInProj, P1Order>(C.lds + RING_OFF, S, E);
        P1bOrder S8; S8.d.init(C.XN8, C.Win8, T, 6144, C.G, (int)blockIdx.x);
#ifdef PROBE_DET
#pragma unroll 1
        for (int rep = 0; rep < 2; ++rep) { EpiGates E8{rep ? C.Y : C.ACT}; pg8::gemm_phase<EpiGates, P1bOrder>(C.lds + RING_OFF, S8, E8); }
#else
#ifdef PROBE_GDUMMY
        EpiGates E8{C.ACT};
#else
        EpiGates E8{C.G_};
#endif
        if (args.probe != 2) pg8::gemm_phase<EpiGates, P1bOrder>(C.lds + RING_OFF, S8, E8);
#endif
    }
    SEAM(1);
    if (IN(3)) { WS_PTRS(); phase3(C, args.probe >= 4 ? args.probe : 0); }
    SEAM(3);
    if (IN(4)) { WS_PTRS();
        DenseOrder S; S.init(C.OALL, C.Wup_t, T, DM, C.G, (int)blockIdx.x);
        EpiMerge E{C.G_, C.MERGED};
        pg8::gemm_phase<EpiMerge, DenseOrder>(C.lds + RING_OFF, S, E);
    }
    SEAM(4);
    if (IN(5)) { WS_PTRS();
        DenseOrder S; S.init(C.MERGED, C.Wout_t, T, DM, C.G, (int)blockIdx.x);
        EpiOut E{C.x, C.out, (unsigned char*)C.HB, args.probe == 1};
        pg8::gemm_phase<EpiOut, DenseOrder, false>(C.lds + RING_OFF, S, E);
    }
    SEAM(5);
    if (IN(6)) { WS_PTRS(); phase6(C); }
    SEAM(6);
    if (IN(7)) { WS_PTRS();
        moe_table<16>(C, tab);
        MoeOrder<true, 16, 2048> S{(const char*)C.HB, (const char*)C.Wgu_t, C.TOK, (const int*)(C.ctl + CW_CNT), tab, C.G, C.vcu};
        EpiGateUp E{C.RS, C.b_gate_up, (unsigned char*)C.ACT};
        pg8::gemm_phase<EpiGateUp, MoeOrder<true, 16, 2048>>(C.lds + RING_OFF, S, E);
    }
    SEAM(7);
    if (IN(8)) { WS_PTRS();
        moe_table<8>(C, tab);
        MoeOrder<false, 8, 2048> S{(const char*)C.ACT, (const char*)C.Wd_t, C.TOK, (const int*)(C.ctl + CW_CNT), tab, C.G, C.vcu};
        EpiDown E{C.b_down, C.Y, args.probe == 1};
        pg8::gemm_phase<EpiDown, MoeOrder<false, 8, 2048>>(C.lds + RING_OFF, S, E);
    }
    SEAM(8);
    if (IN(9)) { WS_PTRS(); moe_table<8>(C, tab); phase9(C, tab);
#ifdef PROBE_DET
        if (blockIdx.x == 0 && C.tid == 0 && __hip_atomic_load((unsigned*)(C.ctl + 2048), RLX_AGENT) != 0u) C.out[12345] = __builtin_nanf("");
#endif
    }
#undef IN
#undef SEAM
}

extern "C" void kernel_launch(void* const* d_in, const int* in_sizes, int n_in, void* d_out, int out_size, void* d_ws, size_t ws_size, hipStream_t stream) {
    static int grid = 0;
    if (grid == 0) {
        if (n_in != 26 || out_size != T * DM || ws_size < WS_END) { fprintf(stderr, "kernel_launch: unexpected problem (n_in %d, out %d, ws %zu < %zu); nothing launched\n", n_in, out_size, ws_size, (size_t)WS_END); grid = -1; return; }
        int dev = 0, cus = 0, per_cu = 0;
        if (hipGetDevice(&dev) != hipSuccess || hipDeviceGetAttribute(&cus, hipDeviceAttributeMultiprocessorCount, dev) != hipSuccess) { grid = -1; return; }
        if (hipFuncSetAttribute((const void*)mk_fwd, hipFuncAttributeMaxDynamicSharedMemorySize, LDS_BYTES) != hipSuccess) { fprintf(stderr, "kernel_launch: hipFuncSetAttribute failed\n"); grid = -1; return; }
        if (hipOccupancyMaxActiveBlocksPerMultiprocessor(&per_cu, (const void*)mk_fwd, NWAVES * 64, LDS_BYTES) != hipSuccess || per_cu < 1) { fprintf(stderr, "kernel_launch: occupancy query says %d\n", per_cu); }
        (void)hipGetLastError();
        grid = cus;
    }
    if (grid < 0) return;
    if (hipMemsetAsync((char*)d_ws + WS_CTL, 0, CTL_ZERO_BYTES, stream) != hipSuccess) return;
#ifdef PROBE_MEMSET8
    hipMemsetAsync((char*)d_ws + WS_XN8, 0, 44 * MiB, stream);
#endif
    Args a{};
    for (int i = 0; i < 26; ++i) a.in[i] = d_in[i];
    a.out = (float*)d_out; a.ws = (unsigned char*)d_ws;
    if (N_LAUNCHES == 1) { a.ph_lo = 0; a.ph_hi = PER_PHASE; hipLaunchKernelGGL(mk_fwd, dim3(grid), dim3(NWAVES * 64), LDS_BYTES, stream, a); }
    else for (int oi = 0; oi < PER_PHASE; ++oi) { static const int order[PER_PHASE] = {0, 1, 2, 3, 4, 5, 6, 7, 8, 9}; const int li = order[oi]; a.ph_lo = li; a.ph_hi = li + 1;
#ifdef PROBE_SPLIT_P1
        if (li == 1) { a.probe = 2; hipLaunchKernelGGL(mk_fwd, dim3(grid), dim3(NWAVES * 64), LDS_BYTES, stream, a); a.probe = 3; hipLaunchKernelGGL(mk_fwd, dim3(grid), dim3(NWAVES * 64), LDS_BYTES, stream, a); a.probe = 0; continue; }
#endif
        hipLaunchKernelGGL(mk_fwd, dim3(grid), dim3(NWAVES * 64), LDS_BYTES, stream, a);
#ifdef PROBE_DUP
        if (li == PROBE_DUP) { if (PROBE_DUP == 3 || PROBE_DUP == 6) hipMemsetAsync((char*)d_ws + WS_CTL, 0, CTL_ZERO_BYTES / 2, stream);
#ifdef PROBE_FLAG
            a.probe = PROBE_FLAG;
#endif
            hipLaunchKernelGGL(mk_fwd, dim3(grid), dim3(NWAVES * 64), LDS_BYTES, stream, a); a.probe = 0; }
#endif
    }
    const hipError_t le = hipPeekAtLastError();
    if (le != hipSuccess) fprintf(stderr, "kernel_launch: launch failed: %s\n", hipGetErrorName(le));
}
```

```cpp
#include <hip/hip_runtime.h>
#include <cstdio>
#include <cstdint>

#define LAS __attribute__((address_space(3)))
#define GAS __attribute__((address_space(1)))

namespace pg8 {
typedef unsigned short bf16_t;
typedef short bf16x8 __attribute__((ext_vector_type(8)));
typedef float f32x4 __attribute__((ext_vector_type(4)));
typedef float f32x2 __attribute__((ext_vector_type(2)));
typedef unsigned u32x4 __attribute__((ext_vector_type(4)));
typedef unsigned u32x2 __attribute__((ext_vector_type(2)));
constexpr int BM = 256, BK = 64, HALF = 128, HTB = HALF * BK * 2, STAGE_BYTES = 8 * HTB, NXCD = 8, WGM = 8;
constexpr int KD = 2048;
typedef int v8i __attribute__((ext_vector_type(8))); typedef int v4i __attribute__((ext_vector_type(4)));
__device__ __forceinline__ v8i cat8(bf16x8 lo, bf16x8 hi) { const v4i a = __builtin_bit_cast(v4i, lo), b = __builtin_bit_cast(v4i, hi); return __builtin_shufflevector(a, b, 0, 1, 2, 3, 4, 5, 6, 7); }
__device__ __forceinline__ bf16x8 lo8(v8i v) { return __builtin_bit_cast(bf16x8, (v4i)__builtin_shufflevector(v, v, 0, 1, 2, 3)); }
__device__ __forceinline__ bf16x8 hi8(v8i v) { return __builtin_bit_cast(bf16x8, (v4i)__builtin_shufflevector(v, v, 4, 5, 6, 7)); }

__host__ __device__ __forceinline__ int lds_byte(int r, int c) { const int st = (r >> 4) * 2 + (c >> 5), rr = r & 15, cc = c & 31, ob = rr * 64 + cc * 2; return st * 1024 + (ob ^ (((ob >> 9) & 1) << 5)); }
__host__ __device__ __forceinline__ void stage_rc(int b, int& R, int& C) { const int st = b / 1024, sb = b % 1024, swz = sb ^ (((sb >> 9) & 1) << 5); R = (st >> 1) * 16 + swz / 64; C = (st & 1) * 32 + (swz % 64) / 2; }
__host__ __device__ __forceinline__ int perm32(int rho) { const int n = rho >> 4, i = rho & 15; return 8 * (i >> 2) + 4 * n + (i & 3); }

__device__ __forceinline__ void glds_s(const char* sbase, unsigned voff, unsigned lds_dst) { unsigned keep;
    asm volatile("s_mov_b32 %0, m0\n\ts_mov_b32 m0, %3\n\ts_nop 0\n\tglobal_load_lds_dwordx4 %1, %2\n\ts_mov_b32 m0, %0" : "=&s"(keep) : "v"(voff), "s"(sbase), "s"(lds_dst) : "memory"); }

#define PG8_PIN4(a, b, c, d, txt) asm volatile(txt : "+v"(a), "+v"(b), "+v"(c), "+v"(d))
#define PG8_PIN_ACC(txt) do { _Pragma("unroll") for (int _a = 0; _a < 2; ++_a) _Pragma("unroll") for (int _b = 0; _b < 2; ++_b) { \
        PG8_PIN4(acc[_a][_b][0][0], acc[_a][_b][0][1], acc[_a][_b][1][0], acc[_a][_b][1][1], ""); PG8_PIN4(acc[_a][_b][2][0], acc[_a][_b][2][1], acc[_a][_b][3][0], acc[_a][_b][3][1], ""); } \
        PG8_PIN4(acc[0][0][0][0], acc[0][1][0][0], acc[1][0][0][0], acc[1][1][0][0], txt); \
        _Pragma("unroll") for (int _a = 0; _a < 2; ++_a) _Pragma("unroll") for (int _b = 0; _b < 2; ++_b) { \
        PG8_PIN4(acc[_a][_b][0][0], acc[_a][_b][0][1], acc[_a][_b][1][0], acc[_a][_b][1][1], ""); PG8_PIN4(acc[_a][_b][2][0], acc[_a][_b][2][1], acc[_a][_b][3][0], acc[_a][_b][3][1], ""); } } while (0)

struct Unit { int pm, pn, e, kind; };

typedef float f32x2_cv __attribute__((ext_vector_type(2))); typedef __bf16 bf16x2_cv __attribute__((ext_vector_type(2)));
__device__ __forceinline__ unsigned cvt_pk_bf16(float lo, float hi) { const f32x2_cv v = {lo, hi}; const bf16x2_cv b = __builtin_convertvector(v, bf16x2_cv); return __builtin_bit_cast(unsigned, b); }
__device__ __forceinline__ float bf_lo(unsigned w) { return __uint_as_float(w << 16); }
__device__ __forceinline__ float bf_hi(unsigned w) { return __uint_as_float(w & 0xffff0000u); }

template <class Epi, class Sched, bool ALIGN_EPI = true, bool SP2 = true>
__device__ __forceinline__ void gemm_phase(LAS unsigned char* lds, const Sched& S, const Epi& E) {
    const int tid = threadIdx.x, wid = __builtin_amdgcn_readfirstlane(tid >> 6), lane = tid & 63, wr = wid >> 2, wc = wid & 3, fr = lane & 15, fq = lane >> 4;
    constexpr bool FP8 = Epi::FP8; constexpr int RB = FP8 ? 2048 : 4096, nt = RB / 128;
    unsigned voffB[2]; int RA[2], CA[2];
#pragma unroll
    for (int i = 0; i < 2; ++i) { int R, C; stage_rc(tid * 16 + i * 8192, R, C); const int Rb = Epi::PERM ? ((R & ~31) + perm32(R & 31)) : R;
        voffB[i] = (unsigned)(Rb * (Epi::BTILED ? 128 : RB) + C * 2); RA[i] = R; CA[i] = C; }
    constexpr size_t kstep = (size_t)(BK * 2);
    constexpr size_t hstep = (size_t)HALF * RB;
    constexpr size_t bkstep = Epi::BTILED ? (size_t)32768 : kstep, bhstep = Epi::BTILED ? (size_t)16384 : hstep;
    const unsigned ldsbase = (unsigned)__builtin_amdgcn_readfirstlane((unsigned)(uintptr_t)lds + (unsigned)wid * 1024u);
    const int aoff = lds_byte(wr * 64 + fr, fq * 8), boff = lds_byte(wc * 32 + fr, fq * 8);
#define PG8_SA(b, h) (((b) * 2 + (h)) * HTB)
#define PG8_SB(b, h) ((4 + (b) * 2 + (h)) * HTB)
#define PG8_STAGE(bufoff, gbase, voff) do { _Pragma("unroll") for (int _i = 0; _i < 2; ++_i) \
        glds_s((const char*)(gbase), (voff)[_i], ldsbase + (unsigned)((bufoff) + _i * 8192)); } while (0)
#define PG8_LDA(dst, b, h) do { _Pragma("unroll") for (int m = 0; m < 4; ++m) dst[m] = cat8(*(const LAS bf16x8*)(lds + PG8_SA(b, h) + aoff + m * 2048), *(const LAS bf16x8*)(lds + PG8_SA(b, h) + aoff + m * 2048 + 1024)); } while (0)
#define PG8_LDB(dst, b, h) do { _Pragma("unroll") for (int n = 0; n < 2; ++n) dst[n] = cat8(*(const LAS bf16x8*)(lds + PG8_SB(b, h) + boff + n * 2048), *(const LAS bf16x8*)(lds + PG8_SB(b, h) + boff + n * 2048 + 1024)); } while (0)
#define PG8_MMA(ai, bj, At, Bt) do { __builtin_amdgcn_s_setprio(1); _Pragma("unroll") for (int m = 0; m < 4; ++m) _Pragma("unroll") for (int n = 0; n < 2; ++n) { \
        if constexpr (FP8 && Epi::ASM_MFMA) asm volatile("v_mfma_scale_f32_16x16x128_f8f6f4 %0, %1, %2, %0, %3, %4 op_sel_hi:[0,0,0]" : "+v"(acc[ai][bj][m][n]) : "v"(Bt[n]), "v"(At[m]), "v"(scl_b), "v"(scl_a)); \
        else if constexpr (FP8) acc[ai][bj][m][n] = __builtin_amdgcn_mfma_scale_f32_16x16x128_f8f6f4(Bt[n], At[m], acc[ai][bj][m][n], 0, 0, 0, Epi::SCALE_B, 0, Epi::SCALE_A); \
        else { acc[ai][bj][m][n] = __builtin_amdgcn_mfma_f32_16x16x32_bf16(lo8(Bt[n]), lo8(At[m]), acc[ai][bj][m][n], 0, 0, 0); \
               acc[ai][bj][m][n] = __builtin_amdgcn_mfma_f32_16x16x32_bf16(hi8(Bt[n]), hi8(At[m]), acc[ai][bj][m][n], 0, 0, 0); } } \
        __builtin_amdgcn_s_setprio(0); } while (0)
#ifdef PROBE_DRAIN8
#define PG8_WAIT_V(n) do { if constexpr (FP8 && !Epi::ASM_MFMA) asm volatile("s_waitcnt vmcnt(0)" ::: "memory"); else asm volatile("s_waitcnt vmcnt(" #n ")" ::: "memory"); } while (0)
#else
#define PG8_WAIT_V(n) asm volatile("s_waitcnt vmcnt(" #n ")" ::: "memory")
#endif
#define PG8_WAIT_L(n) asm volatile("s_waitcnt lgkmcnt(" #n ")" ::: "memory")
#define PG8_BAR __builtin_amdgcn_s_barrier()
#define PG8_SCHED __builtin_amdgcn_sched_barrier(0)
    Unit cur, nxt; int ui = 0;
    int scl_a = Epi::SCALE_A, scl_b = Epi::SCALE_B; asm volatile("" : "+v"(scl_a), "+v"(scl_b));
    if (!S.next(0, cur)) return;
    f32x4 acc[2][2][4][2];
#pragma unroll
    for (int a = 0; a < 2; ++a)
#pragma unroll
        for (int b = 0; b < 2; ++b)
#pragma unroll
            for (int m = 0; m < 4; ++m)
#pragma unroll
                for (int n = 0; n < 2; ++n) acc[a][b][m][n] = (f32x4){0.f, 0.f, 0.f, 0.f};
    if constexpr (Epi::FP8) PG8_PIN_ACC("s_nop 7");
    v8i At[4], B0[2], B1[2];
    const char* cA = S.a_base(cur); const char* cB = S.b_base(cur);
    unsigned vo[2][2], nvo[2][2];
    S.a_offs(cur, RA, CA, vo);
    bool has_next = S.next(1, nxt);
    if (has_next) S.a_offs(nxt, RA, CA, nvo); else { nvo[0][0] = vo[0][0]; nvo[0][1] = vo[0][1]; nvo[1][0] = vo[1][0]; nvo[1][1] = vo[1][1]; }
    if constexpr (SP2) {
        PG8_STAGE(PG8_SB(0, 0), cB, voffB); PG8_STAGE(PG8_SB(0, 1), cB + bhstep, voffB); PG8_STAGE(PG8_SA(0, 0), cA, vo[0]); PG8_STAGE(PG8_SA(0, 1), cA, vo[1]);
        if (wr == 1) PG8_BAR;
        PG8_WAIT_V(2); PG8_BAR;
        PG8_STAGE(PG8_SB(1, 0), cB + bkstep, voffB); PG8_STAGE(PG8_SA(1, 0), cA + kstep, vo[0]); PG8_STAGE(PG8_SB(1, 1), cB + bhstep + bkstep, voffB);
        PG8_WAIT_V(6); PG8_BAR;
    } else {
        PG8_STAGE(PG8_SB(0, 0), cB, voffB); PG8_STAGE(PG8_SA(0, 0), cA, vo[0]); PG8_STAGE(PG8_SB(0, 1), cB + bhstep, voffB); PG8_STAGE(PG8_SA(0, 1), cA, vo[1]);
        if (wr == 1) PG8_BAR;
        PG8_WAIT_V(4); PG8_BAR;
        PG8_STAGE(PG8_SB(1, 0), cB + bkstep, voffB); PG8_STAGE(PG8_SA(1, 0), cA + kstep, vo[0]); PG8_STAGE(PG8_SB(1, 1), cB + bhstep + bkstep, voffB);
        PG8_WAIT_V(6); PG8_BAR;
    }
    for (;;) {
        const char* nA = has_next ? S.a_base(nxt) : cA; const char* nB = has_next ? S.b_base(nxt) : cB;
        for (int t = 0; t < nt; t += 2) {
            const bool last = (t == nt - 2);
            const char* a1 = cA + (size_t)(t + 1) * kstep;
            const char* a2 = last ? nA : cA + (size_t)(t + 2) * kstep; const char* b2 = last ? nB : cB + (size_t)(t + 2) * bkstep;
            const char* a3 = a2 + kstep; const char* b3 = b2 + bkstep;
            unsigned v2[2][2];
            v2[0][0] = last ? nvo[0][0] : vo[0][0]; v2[0][1] = last ? nvo[0][1] : vo[0][1]; v2[1][0] = last ? nvo[1][0] : vo[1][0]; v2[1][1] = last ? nvo[1][1] : vo[1][1];
            if constexpr (SP2) {
            PG8_LDB(B0, 0, 0); PG8_LDB(B1, 0, 1); PG8_SCHED; PG8_LDA(At, 0, 0); PG8_STAGE(PG8_SA(1, 1), a1, vo[1]);
            PG8_WAIT_V(8); PG8_WAIT_L(0); PG8_BAR; PG8_MMA(0, 0, At, B0); PG8_MMA(0, 1, At, B1); PG8_BAR; PG8_SCHED;
            PG8_LDA(At, 0, 1); PG8_STAGE(PG8_SB(0, 0), b2, voffB); PG8_STAGE(PG8_SB(0, 1), b2 + bhstep, voffB); PG8_STAGE(PG8_SA(0, 0), a2, v2[0]);
            PG8_WAIT_V(8); PG8_WAIT_L(0); PG8_BAR; PG8_MMA(1, 0, At, B0); PG8_MMA(1, 1, At, B1); PG8_BAR; PG8_SCHED;
            PG8_LDB(B0, 1, 0); PG8_LDB(B1, 1, 1); PG8_SCHED; PG8_LDA(At, 1, 0); PG8_STAGE(PG8_SA(0, 1), a2, v2[1]);
            PG8_WAIT_V(8); PG8_WAIT_L(0); PG8_BAR; PG8_MMA(0, 0, At, B0); PG8_MMA(0, 1, At, B1); PG8_BAR; PG8_SCHED;
            PG8_LDA(At, 1, 1); PG8_STAGE(PG8_SB(1, 0), b3, voffB); PG8_STAGE(PG8_SB(1, 1), b3 + bhstep, voffB); PG8_STAGE(PG8_SA(1, 0), a3, v2[0]);
            PG8_WAIT_V(8); PG8_WAIT_L(0); PG8_BAR; PG8_MMA(1, 0, At, B0); PG8_MMA(1, 1, At, B1); PG8_BAR; PG8_SCHED;
            } else {
            PG8_LDB(B0, 0, 0); PG8_SCHED; PG8_LDA(At, 0, 0); PG8_STAGE(PG8_SA(1, 1), a1, vo[1]);
            PG8_WAIT_L(8); PG8_BAR; PG8_WAIT_L(0); PG8_MMA(0, 0, At, B0); PG8_BAR; PG8_SCHED;
            PG8_LDB(B1, 0, 1); PG8_STAGE(PG8_SB(0, 0), b2, voffB);
            PG8_BAR; PG8_WAIT_L(0); PG8_MMA(0, 1, At, B1); PG8_BAR;
            PG8_LDA(At, 0, 1); PG8_STAGE(PG8_SA(0, 0), a2, v2[0]);
            PG8_BAR; PG8_WAIT_L(0); PG8_MMA(1, 0, At, B0); PG8_BAR; PG8_SCHED;
            PG8_STAGE(PG8_SB(0, 1), b2 + bhstep, voffB);
            PG8_WAIT_V(6); PG8_BAR; PG8_MMA(1, 1, At, B1); PG8_BAR;
            PG8_LDB(B0, 1, 0); PG8_SCHED; PG8_LDA(At, 1, 0); PG8_STAGE(PG8_SA(0, 1), a2, v2[1]);
            PG8_WAIT_L(8); PG8_BAR; PG8_WAIT_L(0); PG8_MMA(0, 0, At, B0); PG8_BAR; PG8_SCHED;
            PG8_LDB(B1, 1, 1); PG8_STAGE(PG8_SB(1, 0), b3, voffB);
            PG8_BAR; PG8_WAIT_L(0); PG8_MMA(0, 1, At, B1); PG8_BAR;
            PG8_LDA(At, 1, 1); PG8_STAGE(PG8_SA(1, 0), a3, v2[0]);
            PG8_BAR; PG8_WAIT_L(0); PG8_MMA(1, 0, At, B0); PG8_BAR; PG8_SCHED;
            PG8_STAGE(PG8_SB(1, 1), b3 + bhstep, voffB);
            PG8_WAIT_V(6); PG8_BAR; PG8_MMA(1, 1, At, B1); PG8_BAR;
            }
            if constexpr (Epi::MID) { if (t == 10 || t == 22) E.mid(acc, cur, t == 22 ? 1 : 0, wr, wc, fr, fq); }
        }
        Unit nn; const bool has_nn = has_next && S.next(ui + 2, nn); unsigned nnvo[2][2];
        if (has_nn) S.a_offs(nn, RA, CA, nnvo); else { nnvo[0][0] = nvo[0][0]; nnvo[0][1] = nvo[0][1]; nnvo[1][0] = nvo[1][0]; nnvo[1][1] = nvo[1][1]; }
        if constexpr (ALIGN_EPI) { if (wr == 0) PG8_BAR; }
        if constexpr (FP8) PG8_PIN_ACC("s_nop 15\n\ts_nop 7");
        E(acc, cur, wr, wc, fr, fq);
        if (!has_next) break;
#pragma unroll
        for (int a = 0; a < 2; ++a)
#pragma unroll
            for (int b = 0; b < 2; ++b)
#pragma unroll
                for (int m = 0; m < 4; ++m)
#pragma unroll
                    for (int n = 0; n < 2; ++n) acc[a][b][m][n] = (f32x4){0.f, 0.f, 0.f, 0.f};
        if constexpr (FP8) PG8_PIN_ACC("s_nop 7");
        cur = nxt; cA = nA; cB = nB; ++ui; nxt = nn; has_next = has_nn;
        vo[0][0] = nvo[0][0]; vo[0][1] = nvo[0][1]; vo[1][0] = nvo[1][0]; vo[1][1] = nvo[1][1];
        nvo[0][0] = nnvo[0][0]; nvo[0][1] = nnvo[0][1]; nvo[1][0] = nnvo[1][0]; nvo[1][1] = nnvo[1][1];
        if constexpr (ALIGN_EPI) { if (wr == 1) PG8_BAR; }
    }
    PG8_WAIT_V(0);
    if constexpr (!ALIGN_EPI) { if (wr == 0) PG8_BAR; }
    PG8_BAR;
#undef PG8_SA
#undef PG8_SB
#undef PG8_STAGE
#undef PG8_LDA
#undef PG8_LDB
#undef PG8_MMA
#undef PG8_WAIT_V
#undef PG8_WAIT_L
#undef PG8_BAR
#undef PG8_SCHED
}
}

constexpr int NWAVES = 8;
constexpr int BATCH = 2, SEQ = 8192, DM = 2048, T = BATCH * SEQ;
constexpr int NMEM = 256, MROWS = BATCH * NMEM;
constexpr int INW = 10252;
constexpr int NEXP = 32, TOPK = 4, CAP = T;
constexpr int QKVW = 4096;
constexpr int C_FQ = 0, C_FK = 768, C_FV = 1536, C_SQ = 2304, C_SK = 3072, C_SV = 3328, C_MQ = 3584;
constexpr int GW = 6144;
constexpr float NORM_EPS = 1e-6f;
constexpr float LOG2E = 1.4426950408889634f;
constexpr float SWIGLU_LIMIT = 7.0f, SWIGLU_ALPHA = 1.702f;
constexpr int PER_PHASE = 10;
#ifndef MK_LATE_WD
#define MK_LATE_WD 0
#endif
constexpr bool LATE_WD = false;
#ifndef MK_CONV_IN_P3
#define MK_CONV_IN_P3 1
#endif
constexpr bool CONV_IN_P3 = MK_CONV_IN_P3;
#ifndef MK_GATE_WGS
#define MK_GATE_WGS 0
#endif
constexpr int GATE_WGS = MK_GATE_WGS;
constexpr bool GATES_IN_P3 = GATE_WGS > 0;
#ifndef MK_N_LAUNCHES
#define MK_N_LAUNCHES 1
#endif
constexpr int N_LAUNCHES = MK_N_LAUNCHES;

constexpr size_t MiB = 1u << 20;
constexpr size_t WS_CTL = 0, CTL_ZERO_BYTES = 1 * MiB;
constexpr size_t WS_WIN   = 2 * MiB;
constexpr size_t WS_WMKV  = WS_WIN + 40 * MiB;
constexpr size_t WS_WUP   = WS_WMKV + 4 * MiB;
constexpr size_t WS_WOUT  = WS_WUP + 8 * MiB;
constexpr size_t WS_WRT   = WS_WOUT + 8 * MiB;
constexpr size_t WS_WGU   = WS_WRT + 1 * MiB;
constexpr size_t WS_WD    = WS_WGU + 512 * MiB;
constexpr size_t WS_XN    = WS_WD + 256 * MiB;
constexpr size_t WS_MN    = WS_XN + 64 * MiB;
constexpr size_t WS_LOGF  = WS_MN + 2 * MiB;
constexpr size_t WS_CNEG  = WS_LOGF + 1 * MiB;
constexpr size_t WS_ROPE  = WS_CNEG + 1 * MiB;
constexpr size_t WS_QKV   = WS_ROPE + 4 * MiB;
constexpr size_t WS_G     = WS_QKV + 128 * MiB;
constexpr size_t WS_MKV   = WS_G + 192 * MiB;
constexpr size_t WS_OALL  = WS_MKV + 1 * MiB;
constexpr size_t WS_MERGED= WS_OALL + 64 * MiB;
constexpr size_t WS_HB    = WS_MERGED + 64 * MiB;
constexpr size_t WS_TOK   = WS_HB + 64 * MiB;
constexpr size_t WS_GATE  = WS_TOK + 2 * MiB;
constexpr size_t WS_RS    = WS_GATE + 2 * MiB;
constexpr size_t WS_ACT   = WS_RS + 2 * MiB;
constexpr size_t WS_Y     = WS_ACT + 288 * MiB;
constexpr size_t WS_TSLOT = WS_Y + 288 * MiB;
constexpr size_t WS_TGATE = WS_TSLOT + 1 * MiB;
constexpr size_t WS_XN8   = WS_TGATE + 1 * MiB;
constexpr size_t WS_WIN8  = WS_XN8 + 32 * MiB;
constexpr size_t WS_END   = WS_WIN8 + 12 * MiB;
constexpr int CW_BAR = 4096;
constexpr int CW_QHEAD = 64;
constexpr int CW_CNT = 512;

typedef unsigned short bf16;
typedef unsigned v4u __attribute__((ext_vector_type(4)));
typedef unsigned v2u __attribute__((ext_vector_type(2)));
typedef float f32x4 __attribute__((ext_vector_type(4)));
typedef float f32x16 __attribute__((ext_vector_type(16)));
typedef short bf16x8 __attribute__((ext_vector_type(8)));
typedef short s16x4 __attribute__((ext_vector_type(4)));
typedef GAS unsigned gu32;
#define RLX_AGENT __ATOMIC_RELAXED, __HIP_MEMORY_SCOPE_AGENT
#define LDS_WAIT() asm volatile("s_waitcnt lgkmcnt(0)" ::: "memory")
#define VM_WAIT() asm volatile("s_waitcnt vmcnt(0)" ::: "memory")
__device__ __forceinline__ unsigned f2bf(float f) { unsigned u = __builtin_bit_cast(unsigned, f); return (u + 0x7fffu + ((u >> 16) & 1u)) >> 16; }
__device__ __forceinline__ unsigned pk2(float lo, float hi) { return f2bf(lo) | (f2bf(hi) << 16); }
__device__ __forceinline__ float bf2f(unsigned short b) { return __uint_as_float(((unsigned)b) << 16); }
__device__ __forceinline__ float wave_sum(float v) {
#pragma unroll
    for (int o = 1; o < 64; o <<= 1) v += __shfl_xor(v, o);
    return v;
}
__device__ __forceinline__ float sigmoidf_(float x) { return __builtin_amdgcn_rcpf(1.0f + __builtin_amdgcn_exp2f(x * (-LOG2E))); }

constexpr int H8_SHIFT = 4, ACT8_SHIFT = 2, W8_SHIFT = 9;
constexpr float H8_MUL = 16.0f, ACT8_MUL = 4.0f, W8_MUL = 512.0f;
__device__ __forceinline__ float clamp_fp8(float v) { return __builtin_amdgcn_fmed3f(v, -448.0f, 448.0f); }
__device__ __forceinline__ unsigned pk4_fp8(float a, float b, float c, float d) {
    int p = __builtin_amdgcn_cvt_pk_fp8_f32(clamp_fp8(a), clamp_fp8(b), 0, false); p = __builtin_amdgcn_cvt_pk_fp8_f32(clamp_fp8(c), clamp_fp8(d), p, true); return (unsigned)p; }
using pg8::f32x2; using pg8::u32x4; using pg8::u32x2; using pg8::cvt_pk_bf16; using pg8::bf_lo; using pg8::bf_hi;

#define XB_TMO      128
#define XB_XCNT(j)  (256  + 64 * (j))
#define XB_XSUB(j)  (1280 + 64 * (j))
#define XB_XGEN(j)  (2304 + 64 * (j))
#define XB_TOP      3328
#define XB_TOPGEN   3392
#define XCD_BAR_WORDS 3456
#define XB_SPIN_CAP (1u << 18)

__device__ __forceinline__ unsigned xb_ld(unsigned* p)              { return __hip_atomic_load(p, __ATOMIC_RELAXED, __HIP_MEMORY_SCOPE_AGENT); }
__device__ __forceinline__ unsigned xb_add(unsigned* p, unsigned v) { return __hip_atomic_fetch_add(p, v, __ATOMIC_RELAXED, __HIP_MEMORY_SCOPE_AGENT); }
__device__ __forceinline__ unsigned xb_xcc_id() { return (unsigned)__builtin_amdgcn_s_getreg((3 << 11) | 20) & 0xFu; }
#define XB_SPIN(cond, bar) do { unsigned _sp = 0; while (cond) { __builtin_amdgcn_s_sleep(1); \
    if ((++_sp & 255u) == 0u) { if (xb_ld(&(bar)[XB_TMO])) break; if (_sp > XB_SPIN_CAP) { atomicAdd(&(bar)[XB_TMO], 1u); break; } } } } while (0)

struct XcdBarrier { unsigned* bar; unsigned x; volatile LAS unsigned* st; };

__device__ __forceinline__ XcdBarrier xcd_barrier_post(unsigned* bar, volatile LAS unsigned* st) {
    XcdBarrier b; b.bar = bar; b.x = xb_xcc_id(); b.st = st;
    if (threadIdx.x == 0) (void)xb_add(&bar[XB_XCNT(b.x)], 1u);
    return b;
}
__device__ __forceinline__ void xcd_barrier_complete(unsigned* bar, unsigned x, unsigned& nloc, unsigned& nx) {
    const unsigned G = gridDim.x * gridDim.y * gridDim.z;
    unsigned sum, cnt, mine, sp = 0u;
    for (;;) {
        sum = 0u; cnt = 0u; mine = 0u;
#pragma unroll
        for (unsigned j = 0; j < 16; ++j) { const unsigned c = xb_ld(&bar[XB_XCNT(j)]); sum += c; cnt += (c > 0u) ? 1u : 0u; mine = (j == x) ? c : mine; }
        if (sum == G) break;
        __builtin_amdgcn_s_sleep(1);
        if ((++sp & 255u) == 0u) { if (xb_ld(&bar[XB_TMO])) break; if (sp > XB_SPIN_CAP) { atomicAdd(&bar[XB_TMO], 1u); break; } }
    }
    nloc = mine > 0u ? mine : 1u; nx = cnt > 0u ? cnt : 1u;
}
__device__ __forceinline__ void xcd_barrier(const XcdBarrier& b) {
    asm volatile("s_waitcnt vmcnt(0)" ::: "memory");
    __syncthreads();
    if (threadIdx.x == 0) {
        unsigned* bar = b.bar;
        __builtin_amdgcn_s_waitcnt(0);
        unsigned nloc = b.st[0], nx = b.st[1];
        if (nloc == 0u) { xcd_barrier_complete(bar, b.x, nloc, nx); b.st[0] = nloc; b.st[1] = nx; }
        const unsigned old = xb_add(&bar[XB_XSUB(b.x)], 1u);
        const unsigned gen = old / nloc;
        if (old + 1u == (gen + 1u) * nloc) {
            __builtin_amdgcn_fence(__ATOMIC_RELEASE, "agent");
            asm volatile("s_waitcnt vmcnt(0)" ::: "memory");
            const unsigned og = xb_add(&bar[XB_TOP], 1u);
            const unsigned tg = og / nx;
            if (og + 1u == (tg + 1u) * nx) xb_add(&bar[XB_TOPGEN], 1u);
            else XB_SPIN(xb_ld(&bar[XB_TOPGEN]) == tg, bar);
            __builtin_amdgcn_fence(__ATOMIC_ACQUIRE, "agent");
            xb_add(&bar[XB_XGEN(b.x)], 1u);
            asm volatile("s_waitcnt vmcnt(0)" ::: "memory");
        } else {
            XB_SPIN(xb_ld(&bar[XB_XGEN(b.x)]) == gen, bar);
            __builtin_amdgcn_fence(__ATOMIC_ACQUIRE, "agent");
            asm volatile("s_waitcnt vmcnt(0)" ::: "memory");
        }
    }
    __syncthreads();
}

constexpr int RING_OFF = 0, RING_BYTES = 131072;
constexpr int LDSCTL_OFF = RING_BYTES, MISC_OFF = LDSCTL_OFF + 320;
constexpr int MOE_OFF = MISC_OFF + 128;
constexpr int LDS_BYTES = 147456;

struct Ctx {
    LAS unsigned char* lds;
    volatile LAS unsigned* MISC;
    gu32* ctl;
    int tid, lane, wave, vcu, G, probe;
    const float *x, *mem; const int* pos; const float *norm_mix, *w_in, *b_forget, *fox_q_norm, *fox_k_norm, *swa_q_norm, *swa_k_norm, *swa_sinks, *xmem_q_norm, *xmem_k_norm, *norm_mem,
        *w_mem_kv, *w_up_fox, *w_up_swa, *w_up_xmem, *w_out, *norm_ffn, *w_router, *b_router, *w_gate_up, *b_gate_up, *w_down, *b_down;
    float* out;
    bf16 *Win_t, *Wmkv_t, *Wup_t, *Wout_t, *Wr_t, *Wgu_t, *Wd_t, *XN, *MN, *QKV, *G_, *MKV, *OALL, *MERGED, *HB, *ACT;
    float *LOGF, *CNEG, *ROPE, *GATEW, *RS, *TGATE; int *TOK, *TSLOT; bf16* Y; unsigned char *XN8, *Win8;
};

#ifndef PROBE_INW
#define PROBE_INW 64
#endif
__constant__ float INV_FREQ[32] = {1.000000000e+00f, 7.498942614e-01f, 5.623413324e-01f, 4.216965139e-01f, 3.162277639e-01f, 2.371373773e-01f, 1.778279394e-01f, 1.333521307e-01f,
    1.000000015e-01f, 7.498941571e-02f, 5.623413250e-02f, 4.216965288e-02f, 3.162277490e-02f, 2.371373773e-02f, 1.778279431e-02f, 1.333521493e-02f, 9.999999776e-03f, 7.498941850e-03f,
    5.623413250e-03f, 4.216964822e-03f, 3.162277630e-03f, 2.371373586e-03f, 1.778279431e-03f, 1.333521446e-03f, 1.000000047e-03f, 7.498942432e-04f, 5.623413017e-04f, 4.216965172e-04f,
    3.162277571e-04f, 2.371373703e-04f, 1.778279402e-04f, 1.333521504e-04f};

struct TItem { const float* src; const float* ksc; bf16* dst; size_t ldw; int f8, gap; };
__device__ __forceinline__ void titem_load(const TItem& I, f32x4 (&v)[8][2], float (&sc)[8][2], int lane) {
    const int rr = lane >> 4, c4 = lane & 15;
#pragma unroll
    for (int p = 0; p < 8; ++p)
#pragma unroll
        for (int h = 0; h < 2; ++h) { const int k = 8 * p + 2 * rr + h; v[p][h] = *(const GAS f32x4*)(I.src + (size_t)k * I.ldw + 4 * c4 + (c4 >= 8 ? I.gap : 0)); sc[p][h] = I.ksc ? I.ksc[k] : 1.0f; }
}
__device__ __forceinline__ void titem_store(const TItem& I, const f32x4 (&v)[8][2], const float (&sc)[8][2], LAS unsigned* tile, int lane) {
    const int rr = lane >> 4, c4 = lane & 15;
#pragma unroll
    for (int p = 0; p < 8; ++p)
#pragma unroll
        for (int q = 0; q < 4; ++q) { const int n = 4 * c4 + q, sw = (n ^ (n >> 3)) & 7;
            tile[n * 32 + 4 * (p ^ sw) + rr] = pg8::cvt_pk_bf16(v[p][0][q] * sc[p][0], v[p][1][q] * sc[p][1]); }
    LDS_WAIT(); asm volatile("" ::: "memory");
#pragma unroll
    for (int j = 0; j < 8; ++j) { const int n = 8 * j + (lane >> 3), c = lane & 7, sw = (n ^ (n >> 3)) & 7;
        const v4u o = *(const LAS v4u*)(tile + n * 32 + 4 * (c ^ sw));
        *(GAS v4u*)(I.dst + (size_t)n * DM + 8 * c) = o; }
    LDS_WAIT(); asm volatile("" ::: "memory");
}
__device__ __forceinline__ size_t tiled8(size_t row, int kt) { return (row >> 8) * (size_t)(256 * 2048) + (size_t)kt * 32768 + (row & 255) * 128; }
#ifndef CONV_NT
#define CONV_NT 1
#endif
#if CONV_NT
#define CONV_LOAD(p) __builtin_nontemporal_load(p)
#else
#define CONV_LOAD(p) (*(p))
#endif
__device__ __forceinline__ void titem8_load(const TItem& I, int qh, f32x4 (&v)[4][2], int lane) {
    const int rr = lane >> 4, c4 = lane & 15;
#pragma unroll
    for (int pp = 0; pp < 2; ++pp)
#pragma unroll
        for (int h = 0; h < 4; ++h) { const int k = 32 * qh + 16 * pp + 4 * rr + h; v[2 * pp + (h >> 1)][h & 1] = CONV_LOAD((const GAS f32x4*)(I.src + (size_t)k * I.ldw + 4 * c4)); }
}
__device__ __forceinline__ void titem8_pack(const TItem& I, const float* nbase, int qh, const f32x4 (&v)[4][2], LAS unsigned* tile, const LAS float* lnorm, int lane) {
    const int rr = lane >> 4, c4 = lane & 15;
    const int kofs = I.ksc ? (int)(I.ksc - nbase) + 32 * qh + 4 * rr : -1;
#pragma unroll
    for (int pp = 0; pp < 2; ++pp) {
        f32x4 sc = {W8_MUL, W8_MUL, W8_MUL, W8_MUL}; if (kofs >= 0) sc = *(const LAS f32x4*)(lnorm + kofs + 16 * pp);
#pragma unroll
        for (int q = 0; q < 4; ++q) { const int n = 4 * c4 + q, sw = (n ^ (n >> 3)) & 7;
            tile[n * 32 + 4 * ((2 * qh + pp) ^ sw) + rr] = pk4_fp8(v[2 * pp][0][q] * sc.x, v[2 * pp][1][q] * sc.y, v[2 * pp + 1][0][q] * sc.z, v[2 * pp + 1][1][q] * sc.w); } }
}
__device__ __forceinline__ void titem8_flush(const TItem& I, LAS unsigned* tile, int lane) {
    LDS_WAIT(); asm volatile("" ::: "memory");
#pragma unroll
    for (int j = 0; j < 8; ++j) { const int n = 8 * j + (lane >> 3), c = lane & 7, sw = (n ^ (n >> 3)) & 7;
        const v4u o = *(const LAS v4u*)(tile + n * 32 + 4 * (c ^ sw));
        *(GAS v4u*)((unsigned char*)I.dst + (size_t)n * 128 + 16 * c) = o; }
    LDS_WAIT(); asm volatile("" ::: "memory");
}
__device__ __forceinline__ void p0_router_item(const float* W, int k0, bf16* WT, const float* ksc, LAS float* scr, int lane) {
#pragma unroll 8
    for (int i = 0; i < 32; ++i) { const int kk = 2 * i + (lane >> 5); scr[kk * 33 + (lane & 31)] = W[(size_t)(k0 + kk) * 32 + (lane & 31)] * ksc[k0 + kk]; }
    LDS_WAIT(); asm volatile("" ::: "memory");
    const int c = lane & 7;
#pragma unroll
    for (int j = 0; j < 4; ++j) { const int n = (lane >> 3) + 8 * j; const LAS float* s = scr + (8 * c) * 33 + n;
        unsigned h[8], l[8];
#pragma unroll
        for (int q = 0; q < 8; ++q) { const float v = s[q * 33]; h[q] = f2bf(v); l[q] = f2bf(v - __uint_as_float(h[q] << 16)); }
        v4u oh, ol; oh.x = h[0] | (h[1] << 16); oh.y = h[2] | (h[3] << 16); oh.z = h[4] | (h[5] << 16); oh.w = h[6] | (h[7] << 16);
        ol.x = l[0] | (l[1] << 16); ol.y = l[2] | (l[3] << 16); ol.z = l[4] | (l[5] << 16); ol.w = l[6] | (l[7] << 16);
        *(GAS v4u*)(WT + (size_t)n * 2048 + k0 + 8 * c) = oh; *(GAS v4u*)(WT + (size_t)(32 + n) * 2048 + k0 + 8 * c) = ol; }
    LDS_WAIT(); asm volatile("" ::: "memory");
}
__device__ __forceinline__ float log_sigmoidf_(float z) { return fminf(z, 0.f) - log1pf(__expf(-fabsf(z))); }

template <bool XROW>
__device__ __forceinline__ void p0_norm_row(const Ctx& C, const float* xrow, const float* gain, bf16* orow, const LAS float* Wf, int m) {
    const GAS f32x4* xr = (const GAS f32x4*)xrow + C.lane; const GAS f32x4* gr = (const GAS f32x4*)gain + C.lane;
    f32x4 v[8]; float s = 0.f;
#pragma unroll
    for (int j = 0; j < 8; ++j) { v[j] = xr[64 * j]; s += (v[j].x * v[j].x + v[j].y * v[j].y) + (v[j].z * v[j].z + v[j].w * v[j].w); }
    const float rstd = 1.0f / sqrtf(wave_sum(s) * (1.f / DM) + NORM_EPS);
    GAS unsigned long long* o8 = (GAS unsigned long long*)orow + C.lane;
#pragma unroll
    for (int j = 0; j < 8; ++j) { const f32x4 g = gr[64 * j]; v[j] = (v[j] * rstd) * g;
        o8[64 * j] = (unsigned long long)pk2(v[j].x, v[j].y) | ((unsigned long long)pk2(v[j].z, v[j].w) << 32);
        if constexpr (XROW) ((GAS unsigned*)(C.XN8 + (size_t)m * DM))[C.lane + 64 * j] = pk4_fp8(v[j].x * H8_MUL, v[j].y * H8_MUL, v[j].z * H8_MUL, v[j].w * H8_MUL); }
    if constexpr (XROW) {
        float mine = 0.f;
#pragma unroll 1
        for (int h = 0; h < 12; ++h) { const LAS f32x4* w = (const LAS f32x4*)(Wf + h * 2048) + C.lane; float d = 0.f;
#pragma unroll
            for (int j = 0; j < 8; ++j) { const f32x4 ww = w[64 * j]; d += (v[j].x * ww.x + v[j].y * ww.y) + (v[j].z * ww.z + v[j].w * ww.w); }
            d = wave_sum(d); if (C.lane == h) mine = d; }
        const int b = m / SEQ, t = m % SEQ;
        if (C.lane < 12) C.LOGF[(size_t)(b * 12 + C.lane) * SEQ + t] = log_sigmoidf_(mine + C.b_forget[C.lane]);
        if (C.lane < 32) { const float ang = (float)C.pos[m] * INV_FREQ[C.lane]; const double rev = (double)ang * 0.15915494309189535; const float fr = (float)(rev - floor(rev));
            C.ROPE[(size_t)m * 64 + C.lane] = __builtin_amdgcn_cosf(fr); C.ROPE[(size_t)m * 64 + 32 + C.lane] = __builtin_amdgcn_sinf(fr); }
    }
}
constexpr int I_GU = 32 * 16 * 64, I_D = 32 * 16 * 32, I_ING = 16 * 96, I_IN = 32 * PROBE_INW, I_MKV = 32 * 16, I_UF = 12 * 32, I_US = 12 * 32, I_UX = 8 * 32, I_O = 32 * 32;
constexpr int NITEMS = I_GU + I_D + I_ING + I_IN + I_MKV + I_UF + I_US + I_UX + I_O;
constexpr int N8 = I_GU + I_D + I_ING;
__device__ __forceinline__ TItem p0_decode(const Ctx& C, int it) {
        TItem I; int r = it; I.ksc = nullptr; I.f8 = 0; I.gap = 0;
        if (r < I_GU) { const int e = r / 1024, q = r % 1024, kb = 2 * (q / 64), pb = q % 64, tl = pb >> 2, jb = pb & 3;
            const int n0 = (jb < 2) ? (128 * tl + 64 * jb) : (2048 + 128 * tl + 64 * (jb - 2));
            I.ldw = 4096; I.src = C.w_gate_up + (size_t)e * DM * 4096 + (size_t)(64 * kb) * 4096 + n0; I.ksc = C.norm_ffn + 64 * kb; I.f8 = 1; I.dst = (bf16*)((unsigned char*)C.Wgu_t + tiled8((size_t)e * 4096 + 64 * pb, kb >> 1)); return I; } r -= I_GU;
        if (r < I_D) { const int e = r / 512, q = r % 512, kb = 2 * (q / 32), nb = q % 32;
            I.ldw = DM; I.src = C.w_down + (size_t)e * DM * DM + (size_t)(64 * kb) * DM + 64 * nb; I.f8 = 1; I.dst = (bf16*)((unsigned char*)C.Wd_t + tiled8((size_t)e * DM + 64 * nb, kb >> 1)); return I; } r -= I_D;
        if (r < I_ING) { const int kb = 2 * (r / 96), pb = r % 96;
            I.ldw = INW; I.src = C.w_in + (size_t)(64 * kb) * INW + 4108 + 64 * pb; I.f8 = 1; I.dst = (bf16*)((unsigned char*)C.Win8 + tiled8((size_t)64 * pb, kb >> 1)); return I; } r -= I_ING;
        if (r < I_IN) { const int kb = r / PROBE_INW, pb = r % PROBE_INW; int p0 = 64 * pb; const int tl = pb >> 2, q4 = pb & 3;
            if (tl == 3 || tl == 4 || tl == 5 || tl == 12) { p0 = 256 * tl + 128 * (q4 & 1) + 32 * (q4 >> 1); I.gap = 32; }
            const int n0 = (p0 < 2304) ? p0 : p0 + 12;
            I.ldw = INW; I.src = C.w_in + (size_t)(64 * kb) * INW + n0; I.dst = C.Win_t + (size_t)(64 * pb) * DM + 64 * kb; return I; } r -= I_IN;
        if (r < I_MKV) { const int kb = r / 16, nb = r % 16; I.ldw = 1024; I.src = C.w_mem_kv + (size_t)(64 * kb) * 1024 + 64 * nb; I.dst = C.Wmkv_t + (size_t)(64 * nb) * DM + 64 * kb; return I; } r -= I_MKV;
        if (r < I_UF) { const int kb = r / 32, nb = r % 32; I.ldw = DM; I.src = C.w_up_fox + (size_t)(64 * kb) * DM + 64 * nb; I.dst = C.Wup_t + (size_t)(64 * nb) * DM + 64 * kb; return I; } r -= I_UF;
        if (r < I_US) { const int kb = r / 32, nb = r % 32; I.ldw = DM; I.src = C.w_up_swa + (size_t)(64 * kb) * DM + 64 * nb; I.dst = C.Wup_t + (size_t)(64 * nb) * DM + 768 + 64 * kb; return I; } r -= I_US;
        if (r < I_UX) { const int kb = r / 32, nb = r % 32; I.ldw = DM; I.src = C.w_up_xmem + (size_t)(64 * kb) * DM + 64 * nb; I.dst = C.Wup_t + (size_t)(64 * nb) * DM + 1536 + 64 * kb; return I; } r -= I_UX;
        { const int kb = r / 32, nb = r % 32; I.ldw = DM; I.src = C.w_out + (size_t)(64 * kb) * DM + 64 * nb; I.dst = C.Wout_t + (size_t)(64 * nb) * DM + 64 * kb; return I; }
}
__device__ __forceinline__ void p0_fp8_loop(const Ctx& C, int first, int cnt, int me, int stride, LAS unsigned* tile, const LAS float* lnorm) {
    if (me >= cnt) return;
    const int nq = 4 * ((cnt - me + stride - 1) / stride);
    f32x4 b0[4][2], b1[4][2], b2[4][2], b3[4][2], b4[4][2];
#define P0_ITEM(q_) p0_decode(C, first + me + ((q_) >> 2) * stride)
#define P0_STEP(q_, cur_, pre_) do { const int qq = (q_); if (qq < nq) { \
        if (qq + 4 < nq) { const TItem J = P0_ITEM(qq + 4); titem8_load(J, (qq + 4) & 3, pre_, C.lane); } \
        const TItem I = P0_ITEM(qq); titem8_pack(I, C.norm_ffn, qq & 3, cur_, tile, lnorm, C.lane); \
        if ((qq & 3) == 3) titem8_flush(I, tile, C.lane); } } while (0)
    { const TItem I = P0_ITEM(0); titem8_load(I, 0, b0, C.lane); titem8_load(I, 1, b1, C.lane); titem8_load(I, 2, b2, C.lane); titem8_load(I, 3, b3, C.lane); }
    for (int qs = 0; qs < nq; qs += 5) { P0_STEP(qs, b0, b4); P0_STEP(qs + 1, b1, b0); P0_STEP(qs + 2, b2, b1); P0_STEP(qs + 3, b3, b2); P0_STEP(qs + 4, b4, b3); }
#undef P0_ITEM
#undef P0_STEP
}
__device__ __forceinline__ void p0_fill_lnorm(const Ctx& C, LAS float* lnorm) { for (int k = C.tid; k < DM; k += NWAVES * 64) lnorm[k] = C.norm_ffn[k] * W8_MUL; }
__device__ __forceinline__ void p0_x_rows2(const Ctx& C, const LAS float* Wf, int m0, int m1) {
    const GAS f32x4* gr = (const GAS f32x4*)C.norm_mix + C.lane;
    const int mm[2] = {m0, m1};
    f32x4 v[2][8]; float s[2] = {0.f, 0.f};
#pragma unroll
    for (int r = 0; r < 2; ++r) { const GAS f32x4* xr = (const GAS f32x4*)(C.x + (size_t)mm[r] * DM) + C.lane;
#pragma unroll
        for (int j = 0; j < 8; ++j) v[r][j] = xr[64 * j]; }
#pragma unroll
    for (int r = 0; r < 2; ++r)
#pragma unroll
        for (int j = 0; j < 8; ++j) s[r] += (v[r][j].x * v[r][j].x + v[r][j].y * v[r][j].y) + (v[r][j].z * v[r][j].z + v[r][j].w * v[r][j].w);
    float rstd[2];
#pragma unroll
    for (int r = 0; r < 2; ++r) rstd[r] = 1.0f / sqrtf(wave_sum(s[r]) * (1.f / DM) + NORM_EPS);
#pragma unroll
    for (int j = 0; j < 8; ++j) { const f32x4 g = gr[64 * j];
#pragma unroll
        for (int r = 0; r < 2; ++r) { v[r][j] = (v[r][j] * rstd[r]) * g;
            ((GAS unsigned long long*)(C.XN + (size_t)mm[r] * DM))[C.lane + 64 * j] = (unsigned long long)pk2(v[r][j].x, v[r][j].y) | ((unsigned long long)pk2(v[r][j].z, v[r][j].w) << 32);
            ((GAS unsigned*)(C.XN8 + (size_t)mm[r] * DM))[C.lane + 64 * j] = pk4_fp8(v[r][j].x * H8_MUL, v[r][j].y * H8_MUL, v[r][j].z * H8_MUL, v[r][j].w * H8_MUL); } }
    float mine[2] = {0.f, 0.f};
#pragma unroll 1
    for (int h = 0; h < 12; ++h) { const LAS f32x4* w = (const LAS f32x4*)(Wf + h * 2048) + C.lane; float d0 = 0.f, d1 = 0.f;
#pragma unroll
        for (int j = 0; j < 8; ++j) { const f32x4 ww = w[64 * j];
            d0 += (v[0][j].x * ww.x + v[0][j].y * ww.y) + (v[0][j].z * ww.z + v[0][j].w * ww.w); d1 += (v[1][j].x * ww.x + v[1][j].y * ww.y) + (v[1][j].z * ww.z + v[1][j].w * ww.w); }
        d0 = wave_sum(d0); d1 = wave_sum(d1); if (C.lane == h) { mine[0] = d0; mine[1] = d1; } }
#pragma unroll
    for (int r = 0; r < 2; ++r) { const int m = mm[r], b = m / SEQ, t = m % SEQ;
        if (C.lane < 12) C.LOGF[(size_t)(b * 12 + C.lane) * SEQ + t] = log_sigmoidf_(mine[r] + C.b_forget[C.lane]);
        if (C.lane < 32) { const float ang = (float)C.pos[m] * INV_FREQ[C.lane]; const double rev = (double)ang * 0.15915494309189535; const float fr = (float)(rev - floor(rev));
            C.ROPE[(size_t)m * 64 + C.lane] = __builtin_amdgcn_cosf(fr); C.ROPE[(size_t)m * 64 + 32 + C.lane] = __builtin_amdgcn_sinf(fr); } }
}
__device__ __forceinline__ void phase0(const Ctx& C) {
    const int gw = C.vcu * NWAVES + C.wave, NGW = C.G * NWAVES;
    LAS float* scr = (LAS float*)(C.lds + RING_OFF + C.wave * 16384);
    for (int r = gw; r < 32; r += NGW) p0_router_item(C.w_router, 64 * r, C.Wr_t, C.norm_ffn, scr, C.lane);
    LAS unsigned* tile = (LAS unsigned*)(C.lds + RING_OFF + C.wave * 8192);
    __syncthreads();
    LAS float* lnorm = (LAS float*)(C.lds + RING_OFF + 65536);
    p0_fill_lnorm(C, lnorm); __syncthreads();
    p0_fp8_loop(C, CONV_IN_P3 ? I_GU + I_D : 0, CONV_IN_P3 ? I_ING : N8, gw, NGW, tile, lnorm);
    if (N8 + gw < NITEMS) {
        TItem cur = p0_decode(C, N8 + gw); f32x4 va[8][2]; float sa[8][2]; titem_load(cur, va, sa, C.lane);
        for (int it = N8 + gw; it < NITEMS; it += NGW) {
            const int nx = it + NGW; TItem nxt = cur; f32x4 vb[8][2]; float sb[8][2];
            if (nx < NITEMS) { nxt = p0_decode(C, nx); titem_load(nxt, vb, sb, C.lane); }
            titem_store(cur, va, sa, tile, C.lane);
            cur = nxt;
#pragma unroll
            for (int p = 0; p < 8; ++p)
#pragma unroll
                for (int h = 0; h < 2; ++h) { va[p][h] = vb[p][h]; sa[p][h] = sb[p][h]; }
        }
    }
    __syncthreads();
    LAS float* Wf = (LAS float*)(C.lds + RING_OFF);
    for (int idx = C.tid; idx < 12 * 2048; idx += NWAVES * 64) { const int k = idx / 12, h = idx - 12 * k; Wf[h * 2048 + k] = C.w_in[(size_t)k * INW + 2304 + h]; }
    __syncthreads();
    { int m = gw; for (; m + NGW < T; m += 2 * NGW) p0_x_rows2(C, Wf, m, m + NGW); if (m < T) p0_norm_row<true>(C, C.x + (size_t)m * DM, C.norm_mix, C.XN + (size_t)m * DM, Wf, m); }
    for (int m = gw; m < MROWS; m += NGW) p0_norm_row<false>(C, C.mem + (size_t)m * DM, C.norm_mem, C.MN + (size_t)m * DM, Wf, m);
    __syncthreads();
}

constexpr int CONV_CHUNK = 128;
#ifndef MK_WD_IN_P7
#define MK_WD_IN_P7 0
#endif
constexpr bool WD_IN_P7 = MK_WD_IN_P7;
constexpr int CONV_NCHUNK = (WD_IN_P7 ? I_GU : I_GU + I_D) / CONV_CHUNK, CONV_NCHUNK_WD = I_D / CONV_CHUNK;
static_assert(I_GU % CONV_CHUNK == 0 && I_D % CONV_CHUNK == 0, "conversion chunks");
__device__ __forceinline__ void conv_chunk(const Ctx& C, int chunk) {
    LAS unsigned* tile = (LAS unsigned*)(C.lds + RING_OFF + C.wave * 8192);
    p0_fp8_loop(C, chunk * CONV_CHUNK, CONV_CHUNK, C.wave, NWAVES, tile, (const LAS float*)(C.lds + RING_OFF + 65536));
}

using pg8::Unit;
template <int RB>
struct DenseOrderT {
    const char* A; const char* Bt; int nM, nN, nwg, G, c;
    __device__ __forceinline__ void init(const void* A_, const void* Bt_, int M, int N, int G_, int c_) { A = (const char*)A_; Bt = (const char*)Bt_; nM = M / 256; nN = N / 256; nwg = nM * nN; G = G_; c = c_; }
    __device__ __forceinline__ bool map(long L, Unit& u) const {
        if (L >= nwg) return false;
        int wgid = (int)L; { const int q = nwg / 8, r = nwg % 8, xcd = wgid % 8, off = wgid / 8; wgid = (xcd < r ? xcd * (q + 1) : r * (q + 1) + (xcd - r) * q) + off; }
        const int nig = 8 * nN, gid = wgid / nig, fm = gid * 8, gsz = (nM - fm) < 8 ? (nM - fm) : 8;
        u.pm = fm + ((wgid % nig) % gsz); u.pn = (wgid % nig) / gsz; u.e = 0; u.kind = 0; return true;
    }
    __device__ __forceinline__ bool next(int i, Unit& u) const { return map((long)i * G + c, u); }
    __device__ __forceinline__ const char* a_base(const Unit& u) const { return A + (size_t)u.pm * (256 * RB); }
    __device__ __forceinline__ const char* b_base(const Unit& u) const { return Bt + (size_t)u.pn * (256 * RB); }
    __device__ __forceinline__ void a_offs(const Unit&, const int (&R)[2], const int (&Cc)[2], unsigned (&vo)[2][2]) const {
#pragma unroll
        for (int h = 0; h < 2; ++h)
#pragma unroll
            for (int i = 0; i < 2; ++i) vo[h][i] = (unsigned)((h * 128 + R[i]) * RB + Cc[i] * 2);
    }
};
typedef DenseOrderT<4096> DenseOrder;
struct P1Order {
    DenseOrder d; const char* A1; const char* B1;
    __device__ __forceinline__ bool next(int i, Unit& u) const {
        const long L = (long)i * d.G + d.c;
        if (L < d.nwg) return d.map(L, u);
        const int r = (int)(L - d.nwg); if (r >= 8) return false;
        u.pm = r >> 2; u.pn = r & 3; u.e = 0; u.kind = 1; return true;
    }
    __device__ __forceinline__ const char* a_base(const Unit& u) const { return (u.kind ? A1 : d.A) + (size_t)u.pm * (256 * 2048 * 2); }
    __device__ __forceinline__ const char* b_base(const Unit& u) const { return (u.kind ? B1 : d.Bt) + (size_t)u.pn * (256 * 2048 * 2); }
    __device__ __forceinline__ void a_offs(const Unit& u, const int (&R)[2], const int (&Cc)[2], unsigned (&vo)[2][2]) const { d.a_offs(u, R, Cc, vo); }
};
struct P1bOrder {
    DenseOrderT<2048> d;
    __device__ __forceinline__ bool next(int i, Unit& u) const {
        const int c = d.c;
        if (c < 8) return i < 4 ? d.map((long)i * d.G + c, u) : false;
        if (i < 6) return d.map((long)i * d.G + c, u);
        if (i == 6 && c < 24) { const int idx = c - 8; return d.map((long)(4 + (idx & 1)) * d.G + (idx >> 1), u); }
        return false;
    }
    __device__ __forceinline__ const char* a_base(const Unit& u) const { return d.a_base(u); }
    __device__ __forceinline__ const char* b_base(const Unit& u) const { return d.b_base(u); }
    __device__ __forceinline__ void a_offs(const Unit& u, const int (&R)[2], const int (&Cc)[2], unsigned (&vo)[2][2]) const { d.a_offs(u, R, Cc, vo); }
};
struct P1bGrpOrder {
    DenseOrderT<2048> d;
    __device__ __forceinline__ bool next(int i, Unit& u) const { return d.map((long)i * d.G + d.c, u); }
    __device__ __forceinline__ const char* a_base(const Unit& u) const { return d.a_base(u); }
    __device__ __forceinline__ const char* b_base(const Unit& u) const { return d.b_base(u); }
    __device__ __forceinline__ void a_offs(const Unit& u, const int (&R)[2], const int (&Cc)[2], unsigned (&vo)[2][2]) const { d.a_offs(u, R, Cc, vo); }
};
#ifndef MOE_NGRP
#define MOE_NGRP 4
#endif
#ifndef MOE_XCD_LISTS
#define MOE_XCD_LISTS 0
#endif
template <bool GATHER, int NT, int RB>
struct MoeOrder {
    const char* A; const char* Bt; const int* tok; const int* cnt; const LAS int* tab; int G, c;
    __device__ __forceinline__ bool next(int i, Unit& u) const {
        const int tot = __builtin_amdgcn_readfirstlane(tab[32]);
        int L;
        if (MOE_XCD_LISTS && G == 256) { const int x = c >> 5, s_ = i * 32 + (c & 31), seg = ((tot + 255) >> 8) << 5; L = x * seg + s_; if (s_ >= seg || L >= tot) return false; }
        else { L = i * G + c; if (L >= tot) return false; }
        int e = 0;
#pragma unroll 1
        for (int j = 1; j < 32; ++j) e += (__builtin_amdgcn_readfirstlane(tab[j]) <= L) ? 1 : 0;
        const int j = L - __builtin_amdgcn_readfirstlane(tab[e]), mt = __builtin_amdgcn_readfirstlane(tab[33 + e]), per = mt * MOE_NGRP, ntg = j / per, r = j - ntg * per;
        u.e = e; u.pm = r / MOE_NGRP; u.pn = ntg * MOE_NGRP + (r % MOE_NGRP); u.kind = __builtin_amdgcn_readfirstlane(tab[65 + e]) + 256 * u.pm;
        return true;
    }
    __device__ __forceinline__ const char* a_base(const Unit& u) const { return GATHER ? A : A + (size_t)u.kind * RB; }
    __device__ __forceinline__ const char* b_base(const Unit& u) const { return Bt + ((size_t)u.e * NT + u.pn) * (256 * RB); }
    __device__ __forceinline__ void a_offs(const Unit& u, const int (&R)[2], const int (&Cc)[2], unsigned (&vo)[2][2]) const {
#pragma unroll
        for (int h = 0; h < 2; ++h)
#pragma unroll
            for (int i = 0; i < 2; ++i) {
                if constexpr (GATHER) { const int n_e = __builtin_amdgcn_readfirstlane(tab[97 + u.e]); int ri = 256 * u.pm + h * 128 + R[i]; ri = ri < n_e ? ri : n_e - 1;
                    const int row = tok[u.e * CAP + ri]; vo[h][i] = (unsigned)(row * RB + Cc[i] * 2); }
                else vo[h][i] = (unsigned)((h * 128 + R[i]) * RB + Cc[i] * 2);
            }
    }
};

struct EpiInProj {
    static constexpr bool PERM = true, MID = false, FP8 = false, ASM_MFMA = false, BTILED = false; static constexpr int SCALE_A = 0x7f, SCALE_B = 0x7f;
    bf16* QKV; bf16* Gt; bf16* MKV; int noop; const float* gk_fox; const float* gk_swa; const float* rope;
    __device__ __forceinline__ void mid(pg8::f32x4 (&)[2][2][4][2], const Unit&, int, int, int, int, int) const {}
    __device__ __forceinline__ void operator()(const pg8::f32x4 (&acc)[2][2][4][2], const Unit& u, int wr, int wc, int fr, int fq) const {
        asm volatile("" : "+v"(fr), "+v"(fq));
        if (noop) return;
        if (!u.kind && (u.pn == 3 || u.pn == 4 || u.pn == 5 || u.pn == 12)) {
            const bool swa = (u.pn == 12); const float* gp = (swa ? gk_swa : gk_fox) + 8 * fq;
            float gn[2][8];
#pragma unroll
            for (int bj = 0; bj < 2; ++bj) { const pg8::f32x4 a = *(const pg8::f32x4*)(gp + 32 * bj), b = *(const pg8::f32x4*)(gp + 32 * bj + 4);
                gn[bj][0] = a[0]; gn[bj][1] = a[1]; gn[bj][2] = a[2]; gn[bj][3] = a[3]; gn[bj][4] = b[0]; gn[bj][5] = b[1]; gn[bj][6] = b[2]; gn[bj][7] = b[3]; }
#pragma unroll
            for (int ai = 0; ai < 2; ++ai)
#pragma unroll
                for (int m = 0; m < 4; ++m) { const int row = u.pm * 256 + wr * 64 + fr + ai * 128 + m * 16;
                    float x[2][8]; float ss = 0.f;
#pragma unroll
                    for (int bj = 0; bj < 2; ++bj)
#pragma unroll
                        for (int n = 0; n < 2; ++n)
#pragma unroll
                            for (int e = 0; e < 4; ++e) { const float v = acc[ai][bj][m][n][e]; x[bj][4 * n + e] = v; ss += v * v; }
                    ss += __shfl_xor(ss, 16); ss += __shfl_xor(ss, 32);
                    const float rstd = 1.0f / sqrtf(ss * (1.f / 64.f) + NORM_EPS);
#pragma unroll
                    for (int bj = 0; bj < 2; ++bj)
#pragma unroll
                        for (int q = 0; q < 8; ++q) x[bj][q] = (x[bj][q] * rstd) * gn[bj][q];
                    if (swa) { const float* cs = rope + (size_t)row * 64 + 8 * fq;
                        const pg8::f32x4 c0 = *(const pg8::f32x4*)cs, c1 = *(const pg8::f32x4*)(cs + 4), s0 = *(const pg8::f32x4*)(cs + 32), s1 = *(const pg8::f32x4*)(cs + 36);
                        const float cc[8] = {c0[0], c0[1], c0[2], c0[3], c1[0], c1[1], c1[2], c1[3]}, sn[8] = {s0[0], s0[1], s0[2], s0[3], s1[0], s1[1], s1[2], s1[3]};
#pragma unroll
                        for (int q = 0; q < 8; ++q) { const float x1 = x[0][q], x2 = x[1][q]; x[0][q] = x1 * cc[q] - x2 * sn[q]; x[1][q] = x2 * cc[q] + x1 * sn[q]; } }
                    bf16* rowp = QKV + (size_t)row * QKVW + u.pn * 256 + 64 * wc + 8 * fq;
#pragma unroll
                    for (int bj = 0; bj < 2; ++bj) { u32x4 w; w.x = cvt_pk_bf16(x[bj][0], x[bj][1]); w.y = cvt_pk_bf16(x[bj][2], x[bj][3]); w.z = cvt_pk_bf16(x[bj][4], x[bj][5]); w.w = cvt_pk_bf16(x[bj][6], x[bj][7]);
                        *(u32x4*)(rowp + 32 * bj) = w; } }
            return;
        }
        const int row0 = u.pm * 256 + wr * 64 + fr;
        bf16* base; int ldc, colt; bool sg = false;
        if (u.kind) { base = MKV; ldc = 1024; colt = u.pn * 256; }
        else if (u.pn < 16) { base = QKV; ldc = QKVW; colt = u.pn * 256; }
        else { base = Gt; ldc = GW; colt = (u.pn - 16) * 256; sg = true; }
        const int col0 = colt + wc * 32 + 8 * fq;
#pragma unroll
        for (int ai = 0; ai < 2; ++ai)
#pragma unroll
            for (int m = 0; m < 4; ++m) { bf16* rowp = base + (size_t)(row0 + ai * 128 + m * 16) * ldc + col0;
#pragma unroll
                for (int bj = 0; bj < 2; ++bj) { pg8::f32x4 v0 = acc[ai][bj][m][0], v1 = acc[ai][bj][m][1];
                    if (sg) {
#pragma unroll
                        for (int q = 0; q < 4; ++q) { v0[q] = sigmoidf_(fmaxf(v0[q], -30.f)); v1[q] = sigmoidf_(fmaxf(v1[q], -30.f)); } }
                    u32x4 w; w.x = cvt_pk_bf16(v0[0], v0[1]); w.y = cvt_pk_bf16(v0[2], v0[3]); w.z = cvt_pk_bf16(v1[0], v1[1]); w.w = cvt_pk_bf16(v1[2], v1[3]);
                    *(u32x4*)(rowp + bj * 128) = w; } }
    }
};
#ifndef PROBE_GASM
#define PROBE_GASM true
#endif
struct EpiGates {
    static constexpr bool PERM = true, MID = false, FP8 = true, ASM_MFMA = PROBE_GASM, BTILED = true; static constexpr int SCALE_A = 127 - H8_SHIFT, SCALE_B = 127 - W8_SHIFT;
    bf16* Gt;
    __device__ __forceinline__ void mid(pg8::f32x4 (&)[2][2][4][2], const Unit&, int, int, int, int, int) const {}
    __device__ __forceinline__ void operator()(const pg8::f32x4 (&acc)[2][2][4][2], const Unit& u, int wr, int wc, int fr, int fq) const {
        asm volatile("" : "+v"(fr), "+v"(fq));
        const int row0 = u.pm * 256 + wr * 64 + fr, col0 = u.pn * 256 + wc * 32 + 8 * fq;
#pragma unroll
        for (int ai = 0; ai < 2; ++ai)
#pragma unroll
            for (int m = 0; m < 4; ++m) { bf16* rowp = Gt + (size_t)(row0 + ai * 128 + m * 16) * GW + col0;
#pragma unroll
                for (int bj = 0; bj < 2; ++bj) { unsigned wv[4];
#pragma unroll
                    for (int n = 0; n < 2; ++n)
#pragma unroll
                        for (int hq = 0; hq < 2; ++hq) { typedef pg8::f32x2 f2;
                            f2 x = {fmaxf(acc[ai][bj][m][n][2 * hq], -30.f), fmaxf(acc[ai][bj][m][n][2 * hq + 1], -30.f)};
                            const f2 t = x * (-LOG2E); f2 e; e.x = __builtin_amdgcn_exp2f(t.x); e.y = __builtin_amdgcn_exp2f(t.y);
                            const f2 d = e + 1.0f; wv[2 * n + hq] = cvt_pk_bf16(__builtin_amdgcn_rcpf(d.x), __builtin_amdgcn_rcpf(d.y)); }
                    u32x4 w; w.x = wv[0]; w.y = wv[1]; w.z = wv[2]; w.w = wv[3];
                    *(u32x4*)(rowp + bj * 128) = w; } }
    }
};
struct EpiMerge {
    static constexpr bool PERM = true, MID = true, FP8 = false, ASM_MFMA = false, BTILED = false; static constexpr int SCALE_A = 0x7f, SCALE_B = 0x7f;
    const bf16* Gt; bf16* O;
    __device__ __forceinline__ void mid(pg8::f32x4 (&acc)[2][2][4][2], const Unit& u, int which, int wr, int wc, int fr, int fq) const {
        asm volatile("" : "+v"(fr), "+v"(fq));
        const int row0 = u.pm * 256 + wr * 64 + fr, col0 = u.pn * 256 + wc * 32 + 8 * fq;
        const bf16* gn = Gt + (which ? 2048 : 0); const bf16* gd = Gt + (which ? 4096 : 2048);
#pragma unroll
        for (int ai = 0; ai < 2; ++ai)
#pragma unroll
            for (int m = 0; m < 4; ++m) { const size_t ro = (size_t)(row0 + ai * 128 + m * 16) * GW + col0;
#pragma unroll
                for (int bj = 0; bj < 2; ++bj) { const u32x4 a = *(const u32x4*)(gn + ro + bj * 128), b = *(const u32x4*)(gd + ro + bj * 128);
                    pg8::f32x4 r0, r1;
                    r0[0] = bf_lo(a.x) * __builtin_amdgcn_rcpf(bf_lo(b.x)); r0[1] = bf_hi(a.x) * __builtin_amdgcn_rcpf(bf_hi(b.x)); r0[2] = bf_lo(a.y) * __builtin_amdgcn_rcpf(bf_lo(b.y)); r0[3] = bf_hi(a.y) * __builtin_amdgcn_rcpf(bf_hi(b.y));
                    r1[0] = bf_lo(a.z) * __builtin_amdgcn_rcpf(bf_lo(b.z)); r1[1] = bf_hi(a.z) * __builtin_amdgcn_rcpf(bf_hi(b.z)); r1[2] = bf_lo(a.w) * __builtin_amdgcn_rcpf(bf_lo(b.w)); r1[3] = bf_hi(a.w) * __builtin_amdgcn_rcpf(bf_hi(b.w));
                    acc[ai][bj][m][0] *= r0; acc[ai][bj][m][1] *= r1; }
                asm volatile("" : "+v"(acc[ai][0][m][0]), "+v"(acc[ai][0][m][1]), "+v"(acc[ai][1][m][0]), "+v"(acc[ai][1][m][1]));
                asm volatile("" ::: "memory"); }
    }
    __device__ __forceinline__ void operator()(const pg8::f32x4 (&acc)[2][2][4][2], const Unit& u, int wr, int wc, int fr, int fq) const {
        asm volatile("" : "+v"(fr), "+v"(fq));
        const int row0 = u.pm * 256 + wr * 64 + fr, col0 = u.pn * 256 + wc * 32 + 8 * fq;
#pragma unroll
        for (int ai = 0; ai < 2; ++ai)
#pragma unroll
            for (int m = 0; m < 4; ++m) { const size_t rr = (size_t)(row0 + ai * 128 + m * 16);
#pragma unroll
                for (int bj = 0; bj < 2; ++bj) { const u32x4 g = *(const u32x4*)(Gt + rr * GW + 4096 + col0 + bj * 128);
                    const pg8::f32x4 v0 = acc[ai][bj][m][0], v1 = acc[ai][bj][m][1];
                    u32x4 w; w.x = cvt_pk_bf16(v0[0] * bf_lo(g.x), v0[1] * bf_hi(g.x)); w.y = cvt_pk_bf16(v0[2] * bf_lo(g.y), v0[3] * bf_hi(g.y));
                    w.z = cvt_pk_bf16(v1[0] * bf_lo(g.z), v1[1] * bf_hi(g.z)); w.w = cvt_pk_bf16(v1[2] * bf_lo(g.w), v1[3] * bf_hi(g.w));
                    *(u32x4*)(O + rr * DM + col0 + bj * 128) = w; }
                asm volatile("" ::: "memory"); }
    }
};
struct EpiOut {
    static constexpr bool PERM = true, MID = false, FP8 = false, ASM_MFMA = false, BTILED = false; static constexpr int SCALE_A = 0x7f, SCALE_B = 0x7f;
    const float* X; float* out; unsigned char* HB8; int noop;
    __device__ __forceinline__ void mid(pg8::f32x4 (&)[2][2][4][2], const Unit&, int, int, int, int, int) const {}
    __device__ __forceinline__ void operator()(const pg8::f32x4 (&acc)[2][2][4][2], const Unit& u, int wr, int wc, int fr, int fq) const {
        asm volatile("" : "+v"(fr), "+v"(fq));
        if (noop) return;
        const int row0 = u.pm * 256 + wr * 64 + fr, col0 = u.pn * 256 + wc * 32 + 8 * fq;
#pragma unroll
        for (int ai = 0; ai < 2; ++ai)
#pragma unroll
            for (int mp = 0; mp < 2; ++mp) {
                pg8::f32x4 xv[2][2][2];
#pragma unroll
                for (int mm = 0; mm < 2; ++mm) { const size_t off = (size_t)(row0 + ai * 128 + (2 * mp + mm) * 16) * DM + col0;
#pragma unroll
                    for (int bj = 0; bj < 2; ++bj) { xv[mm][bj][0] = *(const pg8::f32x4*)(X + off + bj * 128); xv[mm][bj][1] = *(const pg8::f32x4*)(X + off + bj * 128 + 4); } }
#pragma unroll
                for (int mm = 0; mm < 2; ++mm) { const int m = 2 * mp + mm; const size_t off = (size_t)(row0 + ai * 128 + m * 16) * DM + col0;
#pragma unroll
                    for (int bj = 0; bj < 2; ++bj) { const pg8::f32x4 h0 = xv[mm][bj][0] + acc[ai][bj][m][0], h1 = xv[mm][bj][1] + acc[ai][bj][m][1];
                        *(pg8::f32x4*)(out + off + bj * 128) = h0; *(pg8::f32x4*)(out + off + bj * 128 + 4) = h1;
                        u32x2 w; w.x = pk4_fp8(h0[0] * H8_MUL, h0[1] * H8_MUL, h0[2] * H8_MUL, h0[3] * H8_MUL); w.y = pk4_fp8(h1[0] * H8_MUL, h1[1] * H8_MUL, h1[2] * H8_MUL, h1[3] * H8_MUL);
                        *(u32x2*)(HB8 + off + bj * 128) = w; } }
                asm volatile("" ::: "memory");
            }
    }
};
struct EpiGateUp {
    static constexpr bool PERM = true, MID = false, FP8 = true, ASM_MFMA = true, BTILED = true; static constexpr int SCALE_A = 127 - H8_SHIFT, SCALE_B = 127 - W8_SHIFT;
    const float* RS; const float* bgu; unsigned char* ACT8;
    __device__ __forceinline__ void mid(pg8::f32x4 (&)[2][2][4][2], const Unit&, int, int, int, int, int) const {}
    __device__ __forceinline__ void operator()(const pg8::f32x4 (&acc)[2][2][4][2], const Unit& u, int wr, int wc, int fr, int fq) const {
        asm volatile("" : "+v"(fr), "+v"(fq));
        const int r0 = wr * 64 + fr, hc0 = u.pn * 128 + wc * 32 + 8 * fq;
        const float* bg = bgu + (size_t)u.e * 4096 + hc0;
        const pg8::f32x4 bg0 = *(const pg8::f32x4*)(bg), bg1 = *(const pg8::f32x4*)(bg + 4), bu0 = *(const pg8::f32x4*)(bg + 2048), bu1 = *(const pg8::f32x4*)(bg + 2052);
        float rsv[2][4];
#pragma unroll
        for (int ai = 0; ai < 2; ++ai)
#pragma unroll
            for (int m = 0; m < 4; ++m) rsv[ai][m] = RS[u.e * CAP + 256 * u.pm + r0 + ai * 128 + m * 16];
#pragma unroll
        for (int ai = 0; ai < 2; ++ai)
#pragma unroll
            for (int m = 0; m < 4; ++m) { const int rl = r0 + ai * 128 + m * 16;
                const float rs = rsv[ai][m];
                typedef pg8::f32x2 f2;
                f2 a2[4];
#pragma unroll
                for (int n = 0; n < 2; ++n)
#pragma unroll
                    for (int hq = 0; hq < 2; ++hq) {
                        const f2 ag = {acc[ai][0][m][n][2 * hq], acc[ai][0][m][n][2 * hq + 1]}, au = {acc[ai][1][m][n][2 * hq], acc[ai][1][m][n][2 * hq + 1]};
                        const f2 bgv = n ? (f2){bg1[2 * hq], bg1[2 * hq + 1]} : (f2){bg0[2 * hq], bg0[2 * hq + 1]}, buv = n ? (f2){bu1[2 * hq], bu1[2 * hq + 1]} : (f2){bu0[2 * hq], bu0[2 * hq + 1]};
                        f2 g = ag * rs + bgv, up = au * rs + buv;
                        g.x = fminf(g.x, SWIGLU_LIMIT); g.y = fminf(g.y, SWIGLU_LIMIT);
                        up.x = __builtin_amdgcn_fmed3f(up.x, -SWIGLU_LIMIT, SWIGLU_LIMIT); up.y = __builtin_amdgcn_fmed3f(up.y, -SWIGLU_LIMIT, SWIGLU_LIMIT);
                        const f2 t = g * (-SWIGLU_ALPHA * LOG2E);
                        f2 e; e.x = __builtin_amdgcn_exp2f(t.x); e.y = __builtin_amdgcn_exp2f(t.y);
                        const f2 d = e + 1.0f;
                        f2 r; r.x = __builtin_amdgcn_rcpf(d.x); r.y = __builtin_amdgcn_rcpf(d.y);
                        const f2 sg = (g * ACT8_MUL) * r;
                        a2[2 * n + hq] = up * sg + sg;
                    }
                u32x2 w;
                { int p0 = __builtin_amdgcn_cvt_pk_fp8_f32(a2[0].x, a2[0].y, 0, false); p0 = __builtin_amdgcn_cvt_pk_fp8_f32(a2[1].x, a2[1].y, p0, true); w.x = (unsigned)p0;
                  int p1 = __builtin_amdgcn_cvt_pk_fp8_f32(a2[2].x, a2[2].y, 0, false); p1 = __builtin_amdgcn_cvt_pk_fp8_f32(a2[3].x, a2[3].y, p1, true); w.y = (unsigned)p1; }
                *(u32x2*)(ACT8 + (size_t)(u.kind + rl) * DM + hc0) = w; }
    }
};
struct EpiDown {
    static constexpr bool PERM = true, MID = false, FP8 = true, ASM_MFMA = true, BTILED = true; static constexpr int SCALE_A = 127 - ACT8_SHIFT, SCALE_B = 127 - W8_SHIFT;
    const float* bd; bf16* Y; int noop;
    __device__ __forceinline__ void mid(pg8::f32x4 (&)[2][2][4][2], const Unit&, int, int, int, int, int) const {}
    __device__ __forceinline__ void operator()(const pg8::f32x4 (&acc)[2][2][4][2], const Unit& u, int wr, int wc, int fr, int fq) const {
        asm volatile("" : "+v"(fr), "+v"(fq));
        if (noop) return;
        const int r0 = wr * 64 + fr, col0 = u.pn * 256 + wc * 32 + 8 * fq;
        const float* bb = bd + (size_t)u.e * DM + col0;
        pg8::f32x4 bv[2][2];
#pragma unroll
        for (int bj = 0; bj < 2; ++bj)
#pragma unroll
            for (int n = 0; n < 2; ++n) bv[bj][n] = *(const pg8::f32x4*)(bb + bj * 128 + n * 4);
#pragma unroll
        for (int ai = 0; ai < 2; ++ai)
#pragma unroll
            for (int m = 0; m < 4; ++m) { bf16* rowp = Y + (size_t)(u.kind + r0 + ai * 128 + m * 16) * DM + col0;
#pragma unroll
                for (int bj = 0; bj < 2; ++bj) { const pg8::f32x4 v0 = acc[ai][bj][m][0] + bv[bj][0], v1 = acc[ai][bj][m][1] + bv[bj][1];
                    u32x4 w; w.x = cvt_pk_bf16(v0[0], v0[1]); w.y = cvt_pk_bf16(v0[2], v0[3]); w.z = cvt_pk_bf16(v1[0], v1[1]); w.w = cvt_pk_bf16(v1[2], v1[3]);
                    *(u32x4*)(rowp + bj * 128) = w; } }
    }
};

__device__ __forceinline__ void logf_cumsum(const Ctx& C) {
    LAS float* wt = (LAS float*)(C.lds + RING_OFF);
    for (int sq = (int)blockIdx.x; sq < BATCH * 12; sq += C.G) {
        const float* src = C.LOGF + (size_t)sq * SEQ + C.tid * 16; float* dst = C.CNEG + (size_t)sq * SEQ + C.tid * 16;
        f32x4 a[4]; float tot = 0.f;
#pragma unroll
        for (int j = 0; j < 4; ++j) { a[j] = *(const GAS f32x4*)(src + 4 * j); tot += (a[j].x + a[j].y) + (a[j].z + a[j].w); }
        float incl = tot;
#pragma unroll
        for (int o = 1; o < 64; o <<= 1) { const float n = __shfl_up(incl, o); if (C.lane >= o) incl += n; }
        if (C.lane == 63) wt[C.wave] = incl;
        __syncthreads();
        float run = incl - tot;
        for (int w = 0; w < C.wave; ++w) run += wt[w];
#pragma unroll
        for (int j = 0; j < 4; ++j) { f32x4 c; run += a[j].x; c.x = -run * LOG2E; run += a[j].y; c.y = -run * LOG2E; run += a[j].z; c.z = -run * LOG2E; run += a[j].w; c.w = -run * LOG2E; *(GAS f32x4*)(dst + 4 * j) = c; }
        __syncthreads();
    }
}

#ifndef CONV_FIRST_QUARTERS
#define CONV_FIRST_QUARTERS 2
#endif
namespace att {
typedef __attribute__((address_space(3))) const char* lds_cptr;
__device__ __forceinline__ void glds16(const void* gsrc, unsigned lds_dst) { unsigned keep;
    asm volatile("s_mov_b32 %0, m0\n\ts_mov_b32 m0, %2\n\ts_nop 0\n\tglobal_load_lds_dwordx4 %1, off\n\ts_mov_b32 m0, %0" : "=&s"(keep) : "v"(gsrc), "s"(lds_dst) : "memory"); }
typedef float f32x2_t __attribute__((ext_vector_type(2))); typedef __bf16 bf16x2_t __attribute__((ext_vector_type(2)));
__device__ __forceinline__ unsigned cvtpk_s(float lo, float hi) { f32x2_t v = {lo, hi}; bf16x2_t b = __builtin_convertvector(v, bf16x2_t); return __builtin_bit_cast(unsigned, b); }
__device__ __forceinline__ int crow(int r, int hi) { return (r & 3) + 8 * (r >> 2) + 4 * hi; }

template <int D> struct Geo {
    static constexpr int SLOTB = 64 * D * 2, NSLOT = (D == 64) ? 3 : 2, PPT = (D == 64) ? 2 : 4;
    static constexpr int LDS_K = 0, LDS_V = NSLOT * SLOTB, LDS_WS = 2 * NSLOT * SLOTB, LDS_WMIN = LDS_WS + 2048, LDS_OST = LDS_WMIN + 64, LDS_CB = LDS_OST + 8 * 4096, LDS_END = LDS_CB + 32768;
};

template <int D>
__device__ __forceinline__ void qkt(f32x16& p0, f32x16& p1, lds_cptr Kslot, const bf16x8* qr, int r32, int hi) {
    lds_cptr kb = Kslot + hi * 1024 + r32 * 16;
    p0 = f32x16{}; p1 = f32x16{};
#pragma unroll
    for (int d0 = 0; d0 < D / 16; ++d0) {
        const bf16x8 b0 = *(const LAS bf16x8*)(kb + d0 * 2048);
        const bf16x8 b1 = *(const LAS bf16x8*)(kb + d0 * 2048 + 512);
        p0 = __builtin_amdgcn_mfma_f32_32x32x16_bf16(b0, qr[d0], p0, 0, 0, 0); p1 = __builtin_amdgcn_mfma_f32_32x32x16_bf16(b1, qr[d0], p1, 0, 0, 0); }
}
template <int D>
__device__ __forceinline__ void pv(f32x16* o, int vb, bf16x8 pa0, bf16x8 pa1, bf16x8 pa2, bf16x8 pa3) {
#pragma unroll
    for (int d0 = 0; d0 < D / 32; ++d0) { s16x4 lo[4], hi[4];
#pragma unroll
        for (int ks = 0; ks < 4; ++ks) {
            asm volatile("ds_read_b64_tr_b16 %0,%1 offset:%c2" : "=&v"(lo[ks]) : "v"(vb), "i"(d0 * 4096 + ks * 1024) : "memory");
            asm volatile("ds_read_b64_tr_b16 %0,%1 offset:%c2" : "=&v"(hi[ks]) : "v"(vb), "i"(d0 * 4096 + ks * 1024 + 512) : "memory"); }
        asm volatile("s_waitcnt lgkmcnt(0)" ::: "memory"); __builtin_amdgcn_sched_barrier(0);
#define ATT_PK(k) (bf16x8){lo[k][0], lo[k][1], lo[k][2], lo[k][3], hi[k][0], hi[k][1], hi[k][2], hi[k][3]}
        o[d0] = __builtin_amdgcn_mfma_f32_32x32x16_bf16(pa0, ATT_PK(0), o[d0], 0, 0, 0);
        o[d0] = __builtin_amdgcn_mfma_f32_32x32x16_bf16(pa1, ATT_PK(1), o[d0], 0, 0, 0);
        o[d0] = __builtin_amdgcn_mfma_f32_32x32x16_bf16(pa2, ATT_PK(2), o[d0], 0, 0, 0);
        o[d0] = __builtin_amdgcn_mfma_f32_32x32x16_bf16(pa3, ATT_PK(3), o[d0], 0, 0, 0);
#undef ATT_PK
    }
}

template <int D, int MODE>
__device__ __forceinline__ void attn_unit(LAS unsigned char* shm, const bf16* Q, int pitchQ, const bf16* K, const bf16* V, int pitchKV, bf16* O, const float* cneg, float sink2, int qb, const float* qgain, const float* kgain, const float* ropet, float bqk = 0.f) {
    typedef Geo<D> G;
    int tid = threadIdx.x; asm volatile("" : "+v"(tid));
    const int lane = tid & 63, r32 = lane & 31, hi = lane >> 5; const int wid = __builtin_amdgcn_readfirstlane(tid >> 6);
    const int q0 = qb * 256, q0w = q0 + wid * 32;
    const unsigned lds0 = (unsigned)(uintptr_t)shm;
    LAS float* wsf = (LAS float*)(shm + G::LDS_WS) + wid * 64;
    LAS float* cb = (LAS float*)(shm + G::LDS_CB);
    const int j_lo = (MODE == 1) ? (qb > 0 ? 4 * qb - 2 : 0) : 0, j_hi = (MODE == 2) ? 4 : 4 * qb + 4;
    bf16x8 qr[D / 16];
    { const bf16* Qw = Q + (size_t)(q0w + r32) * pitchQ + hi * 8;
#pragma unroll
      for (int d0 = 0; d0 < D / 16; ++d0) qr[d0] = *(const GAS bf16x8*)(Qw + d0 * 16); }
    {
#define ATT_UNPK(dst, src) do { const v4u w_ = __builtin_bit_cast(v4u, src); dst[0] = pg8::bf_lo(w_.x); dst[1] = pg8::bf_hi(w_.x); dst[2] = pg8::bf_lo(w_.y); dst[3] = pg8::bf_hi(w_.y); dst[4] = pg8::bf_lo(w_.z); dst[5] = pg8::bf_hi(w_.z); dst[6] = pg8::bf_lo(w_.w); dst[7] = pg8::bf_hi(w_.w); } while (0)
#define ATT_PK8(dst, src) do { v4u w_; w_.x = cvtpk_s(src[0], src[1]); w_.y = cvtpk_s(src[2], src[3]); w_.z = cvtpk_s(src[4], src[5]); w_.w = cvtpk_s(src[6], src[7]); dst = __builtin_bit_cast(bf16x8, w_); } while (0)
        float ss = 0.f;
#pragma unroll
        for (int d0 = 0; d0 < D / 16; ++d0) { float t[8]; ATT_UNPK(t, qr[d0]);
#pragma unroll
            for (int j = 0; j < 8; ++j) ss += t[j] * t[j]; }
        { auto rr = __builtin_amdgcn_permlane32_swap(__float_as_uint(ss), __float_as_uint(ss), false, false); ss = __uint_as_float(rr[0]) + __uint_as_float(rr[1]); }
        const float rq = (1.0f / sqrtf(ss * (1.f / D) + NORM_EPS)) * ((D == 64 ? 0.125f : 0.08838834764831845f) * LOG2E);
        if constexpr (MODE == 1) {
            const float* cs = ropet + (size_t)(q0w + r32) * 64 + 8 * hi;
#pragma unroll
            for (int d0 = 0; d0 < 2; ++d0) { float x1[8], x2[8]; ATT_UNPK(x1, qr[d0]); ATT_UNPK(x2, qr[d0 + 2]);
                const float* g1 = qgain + 16 * d0 + 8 * hi;
                const f32x4 ga = *(const GAS f32x4*)g1, gb = *(const GAS f32x4*)(g1 + 4), gc = *(const GAS f32x4*)(g1 + 32), gd = *(const GAS f32x4*)(g1 + 36);
                const f32x4 c0 = *(const GAS f32x4*)(cs + 16 * d0), c1 = *(const GAS f32x4*)(cs + 16 * d0 + 4), s0 = *(const GAS f32x4*)(cs + 32 + 16 * d0), s1 = *(const GAS f32x4*)(cs + 36 + 16 * d0);
                const float gg1[8] = {ga.x, ga.y, ga.z, ga.w, gb.x, gb.y, gb.z, gb.w}, gg2[8] = {gc.x, gc.y, gc.z, gc.w, gd.x, gd.y, gd.z, gd.w};
                const float cc[8] = {c0.x, c0.y, c0.z, c0.w, c1.x, c1.y, c1.z, c1.w}, sn[8] = {s0.x, s0.y, s0.z, s0.w, s1.x, s1.y, s1.z, s1.w};
#pragma unroll
                for (int j = 0; j < 8; ++j) { const float a = (x1[j] * rq) * gg1[j], b = (x2[j] * rq) * gg2[j]; x1[j] = a * cc[j] - b * sn[j]; x2[j] = b * cc[j] + a * sn[j]; }
                ATT_PK8(qr[d0], x1); ATT_PK8(qr[d0 + 2], x2); asm volatile("" ::: "memory"); }
        } else {
#pragma unroll
            for (int d0 = 0; d0 < D / 16; ++d0) { float t[8]; ATT_UNPK(t, qr[d0]);
                const float* gp = qgain + 16 * d0 + 8 * hi; f32x4 ga = *(const GAS f32x4*)gp, gb = *(const GAS f32x4*)(gp + 4);
                if constexpr (MODE == 2) { ga = ga * *(const GAS f32x4*)(kgain + 16 * d0 + 8 * hi); gb = gb * *(const GAS f32x4*)(kgain + 16 * d0 + 8 * hi + 4); }
                t[0] = (t[0] * rq) * ga.x; t[1] = (t[1] * rq) * ga.y; t[2] = (t[2] * rq) * ga.z; t[3] = (t[3] * rq) * ga.w; t[4] = (t[4] * rq) * gb.x; t[5] = (t[5] * rq) * gb.y; t[6] = (t[6] * rq) * gb.z; t[7] = (t[7] * rq) * gb.w;
                ATT_PK8(qr[d0], t); asm volatile("" ::: "memory"); }
        }
#undef ATT_UNPK
#undef ATT_PK8
    }
    if constexpr (MODE == 2) {
        const int key = tid >> 1, hf = tid & 1; const bf16* kp = K + (size_t)key * pitchKV + 64 * hf; float ss = 0.f;
#pragma unroll
        for (int c = 0; c < 8; ++c) { const v4u w = *(const GAS v4u*)(kp + 8 * c); const float a0 = pg8::bf_lo(w.x), a1 = pg8::bf_hi(w.x), a2 = pg8::bf_lo(w.y), a3 = pg8::bf_hi(w.y), a4 = pg8::bf_lo(w.z), a5 = pg8::bf_hi(w.z), a6 = pg8::bf_lo(w.w), a7 = pg8::bf_hi(w.w);
            ss += (a0 * a0 + a1 * a1) + (a2 * a2 + a3 * a3) + (a4 * a4 + a5 * a5) + (a6 * a6 + a7 * a7); }
        ss += __shfl_xor(ss, 1);
        if (hf == 0) cb[key] = 1.0f / sqrtf(ss * (1.f / 128.f) + NORM_EPS);
    }
    if constexpr (MODE == 0) {
        const int nch = (q0 + 256) / 4;
        for (int c = tid; c < nch; c += 512) { const f32x4 v = *(const GAS f32x4*)(cneg + 4 * c); *(LAS f32x4*)(cb + 4 * c) = v; }
    }
#define ATT_DMA(j, slot) do { const int _s = (slot) * G::SLOTB; \
        if constexpr (D == 64) { \
            glds16(K + (size_t)(64 * (j) + lane) * pitchKV + wid * 8, (unsigned)__builtin_amdgcn_readfirstlane(lds0 + G::LDS_K + _s + wid * 1024)); \
            glds16(V + (size_t)(64 * (j) + 16 * (wid & 3) + (lane >> 2)) * pitchKV + (wid >> 2) * 32 + (lane & 3) * 8, (unsigned)__builtin_amdgcn_readfirstlane(lds0 + G::LDS_V + _s + wid * 1024)); \
        } else { \
            _Pragma("unroll") for (int _p = 0; _p < 2; ++_p) { const int _c = wid + 8 * _p; \
                glds16(K + (size_t)(64 * (j) + lane) * pitchKV + _c * 8, (unsigned)__builtin_amdgcn_readfirstlane(lds0 + G::LDS_K + _s + _c * 1024)); } \
            _Pragma("unroll") for (int _p = 0; _p < 2; ++_p) { const int _c = wid + 8 * _p; \
                glds16(V + (size_t)(64 * (j) + 16 * (_c & 3) + (lane >> 2)) * pitchKV + (_c >> 2) * 32 + (lane & 3) * 8, (unsigned)__builtin_amdgcn_readfirstlane(lds0 + G::LDS_V + _s + _c * 1024)); } \
        } } while (0)
    int slot_i = 0;
    constexpr bool REV = (MODE == 0);
    const int nst = j_hi - j_lo;
#define ATT_TILE(st_) (REV ? (j_hi - 1 - (st_)) : (j_lo + (st_)))
#pragma unroll
    for (int p = 0; p < G::NSLOT - 1; ++p) if (p < nst) ATT_DMA(ATT_TILE(p), p);
    float mhat = -1e30f, l_reg = 0.f; f32x16 o[D / 32];
#pragma unroll
    for (int d0 = 0; d0 < D / 32; ++d0) o[d0] = f32x16{};
    const lds_cptr shm3 = (lds_cptr)shm;
    const int vb0 = (int)(lds0 + G::LDS_V) + ((lane >> 4) & 1) * 32 + (lane & 3) * 8 + (4 * hi + ((lane & 15) >> 2)) * 64;
    const int qabs = q0w + r32;
    LAS float* wmin = (LAS float*)(shm + G::LDS_WMIN);
    for (int st = 0; st < nst; ++st) {
        const int j = ATT_TILE(st);
        if (G::NSLOT == 3 && st + 1 < nst) { if constexpr (G::PPT == 2) asm volatile("s_waitcnt vmcnt(2) lgkmcnt(0)\n\ts_barrier" ::: "memory"); else asm volatile("s_waitcnt vmcnt(4) lgkmcnt(0)\n\ts_barrier" ::: "memory"); }
        else asm volatile("s_waitcnt vmcnt(0) lgkmcnt(0)\n\ts_barrier" ::: "memory");
        if constexpr (MODE == 0) { if (st >= 5) {
            const LAS float* wm = wmin + ((st - 1) & 1) * 8; const f32x4 a = *(const LAS f32x4*)wm, b = *(const LAS f32x4*)(wm + 4);
            const float gmin = fminf(fminf(fminf(a.x, a.y), fminf(a.z, a.w)), fminf(fminf(b.x, b.y), fminf(b.z, b.w)));
            if (cb[64 * j + 63] + bqk < gmin - 40.0f) break; } }
        { const int sn_ = st + G::NSLOT - 1; if (sn_ < nst) { int sn = slot_i + G::NSLOT - 1; if (sn >= G::NSLOT) sn -= G::NSLOT; ATT_DMA(ATT_TILE(sn_), sn); } }
        bool need = true;
        if constexpr (MODE == 0) need = (64 * j <= q0w + 31);
        if constexpr (MODE == 1) need = (64 * j <= q0w + 31) && (64 * j + 63 >= q0w - 127);
        if (need) {
            f32x16 p0, p1;
            qkt<D>(p0, p1, shm3 + G::LDS_K + slot_i * G::SLOTB, qr, r32, hi);
            if constexpr (MODE == 2) {
                const LAS float* rkp = cb + 64 * j + 4 * hi;
#pragma unroll
                for (int g = 0; g < 4; ++g) { const f32x4 b0 = *(const LAS f32x4*)(rkp + 8 * g), b1 = *(const LAS f32x4*)(rkp + 32 + 8 * g);
#pragma unroll
                    for (int e = 0; e < 4; ++e) { p0[4 * g + e] *= b0[e]; p1[4 * g + e] *= b1[e]; } }
            }
            if constexpr (MODE == 0) {
                const LAS float* cbp = cb + 64 * j + 4 * hi;
#pragma unroll
                for (int g = 0; g < 4; ++g) { const f32x4 b0 = *(const LAS f32x4*)(cbp + 8 * g), b1 = *(const LAS f32x4*)(cbp + 32 + 8 * g);
#pragma unroll
                    for (int e = 0; e < 4; ++e) { p0[4 * g + e] += b0[e]; p1[4 * g + e] += b1[e]; } }
                if (64 * j + 63 > q0w) {
#pragma unroll
                    for (int r = 0; r < 16; ++r) { const int kv = 64 * j + crow(r, hi); if (kv > qabs) p0[r] = -INFINITY; if (kv + 32 > qabs) p1[r] = -INFINITY; } }
            }
            if constexpr (MODE == 1) {
#pragma unroll
                for (int r = 0; r < 16; ++r) { const int kv = 64 * j + crow(r, hi); const int d0_ = qabs - kv, d1_ = d0_ - 32;
                    if (d0_ < 0 || d0_ >= 128) p0[r] = -INFINITY; if (d1_ < 0 || d1_ >= 128) p1[r] = -INFINITY; }
            }
            float rm = fmaxf(p0[0], p1[0]);
#pragma unroll
            for (int r = 1; r < 16; ++r) rm = fmaxf(rm, fmaxf(p0[r], p1[r]));
            { auto rr = __builtin_amdgcn_permlane32_swap(__float_as_uint(rm), __float_as_uint(rm), false, false); rm = fmaxf(__uint_as_float(rr[0]), __uint_as_float(rr[1])); }
            if (__any(rm > mhat)) {
                const float mn = fmaxf(mhat, rm); const float f = __builtin_amdgcn_exp2f(mhat - mn); mhat = mn; l_reg *= f;
                if (hi == 0) wsf[r32] = f;
                asm volatile("s_waitcnt lgkmcnt(0)" ::: "memory");
#pragma unroll
                for (int g = 0; g < 4; ++g) { const f32x4 fv = *(const LAS f32x4*)(wsf + 8 * g + 4 * hi);
#pragma unroll
                    for (int d_ = 0; d_ < D / 32; ++d_)
#pragma unroll
                        for (int e = 0; e < 4; ++e) o[d_][4 * g + e] *= fv[e]; }
            }
            float sacc = 0.f;
#pragma unroll
            for (int r = 0; r < 16; ++r) { p0[r] = __builtin_amdgcn_exp2f(p0[r] - mhat); p1[r] = __builtin_amdgcn_exp2f(p1[r] - mhat); sacc += p0[r] + p1[r]; }
            l_reg += sacc;
            u32x4 pw0, pw1, pw2, pw3;
            pw0 = (u32x4){cvtpk_s(p0[0], p0[1]), cvtpk_s(p0[2], p0[3]), cvtpk_s(p0[4], p0[5]), cvtpk_s(p0[6], p0[7])};
            pw1 = (u32x4){cvtpk_s(p0[8], p0[9]), cvtpk_s(p0[10], p0[11]), cvtpk_s(p0[12], p0[13]), cvtpk_s(p0[14], p0[15])};
            pw2 = (u32x4){cvtpk_s(p1[0], p1[1]), cvtpk_s(p1[2], p1[3]), cvtpk_s(p1[4], p1[5]), cvtpk_s(p1[6], p1[7])};
            pw3 = (u32x4){cvtpk_s(p1[8], p1[9]), cvtpk_s(p1[10], p1[11]), cvtpk_s(p1[12], p1[13]), cvtpk_s(p1[14], p1[15])};
            pv<D>(o, vb0 + slot_i * G::SLOTB, __builtin_bit_cast(bf16x8, pw0), __builtin_bit_cast(bf16x8, pw1), __builtin_bit_cast(bf16x8, pw2), __builtin_bit_cast(bf16x8, pw3));
        }
        if constexpr (MODE == 0) { float mn = mhat;
#pragma unroll
            for (int of = 1; of < 32; of <<= 1) mn = fminf(mn, __shfl_xor(mn, of));
            if (lane == 0) wmin[(st & 1) * 8 + wid] = mn; }
        ++slot_i; if (slot_i == G::NSLOT) slot_i = 0;
    }
#undef ATT_DMA
#undef ATT_TILE
    if constexpr (MODE == 0) asm volatile("s_waitcnt vmcnt(0)" ::: "memory");
    { auto rr = __builtin_amdgcn_permlane32_swap(__float_as_uint(l_reg), __float_as_uint(l_reg), false, false); l_reg = __uint_as_float(rr[0]) + __uint_as_float(rr[1]); }
    if constexpr (MODE == 1) l_reg += __builtin_amdgcn_exp2f(sink2 - mhat);
    if (hi == 0) wsf[32 + r32] = l_reg;
    asm volatile("s_waitcnt lgkmcnt(0)" ::: "memory");
    float rli[16];
#pragma unroll
    for (int g = 0; g < 4; ++g) { const f32x4 lv = *(const LAS f32x4*)(wsf + 32 + 8 * g + 4 * hi);
#pragma unroll
        for (int e = 0; e < 4; ++e) rli[4 * g + e] = __builtin_amdgcn_rcpf(lv[e]); }
    bf16* Ow = O + (size_t)q0w * 2048;
    LAS bf16* stg = (LAS bf16*)(shm + G::LDS_OST) + wid * 2048;
#pragma unroll
    for (int ps = 0; ps < D / 64; ++ps) {
#pragma unroll
        for (int r = 0; r < 16; ++r) { const int orow = crow(r, hi);
#pragma unroll
            for (int dl = 0; dl < 2; ++dl) stg[orow * 64 + dl * 32 + r32] = (bf16)f2bf(o[2 * ps + dl][r] * rli[r]); }
        asm volatile("s_waitcnt lgkmcnt(0)" ::: "memory");
#pragma unroll
        for (int i = 0; i < 4; ++i) { const int row = i * 8 + (lane >> 3), ch = lane & 7; const v4u v = *(const LAS v4u*)(stg + row * 64 + ch * 8); *(GAS v4u*)(Ow + (size_t)row * 2048 + ps * 64 + ch * 8) = v; }
        asm volatile("s_waitcnt lgkmcnt(0)" ::: "memory");
    }
    asm volatile("s_waitcnt lgkmcnt(0)\n\ts_barrier" ::: "memory");
}
}

constexpr int NU_FOX = BATCH * 12 * 32, NU_SWA = BATCH * 12 * 32, NU_XM = BATCH * 4 * 32;
__device__ __forceinline__ int att_fetch(const Ctx& C, int q) {
    int v = 0; if (C.tid == 0) v = (int)__hip_atomic_fetch_add((unsigned*)(C.ctl + CW_QHEAD + 64 * q), 1u, RLX_AGENT); return v;
}
__device__ __forceinline__ void phase3(const Ctx& C, int sel = 0) {
    LAS unsigned char* shm = C.lds + RING_OFF;
    volatile LAS int* nxtw = (volatile LAS int*)(C.MISC + 12);
    const bool gate_wg = GATES_IN_P3 && sel == 0 && (int)blockIdx.x < GATE_WGS;
    if (gate_wg) {
        P1bGrpOrder S8; S8.d.init(C.XN8, C.Win8, T, 6144, GATE_WGS, (int)blockIdx.x);
        EpiGates E8{C.G_};
        pg8::gemm_phase<EpiGates, P1bGrpOrder>(C.lds + RING_OFF, S8, E8);
        __syncthreads();
    }
    const bool conv_first = CONV_IN_P3 && sel == 0 && !gate_wg && (((blockIdx.x >> 3) & 3) < CONV_FIRST_QUARTERS);
    auto run_conv = [&]() {
        if (!(CONV_IN_P3 && (sel == 0 || sel == 8 || (sel == 9 && ((blockIdx.x >> 3) & 1))))) return;
        int pre = att_fetch(C, 3);
        if (C.tid == 0) *nxtw = pre;
        p0_fill_lnorm(C, (LAS float*)(C.lds + RING_OFF + 65536));
        __syncthreads();
        int cur = __builtin_amdgcn_readfirstlane(*nxtw);
        __syncthreads();
        while (cur < CONV_NCHUNK) {
            pre = att_fetch(C, 3);
            conv_chunk(C, cur);
            if (C.tid == 0) *nxtw = pre;
            __syncthreads();
            cur = __builtin_amdgcn_readfirstlane(*nxtw);
            __syncthreads();
        }
    };
    if (conv_first) run_conv();
    if (sel == 0 || sel == 4) {
        float gq = fabsf(C.fox_q_norm[C.lane]), gk = fabsf(C.fox_k_norm[C.lane]);
#pragma unroll
        for (int of = 1; of < 64; of <<= 1) { gq = fmaxf(gq, __shfl_xor(gq, of)); gk = fmaxf(gk, __shfl_xor(gk, of)); }
        const float bqk = 64.0f * gq * gk * (0.125f * LOG2E) * 1.02f;
        int pre = att_fetch(C, 0);
        if (C.tid == 0) *nxtw = pre;
        __syncthreads();
        int cur = __builtin_amdgcn_readfirstlane(*nxtw);
        __syncthreads();
        while (cur < NU_FOX) {
            pre = att_fetch(C, 0);
            const int qb = 31 - cur / 24, bh = cur % 24, b = bh / 12, h = bh % 12;
            const bf16* base = C.QKV + (size_t)b * SEQ * QKVW + h * 64;
            att::attn_unit<64, 0>(shm, base + C_FQ, QKVW, base + C_FK, base + C_FV, QKVW, C.OALL + (size_t)b * SEQ * 2048 + h * 64, C.CNEG + (size_t)(b * 12 + h) * SEQ, 0.f, qb, C.fox_q_norm, nullptr, nullptr, bqk);
            if (C.tid == 0) *nxtw = pre;
            __syncthreads();
            cur = __builtin_amdgcn_readfirstlane(*nxtw);
            __syncthreads();
        }
    }
    if (sel == 0 || sel == 5) {
        int pre = att_fetch(C, 1);
        if (C.tid == 0) *nxtw = pre;
        __syncthreads();
        int cur = __builtin_amdgcn_readfirstlane(*nxtw);
        __syncthreads();
        while (cur < NU_SWA) {
            pre = att_fetch(C, 1);
            const int qb = cur / 24, bh = cur % 24, b = bh / 12, h = bh % 12, kvh = h / 3;
            const bf16* base = C.QKV + (size_t)b * SEQ * QKVW;
            att::attn_unit<64, 1>(shm, base + C_SQ + h * 64, QKVW, base + C_SK + kvh * 64, base + C_SV + kvh * 64, QKVW, C.OALL + (size_t)b * SEQ * 2048 + 768 + h * 64, nullptr, C.swa_sinks[h] * LOG2E, qb, C.swa_q_norm, nullptr, C.ROPE + (size_t)b * SEQ * 64);
            if (C.tid == 0) *nxtw = pre;
            __syncthreads();
            cur = __builtin_amdgcn_readfirstlane(*nxtw);
            __syncthreads();
        }
    }
    if (sel == 0 || sel == 6) {
        int pre = att_fetch(C, 2);
        if (C.tid == 0) *nxtw = pre;
        __syncthreads();
        int cur = __builtin_amdgcn_readfirstlane(*nxtw);
        __syncthreads();
        while (cur < NU_XM) {
            pre = att_fetch(C, 2);
            const int qb = cur / 8, bh = cur % 8, b = bh / 4, h = bh % 4;
            const bf16* kb = C.MKV + (size_t)b * NMEM * 1024 + h * 128;
            att::attn_unit<128, 2>(shm, C.QKV + (size_t)b * SEQ * QKVW + C_MQ + h * 128, QKVW, kb, kb + 512, 1024, C.OALL + (size_t)b * SEQ * 2048 + 1536 + h * 128, nullptr, 0.f, qb, C.xmem_q_norm, C.xmem_k_norm, nullptr);
            if (C.tid == 0) *nxtw = pre;
            __syncthreads();
            cur = __builtin_amdgcn_readfirstlane(*nxtw);
            __syncthreads();
        }
    }
    if (!conv_first) run_conv();
}

__device__ __forceinline__ void phase6(const Ctx& C) {
    LAS float* PL = (LAS float*)(C.lds + RING_OFF);
    LAS float* SS = PL + 4 * 64 * 33;
    LAS int* hist = (LAS int*)(SS + 512);
    LAS int* gb = hist + 32;
    const int rg = C.wave & 1, kq = C.wave >> 1, r32 = C.lane & 31, hi = C.lane >> 5;
    const bf16* wh = C.Wr_t + (size_t)r32 * 2048 + 512 * kq + 16 * hi; const bf16* wl = wh + 32 * 2048;
    for (int blk = C.vcu; blk < T / 64; blk += C.G) {
        if (C.tid < 32) hist[C.tid] = 0;
        const int tok = blk * 64 + 32 * rg + r32;
        const float* hr = C.out + (size_t)tok * DM + 512 * kq + 16 * hi;
        f32x16 acc = f32x16{}; float ss = 0.f;
#pragma unroll 2
        for (int kb = 0; kb < 16; ++kb) {
            float f[16];
#pragma unroll
            for (int q = 0; q < 4; ++q) { const f32x4 t = *(const GAS f32x4*)(hr + 32 * kb + 4 * q); f[4 * q] = t.x; f[4 * q + 1] = t.y; f[4 * q + 2] = t.z; f[4 * q + 3] = t.w; }
            unsigned hb[16], lb[16];
#pragma unroll
            for (int q = 0; q < 16; ++q) { ss += f[q] * f[q]; hb[q] = f2bf(f[q]); lb[q] = f2bf(f[q] - __uint_as_float(hb[q] << 16)); }
#pragma unroll
            for (int s = 0; s < 2; ++s) {
                const bf16x8 ah = *(const GAS bf16x8*)(wh + 32 * kb + 8 * s), al = *(const GAS bf16x8*)(wl + 32 * kb + 8 * s);
                v4u bh, bl;
                bh.x = hb[8 * s] | (hb[8 * s + 1] << 16); bh.y = hb[8 * s + 2] | (hb[8 * s + 3] << 16); bh.z = hb[8 * s + 4] | (hb[8 * s + 5] << 16); bh.w = hb[8 * s + 6] | (hb[8 * s + 7] << 16);
                bl.x = lb[8 * s] | (lb[8 * s + 1] << 16); bl.y = lb[8 * s + 2] | (lb[8 * s + 3] << 16); bl.z = lb[8 * s + 4] | (lb[8 * s + 5] << 16); bl.w = lb[8 * s + 6] | (lb[8 * s + 7] << 16);
                acc = __builtin_amdgcn_mfma_f32_32x32x16_bf16(ah, __builtin_bit_cast(bf16x8, bh), acc, 0, 0, 0);
                acc = __builtin_amdgcn_mfma_f32_32x32x16_bf16(ah, __builtin_bit_cast(bf16x8, bl), acc, 0, 0, 0);
                acc = __builtin_amdgcn_mfma_f32_32x32x16_bf16(al, __builtin_bit_cast(bf16x8, bh), acc, 0, 0, 0);
            }
        }
        { LAS float* pr = PL + (size_t)(kq * 64 + 32 * rg + r32) * 33;
#pragma unroll
          for (int r = 0; r < 16; ++r) pr[att::crow(r, hi)] = acc[r];
          SS[(kq * 2 + hi) * 64 + 32 * rg + r32] = ss; }
        __syncthreads();
        int sel[4]; float gt[4]; float rstd = 0.f; int lr[4];
        if (C.tid < 64) {
            float lv[32]; float s2 = 0.f;
#pragma unroll
            for (int q = 0; q < 8; ++q) s2 += SS[q * 64 + C.tid];
            rstd = 1.0f / sqrtf(s2 * (1.f / DM) + NORM_EPS);
#pragma unroll
            for (int e = 0; e < 32; ++e) { const float a = (PL[(0 * 64 + C.tid) * 33 + e] + PL[(1 * 64 + C.tid) * 33 + e]) + (PL[(2 * 64 + C.tid) * 33 + e] + PL[(3 * 64 + C.tid) * 33 + e]); lv[e] = a * rstd + C.b_router[e]; }
            float val[4];
#pragma unroll
            for (int k = 0; k < 4; ++k) { float best = lv[0]; int bi = 0;
#pragma unroll
                for (int e = 1; e < 32; ++e) if (lv[e] > best) { best = lv[e]; bi = e; }
                sel[k] = bi; val[k] = best;
#pragma unroll
                for (int e = 0; e < 32; ++e) lv[e] = (e == bi) ? -INFINITY : lv[e]; }
            float den = 0.f;
#pragma unroll
            for (int k = 0; k < 4; ++k) { gt[k] = __expf(val[k] - val[0]); den += gt[k]; }
            const float inv = 1.0f / den;
#pragma unroll
            for (int k = 0; k < 4; ++k) { gt[k] *= inv; lr[k] = __hip_atomic_fetch_add((LAS int*)(hist + sel[k]), 1, __ATOMIC_RELAXED, __HIP_MEMORY_SCOPE_WORKGROUP); }
        }
        __syncthreads();
        if (C.tid < 32) gb[C.tid] = (int)__hip_atomic_fetch_add((unsigned*)(C.ctl + CW_CNT + C.tid), (unsigned)hist[C.tid], RLX_AGENT);
        __syncthreads();
        if (C.tid < 64) {
            const int t = blk * 64 + C.tid;
#pragma unroll
            for (int k = 0; k < 4; ++k) { const int sl = sel[k] * CAP + gb[sel[k]] + lr[k]; C.TOK[sl] = t; C.RS[sl] = rstd; C.TSLOT[t * 4 + k] = sl; C.TGATE[t * 4 + k] = gt[k]; }
        }
        __syncthreads();
    }
}
template <int NT>
__device__ __forceinline__ void moe_table(const Ctx& C, LAS int* tab) {
    __syncthreads();
    if (C.tid == 0) { int us = 0, rb = 0;
        for (int e = 0; e < 32; ++e) { const int n = (int)__hip_atomic_load((unsigned*)(C.ctl + CW_CNT + e), RLX_AGENT); const int mt = (n + 255) >> 8; tab[e] = us; tab[33 + e] = mt; tab[65 + e] = rb; tab[97 + e] = n; us += mt * NT; rb += mt * 256; }
        tab[32] = us; }
    __syncthreads();
}


__device__ __forceinline__ void phase9(const Ctx& C, const LAS int* tab) {
    const int gw = C.vcu * NWAVES + C.wave, NGW = C.G * NWAVES;
    for (int t = gw; t < T; t += NGW) {
        typedef int v4i_ __attribute__((ext_vector_type(4))); const v4i_ sl = *(const GAS v4i_*)(C.TSLOT + 4 * t); const f32x4 g = *(const GAS f32x4*)(C.TGATE + 4 * t);
        const int s[4] = {sl.x, sl.y, sl.z, sl.w}; const float gg[4] = {g.x, g.y, g.z, g.w};
        const bf16* yr[4];
#pragma unroll
        for (int k = 0; k < 4; ++k) { const int e = s[k] >> 14, rk = s[k] & (CAP - 1); yr[k] = C.Y + (size_t)(tab[65 + e] + rk) * DM + 8 * C.lane; }
        float* orow = C.out + (size_t)t * DM + 8 * C.lane;
#pragma unroll
        for (int j = 0; j < 4; ++j) {
            f32x4 a0 = *(const GAS f32x4*)(orow + 512 * j), a1 = *(const GAS f32x4*)(orow + 512 * j + 4);
#pragma unroll
            for (int k = 0; k < 4; ++k) { const v4u y = *(const GAS v4u*)(yr[k] + 512 * j);
                a0.x += gg[k] * pg8::bf_lo(y.x); a0.y += gg[k] * pg8::bf_hi(y.x); a0.z += gg[k] * pg8::bf_lo(y.y); a0.w += gg[k] * pg8::bf_hi(y.y);
                a1.x += gg[k] * pg8::bf_lo(y.z); a1.y += gg[k] * pg8::bf_hi(y.z); a1.z += gg[k] * pg8::bf_lo(y.w); a1.w += gg[k] * pg8::bf_hi(y.w); }
            *(GAS f32x4*)(orow + 512 * j) = a0; *(GAS f32x4*)(orow + 512 * j + 4) = a1;
        }
    }
}

struct Args { const void* in[26]; float* out; unsigned char* ws; int ph_lo, ph_hi, probe, pad; };
__global__ void __launch_bounds__(NWAVES * 64, 2) mk_fwd(Args args) {
    extern __shared__ __attribute__((aligned(16))) unsigned char lds_raw[];
    Ctx C;
    C.lds = (LAS unsigned char*)lds_raw;
    C.MISC = (volatile LAS unsigned*)(C.lds + MISC_OFF);
    C.tid = threadIdx.x; C.lane = C.tid & 63; C.wave = __builtin_amdgcn_readfirstlane(C.tid >> 6);
    C.probe = args.probe; C.G = gridDim.x; { const int bx = blockIdx.x; C.vcu = (C.G % 8 == 0) ? (bx % 8) * (C.G / 8) + bx / 8 : bx; }
    unsigned char* ws = args.ws;
    C.ctl = (gu32*)(ws + WS_CTL);
    C.x = (const float*)args.in[0]; C.mem = (const float*)args.in[1]; C.pos = (const int*)args.in[2]; C.norm_mix = (const float*)args.in[3]; C.w_in = (const float*)args.in[4];
    C.b_forget = (const float*)args.in[5]; C.fox_q_norm = (const float*)args.in[6]; C.fox_k_norm = (const float*)args.in[7]; C.swa_q_norm = (const float*)args.in[8]; C.swa_k_norm = (const float*)args.in[9];
    C.swa_sinks = (const float*)args.in[10]; C.xmem_q_norm = (const float*)args.in[11]; C.xmem_k_norm = (const float*)args.in[12]; C.norm_mem = (const float*)args.in[13]; C.w_mem_kv = (const float*)args.in[14];
    C.w_up_fox = (const float*)args.in[15]; C.w_up_swa = (const float*)args.in[16]; C.w_up_xmem = (const float*)args.in[17]; C.w_out = (const float*)args.in[18]; C.norm_ffn = (const float*)args.in[19];
    C.w_router = (const float*)args.in[20]; C.b_router = (const float*)args.in[21]; C.w_gate_up = (const float*)args.in[22]; C.b_gate_up = (const float*)args.in[23]; C.w_down = (const float*)args.in[24]; C.b_down = (const float*)args.in[25];
    C.out = args.out;
#define WS_PTRS() do { unsigned char* w_ = args.ws; asm volatile("" : "+s"(w_)); \
    C.ctl = (gu32*)(w_ + WS_CTL); C.Win_t = (bf16*)(w_ + WS_WIN); C.Wmkv_t = (bf16*)(w_ + WS_WMKV); C.Wup_t = (bf16*)(w_ + WS_WUP); C.Wout_t = (bf16*)(w_ + WS_WOUT); C.Wr_t = (bf16*)(w_ + WS_WRT); C.Wgu_t = (bf16*)(w_ + WS_WGU); C.Wd_t = (bf16*)(w_ + WS_WD); \
    C.XN = (bf16*)(w_ + WS_XN); C.MN = (bf16*)(w_ + WS_MN); C.QKV = (bf16*)(w_ + WS_QKV); C.G_ = (bf16*)(w_ + WS_G); C.MKV = (bf16*)(w_ + WS_MKV); C.OALL = (bf16*)(w_ + WS_OALL); C.MERGED = (bf16*)(w_ + WS_MERGED); \
    C.HB = (bf16*)(w_ + WS_HB); C.ACT = (bf16*)(w_ + WS_ACT); C.LOGF = (float*)(w_ + WS_LOGF); C.CNEG = (float*)(w_ + WS_CNEG); C.ROPE = (float*)(w_ + WS_ROPE); C.GATEW = (float*)(w_ + WS_GATE); C.RS = (float*)(w_ + WS_RS); \
    C.TOK = (int*)(w_ + WS_TOK); C.TSLOT = (int*)(w_ + WS_TSLOT); C.TGATE = (float*)(w_ + WS_TGATE); C.Y = (bf16*)(w_ + WS_Y); C.XN8 = w_ + WS_XN8; C.Win8 = w_ + WS_WIN8; } while (0)
    WS_PTRS();
    for (int u = C.tid; u < (LDS_BYTES - LDSCTL_OFF) / 4; u += NWAVES * 64) ((LAS unsigned*)(C.lds + LDSCTL_OFF))[u] = 0u;
    __syncthreads();
    XcdBarrier bar; bar.bar = (unsigned*)(C.ctl + CW_BAR); bar.x = 0; bar.st = nullptr;
    if (N_LAUNCHES == 1) bar = xcd_barrier_post((unsigned*)(C.ctl + CW_BAR), C.MISC + 8);
    const int lo = args.ph_lo, hi = args.ph_hi;
#ifndef MK_PHASE_MASK
#define MK_PHASE_MASK 0x3FF
#endif
#define IN(k) ((((MK_PHASE_MASK) >> (k)) & 1) && lo <= (k) && (k) < hi)
#define SEAM(k) do { if (IN(k) && IN((k) + 1)) xcd_barrier(bar); } while (0)
    LAS int* tab = (LAS int*)(C.lds + MOE_OFF);

    if (IN(0)) { WS_PTRS(); phase0(C); }
    SEAM(0);
    if (IN(1)) { WS_PTRS();
        logf_cumsum(C);
        P1Order S; S.d.init(C.XN, C.Win_t, T, PROBE_INW * 64, C.G, (int)blockIdx.x); S.A1 = (const char*)C.MN; S.B1 = (const char*)C.Wmkv_t;
        EpiInProj E{C.QKV, C.G_, C.MKV, args.probe == 1, C.fox_k_norm, C.swa_k_norm, C.ROPE};
        if (args.probe != 3) pg8::gemm_phase<EpiInProj, P1Order>(C.lds + RING_OFF, S, E);
        if (!GATES_IN_P3) {
            P1bOrder S8; S8.d.init(C.XN8, C.Win8, T, 6144, C.G, (int)blockIdx.x);
            EpiGates E8{C.G_};
#ifdef PROBE_HALFGRID
            if (args.probe == 3) {
                if ((int)blockIdx.x < PROBE_HALFGRID) { P1bGrpOrder Sg; Sg.d.init(C.XN8, C.Win8, T, 6144, PROBE_HALFGRID, (int)blockIdx.x); pg8::gemm_phase<EpiGates, P1bGrpOrder>(C.lds + RING_OFF, Sg, E8); }
            } else
#endif
            pg8::gemm_phase<EpiGates, P1bOrder>(C.lds + RING_OFF, S8, E8);
        }
    }
    SEAM(1);
    if (IN(3)) { WS_PTRS(); phase3(C, args.probe >= 4 ? args.probe : 0); }
    SEAM(3);
    if (IN(4)) { WS_PTRS();
        DenseOrder S; S.init(C.OALL, C.Wup_t, T, DM, C.G, (int)blockIdx.x);
        EpiMerge E{C.G_, C.MERGED};
        pg8::gemm_phase<EpiMerge, DenseOrder>(C.lds + RING_OFF, S, E);
    }
    SEAM(4);
    if (IN(5)) { WS_PTRS();
#ifdef P5_STAGGER
        if (((int)blockIdx.x >> 3) & 1) for (int d = 0; d < P5_STAGGER; ++d) __builtin_amdgcn_s_sleep(127);
#endif
        DenseOrder S; S.init(C.MERGED, C.Wout_t, T, DM, C.G, (int)blockIdx.x);
        EpiOut E{C.x, C.out, (unsigned char*)C.HB, args.probe == 1};
        pg8::gemm_phase<EpiOut, DenseOrder, false>(C.lds + RING_OFF, S, E);
    }
    SEAM(5);
    if (IN(6)) { WS_PTRS(); phase6(C); }
    SEAM(6);
    if (IN(7)) { WS_PTRS();
        moe_table<16>(C, tab);
        const int kx = (int)blockIdx.x >> 3; const bool conv_wg = WD_IN_P7 && CONV_IN_P3 && C.G == 256 && (kx % 5 == 4);
        if (conv_wg) {
            volatile LAS int* nxtw = (volatile LAS int*)(C.MISC + 12);
            int pre = att_fetch(C, 4);
            if (C.tid == 0) *nxtw = pre;
            __syncthreads();
            int cur = __builtin_amdgcn_readfirstlane(*nxtw);
            __syncthreads();
            while (cur < CONV_NCHUNK_WD) {
                pre = att_fetch(C, 4);
                conv_chunk(C, I_GU / CONV_CHUNK + cur);
                if (C.tid == 0) *nxtw = pre;
                __syncthreads();
                cur = __builtin_amdgcn_readfirstlane(*nxtw);
                __syncthreads();
            }
        } else {
            const bool split = WD_IN_P7 && CONV_IN_P3 && C.G == 256;
            const int gG = split ? 208 : C.G, gc = split ? ((int)blockIdx.x & 7) * 26 + (kx - (kx + 1) / 5) : C.vcu;
            MoeOrder<true, 16, 2048> S{(const char*)C.HB, (const char*)C.Wgu_t, C.TOK, (const int*)(C.ctl + CW_CNT), tab, gG, gc};
            EpiGateUp E{C.RS, C.b_gate_up, (unsigned char*)C.ACT};
            pg8::gemm_phase<EpiGateUp, MoeOrder<true, 16, 2048>>(C.lds + RING_OFF, S, E);
        }
    }
    SEAM(7);
    if (IN(8)) { WS_PTRS();
        moe_table<8>(C, tab);
#ifdef MOE_STAGGER
        for (int d = 0; d < (int)(blockIdx.x & 7); ++d) __builtin_amdgcn_s_sleep(MOE_STAGGER);
#endif
        MoeOrder<false, 8, 2048> S{(const char*)C.ACT, (const char*)C.Wd_t, C.TOK, (const int*)(C.ctl + CW_CNT), tab, C.G, C.vcu};
        EpiDown E{C.b_down, C.Y, args.probe == 1};
        pg8::gemm_phase<EpiDown, MoeOrder<false, 8, 2048>>(C.lds + RING_OFF, S, E);
    }
    SEAM(8);
    if (IN(9)) { WS_PTRS(); moe_table<8>(C, tab); phase9(C, tab);
#ifdef PROBE_DET
        if (blockIdx.x == 0 && C.tid == 0 && __hip_atomic_load((unsigned*)(C.ctl + 2048), RLX_AGENT) != 0u) C.out[12345] = __builtin_nanf("");
#endif
    }
#undef IN
#undef SEAM
}

extern "C" void kernel_launch(void* const* d_in, const int* in_sizes, int n_in, void* d_out, int out_size, void* d_ws, size_t ws_size, hipStream_t stream) {
    static int grid = 0;
    if (grid == 0) {
        if (n_in != 26 || out_size != T * DM || ws_size < WS_END) { fprintf(stderr, "kernel_launch: unexpected problem (n_in %d, out %d, ws %zu < %zu); nothing launched\n", n_in, out_size, ws_size, (size_t)WS_END); grid = -1; return; }
        int dev = 0, cus = 0, per_cu = 0;
        if (hipGetDevice(&dev) != hipSuccess || hipDeviceGetAttribute(&cus, hipDeviceAttributeMultiprocessorCount, dev) != hipSuccess) { grid = -1; return; }
        if (hipFuncSetAttribute((const void*)mk_fwd, hipFuncAttributeMaxDynamicSharedMemorySize, LDS_BYTES) != hipSuccess) { fprintf(stderr, "kernel_launch: hipFuncSetAttribute failed\n"); grid = -1; return; }
        if (hipOccupancyMaxActiveBlocksPerMultiprocessor(&per_cu, (const void*)mk_fwd, NWAVES * 64, LDS_BYTES) != hipSuccess || per_cu < 1) { fprintf(stderr, "kernel_launch: occupancy query says %d\n", per_cu); }
        (void)hipGetLastError();
        grid = cus;
    }
    if (grid < 0) return;
    if (hipMemsetAsync((char*)d_ws + WS_CTL, 0, CTL_ZERO_BYTES, stream) != hipSuccess) return;
#ifdef PROBE_MEMSET8
    hipMemsetAsync((char*)d_ws + WS_XN8, 0, 44 * MiB, stream);
#endif
    Args a{};
    for (int i = 0; i < 26; ++i) a.in[i] = d_in[i];
    a.out = (float*)d_out; a.ws = (unsigned char*)d_ws;
    if (N_LAUNCHES == 1) { a.ph_lo = 0; a.ph_hi = PER_PHASE; hipLaunchKernelGGL(mk_fwd, dim3(grid), dim3(NWAVES * 64), LDS_BYTES, stream, a); }
    else for (int oi = 0; oi < PER_PHASE; ++oi) { static const int order[PER_PHASE] = {0, 1, 2, 3, 4, 5, 6, 7, 8, 9}; const int li = order[oi]; a.ph_lo = li; a.ph_hi = li + 1;
#ifdef PROBE_SPLIT_P1
        if (li == 1) { a.probe = 2; hipLaunchKernelGGL(mk_fwd, dim3(grid), dim3(NWAVES * 64), LDS_BYTES, stream, a); a.probe = 3; hipLaunchKernelGGL(mk_fwd, dim3(grid), dim3(NWAVES * 64), LDS_BYTES, stream, a); a.probe = 0; continue; }
#endif
        hipLaunchKernelGGL(mk_fwd, dim3(grid), dim3(NWAVES * 64), LDS_BYTES, stream, a);
#ifdef PROBE_DUP
        if (li == PROBE_DUP) { if (PROBE_DUP == 3 || PROBE_DUP == 6) hipMemsetAsync((char*)d_ws + WS_CTL, 0, CTL_ZERO_BYTES / 2, stream);
#ifdef PROBE_FLAG
            a.probe = PROBE_FLAG;
#endif
            hipLaunchKernelGGL(mk_fwd, dim3(grid), dim3(NWAVES * 64), LDS_BYTES, stream, a); a.probe = 0; }
#endif
    }
    const hipError_t le = hipPeekAtLastError();
    if (le != hipSuccess) fprintf(stderr, "kernel_launch: launch failed: %s\n", hipGetErrorName(le));
}
```

```cpp
#include <hip/hip_runtime.h>
#include <cstdio>
#include <cstdint>

#define LAS __attribute__((address_space(3)))
#define GAS __attribute__((address_space(1)))

namespace pg8 {
typedef unsigned short bf16_t;
typedef short bf16x8 __attribute__((ext_vector_type(8)));
typedef float f32x4 __attribute__((ext_vector_type(4)));
typedef float f32x2 __attribute__((ext_vector_type(2)));
typedef unsigned u32x4 __attribute__((ext_vector_type(4)));
typedef unsigned u32x2 __attribute__((ext_vector_type(2)));
constexpr int BM = 256, BK = 64, HALF = 128, HTB = HALF * BK * 2, STAGE_BYTES = 8 * HTB, NXCD = 8, WGM = 8;
constexpr int KD = 2048;
typedef int v8i __attribute__((ext_vector_type(8))); typedef int v4i __attribute__((ext_vector_type(4)));
__device__ __forceinline__ v8i cat8(bf16x8 lo, bf16x8 hi) { const v4i a = __builtin_bit_cast(v4i, lo), b = __builtin_bit_cast(v4i, hi); return __builtin_shufflevector(a, b, 0, 1, 2, 3, 4, 5, 6, 7); }
__device__ __forceinline__ bf16x8 lo8(v8i v) { return __builtin_bit_cast(bf16x8, (v4i)__builtin_shufflevector(v, v, 0, 1, 2, 3)); }
__device__ __forceinline__ bf16x8 hi8(v8i v) { return __builtin_bit_cast(bf16x8, (v4i)__builtin_shufflevector(v, v, 4, 5, 6, 7)); }

__host__ __device__ __forceinline__ int lds_byte(int r, int c) { const int st = (r >> 4) * 2 + (c >> 5), rr = r & 15, cc = c & 31, ob = rr * 64 + cc * 2; return st * 1024 + (ob ^ (((ob >> 9) & 1) << 5)); }
__host__ __device__ __forceinline__ void stage_rc(int b, int& R, int& C) { const int st = b / 1024, sb = b % 1024, swz = sb ^ (((sb >> 9) & 1) << 5); R = (st >> 1) * 16 + swz / 64; C = (st & 1) * 32 + (swz % 64) / 2; }
__host__ __device__ __forceinline__ int perm32(int rho) { const int n = rho >> 4, i = rho & 15; return 8 * (i >> 2) + 4 * n + (i & 3); }

__device__ __forceinline__ void glds_s(const char* sbase, unsigned voff, unsigned lds_dst) { unsigned keep;
    asm volatile("s_mov_b32 %0, m0\n\ts_mov_b32 m0, %3\n\ts_nop 0\n\tglobal_load_lds_dwordx4 %1, %2\n\ts_mov_b32 m0, %0" : "=&s"(keep) : "v"(voff), "s"(sbase), "s"(lds_dst) : "memory"); }

#define PG8_PIN4(a, b, c, d, txt) asm volatile(txt : "+v"(a), "+v"(b), "+v"(c), "+v"(d))
#define PG8_PIN_ACC(txt) do { _Pragma("unroll") for (int _a = 0; _a < 2; ++_a) _Pragma("unroll") for (int _b = 0; _b < 2; ++_b) { \
        PG8_PIN4(acc[_a][_b][0][0], acc[_a][_b][0][1], acc[_a][_b][1][0], acc[_a][_b][1][1], ""); PG8_PIN4(acc[_a][_b][2][0], acc[_a][_b][2][1], acc[_a][_b][3][0], acc[_a][_b][3][1], ""); } \
        PG8_PIN4(acc[0][0][0][0], acc[0][1][0][0], acc[1][0][0][0], acc[1][1][0][0], txt); \
        _Pragma("unroll") for (int _a = 0; _a < 2; ++_a) _Pragma("unroll") for (int _b = 0; _b < 2; ++_b) { \
        PG8_PIN4(acc[_a][_b][0][0], acc[_a][_b][0][1], acc[_a][_b][1][0], acc[_a][_b][1][1], ""); PG8_PIN4(acc[_a][_b][2][0], acc[_a][_b][2][1], acc[_a][_b][3][0], acc[_a][_b][3][1], ""); } } while (0)

struct Unit { int pm, pn, e, kind; };

typedef float f32x2_cv __attribute__((ext_vector_type(2))); typedef __bf16 bf16x2_cv __attribute__((ext_vector_type(2)));
__device__ __forceinline__ unsigned cvt_pk_bf16(float lo, float hi) { const f32x2_cv v = {lo, hi}; const bf16x2_cv b = __builtin_convertvector(v, bf16x2_cv); return __builtin_bit_cast(unsigned, b); }
__device__ __forceinline__ float bf_lo(unsigned w) { return __uint_as_float(w << 16); }
__device__ __forceinline__ float bf_hi(unsigned w) { return __uint_as_float(w & 0xffff0000u); }

template <class Epi, class Sched, bool ALIGN_EPI = true, bool SP2 = true>
__device__ __forceinline__ void gemm_phase(LAS unsigned char* lds, const Sched& S, const Epi& E) {
    const int tid = threadIdx.x, wid = __builtin_amdgcn_readfirstlane(tid >> 6), lane = tid & 63, wr = wid >> 2, wc = wid & 3, fr = lane & 15, fq = lane >> 4;
    constexpr bool FP8 = Epi::FP8; constexpr int RB = FP8 ? 2048 : 4096, nt = RB / 128;
    unsigned voffB[2]; int RA[2], CA[2];
#pragma unroll
    for (int i = 0; i < 2; ++i) { int R, C; stage_rc(tid * 16 + i * 8192, R, C); const int Rb = Epi::PERM ? ((R & ~31) + perm32(R & 31)) : R;
        voffB[i] = (unsigned)(Rb * (Epi::BTILED ? 128 : RB) + C * 2); RA[i] = R; CA[i] = C; }
    constexpr size_t kstep = (size_t)(BK * 2);
    constexpr size_t hstep = (size_t)HALF * RB;
    constexpr size_t bkstep = Epi::BTILED ? (size_t)32768 : kstep, bhstep = Epi::BTILED ? (size_t)16384 : hstep;
    const unsigned ldsbase = (unsigned)__builtin_amdgcn_readfirstlane((unsigned)(uintptr_t)lds + (unsigned)wid * 1024u);
    const int aoff = lds_byte(wr * 64 + fr, fq * 8), boff = lds_byte(wc * 32 + fr, fq * 8);
#define PG8_SA(b, h) (((b) * 2 + (h)) * HTB)
#define PG8_SB(b, h) ((4 + (b) * 2 + (h)) * HTB)
#define PG8_STAGE(bufoff, gbase, voff) do { _Pragma("unroll") for (int _i = 0; _i < 2; ++_i) \
        glds_s((const char*)(gbase), (voff)[_i], ldsbase + (unsigned)((bufoff) + _i * 8192)); } while (0)
#define PG8_LDA(dst, b, h) do { _Pragma("unroll") for (int m = 0; m < 4; ++m) dst[m] = cat8(*(const LAS bf16x8*)(lds + PG8_SA(b, h) + aoff + m * 2048), *(const LAS bf16x8*)(lds + PG8_SA(b, h) + aoff + m * 2048 + 1024)); } while (0)
#define PG8_LDB(dst, b, h) do { _Pragma("unroll") for (int n = 0; n < 2; ++n) dst[n] = cat8(*(const LAS bf16x8*)(lds + PG8_SB(b, h) + boff + n * 2048), *(const LAS bf16x8*)(lds + PG8_SB(b, h) + boff + n * 2048 + 1024)); } while (0)
#define PG8_MMA(ai, bj, At, Bt) do { __builtin_amdgcn_s_setprio(1); _Pragma("unroll") for (int m = 0; m < 4; ++m) _Pragma("unroll") for (int n = 0; n < 2; ++n) { \
        if constexpr (FP8 && Epi::ASM_MFMA) asm volatile("v_mfma_scale_f32_16x16x128_f8f6f4 %0, %1, %2, %0, %3, %4 op_sel_hi:[0,0,0]" : "+v"(acc[ai][bj][m][n]) : "v"(Bt[n]), "v"(At[m]), "v"(scl_b), "v"(scl_a)); \
        else if constexpr (FP8) acc[ai][bj][m][n] = __builtin_amdgcn_mfma_scale_f32_16x16x128_f8f6f4(Bt[n], At[m], acc[ai][bj][m][n], 0, 0, 0, Epi::SCALE_B, 0, Epi::SCALE_A); \
        else { acc[ai][bj][m][n] = __builtin_amdgcn_mfma_f32_16x16x32_bf16(lo8(Bt[n]), lo8(At[m]), acc[ai][bj][m][n], 0, 0, 0); \
               acc[ai][bj][m][n] = __builtin_amdgcn_mfma_f32_16x16x32_bf16(hi8(Bt[n]), hi8(At[m]), acc[ai][bj][m][n], 0, 0, 0); } } \
        __builtin_amdgcn_s_setprio(0); } while (0)
#ifdef PROBE_DRAIN8
#define PG8_WAIT_V(n) do { if constexpr (FP8 && !Epi::ASM_MFMA) asm volatile("s_waitcnt vmcnt(0)" ::: "memory"); else asm volatile("s_waitcnt vmcnt(" #n ")" ::: "memory"); } while (0)
#else
#define PG8_WAIT_V(n) asm volatile("s_waitcnt vmcnt(" #n ")" ::: "memory")
#endif
#define PG8_WAIT_L(n) asm volatile("s_waitcnt lgkmcnt(" #n ")" ::: "memory")
#define PG8_BAR __builtin_amdgcn_s_barrier()
#define PG8_SCHED __builtin_amdgcn_sched_barrier(0)
    Unit cur, nxt; int ui = 0;
    int scl_a = Epi::SCALE_A, scl_b = Epi::SCALE_B; asm volatile("" : "+v"(scl_a), "+v"(scl_b));
    if (!S.next(0, cur)) return;
    f32x4 acc[2][2][4][2];
#pragma unroll
    for (int a = 0; a < 2; ++a)
#pragma unroll
        for (int b = 0; b < 2; ++b)
#pragma unroll
            for (int m = 0; m < 4; ++m)
#pragma unroll
                for (int n = 0; n < 2; ++n) acc[a][b][m][n] = (f32x4){0.f, 0.f, 0.f, 0.f};
    if constexpr (Epi::FP8) PG8_PIN_ACC("s_nop 7");
    v8i At[4], B0[2], B1[2];
    const char* cA = S.a_base(cur); const char* cB = S.b_base(cur);
    unsigned vo[2][2], nvo[2][2];
    S.a_offs(cur, RA, CA, vo);
    bool has_next = S.next(1, nxt);
    if (has_next) S.a_offs(nxt, RA, CA, nvo); else { nvo[0][0] = vo[0][0]; nvo[0][1] = vo[0][1]; nvo[1][0] = vo[1][0]; nvo[1][1] = vo[1][1]; }
    if constexpr (SP2) {
        PG8_STAGE(PG8_SB(0, 0), cB, voffB); PG8_STAGE(PG8_SB(0, 1), cB + bhstep, voffB); PG8_STAGE(PG8_SA(0, 0), cA, vo[0]); PG8_STAGE(PG8_SA(0, 1), cA, vo[1]);
        if (wr == 1) PG8_BAR;
        PG8_WAIT_V(2); PG8_BAR;
        PG8_STAGE(PG8_SB(1, 0), cB + bkstep, voffB); PG8_STAGE(PG8_SA(1, 0), cA + kstep, vo[0]); PG8_STAGE(PG8_SB(1, 1), cB + bhstep + bkstep, voffB);
        PG8_WAIT_V(6); PG8_BAR;
    } else {
        PG8_STAGE(PG8_SB(0, 0), cB, voffB); PG8_STAGE(PG8_SA(0, 0), cA, vo[0]); PG8_STAGE(PG8_SB(0, 1), cB + bhstep, voffB); PG8_STAGE(PG8_SA(0, 1), cA, vo[1]);
        if (wr == 1) PG8_BAR;
        PG8_WAIT_V(4); PG8_BAR;
        PG8_STAGE(PG8_SB(1, 0), cB + bkstep, voffB); PG8_STAGE(PG8_SA(1, 0), cA + kstep, vo[0]); PG8_STAGE(PG8_SB(1, 1), cB + bhstep + bkstep, voffB);
        PG8_WAIT_V(6); PG8_BAR;
    }
    for (;;) {
        const char* nA = has_next ? S.a_base(nxt) : cA; const char* nB = has_next ? S.b_base(nxt) : cB;
        for (int t = 0; t < nt; t += 2) {
            const bool last = (t == nt - 2);
            const char* a1 = cA + (size_t)(t + 1) * kstep;
            const char* a2 = last ? nA : cA + (size_t)(t + 2) * kstep; const char* b2 = last ? nB : cB + (size_t)(t + 2) * bkstep;
            const char* a3 = a2 + kstep; const char* b3 = b2 + bkstep;
            unsigned v2[2][2];
            v2[0][0] = last ? nvo[0][0] : vo[0][0]; v2[0][1] = last ? nvo[0][1] : vo[0][1]; v2[1][0] = last ? nvo[1][0] : vo[1][0]; v2[1][1] = last ? nvo[1][1] : vo[1][1];
            if constexpr (SP2) {
            PG8_LDB(B0, 0, 0); PG8_LDB(B1, 0, 1); PG8_SCHED; PG8_LDA(At, 0, 0); PG8_STAGE(PG8_SA(1, 1), a1, vo[1]);
            PG8_WAIT_V(8); PG8_WAIT_L(0); PG8_BAR; PG8_MMA(0, 0, At, B0); PG8_MMA(0, 1, At, B1); PG8_BAR; PG8_SCHED;
            PG8_LDA(At, 0, 1); PG8_STAGE(PG8_SB(0, 0), b2, voffB); PG8_STAGE(PG8_SB(0, 1), b2 + bhstep, voffB); PG8_STAGE(PG8_SA(0, 0), a2, v2[0]);
            PG8_WAIT_V(8); PG8_WAIT_L(0); PG8_BAR; PG8_MMA(1, 0, At, B0); PG8_MMA(1, 1, At, B1); PG8_BAR; PG8_SCHED;
            PG8_LDB(B0, 1, 0); PG8_LDB(B1, 1, 1); PG8_SCHED; PG8_LDA(At, 1, 0); PG8_STAGE(PG8_SA(0, 1), a2, v2[1]);
            PG8_WAIT_V(8); PG8_WAIT_L(0); PG8_BAR; PG8_MMA(0, 0, At, B0); PG8_MMA(0, 1, At, B1); PG8_BAR; PG8_SCHED;
            PG8_LDA(At, 1, 1); PG8_STAGE(PG8_SB(1, 0), b3, voffB); PG8_STAGE(PG8_SB(1, 1), b3 + bhstep, voffB); PG8_STAGE(PG8_SA(1, 0), a3, v2[0]);
            PG8_WAIT_V(8); PG8_WAIT_L(0); PG8_BAR; PG8_MMA(1, 0, At, B0); PG8_MMA(1, 1, At, B1); PG8_BAR; PG8_SCHED;
            } else {
            PG8_LDB(B0, 0, 0); PG8_SCHED; PG8_LDA(At, 0, 0); PG8_STAGE(PG8_SA(1, 1), a1, vo[1]);
            PG8_WAIT_L(8); PG8_BAR; PG8_WAIT_L(0); PG8_MMA(0, 0, At, B0); PG8_BAR; PG8_SCHED;
            PG8_LDB(B1, 0, 1); PG8_STAGE(PG8_SB(0, 0), b2, voffB);
            PG8_BAR; PG8_WAIT_L(0); PG8_MMA(0, 1, At, B1); PG8_BAR;
            PG8_LDA(At, 0, 1); PG8_STAGE(PG8_SA(0, 0), a2, v2[0]);
            PG8_BAR; PG8_WAIT_L(0); PG8_MMA(1, 0, At, B0); PG8_BAR; PG8_SCHED;
            PG8_STAGE(PG8_SB(0, 1), b2 + bhstep, voffB);
            PG8_WAIT_V(6); PG8_BAR; PG8_MMA(1, 1, At, B1); PG8_BAR;
            PG8_LDB(B0, 1, 0); PG8_SCHED; PG8_LDA(At, 1, 0); PG8_STAGE(PG8_SA(0, 1), a2, v2[1]);
            PG8_WAIT_L(8); PG8_BAR; PG8_WAIT_L(0); PG8_MMA(0, 0, At, B0); PG8_BAR; PG8_SCHED;
            PG8_LDB(B1, 1, 1); PG8_STAGE(PG8_SB(1, 0), b3, voffB);
            PG8_BAR; PG8_WAIT_L(0); PG8_MMA(0, 1, At, B1); PG8_BAR;
            PG8_LDA(At, 1, 1); PG8_STAGE(PG8_SA(1, 0), a3, v2[0]);
            PG8_BAR; PG8_WAIT_L(0); PG8_MMA(1, 0, At, B0); PG8_BAR; PG8_SCHED;
            PG8_STAGE(PG8_SB(1, 1), b3 + bhstep, voffB);
            PG8_WAIT_V(6); PG8_BAR; PG8_MMA(1, 1, At, B1); PG8_BAR;
            }
            if constexpr (Epi::MID) { if (t == 10 || t == 22) E.mid(acc, cur, t == 22 ? 1 : 0, wr, wc, fr, fq); }
        }
        Unit nn; const bool has_nn = has_next && S.next(ui + 2, nn); unsigned nnvo[2][2];
        if (has_nn) S.a_offs(nn, RA, CA, nnvo); else { nnvo[0][0] = nvo[0][0]; nnvo[0][1] = nvo[0][1]; nnvo[1][0] = nvo[1][0]; nnvo[1][1] = nvo[1][1]; }
        if constexpr (ALIGN_EPI) { if (wr == 0) PG8_BAR; }
        if constexpr (FP8) PG8_PIN_ACC("s_nop 15\n\ts_nop 7");
        E(acc, cur, wr, wc, fr, fq);
        if (!has_next) break;
#pragma unroll
        for (int a = 0; a < 2; ++a)
#pragma unroll
            for (int b = 0; b < 2; ++b)
#pragma unroll
                for (int m = 0; m < 4; ++m)
#pragma unroll
                    for (int n = 0; n < 2; ++n) acc[a][b][m][n] = (f32x4){0.f, 0.f, 0.f, 0.f};
        if constexpr (FP8) PG8_PIN_ACC("s_nop 7");
        cur = nxt; cA = nA; cB = nB; ++ui; nxt = nn; has_next = has_nn;
        vo[0][0] = nvo[0][0]; vo[0][1] = nvo[0][1]; vo[1][0] = nvo[1][0]; vo[1][1] = nvo[1][1];
        nvo[0][0] = nnvo[0][0]; nvo[0][1] = nnvo[0][1]; nvo[1][0] = nnvo[1][0]; nvo[1][1] = nnvo[1][1];
        if constexpr (ALIGN_EPI) { if (wr == 1) PG8_BAR; }
    }
    PG8_WAIT_V(0);
    if constexpr (!ALIGN_EPI) { if (wr == 0) PG8_BAR; }
    PG8_BAR;
#undef PG8_SA
#undef PG8_SB
#undef PG8_STAGE
#undef PG8_LDA
#undef PG8_LDB
#undef PG8_MMA
#undef PG8_WAIT_V
#undef PG8_WAIT_L
#undef PG8_BAR
#undef PG8_SCHED
}
}

constexpr int NWAVES = 8;
constexpr int BATCH = 2, SEQ = 8192, DM = 2048, T = BATCH * SEQ;
constexpr int NMEM = 256, MROWS = BATCH * NMEM;
constexpr int INW = 10252;
constexpr int NEXP = 32, TOPK = 4, CAP = T;
constexpr int QKVW = 4096;
constexpr int C_FQ = 0, C_FK = 768, C_FV = 1536, C_SQ = 2304, C_SK = 3072, C_SV = 3328, C_MQ = 3584;
constexpr int GW = 6144;
constexpr float NORM_EPS = 1e-6f;
constexpr float LOG2E = 1.4426950408889634f;
constexpr float SWIGLU_LIMIT = 7.0f, SWIGLU_ALPHA = 1.702f;
constexpr int PER_PHASE = 10;
#ifndef MK_LATE_WD
#define MK_LATE_WD 0
#endif
constexpr bool LATE_WD = false;
#ifndef MK_CONV_IN_P3
#define MK_CONV_IN_P3 1
#endif
constexpr bool CONV_IN_P3 = MK_CONV_IN_P3;
#ifndef H1_BF16
#define H1_BF16 1
#endif
#ifndef CONV_COOP
#define CONV_COOP 1
#endif
#ifndef CONV_IN_P1B
#define CONV_IN_P1B 0
#endif
#ifndef MK_GATE_WGS
#define MK_GATE_WGS 0
#endif
constexpr int GATE_WGS = MK_GATE_WGS;
constexpr bool GATES_IN_P3 = GATE_WGS > 0;
#ifndef MK_N_LAUNCHES
#define MK_N_LAUNCHES 1
#endif
constexpr int N_LAUNCHES = MK_N_LAUNCHES;

constexpr size_t MiB = 1u << 20;
constexpr size_t WS_CTL = 0, CTL_ZERO_BYTES = 32768;
constexpr size_t WS_WIN   = 2 * MiB;
constexpr size_t WS_WMKV  = WS_WIN + 40 * MiB;
constexpr size_t WS_WUP   = WS_WMKV + 4 * MiB;
constexpr size_t WS_WOUT  = WS_WUP + 8 * MiB;
constexpr size_t WS_WRT   = WS_WOUT + 8 * MiB;
constexpr size_t WS_WGU   = WS_WRT + 1 * MiB;
constexpr size_t WS_WD    = WS_WGU + 512 * MiB;
constexpr size_t WS_XN    = WS_WD + 256 * MiB;
constexpr size_t WS_MN    = WS_XN + 64 * MiB;
constexpr size_t WS_LOGF  = WS_MN + 2 * MiB;
constexpr size_t WS_CNEG  = WS_LOGF + 1 * MiB;
constexpr size_t WS_ROPE  = WS_CNEG + 1 * MiB;
constexpr size_t WS_QKV   = WS_ROPE + 4 * MiB;
constexpr size_t WS_G     = WS_QKV + 128 * MiB;
constexpr size_t WS_MKV   = WS_G + 192 * MiB;
constexpr size_t WS_OALL  = WS_MKV + 1 * MiB;
constexpr size_t WS_MERGED= WS_OALL + 64 * MiB;
constexpr size_t WS_HB    = WS_MERGED + 64 * MiB;
constexpr size_t WS_TOK   = WS_HB + 64 * MiB;
constexpr size_t WS_GATE  = WS_TOK + 2 * MiB;
constexpr size_t WS_RS    = WS_GATE + 2 * MiB;
constexpr size_t WS_ACT   = WS_RS + 2 * MiB;
constexpr size_t WS_Y     = WS_ACT + 288 * MiB;
constexpr size_t WS_TSLOT = WS_Y + 288 * MiB;
constexpr size_t WS_TGATE = WS_TSLOT + 1 * MiB;
constexpr size_t WS_XN8   = WS_TGATE + 1 * MiB;
constexpr size_t WS_WIN8  = WS_XN8 + 32 * MiB;
constexpr size_t WS_END   = WS_WIN8 + 12 * MiB;
constexpr int CW_BAR = 4096;
constexpr int CW_QHEAD = 64;
constexpr int CW_CNT = 512;

typedef unsigned short bf16;
typedef unsigned v4u __attribute__((ext_vector_type(4)));
typedef unsigned v2u __attribute__((ext_vector_type(2)));
typedef float f32x4 __attribute__((ext_vector_type(4)));
typedef float f32x16 __attribute__((ext_vector_type(16)));
typedef short bf16x8 __attribute__((ext_vector_type(8)));
typedef short s16x4 __attribute__((ext_vector_type(4)));
typedef GAS unsigned gu32;
#define RLX_AGENT __ATOMIC_RELAXED, __HIP_MEMORY_SCOPE_AGENT
#define LDS_WAIT() asm volatile("s_waitcnt lgkmcnt(0)" ::: "memory")
#define VM_WAIT() asm volatile("s_waitcnt vmcnt(0)" ::: "memory")
__device__ __forceinline__ unsigned f2bf(float f) { unsigned u = __builtin_bit_cast(unsigned, f); return (u + 0x7fffu + ((u >> 16) & 1u)) >> 16; }
__device__ __forceinline__ unsigned pk2(float lo, float hi) { return f2bf(lo) | (f2bf(hi) << 16); }
__device__ __forceinline__ float bf2f(unsigned short b) { return __uint_as_float(((unsigned)b) << 16); }
__device__ __forceinline__ float wave_sum(float v) {
#pragma unroll
    for (int o = 1; o < 64; o <<= 1) v += __shfl_xor(v, o);
    return v;
}
__device__ __forceinline__ float sigmoidf_(float x) { return __builtin_amdgcn_rcpf(1.0f + __builtin_amdgcn_exp2f(x * (-LOG2E))); }

constexpr int H8_SHIFT = 4, ACT8_SHIFT = 2, W8_SHIFT = 9;
constexpr float H8_MUL = 16.0f, ACT8_MUL = 4.0f, W8_MUL = 512.0f;
__device__ __forceinline__ float clamp_fp8(float v) { return __builtin_amdgcn_fmed3f(v, -448.0f, 448.0f); }
__device__ __forceinline__ unsigned pk4_fp8(float a, float b, float c, float d) {
    int p = __builtin_amdgcn_cvt_pk_fp8_f32(clamp_fp8(a), clamp_fp8(b), 0, false); p = __builtin_amdgcn_cvt_pk_fp8_f32(clamp_fp8(c), clamp_fp8(d), p, true); return (unsigned)p; }
using pg8::f32x2; using pg8::u32x4; using pg8::u32x2; using pg8::cvt_pk_bf16; using pg8::bf_lo; using pg8::bf_hi;

#define XB_TMO      128
#define XB_XCNT(j)  (256  + 64 * (j))
#define XB_XSUB(j)  (1280 + 64 * (j))
#define XB_XGEN(j)  (2304 + 64 * (j))
#define XB_TOP      3328
#define XB_TOPGEN   3392
#define XCD_BAR_WORDS 3456
#define XB_SPIN_CAP (1u << 18)

__device__ __forceinline__ unsigned xb_ld(unsigned* p)              { return __hip_atomic_load(p, __ATOMIC_RELAXED, __HIP_MEMORY_SCOPE_AGENT); }
__device__ __forceinline__ unsigned xb_add(unsigned* p, unsigned v) { return __hip_atomic_fetch_add(p, v, __ATOMIC_RELAXED, __HIP_MEMORY_SCOPE_AGENT); }
__device__ __forceinline__ unsigned xb_xcc_id() { return (unsigned)__builtin_amdgcn_s_getreg((3 << 11) | 20) & 0xFu; }
#define XB_SPIN(cond, bar) do { unsigned _sp = 0; while (cond) { __builtin_amdgcn_s_sleep(1); \
    if ((++_sp & 255u) == 0u) { if (xb_ld(&(bar)[XB_TMO])) break; if (_sp > XB_SPIN_CAP) { atomicAdd(&(bar)[XB_TMO], 1u); break; } } } } while (0)

struct XcdBarrier { unsigned* bar; unsigned x; volatile LAS unsigned* st; };

__device__ __forceinline__ XcdBarrier xcd_barrier_post(unsigned* bar, volatile LAS unsigned* st) {
    XcdBarrier b; b.bar = bar; b.x = xb_xcc_id(); b.st = st;
    if (threadIdx.x == 0) (void)xb_add(&bar[XB_XCNT(b.x)], 1u);
    return b;
}
__device__ __forceinline__ void xcd_barrier_complete(unsigned* bar, unsigned x, unsigned& nloc, unsigned& nx) {
    const unsigned G = gridDim.x * gridDim.y * gridDim.z;
    unsigned sum, cnt, mine, sp = 0u;
    for (;;) {
        sum = 0u; cnt = 0u; mine = 0u;
#pragma unroll
        for (unsigned j = 0; j < 16; ++j) { const unsigned c = xb_ld(&bar[XB_XCNT(j)]); sum += c; cnt += (c > 0u) ? 1u : 0u; mine = (j == x) ? c : mine; }
        if (sum == G) break;
        __builtin_amdgcn_s_sleep(1);
        if ((++sp & 255u) == 0u) { if (xb_ld(&bar[XB_TMO])) break; if (sp > XB_SPIN_CAP) { atomicAdd(&bar[XB_TMO], 1u); break; } }
    }
    nloc = mine > 0u ? mine : 1u; nx = cnt > 0u ? cnt : 1u;
}
__device__ __forceinline__ void xcd_barrier(const XcdBarrier& b) {
    asm volatile("s_waitcnt vmcnt(0)" ::: "memory");
    __syncthreads();
    if (threadIdx.x == 0) {
        unsigned* bar = b.bar;
        __builtin_amdgcn_s_waitcnt(0);
        unsigned nloc = b.st[0], nx = b.st[1];
        if (nloc == 0u) { xcd_barrier_complete(bar, b.x, nloc, nx); b.st[0] = nloc; b.st[1] = nx; }
        const unsigned old = xb_add(&bar[XB_XSUB(b.x)], 1u);
        const unsigned gen = old / nloc;
        if (old + 1u == (gen + 1u) * nloc) {
            __builtin_amdgcn_fence(__ATOMIC_RELEASE, "agent");
            asm volatile("s_waitcnt vmcnt(0)" ::: "memory");
            const unsigned og = xb_add(&bar[XB_TOP], 1u);
            const unsigned tg = og / nx;
            if (og + 1u == (tg + 1u) * nx) xb_add(&bar[XB_TOPGEN], 1u);
            else XB_SPIN(xb_ld(&bar[XB_TOPGEN]) == tg, bar);
            __builtin_amdgcn_fence(__ATOMIC_ACQUIRE, "agent");
            xb_add(&bar[XB_XGEN(b.x)], 1u);
            asm volatile("s_waitcnt vmcnt(0)" ::: "memory");
        } else {
            XB_SPIN(xb_ld(&bar[XB_XGEN(b.x)]) == gen, bar);
            __builtin_amdgcn_fence(__ATOMIC_ACQUIRE, "agent");
            asm volatile("s_waitcnt vmcnt(0)" ::: "memory");
        }
    }
    __syncthreads();
}

constexpr int RING_OFF = 0, RING_BYTES = 131072;
constexpr int LDSCTL_OFF = RING_BYTES, MISC_OFF = LDSCTL_OFF + 320;
constexpr int MOE_OFF = MISC_OFF + 128;
constexpr int LDS_BYTES = 147456;

struct Ctx {
    LAS unsigned char* lds;
    volatile LAS unsigned* MISC;
    gu32* ctl;
    int tid, lane, wave, vcu, G, probe;
    const float *x, *mem; const int* pos; const float *norm_mix, *w_in, *b_forget, *fox_q_norm, *fox_k_norm, *swa_q_norm, *swa_k_norm, *swa_sinks, *xmem_q_norm, *xmem_k_norm, *norm_mem,
        *w_mem_kv, *w_up_fox, *w_up_swa, *w_up_xmem, *w_out, *norm_ffn, *w_router, *b_router, *w_gate_up, *b_gate_up, *w_down, *b_down;
    float* out;
    bf16 *Win_t, *Wmkv_t, *Wup_t, *Wout_t, *Wr_t, *Wgu_t, *Wd_t, *XN, *MN, *QKV, *H1B, *G_, *MKV, *OALL, *MERGED, *HB, *ACT;
    float *LOGF, *CNEG, *ROPE, *GATEW, *RS, *TGATE; int *TOK, *TSLOT; bf16* Y; unsigned char *XN8, *Win8;
};

#ifndef PROBE_INW
#define PROBE_INW 64
#endif
__constant__ float INV_FREQ[32] = {1.000000000e+00f, 7.498942614e-01f, 5.623413324e-01f, 4.216965139e-01f, 3.162277639e-01f, 2.371373773e-01f, 1.778279394e-01f, 1.333521307e-01f,
    1.000000015e-01f, 7.498941571e-02f, 5.623413250e-02f, 4.216965288e-02f, 3.162277490e-02f, 2.371373773e-02f, 1.778279431e-02f, 1.333521493e-02f, 9.999999776e-03f, 7.498941850e-03f,
    5.623413250e-03f, 4.216964822e-03f, 3.162277630e-03f, 2.371373586e-03f, 1.778279431e-03f, 1.333521446e-03f, 1.000000047e-03f, 7.498942432e-04f, 5.623413017e-04f, 4.216965172e-04f,
    3.162277571e-04f, 2.371373703e-04f, 1.778279402e-04f, 1.333521504e-04f};

struct TItem { const float* src; const float* ksc; bf16* dst; size_t ldw; int f8, gap; };
__device__ __forceinline__ void titem_load(const TItem& I, f32x4 (&v)[8][2], float (&sc)[8][2], int lane) {
    const int rr = lane >> 4, c4 = lane & 15;
#pragma unroll
    for (int p = 0; p < 8; ++p)
#pragma unroll
        for (int h = 0; h < 2; ++h) { const int k = 8 * p + 2 * rr + h; v[p][h] = *(const GAS f32x4*)(I.src + (size_t)k * I.ldw + 4 * c4 + (c4 >= 8 ? I.gap : 0)); sc[p][h] = I.ksc ? I.ksc[k] : 1.0f; }
}
__device__ __forceinline__ void titem_store(const TItem& I, const f32x4 (&v)[8][2], const float (&sc)[8][2], LAS unsigned* tile, int lane) {
    const int rr = lane >> 4, c4 = lane & 15;
#pragma unroll
    for (int p = 0; p < 8; ++p)
#pragma unroll
        for (int q = 0; q < 4; ++q) { const int n = 4 * c4 + q, sw = (n ^ (n >> 3)) & 7;
            tile[n * 32 + 4 * (p ^ sw) + rr] = pg8::cvt_pk_bf16(v[p][0][q] * sc[p][0], v[p][1][q] * sc[p][1]); }
    LDS_WAIT(); asm volatile("" ::: "memory");
#pragma unroll
    for (int j = 0; j < 8; ++j) { const int n = 8 * j + (lane >> 3), c = lane & 7, sw = (n ^ (n >> 3)) & 7;
        const v4u o = *(const LAS v4u*)(tile + n * 32 + 4 * (c ^ sw));
        *(GAS v4u*)(I.dst + (size_t)n * DM + 8 * c) = o; }
    LDS_WAIT(); asm volatile("" ::: "memory");
}
__device__ __forceinline__ size_t tiled8(size_t row, int kt) { return (row >> 8) * (size_t)(256 * 2048) + (size_t)kt * 32768 + (row & 255) * 128; }
#ifndef CONV_NT
#define CONV_NT 1
#endif
#if CONV_NT
#define CONV_LOAD(p) __builtin_nontemporal_load(p)
#else
#define CONV_LOAD(p) (*(p))
#endif
__device__ __forceinline__ void titem8_load(const TItem& I, int qh, f32x4 (&v)[4][2], int lane) {
    const int rr = lane >> 4, c4 = lane & 15;
#pragma unroll
    for (int pp = 0; pp < 2; ++pp)
#pragma unroll
        for (int h = 0; h < 4; ++h) { const int k = 32 * qh + 16 * pp + 4 * rr + h; v[2 * pp + (h >> 1)][h & 1] = CONV_LOAD((const GAS f32x4*)(I.src + (size_t)k * I.ldw + 4 * c4)); }
}
__device__ __forceinline__ void titem8_pack(const TItem& I, const float* nbase, int qh, const f32x4 (&v)[4][2], LAS unsigned* tile, const LAS float* lnorm, int lane) {
    const int rr = lane >> 4, c4 = lane & 15;
    const int kofs = I.ksc ? (int)(I.ksc - nbase) + 32 * qh + 4 * rr : -1;
#pragma unroll
    for (int pp = 0; pp < 2; ++pp) {
        f32x4 sc = {W8_MUL, W8_MUL, W8_MUL, W8_MUL}; if (kofs >= 0) sc = *(const LAS f32x4*)(lnorm + kofs + 16 * pp);
#pragma unroll
        for (int q = 0; q < 4; ++q) { const int n = 4 * c4 + q, sw = (n ^ (n >> 3)) & 7;
            tile[n * 32 + 4 * ((2 * qh + pp) ^ sw) + rr] = pk4_fp8(v[2 * pp][0][q] * sc.x, v[2 * pp][1][q] * sc.y, v[2 * pp + 1][0][q] * sc.z, v[2 * pp + 1][1][q] * sc.w); } }
}
__device__ __forceinline__ void titem8_flush(const TItem& I, LAS unsigned* tile, int lane) {
    LDS_WAIT(); asm volatile("" ::: "memory");
#pragma unroll
    for (int j = 0; j < 8; ++j) { const int n = 8 * j + (lane >> 3), c = lane & 7, sw = (n ^ (n >> 3)) & 7;
        const v4u o = *(const LAS v4u*)(tile + n * 32 + 4 * (c ^ sw));
        *(GAS v4u*)((unsigned char*)I.dst + (size_t)n * 128 + 16 * c) = o; }
    LDS_WAIT(); asm volatile("" ::: "memory");
}
__device__ __forceinline__ void p0_router_item(const float* W, int k0, bf16* WT, const float* ksc, LAS float* scr, int lane) {
#pragma unroll 8
    for (int i = 0; i < 32; ++i) { const int kk = 2 * i + (lane >> 5); scr[kk * 33 + (lane & 31)] = W[(size_t)(k0 + kk) * 32 + (lane & 31)] * ksc[k0 + kk]; }
    LDS_WAIT(); asm volatile("" ::: "memory");
    const int c = lane & 7;
#pragma unroll
    for (int j = 0; j < 4; ++j) { const int n = (lane >> 3) + 8 * j; const LAS float* s = scr + (8 * c) * 33 + n;
        unsigned h[8], l[8];
#pragma unroll
        for (int q = 0; q < 8; ++q) { const float v = s[q * 33]; h[q] = f2bf(v); l[q] = f2bf(v - __uint_as_float(h[q] << 16)); }
        v4u oh, ol; oh.x = h[0] | (h[1] << 16); oh.y = h[2] | (h[3] << 16); oh.z = h[4] | (h[5] << 16); oh.w = h[6] | (h[7] << 16);
        ol.x = l[0] | (l[1] << 16); ol.y = l[2] | (l[3] << 16); ol.z = l[4] | (l[5] << 16); ol.w = l[6] | (l[7] << 16);
        *(GAS v4u*)(WT + (size_t)n * 2048 + k0 + 8 * c) = oh; *(GAS v4u*)(WT + (size_t)(32 + n) * 2048 + k0 + 8 * c) = ol; }
    LDS_WAIT(); asm volatile("" ::: "memory");
}
__device__ __forceinline__ float log_sigmoidf_(float z) { return fminf(z, 0.f) - log1pf(__expf(-fabsf(z))); }

template <bool XROW>
__device__ __forceinline__ void p0_norm_row(const Ctx& C, const float* xrow, const float* gain, bf16* orow, const LAS float* Wf, int m) {
    const GAS f32x4* xr = (const GAS f32x4*)xrow + C.lane; const GAS f32x4* gr = (const GAS f32x4*)gain + C.lane;
    f32x4 v[8]; float s = 0.f;
#pragma unroll
    for (int j = 0; j < 8; ++j) { v[j] = xr[64 * j]; s += (v[j].x * v[j].x + v[j].y * v[j].y) + (v[j].z * v[j].z + v[j].w * v[j].w); }
    const float rstd = 1.0f / sqrtf(wave_sum(s) * (1.f / DM) + NORM_EPS);
    GAS unsigned long long* o8 = (GAS unsigned long long*)orow + C.lane;
#pragma unroll
    for (int j = 0; j < 8; ++j) { const f32x4 g = gr[64 * j]; v[j] = (v[j] * rstd) * g;
        o8[64 * j] = (unsigned long long)pk2(v[j].x, v[j].y) | ((unsigned long long)pk2(v[j].z, v[j].w) << 32);
        if constexpr (XROW) ((GAS unsigned*)(C.XN8 + (size_t)m * DM))[C.lane + 64 * j] = pk4_fp8(v[j].x * H8_MUL, v[j].y * H8_MUL, v[j].z * H8_MUL, v[j].w * H8_MUL); }
    if constexpr (XROW) {
        float mine = 0.f;
#pragma unroll 1
        for (int h = 0; h < 12; ++h) { const LAS f32x4* w = (const LAS f32x4*)(Wf + h * 2048) + C.lane; float d = 0.f;
#pragma unroll
            for (int j = 0; j < 8; ++j) { const f32x4 ww = w[64 * j]; d += (v[j].x * ww.x + v[j].y * ww.y) + (v[j].z * ww.z + v[j].w * ww.w); }
            d = wave_sum(d); if (C.lane == h) mine = d; }
        const int b = m / SEQ, t = m % SEQ;
        if (C.lane < 12) C.LOGF[(size_t)(b * 12 + C.lane) * SEQ + t] = log_sigmoidf_(mine + C.b_forget[C.lane]);
        if (C.lane < 32) { const float ang = (float)C.pos[m] * INV_FREQ[C.lane]; const double rev = (double)ang * 0.15915494309189535; const float fr = (float)(rev - floor(rev));
            C.ROPE[(size_t)m * 64 + C.lane] = __builtin_amdgcn_cosf(fr); C.ROPE[(size_t)m * 64 + 32 + C.lane] = __builtin_amdgcn_sinf(fr); }
    }
}
constexpr int I_GU = 32 * 16 * 64, I_D = 32 * 16 * 32, I_ING = 16 * 96, I_IN = 32 * PROBE_INW, I_MKV = 32 * 16, I_UF = 12 * 32, I_US = 12 * 32, I_UX = 8 * 32, I_O = 32 * 32;
constexpr int NITEMS = I_GU + I_D + I_ING + I_IN + I_MKV + I_UF + I_US + I_UX + I_O;
constexpr int N8 = I_GU + I_D + I_ING;
__device__ __forceinline__ TItem p0_decode(const Ctx& C, int it) {
        TItem I; int r = it; I.ksc = nullptr; I.f8 = 0; I.gap = 0;
        if (r < I_GU) { const int e = r / 1024, q = r % 1024, kb = 2 * (q / 64), pb = q % 64, tl = pb >> 2, jb = pb & 3;
            const int n0 = (jb < 2) ? (128 * tl + 64 * jb) : (2048 + 128 * tl + 64 * (jb - 2));
            I.ldw = 4096; I.src = C.w_gate_up + (size_t)e * DM * 4096 + (size_t)(64 * kb) * 4096 + n0; I.ksc = C.norm_ffn + 64 * kb; I.f8 = 1; I.dst = (bf16*)((unsigned char*)C.Wgu_t + tiled8((size_t)e * 4096 + 64 * pb, kb >> 1)); return I; } r -= I_GU;
        if (r < I_D) { const int e = r / 512, q = r % 512, kb = 2 * (q / 32), nb = q % 32;
            I.ldw = DM; I.src = C.w_down + (size_t)e * DM * DM + (size_t)(64 * kb) * DM + 64 * nb; I.f8 = 1; I.dst = (bf16*)((unsigned char*)C.Wd_t + tiled8((size_t)e * DM + 64 * nb, kb >> 1)); return I; } r -= I_D;
        if (r < I_ING) { const int kb = 2 * (r / 96), pb = r % 96;
            I.ldw = INW; I.src = C.w_in + (size_t)(64 * kb) * INW + 4108 + 64 * pb; I.f8 = 1; I.dst = (bf16*)((unsigned char*)C.Win8 + tiled8((size_t)64 * pb, kb >> 1)); return I; } r -= I_ING;
        if (r < I_IN) { const int kb = r / PROBE_INW, pb = r % PROBE_INW; int p0 = 64 * pb; const int tl = pb >> 2, q4 = pb & 3;
            if (tl == 3 || tl == 4 || tl == 5 || tl == 12) { p0 = 256 * tl + 128 * (q4 & 1) + 32 * (q4 >> 1); I.gap = 32; }
            const int n0 = (p0 < 2304) ? p0 : p0 + 12;
            I.ldw = INW; I.src = C.w_in + (size_t)(64 * kb) * INW + n0; I.dst = C.Win_t + (size_t)(64 * pb) * DM + 64 * kb; return I; } r -= I_IN;
        if (r < I_MKV) { const int kb = r / 16, nb = r % 16; I.ldw = 1024; I.src = C.w_mem_kv + (size_t)(64 * kb) * 1024 + 64 * nb; I.dst = C.Wmkv_t + (size_t)(64 * nb) * DM + 64 * kb; return I; } r -= I_MKV;
        if (r < I_UF) { const int kb = r / 32, nb = r % 32; I.ldw = DM; I.src = C.w_up_fox + (size_t)(64 * kb) * DM + 64 * nb; I.dst = C.Wup_t + (size_t)(64 * nb) * DM + 64 * kb; return I; } r -= I_UF;
        if (r < I_US) { const int kb = r / 32, nb = r % 32; I.ldw = DM; I.src = C.w_up_swa + (size_t)(64 * kb) * DM + 64 * nb; I.dst = C.Wup_t + (size_t)(64 * nb) * DM + 768 + 64 * kb; return I; } r -= I_US;
        if (r < I_UX) { const int kb = r / 32, nb = r % 32; I.ldw = DM; I.src = C.w_up_xmem + (size_t)(64 * kb) * DM + 64 * nb; I.dst = C.Wup_t + (size_t)(64 * nb) * DM + 1536 + 64 * kb; return I; } r -= I_UX;
        { const int kb = r / 32, nb = r % 32; I.ldw = DM; I.src = C.w_out + (size_t)(64 * kb) * DM + 64 * nb; I.dst = C.Wout_t + (size_t)(64 * nb) * DM + 64 * kb; return I; }
}
__device__ __forceinline__ void p0_fp8_loop(const Ctx& C, int first, int cnt, int me, int stride, LAS unsigned* tile, const LAS float* lnorm) {
    if (me >= cnt) return;
#ifdef PROBE_STREAMCEIL
    if (C.probe == 8) {
        for (int it = me; it < cnt; it += stride) { const int gi = first + it; const float* src = (gi < I_GU ? C.w_gate_up + (size_t)gi * 8192 : C.w_down + (size_t)(gi - I_GU) * 8192) + C.lane * 4;
            f32x4 acc_ = {0.f, 0.f, 0.f, 0.f};
#pragma unroll 8
            for (int r = 0; r < 32; ++r) acc_ += __builtin_nontemporal_load((const GAS f32x4*)(src + r * 256));
            asm volatile("" :: "v"(acc_)); }
        return; }
#endif
    const int nq = 4 * ((cnt - me + stride - 1) / stride);
    f32x4 b0[4][2], b1[4][2], b2[4][2], b3[4][2], b4[4][2];
#define P0_ITEM(q_) p0_decode(C, first + me + ((q_) >> 2) * stride)
#define P0_STEP(q_, cur_, pre_) do { const int qq = (q_); if (qq < nq) { \
        if (qq + 4 < nq) { const TItem J = P0_ITEM(qq + 4); titem8_load(J, (qq + 4) & 3, pre_, C.lane); } \
        const TItem I = P0_ITEM(qq); titem8_pack(I, C.norm_ffn, qq & 3, cur_, tile, lnorm, C.lane); \
        if ((qq & 3) == 3) titem8_flush(I, tile, C.lane); } } while (0)
    { const TItem I = P0_ITEM(0); titem8_load(I, 0, b0, C.lane); titem8_load(I, 1, b1, C.lane); titem8_load(I, 2, b2, C.lane); titem8_load(I, 3, b3, C.lane); }
    for (int qs = 0; qs < nq; qs += 5) { P0_STEP(qs, b0, b4); P0_STEP(qs + 1, b1, b0); P0_STEP(qs + 2, b2, b1); P0_STEP(qs + 3, b3, b2); P0_STEP(qs + 4, b4, b3); }
#undef P0_ITEM
#undef P0_STEP
}
__device__ __forceinline__ void p0_fill_lnorm(const Ctx& C, LAS float* lnorm) { for (int k = C.tid; k < DM; k += NWAVES * 64) lnorm[k] = C.norm_ffn[k] * W8_MUL; }
__device__ __forceinline__ void p0_x_rows2(const Ctx& C, const LAS float* Wf, int m0, int m1) {
    const GAS f32x4* gr = (const GAS f32x4*)C.norm_mix + C.lane;
    const int mm[2] = {m0, m1};
    f32x4 v[2][8]; float s[2] = {0.f, 0.f};
#pragma unroll
    for (int r = 0; r < 2; ++r) { const GAS f32x4* xr = (const GAS f32x4*)(C.x + (size_t)mm[r] * DM) + C.lane;
#pragma unroll
        for (int j = 0; j < 8; ++j) v[r][j] = xr[64 * j]; }
#pragma unroll
    for (int r = 0; r < 2; ++r)
#pragma unroll
        for (int j = 0; j < 8; ++j) s[r] += (v[r][j].x * v[r][j].x + v[r][j].y * v[r][j].y) + (v[r][j].z * v[r][j].z + v[r][j].w * v[r][j].w);
    float rstd[2];
#pragma unroll
    for (int r = 0; r < 2; ++r) rstd[r] = 1.0f / sqrtf(wave_sum(s[r]) * (1.f / DM) + NORM_EPS);
#pragma unroll
    for (int j = 0; j < 8; ++j) { const f32x4 g = gr[64 * j];
#pragma unroll
        for (int r = 0; r < 2; ++r) { v[r][j] = (v[r][j] * rstd[r]) * g;
            ((GAS unsigned long long*)(C.XN + (size_t)mm[r] * DM))[C.lane + 64 * j] = (unsigned long long)pk2(v[r][j].x, v[r][j].y) | ((unsigned long long)pk2(v[r][j].z, v[r][j].w) << 32);
            ((GAS unsigned*)(C.XN8 + (size_t)mm[r] * DM))[C.lane + 64 * j] = pk4_fp8(v[r][j].x * H8_MUL, v[r][j].y * H8_MUL, v[r][j].z * H8_MUL, v[r][j].w * H8_MUL); } }
    float mine[2] = {0.f, 0.f};
#pragma unroll 1
    for (int h = 0; h < 12; ++h) { const LAS f32x4* w = (const LAS f32x4*)(Wf + h * 2048) + C.lane; float d0 = 0.f, d1 = 0.f;
#pragma unroll
        for (int j = 0; j < 8; ++j) { const f32x4 ww = w[64 * j];
            d0 += (v[0][j].x * ww.x + v[0][j].y * ww.y) + (v[0][j].z * ww.z + v[0][j].w * ww.w); d1 += (v[1][j].x * ww.x + v[1][j].y * ww.y) + (v[1][j].z * ww.z + v[1][j].w * ww.w); }
        d0 = wave_sum(d0); d1 = wave_sum(d1); if (C.lane == h) { mine[0] = d0; mine[1] = d1; } }
#pragma unroll
    for (int r = 0; r < 2; ++r) { const int m = mm[r], b = m / SEQ, t = m % SEQ;
        if (C.lane < 12) C.LOGF[(size_t)(b * 12 + C.lane) * SEQ + t] = log_sigmoidf_(mine[r] + C.b_forget[C.lane]);
        if (C.lane < 32) { const float ang = (float)C.pos[m] * INV_FREQ[C.lane]; const double rev = (double)ang * 0.15915494309189535; const float fr = (float)(rev - floor(rev));
            C.ROPE[(size_t)m * 64 + C.lane] = __builtin_amdgcn_cosf(fr); C.ROPE[(size_t)m * 64 + 32 + C.lane] = __builtin_amdgcn_sinf(fr); } }
}
__device__ __forceinline__ void phase0(const Ctx& C) {
    const int gw = C.vcu * NWAVES + C.wave, NGW = C.G * NWAVES;
    LAS float* scr = (LAS float*)(C.lds + RING_OFF + C.wave * 16384);
    for (int r = gw; r < 32; r += NGW) p0_router_item(C.w_router, 64 * r, C.Wr_t, C.norm_ffn, scr, C.lane);
    LAS unsigned* tile = (LAS unsigned*)(C.lds + RING_OFF + C.wave * 8192);
    __syncthreads();
    LAS float* lnorm = (LAS float*)(C.lds + RING_OFF + 65536);
    p0_fill_lnorm(C, lnorm); __syncthreads();
    p0_fp8_loop(C, CONV_IN_P3 ? I_GU + I_D : 0, CONV_IN_P3 ? I_ING : N8, gw, NGW, tile, lnorm);
    if (N8 + gw < NITEMS) {
        TItem cur = p0_decode(C, N8 + gw); f32x4 va[8][2]; float sa[8][2]; titem_load(cur, va, sa, C.lane);
        for (int it = N8 + gw; it < NITEMS; it += NGW) {
            const int nx = it + NGW; TItem nxt = cur; f32x4 vb[8][2]; float sb[8][2];
            if (nx < NITEMS) { nxt = p0_decode(C, nx); titem_load(nxt, vb, sb, C.lane); }
            titem_store(cur, va, sa, tile, C.lane);
            cur = nxt;
#pragma unroll
            for (int p = 0; p < 8; ++p)
#pragma unroll
                for (int h = 0; h < 2; ++h) { va[p][h] = vb[p][h]; sa[p][h] = sb[p][h]; }
        }
    }
    __syncthreads();
    LAS float* Wf = (LAS float*)(C.lds + RING_OFF);
    for (int idx = C.tid; idx < 12 * 2048; idx += NWAVES * 64) { const int k = idx / 12, h = idx - 12 * k; Wf[h * 2048 + k] = C.w_in[(size_t)k * INW + 2304 + h]; }
    __syncthreads();
    { int m = gw; for (; m + NGW < T; m += 2 * NGW) p0_x_rows2(C, Wf, m, m + NGW); if (m < T) p0_norm_row<true>(C, C.x + (size_t)m * DM, C.norm_mix, C.XN + (size_t)m * DM, Wf, m); }
    for (int m = gw; m < MROWS; m += NGW) p0_norm_row<false>(C, C.mem + (size_t)m * DM, C.norm_mem, C.MN + (size_t)m * DM, Wf, m);
    __syncthreads();
}

#ifndef MK_CONV_CHUNK
#define MK_CONV_CHUNK 128
#endif
constexpr int CONV_CHUNK = MK_CONV_CHUNK;
#ifndef MK_WD_IN_P7
#define MK_WD_IN_P7 0
#endif
constexpr bool WD_IN_P7 = MK_WD_IN_P7;
constexpr int CONV_TAIL = MK_CONV_CHUNK;
constexpr int CONV_NBIG = I_GU / CONV_CHUNK, CONV_NSMALL = I_D / CONV_TAIL;
constexpr int CONV_NCHUNK = WD_IN_P7 ? CONV_NBIG : CONV_NBIG + CONV_NSMALL, CONV_NCHUNK_WD = I_D / CONV_CHUNK;
static_assert(I_GU % CONV_CHUNK == 0 && I_D % CONV_CHUNK == 0 && I_D % CONV_TAIL == 0, "conversion chunks");
__device__ __forceinline__ void conv_chunk(const Ctx& C, int chunk) {
    LAS unsigned* tile = (LAS unsigned*)(C.lds + RING_OFF + C.wave * 8192);
    const int first = chunk < CONV_NBIG ? chunk * CONV_CHUNK : I_GU + (chunk - CONV_NBIG) * CONV_TAIL, cnt = chunk < CONV_NBIG ? CONV_CHUNK : CONV_TAIL;
    p0_fp8_loop(C, first, cnt, C.wave, NWAVES, tile, (const LAS float*)(C.lds + RING_OFF + 65536));
}
__device__ __forceinline__ void conv_chunk_wd(const Ctx& C, int chunk) {
    LAS unsigned* tile = (LAS unsigned*)(C.lds + RING_OFF + C.wave * 8192);
    p0_fp8_loop(C, I_GU + chunk * CONV_CHUNK, CONV_CHUNK, C.wave, NWAVES, tile, (const LAS float*)(C.lds + RING_OFF + 65536));
}

#ifndef CONV_NT_ST
#define CONV_NT_ST 0
#endif
#if CONV_NT_ST
#define CONV_STORE(p, v) __builtin_nontemporal_store(v, p)
#else
#define CONV_STORE(p, v) (*(p) = (v))
#endif
#ifndef CONV2_SPLIT
#define CONV2_SPLIT 1
#endif
constexpr int CONV2_NCH_GU = 32 * 16 * CONV2_SPLIT, CONV2_NCH_D = 32 * 16 * CONV2_SPLIT, CONV2_NCHUNK = CONV2_NCH_GU + CONV2_NCH_D;
__device__ __forceinline__ void cblk_load(const float* rowp, size_t ldw, f32x4 (&v)[16]) {
#pragma unroll
    for (int r = 0; r < 16; ++r) v[r] = CONV_LOAD((const GAS f32x4*)(rowp + (size_t)r * ldw));
}
__device__ __forceinline__ void conv_chunk2(const Ctx& C, int chunk) {
    LAS unsigned char* tiles = C.lds + RING_OFF;
    const LAS float* lnorm = (const LAS float*)(C.lds + RING_OFF + 65536);
    const bool gu = chunk < CONV2_NCH_GU; const int c0 = gu ? chunk : chunk - CONV2_NCH_GU, part = c0 % CONV2_SPLIT, cc = c0 / CONV2_SPLIT, e = cc >> 4, kt = cc & 15, nbt = gu ? 16 : 8, nb = nbt / CONV2_SPLIT, tl0 = part * nb;
    const size_t ldw = gu ? 4096 : 2048;
    const float* W = gu ? C.w_gate_up + (size_t)e * DM * 4096 : C.w_down + (size_t)e * DM * DM;
    const float* row0 = W + (size_t)(128 * kt + 16 * C.wave) * ldw;
    const int lcol = gu ? ((C.lane < 32) ? 4 * C.lane : 2048 + 4 * (C.lane - 32)) : 4 * C.lane;
    unsigned char* dst0 = (unsigned char*)(gu ? C.Wgu_t : C.Wd_t) + ((size_t)(e * nbt + tl0) * 16 + kt) * 32768;
    f32x4 sc[4];
#pragma unroll
    for (int j = 0; j < 4; ++j) sc[j] = gu ? *(const LAS f32x4*)(lnorm + 128 * kt + 16 * C.wave + 4 * j) : (f32x4){W8_MUL, W8_MUL, W8_MUL, W8_MUL};
    f32x4 va[16], vb[16];
    cblk_load(row0 + lcol + (gu ? 128 : 256) * tl0, ldw, va);
#define CONV2_STEP(tl_, cur_, nxt_) do { const int tq = (tl_); if (tq < nb) { \
        if (tq + 1 < nb) cblk_load(row0 + lcol + (gu ? 128 : 256) * (tl0 + tq + 1), ldw, nxt_); \
        LAS unsigned char* tile = tiles + (tq & 1) * 32768; \
        _Pragma("unroll") for (int q = 0; q < 4; ++q) { const int n = 4 * C.lane + q; v4u o; \
            o.x = pk4_fp8(cur_[0][q] * sc[0].x, cur_[1][q] * sc[0].y, cur_[2][q] * sc[0].z, cur_[3][q] * sc[0].w); o.y = pk4_fp8(cur_[4][q] * sc[1].x, cur_[5][q] * sc[1].y, cur_[6][q] * sc[1].z, cur_[7][q] * sc[1].w); \
            o.z = pk4_fp8(cur_[8][q] * sc[2].x, cur_[9][q] * sc[2].y, cur_[10][q] * sc[2].z, cur_[11][q] * sc[2].w); o.w = pk4_fp8(cur_[12][q] * sc[3].x, cur_[13][q] * sc[3].y, cur_[14][q] * sc[3].z, cur_[15][q] * sc[3].w); \
            *(LAS v4u*)(tile + n * 128 + 16 * (C.wave ^ ((n >> 2) & 7))) = o; } \
        asm volatile("s_waitcnt lgkmcnt(0)\n\ts_barrier" ::: "memory"); \
        unsigned char* dst = dst0 + (size_t)tq * (16 * 32768); \
        _Pragma("unroll") for (int j = 0; j < 4; ++j) { const int n = (C.tid >> 3) + 64 * j, c = C.tid & 7; \
            const v4u o = *(const LAS v4u*)(tile + n * 128 + 16 * (c ^ ((n >> 2) & 7))); CONV_STORE((GAS v4u*)(dst + n * 128 + 16 * c), o); } } } while (0)
    for (int tl = 0; tl < nb; tl += 2) { CONV2_STEP(tl, va, vb); CONV2_STEP(tl + 1, vb, va); }
#undef CONV2_STEP
    asm volatile("s_waitcnt lgkmcnt(0)\n\ts_barrier" ::: "memory");
}

using pg8::Unit;
template <int RB>
struct DenseOrderT {
    const char* A; const char* Bt; int nM, nN, nwg, G, c;
    __device__ __forceinline__ void init(const void* A_, const void* Bt_, int M, int N, int G_, int c_) { A = (const char*)A_; Bt = (const char*)Bt_; nM = M / 256; nN = N / 256; nwg = nM * nN; G = G_; c = c_; }
    __device__ __forceinline__ bool map(long L, Unit& u) const {
        if (L >= nwg) return false;
        int wgid = (int)L; { const int q = nwg / 8, r = nwg % 8, xcd = wgid % 8, off = wgid / 8; wgid = (xcd < r ? xcd * (q + 1) : r * (q + 1) + (xcd - r) * q) + off; }
        const int nig = 8 * nN, gid = wgid / nig, fm = gid * 8, gsz = (nM - fm) < 8 ? (nM - fm) : 8;
        u.pm = fm + ((wgid % nig) % gsz); u.pn = (wgid % nig) / gsz; u.e = 0; u.kind = 0; return true;
    }
    __device__ __forceinline__ bool next(int i, Unit& u) const { return map((long)i * G + c, u); }
    __device__ __forceinline__ const char* a_base(const Unit& u) const { return A + (size_t)u.pm * (256 * RB); }
    __device__ __forceinline__ const char* b_base(const Unit& u) const { return Bt + (size_t)u.pn * (256 * RB); }
    __device__ __forceinline__ void a_offs(const Unit&, const int (&R)[2], const int (&Cc)[2], unsigned (&vo)[2][2]) const {
#pragma unroll
        for (int h = 0; h < 2; ++h)
#pragma unroll
            for (int i = 0; i < 2; ++i) vo[h][i] = (unsigned)((h * 128 + R[i]) * RB + Cc[i] * 2);
    }
};
typedef DenseOrderT<4096> DenseOrder;
struct P1Order {
    DenseOrder d; const char* A1; const char* B1;
    __device__ __forceinline__ bool next(int i, Unit& u) const {
        const long L = (long)i * d.G + d.c;
        if (L < d.nwg) return d.map(L, u);
        const int r = (int)(L - d.nwg); if (r >= 8) return false;
        u.pm = r >> 2; u.pn = r & 3; u.e = 0; u.kind = 1; return true;
    }
    __device__ __forceinline__ const char* a_base(const Unit& u) const { return (u.kind ? A1 : d.A) + (size_t)u.pm * (256 * 2048 * 2); }
    __device__ __forceinline__ const char* b_base(const Unit& u) const { return (u.kind ? B1 : d.Bt) + (size_t)u.pn * (256 * 2048 * 2); }
    __device__ __forceinline__ void a_offs(const Unit& u, const int (&R)[2], const int (&Cc)[2], unsigned (&vo)[2][2]) const { d.a_offs(u, R, Cc, vo); }
};
struct P1bOrder {
    DenseOrderT<2048> d;
    __device__ __forceinline__ bool next(int i, Unit& u) const {
        const int c = d.c;
        if (c < 8) return i < 4 ? d.map((long)i * d.G + c, u) : false;
        if (i < 6) return d.map((long)i * d.G + c, u);
        if (i == 6 && c < 24) { const int idx = c - 8; return d.map((long)(4 + (idx & 1)) * d.G + (idx >> 1), u); }
        return false;
    }
    __device__ __forceinline__ const char* a_base(const Unit& u) const { return d.a_base(u); }
    __device__ __forceinline__ const char* b_base(const Unit& u) const { return d.b_base(u); }
    __device__ __forceinline__ void a_offs(const Unit& u, const int (&R)[2], const int (&Cc)[2], unsigned (&vo)[2][2]) const { d.a_offs(u, R, Cc, vo); }
};
struct P1bGrpOrder {
    DenseOrderT<2048> d;
    __device__ __forceinline__ bool next(int i, Unit& u) const { return d.map((long)i * d.G + d.c, u); }
    __device__ __forceinline__ const char* a_base(const Unit& u) const { return d.a_base(u); }
    __device__ __forceinline__ const char* b_base(const Unit& u) const { return d.b_base(u); }
    __device__ __forceinline__ void a_offs(const Unit& u, const int (&R)[2], const int (&Cc)[2], unsigned (&vo)[2][2]) const { d.a_offs(u, R, Cc, vo); }
};
#ifndef MOE_NGRP
#define MOE_NGRP 4
#endif
#ifndef MOE_XCD_LISTS
#define MOE_XCD_LISTS 0
#endif
template <bool GATHER, int NT, int RB>
struct MoeOrder {
    const char* A; const char* Bt; const int* tok; const int* cnt; const LAS int* tab; int G, c;
    __device__ __forceinline__ bool next(int i, Unit& u) const {
        const int tot = __builtin_amdgcn_readfirstlane(tab[32]);
        int L;
        if (MOE_XCD_LISTS && G == 256) { const int x = c >> 5, s_ = i * 32 + (c & 31), seg = ((tot + 255) >> 8) << 5; L = x * seg + s_; if (s_ >= seg || L >= tot) return false; }
        else { L = i * G + c; if (L >= tot) return false; }
        int e = 0;
#pragma unroll 1
        for (int j = 1; j < 32; ++j) e += (__builtin_amdgcn_readfirstlane(tab[j]) <= L) ? 1 : 0;
        const int j = L - __builtin_amdgcn_readfirstlane(tab[e]), mt = __builtin_amdgcn_readfirstlane(tab[33 + e]), per = mt * MOE_NGRP, ntg = j / per, r = j - ntg * per;
        u.e = e; u.pm = r / MOE_NGRP; u.pn = ntg * MOE_NGRP + (r % MOE_NGRP); u.kind = __builtin_amdgcn_readfirstlane(tab[65 + e]) + 256 * u.pm;
        return true;
    }
    __device__ __forceinline__ const char* a_base(const Unit& u) const { return GATHER ? A : A + (size_t)u.kind * RB; }
    __device__ __forceinline__ const char* b_base(const Unit& u) const { return Bt + ((size_t)u.e * NT + u.pn) * (256 * RB); }
    __device__ __forceinline__ void a_offs(const Unit& u, const int (&R)[2], const int (&Cc)[2], unsigned (&vo)[2][2]) const {
#pragma unroll
        for (int h = 0; h < 2; ++h)
#pragma unroll
            for (int i = 0; i < 2; ++i) {
                if constexpr (GATHER) { const int n_e = __builtin_amdgcn_readfirstlane(tab[97 + u.e]); int ri = 256 * u.pm + h * 128 + R[i]; ri = ri < n_e ? ri : n_e - 1;
                    const int row = tok[u.e * CAP + ri]; vo[h][i] = (unsigned)(row * RB + Cc[i] * 2); }
                else vo[h][i] = (unsigned)((h * 128 + R[i]) * RB + Cc[i] * 2);
            }
    }
};

struct EpiInProj {
    static constexpr bool PERM = true, MID = false, FP8 = false, ASM_MFMA = false, BTILED = false; static constexpr int SCALE_A = 0x7f, SCALE_B = 0x7f;
    bf16* QKV; bf16* Gt; bf16* MKV; int noop; const float* gk_fox; const float* gk_swa; const float* rope;
    __device__ __forceinline__ void mid(pg8::f32x4 (&)[2][2][4][2], const Unit&, int, int, int, int, int) const {}
    __device__ __forceinline__ void operator()(const pg8::f32x4 (&acc)[2][2][4][2], const Unit& u, int wr, int wc, int fr, int fq) const {
        asm volatile("" : "+v"(fr), "+v"(fq));
        if (noop) return;
        if (!u.kind && (u.pn == 3 || u.pn == 4 || u.pn == 5 || u.pn == 12)) {
            const bool swa = (u.pn == 12); const float* gp = (swa ? gk_swa : gk_fox) + 8 * fq;
            float gn[2][8];
#pragma unroll
            for (int bj = 0; bj < 2; ++bj) { const pg8::f32x4 a = *(const pg8::f32x4*)(gp + 32 * bj), b = *(const pg8::f32x4*)(gp + 32 * bj + 4);
                gn[bj][0] = a[0]; gn[bj][1] = a[1]; gn[bj][2] = a[2]; gn[bj][3] = a[3]; gn[bj][4] = b[0]; gn[bj][5] = b[1]; gn[bj][6] = b[2]; gn[bj][7] = b[3]; }
#pragma unroll
            for (int ai = 0; ai < 2; ++ai)
#pragma unroll
                for (int m = 0; m < 4; ++m) { const int row = u.pm * 256 + wr * 64 + fr + ai * 128 + m * 16;
                    float x[2][8]; float ss = 0.f;
#pragma unroll
                    for (int bj = 0; bj < 2; ++bj)
#pragma unroll
                        for (int n = 0; n < 2; ++n)
#pragma unroll
                            for (int e = 0; e < 4; ++e) { const float v = acc[ai][bj][m][n][e]; x[bj][4 * n + e] = v; ss += v * v; }
                    ss += __shfl_xor(ss, 16); ss += __shfl_xor(ss, 32);
                    const float rstd = 1.0f / sqrtf(ss * (1.f / 64.f) + NORM_EPS);
#pragma unroll
                    for (int bj = 0; bj < 2; ++bj)
#pragma unroll
                        for (int q = 0; q < 8; ++q) x[bj][q] = (x[bj][q] * rstd) * gn[bj][q];
                    if (swa) { const float* cs = rope + (size_t)row * 64 + 8 * fq;
                        const pg8::f32x4 c0 = *(const pg8::f32x4*)cs, c1 = *(const pg8::f32x4*)(cs + 4), s0 = *(const pg8::f32x4*)(cs + 32), s1 = *(const pg8::f32x4*)(cs + 36);
                        const float cc[8] = {c0[0], c0[1], c0[2], c0[3], c1[0], c1[1], c1[2], c1[3]}, sn[8] = {s0[0], s0[1], s0[2], s0[3], s1[0], s1[1], s1[2], s1[3]};
#pragma unroll
                        for (int q = 0; q < 8; ++q) { const float x1 = x[0][q], x2 = x[1][q]; x[0][q] = x1 * cc[q] - x2 * sn[q]; x[1][q] = x2 * cc[q] + x1 * sn[q]; } }
                    bf16* rowp = QKV + (size_t)row * QKVW + u.pn * 256 + 64 * wc + 8 * fq;
#pragma unroll
                    for (int bj = 0; bj < 2; ++bj) { u32x4 w; w.x = cvt_pk_bf16(x[bj][0], x[bj][1]); w.y = cvt_pk_bf16(x[bj][2], x[bj][3]); w.z = cvt_pk_bf16(x[bj][4], x[bj][5]); w.w = cvt_pk_bf16(x[bj][6], x[bj][7]);
                        *(u32x4*)(rowp + 32 * bj) = w; } }
            return;
        }
        const int row0 = u.pm * 256 + wr * 64 + fr;
        bf16* base; int ldc, colt; bool sg = false;
        if (u.kind) { base = MKV; ldc = 1024; colt = u.pn * 256; }
        else if (u.pn < 16) { base = QKV; ldc = QKVW; colt = u.pn * 256; }
        else { base = Gt; ldc = GW; colt = (u.pn - 16) * 256; sg = true; }
        const int col0 = colt + wc * 32 + 8 * fq;
#pragma unroll
        for (int ai = 0; ai < 2; ++ai)
#pragma unroll
            for (int m = 0; m < 4; ++m) { bf16* rowp = base + (size_t)(row0 + ai * 128 + m * 16) * ldc + col0;
#pragma unroll
                for (int bj = 0; bj < 2; ++bj) { pg8::f32x4 v0 = acc[ai][bj][m][0], v1 = acc[ai][bj][m][1];
                    if (sg) {
#pragma unroll
                        for (int q = 0; q < 4; ++q) { v0[q] = sigmoidf_(fmaxf(v0[q], -30.f)); v1[q] = sigmoidf_(fmaxf(v1[q], -30.f)); } }
                    u32x4 w; w.x = cvt_pk_bf16(v0[0], v0[1]); w.y = cvt_pk_bf16(v0[2], v0[3]); w.z = cvt_pk_bf16(v1[0], v1[1]); w.w = cvt_pk_bf16(v1[2], v1[3]);
                    *(u32x4*)(rowp + bj * 128) = w; } }
    }
};
#ifndef PROBE_GASM
#define PROBE_GASM true
#endif
#ifndef G_U8
#define G_U8 1
#endif
__device__ __forceinline__ float ub0(unsigned x) { return (float)(x & 0xffu); }
__device__ __forceinline__ float ub1(unsigned x) { return (float)((x >> 8) & 0xffu); }
__device__ __forceinline__ float ub2(unsigned x) { return (float)((x >> 16) & 0xffu); }
__device__ __forceinline__ float ub3(unsigned x) { return (float)(x >> 24); }
struct EpiGates {
    static constexpr bool PERM = true, MID = false, FP8 = true, ASM_MFMA = PROBE_GASM, BTILED = true; static constexpr int SCALE_A = 127 - H8_SHIFT, SCALE_B = 127 - W8_SHIFT;
    bf16* Gt;
    __device__ __forceinline__ void mid(pg8::f32x4 (&)[2][2][4][2], const Unit&, int, int, int, int, int) const {}
    __device__ __forceinline__ void operator()(const pg8::f32x4 (&acc)[2][2][4][2], const Unit& u, int wr, int wc, int fr, int fq) const {
        asm volatile("" : "+v"(fr), "+v"(fq));
        const int row0 = u.pm * 256 + wr * 64 + fr, col0 = u.pn * 256 + wc * 32 + 8 * fq;
#pragma unroll
        for (int ai = 0; ai < 2; ++ai)
#pragma unroll
            for (int m = 0; m < 4; ++m) { bf16* rowp = Gt + (size_t)(row0 + ai * 128 + m * 16) * GW + col0;
#pragma unroll
                for (int bj = 0; bj < 2; ++bj) { unsigned wv[4];
#pragma unroll
                    for (int n = 0; n < 2; ++n)
#pragma unroll
                        for (int hq = 0; hq < 2; ++hq) { typedef pg8::f32x2 f2;
                            f2 x = {fmaxf(acc[ai][bj][m][n][2 * hq], -30.f), fmaxf(acc[ai][bj][m][n][2 * hq + 1], -30.f)};
                            const f2 t = x * (-LOG2E); f2 e; e.x = __builtin_amdgcn_exp2f(t.x); e.y = __builtin_amdgcn_exp2f(t.y);
                            const f2 d = e + 1.0f;
                            if (G_U8) { f2 r; r.x = __builtin_amdgcn_rcpf(d.x); r.y = __builtin_amdgcn_rcpf(d.y); r = r * 255.0f;
                                unsigned& w = wv[n]; if (hq == 0) w = 0; w = __builtin_amdgcn_cvt_pk_u8_f32(fmaxf(__builtin_rintf(r.x), 1.0f), 2 * hq, w); w = __builtin_amdgcn_cvt_pk_u8_f32(fmaxf(__builtin_rintf(r.y), 1.0f), 2 * hq + 1, w); }
                            else wv[2 * n + hq] = cvt_pk_bf16(__builtin_amdgcn_rcpf(d.x), __builtin_amdgcn_rcpf(d.y)); }
                    if (G_U8) { u32x2 w; w.x = wv[0]; w.y = wv[1]; *(u32x2*)((unsigned char*)Gt + (size_t)(row0 + ai * 128 + m * 16) * GW + col0 + bj * 128) = w; }
                    else { u32x4 w; w.x = wv[0]; w.y = wv[1]; w.z = wv[2]; w.w = wv[3]; *(u32x4*)(rowp + bj * 128) = w; } } }
    }
};
struct EpiMerge {
    static constexpr bool PERM = true, MID = true, FP8 = false, ASM_MFMA = false, BTILED = false; static constexpr int SCALE_A = 0x7f, SCALE_B = 0x7f;
    const bf16* Gt; bf16* O; const float* Xpf; int noop;
    __device__ __forceinline__ void mid(pg8::f32x4 (&acc)[2][2][4][2], const Unit& u, int which, int wr, int wc, int fr, int fq) const {
        asm volatile("" : "+v"(fr), "+v"(fq));
        if (noop & 1) return;
        const int row0 = u.pm * 256 + wr * 64 + fr, col0 = u.pn * 256 + wc * 32 + 8 * fq;
        const unsigned char* gn = (const unsigned char*)Gt + (which ? 2048 : 0); const unsigned char* gd = (const unsigned char*)Gt + (which ? 4096 : 2048);
        u32x2 ga[2][4][2], gb[2][4][2];
#pragma unroll
        for (int ai = 0; ai < 2; ++ai)
#pragma unroll
            for (int m = 0; m < 4; ++m) { const size_t ro = (size_t)(row0 + ai * 128 + m * 16) * GW + col0;
#pragma unroll
                for (int bj = 0; bj < 2; ++bj) { ga[ai][m][bj] = *(const u32x2*)(gn + ro + bj * 128); gb[ai][m][bj] = *(const u32x2*)(gd + ro + bj * 128); } }
#pragma unroll
        for (int ai = 0; ai < 2; ++ai) {
#pragma unroll
            for (int m = 0; m < 4; ++m) {
#pragma unroll
                for (int bj = 0; bj < 2; ++bj) { const u32x2 a = ga[ai][m][bj], b = gb[ai][m][bj];
                    pg8::f32x4 r0, r1;
                    r0[0] = ub0(a.x) * __builtin_amdgcn_rcpf(ub0(b.x)); r0[1] = ub1(a.x) * __builtin_amdgcn_rcpf(ub1(b.x)); r0[2] = ub2(a.x) * __builtin_amdgcn_rcpf(ub2(b.x)); r0[3] = ub3(a.x) * __builtin_amdgcn_rcpf(ub3(b.x));
                    r1[0] = ub0(a.y) * __builtin_amdgcn_rcpf(ub0(b.y)); r1[1] = ub1(a.y) * __builtin_amdgcn_rcpf(ub1(b.y)); r1[2] = ub2(a.y) * __builtin_amdgcn_rcpf(ub2(b.y)); r1[3] = ub3(a.y) * __builtin_amdgcn_rcpf(ub3(b.y));
                    acc[ai][bj][m][0] *= r0; acc[ai][bj][m][1] *= r1; }
                asm volatile("" : "+v"(acc[ai][0][m][0]), "+v"(acc[ai][0][m][1]), "+v"(acc[ai][1][m][0]), "+v"(acc[ai][1][m][1])); }
            asm volatile("" ::: "memory"); }
    }
    __device__ __forceinline__ void operator()(const pg8::f32x4 (&acc)[2][2][4][2], const Unit& u, int wr, int wc, int fr, int fq) const {
        asm volatile("" : "+v"(fr), "+v"(fq));
        if (noop & 2) return;
        const int row0 = u.pm * 256 + wr * 64 + fr, col0 = u.pn * 256 + wc * 32 + 8 * fq;
        u32x2 gx[2][4][2];
#pragma unroll
        for (int ai = 0; ai < 2; ++ai)
#pragma unroll
            for (int m = 0; m < 4; ++m) { const size_t rr = (size_t)(row0 + ai * 128 + m * 16);
#pragma unroll
                for (int bj = 0; bj < 2; ++bj) gx[ai][m][bj] = *(const u32x2*)((const unsigned char*)Gt + rr * GW + 4096 + col0 + bj * 128); }
        constexpr float I255 = 1.0f / 255.0f;
#pragma unroll
        for (int ai = 0; ai < 2; ++ai)
#pragma unroll
            for (int m = 0; m < 4; ++m) { const size_t rr = (size_t)(row0 + ai * 128 + m * 16);
#pragma unroll
                for (int bj = 0; bj < 2; ++bj) { const u32x2 g = gx[ai][m][bj];
                    const pg8::f32x4 v0 = acc[ai][bj][m][0] * I255, v1 = acc[ai][bj][m][1] * I255;
                    u32x4 w; w.x = cvt_pk_bf16(v0[0] * ub0(g.x), v0[1] * ub1(g.x)); w.y = cvt_pk_bf16(v0[2] * ub2(g.x), v0[3] * ub3(g.x));
                    w.z = cvt_pk_bf16(v1[0] * ub0(g.y), v1[1] * ub1(g.y)); w.w = cvt_pk_bf16(v1[2] * ub2(g.y), v1[3] * ub3(g.y));
                    *(u32x4*)(O + rr * DM + col0 + bj * 128) = w; } }
    }
};
struct EpiOut {
    static constexpr bool PERM = true, MID = false, FP8 = false, ASM_MFMA = false, BTILED = false; static constexpr int SCALE_A = 0x7f, SCALE_B = 0x7f;
    const float* X; float* out; unsigned char* HB8; int noop; bf16* H1B;
    __device__ __forceinline__ void mid(pg8::f32x4 (&)[2][2][4][2], const Unit&, int, int, int, int, int) const {}
    __device__ __forceinline__ void operator()(const pg8::f32x4 (&acc)[2][2][4][2], const Unit& u, int wr, int wc, int fr, int fq) const {
        asm volatile("" : "+v"(fr), "+v"(fq));
        if (noop == 1) return;
        const int row0 = u.pm * 256 + wr * 64 + fr, col0 = u.pn * 256 + wc * 32 + 8 * fq;
#pragma unroll
        for (int ai = 0; ai < 2; ++ai) {
            pg8::f32x4 xv[4][2][2];
#pragma unroll
            for (int m = 0; m < 4; ++m) { const size_t off = (size_t)(row0 + ai * 128 + m * 16) * DM + col0;
#pragma unroll
                for (int bj = 0; bj < 2; ++bj) { if (noop == 11) { xv[m][bj][0] = (pg8::f32x4){0.f, 0.f, 0.f, 0.f}; xv[m][bj][1] = xv[m][bj][0]; } else { xv[m][bj][0] = *(const pg8::f32x4*)(X + off + bj * 128); xv[m][bj][1] = *(const pg8::f32x4*)(X + off + bj * 128 + 4); } } }
#pragma unroll
            for (int m = 0; m < 4; ++m) { const size_t off = (size_t)(row0 + ai * 128 + m * 16) * DM + col0;
#pragma unroll
                for (int bj = 0; bj < 2; ++bj) { const pg8::f32x4 h0 = xv[m][bj][0] + acc[ai][bj][m][0], h1 = xv[m][bj][1] + acc[ai][bj][m][1];
                    if (H1_BF16) { u32x4 hb; hb.x = cvt_pk_bf16(h0[0], h0[1]); hb.y = cvt_pk_bf16(h0[2], h0[3]); hb.z = cvt_pk_bf16(h1[0], h1[1]); hb.w = cvt_pk_bf16(h1[2], h1[3]); *(u32x4*)(H1B + off + bj * 128) = hb; }
                    else if (noop != 12) { *(pg8::f32x4*)(out + off + bj * 128) = h0; *(pg8::f32x4*)(out + off + bj * 128 + 4) = h1; }
                    u32x2 w; w.x = pk4_fp8(h0[0] * H8_MUL, h0[1] * H8_MUL, h0[2] * H8_MUL, h0[3] * H8_MUL); w.y = pk4_fp8(h1[0] * H8_MUL, h1[1] * H8_MUL, h1[2] * H8_MUL, h1[3] * H8_MUL);
                    if (noop != 13) *(u32x2*)(HB8 + off + bj * 128) = w; } }
            asm volatile("" ::: "memory");
        }
    }
};
struct EpiGateUp {
    static constexpr bool PERM = true, MID = false, FP8 = true, ASM_MFMA = true, BTILED = true; static constexpr int SCALE_A = 127 - H8_SHIFT, SCALE_B = 127 - W8_SHIFT;
    const float* RS; const float* bgu; unsigned char* ACT8;
    __device__ __forceinline__ void mid(pg8::f32x4 (&)[2][2][4][2], const Unit&, int, int, int, int, int) const {}
    __device__ __forceinline__ void operator()(const pg8::f32x4 (&acc)[2][2][4][2], const Unit& u, int wr, int wc, int fr, int fq) const {
        asm volatile("" : "+v"(fr), "+v"(fq));
        const int r0 = wr * 64 + fr, hc0 = u.pn * 128 + wc * 32 + 8 * fq;
        const float* bg = bgu + (size_t)u.e * 4096 + hc0;
        const pg8::f32x4 bg0 = *(const pg8::f32x4*)(bg), bg1 = *(const pg8::f32x4*)(bg + 4), bu0 = *(const pg8::f32x4*)(bg + 2048), bu1 = *(const pg8::f32x4*)(bg + 2052);
        float rsv[2][4];
#pragma unroll
        for (int ai = 0; ai < 2; ++ai)
#pragma unroll
            for (int m = 0; m < 4; ++m) rsv[ai][m] = RS[u.e * CAP + 256 * u.pm + r0 + ai * 128 + m * 16];
#pragma unroll
        for (int ai = 0; ai < 2; ++ai)
#pragma unroll
            for (int m = 0; m < 4; ++m) { const int rl = r0 + ai * 128 + m * 16;
                const float rs = rsv[ai][m];
                typedef pg8::f32x2 f2;
                f2 a2[4];
#pragma unroll
                for (int n = 0; n < 2; ++n)
#pragma unroll
                    for (int hq = 0; hq < 2; ++hq) {
                        const f2 ag = {acc[ai][0][m][n][2 * hq], acc[ai][0][m][n][2 * hq + 1]}, au = {acc[ai][1][m][n][2 * hq], acc[ai][1][m][n][2 * hq + 1]};
                        const f2 bgv = n ? (f2){bg1[2 * hq], bg1[2 * hq + 1]} : (f2){bg0[2 * hq], bg0[2 * hq + 1]}, buv = n ? (f2){bu1[2 * hq], bu1[2 * hq + 1]} : (f2){bu0[2 * hq], bu0[2 * hq + 1]};
                        f2 g = ag * rs + bgv, up = au * rs + buv;
                        g.x = fminf(g.x, SWIGLU_LIMIT); g.y = fminf(g.y, SWIGLU_LIMIT);
                        up.x = __builtin_amdgcn_fmed3f(up.x, -SWIGLU_LIMIT, SWIGLU_LIMIT); up.y = __builtin_amdgcn_fmed3f(up.y, -SWIGLU_LIMIT, SWIGLU_LIMIT);
                        const f2 t = g * (-SWIGLU_ALPHA * LOG2E);
                        f2 e; e.x = __builtin_amdgcn_exp2f(t.x); e.y = __builtin_amdgcn_exp2f(t.y);
                        const f2 d = e + 1.0f;
                        f2 r; r.x = __builtin_amdgcn_rcpf(d.x); r.y = __builtin_amdgcn_rcpf(d.y);
                        const f2 sg = (g * ACT8_MUL) * r;
                        a2[2 * n + hq] = up * sg + sg;
                    }
                u32x2 w;
                { int p0 = __builtin_amdgcn_cvt_pk_fp8_f32(a2[0].x, a2[0].y, 0, false); p0 = __builtin_amdgcn_cvt_pk_fp8_f32(a2[1].x, a2[1].y, p0, true); w.x = (unsigned)p0;
                  int p1 = __builtin_amdgcn_cvt_pk_fp8_f32(a2[2].x, a2[2].y, 0, false); p1 = __builtin_amdgcn_cvt_pk_fp8_f32(a2[3].x, a2[3].y, p1, true); w.y = (unsigned)p1; }
                *(u32x2*)(ACT8 + (size_t)(u.kind + rl) * DM + hc0) = w; }
    }
};
struct EpiDown {
    static constexpr bool PERM = true, MID = false, FP8 = true, ASM_MFMA = true, BTILED = true; static constexpr int SCALE_A = 127 - ACT8_SHIFT, SCALE_B = 127 - W8_SHIFT;
    const float* bd; bf16* Y; int noop;
    __device__ __forceinline__ void mid(pg8::f32x4 (&)[2][2][4][2], const Unit&, int, int, int, int, int) const {}
    __device__ __forceinline__ void operator()(const pg8::f32x4 (&acc)[2][2][4][2], const Unit& u, int wr, int wc, int fr, int fq) const {
        asm volatile("" : "+v"(fr), "+v"(fq));
        if (noop) return;
        const int r0 = wr * 64 + fr, col0 = u.pn * 256 + wc * 32 + 8 * fq;
        const float* bb = bd + (size_t)u.e * DM + col0;
        pg8::f32x4 bv[2][2];
#pragma unroll
        for (int bj = 0; bj < 2; ++bj)
#pragma unroll
            for (int n = 0; n < 2; ++n) bv[bj][n] = *(const pg8::f32x4*)(bb + bj * 128 + n * 4);
#pragma unroll
        for (int ai = 0; ai < 2; ++ai)
#pragma unroll
            for (int m = 0; m < 4; ++m) { bf16* rowp = Y + (size_t)(u.kind + r0 + ai * 128 + m * 16) * DM + col0;
#pragma unroll
                for (int bj = 0; bj < 2; ++bj) { const pg8::f32x4 v0 = acc[ai][bj][m][0] + bv[bj][0], v1 = acc[ai][bj][m][1] + bv[bj][1];
                    u32x4 w; w.x = cvt_pk_bf16(v0[0], v0[1]); w.y = cvt_pk_bf16(v0[2], v0[3]); w.z = cvt_pk_bf16(v1[0], v1[1]); w.w = cvt_pk_bf16(v1[2], v1[3]);
                    *(u32x4*)(rowp + bj * 128) = w; } }
    }
};

__device__ __forceinline__ void logf_cumsum(const Ctx& C) {
    LAS float* wt = (LAS float*)(C.lds + RING_OFF);
    for (int sq = (int)blockIdx.x; sq < BATCH * 12; sq += C.G) {
        const float* src = C.LOGF + (size_t)sq * SEQ + C.tid * 16; float* dst = C.CNEG + (size_t)sq * SEQ + C.tid * 16;
        f32x4 a[4]; float tot = 0.f;
#pragma unroll
        for (int j = 0; j < 4; ++j) { a[j] = *(const GAS f32x4*)(src + 4 * j); tot += (a[j].x + a[j].y) + (a[j].z + a[j].w); }
        float incl = tot;
#pragma unroll
        for (int o = 1; o < 64; o <<= 1) { const float n = __shfl_up(incl, o); if (C.lane >= o) incl += n; }
        if (C.lane == 63) wt[C.wave] = incl;
        __syncthreads();
        float run = incl - tot;
        for (int w = 0; w < C.wave; ++w) run += wt[w];
#pragma unroll
        for (int j = 0; j < 4; ++j) { f32x4 c; run += a[j].x; c.x = -run * LOG2E; run += a[j].y; c.y = -run * LOG2E; run += a[j].z; c.z = -run * LOG2E; run += a[j].w; c.w = -run * LOG2E; *(GAS f32x4*)(dst + 4 * j) = c; }
        __syncthreads();
    }
}

#ifndef CONV_FIRST_EIGHTHS
#define CONV_FIRST_EIGHTHS 4
#endif
namespace att {
typedef __attribute__((address_space(3))) const char* lds_cptr;
__device__ __forceinline__ void glds16(const void* gsrc, unsigned lds_dst) { unsigned keep;
    asm volatile("s_mov_b32 %0, m0\n\ts_mov_b32 m0, %2\n\ts_nop 0\n\tglobal_load_lds_dwordx4 %1, off\n\ts_mov_b32 m0, %0" : "=&s"(keep) : "v"(gsrc), "s"(lds_dst) : "memory"); }
typedef float f32x2_t __attribute__((ext_vector_type(2))); typedef __bf16 bf16x2_t __attribute__((ext_vector_type(2)));
__device__ __forceinline__ unsigned cvtpk_s(float lo, float hi) { f32x2_t v = {lo, hi}; bf16x2_t b = __builtin_convertvector(v, bf16x2_t); return __builtin_bit_cast(unsigned, b); }
__device__ __forceinline__ int crow(int r, int hi) { return (r & 3) + 8 * (r >> 2) + 4 * hi; }

template <int D> struct Geo {
    static constexpr int SLOTB = 64 * D * 2, NSLOT = (D == 64) ? 3 : 2, PPT = (D == 64) ? 2 : 4;
    static constexpr int LDS_K = 0, LDS_V = NSLOT * SLOTB, LDS_WS = 2 * NSLOT * SLOTB, LDS_WMIN = LDS_WS + 2048, LDS_OST = LDS_WMIN + 64, LDS_CB = LDS_OST + 8 * 4096, LDS_END = LDS_CB + 32768;
};

template <int D>
__device__ __forceinline__ void qkt(f32x16& p0, f32x16& p1, lds_cptr Kslot, const bf16x8* qr, int r32, int hi) {
    lds_cptr kb = Kslot + hi * 1024 + r32 * 16;
    p0 = f32x16{}; p1 = f32x16{};
#pragma unroll
    for (int d0 = 0; d0 < D / 16; ++d0) {
        const bf16x8 b0 = *(const LAS bf16x8*)(kb + d0 * 2048);
        const bf16x8 b1 = *(const LAS bf16x8*)(kb + d0 * 2048 + 512);
        p0 = __builtin_amdgcn_mfma_f32_32x32x16_bf16(b0, qr[d0], p0, 0, 0, 0); p1 = __builtin_amdgcn_mfma_f32_32x32x16_bf16(b1, qr[d0], p1, 0, 0, 0); }
}
template <int D>
__device__ __forceinline__ void pv(f32x16* o, int vb, bf16x8 pa0, bf16x8 pa1, bf16x8 pa2, bf16x8 pa3) {
#pragma unroll
    for (int d0 = 0; d0 < D / 32; ++d0) { s16x4 lo[4], hi[4];
#pragma unroll
        for (int ks = 0; ks < 4; ++ks) {
            asm volatile("ds_read_b64_tr_b16 %0,%1 offset:%c2" : "=&v"(lo[ks]) : "v"(vb), "i"(d0 * 4096 + ks * 1024) : "memory");
            asm volatile("ds_read_b64_tr_b16 %0,%1 offset:%c2" : "=&v"(hi[ks]) : "v"(vb), "i"(d0 * 4096 + ks * 1024 + 512) : "memory"); }
        asm volatile("s_waitcnt lgkmcnt(0)" ::: "memory"); __builtin_amdgcn_sched_barrier(0);
#define ATT_PK(k) (bf16x8){lo[k][0], lo[k][1], lo[k][2], lo[k][3], hi[k][0], hi[k][1], hi[k][2], hi[k][3]}
        o[d0] = __builtin_amdgcn_mfma_f32_32x32x16_bf16(pa0, ATT_PK(0), o[d0], 0, 0, 0);
        o[d0] = __builtin_amdgcn_mfma_f32_32x32x16_bf16(pa1, ATT_PK(1), o[d0], 0, 0, 0);
        o[d0] = __builtin_amdgcn_mfma_f32_32x32x16_bf16(pa2, ATT_PK(2), o[d0], 0, 0, 0);
        o[d0] = __builtin_amdgcn_mfma_f32_32x32x16_bf16(pa3, ATT_PK(3), o[d0], 0, 0, 0);
#undef ATT_PK
    }
}

template <int D, int MODE>
__device__ __forceinline__ void attn_unit(LAS unsigned char* shm, const bf16* Q, int pitchQ, const bf16* K, const bf16* V, int pitchKV, bf16* O, const float* cneg, float sink2, int qb, const float* qgain, const float* kgain, const float* ropet, float bqk = 0.f) {
    typedef Geo<D> G;
    int tid = threadIdx.x; asm volatile("" : "+v"(tid));
    const int lane = tid & 63, r32 = lane & 31, hi = lane >> 5; const int wid = __builtin_amdgcn_readfirstlane(tid >> 6);
    const int q0 = qb * 256, q0w = q0 + wid * 32;
    const unsigned lds0 = (unsigned)(uintptr_t)shm;
    LAS float* wsf = (LAS float*)(shm + G::LDS_WS) + wid * 64;
    LAS float* cb = (LAS float*)(shm + G::LDS_CB);
    const int j_lo = (MODE == 1) ? (qb > 0 ? 4 * qb - 2 : 0) : 0, j_hi = (MODE == 2) ? 4 : 4 * qb + 4;
    bf16x8 qr[D / 16];
    { const bf16* Qw = Q + (size_t)(q0w + r32) * pitchQ + hi * 8;
#pragma unroll
      for (int d0 = 0; d0 < D / 16; ++d0) qr[d0] = *(const GAS bf16x8*)(Qw + d0 * 16); }
    {
#define ATT_UNPK(dst, src) do { const v4u w_ = __builtin_bit_cast(v4u, src); dst[0] = pg8::bf_lo(w_.x); dst[1] = pg8::bf_hi(w_.x); dst[2] = pg8::bf_lo(w_.y); dst[3] = pg8::bf_hi(w_.y); dst[4] = pg8::bf_lo(w_.z); dst[5] = pg8::bf_hi(w_.z); dst[6] = pg8::bf_lo(w_.w); dst[7] = pg8::bf_hi(w_.w); } while (0)
#define ATT_PK8(dst, src) do { v4u w_; w_.x = cvtpk_s(src[0], src[1]); w_.y = cvtpk_s(src[2], src[3]); w_.z = cvtpk_s(src[4], src[5]); w_.w = cvtpk_s(src[6], src[7]); dst = __builtin_bit_cast(bf16x8, w_); } while (0)
        float ss = 0.f;
#pragma unroll
        for (int d0 = 0; d0 < D / 16; ++d0) { float t[8]; ATT_UNPK(t, qr[d0]);
#pragma unroll
            for (int j = 0; j < 8; ++j) ss += t[j] * t[j]; }
        { auto rr = __builtin_amdgcn_permlane32_swap(__float_as_uint(ss), __float_as_uint(ss), false, false); ss = __uint_as_float(rr[0]) + __uint_as_float(rr[1]); }
        const float rq = (1.0f / sqrtf(ss * (1.f / D) + NORM_EPS)) * ((D == 64 ? 0.125f : 0.08838834764831845f) * LOG2E);
        if constexpr (MODE == 1) {
            const float* cs = ropet + (size_t)(q0w + r32) * 64 + 8 * hi;
#pragma unroll
            for (int d0 = 0; d0 < 2; ++d0) { float x1[8], x2[8]; ATT_UNPK(x1, qr[d0]); ATT_UNPK(x2, qr[d0 + 2]);
                const float* g1 = qgain + 16 * d0 + 8 * hi;
                const f32x4 ga = *(const GAS f32x4*)g1, gb = *(const GAS f32x4*)(g1 + 4), gc = *(const GAS f32x4*)(g1 + 32), gd = *(const GAS f32x4*)(g1 + 36);
                const f32x4 c0 = *(const GAS f32x4*)(cs + 16 * d0), c1 = *(const GAS f32x4*)(cs + 16 * d0 + 4), s0 = *(const GAS f32x4*)(cs + 32 + 16 * d0), s1 = *(const GAS f32x4*)(cs + 36 + 16 * d0);
                const float gg1[8] = {ga.x, ga.y, ga.z, ga.w, gb.x, gb.y, gb.z, gb.w}, gg2[8] = {gc.x, gc.y, gc.z, gc.w, gd.x, gd.y, gd.z, gd.w};
                const float cc[8] = {c0.x, c0.y, c0.z, c0.w, c1.x, c1.y, c1.z, c1.w}, sn[8] = {s0.x, s0.y, s0.z, s0.w, s1.x, s1.y, s1.z, s1.w};
#pragma unroll
                for (int j = 0; j < 8; ++j) { const float a = (x1[j] * rq) * gg1[j], b = (x2[j] * rq) * gg2[j]; x1[j] = a * cc[j] - b * sn[j]; x2[j] = b * cc[j] + a * sn[j]; }
                ATT_PK8(qr[d0], x1); ATT_PK8(qr[d0 + 2], x2); asm volatile("" ::: "memory"); }
        } else {
#pragma unroll
            for (int d0 = 0; d0 < D / 16; ++d0) { float t[8]; ATT_UNPK(t, qr[d0]);
                const float* gp = qgain + 16 * d0 + 8 * hi; f32x4 ga = *(const GAS f32x4*)gp, gb = *(const GAS f32x4*)(gp + 4);
                if constexpr (MODE == 2) { ga = ga * *(const GAS f32x4*)(kgain + 16 * d0 + 8 * hi); gb = gb * *(const GAS f32x4*)(kgain + 16 * d0 + 8 * hi + 4); }
                t[0] = (t[0] * rq) * ga.x; t[1] = (t[1] * rq) * ga.y; t[2] = (t[2] * rq) * ga.z; t[3] = (t[3] * rq) * ga.w; t[4] = (t[4] * rq) * gb.x; t[5] = (t[5] * rq) * gb.y; t[6] = (t[6] * rq) * gb.z; t[7] = (t[7] * rq) * gb.w;
                ATT_PK8(qr[d0], t); asm volatile("" ::: "memory"); }
        }
#undef ATT_UNPK
#undef ATT_PK8
    }
    if constexpr (MODE == 2) {
        const int key = tid >> 1, hf = tid & 1; const bf16* kp = K + (size_t)key * pitchKV + 64 * hf; float ss = 0.f;
#pragma unroll
        for (int c = 0; c < 8; ++c) { const v4u w = *(const GAS v4u*)(kp + 8 * c); const float a0 = pg8::bf_lo(w.x), a1 = pg8::bf_hi(w.x), a2 = pg8::bf_lo(w.y), a3 = pg8::bf_hi(w.y), a4 = pg8::bf_lo(w.z), a5 = pg8::bf_hi(w.z), a6 = pg8::bf_lo(w.w), a7 = pg8::bf_hi(w.w);
            ss += (a0 * a0 + a1 * a1) + (a2 * a2 + a3 * a3) + (a4 * a4 + a5 * a5) + (a6 * a6 + a7 * a7); }
        ss += __shfl_xor(ss, 1);
        if (hf == 0) cb[key] = 1.0f / sqrtf(ss * (1.f / 128.f) + NORM_EPS);
    }
    if constexpr (MODE == 0) {
        const int nch = (q0 + 256) / 4;
        for (int c = tid; c < nch; c += 512) { const f32x4 v = *(const GAS f32x4*)(cneg + 4 * c); *(LAS f32x4*)(cb + 4 * c) = v; }
    }
#define ATT_DMA(j, slot) do { const int _s = (slot) * G::SLOTB; \
        if constexpr (D == 64) { \
            glds16(K + (size_t)(64 * (j) + lane) * pitchKV + wid * 8, (unsigned)__builtin_amdgcn_readfirstlane(lds0 + G::LDS_K + _s + wid * 1024)); \
            glds16(V + (size_t)(64 * (j) + 16 * (wid & 3) + (lane >> 2)) * pitchKV + (wid >> 2) * 32 + (lane & 3) * 8, (unsigned)__builtin_amdgcn_readfirstlane(lds0 + G::LDS_V + _s + wid * 1024)); \
        } else { \
            _Pragma("unroll") for (int _p = 0; _p < 2; ++_p) { const int _c = wid + 8 * _p; \
                glds16(K + (size_t)(64 * (j) + lane) * pitchKV + _c * 8, (unsigned)__builtin_amdgcn_readfirstlane(lds0 + G::LDS_K + _s + _c * 1024)); } \
            _Pragma("unroll") for (int _p = 0; _p < 2; ++_p) { const int _c = wid + 8 * _p; \
                glds16(V + (size_t)(64 * (j) + 16 * (_c & 3) + (lane >> 2)) * pitchKV + (_c >> 2) * 32 + (lane & 3) * 8, (unsigned)__builtin_amdgcn_readfirstlane(lds0 + G::LDS_V + _s + _c * 1024)); } \
        } } while (0)
    int slot_i = 0;
    constexpr bool REV = (MODE == 0);
    const int nst = j_hi - j_lo;
#define ATT_TILE(st_) (REV ? (j_hi - 1 - (st_)) : (j_lo + (st_)))
#pragma unroll
    for (int p = 0; p < G::NSLOT - 1; ++p) if (p < nst) ATT_DMA(ATT_TILE(p), p);
    float mhat = -1e30f, l_reg = 0.f; f32x16 o[D / 32];
#pragma unroll
    for (int d0 = 0; d0 < D / 32; ++d0) o[d0] = f32x16{};
    const lds_cptr shm3 = (lds_cptr)shm;
    const int vb0 = (int)(lds0 + G::LDS_V) + ((lane >> 4) & 1) * 32 + (lane & 3) * 8 + (4 * hi + ((lane & 15) >> 2)) * 64;
    const int qabs = q0w + r32;
    LAS float* wmin = (LAS float*)(shm + G::LDS_WMIN);
    for (int st = 0; st < nst; ++st) {
        const int j = ATT_TILE(st);
        if (G::NSLOT == 3 && st + 1 < nst) { if constexpr (G::PPT == 2) asm volatile("s_waitcnt vmcnt(2) lgkmcnt(0)\n\ts_barrier" ::: "memory"); else asm volatile("s_waitcnt vmcnt(4) lgkmcnt(0)\n\ts_barrier" ::: "memory"); }
        else asm volatile("s_waitcnt vmcnt(0) lgkmcnt(0)\n\ts_barrier" ::: "memory");
        if constexpr (MODE == 0) { if (st >= 5) {
            const LAS float* wm = wmin + ((st - 1) & 1) * 8; const f32x4 a = *(const LAS f32x4*)wm, b = *(const LAS f32x4*)(wm + 4);
            const float gmin = fminf(fminf(fminf(a.x, a.y), fminf(a.z, a.w)), fminf(fminf(b.x, b.y), fminf(b.z, b.w)));
            if (cb[64 * j + 63] + bqk < gmin - 40.0f) break; } }
        { const int sn_ = st + G::NSLOT - 1; if (sn_ < nst) { int sn = slot_i + G::NSLOT - 1; if (sn >= G::NSLOT) sn -= G::NSLOT; ATT_DMA(ATT_TILE(sn_), sn); } }
        bool need = true;
        if constexpr (MODE == 0) need = (64 * j <= q0w + 31);
        if constexpr (MODE == 1) need = (64 * j <= q0w + 31) && (64 * j + 63 >= q0w - 127);
        if (need) {
            f32x16 p0, p1;
            qkt<D>(p0, p1, shm3 + G::LDS_K + slot_i * G::SLOTB, qr, r32, hi);
            if constexpr (MODE == 2) {
                const LAS float* rkp = cb + 64 * j + 4 * hi;
#pragma unroll
                for (int g = 0; g < 4; ++g) { const f32x4 b0 = *(const LAS f32x4*)(rkp + 8 * g), b1 = *(const LAS f32x4*)(rkp + 32 + 8 * g);
#pragma unroll
                    for (int e = 0; e < 4; ++e) { p0[4 * g + e] *= b0[e]; p1[4 * g + e] *= b1[e]; } }
            }
            if constexpr (MODE == 0) {
                const LAS float* cbp = cb + 64 * j + 4 * hi;
#pragma unroll
                for (int g = 0; g < 4; ++g) { const f32x4 b0 = *(const LAS f32x4*)(cbp + 8 * g), b1 = *(const LAS f32x4*)(cbp + 32 + 8 * g);
#pragma unroll
                    for (int e = 0; e < 4; ++e) { p0[4 * g + e] += b0[e]; p1[4 * g + e] += b1[e]; } }
                if (64 * j + 63 > q0w) {
#pragma unroll
                    for (int r = 0; r < 16; ++r) { const int kv = 64 * j + crow(r, hi); if (kv > qabs) p0[r] = -INFINITY; if (kv + 32 > qabs) p1[r] = -INFINITY; } }
            }
            if constexpr (MODE == 1) {
#pragma unroll
                for (int r = 0; r < 16; ++r) { const int kv = 64 * j + crow(r, hi); const int d0_ = qabs - kv, d1_ = d0_ - 32;
                    if (d0_ < 0 || d0_ >= 128) p0[r] = -INFINITY; if (d1_ < 0 || d1_ >= 128) p1[r] = -INFINITY; }
            }
            float rm = fmaxf(p0[0], p1[0]);
#pragma unroll
            for (int r = 1; r < 16; ++r) rm = fmaxf(rm, fmaxf(p0[r], p1[r]));
            { auto rr = __builtin_amdgcn_permlane32_swap(__float_as_uint(rm), __float_as_uint(rm), false, false); rm = fmaxf(__uint_as_float(rr[0]), __uint_as_float(rr[1])); }
            if (__any(rm > mhat)) {
                const float mn = fmaxf(mhat, rm); const float f = __builtin_amdgcn_exp2f(mhat - mn); mhat = mn; l_reg *= f;
                if (hi == 0) wsf[r32] = f;
                asm volatile("s_waitcnt lgkmcnt(0)" ::: "memory");
#pragma unroll
                for (int g = 0; g < 4; ++g) { const f32x4 fv = *(const LAS f32x4*)(wsf + 8 * g + 4 * hi);
#pragma unroll
                    for (int d_ = 0; d_ < D / 32; ++d_)
#pragma unroll
                        for (int e = 0; e < 4; ++e) o[d_][4 * g + e] *= fv[e]; }
            }
            float sacc = 0.f;
#pragma unroll
            for (int r = 0; r < 16; ++r) { p0[r] = __builtin_amdgcn_exp2f(p0[r] - mhat); p1[r] = __builtin_amdgcn_exp2f(p1[r] - mhat); sacc += p0[r] + p1[r]; }
            l_reg += sacc;
            u32x4 pw0, pw1, pw2, pw3;
            pw0 = (u32x4){cvtpk_s(p0[0], p0[1]), cvtpk_s(p0[2], p0[3]), cvtpk_s(p0[4], p0[5]), cvtpk_s(p0[6], p0[7])};
            pw1 = (u32x4){cvtpk_s(p0[8], p0[9]), cvtpk_s(p0[10], p0[11]), cvtpk_s(p0[12], p0[13]), cvtpk_s(p0[14], p0[15])};
            pw2 = (u32x4){cvtpk_s(p1[0], p1[1]), cvtpk_s(p1[2], p1[3]), cvtpk_s(p1[4], p1[5]), cvtpk_s(p1[6], p1[7])};
            pw3 = (u32x4){cvtpk_s(p1[8], p1[9]), cvtpk_s(p1[10], p1[11]), cvtpk_s(p1[12], p1[13]), cvtpk_s(p1[14], p1[15])};
            pv<D>(o, vb0 + slot_i * G::SLOTB, __builtin_bit_cast(bf16x8, pw0), __builtin_bit_cast(bf16x8, pw1), __builtin_bit_cast(bf16x8, pw2), __builtin_bit_cast(bf16x8, pw3));
        }
        if constexpr (MODE == 0) { float mn = mhat;
#pragma unroll
            for (int of = 1; of < 32; of <<= 1) mn = fminf(mn, __shfl_xor(mn, of));
            if (lane == 0) wmin[(st & 1) * 8 + wid] = mn; }
        ++slot_i; if (slot_i == G::NSLOT) slot_i = 0;
    }
#undef ATT_DMA
#undef ATT_TILE
    if constexpr (MODE == 0) asm volatile("s_waitcnt vmcnt(0)" ::: "memory");
    { auto rr = __builtin_amdgcn_permlane32_swap(__float_as_uint(l_reg), __float_as_uint(l_reg), false, false); l_reg = __uint_as_float(rr[0]) + __uint_as_float(rr[1]); }
    if constexpr (MODE == 1) l_reg += __builtin_amdgcn_exp2f(sink2 - mhat);
    if (hi == 0) wsf[32 + r32] = l_reg;
    asm volatile("s_waitcnt lgkmcnt(0)" ::: "memory");
    float rli[16];
#pragma unroll
    for (int g = 0; g < 4; ++g) { const f32x4 lv = *(const LAS f32x4*)(wsf + 32 + 8 * g + 4 * hi);
#pragma unroll
        for (int e = 0; e < 4; ++e) rli[4 * g + e] = __builtin_amdgcn_rcpf(lv[e]); }
    bf16* Ow = O + (size_t)q0w * 2048;
    LAS bf16* stg = (LAS bf16*)(shm + G::LDS_OST) + wid * 2048;
#pragma unroll
    for (int ps = 0; ps < D / 64; ++ps) {
#pragma unroll
        for (int r = 0; r < 16; ++r) { const int orow = crow(r, hi);
#pragma unroll
            for (int dl = 0; dl < 2; ++dl) stg[orow * 64 + dl * 32 + r32] = (bf16)f2bf(o[2 * ps + dl][r] * rli[r]); }
        asm volatile("s_waitcnt lgkmcnt(0)" ::: "memory");
#pragma unroll
        for (int i = 0; i < 4; ++i) { const int row = i * 8 + (lane >> 3), ch = lane & 7; const v4u v = *(const LAS v4u*)(stg + row * 64 + ch * 8); *(GAS v4u*)(Ow + (size_t)row * 2048 + ps * 64 + ch * 8) = v; }
        asm volatile("s_waitcnt lgkmcnt(0)" ::: "memory");
    }
    asm volatile("s_waitcnt lgkmcnt(0)\n\ts_barrier" ::: "memory");
}
}

constexpr int NU_FOX = BATCH * 12 * 32, NU_SWA = BATCH * 12 * 32, NU_XM = BATCH * 4 * 32;
__device__ __forceinline__ int att_fetch(const Ctx& C, int q) {
    int v = 0; if (C.tid == 0) v = (int)__hip_atomic_fetch_add((unsigned*)(C.ctl + CW_QHEAD + 64 * q), 1u, RLX_AGENT); return v;
}

#ifndef ATT_XCD_Q
#define ATT_XCD_Q 0
#endif
constexpr int CW_XQ = 1024;
template <class F>
__device__ __forceinline__ void xq_run(const Ctx& C, int kind, int N, volatile LAS int* nxtw, F&& unit) {
    const int xcd = (int)blockIdx.x & 7;
    unsigned* heads = (unsigned*)(C.ctl + CW_XQ + 512 * kind);
    int q = xcd, xs = 0, pre = 0;
    if (C.tid == 0) pre = (int)__hip_atomic_fetch_add(heads + 64 * q, 1u, RLX_AGENT);
    for (;;) {
        if (C.tid == 0) { int qq = q, s = xs, v = pre;
            while (v >= N && ++s < 8) { qq = (xcd + s) & 7; v = (int)__hip_atomic_fetch_add(heads + 64 * qq, 1u, RLX_AGENT); }
            *nxtw = (s < 8) ? (qq | (v << 3) | (s << 16)) : -1; }
        __syncthreads();
        const int cur = __builtin_amdgcn_readfirstlane(*nxtw);
        __syncthreads();
        if (cur < 0) break;
        q = cur & 7; xs = cur >> 16;
        if (C.tid == 0) pre = (int)__hip_atomic_fetch_add(heads + 64 * q, 1u, RLX_AGENT);
        unit(q, (cur >> 3) & 0x1FFF);
    }
}
__device__ __forceinline__ void phase3(const Ctx& C, int sel = 0) {
    LAS unsigned char* shm = C.lds + RING_OFF;
    volatile LAS int* nxtw = (volatile LAS int*)(C.MISC + 12);
    const bool gate_wg = GATES_IN_P3 && sel == 0 && (int)blockIdx.x < GATE_WGS;
    if (gate_wg) {
        P1bGrpOrder S8; S8.d.init(C.XN8, C.Win8, T, 6144, GATE_WGS, (int)blockIdx.x);
        EpiGates E8{C.G_};
        pg8::gemm_phase<EpiGates, P1bGrpOrder>(C.lds + RING_OFF, S8, E8);
        __syncthreads();
    }
    const bool conv_first = CONV_IN_P3 && sel == 0 && !gate_wg && (((blockIdx.x >> 3) & 7) < CONV_FIRST_EIGHTHS);
    auto run_conv = [&]() {
        if (!(CONV_IN_P3 && (sel == 0 || sel == 8 || (sel == 9 && ((blockIdx.x >> 3) & 1))))) return;
        int pre = att_fetch(C, 3);
        if (C.tid == 0) *nxtw = pre;
        p0_fill_lnorm(C, (LAS float*)(C.lds + RING_OFF + 65536));
        __syncthreads();
        int cur = __builtin_amdgcn_readfirstlane(*nxtw);
        __syncthreads();
        while (cur < (CONV_COOP ? CONV2_NCHUNK : CONV_NCHUNK)) {
            pre = att_fetch(C, 3);
            if (CONV_COOP) conv_chunk2(C, cur); else conv_chunk(C, cur);
            if (C.tid == 0) *nxtw = pre;
            __syncthreads();
            cur = __builtin_amdgcn_readfirstlane(*nxtw);
            __syncthreads();
        }
    };
    if (conv_first) run_conv();
    if (sel == 0 || sel == 4 || sel == 7) {
        float gq = fabsf(C.fox_q_norm[C.lane]), gk = fabsf(C.fox_k_norm[C.lane]);
#pragma unroll
        for (int of = 1; of < 64; of <<= 1) { gq = fmaxf(gq, __shfl_xor(gq, of)); gk = fmaxf(gk, __shfl_xor(gk, of)); }
        const float bqk = 64.0f * gq * gk * (0.125f * LOG2E) * 1.02f;
        if (ATT_XCD_Q) {
            xq_run(C, 0, 96, nxtw, [&](int q, int idx) {
                const int qb = 31 - idx / 3, bh = q + 8 * (idx % 3), b = bh / 12, h = bh % 12;
                const bf16* base = C.QKV + (size_t)b * SEQ * QKVW + h * 64;
                att::attn_unit<64, 0>(shm, base + C_FQ, QKVW, base + C_FK, base + C_FV, QKVW, C.OALL + (size_t)b * SEQ * 2048 + h * 64, C.CNEG + (size_t)(b * 12 + h) * SEQ, 0.f, qb, C.fox_q_norm, nullptr, nullptr, bqk); });
        } else {
        int pre = att_fetch(C, 0);
        if (C.tid == 0) *nxtw = pre;
        __syncthreads();
        int cur = __builtin_amdgcn_readfirstlane(*nxtw);
        __syncthreads();
        while (cur < NU_FOX) {
            pre = att_fetch(C, 0);
            const int qb = 31 - cur / 24, bh = cur % 24, b = bh / 12, h = bh % 12;
            const bf16* base = C.QKV + (size_t)b * SEQ * QKVW + h * 64;
            att::attn_unit<64, 0>(shm, base + C_FQ, QKVW, base + C_FK, base + C_FV, QKVW, C.OALL + (size_t)b * SEQ * 2048 + h * 64, C.CNEG + (size_t)(b * 12 + h) * SEQ, 0.f, qb, C.fox_q_norm, nullptr, nullptr, bqk);
            if (C.tid == 0) *nxtw = pre;
            __syncthreads();
            cur = __builtin_amdgcn_readfirstlane(*nxtw);
            __syncthreads();
        }
        }
    }
    if (sel == 0 || sel == 5 || sel == 7) {
        if (ATT_XCD_Q) {
            xq_run(C, 1, 96, nxtw, [&](int q, int idx) {
                const int qb = idx / 3, b = q >> 2, kvh = q & 3, h = kvh * 3 + idx % 3;
                const bf16* base = C.QKV + (size_t)b * SEQ * QKVW;
                att::attn_unit<64, 1>(shm, base + C_SQ + h * 64, QKVW, base + C_SK + kvh * 64, base + C_SV + kvh * 64, QKVW, C.OALL + (size_t)b * SEQ * 2048 + 768 + h * 64, nullptr, C.swa_sinks[h] * LOG2E, qb, C.swa_q_norm, nullptr, C.ROPE + (size_t)b * SEQ * 64); });
        } else {
        int pre = att_fetch(C, 1);
        if (C.tid == 0) *nxtw = pre;
        __syncthreads();
        int cur = __builtin_amdgcn_readfirstlane(*nxtw);
        __syncthreads();
        while (cur < NU_SWA) {
            pre = att_fetch(C, 1);
            const int qb = cur / 24, bh = cur % 24, b = bh / 12, h = bh % 12, kvh = h / 3;
            const bf16* base = C.QKV + (size_t)b * SEQ * QKVW;
            att::attn_unit<64, 1>(shm, base + C_SQ + h * 64, QKVW, base + C_SK + kvh * 64, base + C_SV + kvh * 64, QKVW, C.OALL + (size_t)b * SEQ * 2048 + 768 + h * 64, nullptr, C.swa_sinks[h] * LOG2E, qb, C.swa_q_norm, nullptr, C.ROPE + (size_t)b * SEQ * 64);
            if (C.tid == 0) *nxtw = pre;
            __syncthreads();
            cur = __builtin_amdgcn_readfirstlane(*nxtw);
            __syncthreads();
        }
        }
    }
    if (sel == 0 || sel == 6 || sel == 7) {
        if (ATT_XCD_Q) {
            xq_run(C, 2, 32, nxtw, [&](int q, int qb) {
                const int b = q >> 2, h = q & 3;
                const bf16* kb = C.MKV + (size_t)b * NMEM * 1024 + h * 128;
                att::attn_unit<128, 2>(shm, C.QKV + (size_t)b * SEQ * QKVW + C_MQ + h * 128, QKVW, kb, kb + 512, 1024, C.OALL + (size_t)b * SEQ * 2048 + 1536 + h * 128, nullptr, 0.f, qb, C.xmem_q_norm, C.xmem_k_norm, nullptr); });
        } else {
        int pre = att_fetch(C, 2);
        if (C.tid == 0) *nxtw = pre;
        __syncthreads();
        int cur = __builtin_amdgcn_readfirstlane(*nxtw);
        __syncthreads();
        while (cur < NU_XM) {
            pre = att_fetch(C, 2);
            const int qb = cur / 8, bh = cur % 8, b = bh / 4, h = bh % 4;
            const bf16* kb = C.MKV + (size_t)b * NMEM * 1024 + h * 128;
            att::attn_unit<128, 2>(shm, C.QKV + (size_t)b * SEQ * QKVW + C_MQ + h * 128, QKVW, kb, kb + 512, 1024, C.OALL + (size_t)b * SEQ * 2048 + 1536 + h * 128, nullptr, 0.f, qb, C.xmem_q_norm, C.xmem_k_norm, nullptr);
            if (C.tid == 0) *nxtw = pre;
            __syncthreads();
            cur = __builtin_amdgcn_readfirstlane(*nxtw);
            __syncthreads();
        }
        }
    }
    if (!conv_first) run_conv();
}

__device__ __forceinline__ void phase6(const Ctx& C) {
    LAS float* PL = (LAS float*)(C.lds + RING_OFF);
    LAS float* SS = PL + 4 * 64 * 33;
    LAS int* hist = (LAS int*)(SS + 512);
    LAS int* gb = hist + 32;
    const int rg = C.wave & 1, kq = C.wave >> 1, r32 = C.lane & 31, hi = C.lane >> 5;
    const bf16* wh = C.Wr_t + (size_t)r32 * 2048 + 512 * kq + 16 * hi; const bf16* wl = wh + 32 * 2048;
    for (int blk = C.vcu; blk < T / 64; blk += C.G) {
        if (C.tid < 32) hist[C.tid] = 0;
        const int tok = blk * 64 + 32 * rg + r32;
        f32x16 acc = f32x16{}; float ss = 0.f;
        if (H1_BF16) {
            const bf16* hr = C.H1B + (size_t)tok * DM + 512 * kq + 16 * hi;
#pragma unroll 4
            for (int kb = 0; kb < 16; ++kb) {
#pragma unroll
                for (int s = 0; s < 2; ++s) {
                    const v4u bh = *(const GAS v4u*)(hr + 32 * kb + 8 * s);
                    ss += pg8::bf_lo(bh.x) * pg8::bf_lo(bh.x) + pg8::bf_hi(bh.x) * pg8::bf_hi(bh.x) + pg8::bf_lo(bh.y) * pg8::bf_lo(bh.y) + pg8::bf_hi(bh.y) * pg8::bf_hi(bh.y)
                        + pg8::bf_lo(bh.z) * pg8::bf_lo(bh.z) + pg8::bf_hi(bh.z) * pg8::bf_hi(bh.z) + pg8::bf_lo(bh.w) * pg8::bf_lo(bh.w) + pg8::bf_hi(bh.w) * pg8::bf_hi(bh.w);
                    const bf16x8 ah = *(const GAS bf16x8*)(wh + 32 * kb + 8 * s), al = *(const GAS bf16x8*)(wl + 32 * kb + 8 * s);
                    acc = __builtin_amdgcn_mfma_f32_32x32x16_bf16(ah, __builtin_bit_cast(bf16x8, bh), acc, 0, 0, 0);
                    acc = __builtin_amdgcn_mfma_f32_32x32x16_bf16(al, __builtin_bit_cast(bf16x8, bh), acc, 0, 0, 0);
                }
            }
        } else {
        const float* hr = C.out + (size_t)tok * DM + 512 * kq + 16 * hi;
#pragma unroll 2
        for (int kb = 0; kb < 16; ++kb) {
            float f[16];
#pragma unroll
            for (int q = 0; q < 4; ++q) { const f32x4 t = *(const GAS f32x4*)(hr + 32 * kb + 4 * q); f[4 * q] = t.x; f[4 * q + 1] = t.y; f[4 * q + 2] = t.z; f[4 * q + 3] = t.w; }
            unsigned hb[16], lb[16];
#pragma unroll
            for (int q = 0; q < 16; ++q) { ss += f[q] * f[q]; hb[q] = f2bf(f[q]); lb[q] = f2bf(f[q] - __uint_as_float(hb[q] << 16)); }
#pragma unroll
            for (int s = 0; s < 2; ++s) {
                const bf16x8 ah = *(const GAS bf16x8*)(wh + 32 * kb + 8 * s), al = *(const GAS bf16x8*)(wl + 32 * kb + 8 * s);
                v4u bh, bl;
                bh.x = hb[8 * s] | (hb[8 * s + 1] << 16); bh.y = hb[8 * s + 2] | (hb[8 * s + 3] << 16); bh.z = hb[8 * s + 4] | (hb[8 * s + 5] << 16); bh.w = hb[8 * s + 6] | (hb[8 * s + 7] << 16);
                bl.x = lb[8 * s] | (lb[8 * s + 1] << 16); bl.y = lb[8 * s + 2] | (lb[8 * s + 3] << 16); bl.z = lb[8 * s + 4] | (lb[8 * s + 5] << 16); bl.w = lb[8 * s + 6] | (lb[8 * s + 7] << 16);
                acc = __builtin_amdgcn_mfma_f32_32x32x16_bf16(ah, __builtin_bit_cast(bf16x8, bh), acc, 0, 0, 0);
                acc = __builtin_amdgcn_mfma_f32_32x32x16_bf16(ah, __builtin_bit_cast(bf16x8, bl), acc, 0, 0, 0);
                acc = __builtin_amdgcn_mfma_f32_32x32x16_bf16(al, __builtin_bit_cast(bf16x8, bh), acc, 0, 0, 0);
            }
        }
        }
        { LAS float* pr = PL + (size_t)(kq * 64 + 32 * rg + r32) * 33;
#pragma unroll
          for (int r = 0; r < 16; ++r) pr[att::crow(r, hi)] = acc[r];
          SS[(kq * 2 + hi) * 64 + 32 * rg + r32] = ss; }
        __syncthreads();
        int sel[4]; float gt[4]; float rstd = 0.f; int lr[4];
        if (C.tid < 64) {
            float lv[32]; float s2 = 0.f;
#pragma unroll
            for (int q = 0; q < 8; ++q) s2 += SS[q * 64 + C.tid];
            rstd = 1.0f / sqrtf(s2 * (1.f / DM) + NORM_EPS);
#pragma unroll
            for (int e = 0; e < 32; ++e) { const float a = (PL[(0 * 64 + C.tid) * 33 + e] + PL[(1 * 64 + C.tid) * 33 + e]) + (PL[(2 * 64 + C.tid) * 33 + e] + PL[(3 * 64 + C.tid) * 33 + e]); lv[e] = a * rstd + C.b_router[e]; }
            float val[4];
#pragma unroll
            for (int k = 0; k < 4; ++k) { float best = lv[0]; int bi = 0;
#pragma unroll
                for (int e = 1; e < 32; ++e) if (lv[e] > best) { best = lv[e]; bi = e; }
                sel[k] = bi; val[k] = best;
#pragma unroll
                for (int e = 0; e < 32; ++e) lv[e] = (e == bi) ? -INFINITY : lv[e]; }
            float den = 0.f;
#pragma unroll
            for (int k = 0; k < 4; ++k) { gt[k] = __expf(val[k] - val[0]); den += gt[k]; }
            const float inv = 1.0f / den;
#pragma unroll
            for (int k = 0; k < 4; ++k) { gt[k] *= inv; lr[k] = __hip_atomic_fetch_add((LAS int*)(hist + sel[k]), 1, __ATOMIC_RELAXED, __HIP_MEMORY_SCOPE_WORKGROUP); }
        }
        __syncthreads();
        if (C.tid < 32) gb[C.tid] = (int)__hip_atomic_fetch_add((unsigned*)(C.ctl + CW_CNT + C.tid), (unsigned)hist[C.tid], RLX_AGENT);
        __syncthreads();
        if (C.tid < 64) {
            const int t = blk * 64 + C.tid;
#pragma unroll
            for (int k = 0; k < 4; ++k) { const int sl = sel[k] * CAP + gb[sel[k]] + lr[k]; C.TOK[sl] = t; C.RS[sl] = rstd; C.TSLOT[t * 4 + k] = sl; C.TGATE[t * 4 + k] = gt[k]; }
        }
        __syncthreads();
    }
}
template <int NT>
__device__ __forceinline__ void moe_table(const Ctx& C, LAS int* tab) {
    __syncthreads();
    if (C.tid == 0) { int us = 0, rb = 0;
        for (int e = 0; e < 32; ++e) { const int n = (int)__hip_atomic_load((unsigned*)(C.ctl + CW_CNT + e), RLX_AGENT); const int mt = (n + 255) >> 8; tab[e] = us; tab[33 + e] = mt; tab[65 + e] = rb; tab[97 + e] = n; us += mt * NT; rb += mt * 256; }
        tab[32] = us; }
    __syncthreads();
}


__device__ __forceinline__ void phase9(const Ctx& C, const LAS int* tab) {
    const int gw = C.vcu * NWAVES + C.wave, NGW = C.G * NWAVES;
    for (int t = gw; t < T; t += NGW) {
        typedef int v4i_ __attribute__((ext_vector_type(4))); const v4i_ sl = *(const GAS v4i_*)(C.TSLOT + 4 * t); const f32x4 g = *(const GAS f32x4*)(C.TGATE + 4 * t);
        const int s[4] = {sl.x, sl.y, sl.z, sl.w}; const float gg[4] = {g.x, g.y, g.z, g.w};
        const bf16* yr[4];
#pragma unroll
        for (int k = 0; k < 4; ++k) { const int e = s[k] >> 14, rk = s[k] & (CAP - 1); yr[k] = C.Y + (size_t)(tab[65 + e] + rk) * DM + 8 * C.lane; }
        float* orow = C.out + (size_t)t * DM + 8 * C.lane;
#pragma unroll
        for (int j = 0; j < 4; ++j) {
            f32x4 a0, a1;
            if (H1_BF16) { const v4u hv = *(const GAS v4u*)(C.H1B + (size_t)t * DM + 8 * C.lane + 512 * j);
                a0.x = pg8::bf_lo(hv.x); a0.y = pg8::bf_hi(hv.x); a0.z = pg8::bf_lo(hv.y); a0.w = pg8::bf_hi(hv.y); a1.x = pg8::bf_lo(hv.z); a1.y = pg8::bf_hi(hv.z); a1.z = pg8::bf_lo(hv.w); a1.w = pg8::bf_hi(hv.w); }
            else { a0 = *(const GAS f32x4*)(orow + 512 * j); a1 = *(const GAS f32x4*)(orow + 512 * j + 4); }
#pragma unroll
            for (int k = 0; k < 4; ++k) { const v4u y = *(const GAS v4u*)(yr[k] + 512 * j);
                a0.x += gg[k] * pg8::bf_lo(y.x); a0.y += gg[k] * pg8::bf_hi(y.x); a0.z += gg[k] * pg8::bf_lo(y.y); a0.w += gg[k] * pg8::bf_hi(y.y);
                a1.x += gg[k] * pg8::bf_lo(y.z); a1.y += gg[k] * pg8::bf_hi(y.z); a1.z += gg[k] * pg8::bf_lo(y.w); a1.w += gg[k] * pg8::bf_hi(y.w); }
            *(GAS f32x4*)(orow + 512 * j) = a0; *(GAS f32x4*)(orow + 512 * j + 4) = a1;
        }
    }
}

#ifndef P4_PREFETCH_X
#define P4_PREFETCH_X 0
#endif
#ifndef MOE_ALIGN
#define MOE_ALIGN true
#endif
struct Args { const void* in[26]; float* out; unsigned char* ws; int ph_lo, ph_hi, probe, pad; };
__global__ void __launch_bounds__(NWAVES * 64, 2) mk_fwd(Args args) {
    extern __shared__ __attribute__((aligned(16))) unsigned char lds_raw[];
    Ctx C;
    C.lds = (LAS unsigned char*)lds_raw;
    C.MISC = (volatile LAS unsigned*)(C.lds + MISC_OFF);
    C.tid = threadIdx.x; C.lane = C.tid & 63; C.wave = __builtin_amdgcn_readfirstlane(C.tid >> 6);
    C.probe = args.probe; C.G = gridDim.x; { const int bx = blockIdx.x; C.vcu = (C.G % 8 == 0) ? (bx % 8) * (C.G / 8) + bx / 8 : bx; }
    unsigned char* ws = args.ws;
    C.ctl = (gu32*)(ws + WS_CTL);
    C.x = (const float*)args.in[0]; C.mem = (const float*)args.in[1]; C.pos = (const int*)args.in[2]; C.norm_mix = (const float*)args.in[3]; C.w_in = (const float*)args.in[4];
    C.b_forget = (const float*)args.in[5]; C.fox_q_norm = (const float*)args.in[6]; C.fox_k_norm = (const float*)args.in[7]; C.swa_q_norm = (const float*)args.in[8]; C.swa_k_norm = (const float*)args.in[9];
    C.swa_sinks = (const float*)args.in[10]; C.xmem_q_norm = (const float*)args.in[11]; C.xmem_k_norm = (const float*)args.in[12]; C.norm_mem = (const float*)args.in[13]; C.w_mem_kv = (const float*)args.in[14];
    C.w_up_fox = (const float*)args.in[15]; C.w_up_swa = (const float*)args.in[16]; C.w_up_xmem = (const float*)args.in[17]; C.w_out = (const float*)args.in[18]; C.norm_ffn = (const float*)args.in[19];
    C.w_router = (const float*)args.in[20]; C.b_router = (const float*)args.in[21]; C.w_gate_up = (const float*)args.in[22]; C.b_gate_up = (const float*)args.in[23]; C.w_down = (const float*)args.in[24]; C.b_down = (const float*)args.in[25];
    C.out = args.out;
#define WS_PTRS() do { unsigned char* w_ = args.ws; asm volatile("" : "+s"(w_)); \
    C.ctl = (gu32*)(w_ + WS_CTL); C.Win_t = (bf16*)(w_ + WS_WIN); C.Wmkv_t = (bf16*)(w_ + WS_WMKV); C.Wup_t = (bf16*)(w_ + WS_WUP); C.Wout_t = (bf16*)(w_ + WS_WOUT); C.Wr_t = (bf16*)(w_ + WS_WRT); C.Wgu_t = (bf16*)(w_ + WS_WGU); C.Wd_t = (bf16*)(w_ + WS_WD); \
    C.XN = (bf16*)(w_ + WS_XN); C.MN = (bf16*)(w_ + WS_MN); C.QKV = (bf16*)(w_ + WS_QKV); C.H1B = (bf16*)(w_ + WS_QKV);        C.G_ = (bf16*)(w_ + WS_G); C.MKV = (bf16*)(w_ + WS_MKV); C.OALL = (bf16*)(w_ + WS_OALL); C.MERGED = (bf16*)(w_ + WS_MERGED); \
    C.HB = (bf16*)(w_ + WS_HB); C.ACT = (bf16*)(w_ + WS_ACT); C.LOGF = (float*)(w_ + WS_LOGF); C.CNEG = (float*)(w_ + WS_CNEG); C.ROPE = (float*)(w_ + WS_ROPE); C.GATEW = (float*)(w_ + WS_GATE); C.RS = (float*)(w_ + WS_RS); \
    C.TOK = (int*)(w_ + WS_TOK); C.TSLOT = (int*)(w_ + WS_TSLOT); C.TGATE = (float*)(w_ + WS_TGATE); C.Y = (bf16*)(w_ + WS_Y); C.XN8 = w_ + WS_XN8; C.Win8 = w_ + WS_WIN8; } while (0)
    WS_PTRS();
    for (int u = C.tid; u < (LDS_BYTES - LDSCTL_OFF) / 4; u += NWAVES * 64) ((LAS unsigned*)(C.lds + LDSCTL_OFF))[u] = 0u;
    __syncthreads();
    XcdBarrier bar; bar.bar = (unsigned*)(C.ctl + CW_BAR); bar.x = 0; bar.st = nullptr;
    if (N_LAUNCHES == 1) bar = xcd_barrier_post((unsigned*)(C.ctl + CW_BAR), C.MISC + 8);
    const int lo = args.ph_lo, hi = args.ph_hi;
#ifndef MK_PHASE_MASK
#define MK_PHASE_MASK 0x3FF
#endif
#define IN(k) ((((MK_PHASE_MASK) >> (k)) & 1) && lo <= (k) && (k) < hi)
#define SEAM(k) do { if (IN(k) && IN((k) + 1)) xcd_barrier(bar); } while (0)
    LAS int* tab = (LAS int*)(C.lds + MOE_OFF);

    if (IN(0)) { WS_PTRS(); phase0(C); }
    SEAM(0);
    if (IN(1)) { WS_PTRS();
        logf_cumsum(C);
        P1Order S; S.d.init(C.XN, C.Win_t, T, PROBE_INW * 64, C.G, (int)blockIdx.x); S.A1 = (const char*)C.MN; S.B1 = (const char*)C.Wmkv_t;
        EpiInProj E{C.QKV, C.G_, C.MKV, args.probe == 1, C.fox_k_norm, C.swa_k_norm, C.ROPE};
        if (args.probe != 3) pg8::gemm_phase<EpiInProj, P1Order>(C.lds + RING_OFF, S, E);
        if (!GATES_IN_P3) {
            EpiGates E8{C.G_};
            const int kx = (int)blockIdx.x >> 3; const bool split = CONV_IN_P1B > 0 && CONV_IN_P3 && C.G == 256;
            if (split && (kx & 3) == 3) {
                volatile LAS int* nxtw = (volatile LAS int*)(C.MISC + 12);
                p0_fill_lnorm(C, (LAS float*)(C.lds + RING_OFF + 65536));
#pragma unroll 1
                for (int q = 0; q < CONV_IN_P1B; ++q) {
                    const int pre = att_fetch(C, 3);
                    if (C.tid == 0) *nxtw = pre;
                    __syncthreads();
                    const int cur = __builtin_amdgcn_readfirstlane(*nxtw);
                    __syncthreads();
                    if (cur < CONV_NCHUNK) conv_chunk(C, cur);
                }
            } else if (split) {
                P1bGrpOrder S8; S8.d.init(C.XN8, C.Win8, T, 6144, 192, (kx - ((kx + 1) >> 2)) * 8 + ((int)blockIdx.x & 7));
                pg8::gemm_phase<EpiGates, P1bGrpOrder>(C.lds + RING_OFF, S8, E8);
            } else {
                P1bOrder S8; S8.d.init(C.XN8, C.Win8, T, 6144, C.G, (int)blockIdx.x);
                pg8::gemm_phase<EpiGates, P1bOrder>(C.lds + RING_OFF, S8, E8);
            }
        }
    }
    SEAM(1);
    if (IN(3)) { WS_PTRS(); phase3(C, args.probe >= 4 ? args.probe : 0); }
    SEAM(3);
    if (IN(4)) { WS_PTRS();
        DenseOrder S; S.init(C.OALL, C.Wup_t, T, DM, C.G, (int)blockIdx.x);
        EpiMerge E{C.G_, C.MERGED, P4_PREFETCH_X ? C.x : nullptr, (args.probe >= 21 && args.probe <= 23) ? args.probe - 20 : 0};
        pg8::gemm_phase<EpiMerge, DenseOrder>(C.lds + RING_OFF, S, E);
    }
    SEAM(4);
    if (IN(5)) { WS_PTRS();
#ifdef P5_STAGGER
        if (((int)blockIdx.x >> 3) & 1) for (int d = 0; d < P5_STAGGER; ++d) __builtin_amdgcn_s_sleep(127);
#endif
        DenseOrder S; S.init(C.MERGED, C.Wout_t, T, DM, C.G, (int)blockIdx.x);
        EpiOut E{C.x, C.out, (unsigned char*)C.HB, args.probe == 1 ? 1 : (args.probe >= 11 && args.probe <= 13 ? args.probe : 0), C.H1B};
        pg8::gemm_phase<EpiOut, DenseOrder, false>(C.lds + RING_OFF, S, E);
    }
    SEAM(5);
    if (IN(6)) { WS_PTRS(); phase6(C); }
    SEAM(6);
    if (IN(7)) { WS_PTRS();
        moe_table<16>(C, tab);
        const int kx = (int)blockIdx.x >> 3; const bool conv_wg = WD_IN_P7 && CONV_IN_P3 && C.G == 256 && (kx % 5 == 4);
        if (conv_wg) {
            volatile LAS int* nxtw = (volatile LAS int*)(C.MISC + 12);
            int pre = att_fetch(C, 4);
            if (C.tid == 0) *nxtw = pre;
            __syncthreads();
            int cur = __builtin_amdgcn_readfirstlane(*nxtw);
            __syncthreads();
            while (cur < CONV_NCHUNK_WD) {
                pre = att_fetch(C, 4);
                conv_chunk_wd(C, cur);
                if (C.tid == 0) *nxtw = pre;
                __syncthreads();
                cur = __builtin_amdgcn_readfirstlane(*nxtw);
                __syncthreads();
            }
        } else {
            const bool split = WD_IN_P7 && CONV_IN_P3 && C.G == 256;
            const int gG = split ? 208 : C.G, gc = split ? ((int)blockIdx.x & 7) * 26 + (kx - (kx + 1) / 5) : C.vcu;
            MoeOrder<true, 16, 2048> S{(const char*)C.HB, (const char*)C.Wgu_t, C.TOK, (const int*)(C.ctl + CW_CNT), tab, gG, gc};
            EpiGateUp E{C.RS, C.b_gate_up, (unsigned char*)C.ACT};
            pg8::gemm_phase<EpiGateUp, MoeOrder<true, 16, 2048>, MOE_ALIGN>(C.lds + RING_OFF, S, E);
        }
    }
    SEAM(7);
    if (IN(8)) { WS_PTRS();
        moe_table<8>(C, tab);
#ifdef MOE_STAGGER
        for (int d = 0; d < (int)(blockIdx.x & 7); ++d) __builtin_amdgcn_s_sleep(MOE_STAGGER);
#endif
        MoeOrder<false, 8, 2048> S{(const char*)C.ACT, (const char*)C.Wd_t, C.TOK, (const int*)(C.ctl + CW_CNT), tab, C.G, C.vcu};
        EpiDown E{C.b_down, C.Y, args.probe == 1};
        pg8::gemm_phase<EpiDown, MoeOrder<false, 8, 2048>, MOE_ALIGN>(C.lds + RING_OFF, S, E);
    }
    SEAM(8);
    if (IN(9)) { WS_PTRS(); moe_table<8>(C, tab); phase9(C, tab);
#ifdef PROBE_DET
        if (blockIdx.x == 0 && C.tid == 0 && __hip_atomic_load((unsigned*)(C.ctl + 2048), RLX_AGENT) != 0u) C.out[12345] = __builtin_nanf("");
#endif
    }
#undef IN
#undef SEAM
}

extern "C" void kernel_launch(void* const* d_in, const int* in_sizes, int n_in, void* d_out, int out_size, void* d_ws, size_t ws_size, hipStream_t stream) {
    static int grid = 0;
    if (grid == 0) {
        if (n_in != 26 || out_size != T * DM || ws_size < WS_END) { fprintf(stderr, "kernel_launch: unexpected problem (n_in %d, out %d, ws %zu < %zu); nothing launched\n", n_in, out_size, ws_size, (size_t)WS_END); grid = -1; return; }
        int dev = 0, cus = 0, per_cu = 0;
        if (hipGetDevice(&dev) != hipSuccess || hipDeviceGetAttribute(&cus, hipDeviceAttributeMultiprocessorCount, dev) != hipSuccess) { grid = -1; return; }
        if (hipFuncSetAttribute((const void*)mk_fwd, hipFuncAttributeMaxDynamicSharedMemorySize, LDS_BYTES) != hipSuccess) { fprintf(stderr, "kernel_launch: hipFuncSetAttribute failed\n"); grid = -1; return; }
        if (hipOccupancyMaxActiveBlocksPerMultiprocessor(&per_cu, (const void*)mk_fwd, NWAVES * 64, LDS_BYTES) != hipSuccess || per_cu < 1) { fprintf(stderr, "kernel_launch: occupancy query says %d\n", per_cu); }
        (void)hipGetLastError();
        grid = cus;
    }
    if (grid < 0) return;
    if (hipMemsetAsync((char*)d_ws + WS_CTL, 0, CTL_ZERO_BYTES, stream) != hipSuccess) return;
#ifdef PROBE_MEMSET8
    hipMemsetAsync((char*)d_ws + WS_XN8, 0, 44 * MiB, stream);
#endif
    Args a{};
    for (int i = 0; i < 26; ++i) a.in[i] = d_in[i];
    a.out = (float*)d_out; a.ws = (unsigned char*)d_ws;
    if (N_LAUNCHES == 1) { a.ph_lo = 0; a.ph_hi = PER_PHASE; hipLaunchKernelGGL(mk_fwd, dim3(grid), dim3(NWAVES * 64), LDS_BYTES, stream, a); }
    else for (int oi = 0; oi < PER_PHASE; ++oi) { static const int order[PER_PHASE] = {0, 1, 2, 3, 4, 5, 6, 7, 8, 9}; const int li = order[oi]; a.ph_lo = li; a.ph_hi = li + 1;
#ifdef PROBE_SPLIT_P1
        if (li == 1) { a.probe = 2; hipLaunchKernelGGL(mk_fwd, dim3(grid), dim3(NWAVES * 64), LDS_BYTES, stream, a); a.probe = 3; hipLaunchKernelGGL(mk_fwd, dim3(grid), dim3(NWAVES * 64), LDS_BYTES, stream, a); a.probe = 0; continue; }
#endif
#if defined(PROBE_DUP) && defined(PROBE_FIRST)
        if (li == PROBE_DUP) { a.probe = PROBE_FLAG; hipLaunchKernelGGL(mk_fwd, dim3(grid), dim3(NWAVES * 64), LDS_BYTES, stream, a); a.probe = 0; }
#endif
        hipLaunchKernelGGL(mk_fwd, dim3(grid), dim3(NWAVES * 64), LDS_BYTES, stream, a);
#if defined(PROBE_DUP) && !defined(PROBE_FIRST)
        if (li == PROBE_DUP) { if (PROBE_DUP == 3 || PROBE_DUP == 6) hipMemsetAsync((char*)d_ws + WS_CTL, 0, 4096, stream);
#ifdef PROBE_FLAG
            a.probe = PROBE_FLAG;
#endif
            hipLaunchKernelGGL(mk_fwd, dim3(grid), dim3(NWAVES * 64), LDS_BYTES, stream, a); a.probe = 0; }
#endif
    }
    const hipError_t le = hipPeekAtLastError();
    if (le != hipSuccess) fprintf(stderr, "kernel_launch: launch failed: %s\n", hipGetErrorName(le));
}
```

```cpp
#include <hip/hip_runtime.h>
#include <cstdio>
#include <cstdint>

#define LAS __attribute__((address_space(3)))
#define GAS __attribute__((address_space(1)))

namespace pg8 {
typedef unsigned short bf16_t;
typedef short bf16x8 __attribute__((ext_vector_type(8)));
typedef float f32x4 __attribute__((ext_vector_type(4)));
typedef float f32x2 __attribute__((ext_vector_type(2)));
typedef unsigned u32x4 __attribute__((ext_vector_type(4)));
typedef unsigned u32x2 __attribute__((ext_vector_type(2)));
constexpr int BM = 256, BK = 64, HALF = 128, HTB = HALF * BK * 2, STAGE_BYTES = 8 * HTB, NXCD = 8, WGM = 8;
constexpr int KD = 2048;
typedef int v8i __attribute__((ext_vector_type(8))); typedef int v4i __attribute__((ext_vector_type(4)));
__device__ __forceinline__ v8i cat8(bf16x8 lo, bf16x8 hi) { const v4i a = __builtin_bit_cast(v4i, lo), b = __builtin_bit_cast(v4i, hi); return __builtin_shufflevector(a, b, 0, 1, 2, 3, 4, 5, 6, 7); }
__device__ __forceinline__ bf16x8 lo8(v8i v) { return __builtin_bit_cast(bf16x8, (v4i)__builtin_shufflevector(v, v, 0, 1, 2, 3)); }
__device__ __forceinline__ bf16x8 hi8(v8i v) { return __builtin_bit_cast(bf16x8, (v4i)__builtin_shufflevector(v, v, 4, 5, 6, 7)); }

__host__ __device__ __forceinline__ int lds_byte(int r, int c) { const int st = (r >> 4) * 2 + (c >> 5), rr = r & 15, cc = c & 31, ob = rr * 64 + cc * 2; return st * 1024 + (ob ^ (((ob >> 9) & 1) << 5)); }
__host__ __device__ __forceinline__ void stage_rc(int b, int& R, int& C) { const int st = b / 1024, sb = b % 1024, swz = sb ^ (((sb >> 9) & 1) << 5); R = (st >> 1) * 16 + swz / 64; C = (st & 1) * 32 + (swz % 64) / 2; }
__host__ __device__ __forceinline__ int perm32(int rho) { const int n = rho >> 4, i = rho & 15; return 8 * (i >> 2) + 4 * n + (i & 3); }

__device__ __forceinline__ void glds_s(const char* sbase, unsigned voff, unsigned lds_dst) { unsigned keep;
    asm volatile("s_mov_b32 %0, m0\n\ts_mov_b32 m0, %3\n\ts_nop 0\n\tglobal_load_lds_dwordx4 %1, %2\n\ts_mov_b32 m0, %0" : "=&s"(keep) : "v"(voff), "s"(sbase), "s"(lds_dst) : "memory"); }

#define PG8_PIN4(a, b, c, d, txt) asm volatile(txt : "+v"(a), "+v"(b), "+v"(c), "+v"(d))
#define PG8_PIN_ACC(txt) do { _Pragma("unroll") for (int _a = 0; _a < 2; ++_a) _Pragma("unroll") for (int _b = 0; _b < 2; ++_b) { \
        PG8_PIN4(acc[_a][_b][0][0], acc[_a][_b][0][1], acc[_a][_b][1][0], acc[_a][_b][1][1], ""); PG8_PIN4(acc[_a][_b][2][0], acc[_a][_b][2][1], acc[_a][_b][3][0], acc[_a][_b][3][1], ""); } \
        PG8_PIN4(acc[0][0][0][0], acc[0][1][0][0], acc[1][0][0][0], acc[1][1][0][0], txt); \
        _Pragma("unroll") for (int _a = 0; _a < 2; ++_a) _Pragma("unroll") for (int _b = 0; _b < 2; ++_b) { \
        PG8_PIN4(acc[_a][_b][0][0], acc[_a][_b][0][1], acc[_a][_b][1][0], acc[_a][_b][1][1], ""); PG8_PIN4(acc[_a][_b][2][0], acc[_a][_b][2][1], acc[_a][_b][3][0], acc[_a][_b][3][1], ""); } } while (0)

struct Unit { int pm, pn, e, kind; };

typedef float f32x2_cv __attribute__((ext_vector_type(2))); typedef __bf16 bf16x2_cv __attribute__((ext_vector_type(2)));
__device__ __forceinline__ unsigned cvt_pk_bf16(float lo, float hi) { const f32x2_cv v = {lo, hi}; const bf16x2_cv b = __builtin_convertvector(v, bf16x2_cv); return __builtin_bit_cast(unsigned, b); }
__device__ __forceinline__ float bf_lo(unsigned w) { return __uint_as_float(w << 16); }
__device__ __forceinline__ float bf_hi(unsigned w) { return __uint_as_float(w & 0xffff0000u); }

template <class Epi, class Sched, bool ALIGN_EPI = true, bool SP2 = true>
__device__ __forceinline__ void gemm_phase(LAS unsigned char* lds, const Sched& S, const Epi& E) {
    const int tid = threadIdx.x, wid = __builtin_amdgcn_readfirstlane(tid >> 6), lane = tid & 63, wr = wid >> 2, wc = wid & 3, fr = lane & 15, fq = lane >> 4;
    constexpr bool FP8 = Epi::FP8; constexpr int RB = FP8 ? 2048 : 4096, nt = RB / 128;
    unsigned voffB[2]; int RA[2], CA[2];
#pragma unroll
    for (int i = 0; i < 2; ++i) { int R, C; stage_rc(tid * 16 + i * 8192, R, C); const int Rb = Epi::PERM ? ((R & ~31) + perm32(R & 31)) : R;
        voffB[i] = (unsigned)(Rb * (Epi::BTILED ? 128 : RB) + C * 2); RA[i] = R; CA[i] = C; }
    constexpr size_t kstep = (size_t)(BK * 2);
    constexpr size_t hstep = (size_t)HALF * RB;
    constexpr size_t bkstep = Epi::BTILED ? (size_t)32768 : kstep, bhstep = Epi::BTILED ? (size_t)16384 : hstep;
    const unsigned ldsbase = (unsigned)__builtin_amdgcn_readfirstlane((unsigned)(uintptr_t)lds + (unsigned)wid * 1024u);
    const int aoff = lds_byte(wr * 64 + fr, fq * 8), boff = lds_byte(wc * 32 + fr, fq * 8);
#define PG8_SA(b, h) (((b) * 2 + (h)) * HTB)
#define PG8_SB(b, h) ((4 + (b) * 2 + (h)) * HTB)
#define PG8_STAGE(bufoff, gbase, voff) do { _Pragma("unroll") for (int _i = 0; _i < 2; ++_i) \
        glds_s((const char*)(gbase), (voff)[_i], ldsbase + (unsigned)((bufoff) + _i * 8192)); } while (0)
#define PG8_LDA(dst, b, h) do { _Pragma("unroll") for (int m = 0; m < 4; ++m) dst[m] = cat8(*(const LAS bf16x8*)(lds + PG8_SA(b, h) + aoff + m * 2048), *(const LAS bf16x8*)(lds + PG8_SA(b, h) + aoff + m * 2048 + 1024)); } while (0)
#define PG8_LDB(dst, b, h) do { _Pragma("unroll") for (int n = 0; n < 2; ++n) dst[n] = cat8(*(const LAS bf16x8*)(lds + PG8_SB(b, h) + boff + n * 2048), *(const LAS bf16x8*)(lds + PG8_SB(b, h) + boff + n * 2048 + 1024)); } while (0)
#define PG8_MMA(ai, bj, At, Bt) do { __builtin_amdgcn_s_setprio(1); _Pragma("unroll") for (int m = 0; m < 4; ++m) _Pragma("unroll") for (int n = 0; n < 2; ++n) { \
        if constexpr (FP8 && Epi::ASM_MFMA) asm volatile("v_mfma_scale_f32_16x16x128_f8f6f4 %0, %1, %2, %0, %3, %4 op_sel_hi:[0,0,0]" : "+v"(acc[ai][bj][m][n]) : "v"(Bt[n]), "v"(At[m]), "v"(scl_b), "v"(scl_a)); \
        else if constexpr (FP8) acc[ai][bj][m][n] = __builtin_amdgcn_mfma_scale_f32_16x16x128_f8f6f4(Bt[n], At[m], acc[ai][bj][m][n], 0, 0, 0, Epi::SCALE_B, 0, Epi::SCALE_A); \
        else { acc[ai][bj][m][n] = __builtin_amdgcn_mfma_f32_16x16x32_bf16(lo8(Bt[n]), lo8(At[m]), acc[ai][bj][m][n], 0, 0, 0); \
               acc[ai][bj][m][n] = __builtin_amdgcn_mfma_f32_16x16x32_bf16(hi8(Bt[n]), hi8(At[m]), acc[ai][bj][m][n], 0, 0, 0); } } \
        __builtin_amdgcn_s_setprio(0); } while (0)
#ifdef PROBE_DRAIN8
#define PG8_WAIT_V(n) do { if constexpr (FP8 && !Epi::ASM_MFMA) asm volatile("s_waitcnt vmcnt(0)" ::: "memory"); else asm volatile("s_waitcnt vmcnt(" #n ")" ::: "memory"); } while (0)
#else
#define PG8_WAIT_V(n) asm volatile("s_waitcnt vmcnt(" #n ")" ::: "memory")
#endif
#define PG8_WAIT_L(n) asm volatile("s_waitcnt lgkmcnt(" #n ")" ::: "memory")
#define PG8_BAR __builtin_amdgcn_s_barrier()
#define PG8_SCHED __builtin_amdgcn_sched_barrier(0)
    Unit cur, nxt; int ui = 0;
    int scl_a = Epi::SCALE_A, scl_b = Epi::SCALE_B; asm volatile("" : "+v"(scl_a), "+v"(scl_b));
    if (!S.next(0, cur)) return;
    f32x4 acc[2][2][4][2];
#pragma unroll
    for (int a = 0; a < 2; ++a)
#pragma unroll
        for (int b = 0; b < 2; ++b)
#pragma unroll
            for (int m = 0; m < 4; ++m)
#pragma unroll
                for (int n = 0; n < 2; ++n) acc[a][b][m][n] = (f32x4){0.f, 0.f, 0.f, 0.f};
    if constexpr (Epi::FP8) PG8_PIN_ACC("s_nop 7");
    v8i At[4], B0[2], B1[2];
    const char* cA = S.a_base(cur); const char* cB = S.b_base(cur);
    unsigned vo[2][2], nvo[2][2];
    S.a_offs(cur, RA, CA, vo);
    bool has_next = S.next(1, nxt);
    if (has_next) S.a_offs(nxt, RA, CA, nvo); else { nvo[0][0] = vo[0][0]; nvo[0][1] = vo[0][1]; nvo[1][0] = vo[1][0]; nvo[1][1] = vo[1][1]; }
    if constexpr (SP2) {
        PG8_STAGE(PG8_SB(0, 0), cB, voffB); PG8_STAGE(PG8_SB(0, 1), cB + bhstep, voffB); PG8_STAGE(PG8_SA(0, 0), cA, vo[0]); PG8_STAGE(PG8_SA(0, 1), cA, vo[1]);
        if (wr == 1) PG8_BAR;
        PG8_WAIT_V(2); PG8_BAR;
        PG8_STAGE(PG8_SB(1, 0), cB + bkstep, voffB); PG8_STAGE(PG8_SA(1, 0), cA + kstep, vo[0]); PG8_STAGE(PG8_SB(1, 1), cB + bhstep + bkstep, voffB);
        PG8_WAIT_V(6); PG8_BAR;
    } else {
        PG8_STAGE(PG8_SB(0, 0), cB, voffB); PG8_STAGE(PG8_SA(0, 0), cA, vo[0]); PG8_STAGE(PG8_SB(0, 1), cB + bhstep, voffB); PG8_STAGE(PG8_SA(0, 1), cA, vo[1]);
        if (wr == 1) PG8_BAR;
        PG8_WAIT_V(4); PG8_BAR;
        PG8_STAGE(PG8_SB(1, 0), cB + bkstep, voffB); PG8_STAGE(PG8_SA(1, 0), cA + kstep, vo[0]); PG8_STAGE(PG8_SB(1, 1), cB + bhstep + bkstep, voffB);
        PG8_WAIT_V(6); PG8_BAR;
    }
    for (;;) {
        const char* nA = has_next ? S.a_base(nxt) : cA; const char* nB = has_next ? S.b_base(nxt) : cB;
        for (int t = 0; t < nt; t += 2) {
            const bool last = (t == nt - 2);
            const char* a1 = cA + (size_t)(t + 1) * kstep;
            const char* a2 = last ? nA : cA + (size_t)(t + 2) * kstep; const char* b2 = last ? nB : cB + (size_t)(t + 2) * bkstep;
            const char* a3 = a2 + kstep; const char* b3 = b2 + bkstep;
            unsigned v2[2][2];
            v2[0][0] = last ? nvo[0][0] : vo[0][0]; v2[0][1] = last ? nvo[0][1] : vo[0][1]; v2[1][0] = last ? nvo[1][0] : vo[1][0]; v2[1][1] = last ? nvo[1][1] : vo[1][1];
            if constexpr (SP2) {
            PG8_LDB(B0, 0, 0); PG8_LDB(B1, 0, 1); PG8_SCHED; PG8_LDA(At, 0, 0); PG8_STAGE(PG8_SA(1, 1), a1, vo[1]);
            PG8_WAIT_V(8); PG8_WAIT_L(0); PG8_BAR; PG8_MMA(0, 0, At, B0); PG8_MMA(0, 1, At, B1); PG8_BAR; PG8_SCHED;
            PG8_LDA(At, 0, 1); PG8_STAGE(PG8_SB(0, 0), b2, voffB); PG8_STAGE(PG8_SB(0, 1), b2 + bhstep, voffB); PG8_STAGE(PG8_SA(0, 0), a2, v2[0]);
            PG8_WAIT_V(8); PG8_WAIT_L(0); PG8_BAR; PG8_MMA(1, 0, At, B0); PG8_MMA(1, 1, At, B1); PG8_BAR; PG8_SCHED;
            PG8_LDB(B0, 1, 0); PG8_LDB(B1, 1, 1); PG8_SCHED; PG8_LDA(At, 1, 0); PG8_STAGE(PG8_SA(0, 1), a2, v2[1]);
            PG8_WAIT_V(8); PG8_WAIT_L(0); PG8_BAR; PG8_MMA(0, 0, At, B0); PG8_MMA(0, 1, At, B1); PG8_BAR; PG8_SCHED;
            PG8_LDA(At, 1, 1); PG8_STAGE(PG8_SB(1, 0), b3, voffB); PG8_STAGE(PG8_SB(1, 1), b3 + bhstep, voffB); PG8_STAGE(PG8_SA(1, 0), a3, v2[0]);
            PG8_WAIT_V(8); PG8_WAIT_L(0); PG8_BAR; PG8_MMA(1, 0, At, B0); PG8_MMA(1, 1, At, B1); PG8_BAR; PG8_SCHED;
            } else {
            PG8_LDB(B0, 0, 0); PG8_SCHED; PG8_LDA(At, 0, 0); PG8_STAGE(PG8_SA(1, 1), a1, vo[1]);
            PG8_WAIT_L(8); PG8_BAR; PG8_WAIT_L(0); PG8_MMA(0, 0, At, B0); PG8_BAR; PG8_SCHED;
            PG8_LDB(B1, 0, 1); PG8_STAGE(PG8_SB(0, 0), b2, voffB);
            PG8_BAR; PG8_WAIT_L(0); PG8_MMA(0, 1, At, B1); PG8_BAR;
            PG8_LDA(At, 0, 1); PG8_STAGE(PG8_SA(0, 0), a2, v2[0]);
            PG8_BAR; PG8_WAIT_L(0); PG8_MMA(1, 0, At, B0); PG8_BAR; PG8_SCHED;
            PG8_STAGE(PG8_SB(0, 1), b2 + bhstep, voffB);
            PG8_WAIT_V(6); PG8_BAR; PG8_MMA(1, 1, At, B1); PG8_BAR;
            PG8_LDB(B0, 1, 0); PG8_SCHED; PG8_LDA(At, 1, 0); PG8_STAGE(PG8_SA(0, 1), a2, v2[1]);
            PG8_WAIT_L(8); PG8_BAR; PG8_WAIT_L(0); PG8_MMA(0, 0, At, B0); PG8_BAR; PG8_SCHED;
            PG8_LDB(B1, 1, 1); PG8_STAGE(PG8_SB(1, 0), b3, voffB);
            PG8_BAR; PG8_WAIT_L(0); PG8_MMA(0, 1, At, B1); PG8_BAR;
            PG8_LDA(At, 1, 1); PG8_STAGE(PG8_SA(1, 0), a3, v2[0]);
            PG8_BAR; PG8_WAIT_L(0); PG8_MMA(1, 0, At, B0); PG8_BAR; PG8_SCHED;
            PG8_STAGE(PG8_SB(1, 1), b3 + bhstep, voffB);
            PG8_WAIT_V(6); PG8_BAR; PG8_MMA(1, 1, At, B1); PG8_BAR;
            }
            if constexpr (Epi::MID) { if (t == 10 || t == 22) E.mid(acc, cur, t == 22 ? 1 : 0, wr, wc, fr, fq); }
        }
        Unit nn; const bool has_nn = has_next && S.next(ui + 2, nn); unsigned nnvo[2][2];
        if (has_nn) S.a_offs(nn, RA, CA, nnvo); else { nnvo[0][0] = nvo[0][0]; nnvo[0][1] = nvo[0][1]; nnvo[1][0] = nvo[1][0]; nnvo[1][1] = nvo[1][1]; }
        if constexpr (ALIGN_EPI) { if (wr == 0) PG8_BAR; }
        if constexpr (FP8) PG8_PIN_ACC("s_nop 15\n\ts_nop 7");
        E(acc, cur, wr, wc, fr, fq);
        if (!has_next) break;
#pragma unroll
        for (int a = 0; a < 2; ++a)
#pragma unroll
            for (int b = 0; b < 2; ++b)
#pragma unroll
                for (int m = 0; m < 4; ++m)
#pragma unroll
                    for (int n = 0; n < 2; ++n) acc[a][b][m][n] = (f32x4){0.f, 0.f, 0.f, 0.f};
        if constexpr (FP8) PG8_PIN_ACC("s_nop 7");
        cur = nxt; cA = nA; cB = nB; ++ui; nxt = nn; has_next = has_nn;
        vo[0][0] = nvo[0][0]; vo[0][1] = nvo[0][1]; vo[1][0] = nvo[1][0]; vo[1][1] = nvo[1][1];
        nvo[0][0] = nnvo[0][0]; nvo[0][1] = nnvo[0][1]; nvo[1][0] = nnvo[1][0]; nvo[1][1] = nnvo[1][1];
        if constexpr (ALIGN_EPI) { if (wr == 1) PG8_BAR; }
    }
    PG8_WAIT_V(0);
    if constexpr (!ALIGN_EPI) { if (wr == 0) PG8_BAR; }
    PG8_BAR;
#undef PG8_SA
#undef PG8_SB
#undef PG8_STAGE
#undef PG8_LDA
#undef PG8_LDB
#undef PG8_MMA
#undef PG8_WAIT_V
#undef PG8_WAIT_L
#undef PG8_BAR
#undef PG8_SCHED
}
}

constexpr int NWAVES = 8;
constexpr int BATCH = 2, SEQ = 8192, DM = 2048, T = BATCH * SEQ;
constexpr int NMEM = 256, MROWS = BATCH * NMEM;
constexpr int INW = 10252;
constexpr int NEXP = 32, TOPK = 4, CAP = T;
constexpr int QKVW = 4096;
constexpr int C_FQ = 0, C_FK = 768, C_FV = 1536, C_SQ = 2304, C_SK = 3072, C_SV = 3328, C_MQ = 3584;
constexpr int GW = 6144;
constexpr float NORM_EPS = 1e-6f;
constexpr float LOG2E = 1.4426950408889634f;
constexpr float SWIGLU_LIMIT = 7.0f, SWIGLU_ALPHA = 1.702f;
constexpr int PER_PHASE = 10;
#ifndef MK_LATE_WD
#define MK_LATE_WD 0
#endif
constexpr bool LATE_WD = false;
#ifndef MK_CONV_IN_P3
#define MK_CONV_IN_P3 1
#endif
constexpr bool CONV_IN_P3 = MK_CONV_IN_P3;
#ifndef H1_BF16
#define H1_BF16 1
#endif
#ifndef CONV_COOP
#define CONV_COOP 1
#endif
#ifndef CONV_IN_P1B
#define CONV_IN_P1B 0
#endif
#ifndef MK_GATE_WGS
#define MK_GATE_WGS 0
#endif
constexpr int GATE_WGS = MK_GATE_WGS;
constexpr bool GATES_IN_P3 = GATE_WGS > 0;
#ifndef MK_N_LAUNCHES
#define MK_N_LAUNCHES 1
#endif
constexpr int N_LAUNCHES = MK_N_LAUNCHES;

constexpr size_t MiB = 1u << 20;
constexpr size_t WS_CTL = 0, CTL_ZERO_BYTES = 32768;
constexpr size_t WS_WIN   = 2 * MiB;
constexpr size_t WS_WMKV  = WS_WIN + 40 * MiB;
constexpr size_t WS_WUP   = WS_WMKV + 4 * MiB;
constexpr size_t WS_WOUT  = WS_WUP + 8 * MiB;
constexpr size_t WS_WRT   = WS_WOUT + 8 * MiB;
constexpr size_t WS_WGU   = WS_WRT + 1 * MiB;
constexpr size_t WS_WD    = WS_WGU + 512 * MiB;
constexpr size_t WS_XN    = WS_WD + 256 * MiB;
constexpr size_t WS_MN    = WS_XN + 64 * MiB;
constexpr size_t WS_LOGF  = WS_MN + 2 * MiB;
constexpr size_t WS_CNEG  = WS_LOGF + 1 * MiB;
constexpr size_t WS_ROPE  = WS_CNEG + 1 * MiB;
constexpr size_t WS_QKV   = WS_ROPE + 4 * MiB;
constexpr size_t WS_G     = WS_QKV + 128 * MiB;
constexpr size_t WS_MKV   = WS_G + 192 * MiB;
constexpr size_t WS_OALL  = WS_MKV + 1 * MiB;
constexpr size_t WS_MERGED= WS_OALL + 64 * MiB;
constexpr size_t WS_HB    = WS_MERGED + 64 * MiB;
constexpr size_t WS_TOK   = WS_HB + 64 * MiB;
constexpr size_t WS_GATE  = WS_TOK + 2 * MiB;
constexpr size_t WS_RS    = WS_GATE + 2 * MiB;
constexpr size_t WS_ACT   = WS_RS + 2 * MiB;
constexpr size_t WS_Y     = WS_ACT + 288 * MiB;
constexpr size_t WS_TSLOT = WS_Y + 288 * MiB;
constexpr size_t WS_TGATE = WS_TSLOT + 1 * MiB;
constexpr size_t WS_XN8   = WS_TGATE + 1 * MiB;
constexpr size_t WS_WIN8  = WS_XN8 + 32 * MiB;
constexpr size_t WS_END   = WS_WIN8 + 12 * MiB;
constexpr int CW_BAR = 4096;
constexpr int CW_QHEAD = 64;
constexpr int CW_CNT = 512;

typedef unsigned short bf16;
typedef unsigned v4u __attribute__((ext_vector_type(4)));
typedef unsigned v2u __attribute__((ext_vector_type(2)));
typedef float f32x4 __attribute__((ext_vector_type(4)));
typedef float f32x16 __attribute__((ext_vector_type(16)));
typedef short bf16x8 __attribute__((ext_vector_type(8)));
typedef short s16x4 __attribute__((ext_vector_type(4)));
typedef GAS unsigned gu32;
#define RLX_AGENT __ATOMIC_RELAXED, __HIP_MEMORY_SCOPE_AGENT
#define LDS_WAIT() asm volatile("s_waitcnt lgkmcnt(0)" ::: "memory")
#define VM_WAIT() asm volatile("s_waitcnt vmcnt(0)" ::: "memory")
__device__ __forceinline__ unsigned f2bf(float f) { unsigned u = __builtin_bit_cast(unsigned, f); return (u + 0x7fffu + ((u >> 16) & 1u)) >> 16; }
__device__ __forceinline__ unsigned pk2(float lo, float hi) { return f2bf(lo) | (f2bf(hi) << 16); }
__device__ __forceinline__ float bf2f(unsigned short b) { return __uint_as_float(((unsigned)b) << 16); }
__device__ __forceinline__ float wave_sum(float v) {
#pragma unroll
    for (int o = 1; o < 64; o <<= 1) v += __shfl_xor(v, o);
    return v;
}
__device__ __forceinline__ float sigmoidf_(float x) { return __builtin_amdgcn_rcpf(1.0f + __builtin_amdgcn_exp2f(x * (-LOG2E))); }

constexpr int H8_SHIFT = 4, ACT8_SHIFT = 2, W8_SHIFT = 9;
constexpr float H8_MUL = 16.0f, ACT8_MUL = 4.0f, W8_MUL = 512.0f;
__device__ __forceinline__ float clamp_fp8(float v) { return __builtin_amdgcn_fmed3f(v, -448.0f, 448.0f); }
__device__ __forceinline__ unsigned pk4_fp8(float a, float b, float c, float d) {
    int p = __builtin_amdgcn_cvt_pk_fp8_f32(clamp_fp8(a), clamp_fp8(b), 0, false); p = __builtin_amdgcn_cvt_pk_fp8_f32(clamp_fp8(c), clamp_fp8(d), p, true); return (unsigned)p; }
using pg8::f32x2; using pg8::u32x4; using pg8::u32x2; using pg8::cvt_pk_bf16; using pg8::bf_lo; using pg8::bf_hi;

#define XB_TMO      128
#define XB_XCNT(j)  (256  + 64 * (j))
#define XB_XSUB(j)  (1280 + 64 * (j))
#define XB_XGEN(j)  (2304 + 64 * (j))
#define XB_TOP      3328
#define XB_TOPGEN   3392
#define XCD_BAR_WORDS 3456
#define XB_SPIN_CAP (1u << 18)

__device__ __forceinline__ unsigned xb_ld(unsigned* p)              { return __hip_atomic_load(p, __ATOMIC_RELAXED, __HIP_MEMORY_SCOPE_AGENT); }
__device__ __forceinline__ unsigned xb_add(unsigned* p, unsigned v) { return __hip_atomic_fetch_add(p, v, __ATOMIC_RELAXED, __HIP_MEMORY_SCOPE_AGENT); }
__device__ __forceinline__ unsigned xb_xcc_id() { return (unsigned)__builtin_amdgcn_s_getreg((3 << 11) | 20) & 0xFu; }
#define XB_SPIN(cond, bar) do { unsigned _sp = 0; while (cond) { __builtin_amdgcn_s_sleep(1); \
    if ((++_sp & 255u) == 0u) { if (xb_ld(&(bar)[XB_TMO])) break; if (_sp > XB_SPIN_CAP) { atomicAdd(&(bar)[XB_TMO], 1u); break; } } } } while (0)

struct XcdBarrier { unsigned* bar; unsigned x; volatile LAS unsigned* st; };

__device__ __forceinline__ XcdBarrier xcd_barrier_post(unsigned* bar, volatile LAS unsigned* st) {
    XcdBarrier b; b.bar = bar; b.x = xb_xcc_id(); b.st = st;
    if (threadIdx.x == 0) (void)xb_add(&bar[XB_XCNT(b.x)], 1u);
    return b;
}
__device__ __forceinline__ void xcd_barrier_complete(unsigned* bar, unsigned x, unsigned& nloc, unsigned& nx) {
    const unsigned G = gridDim.x * gridDim.y * gridDim.z;
    unsigned sum, cnt, mine, sp = 0u;
    for (;;) {
        sum = 0u; cnt = 0u; mine = 0u;
#pragma unroll
        for (unsigned j = 0; j < 16; ++j) { const unsigned c = xb_ld(&bar[XB_XCNT(j)]); sum += c; cnt += (c > 0u) ? 1u : 0u; mine = (j == x) ? c : mine; }
        if (sum == G) break;
        __builtin_amdgcn_s_sleep(1);
        if ((++sp & 255u) == 0u) { if (xb_ld(&bar[XB_TMO])) break; if (sp > XB_SPIN_CAP) { atomicAdd(&bar[XB_TMO], 1u); break; } }
    }
    nloc = mine > 0u ? mine : 1u; nx = cnt > 0u ? cnt : 1u;
}
__device__ __forceinline__ void xcd_barrier(const XcdBarrier& b) {
    asm volatile("s_waitcnt vmcnt(0)" ::: "memory");
    __syncthreads();
    if (threadIdx.x == 0) {
        unsigned* bar = b.bar;
        __builtin_amdgcn_s_waitcnt(0);
        unsigned nloc = b.st[0], nx = b.st[1];
        if (nloc == 0u) { xcd_barrier_complete(bar, b.x, nloc, nx); b.st[0] = nloc; b.st[1] = nx; }
        const unsigned old = xb_add(&bar[XB_XSUB(b.x)], 1u);
        const unsigned gen = old / nloc;
        if (old + 1u == (gen + 1u) * nloc) {
            __builtin_amdgcn_fence(__ATOMIC_RELEASE, "agent");
            asm volatile("s_waitcnt vmcnt(0)" ::: "memory");
            const unsigned og = xb_add(&bar[XB_TOP], 1u);
            const unsigned tg = og / nx;
            if (og + 1u == (tg + 1u) * nx) xb_add(&bar[XB_TOPGEN], 1u);
            else XB_SPIN(xb_ld(&bar[XB_TOPGEN]) == tg, bar);
            __builtin_amdgcn_fence(__ATOMIC_ACQUIRE, "agent");
            xb_add(&bar[XB_XGEN(b.x)], 1u);
            asm volatile("s_waitcnt vmcnt(0)" ::: "memory");
        } else {
            XB_SPIN(xb_ld(&bar[XB_XGEN(b.x)]) == gen, bar);
            __builtin_amdgcn_fence(__ATOMIC_ACQUIRE, "agent");
            asm volatile("s_waitcnt vmcnt(0)" ::: "memory");
        }
    }
    __syncthreads();
}

constexpr int RING_OFF = 0, RING_BYTES = 131072;
constexpr int LDSCTL_OFF = RING_BYTES, MISC_OFF = LDSCTL_OFF + 320;
constexpr int MOE_OFF = MISC_OFF + 128;
constexpr int LDS_BYTES = 147456;

struct Ctx {
    LAS unsigned char* lds;
    volatile LAS unsigned* MISC;
    gu32* ctl;
    int tid, lane, wave, vcu, G, probe;
    const float *x, *mem; const int* pos; const float *norm_mix, *w_in, *b_forget, *fox_q_norm, *fox_k_norm, *swa_q_norm, *swa_k_norm, *swa_sinks, *xmem_q_norm, *xmem_k_norm, *norm_mem,
        *w_mem_kv, *w_up_fox, *w_up_swa, *w_up_xmem, *w_out, *norm_ffn, *w_router, *b_router, *w_gate_up, *b_gate_up, *w_down, *b_down;
    float* out;
    bf16 *Win_t, *Wmkv_t, *Wup_t, *Wout_t, *Wr_t, *Wgu_t, *Wd_t, *XN, *MN, *QKV, *H1B, *G_, *MKV, *OALL, *MERGED, *HB, *ACT;
    float *LOGF, *CNEG, *ROPE, *GATEW, *RS, *TGATE; int *TOK, *TSLOT; bf16* Y; unsigned char *XN8, *Win8;
};

#ifndef PROBE_INW
#define PROBE_INW 64
#endif
__constant__ float INV_FREQ[32] = {1.000000000e+00f, 7.498942614e-01f, 5.623413324e-01f, 4.216965139e-01f, 3.162277639e-01f, 2.371373773e-01f, 1.778279394e-01f, 1.333521307e-01f,
    1.000000015e-01f, 7.498941571e-02f, 5.623413250e-02f, 4.216965288e-02f, 3.162277490e-02f, 2.371373773e-02f, 1.778279431e-02f, 1.333521493e-02f, 9.999999776e-03f, 7.498941850e-03f,
    5.623413250e-03f, 4.216964822e-03f, 3.162277630e-03f, 2.371373586e-03f, 1.778279431e-03f, 1.333521446e-03f, 1.000000047e-03f, 7.498942432e-04f, 5.623413017e-04f, 4.216965172e-04f,
    3.162277571e-04f, 2.371373703e-04f, 1.778279402e-04f, 1.333521504e-04f};

struct TItem { const float* src; const float* ksc; bf16* dst; size_t ldw; int f8, gap; };
__device__ __forceinline__ void titem_load(const TItem& I, f32x4 (&v)[8][2], float (&sc)[8][2], int lane) {
    const int rr = lane >> 4, c4 = lane & 15;
#pragma unroll
    for (int p = 0; p < 8; ++p)
#pragma unroll
        for (int h = 0; h < 2; ++h) { const int k = 8 * p + 2 * rr + h; v[p][h] = *(const GAS f32x4*)(I.src + (size_t)k * I.ldw + 4 * c4 + (c4 >= 8 ? I.gap : 0)); sc[p][h] = I.ksc ? I.ksc[k] : 1.0f; }
}
__device__ __forceinline__ void titem_store(const TItem& I, const f32x4 (&v)[8][2], const float (&sc)[8][2], LAS unsigned* tile, int lane) {
    const int rr = lane >> 4, c4 = lane & 15;
#pragma unroll
    for (int p = 0; p < 8; ++p)
#pragma unroll
        for (int q = 0; q < 4; ++q) { const int n = 4 * c4 + q, sw = (n ^ (n >> 3)) & 7;
            tile[n * 32 + 4 * (p ^ sw) + rr] = pg8::cvt_pk_bf16(v[p][0][q] * sc[p][0], v[p][1][q] * sc[p][1]); }
    LDS_WAIT(); asm volatile("" ::: "memory");
#pragma unroll
    for (int j = 0; j < 8; ++j) { const int n = 8 * j + (lane >> 3), c = lane & 7, sw = (n ^ (n >> 3)) & 7;
        const v4u o = *(const LAS v4u*)(tile + n * 32 + 4 * (c ^ sw));
        *(GAS v4u*)(I.dst + (size_t)n * DM + 8 * c) = o; }
    LDS_WAIT(); asm volatile("" ::: "memory");
}
__device__ __forceinline__ size_t tiled8(size_t row, int kt) { return (row >> 8) * (size_t)(256 * 2048) + (size_t)kt * 32768 + (row & 255) * 128; }
#ifndef CONV_NT
#define CONV_NT 1
#endif
#if CONV_NT
#define CONV_LOAD(p) __builtin_nontemporal_load(p)
#else
#define CONV_LOAD(p) (*(p))
#endif
__device__ __forceinline__ void titem8_load(const TItem& I, int qh, f32x4 (&v)[4][2], int lane) {
    const int rr = lane >> 4, c4 = lane & 15;
#pragma unroll
    for (int pp = 0; pp < 2; ++pp)
#pragma unroll
        for (int h = 0; h < 4; ++h) { const int k = 32 * qh + 16 * pp + 4 * rr + h; v[2 * pp + (h >> 1)][h & 1] = CONV_LOAD((const GAS f32x4*)(I.src + (size_t)k * I.ldw + 4 * c4)); }
}
__device__ __forceinline__ void titem8_pack(const TItem& I, const float* nbase, int qh, const f32x4 (&v)[4][2], LAS unsigned* tile, const LAS float* lnorm, int lane) {
    const int rr = lane >> 4, c4 = lane & 15;
    const int kofs = I.ksc ? (int)(I.ksc - nbase) + 32 * qh + 4 * rr : -1;
#pragma unroll
    for (int pp = 0; pp < 2; ++pp) {
        f32x4 sc = {W8_MUL, W8_MUL, W8_MUL, W8_MUL}; if (kofs >= 0) sc = *(const LAS f32x4*)(lnorm + kofs + 16 * pp);
#pragma unroll
        for (int q = 0; q < 4; ++q) { const int n = 4 * c4 + q, sw = (n ^ (n >> 3)) & 7;
            tile[n * 32 + 4 * ((2 * qh + pp) ^ sw) + rr] = pk4_fp8(v[2 * pp][0][q] * sc.x, v[2 * pp][1][q] * sc.y, v[2 * pp + 1][0][q] * sc.z, v[2 * pp + 1][1][q] * sc.w); } }
}
__device__ __forceinline__ void titem8_flush(const TItem& I, LAS unsigned* tile, int lane) {
    LDS_WAIT(); asm volatile("" ::: "memory");
#pragma unroll
    for (int j = 0; j < 8; ++j) { const int n = 8 * j + (lane >> 3), c = lane & 7, sw = (n ^ (n >> 3)) & 7;
        const v4u o = *(const LAS v4u*)(tile + n * 32 + 4 * (c ^ sw));
        *(GAS v4u*)((unsigned char*)I.dst + (size_t)n * 128 + 16 * c) = o; }
    LDS_WAIT(); asm volatile("" ::: "memory");
}
__device__ __forceinline__ void p0_router_item(const float* W, int k0, bf16* WT, const float* ksc, LAS float* scr, int lane) {
#pragma unroll 8
    for (int i = 0; i < 32; ++i) { const int kk = 2 * i + (lane >> 5); scr[kk * 33 + (lane & 31)] = W[(size_t)(k0 + kk) * 32 + (lane & 31)] * ksc[k0 + kk]; }
    LDS_WAIT(); asm volatile("" ::: "memory");
    const int c = lane & 7;
#pragma unroll
    for (int j = 0; j < 4; ++j) { const int n = (lane >> 3) + 8 * j; const LAS float* s = scr + (8 * c) * 33 + n;
        unsigned h[8], l[8];
#pragma unroll
        for (int q = 0; q < 8; ++q) { const float v = s[q * 33]; h[q] = f2bf(v); l[q] = f2bf(v - __uint_as_float(h[q] << 16)); }
        v4u oh, ol; oh.x = h[0] | (h[1] << 16); oh.y = h[2] | (h[3] << 16); oh.z = h[4] | (h[5] << 16); oh.w = h[6] | (h[7] << 16);
        ol.x = l[0] | (l[1] << 16); ol.y = l[2] | (l[3] << 16); ol.z = l[4] | (l[5] << 16); ol.w = l[6] | (l[7] << 16);
        *(GAS v4u*)(WT + (size_t)n * 2048 + k0 + 8 * c) = oh; *(GAS v4u*)(WT + (size_t)(32 + n) * 2048 + k0 + 8 * c) = ol; }
    LDS_WAIT(); asm volatile("" ::: "memory");
}
__device__ __forceinline__ float log_sigmoidf_(float z) { return fminf(z, 0.f) - log1pf(__expf(-fabsf(z))); }

template <bool XROW>
__device__ __forceinline__ void p0_norm_row(const Ctx& C, const float* xrow, const float* gain, bf16* orow, const LAS float* Wf, int m) {
    const GAS f32x4* xr = (const GAS f32x4*)xrow + C.lane; const GAS f32x4* gr = (const GAS f32x4*)gain + C.lane;
    f32x4 v[8]; float s = 0.f;
#pragma unroll
    for (int j = 0; j < 8; ++j) { v[j] = xr[64 * j]; s += (v[j].x * v[j].x + v[j].y * v[j].y) + (v[j].z * v[j].z + v[j].w * v[j].w); }
    const float rstd = 1.0f / sqrtf(wave_sum(s) * (1.f / DM) + NORM_EPS);
    GAS unsigned long long* o8 = (GAS unsigned long long*)orow + C.lane;
#pragma unroll
    for (int j = 0; j < 8; ++j) { const f32x4 g = gr[64 * j]; v[j] = (v[j] * rstd) * g;
        o8[64 * j] = (unsigned long long)pk2(v[j].x, v[j].y) | ((unsigned long long)pk2(v[j].z, v[j].w) << 32);
        if constexpr (XROW) ((GAS unsigned*)(C.XN8 + (size_t)m * DM))[C.lane + 64 * j] = pk4_fp8(v[j].x * H8_MUL, v[j].y * H8_MUL, v[j].z * H8_MUL, v[j].w * H8_MUL); }
    if constexpr (XROW) {
        float mine = 0.f;
#pragma unroll 1
        for (int h = 0; h < 12; ++h) { const LAS f32x4* w = (const LAS f32x4*)(Wf + h * 2048) + C.lane; float d = 0.f;
#pragma unroll
            for (int j = 0; j < 8; ++j) { const f32x4 ww = w[64 * j]; d += (v[j].x * ww.x + v[j].y * ww.y) + (v[j].z * ww.z + v[j].w * ww.w); }
            d = wave_sum(d); if (C.lane == h) mine = d; }
        const int b = m / SEQ, t = m % SEQ;
        if (C.lane < 12) C.LOGF[(size_t)(b * 12 + C.lane) * SEQ + t] = log_sigmoidf_(mine + C.b_forget[C.lane]);
        if (C.lane < 32) { const float ang = (float)C.pos[m] * INV_FREQ[C.lane]; const double rev = (double)ang * 0.15915494309189535; const float fr = (float)(rev - floor(rev));
            C.ROPE[(size_t)m * 64 + C.lane] = __builtin_amdgcn_cosf(fr); C.ROPE[(size_t)m * 64 + 32 + C.lane] = __builtin_amdgcn_sinf(fr); }
    }
}
constexpr int I_GU = 32 * 16 * 64, I_D = 32 * 16 * 32, I_ING = 16 * 96, I_IN = 32 * PROBE_INW, I_MKV = 32 * 16, I_UF = 12 * 32, I_US = 12 * 32, I_UX = 8 * 32, I_O = 32 * 32;
constexpr int NITEMS = I_GU + I_D + I_ING + I_IN + I_MKV + I_UF + I_US + I_UX + I_O;
constexpr int N8 = I_GU + I_D + I_ING;
__device__ __forceinline__ TItem p0_decode(const Ctx& C, int it) {
        TItem I; int r = it; I.ksc = nullptr; I.f8 = 0; I.gap = 0;
        if (r < I_GU) { const int e = r / 1024, q = r % 1024, kb = 2 * (q / 64), pb = q % 64, tl = pb >> 2, jb = pb & 3;
            const int n0 = (jb < 2) ? (128 * tl + 64 * jb) : (2048 + 128 * tl + 64 * (jb - 2));
            I.ldw = 4096; I.src = C.w_gate_up + (size_t)e * DM * 4096 + (size_t)(64 * kb) * 4096 + n0; I.ksc = C.norm_ffn + 64 * kb; I.f8 = 1; I.dst = (bf16*)((unsigned char*)C.Wgu_t + tiled8((size_t)e * 4096 + 64 * pb, kb >> 1)); return I; } r -= I_GU;
        if (r < I_D) { const int e = r / 512, q = r % 512, kb = 2 * (q / 32), nb = q % 32;
            I.ldw = DM; I.src = C.w_down + (size_t)e * DM * DM + (size_t)(64 * kb) * DM + 64 * nb; I.f8 = 1; I.dst = (bf16*)((unsigned char*)C.Wd_t + tiled8((size_t)e * DM + 64 * nb, kb >> 1)); return I; } r -= I_D;
        if (r < I_ING) { const int kb = 2 * (r / 96), pb = r % 96;
            I.ldw = INW; I.src = C.w_in + (size_t)(64 * kb) * INW + 4108 + 64 * pb; I.f8 = 1; I.dst = (bf16*)((unsigned char*)C.Win8 + tiled8((size_t)64 * pb, kb >> 1)); return I; } r -= I_ING;
        if (r < I_IN) { const int kb = r / PROBE_INW, pb = r % PROBE_INW; int p0 = 64 * pb; const int tl = pb >> 2, q4 = pb & 3;
            if (tl == 3 || tl == 4 || tl == 5 || tl == 12) { p0 = 256 * tl + 128 * (q4 & 1) + 32 * (q4 >> 1); I.gap = 32; }
            const int n0 = (p0 < 2304) ? p0 : p0 + 12;
            I.ldw = INW; I.src = C.w_in + (size_t)(64 * kb) * INW + n0; I.dst = C.Win_t + (size_t)(64 * pb) * DM + 64 * kb; return I; } r -= I_IN;
        if (r < I_MKV) { const int kb = r / 16, nb = r % 16; I.ldw = 1024; I.src = C.w_mem_kv + (size_t)(64 * kb) * 1024 + 64 * nb; I.dst = C.Wmkv_t + (size_t)(64 * nb) * DM + 64 * kb; return I; } r -= I_MKV;
        if (r < I_UF) { const int kb = r / 32, nb = r % 32; I.ldw = DM; I.src = C.w_up_fox + (size_t)(64 * kb) * DM + 64 * nb; I.dst = C.Wup_t + (size_t)(64 * nb) * DM + 64 * kb; return I; } r -= I_UF;
        if (r < I_US) { const int kb = r / 32, nb = r % 32; I.ldw = DM; I.src = C.w_up_swa + (size_t)(64 * kb) * DM + 64 * nb; I.dst = C.Wup_t + (size_t)(64 * nb) * DM + 768 + 64 * kb; return I; } r -= I_US;
        if (r < I_UX) { const int kb = r / 32, nb = r % 32; I.ldw = DM; I.src = C.w_up_xmem + (size_t)(64 * kb) * DM + 64 * nb; I.dst = C.Wup_t + (size_t)(64 * nb) * DM + 1536 + 64 * kb; return I; } r -= I_UX;
        { const int kb = r / 32, nb = r % 32; I.ldw = DM; I.src = C.w_out + (size_t)(64 * kb) * DM + 64 * nb; I.dst = C.Wout_t + (size_t)(64 * nb) * DM + 64 * kb; return I; }
}
__device__ __forceinline__ void p0_fp8_loop(const Ctx& C, int first, int cnt, int me, int stride, LAS unsigned* tile, const LAS float* lnorm) {
    if (me >= cnt) return;
#ifdef PROBE_STREAMCEIL
    if (C.probe == 8) {
        for (int it = me; it < cnt; it += stride) { const int gi = first + it; const float* src = (gi < I_GU ? C.w_gate_up + (size_t)gi * 8192 : C.w_down + (size_t)(gi - I_GU) * 8192) + C.lane * 4;
            f32x4 acc_ = {0.f, 0.f, 0.f, 0.f};
#pragma unroll 8
            for (int r = 0; r < 32; ++r) acc_ += __builtin_nontemporal_load((const GAS f32x4*)(src + r * 256));
            asm volatile("" :: "v"(acc_)); }
        return; }
#endif
    const int nq = 4 * ((cnt - me + stride - 1) / stride);
    f32x4 b0[4][2], b1[4][2], b2[4][2], b3[4][2], b4[4][2];
#define P0_ITEM(q_) p0_decode(C, first + me + ((q_) >> 2) * stride)
#define P0_STEP(q_, cur_, pre_) do { const int qq = (q_); if (qq < nq) { \
        if (qq + 4 < nq) { const TItem J = P0_ITEM(qq + 4); titem8_load(J, (qq + 4) & 3, pre_, C.lane); } \
        const TItem I = P0_ITEM(qq); titem8_pack(I, C.norm_ffn, qq & 3, cur_, tile, lnorm, C.lane); \
        if ((qq & 3) == 3) titem8_flush(I, tile, C.lane); } } while (0)
    { const TItem I = P0_ITEM(0); titem8_load(I, 0, b0, C.lane); titem8_load(I, 1, b1, C.lane); titem8_load(I, 2, b2, C.lane); titem8_load(I, 3, b3, C.lane); }
    for (int qs = 0; qs < nq; qs += 5) { P0_STEP(qs, b0, b4); P0_STEP(qs + 1, b1, b0); P0_STEP(qs + 2, b2, b1); P0_STEP(qs + 3, b3, b2); P0_STEP(qs + 4, b4, b3); }
#undef P0_ITEM
#undef P0_STEP
}
__device__ __forceinline__ void p0_fill_lnorm(const Ctx& C, LAS float* lnorm) { for (int k = C.tid; k < DM; k += NWAVES * 64) lnorm[k] = C.norm_ffn[k] * W8_MUL; }
__device__ __forceinline__ void p0_x_rows2(const Ctx& C, const LAS float* Wf, int m0, int m1) {
    const GAS f32x4* gr = (const GAS f32x4*)C.norm_mix + C.lane;
    const int mm[2] = {m0, m1};
    f32x4 v[2][8]; float s[2] = {0.f, 0.f};
#pragma unroll
    for (int r = 0; r < 2; ++r) { const GAS f32x4* xr = (const GAS f32x4*)(C.x + (size_t)mm[r] * DM) + C.lane;
#pragma unroll
        for (int j = 0; j < 8; ++j) v[r][j] = xr[64 * j]; }
#pragma unroll
    for (int r = 0; r < 2; ++r)
#pragma unroll
        for (int j = 0; j < 8; ++j) s[r] += (v[r][j].x * v[r][j].x + v[r][j].y * v[r][j].y) + (v[r][j].z * v[r][j].z + v[r][j].w * v[r][j].w);
    float rstd[2];
#pragma unroll
    for (int r = 0; r < 2; ++r) rstd[r] = 1.0f / sqrtf(wave_sum(s[r]) * (1.f / DM) + NORM_EPS);
#pragma unroll
    for (int j = 0; j < 8; ++j) { const f32x4 g = gr[64 * j];
#pragma unroll
        for (int r = 0; r < 2; ++r) { v[r][j] = (v[r][j] * rstd[r]) * g;
            ((GAS unsigned long long*)(C.XN + (size_t)mm[r] * DM))[C.lane + 64 * j] = (unsigned long long)pk2(v[r][j].x, v[r][j].y) | ((unsigned long long)pk2(v[r][j].z, v[r][j].w) << 32);
            ((GAS unsigned*)(C.XN8 + (size_t)mm[r] * DM))[C.lane + 64 * j] = pk4_fp8(v[r][j].x * H8_MUL, v[r][j].y * H8_MUL, v[r][j].z * H8_MUL, v[r][j].w * H8_MUL); } }
    float mine[2] = {0.f, 0.f};
#pragma unroll 1
    for (int h = 0; h < 12; ++h) { const LAS f32x4* w = (const LAS f32x4*)(Wf + h * 2048) + C.lane; float d0 = 0.f, d1 = 0.f;
#pragma unroll
        for (int j = 0; j < 8; ++j) { const f32x4 ww = w[64 * j];
            d0 += (v[0][j].x * ww.x + v[0][j].y * ww.y) + (v[0][j].z * ww.z + v[0][j].w * ww.w); d1 += (v[1][j].x * ww.x + v[1][j].y * ww.y) + (v[1][j].z * ww.z + v[1][j].w * ww.w); }
        d0 = wave_sum(d0); d1 = wave_sum(d1); if (C.lane == h) { mine[0] = d0; mine[1] = d1; } }
#pragma unroll
    for (int r = 0; r < 2; ++r) { const int m = mm[r], b = m / SEQ, t = m % SEQ;
        if (C.lane < 12) C.LOGF[(size_t)(b * 12 + C.lane) * SEQ + t] = log_sigmoidf_(mine[r] + C.b_forget[C.lane]);
        if (C.lane < 32) { const float ang = (float)C.pos[m] * INV_FREQ[C.lane]; const double rev = (double)ang * 0.15915494309189535; const float fr = (float)(rev - floor(rev));
            C.ROPE[(size_t)m * 64 + C.lane] = __builtin_amdgcn_cosf(fr); C.ROPE[(size_t)m * 64 + 32 + C.lane] = __builtin_amdgcn_sinf(fr); } }
}
__device__ __forceinline__ void phase0(const Ctx& C) {
    const int gw = C.vcu * NWAVES + C.wave, NGW = C.G * NWAVES;
    LAS float* scr = (LAS float*)(C.lds + RING_OFF + C.wave * 16384);
    for (int r = gw; r < 32; r += NGW) p0_router_item(C.w_router, 64 * r, C.Wr_t, C.norm_ffn, scr, C.lane);
    LAS unsigned* tile = (LAS unsigned*)(C.lds + RING_OFF + C.wave * 8192);
    __syncthreads();
    LAS float* lnorm = (LAS float*)(C.lds + RING_OFF + 65536);
    p0_fill_lnorm(C, lnorm); __syncthreads();
    p0_fp8_loop(C, CONV_IN_P3 ? I_GU + I_D : 0, CONV_IN_P3 ? I_ING : N8, gw, NGW, tile, lnorm);
    if (N8 + gw < NITEMS) {
        TItem cur = p0_decode(C, N8 + gw); f32x4 va[8][2]; float sa[8][2]; titem_load(cur, va, sa, C.lane);
        for (int it = N8 + gw; it < NITEMS; it += NGW) {
            const int nx = it + NGW; TItem nxt = cur; f32x4 vb[8][2]; float sb[8][2];
            if (nx < NITEMS) { nxt = p0_decode(C, nx); titem_load(nxt, vb, sb, C.lane); }
            titem_store(cur, va, sa, tile, C.lane);
            cur = nxt;
#pragma unroll
            for (int p = 0; p < 8; ++p)
#pragma unroll
                for (int h = 0; h < 2; ++h) { va[p][h] = vb[p][h]; sa[p][h] = sb[p][h]; }
        }
    }
    __syncthreads();
    LAS float* Wf = (LAS float*)(C.lds + RING_OFF);
    for (int idx = C.tid; idx < 12 * 2048; idx += NWAVES * 64) { const int k = idx / 12, h = idx - 12 * k; Wf[h * 2048 + k] = C.w_in[(size_t)k * INW + 2304 + h]; }
    __syncthreads();
    { int m = gw; for (; m + NGW < T; m += 2 * NGW) p0_x_rows2(C, Wf, m, m + NGW); if (m < T) p0_norm_row<true>(C, C.x + (size_t)m * DM, C.norm_mix, C.XN + (size_t)m * DM, Wf, m); }
    for (int m = gw; m < MROWS; m += NGW) p0_norm_row<false>(C, C.mem + (size_t)m * DM, C.norm_mem, C.MN + (size_t)m * DM, Wf, m);
    __syncthreads();
}

#ifndef MK_CONV_CHUNK
#define MK_CONV_CHUNK 128
#endif
constexpr int CONV_CHUNK = MK_CONV_CHUNK;
#ifndef MK_WD_IN_P7
#define MK_WD_IN_P7 0
#endif
constexpr bool WD_IN_P7 = MK_WD_IN_P7;
constexpr int CONV_TAIL = MK_CONV_CHUNK;
constexpr int CONV_NBIG = I_GU / CONV_CHUNK, CONV_NSMALL = I_D / CONV_TAIL;
constexpr int CONV_NCHUNK = WD_IN_P7 ? CONV_NBIG : CONV_NBIG + CONV_NSMALL, CONV_NCHUNK_WD = I_D / CONV_CHUNK;
static_assert(I_GU % CONV_CHUNK == 0 && I_D % CONV_CHUNK == 0 && I_D % CONV_TAIL == 0, "conversion chunks");
__device__ __forceinline__ void conv_chunk(const Ctx& C, int chunk) {
    LAS unsigned* tile = (LAS unsigned*)(C.lds + RING_OFF + C.wave * 8192);
    const int first = chunk < CONV_NBIG ? chunk * CONV_CHUNK : I_GU + (chunk - CONV_NBIG) * CONV_TAIL, cnt = chunk < CONV_NBIG ? CONV_CHUNK : CONV_TAIL;
    p0_fp8_loop(C, first, cnt, C.wave, NWAVES, tile, (const LAS float*)(C.lds + RING_OFF + 65536));
}
__device__ __forceinline__ void conv_chunk_wd(const Ctx& C, int chunk) {
    LAS unsigned* tile = (LAS unsigned*)(C.lds + RING_OFF + C.wave * 8192);
    p0_fp8_loop(C, I_GU + chunk * CONV_CHUNK, CONV_CHUNK, C.wave, NWAVES, tile, (const LAS float*)(C.lds + RING_OFF + 65536));
}

#ifndef CONV_NT_ST
#define CONV_NT_ST 0
#endif
#if CONV_NT_ST
#define CONV_STORE(p, v) __builtin_nontemporal_store(v, p)
#else
#define CONV_STORE(p, v) (*(p) = (v))
#endif
#ifndef CONV2_SPLIT
#define CONV2_SPLIT 1
#endif
constexpr int CONV2_NCH_GU = 32 * 16 * CONV2_SPLIT, CONV2_NCH_D = 32 * 16 * CONV2_SPLIT, CONV2_NCHUNK = CONV2_NCH_GU + CONV2_NCH_D;
__device__ __forceinline__ void cblk_load(const float* rowp, size_t ldw, f32x4 (&v)[16]) {
#pragma unroll
    for (int r = 0; r < 16; ++r) v[r] = CONV_LOAD((const GAS f32x4*)(rowp + (size_t)r * ldw));
}
__device__ __forceinline__ void conv_chunk2(const Ctx& C, int chunk) {
    LAS unsigned char* tiles = C.lds + RING_OFF;
    const LAS float* lnorm = (const LAS float*)(C.lds + RING_OFF + 65536);
    const bool gu = chunk < CONV2_NCH_GU; const int c0 = gu ? chunk : chunk - CONV2_NCH_GU, part = c0 % CONV2_SPLIT, cc = c0 / CONV2_SPLIT, e = cc >> 4, kt = cc & 15, nbt = gu ? 16 : 8, nb = nbt / CONV2_SPLIT, tl0 = part * nb;
    const size_t ldw = gu ? 4096 : 2048;
    const float* W = gu ? C.w_gate_up + (size_t)e * DM * 4096 : C.w_down + (size_t)e * DM * DM;
    const float* row0 = W + (size_t)(128 * kt + 16 * C.wave) * ldw;
    const int lcol = gu ? ((C.lane < 32) ? 4 * C.lane : 2048 + 4 * (C.lane - 32)) : 4 * C.lane;
    unsigned char* dst0 = (unsigned char*)(gu ? C.Wgu_t : C.Wd_t) + ((size_t)(e * nbt + tl0) * 16 + kt) * 32768;
    f32x4 sc[4];
#pragma unroll
    for (int j = 0; j < 4; ++j) sc[j] = gu ? *(const LAS f32x4*)(lnorm + 128 * kt + 16 * C.wave + 4 * j) : (f32x4){W8_MUL, W8_MUL, W8_MUL, W8_MUL};
    f32x4 va[16], vb[16];
    cblk_load(row0 + lcol + (gu ? 128 : 256) * tl0, ldw, va);
#define CONV2_STEP(tl_, cur_, nxt_) do { const int tq = (tl_); if (tq < nb) { \
        if (tq + 1 < nb) cblk_load(row0 + lcol + (gu ? 128 : 256) * (tl0 + tq + 1), ldw, nxt_); \
        LAS unsigned char* tile = tiles + (tq & 1) * 32768; \
        _Pragma("unroll") for (int q = 0; q < 4; ++q) { const int n = 4 * C.lane + q; v4u o; \
            o.x = pk4_fp8(cur_[0][q] * sc[0].x, cur_[1][q] * sc[0].y, cur_[2][q] * sc[0].z, cur_[3][q] * sc[0].w); o.y = pk4_fp8(cur_[4][q] * sc[1].x, cur_[5][q] * sc[1].y, cur_[6][q] * sc[1].z, cur_[7][q] * sc[1].w); \
            o.z = pk4_fp8(cur_[8][q] * sc[2].x, cur_[9][q] * sc[2].y, cur_[10][q] * sc[2].z, cur_[11][q] * sc[2].w); o.w = pk4_fp8(cur_[12][q] * sc[3].x, cur_[13][q] * sc[3].y, cur_[14][q] * sc[3].z, cur_[15][q] * sc[3].w); \
            *(LAS v4u*)(tile + n * 128 + 16 * (C.wave ^ ((n >> 2) & 7))) = o; } \
        asm volatile("s_waitcnt lgkmcnt(0)\n\ts_barrier" ::: "memory"); \
        unsigned char* dst = dst0 + (size_t)tq * (16 * 32768); \
        _Pragma("unroll") for (int j = 0; j < 4; ++j) { const int n = (C.tid >> 3) + 64 * j, c = C.tid & 7; \
            const v4u o = *(const LAS v4u*)(tile + n * 128 + 16 * (c ^ ((n >> 2) & 7))); CONV_STORE((GAS v4u*)(dst + n * 128 + 16 * c), o); } } } while (0)
    for (int tl = 0; tl < nb; tl += 2) { CONV2_STEP(tl, va, vb); CONV2_STEP(tl + 1, vb, va); }
#undef CONV2_STEP
    asm volatile("s_waitcnt lgkmcnt(0)\n\ts_barrier" ::: "memory");
}

using pg8::Unit;
template <int RB>
struct DenseOrderT {
    const char* A; const char* Bt; int nM, nN, nwg, G, c;
    __device__ __forceinline__ void init(const void* A_, const void* Bt_, int M, int N, int G_, int c_) { A = (const char*)A_; Bt = (const char*)Bt_; nM = M / 256; nN = N / 256; nwg = nM * nN; G = G_; c = c_; }
    __device__ __forceinline__ bool map(long L, Unit& u) const {
        if (L >= nwg) return false;
        int wgid = (int)L; { const int q = nwg / 8, r = nwg % 8, xcd = wgid % 8, off = wgid / 8; wgid = (xcd < r ? xcd * (q + 1) : r * (q + 1) + (xcd - r) * q) + off; }
        const int nig = 8 * nN, gid = wgid / nig, fm = gid * 8, gsz = (nM - fm) < 8 ? (nM - fm) : 8;
        u.pm = fm + ((wgid % nig) % gsz); u.pn = (wgid % nig) / gsz; u.e = 0; u.kind = 0; return true;
    }
    __device__ __forceinline__ bool next(int i, Unit& u) const { return map((long)i * G + c, u); }
    __device__ __forceinline__ const char* a_base(const Unit& u) const { return A + (size_t)u.pm * (256 * RB); }
    __device__ __forceinline__ const char* b_base(const Unit& u) const { return Bt + (size_t)u.pn * (256 * RB); }
    __device__ __forceinline__ void a_offs(const Unit&, const int (&R)[2], const int (&Cc)[2], unsigned (&vo)[2][2]) const {
#pragma unroll
        for (int h = 0; h < 2; ++h)
#pragma unroll
            for (int i = 0; i < 2; ++i) vo[h][i] = (unsigned)((h * 128 + R[i]) * RB + Cc[i] * 2);
    }
};
typedef DenseOrderT<4096> DenseOrder;
struct P1Order {
    DenseOrder d; const char* A1; const char* B1;
    __device__ __forceinline__ bool next(int i, Unit& u) const {
        const long L = (long)i * d.G + d.c;
        if (L < d.nwg) return d.map(L, u);
        const int r = (int)(L - d.nwg); if (r >= 8) return false;
        u.pm = r >> 2; u.pn = r & 3; u.e = 0; u.kind = 1; return true;
    }
    __device__ __forceinline__ const char* a_base(const Unit& u) const { return (u.kind ? A1 : d.A) + (size_t)u.pm * (256 * 2048 * 2); }
    __device__ __forceinline__ const char* b_base(const Unit& u) const { return (u.kind ? B1 : d.Bt) + (size_t)u.pn * (256 * 2048 * 2); }
    __device__ __forceinline__ void a_offs(const Unit& u, const int (&R)[2], const int (&Cc)[2], unsigned (&vo)[2][2]) const { d.a_offs(u, R, Cc, vo); }
};
struct P1bOrder {
    DenseOrderT<2048> d;
    __device__ __forceinline__ bool next(int i, Unit& u) const {
        const int c = d.c;
        if (c < 8) return i < 4 ? d.map((long)i * d.G + c, u) : false;
        if (i < 6) return d.map((long)i * d.G + c, u);
        if (i == 6 && c < 24) { const int idx = c - 8; return d.map((long)(4 + (idx & 1)) * d.G + (idx >> 1), u); }
        return false;
    }
    __device__ __forceinline__ const char* a_base(const Unit& u) const { return d.a_base(u); }
    __device__ __forceinline__ const char* b_base(const Unit& u) const { return d.b_base(u); }
    __device__ __forceinline__ void a_offs(const Unit& u, const int (&R)[2], const int (&Cc)[2], unsigned (&vo)[2][2]) const { d.a_offs(u, R, Cc, vo); }
};
struct P1bGrpOrder {
    DenseOrderT<2048> d;
    __device__ __forceinline__ bool next(int i, Unit& u) const { return d.map((long)i * d.G + d.c, u); }
    __device__ __forceinline__ const char* a_base(const Unit& u) const { return d.a_base(u); }
    __device__ __forceinline__ const char* b_base(const Unit& u) const { return d.b_base(u); }
    __device__ __forceinline__ void a_offs(const Unit& u, const int (&R)[2], const int (&Cc)[2], unsigned (&vo)[2][2]) const { d.a_offs(u, R, Cc, vo); }
};
#ifndef MOE_NGRP
#define MOE_NGRP 4
#endif
#ifndef MOE_XCD_LISTS
#define MOE_XCD_LISTS 0
#endif
template <bool GATHER, int NT, int RB>
struct MoeOrder {
    const char* A; const char* Bt; const int* tok; const int* cnt; const LAS int* tab; int G, c;
    __device__ __forceinline__ bool next(int i, Unit& u) const {
        const int tot = __builtin_amdgcn_readfirstlane(tab[32]);
        int L;
        if (MOE_XCD_LISTS && G == 256) { const int x = c >> 5, s_ = i * 32 + (c & 31), seg = ((tot + 255) >> 8) << 5; L = x * seg + s_; if (s_ >= seg || L >= tot) return false; }
        else { L = i * G + c; if (L >= tot) return false; }
        int e = 0;
#pragma unroll 1
        for (int j = 1; j < 32; ++j) e += (__builtin_amdgcn_readfirstlane(tab[j]) <= L) ? 1 : 0;
        const int j = L - __builtin_amdgcn_readfirstlane(tab[e]), mt = __builtin_amdgcn_readfirstlane(tab[33 + e]), per = mt * MOE_NGRP, ntg = j / per, r = j - ntg * per;
        u.e = e; u.pm = r / MOE_NGRP; u.pn = ntg * MOE_NGRP + (r % MOE_NGRP); u.kind = __builtin_amdgcn_readfirstlane(tab[65 + e]) + 256 * u.pm;
        return true;
    }
    __device__ __forceinline__ const char* a_base(const Unit& u) const { return GATHER ? A : A + (size_t)u.kind * RB; }
    __device__ __forceinline__ const char* b_base(const Unit& u) const { return Bt + ((size_t)u.e * NT + u.pn) * (256 * RB); }
    __device__ __forceinline__ void a_offs(const Unit& u, const int (&R)[2], const int (&Cc)[2], unsigned (&vo)[2][2]) const {
#pragma unroll
        for (int h = 0; h < 2; ++h)
#pragma unroll
            for (int i = 0; i < 2; ++i) {
                if constexpr (GATHER) { const int n_e = __builtin_amdgcn_readfirstlane(tab[97 + u.e]); int ri = 256 * u.pm + h * 128 + R[i]; ri = ri < n_e ? ri : n_e - 1;
                    const int row = tok[u.e * CAP + ri]; vo[h][i] = (unsigned)(row * RB + Cc[i] * 2); }
                else vo[h][i] = (unsigned)((h * 128 + R[i]) * RB + Cc[i] * 2);
            }
    }
};

struct EpiInProj {
    static constexpr bool PERM = true, MID = false, FP8 = false, ASM_MFMA = false, BTILED = false; static constexpr int SCALE_A = 0x7f, SCALE_B = 0x7f;
    bf16* QKV; bf16* Gt; bf16* MKV; int noop; const float* gk_fox; const float* gk_swa; const float* rope;
    __device__ __forceinline__ void mid(pg8::f32x4 (&)[2][2][4][2], const Unit&, int, int, int, int, int) const {}
    __device__ __forceinline__ void operator()(const pg8::f32x4 (&acc)[2][2][4][2], const Unit& u, int wr, int wc, int fr, int fq) const {
        asm volatile("" : "+v"(fr), "+v"(fq));
        if (noop) return;
        if (!u.kind && (u.pn == 3 || u.pn == 4 || u.pn == 5 || u.pn == 12)) {
            const bool swa = (u.pn == 12); const float* gp = (swa ? gk_swa : gk_fox) + 8 * fq;
            float gn[2][8];
#pragma unroll
            for (int bj = 0; bj < 2; ++bj) { const pg8::f32x4 a = *(const pg8::f32x4*)(gp + 32 * bj), b = *(const pg8::f32x4*)(gp + 32 * bj + 4);
                gn[bj][0] = a[0]; gn[bj][1] = a[1]; gn[bj][2] = a[2]; gn[bj][3] = a[3]; gn[bj][4] = b[0]; gn[bj][5] = b[1]; gn[bj][6] = b[2]; gn[bj][7] = b[3]; }
#pragma unroll
            for (int ai = 0; ai < 2; ++ai)
#pragma unroll
                for (int m = 0; m < 4; ++m) { const int row = u.pm * 256 + wr * 64 + fr + ai * 128 + m * 16;
                    float x[2][8]; float ss = 0.f;
#pragma unroll
                    for (int bj = 0; bj < 2; ++bj)
#pragma unroll
                        for (int n = 0; n < 2; ++n)
#pragma unroll
                            for (int e = 0; e < 4; ++e) { const float v = acc[ai][bj][m][n][e]; x[bj][4 * n + e] = v; ss += v * v; }
                    ss += __shfl_xor(ss, 16); ss += __shfl_xor(ss, 32);
                    const float rstd = 1.0f / sqrtf(ss * (1.f / 64.f) + NORM_EPS);
#pragma unroll
                    for (int bj = 0; bj < 2; ++bj)
#pragma unroll
                        for (int q = 0; q < 8; ++q) x[bj][q] = (x[bj][q] * rstd) * gn[bj][q];
                    if (swa) { const float* cs = rope + (size_t)row * 64 + 8 * fq;
                        const pg8::f32x4 c0 = *(const pg8::f32x4*)cs, c1 = *(const pg8::f32x4*)(cs + 4), s0 = *(const pg8::f32x4*)(cs + 32), s1 = *(const pg8::f32x4*)(cs + 36);
                        const float cc[8] = {c0[0], c0[1], c0[2], c0[3], c1[0], c1[1], c1[2], c1[3]}, sn[8] = {s0[0], s0[1], s0[2], s0[3], s1[0], s1[1], s1[2], s1[3]};
#pragma unroll
                        for (int q = 0; q < 8; ++q) { const float x1 = x[0][q], x2 = x[1][q]; x[0][q] = x1 * cc[q] - x2 * sn[q]; x[1][q] = x2 * cc[q] + x1 * sn[q]; } }
                    bf16* rowp = QKV + (size_t)row * QKVW + u.pn * 256 + 64 * wc + 8 * fq;
#pragma unroll
                    for (int bj = 0; bj < 2; ++bj) { u32x4 w; w.x = cvt_pk_bf16(x[bj][0], x[bj][1]); w.y = cvt_pk_bf16(x[bj][2], x[bj][3]); w.z = cvt_pk_bf16(x[bj][4], x[bj][5]); w.w = cvt_pk_bf16(x[bj][6], x[bj][7]);
                        *(u32x4*)(rowp + 32 * bj) = w; } }
            return;
        }
        const int row0 = u.pm * 256 + wr * 64 + fr;
        bf16* base; int ldc, colt; bool sg = false;
        if (u.kind) { base = MKV; ldc = 1024; colt = u.pn * 256; }
        else if (u.pn < 16) { base = QKV; ldc = QKVW; colt = u.pn * 256; }
        else { base = Gt; ldc = GW; colt = (u.pn - 16) * 256; sg = true; }
        const int col0 = colt + wc * 32 + 8 * fq;
#pragma unroll
        for (int ai = 0; ai < 2; ++ai)
#pragma unroll
            for (int m = 0; m < 4; ++m) { bf16* rowp = base + (size_t)(row0 + ai * 128 + m * 16) * ldc + col0;
#pragma unroll
                for (int bj = 0; bj < 2; ++bj) { pg8::f32x4 v0 = acc[ai][bj][m][0], v1 = acc[ai][bj][m][1];
                    if (sg) {
#pragma unroll
                        for (int q = 0; q < 4; ++q) { v0[q] = sigmoidf_(fmaxf(v0[q], -30.f)); v1[q] = sigmoidf_(fmaxf(v1[q], -30.f)); } }
                    u32x4 w; w.x = cvt_pk_bf16(v0[0], v0[1]); w.y = cvt_pk_bf16(v0[2], v0[3]); w.z = cvt_pk_bf16(v1[0], v1[1]); w.w = cvt_pk_bf16(v1[2], v1[3]);
                    *(u32x4*)(rowp + bj * 128) = w; } }
    }
};
#ifndef PROBE_GASM
#define PROBE_GASM true
#endif
#ifndef G_U8
#define G_U8 1
#endif
__device__ __forceinline__ float ub0(unsigned x) { return (float)(x & 0xffu); }
__device__ __forceinline__ float ub1(unsigned x) { return (float)((x >> 8) & 0xffu); }
__device__ __forceinline__ float ub2(unsigned x) { return (float)((x >> 16) & 0xffu); }
__device__ __forceinline__ float ub3(unsigned x) { return (float)(x >> 24); }
struct EpiGates {
    static constexpr bool PERM = true, MID = false, FP8 = true, ASM_MFMA = PROBE_GASM, BTILED = true; static constexpr int SCALE_A = 127 - H8_SHIFT, SCALE_B = 127 - W8_SHIFT;
    bf16* Gt;
    __device__ __forceinline__ void mid(pg8::f32x4 (&)[2][2][4][2], const Unit&, int, int, int, int, int) const {}
    __device__ __forceinline__ void operator()(const pg8::f32x4 (&acc)[2][2][4][2], const Unit& u, int wr, int wc, int fr, int fq) const {
        asm volatile("" : "+v"(fr), "+v"(fq));
        const int row0 = u.pm * 256 + wr * 64 + fr, col0 = u.pn * 256 + wc * 32 + 8 * fq;
#pragma unroll
        for (int ai = 0; ai < 2; ++ai)
#pragma unroll
            for (int m = 0; m < 4; ++m) { bf16* rowp = Gt + (size_t)(row0 + ai * 128 + m * 16) * GW + col0;
#pragma unroll
                for (int bj = 0; bj < 2; ++bj) { unsigned wv[4];
#pragma unroll
                    for (int n = 0; n < 2; ++n)
#pragma unroll
                        for (int hq = 0; hq < 2; ++hq) { typedef pg8::f32x2 f2;
                            f2 x = {fmaxf(acc[ai][bj][m][n][2 * hq], -30.f), fmaxf(acc[ai][bj][m][n][2 * hq + 1], -30.f)};
                            const f2 t = x * (-LOG2E); f2 e; e.x = __builtin_amdgcn_exp2f(t.x); e.y = __builtin_amdgcn_exp2f(t.y);
                            const f2 d = e + 1.0f;
                            if (G_U8) { f2 r; r.x = __builtin_amdgcn_rcpf(d.x); r.y = __builtin_amdgcn_rcpf(d.y); r = r * 255.0f;
                                unsigned& w = wv[n]; if (hq == 0) w = 0; w = __builtin_amdgcn_cvt_pk_u8_f32(fmaxf(__builtin_rintf(r.x), 1.0f), 2 * hq, w); w = __builtin_amdgcn_cvt_pk_u8_f32(fmaxf(__builtin_rintf(r.y), 1.0f), 2 * hq + 1, w); }
                            else wv[2 * n + hq] = cvt_pk_bf16(__builtin_amdgcn_rcpf(d.x), __builtin_amdgcn_rcpf(d.y)); }
                    if (G_U8) { u32x2 w; w.x = wv[0]; w.y = wv[1]; *(u32x2*)((unsigned char*)Gt + (size_t)(row0 + ai * 128 + m * 16) * GW + col0 + bj * 128) = w; }
                    else { u32x4 w; w.x = wv[0]; w.y = wv[1]; w.z = wv[2]; w.w = wv[3]; *(u32x4*)(rowp + bj * 128) = w; } } }
    }
};
struct EpiMerge {
    static constexpr bool PERM = true, MID = true, FP8 = false, ASM_MFMA = false, BTILED = false; static constexpr int SCALE_A = 0x7f, SCALE_B = 0x7f;
    const bf16* Gt; bf16* O; const float* Xpf; int noop;
    __device__ __forceinline__ void mid(pg8::f32x4 (&acc)[2][2][4][2], const Unit& u, int which, int wr, int wc, int fr, int fq) const {
        asm volatile("" : "+v"(fr), "+v"(fq));
        if (noop & 1) return;
        const int row0 = u.pm * 256 + wr * 64 + fr, col0 = u.pn * 256 + wc * 32 + 8 * fq;
        const unsigned char* gn = (const unsigned char*)Gt + (which ? 2048 : 0); const unsigned char* gd = (const unsigned char*)Gt + (which ? 4096 : 2048);
        u32x2 ga[2][4][2], gb[2][4][2];
#pragma unroll
        for (int ai = 0; ai < 2; ++ai)
#pragma unroll
            for (int m = 0; m < 4; ++m) { const size_t ro = (size_t)(row0 + ai * 128 + m * 16) * GW + col0;
#pragma unroll
                for (int bj = 0; bj < 2; ++bj) { ga[ai][m][bj] = *(const u32x2*)(gn + ro + bj * 128); gb[ai][m][bj] = *(const u32x2*)(gd + ro + bj * 128); } }
#pragma unroll
        for (int ai = 0; ai < 2; ++ai) {
#pragma unroll
            for (int m = 0; m < 4; ++m) {
#pragma unroll
                for (int bj = 0; bj < 2; ++bj) { const u32x2 a = ga[ai][m][bj], b = gb[ai][m][bj];
                    pg8::f32x4 r0, r1;
                    r0[0] = ub0(a.x) * __builtin_amdgcn_rcpf(ub0(b.x)); r0[1] = ub1(a.x) * __builtin_amdgcn_rcpf(ub1(b.x)); r0[2] = ub2(a.x) * __builtin_amdgcn_rcpf(ub2(b.x)); r0[3] = ub3(a.x) * __builtin_amdgcn_rcpf(ub3(b.x));
                    r1[0] = ub0(a.y) * __builtin_amdgcn_rcpf(ub0(b.y)); r1[1] = ub1(a.y) * __builtin_amdgcn_rcpf(ub1(b.y)); r1[2] = ub2(a.y) * __builtin_amdgcn_rcpf(ub2(b.y)); r1[3] = ub3(a.y) * __builtin_amdgcn_rcpf(ub3(b.y));
                    acc[ai][bj][m][0] *= r0; acc[ai][bj][m][1] *= r1; }
                asm volatile("" : "+v"(acc[ai][0][m][0]), "+v"(acc[ai][0][m][1]), "+v"(acc[ai][1][m][0]), "+v"(acc[ai][1][m][1])); }
            asm volatile("" ::: "memory"); }
    }
    __device__ __forceinline__ void operator()(const pg8::f32x4 (&acc)[2][2][4][2], const Unit& u, int wr, int wc, int fr, int fq) const {
        asm volatile("" : "+v"(fr), "+v"(fq));
        if (noop & 2) return;
        const int row0 = u.pm * 256 + wr * 64 + fr, col0 = u.pn * 256 + wc * 32 + 8 * fq;
        u32x2 gx[2][4][2];
#pragma unroll
        for (int ai = 0; ai < 2; ++ai)
#pragma unroll
            for (int m = 0; m < 4; ++m) { const size_t rr = (size_t)(row0 + ai * 128 + m * 16);
#pragma unroll
                for (int bj = 0; bj < 2; ++bj) gx[ai][m][bj] = *(const u32x2*)((const unsigned char*)Gt + rr * GW + 4096 + col0 + bj * 128); }
        constexpr float I255 = 1.0f / 255.0f;
#pragma unroll
        for (int ai = 0; ai < 2; ++ai)
#pragma unroll
            for (int m = 0; m < 4; ++m) { const size_t rr = (size_t)(row0 + ai * 128 + m * 16);
#pragma unroll
                for (int bj = 0; bj < 2; ++bj) { const u32x2 g = gx[ai][m][bj];
                    const pg8::f32x4 v0 = acc[ai][bj][m][0] * I255, v1 = acc[ai][bj][m][1] * I255;
                    u32x4 w; w.x = cvt_pk_bf16(v0[0] * ub0(g.x), v0[1] * ub1(g.x)); w.y = cvt_pk_bf16(v0[2] * ub2(g.x), v0[3] * ub3(g.x));
                    w.z = cvt_pk_bf16(v1[0] * ub0(g.y), v1[1] * ub1(g.y)); w.w = cvt_pk_bf16(v1[2] * ub2(g.y), v1[3] * ub3(g.y));
                    *(u32x4*)(O + rr * DM + col0 + bj * 128) = w; } }
    }
};
struct EpiOut {
    static constexpr bool PERM = true, MID = false, FP8 = false, ASM_MFMA = false, BTILED = false; static constexpr int SCALE_A = 0x7f, SCALE_B = 0x7f;
    const float* X; float* out; unsigned char* HB8; int noop; bf16* H1B;
    __device__ __forceinline__ void mid(pg8::f32x4 (&)[2][2][4][2], const Unit&, int, int, int, int, int) const {}
    __device__ __forceinline__ void operator()(const pg8::f32x4 (&acc)[2][2][4][2], const Unit& u, int wr, int wc, int fr, int fq) const {
        asm volatile("" : "+v"(fr), "+v"(fq));
        if (noop == 1) return;
        const int row0 = u.pm * 256 + wr * 64 + fr, col0 = u.pn * 256 + wc * 32 + 8 * fq;
#pragma unroll
        for (int ai = 0; ai < 2; ++ai) {
            pg8::f32x4 xv[4][2][2];
#pragma unroll
            for (int m = 0; m < 4; ++m) { const size_t off = (size_t)(row0 + ai * 128 + m * 16) * DM + col0;
#pragma unroll
                for (int bj = 0; bj < 2; ++bj) { if (noop == 11) { xv[m][bj][0] = (pg8::f32x4){0.f, 0.f, 0.f, 0.f}; xv[m][bj][1] = xv[m][bj][0]; } else { xv[m][bj][0] = *(const pg8::f32x4*)(X + off + bj * 128); xv[m][bj][1] = *(const pg8::f32x4*)(X + off + bj * 128 + 4); } } }
#pragma unroll
            for (int m = 0; m < 4; ++m) { const size_t off = (size_t)(row0 + ai * 128 + m * 16) * DM + col0;
#pragma unroll
                for (int bj = 0; bj < 2; ++bj) { const pg8::f32x4 h0 = xv[m][bj][0] + acc[ai][bj][m][0], h1 = xv[m][bj][1] + acc[ai][bj][m][1];
                    if (H1_BF16) { u32x4 hb; hb.x = cvt_pk_bf16(h0[0], h0[1]); hb.y = cvt_pk_bf16(h0[2], h0[3]); hb.z = cvt_pk_bf16(h1[0], h1[1]); hb.w = cvt_pk_bf16(h1[2], h1[3]); *(u32x4*)(H1B + off + bj * 128) = hb; }
                    else if (noop != 12) { *(pg8::f32x4*)(out + off + bj * 128) = h0; *(pg8::f32x4*)(out + off + bj * 128 + 4) = h1; }
                    u32x2 w; w.x = pk4_fp8(h0[0] * H8_MUL, h0[1] * H8_MUL, h0[2] * H8_MUL, h0[3] * H8_MUL); w.y = pk4_fp8(h1[0] * H8_MUL, h1[1] * H8_MUL, h1[2] * H8_MUL, h1[3] * H8_MUL);
                    if (noop != 13) *(u32x2*)(HB8 + off + bj * 128) = w; } }
            asm volatile("" ::: "memory");
        }
    }
};
struct EpiGateUp {
    static constexpr bool PERM = true, MID = false, FP8 = true, ASM_MFMA = true, BTILED = true; static constexpr int SCALE_A = 127 - H8_SHIFT, SCALE_B = 127 - W8_SHIFT;
    const float* RS; const float* bgu; unsigned char* ACT8;
    __device__ __forceinline__ void mid(pg8::f32x4 (&)[2][2][4][2], const Unit&, int, int, int, int, int) const {}
    __device__ __forceinline__ void operator()(const pg8::f32x4 (&acc)[2][2][4][2], const Unit& u, int wr, int wc, int fr, int fq) const {
        asm volatile("" : "+v"(fr), "+v"(fq));
        const int r0 = wr * 64 + fr, hc0 = u.pn * 128 + wc * 32 + 8 * fq;
        const float* bg = bgu + (size_t)u.e * 4096 + hc0;
        const pg8::f32x4 bg0 = *(const pg8::f32x4*)(bg), bg1 = *(const pg8::f32x4*)(bg + 4), bu0 = *(const pg8::f32x4*)(bg + 2048), bu1 = *(const pg8::f32x4*)(bg + 2052);
        float rsv[2][4];
#pragma unroll
        for (int ai = 0; ai < 2; ++ai)
#pragma unroll
            for (int m = 0; m < 4; ++m) rsv[ai][m] = RS[u.e * CAP + 256 * u.pm + r0 + ai * 128 + m * 16];
#pragma unroll
        for (int ai = 0; ai < 2; ++ai)
#pragma unroll
            for (int m = 0; m < 4; ++m) { const int rl = r0 + ai * 128 + m * 16;
                const float rs = rsv[ai][m];
                typedef pg8::f32x2 f2;
                f2 a2[4];
#pragma unroll
                for (int n = 0; n < 2; ++n)
#pragma unroll
                    for (int hq = 0; hq < 2; ++hq) {
                        const f2 ag = {acc[ai][0][m][n][2 * hq], acc[ai][0][m][n][2 * hq + 1]}, au = {acc[ai][1][m][n][2 * hq], acc[ai][1][m][n][2 * hq + 1]};
                        const f2 bgv = n ? (f2){bg1[2 * hq], bg1[2 * hq + 1]} : (f2){bg0[2 * hq], bg0[2 * hq + 1]}, buv = n ? (f2){bu1[2 * hq], bu1[2 * hq + 1]} : (f2){bu0[2 * hq], bu0[2 * hq + 1]};
                        f2 g = ag * rs + bgv, up = au * rs + buv;
                        g.x = fminf(g.x, SWIGLU_LIMIT); g.y = fminf(g.y, SWIGLU_LIMIT);
                        up.x = __builtin_amdgcn_fmed3f(up.x, -SWIGLU_LIMIT, SWIGLU_LIMIT); up.y = __builtin_amdgcn_fmed3f(up.y, -SWIGLU_LIMIT, SWIGLU_LIMIT);
                        const f2 t = g * (-SWIGLU_ALPHA * LOG2E);
                        f2 e; e.x = __builtin_amdgcn_exp2f(t.x); e.y = __builtin_amdgcn_exp2f(t.y);
                        const f2 d = e + 1.0f;
                        f2 r; r.x = __builtin_amdgcn_rcpf(d.x); r.y = __builtin_amdgcn_rcpf(d.y);
                        const f2 sg = (g * ACT8_MUL) * r;
                        a2[2 * n + hq] = up * sg + sg;
                    }
                u32x2 w;
                { int p0 = __builtin_amdgcn_cvt_pk_fp8_f32(a2[0].x, a2[0].y, 0, false); p0 = __builtin_amdgcn_cvt_pk_fp8_f32(a2[1].x, a2[1].y, p0, true); w.x = (unsigned)p0;
                  int p1 = __builtin_amdgcn_cvt_pk_fp8_f32(a2[2].x, a2[2].y, 0, false); p1 = __builtin_amdgcn_cvt_pk_fp8_f32(a2[3].x, a2[3].y, p1, true); w.y = (unsigned)p1; }
                *(u32x2*)(ACT8 + (size_t)(u.kind + rl) * DM + hc0) = w; }
    }
};
struct EpiDown {
    static constexpr bool PERM = true, MID = false, FP8 = true, ASM_MFMA = true, BTILED = true; static constexpr int SCALE_A = 127 - ACT8_SHIFT, SCALE_B = 127 - W8_SHIFT;
    const float* bd; bf16* Y; int noop;
    __device__ __forceinline__ void mid(pg8::f32x4 (&)[2][2][4][2], const Unit&, int, int, int, int, int) const {}
    __device__ __forceinline__ void operator()(const pg8::f32x4 (&acc)[2][2][4][2], const Unit& u, int wr, int wc, int fr, int fq) const {
        asm volatile("" : "+v"(fr), "+v"(fq));
        if (noop) return;
        const int r0 = wr * 64 + fr, col0 = u.pn * 256 + wc * 32 + 8 * fq;
        const float* bb = bd + (size_t)u.e * DM + col0;
        pg8::f32x4 bv[2][2];
#pragma unroll
        for (int bj = 0; bj < 2; ++bj)
#pragma unroll
            for (int n = 0; n < 2; ++n) bv[bj][n] = *(const pg8::f32x4*)(bb + bj * 128 + n * 4);
#pragma unroll
        for (int ai = 0; ai < 2; ++ai)
#pragma unroll
            for (int m = 0; m < 4; ++m) { bf16* rowp = Y + (size_t)(u.kind + r0 + ai * 128 + m * 16) * DM + col0;
#pragma unroll
                for (int bj = 0; bj < 2; ++bj) { const pg8::f32x4 v0 = acc[ai][bj][m][0] + bv[bj][0], v1 = acc[ai][bj][m][1] + bv[bj][1];
                    u32x4 w; w.x = cvt_pk_bf16(v0[0], v0[1]); w.y = cvt_pk_bf16(v0[2], v0[3]); w.z = cvt_pk_bf16(v1[0], v1[1]); w.w = cvt_pk_bf16(v1[2], v1[3]);
                    *(u32x4*)(rowp + bj * 128) = w; } }
    }
};

__device__ __forceinline__ void logf_cumsum(const Ctx& C) {
    LAS float* wt = (LAS float*)(C.lds + RING_OFF);
    for (int sq = (int)blockIdx.x; sq < BATCH * 12; sq += C.G) {
        const float* src = C.LOGF + (size_t)sq * SEQ + C.tid * 16; float* dst = C.CNEG + (size_t)sq * SEQ + C.tid * 16;
        f32x4 a[4]; float tot = 0.f;
#pragma unroll
        for (int j = 0; j < 4; ++j) { a[j] = *(const GAS f32x4*)(src + 4 * j); tot += (a[j].x + a[j].y) + (a[j].z + a[j].w); }
        float incl = tot;
#pragma unroll
        for (int o = 1; o < 64; o <<= 1) { const float n = __shfl_up(incl, o); if (C.lane >= o) incl += n; }
        if (C.lane == 63) wt[C.wave] = incl;
        __syncthreads();
        float run = incl - tot;
        for (int w = 0; w < C.wave; ++w) run += wt[w];
#pragma unroll
        for (int j = 0; j < 4; ++j) { f32x4 c; run += a[j].x; c.x = -run * LOG2E; run += a[j].y; c.y = -run * LOG2E; run += a[j].z; c.z = -run * LOG2E; run += a[j].w; c.w = -run * LOG2E; *(GAS f32x4*)(dst + 4 * j) = c; }
        __syncthreads();
    }
}

#ifndef CONV_FIRST_EIGHTHS
#define CONV_FIRST_EIGHTHS 4
#endif
namespace att {
typedef __attribute__((address_space(3))) const char* lds_cptr;
__device__ __forceinline__ void glds16(const void* gsrc, unsigned lds_dst) { unsigned keep;
    asm volatile("s_mov_b32 %0, m0\n\ts_mov_b32 m0, %2\n\ts_nop 0\n\tglobal_load_lds_dwordx4 %1, off\n\ts_mov_b32 m0, %0" : "=&s"(keep) : "v"(gsrc), "s"(lds_dst) : "memory"); }
typedef float f32x2_t __attribute__((ext_vector_type(2))); typedef __bf16 bf16x2_t __attribute__((ext_vector_type(2)));
__device__ __forceinline__ unsigned cvtpk_s(float lo, float hi) { f32x2_t v = {lo, hi}; bf16x2_t b = __builtin_convertvector(v, bf16x2_t); return __builtin_bit_cast(unsigned, b); }
__device__ __forceinline__ int crow(int r, int hi) { return (r & 3) + 8 * (r >> 2) + 4 * hi; }

template <int D> struct Geo {
    static constexpr int SLOTB = 64 * D * 2, NSLOT = (D == 64) ? 3 : 2, PPT = (D == 64) ? 2 : 4;
    static constexpr int LDS_K = 0, LDS_V = NSLOT * SLOTB, LDS_WS = 2 * NSLOT * SLOTB, LDS_WMIN = LDS_WS + 2048, LDS_OST = LDS_WMIN + 64, LDS_CB = LDS_OST + 8 * 4096, LDS_END = LDS_CB + 32768;
};

template <int D>
__device__ __forceinline__ void qkt(f32x16& p0, f32x16& p1, lds_cptr Kslot, const bf16x8* qr, int r32, int hi) {
    lds_cptr kb = Kslot + hi * 1024 + r32 * 16;
    p0 = f32x16{}; p1 = f32x16{};
#pragma unroll
    for (int d0 = 0; d0 < D / 16; ++d0) {
        const bf16x8 b0 = *(const LAS bf16x8*)(kb + d0 * 2048);
        const bf16x8 b1 = *(const LAS bf16x8*)(kb + d0 * 2048 + 512);
        p0 = __builtin_amdgcn_mfma_f32_32x32x16_bf16(b0, qr[d0], p0, 0, 0, 0); p1 = __builtin_amdgcn_mfma_f32_32x32x16_bf16(b1, qr[d0], p1, 0, 0, 0); }
}
template <int D>
__device__ __forceinline__ void pv(f32x16* o, int vb, bf16x8 pa0, bf16x8 pa1, bf16x8 pa2, bf16x8 pa3) {
#pragma unroll
    for (int d0 = 0; d0 < D / 32; ++d0) { s16x4 lo[4], hi[4];
#pragma unroll
        for (int ks = 0; ks < 4; ++ks) {
            asm volatile("ds_read_b64_tr_b16 %0,%1 offset:%c2" : "=&v"(lo[ks]) : "v"(vb), "i"(d0 * 4096 + ks * 1024) : "memory");
            asm volatile("ds_read_b64_tr_b16 %0,%1 offset:%c2" : "=&v"(hi[ks]) : "v"(vb), "i"(d0 * 4096 + ks * 1024 + 512) : "memory"); }
        asm volatile("s_waitcnt lgkmcnt(0)" ::: "memory"); __builtin_amdgcn_sched_barrier(0);
#define ATT_PK(k) (bf16x8){lo[k][0], lo[k][1], lo[k][2], lo[k][3], hi[k][0], hi[k][1], hi[k][2], hi[k][3]}
        o[d0] = __builtin_amdgcn_mfma_f32_32x32x16_bf16(pa0, ATT_PK(0), o[d0], 0, 0, 0);
        o[d0] = __builtin_amdgcn_mfma_f32_32x32x16_bf16(pa1, ATT_PK(1), o[d0], 0, 0, 0);
        o[d0] = __builtin_amdgcn_mfma_f32_32x32x16_bf16(pa2, ATT_PK(2), o[d0], 0, 0, 0);
        o[d0] = __builtin_amdgcn_mfma_f32_32x32x16_bf16(pa3, ATT_PK(3), o[d0], 0, 0, 0);
#undef ATT_PK
    }
}

template <int D, int MODE>
__device__ __forceinline__ void attn_unit(LAS unsigned char* shm, const bf16* Q, int pitchQ, const bf16* K, const bf16* V, int pitchKV, bf16* O, const float* cneg, float sink2, int qb, const float* qgain, const float* kgain, const float* ropet, float bqk = 0.f) {
    typedef Geo<D> G;
    int tid = threadIdx.x; asm volatile("" : "+v"(tid));
    const int lane = tid & 63, r32 = lane & 31, hi = lane >> 5; const int wid = __builtin_amdgcn_readfirstlane(tid >> 6);
    const int q0 = qb * 256, q0w = q0 + wid * 32;
    const unsigned lds0 = (unsigned)(uintptr_t)shm;
    LAS float* wsf = (LAS float*)(shm + G::LDS_WS) + wid * 64;
    LAS float* cb = (LAS float*)(shm + G::LDS_CB);
    const int j_lo = (MODE == 1) ? (qb > 0 ? 4 * qb - 2 : 0) : 0, j_hi = (MODE == 2) ? 4 : 4 * qb + 4;
    bf16x8 qr[D / 16];
    { const bf16* Qw = Q + (size_t)(q0w + r32) * pitchQ + hi * 8;
#pragma unroll
      for (int d0 = 0; d0 < D / 16; ++d0) qr[d0] = *(const GAS bf16x8*)(Qw + d0 * 16); }
    {
#define ATT_UNPK(dst, src) do { const v4u w_ = __builtin_bit_cast(v4u, src); dst[0] = pg8::bf_lo(w_.x); dst[1] = pg8::bf_hi(w_.x); dst[2] = pg8::bf_lo(w_.y); dst[3] = pg8::bf_hi(w_.y); dst[4] = pg8::bf_lo(w_.z); dst[5] = pg8::bf_hi(w_.z); dst[6] = pg8::bf_lo(w_.w); dst[7] = pg8::bf_hi(w_.w); } while (0)
#define ATT_PK8(dst, src) do { v4u w_; w_.x = cvtpk_s(src[0], src[1]); w_.y = cvtpk_s(src[2], src[3]); w_.z = cvtpk_s(src[4], src[5]); w_.w = cvtpk_s(src[6], src[7]); dst = __builtin_bit_cast(bf16x8, w_); } while (0)
        float ss = 0.f;
#pragma unroll
        for (int d0 = 0; d0 < D / 16; ++d0) { float t[8]; ATT_UNPK(t, qr[d0]);
#pragma unroll
            for (int j = 0; j < 8; ++j) ss += t[j] * t[j]; }
        { auto rr = __builtin_amdgcn_permlane32_swap(__float_as_uint(ss), __float_as_uint(ss), false, false); ss = __uint_as_float(rr[0]) + __uint_as_float(rr[1]); }
        const float rq = (1.0f / sqrtf(ss * (1.f / D) + NORM_EPS)) * ((D == 64 ? 0.125f : 0.08838834764831845f) * LOG2E);
        if constexpr (MODE == 1) {
            const float* cs = ropet + (size_t)(q0w + r32) * 64 + 8 * hi;
#pragma unroll
            for (int d0 = 0; d0 < 2; ++d0) { float x1[8], x2[8]; ATT_UNPK(x1, qr[d0]); ATT_UNPK(x2, qr[d0 + 2]);
                const float* g1 = qgain + 16 * d0 + 8 * hi;
                const f32x4 ga = *(const GAS f32x4*)g1, gb = *(const GAS f32x4*)(g1 + 4), gc = *(const GAS f32x4*)(g1 + 32), gd = *(const GAS f32x4*)(g1 + 36);
                const f32x4 c0 = *(const GAS f32x4*)(cs + 16 * d0), c1 = *(const GAS f32x4*)(cs + 16 * d0 + 4), s0 = *(const GAS f32x4*)(cs + 32 + 16 * d0), s1 = *(const GAS f32x4*)(cs + 36 + 16 * d0);
                const float gg1[8] = {ga.x, ga.y, ga.z, ga.w, gb.x, gb.y, gb.z, gb.w}, gg2[8] = {gc.x, gc.y, gc.z, gc.w, gd.x, gd.y, gd.z, gd.w};
                const float cc[8] = {c0.x, c0.y, c0.z, c0.w, c1.x, c1.y, c1.z, c1.w}, sn[8] = {s0.x, s0.y, s0.z, s0.w, s1.x, s1.y, s1.z, s1.w};
#pragma unroll
                for (int j = 0; j < 8; ++j) { const float a = (x1[j] * rq) * gg1[j], b = (x2[j] * rq) * gg2[j]; x1[j] = a * cc[j] - b * sn[j]; x2[j] = b * cc[j] + a * sn[j]; }
                ATT_PK8(qr[d0], x1); ATT_PK8(qr[d0 + 2], x2); asm volatile("" ::: "memory"); }
        } else {
#pragma unroll
            for (int d0 = 0; d0 < D / 16; ++d0) { float t[8]; ATT_UNPK(t, qr[d0]);
                const float* gp = qgain + 16 * d0 + 8 * hi; f32x4 ga = *(const GAS f32x4*)gp, gb = *(const GAS f32x4*)(gp + 4);
                if constexpr (MODE == 2) { ga = ga * *(const GAS f32x4*)(kgain + 16 * d0 + 8 * hi); gb = gb * *(const GAS f32x4*)(kgain + 16 * d0 + 8 * hi + 4); }
                t[0] = (t[0] * rq) * ga.x; t[1] = (t[1] * rq) * ga.y; t[2] = (t[2] * rq) * ga.z; t[3] = (t[3] * rq) * ga.w; t[4] = (t[4] * rq) * gb.x; t[5] = (t[5] * rq) * gb.y; t[6] = (t[6] * rq) * gb.z; t[7] = (t[7] * rq) * gb.w;
                ATT_PK8(qr[d0], t); asm volatile("" ::: "memory"); }
        }
#undef ATT_UNPK
#undef ATT_PK8
    }
    if constexpr (MODE == 2) {
        const int key = tid >> 1, hf = tid & 1; const bf16* kp = K + (size_t)key * pitchKV + 64 * hf; float ss = 0.f;
#pragma unroll
        for (int c = 0; c < 8; ++c) { const v4u w = *(const GAS v4u*)(kp + 8 * c); const float a0 = pg8::bf_lo(w.x), a1 = pg8::bf_hi(w.x), a2 = pg8::bf_lo(w.y), a3 = pg8::bf_hi(w.y), a4 = pg8::bf_lo(w.z), a5 = pg8::bf_hi(w.z), a6 = pg8::bf_lo(w.w), a7 = pg8::bf_hi(w.w);
            ss += (a0 * a0 + a1 * a1) + (a2 * a2 + a3 * a3) + (a4 * a4 + a5 * a5) + (a6 * a6 + a7 * a7); }
        ss += __shfl_xor(ss, 1);
        if (hf == 0) cb[key] = 1.0f / sqrtf(ss * (1.f / 128.f) + NORM_EPS);
    }
    if constexpr (MODE == 0) {
        const int nch = (q0 + 256) / 4;
        for (int c = tid; c < nch; c += 512) { const f32x4 v = *(const GAS f32x4*)(cneg + 4 * c); *(LAS f32x4*)(cb + 4 * c) = v; }
    }
#define ATT_DMA(j, slot) do { const int _s = (slot) * G::SLOTB; \
        if constexpr (D == 64) { \
            glds16(K + (size_t)(64 * (j) + lane) * pitchKV + wid * 8, (unsigned)__builtin_amdgcn_readfirstlane(lds0 + G::LDS_K + _s + wid * 1024)); \
            glds16(V + (size_t)(64 * (j) + 16 * (wid & 3) + (lane >> 2)) * pitchKV + (wid >> 2) * 32 + (lane & 3) * 8, (unsigned)__builtin_amdgcn_readfirstlane(lds0 + G::LDS_V + _s + wid * 1024)); \
        } else { \
            _Pragma("unroll") for (int _p = 0; _p < 2; ++_p) { const int _c = wid + 8 * _p; \
                glds16(K + (size_t)(64 * (j) + lane) * pitchKV + _c * 8, (unsigned)__builtin_amdgcn_readfirstlane(lds0 + G::LDS_K + _s + _c * 1024)); } \
            _Pragma("unroll") for (int _p = 0; _p < 2; ++_p) { const int _c = wid + 8 * _p; \
                glds16(V + (size_t)(64 * (j) + 16 * (_c & 3) + (lane >> 2)) * pitchKV + (_c >> 2) * 32 + (lane & 3) * 8, (unsigned)__builtin_amdgcn_readfirstlane(lds0 + G::LDS_V + _s + _c * 1024)); } \
        } } while (0)
    int slot_i = 0;
    constexpr bool REV = (MODE == 0);
    const int nst = j_hi - j_lo;
#define ATT_TILE(st_) (REV ? (j_hi - 1 - (st_)) : (j_lo + (st_)))
#pragma unroll
    for (int p = 0; p < G::NSLOT - 1; ++p) if (p < nst) ATT_DMA(ATT_TILE(p), p);
    float mhat = -1e30f, l_reg = 0.f; f32x16 o[D / 32];
#pragma unroll
    for (int d0 = 0; d0 < D / 32; ++d0) o[d0] = f32x16{};
    const lds_cptr shm3 = (lds_cptr)shm;
    const int vb0 = (int)(lds0 + G::LDS_V) + ((lane >> 4) & 1) * 32 + (lane & 3) * 8 + (4 * hi + ((lane & 15) >> 2)) * 64;
    const int qabs = q0w + r32;
    LAS float* wmin = (LAS float*)(shm + G::LDS_WMIN);
    for (int st = 0; st < nst; ++st) {
        const int j = ATT_TILE(st);
        if (G::NSLOT == 3 && st + 1 < nst) { if constexpr (G::PPT == 2) asm volatile("s_waitcnt vmcnt(2) lgkmcnt(0)\n\ts_barrier" ::: "memory"); else asm volatile("s_waitcnt vmcnt(4) lgkmcnt(0)\n\ts_barrier" ::: "memory"); }
        else asm volatile("s_waitcnt vmcnt(0) lgkmcnt(0)\n\ts_barrier" ::: "memory");
        if constexpr (MODE == 0) { if (st >= 5) {
            const LAS float* wm = wmin + ((st - 1) & 1) * 8; const f32x4 a = *(const LAS f32x4*)wm, b = *(const LAS f32x4*)(wm + 4);
            const float gmin = fminf(fminf(fminf(a.x, a.y), fminf(a.z, a.w)), fminf(fminf(b.x, b.y), fminf(b.z, b.w)));
            if (cb[64 * j + 63] + bqk < gmin - 40.0f) break; } }
        { const int sn_ = st + G::NSLOT - 1; if (sn_ < nst) { int sn = slot_i + G::NSLOT - 1; if (sn >= G::NSLOT) sn -= G::NSLOT; ATT_DMA(ATT_TILE(sn_), sn); } }
        bool need = true;
        if constexpr (MODE == 0) need = (64 * j <= q0w + 31);
        if constexpr (MODE == 1) need = (64 * j <= q0w + 31) && (64 * j + 63 >= q0w - 127);
        if (need) {
            f32x16 p0, p1;
            qkt<D>(p0, p1, shm3 + G::LDS_K + slot_i * G::SLOTB, qr, r32, hi);
            if constexpr (MODE == 2) {
                const LAS float* rkp = cb + 64 * j + 4 * hi;
#pragma unroll
                for (int g = 0; g < 4; ++g) { const f32x4 b0 = *(const LAS f32x4*)(rkp + 8 * g), b1 = *(const LAS f32x4*)(rkp + 32 + 8 * g);
#pragma unroll
                    for (int e = 0; e < 4; ++e) { p0[4 * g + e] *= b0[e]; p1[4 * g + e] *= b1[e]; } }
            }
            if constexpr (MODE == 0) {
                const LAS float* cbp = cb + 64 * j + 4 * hi;
#pragma unroll
                for (int g = 0; g < 4; ++g) { const f32x4 b0 = *(const LAS f32x4*)(cbp + 8 * g), b1 = *(const LAS f32x4*)(cbp + 32 + 8 * g);
#pragma unroll
                    for (int e = 0; e < 4; ++e) { p0[4 * g + e] += b0[e]; p1[4 * g + e] += b1[e]; } }
                if (64 * j + 63 > q0w) {
#pragma unroll
                    for (int r = 0; r < 16; ++r) { const int kv = 64 * j + crow(r, hi); if (kv > qabs) p0[r] = -INFINITY; if (kv + 32 > qabs) p1[r] = -INFINITY; } }
            }
            if constexpr (MODE == 1) {
#pragma unroll
                for (int r = 0; r < 16; ++r) { const int kv = 64 * j + crow(r, hi); const int d0_ = qabs - kv, d1_ = d0_ - 32;
                    if (d0_ < 0 || d0_ >= 128) p0[r] = -INFINITY; if (d1_ < 0 || d1_ >= 128) p1[r] = -INFINITY; }
            }
            float rm = fmaxf(p0[0], p1[0]);
#pragma unroll
            for (int r = 1; r < 16; ++r) rm = fmaxf(rm, fmaxf(p0[r], p1[r]));
            { auto rr = __builtin_amdgcn_permlane32_swap(__float_as_uint(rm), __float_as_uint(rm), false, false); rm = fmaxf(__uint_as_float(rr[0]), __uint_as_float(rr[1])); }
            if (__any(rm > mhat)) {
                const float mn = fmaxf(mhat, rm); const float f = __builtin_amdgcn_exp2f(mhat - mn); mhat = mn; l_reg *= f;
                if (hi == 0) wsf[r32] = f;
                asm volatile("s_waitcnt lgkmcnt(0)" ::: "memory");
#pragma unroll
                for (int g = 0; g < 4; ++g) { const f32x4 fv = *(const LAS f32x4*)(wsf + 8 * g + 4 * hi);
#pragma unroll
                    for (int d_ = 0; d_ < D / 32; ++d_)
#pragma unroll
                        for (int e = 0; e < 4; ++e) o[d_][4 * g + e] *= fv[e]; }
            }
            float sacc = 0.f;
#pragma unroll
            for (int r = 0; r < 16; ++r) { p0[r] = __builtin_amdgcn_exp2f(p0[r] - mhat); p1[r] = __builtin_amdgcn_exp2f(p1[r] - mhat); sacc += p0[r] + p1[r]; }
            l_reg += sacc;
            u32x4 pw0, pw1, pw2, pw3;
            pw0 = (u32x4){cvtpk_s(p0[0], p0[1]), cvtpk_s(p0[2], p0[3]), cvtpk_s(p0[4], p0[5]), cvtpk_s(p0[6], p0[7])};
            pw1 = (u32x4){cvtpk_s(p0[8], p0[9]), cvtpk_s(p0[10], p0[11]), cvtpk_s(p0[12], p0[13]), cvtpk_s(p0[14], p0[15])};
            pw2 = (u32x4){cvtpk_s(p1[0], p1[1]), cvtpk_s(p1[2], p1[3]), cvtpk_s(p1[4], p1[5]), cvtpk_s(p1[6], p1[7])};
            pw3 = (u32x4){cvtpk_s(p1[8], p1[9]), cvtpk_s(p1[10], p1[11]), cvtpk_s(p1[12], p1[13]), cvtpk_s(p1[14], p1[15])};
            pv<D>(o, vb0 + slot_i * G::SLOTB, __builtin_bit_cast(bf16x8, pw0), __builtin_bit_cast(bf16x8, pw1), __builtin_bit_cast(bf16x8, pw2), __builtin_bit_cast(bf16x8, pw3));
        }
        if constexpr (MODE == 0) { float mn = mhat;
#pragma unroll
            for (int of = 1; of < 32; of <<= 1) mn = fminf(mn, __shfl_xor(mn, of));
            if (lane == 0) wmin[(st & 1) * 8 + wid] = mn; }
        ++slot_i; if (slot_i == G::NSLOT) slot_i = 0;
    }
#undef ATT_DMA
#undef ATT_TILE
    if constexpr (MODE == 0) asm volatile("s_waitcnt vmcnt(0)" ::: "memory");
    { auto rr = __builtin_amdgcn_permlane32_swap(__float_as_uint(l_reg), __float_as_uint(l_reg), false, false); l_reg = __uint_as_float(rr[0]) + __uint_as_float(rr[1]); }
    if constexpr (MODE == 1) l_reg += __builtin_amdgcn_exp2f(sink2 - mhat);
    if (hi == 0) wsf[32 + r32] = l_reg;
    asm volatile("s_waitcnt lgkmcnt(0)" ::: "memory");
    float rli[16];
#pragma unroll
    for (int g = 0; g < 4; ++g) { const f32x4 lv = *(const LAS f32x4*)(wsf + 32 + 8 * g + 4 * hi);
#pragma unroll
        for (int e = 0; e < 4; ++e) rli[4 * g + e] = __builtin_amdgcn_rcpf(lv[e]); }
    bf16* Ow = O + (size_t)q0w * 2048;
    LAS bf16* stg = (LAS bf16*)(shm + G::LDS_OST) + wid * 2048;
#pragma unroll
    for (int ps = 0; ps < D / 64; ++ps) {
#pragma unroll
        for (int r = 0; r < 16; ++r) { const int orow = crow(r, hi);
#pragma unroll
            for (int dl = 0; dl < 2; ++dl) stg[orow * 64 + dl * 32 + r32] = (bf16)f2bf(o[2 * ps + dl][r] * rli[r]); }
        asm volatile("s_waitcnt lgkmcnt(0)" ::: "memory");
#pragma unroll
        for (int i = 0; i < 4; ++i) { const int row = i * 8 + (lane >> 3), ch = lane & 7; const v4u v = *(const LAS v4u*)(stg + row * 64 + ch * 8); *(GAS v4u*)(Ow + (size_t)row * 2048 + ps * 64 + ch * 8) = v; }
        asm volatile("s_waitcnt lgkmcnt(0)" ::: "memory");
    }
    asm volatile("s_waitcnt lgkmcnt(0)\n\ts_barrier" ::: "memory");
}
}

constexpr int NU_FOX = BATCH * 12 * 32, NU_SWA = BATCH * 12 * 32, NU_XM = BATCH * 4 * 32;
__device__ __forceinline__ int att_fetch(const Ctx& C, int q) {
    int v = 0; if (C.tid == 0) v = (int)__hip_atomic_fetch_add((unsigned*)(C.ctl + CW_QHEAD + 64 * q), 1u, RLX_AGENT); return v;
}

#ifndef ATT_XCD_Q
#define ATT_XCD_Q 0
#endif
constexpr int CW_XQ = 1024;
template <class F>
__device__ __forceinline__ void xq_run(const Ctx& C, int kind, int N, volatile LAS int* nxtw, F&& unit) {
    const int xcd = (int)blockIdx.x & 7;
    unsigned* heads = (unsigned*)(C.ctl + CW_XQ + 512 * kind);
    int q = xcd, xs = 0, pre = 0;
    if (C.tid == 0) pre = (int)__hip_atomic_fetch_add(heads + 64 * q, 1u, RLX_AGENT);
    for (;;) {
        if (C.tid == 0) { int qq = q, s = xs, v = pre;
            while (v >= N && ++s < 8) { qq = (xcd + s) & 7; v = (int)__hip_atomic_fetch_add(heads + 64 * qq, 1u, RLX_AGENT); }
            *nxtw = (s < 8) ? (qq | (v << 3) | (s << 16)) : -1; }
        __syncthreads();
        const int cur = __builtin_amdgcn_readfirstlane(*nxtw);
        __syncthreads();
        if (cur < 0) break;
        q = cur & 7; xs = cur >> 16;
        if (C.tid == 0) pre = (int)__hip_atomic_fetch_add(heads + 64 * q, 1u, RLX_AGENT);
        unit(q, (cur >> 3) & 0x1FFF);
    }
}
__device__ __forceinline__ void phase3(const Ctx& C, int sel = 0) {
    LAS unsigned char* shm = C.lds + RING_OFF;
    volatile LAS int* nxtw = (volatile LAS int*)(C.MISC + 12);
    const bool gate_wg = GATES_IN_P3 && sel == 0 && (int)blockIdx.x < GATE_WGS;
    if (gate_wg) {
        P1bGrpOrder S8; S8.d.init(C.XN8, C.Win8, T, 6144, GATE_WGS, (int)blockIdx.x);
        EpiGates E8{C.G_};
        pg8::gemm_phase<EpiGates, P1bGrpOrder>(C.lds + RING_OFF, S8, E8);
        __syncthreads();
    }
    const bool conv_first = CONV_IN_P3 && sel == 0 && !gate_wg && (((blockIdx.x >> 3) & 7) < CONV_FIRST_EIGHTHS);
    auto run_conv = [&]() {
        if (!(CONV_IN_P3 && (sel == 0 || sel == 8 || ((sel == 9 || sel == 10 || sel == 11) && ((blockIdx.x >> 3) & 1))))) return;
        int pre = att_fetch(C, 3);
        if (C.tid == 0) *nxtw = pre;
        p0_fill_lnorm(C, (LAS float*)(C.lds + RING_OFF + 65536));
        __syncthreads();
        int cur = __builtin_amdgcn_readfirstlane(*nxtw);
        __syncthreads();
        const int nchunk = sel == 11 ? 256 : (CONV_COOP ? CONV2_NCHUNK : CONV_NCHUNK);
        while (cur < nchunk) {
            pre = att_fetch(C, 3);
            if (CONV_COOP) conv_chunk2(C, cur); else conv_chunk(C, cur);
            if (C.tid == 0) *nxtw = pre;
            __syncthreads();
            cur = __builtin_amdgcn_readfirstlane(*nxtw);
            __syncthreads();
        }
    };
    if (conv_first) run_conv();
    const bool att10 = (sel == 10 || sel == 11) && !((blockIdx.x >> 3) & 1);
    if (sel == 0 || sel == 4 || sel == 7 || att10) {
        float gq = fabsf(C.fox_q_norm[C.lane]), gk = fabsf(C.fox_k_norm[C.lane]);
#pragma unroll
        for (int of = 1; of < 64; of <<= 1) { gq = fmaxf(gq, __shfl_xor(gq, of)); gk = fmaxf(gk, __shfl_xor(gk, of)); }
        const float bqk = 64.0f * gq * gk * (0.125f * LOG2E) * 1.02f;
        if (ATT_XCD_Q) {
            xq_run(C, 0, 96, nxtw, [&](int q, int idx) {
                const int qb = 31 - idx / 3, bh = q + 8 * (idx % 3), b = bh / 12, h = bh % 12;
                const bf16* base = C.QKV + (size_t)b * SEQ * QKVW + h * 64;
                att::attn_unit<64, 0>(shm, base + C_FQ, QKVW, base + C_FK, base + C_FV, QKVW, C.OALL + (size_t)b * SEQ * 2048 + h * 64, C.CNEG + (size_t)(b * 12 + h) * SEQ, 0.f, qb, C.fox_q_norm, nullptr, nullptr, bqk); });
        } else {
        int pre = att_fetch(C, 0);
        if (C.tid == 0) *nxtw = pre;
        __syncthreads();
        int cur = __builtin_amdgcn_readfirstlane(*nxtw);
        __syncthreads();
        while (cur < NU_FOX) {
            pre = att_fetch(C, 0);
            const int qb = 31 - cur / 24, bh = cur % 24, b = bh / 12, h = bh % 12;
            const bf16* base = C.QKV + (size_t)b * SEQ * QKVW + h * 64;
            att::attn_unit<64, 0>(shm, base + C_FQ, QKVW, base + C_FK, base + C_FV, QKVW, C.OALL + (size_t)b * SEQ * 2048 + h * 64, C.CNEG + (size_t)(b * 12 + h) * SEQ, 0.f, qb, C.fox_q_norm, nullptr, nullptr, bqk);
            if (C.tid == 0) *nxtw = pre;
            __syncthreads();
            cur = __builtin_amdgcn_readfirstlane(*nxtw);
            __syncthreads();
        }
        }
    }
    if (sel == 0 || sel == 5 || sel == 7 || att10) {
        if (ATT_XCD_Q) {
            xq_run(C, 1, 96, nxtw, [&](int q, int idx) {
                const int qb = idx / 3, b = q >> 2, kvh = q & 3, h = kvh * 3 + idx % 3;
                const bf16* base = C.QKV + (size_t)b * SEQ * QKVW;
                att::attn_unit<64, 1>(shm, base + C_SQ + h * 64, QKVW, base + C_SK + kvh * 64, base + C_SV + kvh * 64, QKVW, C.OALL + (size_t)b * SEQ * 2048 + 768 + h * 64, nullptr, C.swa_sinks[h] * LOG2E, qb, C.swa_q_norm, nullptr, C.ROPE + (size_t)b * SEQ * 64); });
        } else {
        int pre = att_fetch(C, 1);
        if (C.tid == 0) *nxtw = pre;
        __syncthreads();
        int cur = __builtin_amdgcn_readfirstlane(*nxtw);
        __syncthreads();
        while (cur < NU_SWA) {
            pre = att_fetch(C, 1);
            const int qb = cur / 24, bh = cur % 24, b = bh / 12, h = bh % 12, kvh = h / 3;
            const bf16* base = C.QKV + (size_t)b * SEQ * QKVW;
            att::attn_unit<64, 1>(shm, base + C_SQ + h * 64, QKVW, base + C_SK + kvh * 64, base + C_SV + kvh * 64, QKVW, C.OALL + (size_t)b * SEQ * 2048 + 768 + h * 64, nullptr, C.swa_sinks[h] * LOG2E, qb, C.swa_q_norm, nullptr, C.ROPE + (size_t)b * SEQ * 64);
            if (C.tid == 0) *nxtw = pre;
            __syncthreads();
            cur = __builtin_amdgcn_readfirstlane(*nxtw);
            __syncthreads();
        }
        }
    }
    if (sel == 0 || sel == 6 || sel == 7 || att10) {
        if (ATT_XCD_Q) {
            xq_run(C, 2, 32, nxtw, [&](int q, int qb) {
                const int b = q >> 2, h = q & 3;
                const bf16* kb = C.MKV + (size_t)b * NMEM * 1024 + h * 128;
                att::attn_unit<128, 2>(shm, C.QKV + (size_t)b * SEQ * QKVW + C_MQ + h * 128, QKVW, kb, kb + 512, 1024, C.OALL + (size_t)b * SEQ * 2048 + 1536 + h * 128, nullptr, 0.f, qb, C.xmem_q_norm, C.xmem_k_norm, nullptr); });
        } else {
        int pre = att_fetch(C, 2);
        if (C.tid == 0) *nxtw = pre;
        __syncthreads();
        int cur = __builtin_amdgcn_readfirstlane(*nxtw);
        __syncthreads();
        while (cur < NU_XM) {
            pre = att_fetch(C, 2);
            const int qb = cur / 8, bh = cur % 8, b = bh / 4, h = bh % 4;
            const bf16* kb = C.MKV + (size_t)b * NMEM * 1024 + h * 128;
            att::attn_unit<128, 2>(shm, C.QKV + (size_t)b * SEQ * QKVW + C_MQ + h * 128, QKVW, kb, kb + 512, 1024, C.OALL + (size_t)b * SEQ * 2048 + 1536 + h * 128, nullptr, 0.f, qb, C.xmem_q_norm, C.xmem_k_norm, nullptr);
            if (C.tid == 0) *nxtw = pre;
            __syncthreads();
            cur = __builtin_amdgcn_readfirstlane(*nxtw);
            __syncthreads();
        }
        }
    }
    if (!conv_first) run_conv();
}

__device__ __forceinline__ void phase6(const Ctx& C) {
    LAS float* PL = (LAS float*)(C.lds + RING_OFF);
    LAS float* SS = PL + 4 * 64 * 33;
    LAS int* hist = (LAS int*)(SS + 512);
    LAS int* gb = hist + 32;
    const int rg = C.wave & 1, kq = C.wave >> 1, r32 = C.lane & 31, hi = C.lane >> 5;
    const bf16* wh = C.Wr_t + (size_t)r32 * 2048 + 512 * kq + 16 * hi; const bf16* wl = wh + 32 * 2048;
    for (int blk = C.vcu; blk < T / 64; blk += C.G) {
        if (C.tid < 32) hist[C.tid] = 0;
        const int tok = blk * 64 + 32 * rg + r32;
        f32x16 acc = f32x16{}; float ss = 0.f;
        if (H1_BF16) {
            const bf16* hr = C.H1B + (size_t)tok * DM + 512 * kq + 16 * hi;
#pragma unroll 4
            for (int kb = 0; kb < 16; ++kb) {
#pragma unroll
                for (int s = 0; s < 2; ++s) {
                    const v4u bh = *(const GAS v4u*)(hr + 32 * kb + 8 * s);
                    ss += pg8::bf_lo(bh.x) * pg8::bf_lo(bh.x) + pg8::bf_hi(bh.x) * pg8::bf_hi(bh.x) + pg8::bf_lo(bh.y) * pg8::bf_lo(bh.y) + pg8::bf_hi(bh.y) * pg8::bf_hi(bh.y)
                        + pg8::bf_lo(bh.z) * pg8::bf_lo(bh.z) + pg8::bf_hi(bh.z) * pg8::bf_hi(bh.z) + pg8::bf_lo(bh.w) * pg8::bf_lo(bh.w) + pg8::bf_hi(bh.w) * pg8::bf_hi(bh.w);
                    const bf16x8 ah = *(const GAS bf16x8*)(wh + 32 * kb + 8 * s), al = *(const GAS bf16x8*)(wl + 32 * kb + 8 * s);
                    acc = __builtin_amdgcn_mfma_f32_32x32x16_bf16(ah, __builtin_bit_cast(bf16x8, bh), acc, 0, 0, 0);
                    acc = __builtin_amdgcn_mfma_f32_32x32x16_bf16(al, __builtin_bit_cast(bf16x8, bh), acc, 0, 0, 0);
                }
            }
        } else {
        const float* hr = C.out + (size_t)tok * DM + 512 * kq + 16 * hi;
#pragma unroll 2
        for (int kb = 0; kb < 16; ++kb) {
            float f[16];
#pragma unroll
            for (int q = 0; q < 4; ++q) { const f32x4 t = *(const GAS f32x4*)(hr + 32 * kb + 4 * q); f[4 * q] = t.x; f[4 * q + 1] = t.y; f[4 * q + 2] = t.z; f[4 * q + 3] = t.w; }
            unsigned hb[16], lb[16];
#pragma unroll
            for (int q = 0; q < 16; ++q) { ss += f[q] * f[q]; hb[q] = f2bf(f[q]); lb[q] = f2bf(f[q] - __uint_as_float(hb[q] << 16)); }
#pragma unroll
            for (int s = 0; s < 2; ++s) {
                const bf16x8 ah = *(const GAS bf16x8*)(wh + 32 * kb + 8 * s), al = *(const GAS bf16x8*)(wl + 32 * kb + 8 * s);
                v4u bh, bl;
                bh.x = hb[8 * s] | (hb[8 * s + 1] << 16); bh.y = hb[8 * s + 2] | (hb[8 * s + 3] << 16); bh.z = hb[8 * s + 4] | (hb[8 * s + 5] << 16); bh.w = hb[8 * s + 6] | (hb[8 * s + 7] << 16);
                bl.x = lb[8 * s] | (lb[8 * s + 1] << 16); bl.y = lb[8 * s + 2] | (lb[8 * s + 3] << 16); bl.z = lb[8 * s + 4] | (lb[8 * s + 5] << 16); bl.w = lb[8 * s + 6] | (lb[8 * s + 7] << 16);
                acc = __builtin_amdgcn_mfma_f32_32x32x16_bf16(ah, __builtin_bit_cast(bf16x8, bh), acc, 0, 0, 0);
                acc = __builtin_amdgcn_mfma_f32_32x32x16_bf16(ah, __builtin_bit_cast(bf16x8, bl), acc, 0, 0, 0);
                acc = __builtin_amdgcn_mfma_f32_32x32x16_bf16(al, __builtin_bit_cast(bf16x8, bh), acc, 0, 0, 0);
            }
        }
        }
        { LAS float* pr = PL + (size_t)(kq * 64 + 32 * rg + r32) * 33;
#pragma unroll
          for (int r = 0; r < 16; ++r) pr[att::crow(r, hi)] = acc[r];
          SS[(kq * 2 + hi) * 64 + 32 * rg + r32] = ss; }
        __syncthreads();
        int sel[4]; float gt[4]; float rstd = 0.f; int lr[4];
        if (C.tid < 64) {
            float lv[32]; float s2 = 0.f;
#pragma unroll
            for (int q = 0; q < 8; ++q) s2 += SS[q * 64 + C.tid];
            rstd = 1.0f / sqrtf(s2 * (1.f / DM) + NORM_EPS);
#pragma unroll
            for (int e = 0; e < 32; ++e) { const float a = (PL[(0 * 64 + C.tid) * 33 + e] + PL[(1 * 64 + C.tid) * 33 + e]) + (PL[(2 * 64 + C.tid) * 33 + e] + PL[(3 * 64 + C.tid) * 33 + e]); lv[e] = a * rstd + C.b_router[e]; }
            float val[4];
#pragma unroll
            for (int k = 0; k < 4; ++k) { float best = lv[0]; int bi = 0;
#pragma unroll
                for (int e = 1; e < 32; ++e) if (lv[e] > best) { best = lv[e]; bi = e; }
                sel[k] = bi; val[k] = best;
#pragma unroll
                for (int e = 0; e < 32; ++e) lv[e] = (e == bi) ? -INFINITY : lv[e]; }
            float den = 0.f;
#pragma unroll
            for (int k = 0; k < 4; ++k) { gt[k] = __expf(val[k] - val[0]); den += gt[k]; }
            const float inv = 1.0f / den;
#pragma unroll
            for (int k = 0; k < 4; ++k) { gt[k] *= inv; lr[k] = __hip_atomic_fetch_add((LAS int*)(hist + sel[k]), 1, __ATOMIC_RELAXED, __HIP_MEMORY_SCOPE_WORKGROUP); }
        }
        __syncthreads();
        if (C.tid < 32) gb[C.tid] = (int)__hip_atomic_fetch_add((unsigned*)(C.ctl + CW_CNT + C.tid), (unsigned)hist[C.tid], RLX_AGENT);
        __syncthreads();
        if (C.tid < 64) {
            const int t = blk * 64 + C.tid;
#pragma unroll
            for (int k = 0; k < 4; ++k) { const int sl = sel[k] * CAP + gb[sel[k]] + lr[k]; C.TOK[sl] = t; C.RS[sl] = rstd; C.TSLOT[t * 4 + k] = sl; C.TGATE[t * 4 + k] = gt[k]; }
        }
        __syncthreads();
    }
}
template <int NT>
__device__ __forceinline__ void moe_table(const Ctx& C, LAS int* tab) {
    __syncthreads();
    if (C.tid == 0) { int us = 0, rb = 0;
        for (int e = 0; e < 32; ++e) { const int n = (int)__hip_atomic_load((unsigned*)(C.ctl + CW_CNT + e), RLX_AGENT); const int mt = (n + 255) >> 8; tab[e] = us; tab[33 + e] = mt; tab[65 + e] = rb; tab[97 + e] = n; us += mt * NT; rb += mt * 256; }
        tab[32] = us; }
    __syncthreads();
}


#ifndef P9_NT
#define P9_NT 1
#endif
__device__ __forceinline__ void phase9(const Ctx& C, const LAS int* tab) {
    const int gw = C.vcu * NWAVES + C.wave, NGW = C.G * NWAVES;
    for (int t = gw; t < T; t += NGW) {
        typedef int v4i_ __attribute__((ext_vector_type(4))); const v4i_ sl = *(const GAS v4i_*)(C.TSLOT + 4 * t); const f32x4 g = *(const GAS f32x4*)(C.TGATE + 4 * t);
        const int s[4] = {sl.x, sl.y, sl.z, sl.w}; const float gg[4] = {g.x, g.y, g.z, g.w};
        const bf16* yr[4];
#pragma unroll
        for (int k = 0; k < 4; ++k) { const int e = s[k] >> 14, rk = s[k] & (CAP - 1); yr[k] = C.Y + (size_t)(tab[65 + e] + rk) * DM + 8 * C.lane; }
        float* orow = C.out + (size_t)t * DM + 8 * C.lane;
#pragma unroll
        for (int j = 0; j < 4; ++j) {
            f32x4 a0, a1;
            if (H1_BF16) { const v4u hv = P9_NT ? __builtin_nontemporal_load((const GAS v4u*)(C.H1B + (size_t)t * DM + 8 * C.lane + 512 * j)) : *(const GAS v4u*)(C.H1B + (size_t)t * DM + 8 * C.lane + 512 * j);
                a0.x = pg8::bf_lo(hv.x); a0.y = pg8::bf_hi(hv.x); a0.z = pg8::bf_lo(hv.y); a0.w = pg8::bf_hi(hv.y); a1.x = pg8::bf_lo(hv.z); a1.y = pg8::bf_hi(hv.z); a1.z = pg8::bf_lo(hv.w); a1.w = pg8::bf_hi(hv.w); }
            else { a0 = *(const GAS f32x4*)(orow + 512 * j); a1 = *(const GAS f32x4*)(orow + 512 * j + 4); }
#pragma unroll
            for (int k = 0; k < 4; ++k) { const v4u y = P9_NT ? __builtin_nontemporal_load((const GAS v4u*)(yr[k] + 512 * j)) : *(const GAS v4u*)(yr[k] + 512 * j);
                a0.x += gg[k] * pg8::bf_lo(y.x); a0.y += gg[k] * pg8::bf_hi(y.x); a0.z += gg[k] * pg8::bf_lo(y.y); a0.w += gg[k] * pg8::bf_hi(y.y);
                a1.x += gg[k] * pg8::bf_lo(y.z); a1.y += gg[k] * pg8::bf_hi(y.z); a1.z += gg[k] * pg8::bf_lo(y.w); a1.w += gg[k] * pg8::bf_hi(y.w); }
            if (P9_NT) { __builtin_nontemporal_store(a0, (GAS f32x4*)(orow + 512 * j)); __builtin_nontemporal_store(a1, (GAS f32x4*)(orow + 512 * j + 4)); }
            else { *(GAS f32x4*)(orow + 512 * j) = a0; *(GAS f32x4*)(orow + 512 * j + 4) = a1; }
        }
    }
}

#ifndef P4_PREFETCH_X
#define P4_PREFETCH_X 0
#endif
#ifndef MOE_ALIGN
#define MOE_ALIGN true
#endif
struct Args { const void* in[26]; float* out; unsigned char* ws; int ph_lo, ph_hi, probe, pad; };
__global__ void __launch_bounds__(NWAVES * 64, 2) mk_fwd(Args args) {
    extern __shared__ __attribute__((aligned(16))) unsigned char lds_raw[];
    Ctx C;
    C.lds = (LAS unsigned char*)lds_raw;
    C.MISC = (volatile LAS unsigned*)(C.lds + MISC_OFF);
    C.tid = threadIdx.x; C.lane = C.tid & 63; C.wave = __builtin_amdgcn_readfirstlane(C.tid >> 6);
    C.probe = args.probe; C.G = gridDim.x; { const int bx = blockIdx.x; C.vcu = (C.G % 8 == 0) ? (bx % 8) * (C.G / 8) + bx / 8 : bx; }
    unsigned char* ws = args.ws;
    C.ctl = (gu32*)(ws + WS_CTL);
    C.x = (const float*)args.in[0]; C.mem = (const float*)args.in[1]; C.pos = (const int*)args.in[2]; C.norm_mix = (const float*)args.in[3]; C.w_in = (const float*)args.in[4];
    C.b_forget = (const float*)args.in[5]; C.fox_q_norm = (const float*)args.in[6]; C.fox_k_norm = (const float*)args.in[7]; C.swa_q_norm = (const float*)args.in[8]; C.swa_k_norm = (const float*)args.in[9];
    C.swa_sinks = (const float*)args.in[10]; C.xmem_q_norm = (const float*)args.in[11]; C.xmem_k_norm = (const float*)args.in[12]; C.norm_mem = (const float*)args.in[13]; C.w_mem_kv = (const float*)args.in[14];
    C.w_up_fox = (const float*)args.in[15]; C.w_up_swa = (const float*)args.in[16]; C.w_up_xmem = (const float*)args.in[17]; C.w_out = (const float*)args.in[18]; C.norm_ffn = (const float*)args.in[19];
    C.w_router = (const float*)args.in[20]; C.b_router = (const float*)args.in[21]; C.w_gate_up = (const float*)args.in[22]; C.b_gate_up = (const float*)args.in[23]; C.w_down = (const float*)args.in[24]; C.b_down = (const float*)args.in[25];
    C.out = args.out;
#define WS_PTRS() do { unsigned char* w_ = args.ws; asm volatile("" : "+s"(w_)); \
    C.ctl = (gu32*)(w_ + WS_CTL); C.Win_t = (bf16*)(w_ + WS_WIN); C.Wmkv_t = (bf16*)(w_ + WS_WMKV); C.Wup_t = (bf16*)(w_ + WS_WUP); C.Wout_t = (bf16*)(w_ + WS_WOUT); C.Wr_t = (bf16*)(w_ + WS_WRT); C.Wgu_t = (bf16*)(w_ + WS_WGU); C.Wd_t = (bf16*)(w_ + WS_WD); \
    C.XN = (bf16*)(w_ + WS_XN); C.MN = (bf16*)(w_ + WS_MN); C.QKV = (bf16*)(w_ + WS_QKV); C.H1B = (bf16*)(w_ + WS_QKV);        C.G_ = (bf16*)(w_ + WS_G); C.MKV = (bf16*)(w_ + WS_MKV); C.OALL = (bf16*)(w_ + WS_OALL); C.MERGED = (bf16*)(w_ + WS_MERGED); \
    C.HB = (bf16*)(w_ + WS_HB); C.ACT = (bf16*)(w_ + WS_ACT); C.LOGF = (float*)(w_ + WS_LOGF); C.CNEG = (float*)(w_ + WS_CNEG); C.ROPE = (float*)(w_ + WS_ROPE); C.GATEW = (float*)(w_ + WS_GATE); C.RS = (float*)(w_ + WS_RS); \
    C.TOK = (int*)(w_ + WS_TOK); C.TSLOT = (int*)(w_ + WS_TSLOT); C.TGATE = (float*)(w_ + WS_TGATE); C.Y = (bf16*)(w_ + WS_Y); C.XN8 = w_ + WS_XN8; C.Win8 = w_ + WS_WIN8; } while (0)
    WS_PTRS();
    for (int u = C.tid; u < (LDS_BYTES - LDSCTL_OFF) / 4; u += NWAVES * 64) ((LAS unsigned*)(C.lds + LDSCTL_OFF))[u] = 0u;
    __syncthreads();
    XcdBarrier bar; bar.bar = (unsigned*)(C.ctl + CW_BAR); bar.x = 0; bar.st = nullptr;
    if (N_LAUNCHES == 1) bar = xcd_barrier_post((unsigned*)(C.ctl + CW_BAR), C.MISC + 8);
    const int lo = args.ph_lo, hi = args.ph_hi;
#ifndef MK_PHASE_MASK
#define MK_PHASE_MASK 0x3FF
#endif
#define IN(k) ((((MK_PHASE_MASK) >> (k)) & 1) && lo <= (k) && (k) < hi)
#define SEAM(k) do { if (IN(k) && IN((k) + 1)) xcd_barrier(bar); } while (0)
    LAS int* tab = (LAS int*)(C.lds + MOE_OFF);

    if (IN(0)) { WS_PTRS(); phase0(C); }
    SEAM(0);
    if (IN(1)) { WS_PTRS();
        logf_cumsum(C);
        P1Order S; S.d.init(C.XN, C.Win_t, T, PROBE_INW * 64, C.G, (int)blockIdx.x); S.A1 = (const char*)C.MN; S.B1 = (const char*)C.Wmkv_t;
        EpiInProj E{C.QKV, C.G_, C.MKV, args.probe == 1, C.fox_k_norm, C.swa_k_norm, C.ROPE};
        if (args.probe != 3) pg8::gemm_phase<EpiInProj, P1Order>(C.lds + RING_OFF, S, E);
        if (!GATES_IN_P3) {
            EpiGates E8{C.G_};
            const int kx = (int)blockIdx.x >> 3; const bool split = CONV_IN_P1B > 0 && CONV_IN_P3 && C.G == 256;
            if (split && (kx & 3) == 3) {
                volatile LAS int* nxtw = (volatile LAS int*)(C.MISC + 12);
                p0_fill_lnorm(C, (LAS float*)(C.lds + RING_OFF + 65536));
#pragma unroll 1
                for (int q = 0; q < CONV_IN_P1B; ++q) {
                    const int pre = att_fetch(C, 3);
                    if (C.tid == 0) *nxtw = pre;
                    __syncthreads();
                    const int cur = __builtin_amdgcn_readfirstlane(*nxtw);
                    __syncthreads();
                    if (cur < CONV_NCHUNK) conv_chunk(C, cur);
                }
            } else if (split) {
                P1bGrpOrder S8; S8.d.init(C.XN8, C.Win8, T, 6144, 192, (kx - ((kx + 1) >> 2)) * 8 + ((int)blockIdx.x & 7));
                pg8::gemm_phase<EpiGates, P1bGrpOrder>(C.lds + RING_OFF, S8, E8);
            } else {
                P1bOrder S8; S8.d.init(C.XN8, C.Win8, T, 6144, C.G, (int)blockIdx.x);
                pg8::gemm_phase<EpiGates, P1bOrder>(C.lds + RING_OFF, S8, E8);
            }
        }
    }
    SEAM(1);
    if (IN(3)) { WS_PTRS(); phase3(C, args.probe >= 4 ? args.probe : 0); }
    SEAM(3);
    if (IN(4)) { WS_PTRS();
        DenseOrder S; S.init(C.OALL, C.Wup_t, T, DM, C.G, (int)blockIdx.x);
        EpiMerge E{C.G_, C.MERGED, P4_PREFETCH_X ? C.x : nullptr, (args.probe >= 21 && args.probe <= 23) ? args.probe - 20 : 0};
        pg8::gemm_phase<EpiMerge, DenseOrder>(C.lds + RING_OFF, S, E);
    }
    SEAM(4);
    if (IN(5)) { WS_PTRS();
#ifdef P5_STAGGER
        if (((int)blockIdx.x >> 3) & 1) for (int d = 0; d < P5_STAGGER; ++d) __builtin_amdgcn_s_sleep(127);
#endif
        DenseOrder S; S.init(C.MERGED, C.Wout_t, T, DM, C.G, (int)blockIdx.x);
        EpiOut E{C.x, C.out, (unsigned char*)C.HB, args.probe == 1 ? 1 : (args.probe >= 11 && args.probe <= 13 ? args.probe : 0), C.H1B};
        pg8::gemm_phase<EpiOut, DenseOrder, false>(C.lds + RING_OFF, S, E);
    }
    SEAM(5);
    if (IN(6)) { WS_PTRS(); phase6(C); }
    SEAM(6);
    if (IN(7)) { WS_PTRS();
        moe_table<16>(C, tab);
        const int kx = (int)blockIdx.x >> 3; const bool conv_wg = WD_IN_P7 && CONV_IN_P3 && C.G == 256 && (kx % 5 == 4);
        if (conv_wg) {
            volatile LAS int* nxtw = (volatile LAS int*)(C.MISC + 12);
            int pre = att_fetch(C, 4);
            if (C.tid == 0) *nxtw = pre;
            __syncthreads();
            int cur = __builtin_amdgcn_readfirstlane(*nxtw);
            __syncthreads();
            while (cur < CONV_NCHUNK_WD) {
                pre = att_fetch(C, 4);
                conv_chunk_wd(C, cur);
                if (C.tid == 0) *nxtw = pre;
                __syncthreads();
                cur = __builtin_amdgcn_readfirstlane(*nxtw);
                __syncthreads();
            }
        } else {
            const bool split = WD_IN_P7 && CONV_IN_P3 && C.G == 256;
            const int gG = split ? 208 : C.G, gc = split ? ((int)blockIdx.x & 7) * 26 + (kx - (kx + 1) / 5) : C.vcu;
            MoeOrder<true, 16, 2048> S{(const char*)C.HB, (const char*)C.Wgu_t, C.TOK, (const int*)(C.ctl + CW_CNT), tab, gG, gc};
            EpiGateUp E{C.RS, C.b_gate_up, (unsigned char*)C.ACT};
            pg8::gemm_phase<EpiGateUp, MoeOrder<true, 16, 2048>, MOE_ALIGN>(C.lds + RING_OFF, S, E);
        }
    }
    SEAM(7);
    if (IN(8)) { WS_PTRS();
        moe_table<8>(C, tab);
#ifdef MOE_STAGGER
        for (int d = 0; d < (int)(blockIdx.x & 7); ++d) __builtin_amdgcn_s_sleep(MOE_STAGGER);
#endif
        MoeOrder<false, 8, 2048> S{(const char*)C.ACT, (const char*)C.Wd_t, C.TOK, (const int*)(C.ctl + CW_CNT), tab, C.G, C.vcu};
        EpiDown E{C.b_down, C.Y, args.probe == 1};
        pg8::gemm_phase<EpiDown, MoeOrder<false, 8, 2048>, MOE_ALIGN>(C.lds + RING_OFF, S, E);
    }
    SEAM(8);
    if (IN(9)) { WS_PTRS(); moe_table<8>(C, tab); phase9(C, tab);
#ifdef PROBE_DET
        if (blockIdx.x == 0 && C.tid == 0 && __hip_atomic_load((unsigned*)(C.ctl + 2048), RLX_AGENT) != 0u) C.out[12345] = __builtin_nanf("");
#endif
    }
#undef IN
#undef SEAM
}

extern "C" void kernel_launch(void* const* d_in, const int* in_sizes, int n_in, void* d_out, int out_size, void* d_ws, size_t ws_size, hipStream_t stream) {
    static int grid = 0;
    if (grid == 0) {
        if (n_in != 26 || out_size != T * DM || ws_size < WS_END) { fprintf(stderr, "kernel_launch: unexpected problem (n_in %d, out %d, ws %zu < %zu); nothing launched\n", n_in, out_size, ws_size, (size_t)WS_END); grid = -1; return; }
        int dev = 0, cus = 0, per_cu = 0;
        if (hipGetDevice(&dev) != hipSuccess || hipDeviceGetAttribute(&cus, hipDeviceAttributeMultiprocessorCount, dev) != hipSuccess) { grid = -1; return; }
        if (hipFuncSetAttribute((const void*)mk_fwd, hipFuncAttributeMaxDynamicSharedMemorySize, LDS_BYTES) != hipSuccess) { fprintf(stderr, "kernel_launch: hipFuncSetAttribute failed\n"); grid = -1; return; }
        if (hipOccupancyMaxActiveBlocksPerMultiprocessor(&per_cu, (const void*)mk_fwd, NWAVES * 64, LDS_BYTES) != hipSuccess || per_cu < 1) { fprintf(stderr, "kernel_launch: occupancy query says %d\n", per_cu); }
        (void)hipGetLastError();
        grid = cus;
    }
    if (grid < 0) return;
    if (hipMemsetAsync((char*)d_ws + WS_CTL, 0, CTL_ZERO_BYTES, stream) != hipSuccess) return;
#ifdef PROBE_MEMSET8
    hipMemsetAsync((char*)d_ws + WS_XN8, 0, 44 * MiB, stream);
#endif
    Args a{};
    for (int i = 0; i < 26; ++i) a.in[i] = d_in[i];
    a.out = (float*)d_out; a.ws = (unsigned char*)d_ws;
    if (N_LAUNCHES == 1) { a.ph_lo = 0; a.ph_hi = PER_PHASE; hipLaunchKernelGGL(mk_fwd, dim3(grid), dim3(NWAVES * 64), LDS_BYTES, stream, a); }
    else for (int oi = 0; oi < PER_PHASE; ++oi) { static const int order[PER_PHASE] = {0, 1, 2, 3, 4, 5, 6, 7, 8, 9}; const int li = order[oi]; a.ph_lo = li; a.ph_hi = li + 1;
#ifdef PROBE_SPLIT_P1
        if (li == 1) { a.probe = 2; hipLaunchKernelGGL(mk_fwd, dim3(grid), dim3(NWAVES * 64), LDS_BYTES, stream, a); a.probe = 3; hipLaunchKernelGGL(mk_fwd, dim3(grid), dim3(NWAVES * 64), LDS_BYTES, stream, a); a.probe = 0; continue; }
#endif
#if defined(PROBE_DUP) && defined(PROBE_FIRST)
        if (li == PROBE_DUP) { a.probe = PROBE_FLAG; hipLaunchKernelGGL(mk_fwd, dim3(grid), dim3(NWAVES * 64), LDS_BYTES, stream, a); a.probe = 0; }
#endif
        hipLaunchKernelGGL(mk_fwd, dim3(grid), dim3(NWAVES * 64), LDS_BYTES, stream, a);
#if defined(PROBE_DUP) && !defined(PROBE_FIRST)
        if (li == PROBE_DUP) { if (PROBE_DUP == 3 || PROBE_DUP == 6) hipMemsetAsync((char*)d_ws + WS_CTL, 0, 4096, stream);
#ifdef PROBE_FLAG
            a.probe = PROBE_FLAG;
#endif
            hipLaunchKernelGGL(mk_fwd, dim3(grid), dim3(NWAVES * 64), LDS_BYTES, stream, a); a.probe = 0; }
#endif
    }
    const hipError_t le = hipPeekAtLastError();
    if (le != hipSuccess) fprintf(stderr, "kernel_launch: launch failed: %s\n", hipGetErrorName(le));
}
```
